# Optimizing an MI355X kernel written in HIP

```python
import math
import jax, jax.numpy as jnp
from jax import lax
import numpy as np

D_MODEL = 1024
BATCH = 16
SEQ = 2048
DEPTH = 2

HEAD_DIM = 64
CONV_CH = 256
CONV_WIDTH = 31
DSA_HEADS = 6
MOBA_HEADS = 6
DSA_W = DSA_HEADS * HEAD_DIM
MOBA_W = MOBA_HEADS * HEAD_DIM
MIX_W = CONV_CH + DSA_W + MOBA_W
IDX_HEADS = 4
IDX_DIM = 32
DSA_TOPK = 256
DSA_Q_BLOCK = 128
MOBA_BLOCK = 256
MOBA_TOPK = 3
MOBA_Q_BLOCK = 16
ROPE_THETA = 500000.0
ROPE_FRACTION = 4
N_EXPERTS = 16
N_EXPERT_GROUPS = 4
EXPERTS_PER_GROUP = N_EXPERTS // N_EXPERT_GROUPS
TOP_K = 2
D_EXPERT = 256
EPS = 1e-6
IN_SPLITS = (CONV_CH, CONV_CH, DSA_W, HEAD_DIM, HEAD_DIM, IDX_HEADS * IDX_DIM, IDX_DIM, IDX_HEADS, MOBA_W, MOBA_W, MOBA_W)
IN_W = 2 * CONV_CH + DSA_W + 2 * HEAD_DIM + IDX_HEADS * IDX_DIM + IDX_DIM + IDX_HEADS + 3 * MOBA_W

kernel_name = 'hybrid_conv_dsa_moba_moe_block'

F32 = jnp.float32


def rms_norm(x, g):
    xf = x.astype(F32)
    y = xf * lax.rsqrt(jnp.mean(xf * xf, axis=-1, keepdims=True) + EPS)
    return (y * g.astype(F32)).astype(x.dtype)


def modulate(h, shift, scale):
    return h * (1 + scale[:, None, :]) + shift[:, None, :]


def rope_partial(x, pos):
    d = x.shape[-1]
    rot = d // ROPE_FRACTION
    half = rot // 2
    inv = jnp.exp(-math.log(ROPE_THETA) * (jnp.arange(half, dtype=F32) * 2.0 / rot))
    ang = pos.astype(F32)[:, None] * inv[None, :]
    cos = jnp.cos(ang)[:, None, :]
    sin = jnp.sin(ang)[:, None, :]
    xf = x.astype(F32)
    x1 = xf[..., :half]
    x2 = xf[..., half:rot]
    out = jnp.concatenate([x1 * cos - x2 * sin, x2 * cos + x1 * sin, xf[..., rot:]], axis=-1)
    return out.astype(x.dtype)


def conformer_conv(u, g, w_dw, b_dw, ln_g, ln_b):
    a = u * jax.nn.sigmoid(g)
    y = lax.conv_general_dilated(a, w_dw[:, None, :].astype(a.dtype), window_strides=(1,),
                                 padding=((CONV_WIDTH - 1, 0),),
                                 dimension_numbers=('NWC', 'WIO', 'NWC'),
                                 feature_group_count=CONV_CH)
    y = (y + b_dw).astype(F32)
    mu = jnp.mean(y, axis=-1, keepdims=True)
    var = jnp.mean(jnp.square(y - mu), axis=-1, keepdims=True)
    y = (y - mu) * lax.rsqrt(var + EPS) * ln_g.astype(F32) + ln_b.astype(F32)
    return jax.nn.silu(y).astype(u.dtype)


def dsa_attention(q, k, v, qi, ki, wi):
    B, L, H, dh = q.shape
    topk = min(DSA_TOPK, L // 4)
    nq = L // DSA_Q_BLOCK
    key_pos = jnp.arange(L)
    ki32 = ki.astype(F32)
    scale = dh ** -0.5

    def blocks(a):
        return jnp.moveaxis(a.reshape((B, nq, DSA_Q_BLOCK) + a.shape[2:]), 1, 0)

    def one_block(args):
        qb, qib, wib, t0 = args
        tq = t0 + jnp.arange(DSA_Q_BLOCK)
        logits = jnp.einsum('bqhd,bsd->bqhs', qib.astype(F32), ki32) * (IDX_DIM ** -0.5)
        score = jnp.einsum('bqh,bqhs->bqs', wib.astype(F32) * (IDX_HEADS ** -0.5), jax.nn.relu(logits))
        causal = key_pos[None, :] <= tq[:, None]
        score = jnp.where(causal[None], score, -jnp.inf)
        _, idx = lax.top_k(score, topk)
        valid = idx <= tq[None, :, None]
        k_sel = jax.vmap(lambda kk, ii: kk[ii])(k, idx)
        v_sel = jax.vmap(lambda vv, ii: vv[ii])(v, idx)
        s = jnp.einsum('bqhd,bqkd->bqhk', qb, k_sel).astype(F32) * scale
        s = jnp.where(valid[:, :, None, :], s, -jnp.inf)
        p = jax.nn.softmax(s, axis=-1).astype(v.dtype)
        return jnp.einsum('bqhk,bqkd->bqhd', p, v_sel)

    t0s = jnp.arange(nq, dtype=jnp.int32) * DSA_Q_BLOCK
    out = lax.map(one_block, (blocks(q), blocks(qi), blocks(wi), t0s))
    return jnp.moveaxis(out, 0, 1).reshape(B, L, H * dh)


def moba_attention(q, k, v):
    B, L, H, dh = q.shape
    nb = -(-L // MOBA_BLOCK)
    n_sel = min(MOBA_TOPK, nb - 1)
    pad = nb * MOBA_BLOCK - L
    scale = dh ** -0.5

    def to_blocks(a):
        a = jnp.pad(a, ((0, 0), (0, pad), (0, 0), (0, 0)))
        return a.reshape(B, nb, MOBA_BLOCK, H, dh).transpose(0, 3, 1, 2, 4)

    kb = to_blocks(k)
    vb = to_blocks(v)
    k_mean = jnp.mean(kb.astype(F32), axis=3)
    nq = L // MOBA_Q_BLOCK
    b_i = jnp.arange(B)[:, None, None, None]
    h_i = jnp.arange(H)[None, None, :, None]
    blk_ids = jnp.arange(nb)
    in_blk = jnp.arange(MOBA_BLOCK)

    def one_block(args):
        qb, t0 = args
        tq = t0 + jnp.arange(MOBA_Q_BLOCK)
        own = t0 // MOBA_BLOCK
        k_own = lax.dynamic_index_in_dim(kb, own, axis=2, keepdims=False)
        v_own = lax.dynamic_index_in_dim(vb, own, axis=2, keepdims=False)
        own_mask = (own * MOBA_BLOCK + in_blk)[None, :] <= tq[:, None]
        s_own = jnp.einsum('bqhd,bhkd->bqhk', qb, k_own).astype(F32) * scale
        s_own = jnp.where(own_mask[None, :, None, :], s_own, -jnp.inf)
        if n_sel == 0:
            p_own = jax.nn.softmax(s_own, axis=-1).astype(v.dtype)
            return jnp.einsum('bqhk,bhkd->bqhd', p_own, v_own)
        gate = jnp.einsum('bqhd,bhnd->bqhn', qb.astype(F32), k_mean)
        gate = jnp.where(blk_ids < own, gate, -jnp.inf)
        _, sel = lax.top_k(gate, n_sel)
        valid = sel < own
        k_sel = kb[b_i, h_i, sel]
        v_sel = vb[b_i, h_i, sel]
        s_past = jnp.einsum('bqhd,bqhnkd->bqhnk', qb, k_sel).astype(F32) * scale
        s_past = jnp.where(valid[..., None], s_past, -jnp.inf)
        s = jnp.concatenate([s_past.reshape(B, MOBA_Q_BLOCK, H, n_sel * MOBA_BLOCK), s_own], axis=-1)
        p = jax.nn.softmax(s, axis=-1).astype(v.dtype)
        p_past = p[..., :n_sel * MOBA_BLOCK].reshape(B, MOBA_Q_BLOCK, H, n_sel, MOBA_BLOCK)
        p_own = p[..., n_sel * MOBA_BLOCK:]
        return (jnp.einsum('bqhnk,bqhnkd->bqhd', p_past, v_sel)
                + jnp.einsum('bqhk,bhkd->bqhd', p_own, v_own))

    q_blocks = jnp.moveaxis(q.reshape(B, nq, MOBA_Q_BLOCK, H, dh), 1, 0)
    t0s = jnp.arange(nq, dtype=jnp.int32) * MOBA_Q_BLOCK
    out = lax.map(one_block, (q_blocks, t0s))
    return jnp.moveaxis(out, 0, 1).reshape(B, L, H * dh)


def token_mixers(h, pos, w_in, w_dw, b_dw, ln_g, ln_b, w_o):
    B, L, _ = h.shape
    proj = h @ w_in
    offs = np.cumsum(IN_SPLITS)[:-1].tolist()
    cu, cg, dq, dk, dv, iq, ik, iw, mq, mk, mv = jnp.split(proj, offs, axis=-1)
    y_conv = conformer_conv(cu, cg, w_dw, b_dw, ln_g, ln_b)
    dq = rope_partial(dq.reshape(B, L, DSA_HEADS, HEAD_DIM), pos)
    dk = rope_partial(dk[:, :, None, :], pos)[:, :, 0, :]
    iq = rope_partial(iq.reshape(B, L, IDX_HEADS, IDX_DIM), pos)
    ik = rope_partial(ik[:, :, None, :], pos)[:, :, 0, :]
    y_dsa = dsa_attention(dq, dk, dv, iq, ik, iw)
    mq = rope_partial(mq.reshape(B, L, MOBA_HEADS, HEAD_DIM), pos)
    mk = rope_partial(mk.reshape(B, L, MOBA_HEADS, HEAD_DIM), pos)
    mv = mv.reshape(B, L, MOBA_HEADS, HEAD_DIM)
    y_moba = moba_attention(mq, mk, mv)
    return jnp.concatenate([y_conv, y_dsa, y_moba], axis=-1) @ w_o


def grouped_moe(h, w_router, b_router, w_gate, w_up, w_down):
    B, L, D = h.shape
    aff = jax.nn.sigmoid(jnp.einsum('bld,de->ble', h.astype(F32), w_router.astype(F32)))
    biased = aff + b_router.astype(F32)
    grp = biased.reshape(B, L, N_EXPERT_GROUPS, EXPERTS_PER_GROUP)
    grp_score = jnp.sum(lax.top_k(grp, TOP_K)[0], axis=-1)
    best = jnp.argmax(grp_score, axis=-1)
    in_grp = (jnp.arange(N_EXPERTS) // EXPERTS_PER_GROUP) == best[..., None]
    _, top_idx = lax.top_k(jnp.where(in_grp, biased, -jnp.inf), TOP_K)
    w = jnp.take_along_axis(aff, top_idx, axis=-1)
    w = w / jnp.sum(w, axis=-1, keepdims=True)
    gates = jnp.sum(jax.nn.one_hot(top_idx, N_EXPERTS, dtype=F32) * w[..., None], axis=-2).astype(h.dtype)
    out = jnp.zeros_like(h)
    for e in range(N_EXPERTS):
        a = jax.nn.silu(h @ w_gate[e]) * (h @ w_up[e])
        out = out + gates[..., e:e + 1] * (a @ w_down[e])
    return out


def setup_inputs(seed: int = 0) -> dict:
    key = jax.random.key(seed)
    ks = jax.random.split(key, 18)

    def nrm(k, shape, s):
        return jax.random.normal(k, shape, F32) * s

    return {
        'x': nrm(ks[0], (BATCH, SEQ, D_MODEL), 1.0),
        'c': nrm(ks[1], (BATCH, D_MODEL), 1.0),
        'w_ada': nrm(ks[2], (DEPTH, D_MODEL, 6 * D_MODEL), 0.5 * D_MODEL ** -0.5),
        'b_ada': nrm(ks[3], (DEPTH, 6 * D_MODEL), 0.02),
        'g_mix': 1.0 + nrm(ks[4], (DEPTH, D_MODEL), 0.02),
        'w_in': nrm(ks[5], (DEPTH, D_MODEL, IN_W), D_MODEL ** -0.5),
        'w_dw': nrm(ks[6], (DEPTH, CONV_WIDTH, CONV_CH), CONV_WIDTH ** -0.5),
        'b_dw': nrm(ks[7], (DEPTH, CONV_CH), 0.02),
        'ln_conv_g': 1.0 + nrm(ks[8], (DEPTH, CONV_CH), 0.02),
        'ln_conv_b': nrm(ks[9], (DEPTH, CONV_CH), 0.02),
        'w_o': nrm(ks[10], (DEPTH, MIX_W, D_MODEL), MIX_W ** -0.5),
        'g_ffn': 1.0 + nrm(ks[11], (DEPTH, D_MODEL), 0.02),
        'w_router': nrm(ks[12], (D_MODEL, N_EXPERTS), D_MODEL ** -0.5),
        'b_router': nrm(ks[13], (N_EXPERTS,), 0.01),
        'w_gate': nrm(ks[14], (DEPTH, N_EXPERTS, D_MODEL, D_EXPERT), D_MODEL ** -0.5),
        'w_up': nrm(ks[15], (DEPTH, N_EXPERTS, D_MODEL, D_EXPERT), D_MODEL ** -0.5),
        'w_down': nrm(ks[16], (DEPTH, N_EXPERTS, D_EXPERT, D_MODEL), D_EXPERT ** -0.5),
        'g_final': 1.0 + nrm(ks[17], (D_MODEL,), 0.02),
    }


def reference(x, c, w_ada, b_ada, g_mix, w_in, w_dw, b_dw, ln_conv_g, ln_conv_b, w_o, g_ffn,
              w_router, b_router, w_gate, w_up, w_down, g_final):
    L = x.shape[1]
    pos = jnp.arange(L)
    c_act = jax.nn.silu(c)
    for l in range(DEPTH):
        mod = c_act @ w_ada[l] + b_ada[l]
        sh1, sc1, g1, sh2, sc2, g2 = jnp.split(mod, 6, axis=-1)
        h = modulate(rms_norm(x, g_mix[l]), sh1, sc1)
        x = x + g1[:, None, :] * token_mixers(h, pos, w_in[l], w_dw[l], b_dw[l], ln_conv_g[l], ln_conv_b[l], w_o[l])
        h = modulate(rms_norm(x, g_ffn[l]), sh2, sc2)
        x = x + g2[:, None, :] * grouped_moe(h, w_router, b_router, w_gate[l], w_up[l], w_down[l])
    return rms_norm(x, g_final)
```

```cpp
#include <hip/hip_runtime.h>
#include <cstdio>
#include <cstdint>

#define T_TOK 32768
#define DM 1024
#define SEQ 2048
#define NBATCH 16
#define INW 2340
#define C_CU 0
#define C_CG 256
#define C_DQ 512
#define C_DK 896
#define C_DV 960
#define C_IQ 1024
#define C_IK 1152
#define C_IW 1184
#define C_MQ 1188
#define C_MK 1572
#define C_MV 1956
#define LOG_THETA 13.122363377404328f
#define NCLS 24

__global__ void __launch_bounds__(256) k_mod(const float* __restrict__ c, const float* __restrict__ w_ada, float* __restrict__ part) {
    const int u = blockIdx.x, tid = threadIdx.x;
    const int kc = u % 8, cc = (u / 8) % 24, l = u / 192;
    __shared__ float ca[16][128];
    for (int i = tid; i < 2048; i += 256) { int b = i >> 7, k = i & 127; float v = c[b * 1024 + kc * 128 + k]; ca[b][k] = v / (1.0f + expf(-v)); }
    __syncthreads();
    const int n = cc * 256 + tid;
    float acc[16];
#pragma unroll
    for (int b = 0; b < 16; ++b) acc[b] = 0.f;
    const float* w = w_ada + ((size_t)l * 1024 + kc * 128) * 6144 + n;
    for (int k = 0; k < 128; ++k) {
        const float wv = w[(size_t)k * 6144];
#pragma unroll
        for (int b = 0; b < 16; ++b) acc[b] = fmaf(ca[b][k], wv, acc[b]);
    }
#pragma unroll
    for (int b = 0; b < 16; ++b) part[(((size_t)kc * 2 + l) * 16 + b) * 6144 + n] = acc[b];
}
__global__ void __launch_bounds__(256) k_modsum(const float* __restrict__ part, const float* __restrict__ b_ada, float* __restrict__ modf) {
    const int i = blockIdx.x * 256 + threadIdx.x;
    if (i >= 2 * 16 * 6144) return;
    const int n = i % 6144, l = i / (16 * 6144);
    float s = b_ada[l * 6144 + n];
    for (int kc = 0; kc < 8; ++kc) s += part[(size_t)kc * (2 * 16 * 6144) + i];
    modf[i] = s;
}

__global__ void __launch_bounds__(256) k_norm(const float* __restrict__ x, const float* __restrict__ g, const float* __restrict__ sh, const float* __restrict__ sc, float* __restrict__ out) {
    const int row = blockIdx.x * 4 + (threadIdx.x >> 6), lane = threadIdx.x & 63;
    const int b = row >> 11;
    const float4* xr = (const float4*)(x + (size_t)row * DM);
    float4 v[4]; float ss = 0.f;
#pragma unroll
    for (int i = 0; i < 4; ++i) { v[i] = xr[lane + 64 * i]; ss += v[i].x * v[i].x + v[i].y * v[i].y + v[i].z * v[i].z + v[i].w * v[i].w; }
#pragma unroll
    for (int o = 32; o >= 1; o >>= 1) ss += __shfl_xor(ss, o);
    const float rstd = 1.0f / sqrtf(ss * (1.0f / 1024.0f) + 1e-6f);
    float4* orow = (float4*)(out + (size_t)row * DM);
#pragma unroll
    for (int i = 0; i < 4; ++i) {
        const int k = (lane + 64 * i) * 4;
        const float4 gg = *(const float4*)(g + k);
        float4 y; y.x = v[i].x * rstd * gg.x; y.y = v[i].y * rstd * gg.y; y.z = v[i].z * rstd * gg.z; y.w = v[i].w * rstd * gg.w;
        if (sh) {
            const float4 s1 = *(const float4*)(sh + (size_t)b * 6144 + k), s2 = *(const float4*)(sc + (size_t)b * 6144 + k);
            y.x = y.x * (1.f + s2.x) + s1.x; y.y = y.y * (1.f + s2.y) + s1.y; y.z = y.z * (1.f + s2.z) + s1.z; y.w = y.w * (1.f + s2.w) + s1.w;
        }
        orow[lane + 64 * i] = y;
    }
}

template <class AF, class BF, class EF>
__device__ __forceinline__ void gemm64(int K, int ncols_valid, AF af, BF bf, EF ef) {
    __shared__ float As[16][68];
    __shared__ float Bs[16][68];
    const int tid = threadIdx.x, ty = tid >> 4, tx = tid & 15;
    float acc[4][4];
#pragma unroll
    for (int i = 0; i < 4; ++i)
#pragma unroll
        for (int j = 0; j < 4; ++j) acc[i][j] = 0.f;
    const int ar = tid >> 2, akq = (tid & 3) * 4;
    const float* arow = af(ar);
    const int bk = tid >> 4, bn4 = (tid & 15) * 4;
    for (int k0 = 0; k0 < K; k0 += 16) {
        float4 av = arow ? *(const float4*)(arow + k0 + akq) : make_float4(0.f, 0.f, 0.f, 0.f);
        float4 bv = make_float4(0.f, 0.f, 0.f, 0.f);
        if (bn4 < ncols_valid) bv = *(const float4*)(bf(k0 + bk) + bn4);
        __syncthreads();
        As[akq + 0][ar] = av.x; As[akq + 1][ar] = av.y; As[akq + 2][ar] = av.z; As[akq + 3][ar] = av.w;
        *(float4*)&Bs[bk][bn4] = bv;
        __syncthreads();
#pragma unroll
        for (int kk = 0; kk < 16; ++kk) {
            const float4 a = *(const float4*)&As[kk][ty * 4];
            const float4 b = *(const float4*)&Bs[kk][tx * 4];
            const float aa[4] = {a.x, a.y, a.z, a.w}, bb[4] = {b.x, b.y, b.z, b.w};
#pragma unroll
            for (int i = 0; i < 4; ++i)
#pragma unroll
                for (int j = 0; j < 4; ++j) acc[i][j] = fmaf(aa[i], bb[j], acc[i][j]);
        }
    }
#pragma unroll
    for (int i = 0; i < 4; ++i)
#pragma unroll
        for (int j = 0; j < 4; ++j) if (tx * 4 + j < ncols_valid) ef(ty * 4 + i, tx * 4 + j, acc[i][j]);
}

__global__ void __launch_bounds__(256) k_inproj(const float* __restrict__ hn, const float* __restrict__ w, float* __restrict__ proj) {
    const int tn = blockIdx.x % 37, tm = blockIdx.x / 37;
    const int n0 = tn * 64, m0 = tm * 64;
    const int nv = (INW - n0) < 64 ? (INW - n0) : 64;
    gemm64(1024, nv,
        [&](int r) { return hn + (size_t)(m0 + r) * DM; },
        [&](int k) { return w + (size_t)k * INW + n0; },
        [&](int r, int cidx, float v) { proj[(size_t)(m0 + r) * INW + n0 + cidx] = v; });
}
__global__ void __launch_bounds__(256) k_outproj(const float* __restrict__ ycat, const float* __restrict__ w, const float* __restrict__ xi, const float* __restrict__ g1, float* __restrict__ xo) {
    const int tn = blockIdx.x % 16, tm = blockIdx.x / 16;
    const int n0 = tn * 64, m0 = tm * 64;
    gemm64(1024, 64,
        [&](int r) { return ycat + (size_t)(m0 + r) * DM; },
        [&](int k) { return w + (size_t)k * DM + n0; },
        [&](int r, int cidx, float v) { const int row = m0 + r, col = n0 + cidx; const int b = row >> 11;
            xo[(size_t)row * DM + col] = xi[(size_t)row * DM + col] + g1[(size_t)b * 6144 + col] * v; });
}

__global__ void __launch_bounds__(256) k_rope(float* __restrict__ proj) {
    const int i = blockIdx.x * 256 + threadIdx.x;
    if (i >= T_TOK * 172) return;
    const int tok = i / 172; int p = i % 172;
    const int t = tok & 2047;
    int col, half, fi;
    if (p < 48) { col = C_DQ + (p >> 3) * 64 + (p & 7); half = 8; fi = p & 7; }
    else if (p < 56) { p -= 48; col = C_DK + p; half = 8; fi = p; }
    else if (p < 72) { p -= 56; col = C_IQ + (p >> 2) * 32 + (p & 3); half = 4; fi = p & 3; }
    else if (p < 76) { p -= 72; col = C_IK + p; half = 4; fi = p; }
    else if (p < 124) { p -= 76; col = C_MQ + (p >> 3) * 64 + (p & 7); half = 8; fi = p & 7; }
    else { p -= 124; col = C_MK + (p >> 3) * 64 + (p & 7); half = 8; fi = p & 7; }
    const float rot = (float)(2 * half);
    const float inv = expf(-LOG_THETA * ((float)fi * 2.0f / rot));
    const float ang = (float)t * inv;
    float sn, cs; sincosf(ang, &sn, &cs);
    float* r = proj + (size_t)tok * INW + col;
    const float x1 = r[0], x2 = r[half];
    r[0] = x1 * cs - x2 * sn;
    r[half] = x2 * cs + x1 * sn;
}

__global__ void __launch_bounds__(256) k_conv(const float* __restrict__ proj, const float* __restrict__ w_dw, const float* __restrict__ b_dw, const float* __restrict__ lg, const float* __restrict__ lb, float* __restrict__ ycat) {
    const int tok = blockIdx.x, ch = threadIdx.x, t = tok & 2047;
    float y = b_dw[ch];
    for (int i = 0; i < 31; ++i) {
        const int tt = t - 30 + i;
        if (tt >= 0) {
            const float* r = proj + (size_t)(tok - 30 + i) * INW;
            const float u = r[C_CU + ch], g = r[C_CG + ch];
            const float a = u * (1.0f / (1.0f + expf(-g)));
            y = fmaf(a, w_dw[i * 256 + ch], y);
        }
    }
    __shared__ float red[8];
    float s = y;
#pragma unroll
    for (int o = 32; o >= 1; o >>= 1) s += __shfl_xor(s, o);
    if ((ch & 63) == 0) red[ch >> 6] = s;
    __syncthreads();
    const float mu = (red[0] + red[1] + red[2] + red[3]) * (1.0f / 256.0f);
    const float d = y - mu;
    float q = d * d;
#pragma unroll
    for (int o = 32; o >= 1; o >>= 1) q += __shfl_xor(q, o);
    if ((ch & 63) == 0) red[4 + (ch >> 6)] = q;
    __syncthreads();
    const float var = (red[4] + red[5] + red[6] + red[7]) * (1.0f / 256.0f);
    float z = d * (1.0f / sqrtf(var + 1e-6f)) * lg[ch] + lb[ch];
    z = z / (1.0f + expf(-z));
    ycat[(size_t)tok * DM + ch] = z;
}

__global__ void __launch_bounds__(256) k_kmean(const float* __restrict__ proj, float* __restrict__ kmean) {
    const int i = blockIdx.x * 256 + threadIdx.x;
    if (i >= 49152) return;
    const int d = i & 63, blk = (i >> 6) & 7, h = (i >> 9) % 6, b = i / 3072;
    const float* r = proj + ((size_t)b * SEQ + blk * 256) * INW + C_MK + h * 64 + d;
    float s = 0.f;
    for (int k = 0; k < 256; ++k) s += r[(size_t)k * INW];
    kmean[i] = s * (1.0f / 256.0f);
}

__device__ __forceinline__ unsigned f2sortable(float f) { unsigned u = __float_as_uint(f); return (u & 0x80000000u) ? ~u : (u | 0x80000000u); }

__device__ __forceinline__ float block_max(float v, float* red) {
#pragma unroll
    for (int o = 32; o >= 1; o >>= 1) v = fmaxf(v, __shfl_xor(v, o));
    __syncthreads();
    if ((threadIdx.x & 63) == 0) red[threadIdx.x >> 6] = v;
    __syncthreads();
    return fmaxf(fmaxf(red[0], red[1]), fmaxf(red[2], red[3]));
}
__device__ __forceinline__ float block_sum(float v, float* red) {
#pragma unroll
    for (int o = 32; o >= 1; o >>= 1) v += __shfl_xor(v, o);
    __syncthreads();
    if ((threadIdx.x & 63) == 0) red[threadIdx.x >> 6] = v;
    __syncthreads();
    return (red[0] + red[1]) + (red[2] + red[3]);
}
__device__ __forceinline__ int block_sumi(int v, int* red) {
#pragma unroll
    for (int o = 32; o >= 1; o >>= 1) v += __shfl_xor(v, o);
    __syncthreads();
    if ((threadIdx.x & 63) == 0) red[threadIdx.x >> 6] = v;
    __syncthreads();
    return (red[0] + red[1]) + (red[2] + red[3]);
}

__global__ void __launch_bounds__(256) k_dsa(const float* __restrict__ proj, float* __restrict__ ycat) {
    const int tok = blockIdx.x, tid = threadIdx.x, t = tok & 2047, b = tok >> 11;
    __shared__ float qi[128]; __shared__ float wi[4];
    __shared__ unsigned su[2048];
    __shared__ float sv[2048];
    __shared__ unsigned char selm[2048];
    __shared__ float redf[4]; __shared__ int redi[4];
    __shared__ float qh[64]; __shared__ float part[4][64];
    const float* prow = proj + (size_t)tok * INW;
    if (tid < 128) qi[tid] = prow[C_IQ + tid];
    if (tid < 4) wi[tid] = prow[C_IW + tid] * 0.5f;
    __syncthreads();
    const int nk = t + 1;
    const float* pb = proj + (size_t)b * SEQ * INW;
    for (int j = tid; j < nk; j += 256) {
        const float* kr = pb + (size_t)j * INW + C_IK;
        float kk[32];
#pragma unroll
        for (int d = 0; d < 32; d += 4) { const float4 v = *(const float4*)(kr + d); kk[d] = v.x; kk[d + 1] = v.y; kk[d + 2] = v.z; kk[d + 3] = v.w; }
        float s = 0.f;
#pragma unroll
        for (int h = 0; h < 4; ++h) {
            float lg = 0.f;
#pragma unroll
            for (int d = 0; d < 32; ++d) lg = fmaf(qi[h * 32 + d], kk[d], lg);
            lg *= 0.17677669529663687f;
            s += wi[h] * fmaxf(lg, 0.f);
        }
        s += 0.0f;
        su[j] = f2sortable(s);
    }
    __syncthreads();
    if (nk <= 256) {
        for (int j = tid; j < nk; j += 256) selm[j] = 1;
    } else {
        unsigned lo = 0u, hi = 0xFFFFFFFFu;
        while (lo < hi) {
            const unsigned mid = lo + (unsigned)(((unsigned long long)hi - lo + 1ull) >> 1);
            int cnt = 0;
            for (int j = tid; j < nk; j += 256) cnt += (su[j] >= mid);
            cnt = block_sumi(cnt, redi);
            if (cnt >= 256) lo = mid; else hi = mid - 1u;
        }
        const unsigned v = lo;
        int cgt = 0;
        for (int j = tid; j < nk; j += 256) cgt += (su[j] > v);
        cgt = block_sumi(cgt, redi);
        const int m = 256 - cgt;
        int jl = 0, jh = nk - 1;
        while (jl < jh) {
            const int mid = (jl + jh) >> 1;
            int cnt = 0;
            for (int j = tid; j < nk; j += 256) cnt += (su[j] == v && j <= mid);
            cnt = block_sumi(cnt, redi);
            if (cnt >= m) jh = mid; else jl = mid + 1;
        }
        const int J = jl;
        for (int j = tid; j < nk; j += 256) { const unsigned u = su[j]; selm[j] = (u > v || (u == v && j <= J)) ? 1 : 0; }
    }
    __syncthreads();
    for (int h = 0; h < 6; ++h) {
        __syncthreads();
        if (tid < 64) qh[tid] = prow[C_DQ + h * 64 + tid];
        __syncthreads();
        float mx = -INFINITY;
        for (int j = tid; j < nk; j += 256) {
            float s = -INFINITY;
            if (selm[j]) {
                const float* kr = pb + (size_t)j * INW + C_DK;
                float a = 0.f;
                for (int d = 0; d < 64; ++d) a = fmaf(qh[d], kr[d], a);
                s = a * 0.125f;
            }
            sv[j] = s; mx = fmaxf(mx, s);
        }
        mx = block_max(mx, redf);
        float sm = 0.f;
        for (int j = tid; j < nk; j += 256) { const float e = expf(sv[j] - mx); sv[j] = e; sm += e; }
        sm = block_sum(sm, redf);
        const float inv = 1.0f / sm;
        const int d = tid & 63, qtr = tid >> 6;
        float o = 0.f;
        for (int j = qtr; j < nk; j += 4) { const float p = sv[j]; if (p != 0.f) o = fmaf(p, pb[(size_t)j * INW + C_DV + d], o); }
        part[qtr][d] = o;
        __syncthreads();
        if (tid < 64) ycat[(size_t)tok * DM + 256 + h * 64 + tid] = ((part[0][tid] + part[1][tid]) + (part[2][tid] + part[3][tid])) * inv;
    }
}

__global__ void __launch_bounds__(256) k_moba(const float* __restrict__ proj, const float* __restrict__ kmean, float* __restrict__ ycat) {
    const int tok = blockIdx.x, tid = threadIdx.x, t = tok & 2047, b = tok >> 11;
    const int own = t >> 8;
    __shared__ float qh[64]; __shared__ float gate[8]; __shared__ int blks[4]; __shared__ int nblk;
    __shared__ float sc[1024]; __shared__ float redf[4]; __shared__ float part[4][64];
    const float* prow = proj + (size_t)tok * INW;
    const float* pb = proj + (size_t)b * SEQ * INW;
    for (int h = 0; h < 6; ++h) {
        __syncthreads();
        if (tid < 64) qh[tid] = prow[C_MQ + h * 64 + tid];
        __syncthreads();
        if (tid < 8) {
            float g = -INFINITY;
            if (tid < own) { const float* km = kmean + (((size_t)b * 6 + h) * 8 + tid) * 64; float a = 0.f; for (int d = 0; d < 64; ++d) a = fmaf(qh[d], km[d], a); g = a; }
            gate[tid] = g;
        }
        __syncthreads();
        if (tid == 0) {
            int n = 0; unsigned used = 0u;
            const int want = own < 3 ? own : 3;
            for (int r = 0; r < want; ++r) {
                int best = -1; float bv = -INFINITY;
                for (int j = 0; j < own; ++j) if (!((used >> j) & 1u) && (best < 0 || gate[j] > bv)) { best = j; bv = gate[j]; }
                used |= 1u << best; blks[n++] = best;
            }
            blks[n++] = own;
            nblk = n;
        }
        __syncthreads();
        const int nb = nblk;
        const int ntot = nb * 256;
        float mx = -INFINITY;
        for (int i = tid; i < ntot; i += 256) {
            const int bi = i >> 8, kk = i & 255; const int key = blks[bi] * 256 + kk;
            float s = -INFINITY;
            if (key <= t) {
                const float* kr = pb + (size_t)key * INW + C_MK + h * 64;
                float a = 0.f;
                for (int d = 0; d < 64; ++d) a = fmaf(qh[d], kr[d], a);
                s = a * 0.125f;
            }
            sc[i] = s; mx = fmaxf(mx, s);
        }
        mx = block_max(mx, redf);
        float sm = 0.f;
        for (int i = tid; i < ntot; i += 256) { const float e = expf(sc[i] - mx); sc[i] = e; sm += e; }
        sm = block_sum(sm, redf);
        const float inv = 1.0f / sm;
        const int d = tid & 63, qtr = tid >> 6;
        float o = 0.f;
        for (int i = qtr; i < ntot; i += 4) {
            const float p = sc[i];
            if (p != 0.f) { const int key = blks[i >> 8] * 256 + (i & 255); o = fmaf(p, pb[(size_t)key * INW + C_MV + h * 64 + d], o); }
        }
        part[qtr][d] = o;
        __syncthreads();
        if (tid < 64) ycat[(size_t)tok * DM + 640 + h * 64 + tid] = ((part[0][tid] + part[1][tid]) + (part[2][tid] + part[3][tid])) * inv;
    }
}

__global__ void __launch_bounds__(256) k_router(const float* __restrict__ hn, const float* __restrict__ w_router, const float* __restrict__ b_router, int* __restrict__ tcls, float* __restrict__ tokw, int* __restrict__ cnt) {
    const int tok = blockIdx.x * 4 + (threadIdx.x >> 6), lane = threadIdx.x & 63;
    float acc[16];
#pragma unroll
    for (int e = 0; e < 16; ++e) acc[e] = 0.f;
    const float* hr = hn + (size_t)tok * DM;
    for (int k = lane; k < 1024; k += 64) {
        const float hv = hr[k];
        const float4* wr = (const float4*)(w_router + (size_t)k * 16);
#pragma unroll
        for (int q = 0; q < 4; ++q) { const float4 w4 = wr[q]; acc[q * 4] = fmaf(hv, w4.x, acc[q * 4]); acc[q * 4 + 1] = fmaf(hv, w4.y, acc[q * 4 + 1]); acc[q * 4 + 2] = fmaf(hv, w4.z, acc[q * 4 + 2]); acc[q * 4 + 3] = fmaf(hv, w4.w, acc[q * 4 + 3]); }
    }
#pragma unroll
    for (int e = 0; e < 16; ++e) {
#pragma unroll
        for (int o = 32; o >= 1; o >>= 1) acc[e] += __shfl_xor(acc[e], o);
    }
    if (lane == 0) {
        float aff[16], bia[16];
#pragma unroll
        for (int e = 0; e < 16; ++e) { aff[e] = 1.0f / (1.0f + expf(-acc[e])); bia[e] = aff[e] + b_router[e]; }
        int bestg = 0; float bests = -INFINITY;
#pragma unroll
        for (int g = 0; g < 4; ++g) {
            float m1 = -INFINITY, m2 = -INFINITY;
#pragma unroll
            for (int j = 0; j < 4; ++j) { const float v = bia[g * 4 + j]; if (v > m1) { m2 = m1; m1 = v; } else if (v > m2) m2 = v; }
            const float s = m1 + m2;
            if (s > bests) { bests = s; bestg = g; }
        }
        int i1 = -1, i2 = -1; float v1 = -INFINITY, v2 = -INFINITY;
#pragma unroll
        for (int g = 0; g < 4; ++g) if (g == bestg) {
#pragma unroll
            for (int j = 0; j < 4; ++j) { const float v = bia[g * 4 + j]; if (v > v1) { v2 = v1; i2 = i1; v1 = v; i1 = j; } else if (v > v2) { v2 = v; i2 = j; } }
        }
        const int a = i1 < i2 ? i1 : i2, bb = i1 < i2 ? i2 : i1;
        float affs[4];
#pragma unroll
        for (int g = 0; g < 4; ++g) if (g == bestg) {
#pragma unroll
            for (int j = 0; j < 4; ++j) affs[j] = aff[g * 4 + j];
        }
        float wa = 0.f, wb = 0.f;
#pragma unroll
        for (int j = 0; j < 4; ++j) { if (j == a) wa = affs[j]; if (j == bb) wb = affs[j]; }
        const float sw = wa + wb;
        const int pi = (a == 0) ? (bb - 1) : (a == 1 ? (bb + 1) : 5);
        const int cls = bestg * 6 + pi;
        tcls[tok] = cls;
        tokw[tok * 2] = wa / sw; tokw[tok * 2 + 1] = wb / sw;
        atomicAdd(&cnt[cls], 1);
    }
}
__global__ void __launch_bounds__(256) k_place(const int* __restrict__ tcls, const int* __restrict__ cnt, int* __restrict__ fill, int* __restrict__ sorted) {
    const int tok = blockIdx.x * 256 + threadIdx.x;
    __shared__ int off[NCLS];
    if (threadIdx.x == 0) { int s = 0; for (int c = 0; c < NCLS; ++c) { off[c] = s; s += cnt[c]; } }
    __syncthreads();
    const int c = tcls[tok];
    const int p = atomicAdd(&fill[c], 1);
    sorted[off[c] + p] = tok;
}

__device__ __forceinline__ bool moe_tile(const int* cnt, int tile, int TM, int& cls, int& p0, int& pend) {
    int off = 0, tb = 0;
    for (int c = 0; c < NCLS; ++c) {
        const int n = cnt[c], nt = (n + TM - 1) / TM;
        if (tile < tb + nt) { cls = c; p0 = off + (tile - tb) * TM; pend = off + n; return true; }
        tb += nt; off += n;
    }
    return false;
}
__device__ __forceinline__ void cls_experts(int cls, int& e1, int& e2) {
    const int g = cls / 6, pi = cls % 6;
    const int a = pi < 3 ? 0 : (pi < 5 ? 1 : 2);
    const int b = pi < 3 ? pi + 1 : (pi < 5 ? pi - 1 : 3);
    e1 = g * 4 + a; e2 = g * 4 + b;
}

__global__ void __launch_bounds__(256) k_moe_up(const float* __restrict__ hn, const float* __restrict__ wg, const float* __restrict__ wu, const int* __restrict__ cnt, const int* __restrict__ sorted, float* __restrict__ gu) {
    const int tn = blockIdx.x % 16, tile = blockIdx.x / 16;
    int cls, p0, pend;
    if (!moe_tile(cnt, tile, 64, cls, p0, pend)) return;
    int e1, e2; cls_experts(cls, e1, e2);
    const int n0 = tn * 64, sub = n0 >> 8, col = n0 & 255;
    const float* wbase = ((sub & 1) ? wu : wg) + (size_t)((sub >> 1) ? e2 : e1) * 1024 * 256 + col;
    gemm64(1024, 64,
        [&](int r) { const int p = p0 + r; return p < pend ? hn + (size_t)sorted[p] * DM : (const float*)nullptr; },
        [&](int k) { return wbase + (size_t)k * 256; },
        [&](int r, int cidx, float v) { const int p = p0 + r; if (p < pend) gu[(size_t)p * 1024 + n0 + cidx] = v; });
}
__global__ void __launch_bounds__(256) k_moe_act(const float* __restrict__ gu, const int* __restrict__ sorted, const float* __restrict__ tokw, float* __restrict__ act) {
    const size_t i = (size_t)blockIdx.x * 256 + threadIdx.x;
    const int p = (int)(i >> 9), j = (int)(i & 511);
    const int s = j >> 8, jj = j & 255;
    const float g = gu[(size_t)p * 1024 + s * 512 + jj], u = gu[(size_t)p * 1024 + s * 512 + 256 + jj];
    const float w = tokw[sorted[p] * 2 + s];
    act[i] = (g / (1.0f + expf(-g))) * u * w;
}
__global__ void __launch_bounds__(256) k_moe_down(const float* __restrict__ act, const float* __restrict__ wd, const int* __restrict__ cnt, const int* __restrict__ sorted, const float* __restrict__ g2, float* __restrict__ xio) {
    const int tn = blockIdx.x % 16, tile = blockIdx.x / 16;
    int cls, p0, pend;
    if (!moe_tile(cnt, tile, 64, cls, p0, pend)) return;
    int e1, e2; cls_experts(cls, e1, e2);
    const int n0 = tn * 64;
    gemm64(512, 64,
        [&](int r) { const int p = p0 + r; return p < pend ? act + (size_t)p * 512 : (const float*)nullptr; },
        [&](int k) { return wd + ((size_t)(k < 256 ? e1 : e2) * 256 + (k & 255)) * 1024 + n0; },
        [&](int r, int cidx, float v) { const int p = p0 + r; if (p < pend) { const int tok = sorted[p]; const int b = tok >> 11; const int col = n0 + cidx;
            xio[(size_t)tok * DM + col] += g2[(size_t)b * 6144 + col] * v; } });
}

extern "C" void kernel_launch(void* const* d_in, const int* in_sizes, int n_in, void* d_out, int out_size, void* d_ws, size_t ws_size, hipStream_t stream) {
    const float* x = (const float*)d_in[0];
    const float* c = (const float*)d_in[1];
    const float* w_ada = (const float*)d_in[2];
    const float* b_ada = (const float*)d_in[3];
    const float* g_mix = (const float*)d_in[4];
    const float* w_in = (const float*)d_in[5];
    const float* w_dw = (const float*)d_in[6];
    const float* b_dw = (const float*)d_in[7];
    const float* ln_g = (const float*)d_in[8];
    const float* ln_b = (const float*)d_in[9];
    const float* w_o = (const float*)d_in[10];
    const float* g_ffn = (const float*)d_in[11];
    const float* w_router = (const float*)d_in[12];
    const float* b_router = (const float*)d_in[13];
    const float* w_gate = (const float*)d_in[14];
    const float* w_up = (const float*)d_in[15];
    const float* w_down = (const float*)d_in[16];
    const float* g_final = (const float*)d_in[17];
    float* out = (float*)d_out;
    char* ws = (char*)d_ws;
    size_t off = 0;
    auto carve = [&](size_t bytes) { void* p = ws + off; off += (bytes + 255) & ~(size_t)255; return p; };
    float* regA = (float*)carve((size_t)T_TOK * DM * 4);
    float* regB = (float*)carve((size_t)T_TOK * INW * 4);
    float* part = (float*)carve((size_t)8 * 2 * 16 * 6144 * 4);
    float* modf = (float*)carve((size_t)2 * 16 * 6144 * 4);
    float* kmean = (float*)carve((size_t)49152 * 4);
    int* tcls = (int*)carve((size_t)T_TOK * 4);
    float* tokw = (float*)carve((size_t)T_TOK * 2 * 4);
    int* sorted = (int*)carve((size_t)T_TOK * 4);
    int* cnts = (int*)carve(256 * 4);
    if (off > ws_size) { fprintf(stderr, "workspace too small: need %zu have %zu\n", off, ws_size); return; }
    float* proj = regB;
    float* gu = regB;
    float* act = regB + (size_t)T_TOK * 1024;
    float* xa = out;

    (void)hipMemsetAsync(cnts, 0, 256 * 4, stream);
    k_mod<<<384, 256, 0, stream>>>(c, w_ada, part);
    k_modsum<<<(2 * 16 * 6144 + 255) / 256, 256, 0, stream>>>(part, b_ada, modf);
    for (int l = 0; l < 2; ++l) {
        const float* mf = modf + (size_t)l * 16 * 6144;
        const float* xin = (l == 0) ? x : xa;
        k_norm<<<T_TOK / 4, 256, 0, stream>>>(xin, g_mix + l * DM, mf + 0 * 1024, mf + 1 * 1024, regA);
        k_inproj<<<512 * 37, 256, 0, stream>>>(regA, w_in + (size_t)l * DM * INW, proj);
        k_rope<<<(T_TOK * 172 + 255) / 256, 256, 0, stream>>>(proj);
        k_conv<<<T_TOK, 256, 0, stream>>>(proj, w_dw + l * 31 * 256, b_dw + l * 256, ln_g + l * 256, ln_b + l * 256, regA);
        k_kmean<<<192, 256, 0, stream>>>(proj, kmean);
        k_dsa<<<T_TOK, 256, 0, stream>>>(proj, regA);
        k_moba<<<T_TOK, 256, 0, stream>>>(proj, kmean, regA);
        k_outproj<<<512 * 16, 256, 0, stream>>>(regA, w_o + (size_t)l * DM * DM, xin, mf + 2 * 1024, xa);
        k_norm<<<T_TOK / 4, 256, 0, stream>>>(xa, g_ffn + l * DM, mf + 3 * 1024, mf + 4 * 1024, regA);
        int* cnt = cnts + l * 64; int* fill = cnt + 32;
        k_router<<<T_TOK / 4, 256, 0, stream>>>(regA, w_router, b_router, tcls, tokw, cnt);
        k_place<<<T_TOK / 256, 256, 0, stream>>>(tcls, cnt, fill, sorted);
        k_moe_up<<<(512 + NCLS) * 16, 256, 0, stream>>>(regA, w_gate + (size_t)l * 16 * 1024 * 256, w_up + (size_t)l * 16 * 1024 * 256, cnt, sorted, gu);
        k_moe_act<<<T_TOK * 512 / 256, 256, 0, stream>>>(gu, sorted, tokw, act);
        k_moe_down<<<(512 + NCLS) * 16, 256, 0, stream>>>(act, w_down + (size_t)l * 16 * 256 * 1024, cnt, sorted, mf + 5 * 1024, xa);
    }
    k_norm<<<T_TOK / 4, 256, 0, stream>>>(xa, g_final, nullptr, nullptr, out);
}
```

```cpp
#include <hip/hip_runtime.h>
#include <cstdio>
#include <cstdint>

#ifndef MK_SPLIT
#define MK_SPLIT 0
#endif

#define T_TOK 32768
#define DM 1024
#define SEQ 2048
#define INW 2340
#define NP 2432
#define PC_CU 0
#define PC_CG 256
#define PC_DQ 512
#define PC_DK 896
#define PC_DV 960
#define PC_IQ 1024
#define PC_IK 1152
#define PC_IW 1184
#define PC_MQ 1280
#define PC_MK 1664
#define PC_MV 2048
#define LOG_THETA 13.122363377404328f
#define NCLS 24
#define LDS_BYTES 66048
#define NPHASE 19

typedef _Float16 half_t;
typedef _Float16 h8 __attribute__((ext_vector_type(8)));
typedef _Float16 h4 __attribute__((ext_vector_type(4)));
typedef short s4v __attribute__((ext_vector_type(4)));
typedef short s8v __attribute__((ext_vector_type(8)));
typedef float f16v __attribute__((ext_vector_type(16)));
typedef float f4v __attribute__((ext_vector_type(4)));
#define LAS __attribute__((address_space(3)))

struct Params {
    const float *x, *c, *w_ada, *b_ada, *g_mix, *w_in, *w_dw, *b_dw, *ln_g, *ln_b, *w_o, *g_ffn, *w_router, *b_router, *w_gate, *w_up, *w_down, *g_final;
    float* out;
    half_t *Wt_in, *Wt_o, *Wt_gu, *Wt_d, *hn, *P, *ycat, *act;
    float *modpart, *modf, *kmean, *rope, *iwf, *tokw;
    unsigned* dmask; int* cnt; int* lists; unsigned* bar;
    int ph_lo, ph_hi;
};

#define XB_TMO      128
#define XB_XCNT(j)  (256  + 64 * (j))
#define XB_XSUB(j)  (1280 + 64 * (j))
#define XB_XGEN(j)  (2304 + 64 * (j))
#define XB_TOP      3328
#define XB_TOPGEN   3392
#define XCD_BAR_WORDS 3456
#define XB_SPIN_CAP (1u << 20)
__device__ __forceinline__ unsigned xb_ld(unsigned* p)              { return __hip_atomic_load(p, __ATOMIC_RELAXED, __HIP_MEMORY_SCOPE_AGENT); }
__device__ __forceinline__ unsigned xb_add(unsigned* p, unsigned v) { return __hip_atomic_fetch_add(p, v, __ATOMIC_RELAXED, __HIP_MEMORY_SCOPE_AGENT); }
__device__ __forceinline__ unsigned xb_xcc_id() { return (unsigned)__builtin_amdgcn_s_getreg((3 << 11) | 20) & 0xFu; }
#define XB_SPIN(cond, bar) do { unsigned _sp = 0; while (cond) { __builtin_amdgcn_s_sleep(1); \
    if ((++_sp & 255u) == 0u) { if (xb_ld(&(bar)[XB_TMO])) break; if (_sp > XB_SPIN_CAP) { atomicAdd(&(bar)[XB_TMO], 1u); break; } } } } while (0)
struct XcdBarrier { unsigned* bar; unsigned x; volatile LAS unsigned* st; };
__device__ __forceinline__ XcdBarrier xcd_barrier_post(unsigned* bar, volatile LAS unsigned* st) {
    XcdBarrier b; b.bar = bar; b.x = xb_xcc_id(); b.st = st;
    if (threadIdx.x == 0) (void)xb_add(&bar[XB_XCNT(b.x)], 1u);
    return b;
}
__device__ __forceinline__ void xcd_barrier_complete(unsigned* bar, unsigned x, unsigned& nloc, unsigned& nx) {
    const unsigned G = gridDim.x * gridDim.y * gridDim.z;
    unsigned sum, cnt, mine, sp = 0u;
    for (;;) {
        sum = 0u; cnt = 0u; mine = 0u;
#pragma unroll
        for (unsigned j = 0; j < 16; ++j) { const unsigned c = xb_ld(&bar[XB_XCNT(j)]); sum += c; cnt += (c > 0u) ? 1u : 0u; mine = (j == x) ? c : mine; }
        if (sum == G) break;
        __builtin_amdgcn_s_sleep(1);
        if ((++sp & 255u) == 0u) { if (xb_ld(&bar[XB_TMO])) break; if (sp > XB_SPIN_CAP) { atomicAdd(&bar[XB_TMO], 1u); break; } }
    }
    nloc = mine > 0u ? mine : 1u; nx = cnt > 0u ? cnt : 1u;
}
__device__ __forceinline__ void xcd_barrier(const XcdBarrier& b) {
    asm volatile("s_waitcnt vmcnt(0)" ::: "memory");
    __syncthreads();
    if (threadIdx.x == 0) {
        unsigned* bar = b.bar;
        __builtin_amdgcn_s_waitcnt(0);
        unsigned nloc = b.st[0], nx = b.st[1];
        if (nloc == 0u) { xcd_barrier_complete(bar, b.x, nloc, nx); b.st[0] = nloc; b.st[1] = nx; }
        const unsigned old = xb_add(&bar[XB_XSUB(b.x)], 1u);
        const unsigned gen = old / nloc;
        if (old + 1u == (gen + 1u) * nloc) {
            __builtin_amdgcn_fence(__ATOMIC_RELEASE, "agent");
            asm volatile("s_waitcnt vmcnt(0)" ::: "memory");
            const unsigned og = xb_add(&bar[XB_TOP], 1u);
            const unsigned tg = og / nx;
            if (og + 1u == (tg + 1u) * nx) xb_add(&bar[XB_TOPGEN], 1u);
            else XB_SPIN(xb_ld(&bar[XB_TOPGEN]) == tg, bar);
            __builtin_amdgcn_fence(__ATOMIC_ACQUIRE, "agent");
            xb_add(&bar[XB_XGEN(b.x)], 1u);
            asm volatile("s_waitcnt vmcnt(0)" ::: "memory");
        } else {
            XB_SPIN(xb_ld(&bar[XB_XGEN(b.x)]) == gen, bar);
            __builtin_amdgcn_fence(__ATOMIC_ACQUIRE, "agent");
            asm volatile("s_waitcnt vmcnt(0)" ::: "memory");
        }
    }
    __syncthreads();
}

__device__ __forceinline__ int TID() { int t = threadIdx.x; asm volatile("" : "+v"(t)); return t; }
__device__ __forceinline__ int BID() { int b = blockIdx.x; asm volatile("" : "+s"(b)); return b; }
__device__ __forceinline__ float sigmoidf_(float v) { return 1.0f / (1.0f + __expf(-v)); }
__device__ __forceinline__ void glds16(const void* g, char* l) { __builtin_amdgcn_global_load_lds((const unsigned*)g, (unsigned*)l, 16, 0, 0); }
__device__ __forceinline__ unsigned f2sortable(float f) { unsigned u = __float_as_uint(f); return (u & 0x80000000u) ? ~u : (u | 0x80000000u); }
__device__ __forceinline__ h4 pack4(float a, float b, float c, float d) { h4 r = {(half_t)a, (half_t)b, (half_t)c, (half_t)d}; return r; }

template <class CF>
__device__ __forceinline__ void conv_tile(char* lds, CF colf, int src_ld, int k0, half_t* dst_tile  , int dstK) {
    float* tl = (float*)lds;
    const int tid = TID();
    __syncthreads();
    {
        const int nn = tid & 63;
        const float* cp = colf(nn);
#pragma unroll 4
        for (int i = 0; i < 16; ++i) { const int k = i * 4 + (tid >> 6); tl[k * 65 + nn] = cp ? cp[(size_t)(k0 + k) * src_ld] : 0.f; }
    }
    __syncthreads();
    {
        const int n = tid >> 2, kq = (tid & 3) * 16;
        h8 a, b;
#pragma unroll
        for (int j = 0; j < 8; ++j) { a[j] = (half_t)tl[(kq + j) * 65 + n]; b[j] = (half_t)tl[(kq + 8 + j) * 65 + n]; }
        h8* d = (h8*)(dst_tile + (size_t)n * dstK + kq);
        d[0] = a; d[1] = b;
    }
}

__device__ void phase_prologue(const Params& p, char* lds) {
    const int tid = TID();
    const int NA = 2 * 16 * 38, NB = 2 * 16 * 16, NC = 2 * 16 * 16 * 8, ND = 2 * 16 * 4 * 16, NE = 384, NF = 8;
    const int total = NA + NB + NC + ND + NE + NF;
    for (int u0 = BID(); u0 < total; u0 += gridDim.x) {
        int u = u0;
        if (u < NA) {
            const int nt = u % 38, kt = (u / 38) % 16, l = u / (38 * 16);
            const float* src = p.w_in + (size_t)l * DM * INW;
            const int n0 = nt * 64;
            conv_tile(lds, [&](int nn) -> const float* { const int np = n0 + nn; const int sc = np < 1188 ? np : (np < 1280 ? -1 : np - 92); return sc >= 0 ? src + sc : (const float*)nullptr; },
                      INW, kt * 64, p.Wt_in + ((size_t)l * NP + n0) * DM + kt * 64, DM);
            continue;
        }
        u -= NA;
        if (u < NB) {
            const int nt = u % 16, kt = (u / 16) % 16, l = u / 256;
            const float* src = p.w_o + (size_t)l * DM * DM + nt * 64;
            conv_tile(lds, [&](int nn) -> const float* { return src + nn; }, DM, kt * 64, p.Wt_o + ((size_t)l * DM + nt * 64) * DM + kt * 64, DM);
            continue;
        }
        u -= NB;
        if (u < NC) {
            const int nt = u % 8, kt = (u / 8) % 16, le = u / 128;
            const float* sg = p.w_gate + (size_t)le * 1024 * 256 + nt * 32;
            const float* su = p.w_up + (size_t)le * 1024 * 256 + nt * 32;
            conv_tile(lds, [&](int nn) -> const float* { return nn < 32 ? sg + nn : su + (nn - 32); }, 256, kt * 64, p.Wt_gu + ((size_t)le * 512 + nt * 64) * 1024 + kt * 64, 1024);
            continue;
        }
        u -= NC;
        if (u < ND) {
            const int nt = u % 16, kt = (u / 16) % 4, le = u / 64;
            const float* src = p.w_down + (size_t)le * 256 * 1024 + nt * 64;
            conv_tile(lds, [&](int nn) -> const float* { return src + nn; }, 1024, kt * 64, p.Wt_d + ((size_t)le * 1024 + nt * 64) * 256 + kt * 64, 256);
            continue;
        }
        u -= ND;
        if (u < NE) {
            const int kc = u % 8, cc = (u / 8) % 24, l = u / 192;
            float* ca = (float*)lds;
            __syncthreads();
            for (int i = tid; i < 2048; i += 256) { const int b = i >> 7, k = i & 127; const float v = p.c[b * 1024 + kc * 128 + k]; ca[i] = v / (1.0f + expf(-v)); }
            __syncthreads();
            const int n = cc * 256 + tid;
            float acc[16];
#pragma unroll
            for (int b = 0; b < 16; ++b) acc[b] = 0.f;
            const float* w = p.w_ada + ((size_t)l * 1024 + kc * 128) * 6144 + n;
#pragma unroll 4
            for (int k = 0; k < 128; ++k) {
                const float wv = w[(size_t)k * 6144];
#pragma unroll
                for (int b = 0; b < 16; ++b) acc[b] = fmaf(ca[b * 128 + k], wv, acc[b]);
            }
#pragma unroll
            for (int b = 0; b < 16; ++b) p.modpart[(((size_t)kc * 2 + l) * 16 + b) * 6144 + n] = acc[b];
            continue;
        }
        u -= NE;
        {
            for (int i = u * 256 + tid; i < 2048 * 12; i += NF * 256) {
                const int t = i / 12, r = i % 12;
                const int fi = r < 8 ? r : r - 8;
                const float rot = r < 8 ? 16.f : 8.f;
                const float inv = expf(-LOG_THETA * ((float)fi * 2.0f / rot));
                const float ang = (float)t * inv;
                float sn, cs; sincosf(ang, &sn, &cs);
                if (r < 8) { p.rope[t * 8 + fi] = cs; p.rope[16384 + t * 8 + fi] = sn; }
                else { p.rope[32768 + t * 4 + fi] = cs; p.rope[32768 + 8192 + t * 4 + fi] = sn; }
            }
        }
    }
}

__device__ void phase_modsum(const Params& p) {
    for (int i = BID() * 256 + TID(); i < 2 * 16 * 6144; i += gridDim.x * 256) {
        const int n = i % 6144, l = i / (16 * 6144);
        float s = p.b_ada[l * 6144 + n];
#pragma unroll
        for (int kc = 0; kc < 8; ++kc) s += p.modpart[(size_t)kc * (2 * 16 * 6144) + i];
        p.modf[i] = s;
    }
}

template <int MODE>
__device__ void phase_norm(const Params& p, const float* xin, const float* g, const float* sh, const float* sc, int layer) {
    const int lane = TID() & 63, wave = TID() >> 6;
    for (int row = BID() * 4 + wave; row < T_TOK; row += gridDim.x * 4) {
        const int b = row >> 11;
        const float4* xr = (const float4*)(xin + (size_t)row * DM);
        float4 v[4]; float ss = 0.f;
#pragma unroll
        for (int i = 0; i < 4; ++i) { v[i] = xr[lane + 64 * i]; ss += v[i].x * v[i].x + v[i].y * v[i].y + v[i].z * v[i].z + v[i].w * v[i].w; }
#pragma unroll
        for (int o = 32; o >= 1; o >>= 1) ss += __shfl_xor(ss, o);
        const float rstd = 1.0f / sqrtf(ss * (1.0f / 1024.0f) + 1e-6f);
        float acc[16];
        if (MODE == 1) {
#pragma unroll
            for (int e = 0; e < 16; ++e) acc[e] = 0.f;
        }
#pragma unroll
        for (int i = 0; i < 4; ++i) {
            const int k = (lane + 64 * i) * 4;
            const float4 gg = *(const float4*)(g + k);
            float y[4] = {v[i].x * rstd * gg.x, v[i].y * rstd * gg.y, v[i].z * rstd * gg.z, v[i].w * rstd * gg.w};
            if (MODE != 2) {
                const float4 s1 = *(const float4*)(sh + (size_t)b * 6144 + k), s2 = *(const float4*)(sc + (size_t)b * 6144 + k);
                y[0] = y[0] * (1.f + s2.x) + s1.x; y[1] = y[1] * (1.f + s2.y) + s1.y; y[2] = y[2] * (1.f + s2.z) + s1.z; y[3] = y[3] * (1.f + s2.w) + s1.w;
                *(h4*)(p.hn + (size_t)row * DM + k) = pack4(y[0], y[1], y[2], y[3]);
            } else {
                *(float4*)(p.out + (size_t)row * DM + k) = make_float4(y[0], y[1], y[2], y[3]);
            }
            if (MODE == 1) {
#pragma unroll
                for (int j = 0; j < 4; ++j) {
                    const float4* wr = (const float4*)(p.w_router + (size_t)(k + j) * 16);
#pragma unroll
                    for (int q = 0; q < 4; ++q) { const float4 w4 = wr[q]; acc[q * 4] = fmaf(y[j], w4.x, acc[q * 4]); acc[q * 4 + 1] = fmaf(y[j], w4.y, acc[q * 4 + 1]); acc[q * 4 + 2] = fmaf(y[j], w4.z, acc[q * 4 + 2]); acc[q * 4 + 3] = fmaf(y[j], w4.w, acc[q * 4 + 3]); }
                }
            }
        }
        if (MODE == 1) {
#pragma unroll
            for (int e = 0; e < 16; ++e) {
#pragma unroll
                for (int o = 32; o >= 1; o >>= 1) acc[e] += __shfl_xor(acc[e], o);
            }
            if (lane == 0) {
                float aff[16], bia[16];
#pragma unroll
                for (int e = 0; e < 16; ++e) { aff[e] = 1.0f / (1.0f + expf(-acc[e])); bia[e] = aff[e] + p.b_router[e]; }
                int bestg = 0; float bests = -INFINITY;
#pragma unroll
                for (int gi = 0; gi < 4; ++gi) {
                    float m1 = -INFINITY, m2 = -INFINITY;
#pragma unroll
                    for (int j = 0; j < 4; ++j) { const float vv = bia[gi * 4 + j]; if (vv > m1) { m2 = m1; m1 = vv; } else if (vv > m2) m2 = vv; }
                    const float s = m1 + m2;
                    if (s > bests) { bests = s; bestg = gi; }
                }
                float bsel[4], asel[4];
#pragma unroll
                for (int j = 0; j < 4; ++j) { bsel[j] = 0.f; asel[j] = 0.f; }
#pragma unroll
                for (int gi = 0; gi < 4; ++gi) if (gi == bestg) {
#pragma unroll
                    for (int j = 0; j < 4; ++j) { bsel[j] = bia[gi * 4 + j]; asel[j] = aff[gi * 4 + j]; }
                }
                int i1 = -1, i2 = -1; float v1 = -INFINITY, v2 = -INFINITY;
#pragma unroll
                for (int j = 0; j < 4; ++j) { const float vv = bsel[j]; if (vv > v1) { v2 = v1; i2 = i1; v1 = vv; i1 = j; } else if (vv > v2) { v2 = vv; i2 = j; } }
                const int a = i1 < i2 ? i1 : i2, bb = i1 < i2 ? i2 : i1;
                float wa = 0.f, wb = 0.f;
#pragma unroll
                for (int j = 0; j < 4; ++j) { if (j == a) wa = asel[j]; if (j == bb) wb = asel[j]; }
                const float sw = wa + wb;
                const int pi = (a == 0) ? (bb - 1) : (a == 1 ? (bb + 1) : 5);
                const int cls = bestg * 6 + pi;
                *(float2*)(p.tokw + (size_t)row * 2) = make_float2(wa / sw, wb / sw);
                const int pos = atomicAdd(&p.cnt[layer * 32 + cls], 1);
                p.lists[(size_t)cls * T_TOK + pos] = row;
            }
        }
    }
}

template <class WF, class XF, class EPI>
__device__ __forceinline__ void gemm_tile(char* lds, int nkt, WF wf, XF xf, EPI epi) {
    const int tid = TID(), lane = tid & 63, wave = tid >> 6;
    const int wn = wave & 1, wm = wave >> 1, hh = lane >> 5;
    const int lrow = tid >> 3;
    const int lchunk = (tid & 7) ^ ((tid >> 4) & 7);
    const half_t* xs[4];
#pragma unroll
    for (int i = 0; i < 4; ++i) xs[i] = xf(lrow + 32 * i) + lchunk * 8;
    char* ldst = lds + lrow * 128 + (tid & 7) * 16;
    f16v acc[2][2];
#pragma unroll
    for (int i = 0; i < 2; ++i)
#pragma unroll
        for (int j = 0; j < 2; ++j)
#pragma unroll
            for (int r = 0; r < 16; ++r) acc[i][j][r] = 0.f;
    auto issue = [&](int kt, int s) {
        char* d = ldst + s * 32768;
#pragma unroll
        for (int i = 0; i < 4; ++i) glds16(wf(kt, lrow + 32 * i) + lchunk * 8, d + i * 4096);
#pragma unroll
        for (int i = 0; i < 4; ++i) glds16(xs[i] + kt * 64, d + 16384 + i * 4096);
    };
    __syncthreads();
    issue(0, 0);
    const int rsw = (lane >> 1) & 7;
    const int roff_w = (wn * 64 + (lane & 31)) * 128, roff_x = 16384 + (wm * 64 + (lane & 31)) * 128;
    for (int kt = 0; kt < nkt; ++kt) {
        asm volatile("s_waitcnt vmcnt(0)" ::: "memory");
        __syncthreads();
        if (kt + 1 < nkt) issue(kt + 1, (kt + 1) & 1);
        const char* base = lds + (kt & 1) * 32768;
#pragma unroll
        for (int ks = 0; ks < 4; ++ks) {
            const int co = ((2 * ks + hh) ^ rsw) << 4;
            const h8 a0 = *(const h8*)(base + roff_w + co), a1 = *(const h8*)(base + roff_w + 4096 + co);
            const h8 b0 = *(const h8*)(base + roff_x + co), b1 = *(const h8*)(base + roff_x + 4096 + co);
            acc[0][0] = __builtin_amdgcn_mfma_f32_32x32x16_f16(a0, b0, acc[0][0], 0, 0, 0);
            acc[0][1] = __builtin_amdgcn_mfma_f32_32x32x16_f16(a0, b1, acc[0][1], 0, 0, 0);
            acc[1][0] = __builtin_amdgcn_mfma_f32_32x32x16_f16(a1, b0, acc[1][0], 0, 0, 0);
            acc[1][1] = __builtin_amdgcn_mfma_f32_32x32x16_f16(a1, b1, acc[1][1], 0, 0, 0);
        }
    }
    epi(acc, wn, wm, lane);
}

__device__ void phase_inproj(const Params& p, char* lds, int l) {
    const half_t* W = p.Wt_in + (size_t)l * NP * DM;
    const float* rc16 = p.rope; const float* rs16 = p.rope + 16384; const float* rc8 = p.rope + 32768; const float* rs8 = p.rope + 32768 + 8192;
    for (int u = BID(); u < 256 * 19; u += gridDim.x) {
        const int nt = u % 19, mt = u / 19;
        gemm_tile(lds, 16,
            [&](int kt, int row) { return W + (size_t)(nt * 128 + row) * DM + kt * 64; },
            [&](int row) { return p.hn + (size_t)(mt * 128 + row) * DM; },
            [&](f16v (&acc)[2][2], int wn, int wm, int lane) {
                const int hh = lane >> 5;
#pragma unroll
                for (int i = 0; i < 2; ++i) {
                    const int nb = nt * 128 + wn * 64 + i * 32;
                    if (nb == 1216 || nb == 1248) continue;
                    const bool rope64 = ((nb >= PC_DQ && nb < PC_DV) || (nb >= PC_MQ && nb < PC_MV)) && ((nb & 63) == 0);
                    const bool rope32 = (nb >= PC_IQ && nb < PC_IW);
#pragma unroll
                    for (int j = 0; j < 2; ++j) {
                        const int tok = mt * 128 + wm * 64 + j * 32 + (lane & 31);
                        const int t = tok & 2047;
                        f16v v = acc[i][j];
                        if (nb == PC_IW) { if (hh == 0) *(float4*)(p.iwf + (size_t)tok * 4) = make_float4(v[0], v[1], v[2], v[3]); continue; }
                        if (rope64) {
                            const float4 c4 = *(const float4*)(rc16 + t * 8 + 4 * hh), s4 = *(const float4*)(rs16 + t * 8 + 4 * hh);
                            const float cc[4] = {c4.x, c4.y, c4.z, c4.w}, sn[4] = {s4.x, s4.y, s4.z, s4.w};
#pragma unroll
                            for (int r = 0; r < 4; ++r) { const float x1 = v[r], x2 = v[r + 4]; v[r] = x1 * cc[r] - x2 * sn[r]; v[r + 4] = x2 * cc[r] + x1 * sn[r]; }
                        } else if (rope32) {
                            const float4 c4 = *(const float4*)(rc8 + t * 4), s4 = *(const float4*)(rs8 + t * 4);
                            const float cc[4] = {c4.x, c4.y, c4.z, c4.w}, sn[4] = {s4.x, s4.y, s4.z, s4.w};
#pragma unroll
                            for (int r = 0; r < 4; ++r) { const float o = __shfl_xor(v[r], 32); v[r] = hh ? (v[r] * cc[r] + o * sn[r]) : (v[r] * cc[r] - o * sn[r]); }
                        }
                        half_t* dst = p.P + (size_t)tok * NP + nb + 4 * hh;
#pragma unroll
                        for (int g = 0; g < 4; ++g) *(h4*)(dst + 8 * g) = pack4(v[4 * g], v[4 * g + 1], v[4 * g + 2], v[4 * g + 3]);
                    }
                }
            });
    }
}

__device__ void phase_outproj(const Params& p, char* lds, int l, const float* xin) {
    const half_t* W = p.Wt_o + (size_t)l * DM * DM;
    const float* g1 = p.modf + (size_t)l * 16 * 6144 + 2 * 1024;
    for (int u = BID(); u < 256 * 8; u += gridDim.x) {
        const int nt = u % 8, mt = u / 8;
        gemm_tile(lds, 16,
            [&](int kt, int row) { return W + (size_t)(nt * 128 + row) * DM + kt * 64; },
            [&](int row) { return p.ycat + (size_t)(mt * 128 + row) * DM; },
            [&](f16v (&acc)[2][2], int wn, int wm, int lane) {
                const int hh = lane >> 5;
#pragma unroll
                for (int j = 0; j < 2; ++j) {
                    const int tok = mt * 128 + wm * 64 + j * 32 + (lane & 31);
                    const int b = tok >> 11;
#pragma unroll
                    for (int i = 0; i < 2; ++i) {
                        const int nb = nt * 128 + wn * 64 + i * 32 + 4 * hh;
#pragma unroll
                        for (int g = 0; g < 4; ++g) {
                            const int n = nb + 8 * g;
                            const float4 xi = *(const float4*)(xin + (size_t)tok * DM + n);
                            const float4 gg = *(const float4*)(g1 + (size_t)b * 6144 + n);
                            float4 o; o.x = xi.x + gg.x * acc[i][j][4 * g]; o.y = xi.y + gg.y * acc[i][j][4 * g + 1]; o.z = xi.z + gg.z * acc[i][j][4 * g + 2]; o.w = xi.w + gg.w * acc[i][j][4 * g + 3];
                            *(float4*)(p.out + (size_t)tok * DM + n) = o;
                        }
                    }
                }
            });
    }
}

__device__ __forceinline__ bool moe_tile(const int* cnt, int tile, int& cls, int& pos0, int& n) {
    int tb = 0;
    for (int c = 0; c < NCLS; ++c) {
        const int nc = cnt[c], nt = (nc + 127) >> 7;
        if (tile < tb + nt) { cls = c; pos0 = (tile - tb) * 128; n = nc; return true; }
        tb += nt;
    }
    return false;
}
__device__ __forceinline__ void cls_experts(int cls, int& e1, int& e2) {
    const int g = cls / 6, pi = cls % 6;
    const int a = pi < 3 ? 0 : (pi < 5 ? 1 : 2);
    const int b = pi < 3 ? pi + 1 : (pi < 5 ? pi - 1 : 3);
    e1 = g * 4 + a; e2 = g * 4 + b;
}
__device__ void phase_moe_up(const Params& p, char* lds, int l) {
    const int* cnt = p.cnt + l * 32;
    for (int u = BID(); u < (256 + NCLS) * 8; u += gridDim.x) {
        const int nt = u % 8, tile = u / 8;
        int cls, pos0, nc;
        if (!moe_tile(cnt, tile, cls, pos0, nc)) break;
        int e1, e2; cls_experts(cls, e1, e2);
        const int slot = nt >> 2;
        const half_t* W = p.Wt_gu + ((size_t)(l * 16 + (slot ? e2 : e1)) * 512 + (nt & 3) * 128) * 1024;
        const int* lst = p.lists + (size_t)cls * T_TOK + pos0;
        const int nvalid = nc - pos0;
        gemm_tile(lds, 16,
            [&](int kt, int row) { return W + (size_t)row * 1024 + kt * 64; },
            [&](int row) { const int tok = lst[row < nvalid ? row : 0]; return p.hn + (size_t)tok * DM; },
            [&](f16v (&acc)[2][2], int wn, int wm, int lane) {
                const int hh = lane >> 5;
#pragma unroll
                for (int j = 0; j < 2; ++j) {
                    const int row = wm * 64 + j * 32 + (lane & 31);
                    if (row < nvalid) {
                        const int tok = lst[row];
                        const float wgt = p.tokw[(size_t)tok * 2 + slot];
                        half_t* dst = p.act + (size_t)tok * 512 + slot * 256 + ((nt & 3) * 2 + wn) * 32 + 4 * hh;
#pragma unroll
                        for (int g = 0; g < 4; ++g) {
                            float a[4];
#pragma unroll
                            for (int r = 0; r < 4; ++r) { const float gv = acc[0][j][4 * g + r], uv = acc[1][j][4 * g + r]; a[r] = gv * sigmoidf_(gv) * uv * wgt; }
                            *(h4*)(dst + 8 * g) = pack4(a[0], a[1], a[2], a[3]);
                        }
                    }
                }
            });
    }
}
__device__ void phase_moe_down(const Params& p, char* lds, int l) {
    const int* cnt = p.cnt + l * 32;
    const float* g2 = p.modf + (size_t)l * 16 * 6144 + 5 * 1024;
    for (int u = BID(); u < (256 + NCLS) * 8; u += gridDim.x) {
        const int nt = u % 8, tile = u / 8;
        int cls, pos0, nc;
        if (!moe_tile(cnt, tile, cls, pos0, nc)) break;
        int e1, e2; cls_experts(cls, e1, e2);
        const half_t* W1 = p.Wt_d + ((size_t)(l * 16 + e1) * 1024 + nt * 128) * 256;
        const half_t* W2 = p.Wt_d + ((size_t)(l * 16 + e2) * 1024 + nt * 128) * 256;
        const int* lst = p.lists + (size_t)cls * T_TOK + pos0;
        const int nvalid = nc - pos0;
        gemm_tile(lds, 8,
            [&](int kt, int row) { return (kt < 4 ? W1 : W2) + (size_t)row * 256 + (kt & 3) * 64; },
            [&](int row) { const int tok = lst[row < nvalid ? row : 0]; return p.act + (size_t)tok * 512; },
            [&](f16v (&acc)[2][2], int wn, int wm, int lane) {
                const int hh = lane >> 5;
#pragma unroll
                for (int j = 0; j < 2; ++j) {
                    const int row = wm * 64 + j * 32 + (lane & 31);
                    if (row < nvalid) {
                        const int tok = lst[row];
                        const int b = tok >> 11;
#pragma unroll
                        for (int i = 0; i < 2; ++i) {
                            const int nb = nt * 128 + wn * 64 + i * 32 + 4 * hh;
#pragma unroll
                            for (int g = 0; g < 4; ++g) {
                                const int n = nb + 8 * g;
                                float4* xp = (float4*)(p.out + (size_t)tok * DM + n);
                                float4 xi = *xp;
                                const float4 gg = *(const float4*)(g2 + (size_t)b * 6144 + n);
                                xi.x += gg.x * acc[i][j][4 * g]; xi.y += gg.y * acc[i][j][4 * g + 1]; xi.z += gg.z * acc[i][j][4 * g + 2]; xi.w += gg.w * acc[i][j][4 * g + 3];
                                *xp = xi;
                            }
                        }
                    }
                }
            });
    }
}

__device__ void dsa_select_unit(const Params& p, char* lds, int b, int qt) {
    unsigned* hist = (unsigned*)lds;
    unsigned* maskl = hist + 4096;
    unsigned* stP = maskl + 1024;
    unsigned* stNeed = stP + 16;
    unsigned* stDone = stNeed + 16;
    unsigned* stJ = stDone + 16;
    unsigned* flag = stJ + 16;
    const int tid = TID(), lane = tid & 63, wave = tid >> 6;
    const int q0 = qt * 16, tokbase = b * SEQ;
    __syncthreads();
    if (q0 < 256) {
        for (int i = tid; i < 1024; i += 256) {
            const int q = i >> 6, wd = i & 63;
            const int n = q0 + q + 1 - 32 * wd;
            const unsigned w = n >= 32 ? 0xFFFFFFFFu : (n <= 0 ? 0u : ((1u << n) - 1u));
            p.dmask[(size_t)(tokbase + q0 + q) * 64 + wd] = w;
        }
        return;
    }
    for (int i = tid; i < 1024; i += 256) maskl[i] = 0u;
    if (tid < 16) { stP[tid] = 0u; stNeed[tid] = 256u; stDone[tid] = 0u; stJ[tid] = 0u; }
    const int ql = lane & 15, fq = lane >> 4;
    const int tq = q0 + ql;
    const half_t* Pb = p.P + (size_t)tokbase * NP;
    h8 iqf[4];
#pragma unroll
    for (int hd = 0; hd < 4; ++hd) iqf[hd] = *(const h8*)(Pb + (size_t)tq * NP + PC_IQ + hd * 32 + 8 * fq);
    const float4 iw4 = *(const float4*)(p.iwf + (size_t)(tokbase + tq) * 4);
    const float wsc0 = iw4.x * 0.08838834764831845f, wsc1 = iw4.y * 0.08838834764831845f, wsc2 = iw4.z * 0.08838834764831845f, wsc3 = iw4.w * 0.08838834764831845f;
    const int ng = qt + 1;
    bool alldone = false;
    for (int pass = 0; pass < 8; ++pass) {
        const bool fin = alldone;
        if (!fin) { for (int i = tid; i < 4096; i += 256) hist[i] = 0u; }
        if (tid == 0) *flag = 0u;
        __syncthreads();
        const unsigned sP = stP[ql], sDone = stDone[ql], sJ = stJ[ql];
        const int sh = sDone <= 4u ? (int)(32u - 8u * (sDone ? sDone : 1u)) : 0;
        for (int g = wave; g < ng; g += 4) {
            const h8 ikf = *(const h8*)(Pb + (size_t)(16 * g + ql) * NP + PC_IK + 8 * fq);
            const f4v z = {0.f, 0.f, 0.f, 0.f};
            const f4v c0 = __builtin_amdgcn_mfma_f32_16x16x32_f16(ikf, iqf[0], z, 0, 0, 0);
            const f4v c1 = __builtin_amdgcn_mfma_f32_16x16x32_f16(ikf, iqf[1], z, 0, 0, 0);
            const f4v c2 = __builtin_amdgcn_mfma_f32_16x16x32_f16(ikf, iqf[2], z, 0, 0, 0);
            const f4v c3 = __builtin_amdgcn_mfma_f32_16x16x32_f16(ikf, iqf[3], z, 0, 0, 0);
            unsigned nib = 0u;
#pragma unroll
            for (int r = 0; r < 4; ++r) {
                const int j = 16 * g + 4 * fq + r;
                float s = wsc0 * fmaxf(c0[r], 0.f);
                s = fmaf(wsc1, fmaxf(c1[r], 0.f), s);
                s = fmaf(wsc2, fmaxf(c2[r], 0.f), s);
                s = fmaf(wsc3, fmaxf(c3[r], 0.f), s);
                s += 0.0f;
                const unsigned uu = f2sortable(s);
                const unsigned jinv = (unsigned)(2047 - j);
                const bool valid = (j <= tq);
                if (fin) {
                    const unsigned um = uu >> sh;
                    const bool sel = valid && ((um > sP) || (um == sP && jinv >= sJ));
                    nib |= (sel ? 1u : 0u) << r;
                } else if (valid && sDone == 0u) {
                    bool match; unsigned dig;
                    if (pass == 0) { match = true; dig = uu >> 24; }
                    else if (pass < 4) { match = (uu >> (32 - 8 * pass)) == sP; dig = (uu >> (24 - 8 * pass)) & 255u; }
                    else if (pass == 4) { match = (uu == sP); dig = jinv >> 3; }
                    else { match = (uu == sP) && ((jinv >> 3) == (sJ >> 3)); dig = jinv & 7u; }
                    if (match) atomicAdd(&hist[ql * 256 + dig], 1u);
                }
            }
            if (fin && nib) atomicOr(&maskl[ql * 64 + (g >> 1)], nib << ((g & 1) * 16 + 4 * fq));
        }
        __syncthreads();
        if (fin) break;
        {
            const int qq = tid >> 4, seg = tid & 15;
            const bool active = (stDone[qq] == 0u);
            unsigned c16 = 0u;
            if (active) {
#pragma unroll
                for (int d = 0; d < 16; ++d) c16 += hist[qq * 256 + seg * 16 + d];
            }
            unsigned v = c16;
#pragma unroll
            for (int off = 1; off < 16; off <<= 1) { const unsigned t = __shfl_down(v, off, 16); if (seg + off < 16) v += t; }
            const unsigned suf = v - c16;
            const unsigned need = stNeed[qq];
            if (active && suf < need && need <= suf + c16) {
                unsigned run = suf, D = 0u, cD = 0u, nn = need;
                for (int d = 15; d >= 0; --d) {
                    const unsigned cc = hist[qq * 256 + seg * 16 + d];
                    if (run + cc >= need) { D = (unsigned)(seg * 16 + d); cD = cc; nn = need - run; break; }
                    run += cc;
                }
                bool done = (cD == nn);
                if (pass < 4) { stP[qq] = (stP[qq] << 8) | D; stNeed[qq] = nn; if (done) stDone[qq] = (unsigned)(pass + 1); }
                else if (pass == 4) { stJ[qq] = D << 3; stNeed[qq] = nn; if (done) stDone[qq] = 5u; }
                else { stJ[qq] = stJ[qq] | D; stNeed[qq] = nn; done = true; stDone[qq] = 6u; }
                if (!done) atomicAdd(flag, 1u);
            }
        }
        __syncthreads();
        alldone = (*flag == 0u);
    }
    for (int i = tid; i < 1024; i += 256) p.dmask[(size_t)(tokbase + q0 + (i >> 6)) * 64 + (i & 63)] = maskl[i];
}

__device__ void conv_unit(const Params& p, char* lds, int l, int b, int c) {
    float* a = (float*)lds;
    float* red = a + 62 * 256;
    const int ch = TID(), lane = ch & 63, wave = ch >> 6;
    const int t0 = c * 32, tokbase = b * SEQ;
    __syncthreads();
    for (int rr = 0; rr < 62; ++rr) {
        const int tt = t0 - 30 + rr;
        float av = 0.f;
        if (tt >= 0) {
            const half_t* r = p.P + (size_t)(tokbase + tt) * NP;
            const float u = (float)r[PC_CU + ch], g = (float)r[PC_CG + ch];
            av = u * sigmoidf_(g);
        }
        a[rr * 256 + ch] = av;
    }
    float w[31];
#pragma unroll
    for (int i = 0; i < 31; ++i) w[i] = p.w_dw[(l * 31 + i) * 256 + ch];
    const float bias = p.b_dw[l * 256 + ch];
    float y[32];
#pragma unroll
    for (int tk = 0; tk < 32; ++tk) {
        float s = bias;
#pragma unroll
        for (int i = 0; i < 31; ++i) s = fmaf(a[(tk + i) * 256 + ch], w[i], s);
        y[tk] = s;
        float s1 = s, s2 = s * s;
#pragma unroll
        for (int o = 32; o >= 1; o >>= 1) { s1 += __shfl_xor(s1, o); s2 += __shfl_xor(s2, o); }
        if (lane == 0) { red[(tk * 4 + wave) * 2] = s1; red[(tk * 4 + wave) * 2 + 1] = s2; }
    }
    __syncthreads();
    const float lg = p.ln_g[l * 256 + ch], lb = p.ln_b[l * 256 + ch];
#pragma unroll
    for (int tk = 0; tk < 32; ++tk) {
        const float s1 = (red[tk * 8] + red[tk * 8 + 2]) + (red[tk * 8 + 4] + red[tk * 8 + 6]);
        const float s2 = (red[tk * 8 + 1] + red[tk * 8 + 3]) + (red[tk * 8 + 5] + red[tk * 8 + 7]);
        const float mu = s1 * (1.0f / 256.0f);
        float var = s2 * (1.0f / 256.0f) - mu * mu; var = var < 0.f ? 0.f : var;
        float z = (y[tk] - mu) * (1.0f / sqrtf(var + 1e-6f)) * lg + lb;
        z = z * sigmoidf_(z);
        p.ycat[(size_t)(tokbase + t0 + tk) * DM + ch] = (half_t)z;
    }
}

__device__ void kmean_unit(const Params& p, char* lds, int b, int h, int blk) {
    float* part = (float*)lds;
    const int tid = TID(), d = tid & 63, pt = tid >> 6;
    const half_t* r = p.P + (size_t)(b * SEQ + blk * 256 + pt * 64) * NP + PC_MK + h * 64 + d;
    float s = 0.f;
    for (int k = 0; k < 64; ++k) s += (float)r[(size_t)k * NP];
    __syncthreads();
    part[pt * 64 + d] = s;
    __syncthreads();
    if (tid < 64) p.kmean[(((size_t)b * 6 + h) * 8 + blk) * 64 + tid] = ((part[tid] + part[64 + tid]) + (part[128 + tid] + part[192 + tid])) * (1.0f / 256.0f);
}

__device__ void phase_post(const Params& p, char* lds, int l) {
    const int NA = 2048, NB = 1024, NC = 768;
    for (int u = BID(); u < NA + NB + NC; u += gridDim.x) {
        if (u < NA) { dsa_select_unit(p, lds, u % 16, 127 - (u / 16)); }
        else if (u < NA + NB) { const int v = u - NA; conv_unit(p, lds, l, v % 16, v / 16); }
        else { const int v = u - NA - NB; kmean_unit(p, lds, v / 48, (v / 8) % 6, v % 8); }
    }
}

template <int MODE>
__device__ void attn_unit(const Params& p, char* lds, int b, int h, int qt) {
    const int tid = TID(), lane = tid & 63, wave = tid >> 6, hh = lane >> 5, ql = lane & 31;
    const int q0 = qt * 128, tokbase = b * SEQ;
    const int tq = q0 + wave * 32 + ql;
    const half_t* Pb = p.P + (size_t)tokbase * NP;
    const int QOFF = MODE ? PC_MQ + h * 64 : PC_DQ + h * 64;
    const int KOFF = MODE ? PC_MK + h * 64 : PC_DK;
    const int VOFF = MODE ? PC_MV + h * 64 : PC_DV;
    const int own = qt >> 1;
    unsigned mysel = 0u, anysel = 0u;
    __syncthreads();
    if (MODE == 1) {
        float* km = (float*)(lds + 32768);
        float* gts = km + 512;
        unsigned* selq = (unsigned*)(gts + 1024);
        unsigned* anyb = selq + 128;
        for (int i = tid; i < 512; i += 256) km[i] = p.kmean[((size_t)b * 6 + h) * 512 + i];
        if (tid == 0) *anyb = 0u;
        __syncthreads();
        {
            const int q = tid & 127, hf = tid >> 7;
            if (hf * 4 < own) {
                const half_t* qr = Pb + (size_t)(q0 + q) * NP + QOFF;
                float g0 = 0.f, g1 = 0.f, g2 = 0.f, g3 = 0.f;
#pragma unroll
                for (int c8 = 0; c8 < 8; ++c8) {
                    const h8 qv = *(const h8*)(qr + c8 * 8);
#pragma unroll
                    for (int j = 0; j < 8; ++j) {
                        const float qf = (float)qv[j]; const int d = c8 * 8 + j;
                        g0 = fmaf(qf, km[(hf * 4 + 0) * 64 + d], g0); g1 = fmaf(qf, km[(hf * 4 + 1) * 64 + d], g1);
                        g2 = fmaf(qf, km[(hf * 4 + 2) * 64 + d], g2); g3 = fmaf(qf, km[(hf * 4 + 3) * 64 + d], g3);
                    }
                }
                gts[q * 8 + hf * 4 + 0] = g0; gts[q * 8 + hf * 4 + 1] = g1; gts[q * 8 + hf * 4 + 2] = g2; gts[q * 8 + hf * 4 + 3] = g3;
            }
        }
        __syncthreads();
        if (tid < 128) {
            unsigned m = 0u;
            const int want = own < 3 ? own : 3;
            for (int r = 0; r < want; ++r) {
                int best = -1; float bv = -INFINITY;
                for (int j = 0; j < own; ++j) { const float gv = gts[tid * 8 + j]; if (!((m >> j) & 1u) && (best < 0 || gv > bv)) { best = j; bv = gv; } }
                m |= 1u << best;
            }
            selq[tid] = m;
            if (m) atomicOr(anyb, m);
        }
        __syncthreads();
        mysel = selq[wave * 32 + ql];
        anysel = *anyb;
        __syncthreads();
    }
    h8 qf[4];
#pragma unroll
    for (int ks = 0; ks < 4; ++ks) qf[ks] = *(const h8*)(Pb + (size_t)tq * NP + QOFF + 16 * ks + 8 * hh);
    f16v O0, O1;
#pragma unroll
    for (int r = 0; r < 16; ++r) { O0[r] = 0.f; O1[r] = 0.f; }
    float m_run = -1e30f, l_run = 0.f;
    const float CS = 0.18033688011112042f;
    const int ntile = 2 * qt + 2;
    auto skip = [&](int kt) -> bool { return MODE == 1 && kt < 4 * own && !((anysel >> (kt >> 2)) & 1u); };
    auto nexttile = [&](int kt) -> int { ++kt; while (kt < ntile && skip(kt)) ++kt; return kt; };
    const int lrow = tid >> 3;
    const int kchunk = (tid & 7) ^ ((tid >> 4) & 7);
    const int vchunk = (tid & 7) ^ (((tid >> 4) & 1) << 2);
    char* ldst = lds + lrow * 128 + (tid & 7) * 16;
    auto issue = [&](int kt, int s) {
        const half_t* src = Pb + (size_t)(kt * 64 + lrow) * NP;
        char* d = ldst + s * 16384;
        glds16(src + KOFF + kchunk * 8, d);
        glds16(src + (size_t)32 * NP + KOFF + kchunk * 8, d + 4096);
        glds16(src + VOFF + vchunk * 8, d + 8192);
        glds16(src + (size_t)32 * NP + VOFF + vchunk * 8, d + 8192 + 4096);
    };
    const int rsw = (lane >> 1) & 7;
    const int kro = ql * 128;
    const int li = lane & 15, qp = li >> 2, pp = li & 3, swv = (qp >> 1) & 1;
    const int vb0 = 8192 + (4 * hh + qp) * 128 + 32 * ((lane >> 4) & 1) + 8 * pp + 64 * (0 ^ swv);
    const int vb1 = 8192 + (4 * hh + qp) * 128 + 32 * ((lane >> 4) & 1) + 8 * pp + 64 * (1 ^ swv);
    int kt = -1; kt = nexttile(kt);
    int s = 0;
    if (kt < ntile) issue(kt, 0);
    while (kt < ntile) {
        const int ktn = nexttile(kt);
        asm volatile("s_waitcnt vmcnt(0)" ::: "memory");
        __syncthreads();
        if (ktn < ntile) issue(ktn, s ^ 1);
        const bool wave_active = (kt * 64 <= q0 + wave * 32 + 31);
        if (wave_active) {
            const char* base = lds + s * 16384;
            uint2 mw = make_uint2(0u, 0u);
            if (MODE == 0) mw = *(const uint2*)(p.dmask + (size_t)(tokbase + tq) * 64 + 2 * kt);
            f16v s0, s1;
#pragma unroll
            for (int r = 0; r < 16; ++r) { s0[r] = 0.f; s1[r] = 0.f; }
#pragma unroll
            for (int ks = 0; ks < 4; ++ks) {
                const int co = ((2 * ks + hh) ^ rsw) << 4;
                const h8 k0 = *(const h8*)(base + kro + co), k1 = *(const h8*)(base + kro + 4096 + co);
                s0 = __builtin_amdgcn_mfma_f32_32x32x16_f16(k0, qf[ks], s0, 0, 0, 0);
                s1 = __builtin_amdgcn_mfma_f32_32x32x16_f16(k1, qf[ks], s1, 0, 0, 0);
            }
            if (MODE == 0) {
                const unsigned w0 = mw.x >> (4 * hh), w1 = mw.y >> (4 * hh);
#pragma unroll
                for (int r = 0; r < 16; ++r) {
                    const int pos = (r & 3) + 8 * (r >> 2);
                    s0[r] = ((w0 >> pos) & 1u) ? s0[r] : -INFINITY;
                    s1[r] = ((w1 >> pos) & 1u) ? s1[r] : -INFINITY;
                }
            } else {
                if (kt < 4 * own) {
                    const bool v = (mysel >> (kt >> 2)) & 1u;
                    if (!v) {
#pragma unroll
                        for (int r = 0; r < 16; ++r) { s0[r] = -INFINITY; s1[r] = -INFINITY; }
                    }
                } else if (kt * 64 + 63 > q0 + wave * 32) {
#pragma unroll
                    for (int r = 0; r < 16; ++r) {
                        const int key = kt * 64 + (r & 3) + 8 * (r >> 2) + 4 * hh;
                        s0[r] = (key <= tq) ? s0[r] : -INFINITY;
                        s1[r] = (key + 32 <= tq) ? s1[r] : -INFINITY;
                    }
                }
            }
            float mx = s0[0];
#pragma unroll
            for (int r = 1; r < 16; ++r) mx = fmaxf(mx, s0[r]);
#pragma unroll
            for (int r = 0; r < 16; ++r) mx = fmaxf(mx, s1[r]);
            mx = fmaxf(mx, __shfl_xor(mx, 32));
            const float mnew = fmaxf(m_run, mx);
            const float alpha = __builtin_amdgcn_exp2f((m_run - mnew) * CS);
            const float mc = mnew * CS;
            m_run = mnew;
            float ls = 0.f;
#pragma unroll
            for (int r = 0; r < 16; ++r) { s0[r] = __builtin_amdgcn_exp2f(fmaf(s0[r], CS, -mc)); ls += s0[r]; }
#pragma unroll
            for (int r = 0; r < 16; ++r) { s1[r] = __builtin_amdgcn_exp2f(fmaf(s1[r], CS, -mc)); ls += s1[r]; }
            l_run = l_run * alpha + ls;
#pragma unroll
            for (int r = 0; r < 16; ++r) { O0[r] *= alpha; O1[r] *= alpha; }
#pragma unroll
            for (int ksub = 0; ksub < 2; ++ksub) {
#pragma unroll
                for (int sp = 0; sp < 2; ++sp) {
                    h8 pf;
#pragma unroll
                    for (int j = 0; j < 8; ++j) pf[j] = (half_t)(ksub ? s1[8 * sp + j] : s0[8 * sp + j]);
                    const int roff = (32 * ksub + 16 * sp) * 128;
                    {
                        const s4v lo = __builtin_amdgcn_ds_read_tr16_b64_v4i16((LAS s4v*)(base + vb0 + roff));
                        const s4v hi = __builtin_amdgcn_ds_read_tr16_b64_v4i16((LAS s4v*)(base + vb0 + roff + 8 * 128));
                        const h8 vf = __builtin_bit_cast(h8, __builtin_shufflevector(lo, hi, 0, 1, 2, 3, 4, 5, 6, 7));
                        O0 = __builtin_amdgcn_mfma_f32_32x32x16_f16(vf, pf, O0, 0, 0, 0);
                    }
                    {
                        const s4v lo = __builtin_amdgcn_ds_read_tr16_b64_v4i16((LAS s4v*)(base + vb1 + roff));
                        const s4v hi = __builtin_amdgcn_ds_read_tr16_b64_v4i16((LAS s4v*)(base + vb1 + roff + 8 * 128));
                        const h8 vf = __builtin_bit_cast(h8, __builtin_shufflevector(lo, hi, 0, 1, 2, 3, 4, 5, 6, 7));
                        O1 = __builtin_amdgcn_mfma_f32_32x32x16_f16(vf, pf, O1, 0, 0, 0);
                    }
                }
            }
        }
        kt = ktn; s ^= 1;
    }
    const float lt = l_run + __shfl_xor(l_run, 32);
    const float inv = 1.0f / lt;
    half_t* dst = p.ycat + (size_t)(tokbase + tq) * DM + (MODE ? 640 : 256) + h * 64 + 4 * hh;
#pragma unroll
    for (int g = 0; g < 4; ++g) {
        *(h4*)(dst + 8 * g) = pack4(O0[4 * g] * inv, O0[4 * g + 1] * inv, O0[4 * g + 2] * inv, O0[4 * g + 3] * inv);
        *(h4*)(dst + 32 + 8 * g) = pack4(O1[4 * g] * inv, O1[4 * g + 1] * inv, O1[4 * g + 2] * inv, O1[4 * g + 3] * inv);
    }
}

__device__ void phase_attn(const Params& p, char* lds) {
    for (int u = BID(); u < 3072; u += gridDim.x) {
        const int qt = 15 - (u / 192), rem = u % 192;
        const int type = rem & 1, bh = rem >> 1;
        if (type == 0) attn_unit<0>(p, lds, bh / 6, bh % 6, qt);
        else attn_unit<1>(p, lds, bh / 6, bh % 6, qt);
    }
}

__global__ void __launch_bounds__(256, 2) mk_fwd(Params p) {
    extern __shared__ __attribute__((aligned(16))) char lds[];
    volatile LAS unsigned* stw = (volatile LAS unsigned*)(lds + 65536);
    if (threadIdx.x < 4) stw[threadIdx.x] = 0u;
    __syncthreads();
    XcdBarrier bar; bar.bar = p.bar; bar.x = 0; bar.st = stw;
#if !MK_SPLIT
    bar = xcd_barrier_post(p.bar, stw);
#endif
    for (int ph = p.ph_lo; ph < p.ph_hi; ++ph) {
        if (ph == 0) phase_prologue(p, lds);
        else if (ph == 1) phase_modsum(p);
        else if (ph == NPHASE - 1) phase_norm<2>(p, p.out, p.g_final, nullptr, nullptr, 0);
        else {
            const int l = (ph - 2) >> 3, sub = (ph - 2) & 7;
            const float* mf = p.modf + (size_t)l * 16 * 6144;
            const float* xin = l == 0 ? p.x : p.out;
            if (sub == 0) phase_norm<0>(p, xin, p.g_mix + l * DM, mf, mf + 1024, l);
            else if (sub == 1) phase_inproj(p, lds, l);
            else if (sub == 2) phase_post(p, lds, l);
            else if (sub == 3) phase_attn(p, lds);
            else if (sub == 4) phase_outproj(p, lds, l, xin);
            else if (sub == 5) phase_norm<1>(p, p.out, p.g_ffn + l * DM, mf + 3 * 1024, mf + 4 * 1024, l);
            else if (sub == 6) phase_moe_up(p, lds, l);
            else phase_moe_down(p, lds, l);
        }
#if !MK_SPLIT
        if (ph + 1 < p.ph_hi) xcd_barrier(bar);
#endif
    }
}

extern "C" void kernel_launch(void* const* d_in, const int* in_sizes, int n_in, void* d_out, int out_size, void* d_ws, size_t ws_size, hipStream_t stream) {
    static int grid = 0;
    if (grid == 0) {
        int dev = 0, cus = 0, per_cu = 0;
        (void)hipGetDevice(&dev);
        (void)hipDeviceGetAttribute(&cus, hipDeviceAttributeMultiprocessorCount, dev);
        (void)hipFuncSetAttribute((const void*)mk_fwd, hipFuncAttributeMaxDynamicSharedMemorySize, LDS_BYTES);
        if (hipOccupancyMaxActiveBlocksPerMultiprocessor(&per_cu, (const void*)mk_fwd, 256, LDS_BYTES) != hipSuccess || per_cu < 1) per_cu = 1;
        (void)hipGetLastError();
        if (per_cu > 2) per_cu = 2;
        grid = cus * per_cu;
        fprintf(stderr, "mk_fwd: cus %d per_cu %d grid %d\n", cus, per_cu, grid);
    }
    Params p{};
    const float** pin = (const float**)&p.x;
    for (int i = 0; i < 18; ++i) pin[i] = (const float*)d_in[i];
    p.out = (float*)d_out;
    char* ws = (char*)d_ws;
    size_t off = 0;
    auto carve = [&](size_t bytes) { void* q = ws + off; off += (bytes + 255) & ~(size_t)255; return q; };
    p.bar = (unsigned*)carve(XCD_BAR_WORDS * 4);
    p.cnt = (int*)carve(64 * 4);
    const size_t zero_bytes = off;
    p.Wt_in = (half_t*)carve((size_t)2 * NP * DM * 2);
    p.Wt_o = (half_t*)carve((size_t)2 * DM * DM * 2);
    p.Wt_gu = (half_t*)carve((size_t)2 * 16 * 512 * 1024 * 2);
    p.Wt_d = (half_t*)carve((size_t)2 * 16 * 1024 * 256 * 2);
    p.hn = (half_t*)carve((size_t)T_TOK * DM * 2);
    p.P = (half_t*)carve((size_t)T_TOK * NP * 2);
    p.ycat = (half_t*)carve((size_t)T_TOK * DM * 2);
    p.act = (half_t*)carve((size_t)T_TOK * 512 * 2);
    p.modpart = (float*)carve((size_t)8 * 2 * 16 * 6144 * 4);
    p.modf = (float*)carve((size_t)2 * 16 * 6144 * 4);
    p.kmean = (float*)carve((size_t)16 * 6 * 8 * 64 * 4);
    p.rope = (float*)carve((size_t)2048 * 24 * 4);
    p.iwf = (float*)carve((size_t)T_TOK * 4 * 4);
    p.tokw = (float*)carve((size_t)T_TOK * 2 * 4);
    p.dmask = (unsigned*)carve((size_t)T_TOK * 64 * 4);
    p.lists = (int*)carve((size_t)NCLS * T_TOK * 4);
    if (off > ws_size) { fprintf(stderr, "workspace too small: need %zu have %zu\n", off, ws_size); return; }
    (void)hipMemsetAsync(d_ws, 0, zero_bytes, stream);
#if MK_SPLIT
    for (int ph = 0; ph < NPHASE; ++ph) {
        p.ph_lo = ph; p.ph_hi = ph + 1;
        hipLaunchKernelGGL(mk_fwd, dim3(grid), dim3(256), LDS_BYTES, stream, p);
    }
#else
    p.ph_lo = 0; p.ph_hi = NPHASE;
    hipLaunchKernelGGL(mk_fwd, dim3(grid), dim3(256), LDS_BYTES, stream, p);
#endif
}
```

```cpp
#include <hip/hip_runtime.h>
#include <cstdio>
#include <cstdint>

#ifndef MK_SPLIT
#define MK_SPLIT 0
#endif

#define T_TOK 32768
#define DM 1024
#define SEQ 2048
#define INW 2340
#define NP 2432
#define PC_CU 0
#define PC_CG 256
#define PC_DQ 512
#define PC_DK 896
#define PC_DV 960
#define PC_IQ 1024
#define PC_IK 1152
#define PC_IW 1184
#define PC_MQ 1280
#define PC_MK 1664
#define PC_MV 2048
#define LOG_THETA 13.122363377404328f
#define NCLS 24
#define LDS_BYTES 66048
#define NPHASE 19
#ifndef DUP_SUB
#define DUP_SUB -1
#endif

typedef _Float16 half_t;
typedef _Float16 h8 __attribute__((ext_vector_type(8)));
typedef _Float16 h4 __attribute__((ext_vector_type(4)));
typedef short s4v __attribute__((ext_vector_type(4)));
typedef short s8v __attribute__((ext_vector_type(8)));
typedef float f16v __attribute__((ext_vector_type(16)));
typedef float f4v __attribute__((ext_vector_type(4)));
#define LAS __attribute__((address_space(3)))

struct Params {
    const float *x, *c, *w_ada, *b_ada, *g_mix, *w_in, *w_dw, *b_dw, *ln_g, *ln_b, *w_o, *g_ffn, *w_router, *b_router, *w_gate, *w_up, *w_down, *g_final;
    float* out;
    half_t *Wt_in, *Wt_o, *Wt_gu, *Wt_d, *hn, *P, *ycat, *act;
    float *modpart, *modf, *kmean, *rope, *iwf, *tokw;
    unsigned* dmask; int* cnt; int* lists; unsigned* bar;
    int ph_lo, ph_hi;
};

#define XB_TMO      128
#define XB_XCNT(j)  (256  + 64 * (j))
#define XB_XSUB(j)  (1280 + 64 * (j))
#define XB_XGEN(j)  (2304 + 64 * (j))
#define XB_TOP      3328
#define XB_TOPGEN   3392
#define XCD_BAR_WORDS 3456
#define XB_SPIN_CAP (1u << 20)
__device__ __forceinline__ unsigned xb_ld(unsigned* p)              { return __hip_atomic_load(p, __ATOMIC_RELAXED, __HIP_MEMORY_SCOPE_AGENT); }
__device__ __forceinline__ unsigned xb_add(unsigned* p, unsigned v) { return __hip_atomic_fetch_add(p, v, __ATOMIC_RELAXED, __HIP_MEMORY_SCOPE_AGENT); }
__device__ __forceinline__ unsigned xb_xcc_id() { return (unsigned)__builtin_amdgcn_s_getreg((3 << 11) | 20) & 0xFu; }
#define XB_SPIN(cond, bar) do { unsigned _sp = 0; while (cond) { __builtin_amdgcn_s_sleep(1); \
    if ((++_sp & 255u) == 0u) { if (xb_ld(&(bar)[XB_TMO])) break; if (_sp > XB_SPIN_CAP) { atomicAdd(&(bar)[XB_TMO], 1u); break; } } } } while (0)
struct XcdBarrier { unsigned* bar; unsigned x; volatile LAS unsigned* st; };
__device__ __forceinline__ XcdBarrier xcd_barrier_post(unsigned* bar, volatile LAS unsigned* st) {
    XcdBarrier b; b.bar = bar; b.x = xb_xcc_id(); b.st = st;
    if (threadIdx.x == 0) (void)xb_add(&bar[XB_XCNT(b.x)], 1u);
    return b;
}
__device__ __forceinline__ void xcd_barrier_complete(unsigned* bar, unsigned x, unsigned& nloc, unsigned& nx) {
    const unsigned G = gridDim.x * gridDim.y * gridDim.z;
    unsigned sum, cnt, mine, sp = 0u;
    for (;;) {
        sum = 0u; cnt = 0u; mine = 0u;
#pragma unroll
        for (unsigned j = 0; j < 16; ++j) { const unsigned c = xb_ld(&bar[XB_XCNT(j)]); sum += c; cnt += (c > 0u) ? 1u : 0u; mine = (j == x) ? c : mine; }
        if (sum == G) break;
        __builtin_amdgcn_s_sleep(1);
        if ((++sp & 255u) == 0u) { if (xb_ld(&bar[XB_TMO])) break; if (sp > XB_SPIN_CAP) { atomicAdd(&bar[XB_TMO], 1u); break; } }
    }
    nloc = mine > 0u ? mine : 1u; nx = cnt > 0u ? cnt : 1u;
}
__device__ __forceinline__ void xcd_barrier(const XcdBarrier& b) {
    asm volatile("s_waitcnt vmcnt(0)" ::: "memory");
    __syncthreads();
    if (threadIdx.x == 0) {
        unsigned* bar = b.bar;
        __builtin_amdgcn_s_waitcnt(0);
        unsigned nloc = b.st[0], nx = b.st[1];
        if (nloc == 0u) { xcd_barrier_complete(bar, b.x, nloc, nx); b.st[0] = nloc; b.st[1] = nx; }
        const unsigned old = xb_add(&bar[XB_XSUB(b.x)], 1u);
        const unsigned gen = old / nloc;
        if (old + 1u == (gen + 1u) * nloc) {
            __builtin_amdgcn_fence(__ATOMIC_RELEASE, "agent");
            asm volatile("s_waitcnt vmcnt(0)" ::: "memory");
            const unsigned og = xb_add(&bar[XB_TOP], 1u);
            const unsigned tg = og / nx;
            if (og + 1u == (tg + 1u) * nx) xb_add(&bar[XB_TOPGEN], 1u);
            else XB_SPIN(xb_ld(&bar[XB_TOPGEN]) == tg, bar);
            __builtin_amdgcn_fence(__ATOMIC_ACQUIRE, "agent");
            xb_add(&bar[XB_XGEN(b.x)], 1u);
            asm volatile("s_waitcnt vmcnt(0)" ::: "memory");
        } else {
            XB_SPIN(xb_ld(&bar[XB_XGEN(b.x)]) == gen, bar);
            __builtin_amdgcn_fence(__ATOMIC_ACQUIRE, "agent");
            asm volatile("s_waitcnt vmcnt(0)" ::: "memory");
        }
    }
    __syncthreads();
}

typedef const __attribute__((address_space(4))) Params* KP;
__device__ __forceinline__ int TID() { int t = threadIdx.x; asm volatile("" : "+v"(t)); return t; }
__device__ __forceinline__ int BID() { int b = blockIdx.x; asm volatile("" : "+s"(b)); return b; }
__device__ __forceinline__ float sigmoidf_(float v) { return 1.0f / (1.0f + __expf(-v)); }
__device__ __forceinline__ void glds16(const void* g, char* l) { __builtin_amdgcn_global_load_lds((const unsigned*)g, (unsigned*)l, 16, 0, 0); }
__device__ __forceinline__ unsigned f2sortable(float f) { unsigned u = __float_as_uint(f); return (u & 0x80000000u) ? ~u : (u | 0x80000000u); }
__device__ __forceinline__ h4 pack4(float a, float b, float c, float d) { h4 r = {(half_t)a, (half_t)b, (half_t)c, (half_t)d}; return r; }

template <class CF>
__device__ __forceinline__ void conv_tile(char* lds, CF colf, int src_ld, int k0, half_t* dst_tile  , int dstK) {
    float* tl = (float*)lds;
    const int tid = TID();
    __syncthreads();
    {
        const int nn = tid & 63;
        const float* cp = colf(nn);
#pragma unroll 4
        for (int i = 0; i < 16; ++i) { const int k = i * 4 + (tid >> 6); tl[k * 65 + nn] = cp ? cp[(size_t)(k0 + k) * src_ld] : 0.f; }
    }
    __syncthreads();
    {
        const int n = tid >> 2, kq = (tid & 3) * 16;
        h8 a, b;
#pragma unroll
        for (int j = 0; j < 8; ++j) { a[j] = (half_t)tl[(kq + j) * 65 + n]; b[j] = (half_t)tl[(kq + 8 + j) * 65 + n]; }
        h8* d = (h8*)(dst_tile + (size_t)n * dstK + kq);
        d[0] = a; d[1] = b;
    }
}

__device__ __forceinline__ void phase_prologue(KP p, char* lds) {
    const int tid = TID();
    const int NA = 2 * 16 * 38, NB = 2 * 16 * 16, NC = 2 * 16 * 16 * 8, ND = 2 * 16 * 4 * 16, NE = 384, NF = 8;
    const int total = NA + NB + NC + ND + NE + NF;
    for (int u0 = BID(); u0 < total; u0 += gridDim.x) {
        int u = u0;
        if (u < NA) {
            const int nt = u % 38, kt = (u / 38) % 16, l = u / (38 * 16);
            const float* src = p->w_in + (size_t)l * DM * INW;
            const int n0 = nt * 64;
            conv_tile(lds, [&](int nn) -> const float* { const int np = n0 + nn; const int sc = np < 1188 ? np : (np < 1280 ? -1 : np - 92); return sc >= 0 ? src + sc : (const float*)nullptr; },
                      INW, kt * 64, p->Wt_in + ((size_t)l * NP + n0) * DM + kt * 64, DM);
            continue;
        }
        u -= NA;
        if (u < NB) {
            const int nt = u % 16, kt = (u / 16) % 16, l = u / 256;
            const float* src = p->w_o + (size_t)l * DM * DM + nt * 64;
            conv_tile(lds, [&](int nn) -> const float* { return src + nn; }, DM, kt * 64, p->Wt_o + ((size_t)l * DM + nt * 64) * DM + kt * 64, DM);
            continue;
        }
        u -= NB;
        if (u < NC) {
            const int nt = u % 8, kt = (u / 8) % 16, le = u / 128;
            const float* sg = p->w_gate + (size_t)le * 1024 * 256 + nt * 32;
            const float* su = p->w_up + (size_t)le * 1024 * 256 + nt * 32;
            conv_tile(lds, [&](int nn) -> const float* { return nn < 32 ? sg + nn : su + (nn - 32); }, 256, kt * 64, p->Wt_gu + ((size_t)le * 512 + nt * 64) * 1024 + kt * 64, 1024);
            continue;
        }
        u -= NC;
        if (u < ND) {
            const int nt = u % 16, kt = (u / 16) % 4, le = u / 64;
            const float* src = p->w_down + (size_t)le * 256 * 1024 + nt * 64;
            conv_tile(lds, [&](int nn) -> const float* { return src + nn; }, 1024, kt * 64, p->Wt_d + ((size_t)le * 1024 + nt * 64) * 256 + kt * 64, 256);
            continue;
        }
        u -= ND;
        if (u < NE) {
            const int kc = u % 8, cc = (u / 8) % 24, l = u / 192;
            float* ca = (float*)lds;
            __syncthreads();
            for (int i = tid; i < 2048; i += 256) { const int b = i >> 7, k = i & 127; const float v = p->c[b * 1024 + kc * 128 + k]; ca[i] = v / (1.0f + expf(-v)); }
            __syncthreads();
            const int n = cc * 256 + tid;
            float acc[16];
#pragma unroll
            for (int b = 0; b < 16; ++b) acc[b] = 0.f;
            const float* w = p->w_ada + ((size_t)l * 1024 + kc * 128) * 6144 + n;
#pragma unroll 4
            for (int k = 0; k < 128; ++k) {
                const float wv = w[(size_t)k * 6144];
#pragma unroll
                for (int b = 0; b < 16; ++b) acc[b] = fmaf(ca[b * 128 + k], wv, acc[b]);
            }
#pragma unroll
            for (int b = 0; b < 16; ++b) p->modpart[(((size_t)kc * 2 + l) * 16 + b) * 6144 + n] = acc[b];
            continue;
        }
        u -= NE;
        {
            for (int i = u * 256 + tid; i < 2048 * 12; i += NF * 256) {
                const int t = i / 12, r = i % 12;
                const int fi = r < 8 ? r : r - 8;
                const float rot = r < 8 ? 16.f : 8.f;
                const float inv = expf(-LOG_THETA * ((float)fi * 2.0f / rot));
                const float ang = (float)t * inv;
                float sn, cs; sincosf(ang, &sn, &cs);
                if (r < 8) { p->rope[t * 8 + fi] = cs; p->rope[16384 + t * 8 + fi] = sn; }
                else { p->rope[32768 + t * 4 + fi] = cs; p->rope[32768 + 8192 + t * 4 + fi] = sn; }
            }
        }
    }
}

__device__ __forceinline__ void phase_modsum(KP p) {
    for (int i = BID() * 256 + TID(); i < 2 * 16 * 6144; i += gridDim.x * 256) {
        const int n = i % 6144, l = i / (16 * 6144);
        float s = p->b_ada[l * 6144 + n];
#pragma unroll
        for (int kc = 0; kc < 8; ++kc) s += p->modpart[(size_t)kc * (2 * 16 * 6144) + i];
        p->modf[i] = s;
    }
}

template <int MODE>
__device__ __forceinline__ void phase_norm(KP p, char* lds, const float* xin, const float* g, const float* sh, const float* sc, int layer) {
    const int lane = TID() & 63, wave = TID() >> 6;
    float* wt = (float*)lds;
    if (MODE == 1) {
        __syncthreads();
        for (int i = TID(); i < 4096; i += 256) {
            const float4 w4 = ((const float4*)p->w_router)[i];
            const int k = i >> 2, e0 = (i & 3) * 4;
            wt[(e0 + 0) * 1024 + k] = w4.x; wt[(e0 + 1) * 1024 + k] = w4.y; wt[(e0 + 2) * 1024 + k] = w4.z; wt[(e0 + 3) * 1024 + k] = w4.w;
        }
        __syncthreads();
    }
    for (int row = BID() * 4 + wave; row < T_TOK; row += gridDim.x * 4) {
        const int b = row >> 11;
        const float4* xr = (const float4*)(xin + (size_t)row * DM);
        float4 v[4]; float ss = 0.f;
#pragma unroll
        for (int i = 0; i < 4; ++i) { v[i] = xr[lane + 64 * i]; ss += v[i].x * v[i].x + v[i].y * v[i].y + v[i].z * v[i].z + v[i].w * v[i].w; }
#pragma unroll
        for (int o = 32; o >= 1; o >>= 1) ss += __shfl_xor(ss, o);
        const float rstd = 1.0f / sqrtf(ss * (1.0f / 1024.0f) + 1e-6f);
        float acc[16];
        if (MODE == 1) {
#pragma unroll
            for (int e = 0; e < 16; ++e) acc[e] = 0.f;
        }
#pragma unroll
        for (int i = 0; i < 4; ++i) {
            const int k = (lane + 64 * i) * 4;
            const float4 gg = *(const float4*)(g + k);
            float y[4] = {v[i].x * rstd * gg.x, v[i].y * rstd * gg.y, v[i].z * rstd * gg.z, v[i].w * rstd * gg.w};
            if (MODE != 2) {
                const float4 s1 = *(const float4*)(sh + (size_t)b * 6144 + k), s2 = *(const float4*)(sc + (size_t)b * 6144 + k);
                y[0] = y[0] * (1.f + s2.x) + s1.x; y[1] = y[1] * (1.f + s2.y) + s1.y; y[2] = y[2] * (1.f + s2.z) + s1.z; y[3] = y[3] * (1.f + s2.w) + s1.w;
                *(h4*)(p->hn + (size_t)row * DM + k) = pack4(y[0], y[1], y[2], y[3]);
            } else {
                *(float4*)(p->out + (size_t)row * DM + k) = make_float4(y[0], y[1], y[2], y[3]);
            }
            if (MODE == 1) {
#pragma unroll
                for (int e = 0; e < 16; ++e) {
                    const float4 w4 = *(const float4*)(wt + e * 1024 + k);
                    acc[e] = fmaf(y[0], w4.x, fmaf(y[1], w4.y, fmaf(y[2], w4.z, fmaf(y[3], w4.w, acc[e]))));
                    if ((e & 3) == 3) __builtin_amdgcn_sched_barrier(0);
                }
            }
        }
        if (MODE == 1) {
            const bool b5 = lane & 32, b4 = lane & 16, b3 = lane & 8, b2 = lane & 4;
            float r8[8], r4[4], r2[2];
#pragma unroll
            for (int e = 0; e < 8; ++e) { const float snd = b5 ? acc[e] : acc[e + 8], kp = b5 ? acc[e + 8] : acc[e]; r8[e] = kp + __shfl_xor(snd, 32); }
#pragma unroll
            for (int e = 0; e < 4; ++e) { const float snd = b4 ? r8[e] : r8[e + 4], kp = b4 ? r8[e + 4] : r8[e]; r4[e] = kp + __shfl_xor(snd, 16); }
#pragma unroll
            for (int e = 0; e < 2; ++e) { const float snd = b3 ? r4[e] : r4[e + 2], kp = b3 ? r4[e + 2] : r4[e]; r2[e] = kp + __shfl_xor(snd, 8); }
            float rv; { const float snd = b2 ? r2[0] : r2[1], kp = b2 ? r2[1] : r2[0]; rv = kp + __shfl_xor(snd, 4); }
            rv += __shfl_xor(rv, 2); rv += __shfl_xor(rv, 1);
#pragma unroll
            for (int e = 0; e < 16; ++e) acc[e] = __builtin_bit_cast(float, __builtin_amdgcn_readlane(__builtin_bit_cast(int, rv), 4 * e));
            if (lane == 0) {
                float aff[16], bia[16];
#pragma unroll
                for (int e = 0; e < 16; ++e) { aff[e] = 1.0f / (1.0f + expf(-acc[e])); bia[e] = aff[e] + p->b_router[e]; }
                int bestg = 0; float bests = -INFINITY;
#pragma unroll
                for (int gi = 0; gi < 4; ++gi) {
                    float m1 = -INFINITY, m2 = -INFINITY;
#pragma unroll
                    for (int j = 0; j < 4; ++j) { const float vv = bia[gi * 4 + j]; if (vv > m1) { m2 = m1; m1 = vv; } else if (vv > m2) m2 = vv; }
                    const float s = m1 + m2;
                    if (s > bests) { bests = s; bestg = gi; }
                }
                float bsel[4], asel[4];
#pragma unroll
                for (int j = 0; j < 4; ++j) { bsel[j] = 0.f; asel[j] = 0.f; }
#pragma unroll
                for (int gi = 0; gi < 4; ++gi) if (gi == bestg) {
#pragma unroll
                    for (int j = 0; j < 4; ++j) { bsel[j] = bia[gi * 4 + j]; asel[j] = aff[gi * 4 + j]; }
                }
                int i1 = -1, i2 = -1; float v1 = -INFINITY, v2 = -INFINITY;
#pragma unroll
                for (int j = 0; j < 4; ++j) { const float vv = bsel[j]; if (vv > v1) { v2 = v1; i2 = i1; v1 = vv; i1 = j; } else if (vv > v2) { v2 = vv; i2 = j; } }
                const int a = i1 < i2 ? i1 : i2, bb = i1 < i2 ? i2 : i1;
                float wa = 0.f, wb = 0.f;
#pragma unroll
                for (int j = 0; j < 4; ++j) { if (j == a) wa = asel[j]; if (j == bb) wb = asel[j]; }
                const float sw = wa + wb;
                const int pi = (a == 0) ? (bb - 1) : (a == 1 ? (bb + 1) : 5);
                const int cls = bestg * 6 + pi;
                *(float2*)(p->tokw + (size_t)row * 2) = make_float2(wa / sw, wb / sw);
                const int pos = atomicAdd(&p->cnt[layer * 32 + cls], 1);
                p->lists[(size_t)cls * T_TOK + pos] = row;
            }
        }
    }
}

template <class WF, class XF, class EPI>
__device__ __forceinline__ void gemm_tile(char* lds, int nkt, WF wf, XF xf, EPI epi) {
    const int tid = TID(), lane = tid & 63, wave = tid >> 6;
    const int wn = wave & 1, wm = wave >> 1, hh = lane >> 5;
    const int lrow = tid >> 3;
    const int lchunk = (tid & 7) ^ ((tid >> 4) & 7);
    const half_t* xs[4];
#pragma unroll
    for (int i = 0; i < 4; ++i) xs[i] = xf(lrow + 32 * i) + lchunk * 8;
    char* ldst = lds + lrow * 128 + (tid & 7) * 16;
    f16v acc[2][2];
#pragma unroll
    for (int i = 0; i < 2; ++i)
#pragma unroll
        for (int j = 0; j < 2; ++j)
#pragma unroll
            for (int r = 0; r < 16; ++r) acc[i][j][r] = 0.f;
    auto issue = [&](int kt, int s) {
        char* d = ldst + s * 32768;
#pragma unroll
        for (int i = 0; i < 4; ++i) glds16(wf(kt, lrow + 32 * i) + lchunk * 8, d + i * 4096);
#pragma unroll
        for (int i = 0; i < 4; ++i) glds16(xs[i] + kt * 64, d + 16384 + i * 4096);
    };
    __syncthreads();
    issue(0, 0);
    const int rsw = (lane >> 1) & 7;
    const int roff_w = (wn * 64 + (lane & 31)) * 128, roff_x = 16384 + (wm * 64 + (lane & 31)) * 128;
    for (int kt = 0; kt < nkt; ++kt) {
        asm volatile("s_waitcnt vmcnt(0)" ::: "memory");
        __syncthreads();
        if (kt + 1 < nkt) issue(kt + 1, (kt + 1) & 1);
        const char* base = lds + (kt & 1) * 32768;
#pragma unroll
        for (int ks = 0; ks < 4; ++ks) {
            const int co = ((2 * ks + hh) ^ rsw) << 4;
            const h8 a0 = *(const h8*)(base + roff_w + co), a1 = *(const h8*)(base + roff_w + 4096 + co);
            const h8 b0 = *(const h8*)(base + roff_x + co), b1 = *(const h8*)(base + roff_x + 4096 + co);
            acc[0][0] = __builtin_amdgcn_mfma_f32_32x32x16_f16(a0, b0, acc[0][0], 0, 0, 0);
            acc[0][1] = __builtin_amdgcn_mfma_f32_32x32x16_f16(a0, b1, acc[0][1], 0, 0, 0);
            acc[1][0] = __builtin_amdgcn_mfma_f32_32x32x16_f16(a1, b0, acc[1][0], 0, 0, 0);
            acc[1][1] = __builtin_amdgcn_mfma_f32_32x32x16_f16(a1, b1, acc[1][1], 0, 0, 0);
        }
    }
    epi(acc, wn, wm, lane);
}

__device__ __forceinline__ void phase_inproj(KP p, char* lds, int l) {
    const half_t* W = p->Wt_in + (size_t)l * NP * DM;
    const float* rc16 = p->rope; const float* rs16 = p->rope + 16384; const float* rc8 = p->rope + 32768; const float* rs8 = p->rope + 32768 + 8192;
    for (int u = BID(); u < 256 * 19; u += gridDim.x) {
        const int nt = u % 19, mt = u / 19;
        gemm_tile(lds, 16,
            [&](int kt, int row) { return W + (size_t)(nt * 128 + row) * DM + kt * 64; },
            [&](int row) { return p->hn + (size_t)(mt * 128 + row) * DM; },
            [&](f16v (&acc)[2][2], int wn, int wm, int lane) {
                const int hh = lane >> 5;
#pragma unroll
                for (int i = 0; i < 2; ++i) {
                    const int nb = nt * 128 + wn * 64 + i * 32;
                    if (nb == 1216 || nb == 1248) continue;
                    const bool rope64 = ((nb >= PC_DQ && nb < PC_DV) || (nb >= PC_MQ && nb < PC_MV)) && ((nb & 63) == 0);
                    const bool rope32 = (nb >= PC_IQ && nb < PC_IW);
#pragma unroll
                    for (int j = 0; j < 2; ++j) {
                        const int tok = mt * 128 + wm * 64 + j * 32 + (lane & 31);
                        const int t = tok & 2047;
                        f16v v = acc[i][j];
                        if (nb == PC_IW) { if (hh == 0) *(float4*)(p->iwf + (size_t)tok * 4) = make_float4(v[0], v[1], v[2], v[3]); continue; }
                        if (rope64) {
                            const float4 c4 = *(const float4*)(rc16 + t * 8 + 4 * hh), s4 = *(const float4*)(rs16 + t * 8 + 4 * hh);
                            const float cc[4] = {c4.x, c4.y, c4.z, c4.w}, sn[4] = {s4.x, s4.y, s4.z, s4.w};
#pragma unroll
                            for (int r = 0; r < 4; ++r) { const float x1 = v[r], x2 = v[r + 4]; v[r] = x1 * cc[r] - x2 * sn[r]; v[r + 4] = x2 * cc[r] + x1 * sn[r]; }
                        } else if (rope32) {
                            const float4 c4 = *(const float4*)(rc8 + t * 4), s4 = *(const float4*)(rs8 + t * 4);
                            const float cc[4] = {c4.x, c4.y, c4.z, c4.w}, sn[4] = {s4.x, s4.y, s4.z, s4.w};
#pragma unroll
                            for (int r = 0; r < 4; ++r) { const float o = __shfl_xor(v[r], 32); v[r] = hh ? (v[r] * cc[r] + o * sn[r]) : (v[r] * cc[r] - o * sn[r]); }
                        }
                        half_t* dst = p->P + (size_t)tok * NP + nb + 4 * hh;
#pragma unroll
                        for (int g = 0; g < 4; ++g) *(h4*)(dst + 8 * g) = pack4(v[4 * g], v[4 * g + 1], v[4 * g + 2], v[4 * g + 3]);
                    }
                }
            });
    }
}

__device__ __forceinline__ void phase_outproj(KP p, char* lds, int l, const float* xin) {
    const half_t* W = p->Wt_o + (size_t)l * DM * DM;
    const float* g1 = p->modf + (size_t)l * 16 * 6144 + 2 * 1024;
    for (int u = BID(); u < 256 * 8; u += gridDim.x) {
        const int nt = u % 8, mt = u / 8;
        gemm_tile(lds, 16,
            [&](int kt, int row) { return W + (size_t)(nt * 128 + row) * DM + kt * 64; },
            [&](int row) { return p->ycat + (size_t)(mt * 128 + row) * DM; },
            [&](f16v (&acc)[2][2], int wn, int wm, int lane) {
                const int hh = lane >> 5;
#pragma unroll
                for (int j = 0; j < 2; ++j) {
                    const int tok = mt * 128 + wm * 64 + j * 32 + (lane & 31);
                    const int b = tok >> 11;
#pragma unroll
                    for (int i = 0; i < 2; ++i) {
                        const int nb = nt * 128 + wn * 64 + i * 32 + 4 * hh;
#pragma unroll
                        for (int g = 0; g < 4; ++g) {
                            const int n = nb + 8 * g;
                            const float4 xi = *(const float4*)(xin + (size_t)tok * DM + n);
                            const float4 gg = *(const float4*)(g1 + (size_t)b * 6144 + n);
                            float4 o; o.x = xi.x + gg.x * acc[i][j][4 * g]; o.y = xi.y + gg.y * acc[i][j][4 * g + 1]; o.z = xi.z + gg.z * acc[i][j][4 * g + 2]; o.w = xi.w + gg.w * acc[i][j][4 * g + 3];
                            *(float4*)(p->out + (size_t)tok * DM + n) = o;
                        }
                    }
                }
            });
    }
}

__device__ __forceinline__ bool moe_tile(const int* cnt, int tile, int& cls, int& pos0, int& n) {
    int tb = 0;
    for (int c = 0; c < NCLS; ++c) {
        const int nc = cnt[c], nt = (nc + 127) >> 7;
        if (tile < tb + nt) { cls = c; pos0 = (tile - tb) * 128; n = nc; return true; }
        tb += nt;
    }
    return false;
}
__device__ __forceinline__ void cls_experts(int cls, int& e1, int& e2) {
    const int g = cls / 6, pi = cls % 6;
    const int a = pi < 3 ? 0 : (pi < 5 ? 1 : 2);
    const int b = pi < 3 ? pi + 1 : (pi < 5 ? pi - 1 : 3);
    e1 = g * 4 + a; e2 = g * 4 + b;
}
__device__ __forceinline__ void phase_moe_up(KP p, char* lds, int l) {
    const int* cnt = p->cnt + l * 32;
    for (int u = BID(); u < (256 + NCLS) * 8; u += gridDim.x) {
        const int nt = u % 8, tile = u / 8;
        int cls, pos0, nc;
        if (!moe_tile(cnt, tile, cls, pos0, nc)) break;
        int e1, e2; cls_experts(cls, e1, e2);
        const int slot = nt >> 2;
        const half_t* W = p->Wt_gu + ((size_t)(l * 16 + (slot ? e2 : e1)) * 512 + (nt & 3) * 128) * 1024;
        const int* lst = p->lists + (size_t)cls * T_TOK + pos0;
        const int nvalid = nc - pos0;
        gemm_tile(lds, 16,
            [&](int kt, int row) { return W + (size_t)row * 1024 + kt * 64; },
            [&](int row) { const int tok = lst[row < nvalid ? row : 0]; return p->hn + (size_t)tok * DM; },
            [&](f16v (&acc)[2][2], int wn, int wm, int lane) {
                const int hh = lane >> 5;
#pragma unroll
                for (int j = 0; j < 2; ++j) {
                    const int row = wm * 64 + j * 32 + (lane & 31);
                    if (row < nvalid) {
                        const int tok = lst[row];
                        const float wgt = p->tokw[(size_t)tok * 2 + slot];
                        half_t* dst = p->act + (size_t)tok * 512 + slot * 256 + ((nt & 3) * 2 + wn) * 32 + 4 * hh;
#pragma unroll
                        for (int g = 0; g < 4; ++g) {
                            float a[4];
#pragma unroll
                            for (int r = 0; r < 4; ++r) { const float gv = acc[0][j][4 * g + r], uv = acc[1][j][4 * g + r]; a[r] = gv * sigmoidf_(gv) * uv * wgt; }
                            *(h4*)(dst + 8 * g) = pack4(a[0], a[1], a[2], a[3]);
                        }
                    }
                }
            });
    }
}
__device__ __forceinline__ void phase_moe_down(KP p, char* lds, int l) {
    const int* cnt = p->cnt + l * 32;
    const float* g2 = p->modf + (size_t)l * 16 * 6144 + 5 * 1024;
    for (int u = BID(); u < (256 + NCLS) * 8; u += gridDim.x) {
        const int nt = u % 8, tile = u / 8;
        int cls, pos0, nc;
        if (!moe_tile(cnt, tile, cls, pos0, nc)) break;
        int e1, e2; cls_experts(cls, e1, e2);
        const half_t* W1 = p->Wt_d + ((size_t)(l * 16 + e1) * 1024 + nt * 128) * 256;
        const half_t* W2 = p->Wt_d + ((size_t)(l * 16 + e2) * 1024 + nt * 128) * 256;
        const int* lst = p->lists + (size_t)cls * T_TOK + pos0;
        const int nvalid = nc - pos0;
        gemm_tile(lds, 8,
            [&](int kt, int row) { return (kt < 4 ? W1 : W2) + (size_t)row * 256 + (kt & 3) * 64; },
            [&](int row) { const int tok = lst[row < nvalid ? row : 0]; return p->act + (size_t)tok * 512; },
            [&](f16v (&acc)[2][2], int wn, int wm, int lane) {
                const int hh = lane >> 5;
#pragma unroll
                for (int j = 0; j < 2; ++j) {
                    const int row = wm * 64 + j * 32 + (lane & 31);
                    if (row < nvalid) {
                        const int tok = lst[row];
                        const int b = tok >> 11;
#pragma unroll
                        for (int i = 0; i < 2; ++i) {
                            const int nb = nt * 128 + wn * 64 + i * 32 + 4 * hh;
#pragma unroll
                            for (int g = 0; g < 4; ++g) {
                                const int n = nb + 8 * g;
                                float4* xp = (float4*)(p->out + (size_t)tok * DM + n);
                                float4 xi = *xp;
                                const float4 gg = *(const float4*)(g2 + (size_t)b * 6144 + n);
                                xi.x += gg.x * acc[i][j][4 * g]; xi.y += gg.y * acc[i][j][4 * g + 1]; xi.z += gg.z * acc[i][j][4 * g + 2]; xi.w += gg.w * acc[i][j][4 * g + 3];
                                *xp = xi;
                            }
                        }
                    }
                }
            });
    }
}

__device__ __forceinline__ void dsa_select_unit(KP p, char* lds, int b, int qt) {
    unsigned* hist = (unsigned*)lds;
    unsigned* maskl = hist + 16 * 257 + 16;
    unsigned* stP = maskl + 1024;
    unsigned* stNeed = stP + 16;
    unsigned* stDone = stNeed + 16;
    unsigned* flag = stDone + 16;
    unsigned* dummyb = flag + 16;
    const int tid = TID(), lane = tid & 63, wave = tid >> 6;
    const int q0 = qt * 16, tokbase = b * SEQ;
    __syncthreads();
    if (q0 < 256) {
        for (int i = tid; i < 1024; i += 256) {
            const int q = i >> 6, wd = i & 63;
            const int n = q0 + q + 1 - 32 * wd;
            const unsigned w = n >= 32 ? 0xFFFFFFFFu : (n <= 0 ? 0u : ((1u << n) - 1u));
            p->dmask[(size_t)(tokbase + q0 + q) * 64 + wd] = w;
        }
        return;
    }
    for (int i = tid; i < 1024; i += 256) maskl[i] = 0u;
    if (tid < 16) { stP[tid] = 0u; stNeed[tid] = 256u; stDone[tid] = 0u; }
    const int ql = lane & 15, fq = lane >> 4;
    const int tq = q0 + ql;
    const half_t* Pb = p->P + (size_t)tokbase * NP;
    h8 iqf[4];
#pragma unroll
    for (int hd = 0; hd < 4; ++hd) iqf[hd] = *(const h8*)(Pb + (size_t)tq * NP + PC_IQ + hd * 32 + 8 * fq);
    const float4 iw4 = *(const float4*)(p->iwf + (size_t)(tokbase + tq) * 4);
    const float wsc0 = iw4.x * 0.08838834764831845f, wsc1 = iw4.y * 0.08838834764831845f, wsc2 = iw4.z * 0.08838834764831845f, wsc3 = iw4.w * 0.08838834764831845f;
    const int ng = qt + 1;
    unsigned sc[32][4];
    const half_t* ikp = Pb + (size_t)ql * NP + PC_IK + 8 * fq;
#pragma unroll
    for (int gb = 0; gb < 4; ++gb) {
        h8 ik[8];
#pragma unroll
        for (int x = 0; x < 8; ++x) {
            int g = wave + 4 * (gb * 8 + x);
            g = g < ng ? g : ng - 1;
            ik[x] = *(const h8*)(ikp + (size_t)(16 * g) * NP);
        }
#pragma unroll
        for (int x = 0; x < 8; ++x) {
            const int gi = gb * 8 + x;
            const int g = wave + 4 * gi;
            const f4v z = {0.f, 0.f, 0.f, 0.f};
            const f4v c0 = __builtin_amdgcn_mfma_f32_16x16x32_f16(ik[x], iqf[0], z, 0, 0, 0);
            const f4v c1 = __builtin_amdgcn_mfma_f32_16x16x32_f16(ik[x], iqf[1], z, 0, 0, 0);
            const f4v c2 = __builtin_amdgcn_mfma_f32_16x16x32_f16(ik[x], iqf[2], z, 0, 0, 0);
            const f4v c3 = __builtin_amdgcn_mfma_f32_16x16x32_f16(ik[x], iqf[3], z, 0, 0, 0);
#pragma unroll
            for (int r = 0; r < 4; ++r) {
                const int j = 16 * g + 4 * fq + r;
                float sv = wsc0 * fmaxf(c0[r], 0.f);
                sv = fmaf(wsc1, fmaxf(c1[r], 0.f), sv);
                sv = fmaf(wsc2, fmaxf(c2[r], 0.f), sv);
                sv = fmaf(wsc3, fmaxf(c3[r], 0.f), sv);
                sv += 0.0f;
                const unsigned ck = (f2sortable(sv) & 0xFFFFF800u) | (unsigned)(2047 - j);
                sc[gi][r] = (g < ng && j <= tq) ? ck : 0u;
            }
        }
    }
    bool alldone = false;
    for (int pass = 0; pass < 5; ++pass) {
        const bool fin = alldone;
        if (!fin) { for (int i = tid; i < 16 * 257; i += 256) hist[i] = 0u; }
        if (tid == 0) *flag = 0u;
        __syncthreads();
        const unsigned sP = stP[ql], sDone = stDone[ql];
        int wv = wave, fqv = fq;
        asm volatile("" : "+v"(wv), "+v"(fqv));
        if (fin) {
            const int sh = (int)(32u - 8u * (sDone ? sDone : 1u));
            unsigned* mrow = maskl + ql * 64;
#pragma unroll
            for (int gi = 0; gi < 32; ++gi) {
                const int g = wv + 4 * gi;
                unsigned nib = 0u;
#pragma unroll
                for (int r = 0; r < 4; ++r) {
                    const unsigned uu = sc[gi][r];
                    const bool sel = (uu != 0u) & ((uu >> sh) >= sP);
                    nib |= (sel ? 1u : 0u) << r;
                }
                if (g < ng) atomicOr(&mrow[g >> 1], nib << ((g & 1) * 16 + 4 * fqv));
            }
        } else {
            const int shm = pass ? 32 - 8 * pass : 0, shd = 24 - 8 * pass;
            const unsigned cmpv = pass ? sP : 0u;
            const unsigned msk = pass ? 0xFFFFFFFFu : 0u;
            unsigned* hrow = hist + ql * 257;
            unsigned* dummy = dummyb + lane;
            const bool act = (sDone == 0u);
#pragma unroll
            for (int gi = 0; gi < 32; ++gi) {
                const int g = wv + 4 * gi;
                if (g < ng) {
#pragma unroll
                    for (int r = 0; r < 4; ++r) {
                        const unsigned uu = sc[gi][r];
                        const bool match = act & (uu != 0u) & ((((uu >> shm) & msk) == cmpv));
                        const unsigned dig = (uu >> shd) & 255u;
                        unsigned* a = match ? hrow + dig : dummy;
                        atomicAdd(a, 1u);
                    }
                }
            }
        }
        __syncthreads();
        if (fin) break;
        {
            const int qq = tid >> 4, seg = tid & 15;
            const bool active = (stDone[qq] == 0u);
            unsigned c16 = 0u;
            if (active) {
#pragma unroll
                for (int d = 0; d < 16; ++d) c16 += hist[qq * 257 + seg * 16 + d];
            }
            unsigned v = c16;
#pragma unroll
            for (int off = 1; off < 16; off <<= 1) { const unsigned t = __shfl_down(v, off, 16); if (seg + off < 16) v += t; }
            const unsigned suf = v - c16;
            const unsigned need = stNeed[qq];
            if (active && suf < need && need <= suf + c16) {
                unsigned run = suf, D = 0u, cD = 0u, nn = need;
                for (int d = 15; d >= 0; --d) {
                    const unsigned cc = hist[qq * 257 + seg * 16 + d];
                    if (run + cc >= need) { D = (unsigned)(seg * 16 + d); cD = cc; nn = need - run; break; }
                    run += cc;
                }
                const bool done = (cD == nn) || pass == 3;
                stP[qq] = (stP[qq] << 8) | D; stNeed[qq] = nn;
                if (done) stDone[qq] = (unsigned)(pass + 1); else atomicAdd(flag, 1u);
            }
        }
        __syncthreads();
        alldone = (*flag == 0u);
    }
    for (int i = tid; i < 1024; i += 256) p->dmask[(size_t)(tokbase + q0 + (i >> 6)) * 64 + (i & 63)] = maskl[i];
}

__device__ __forceinline__ void conv_unit(KP p, char* lds, int l, int b, int c) {
    float* a = (float*)lds;
    float* red = a + 62 * 256;
    const int ch = TID(), lane = ch & 63, wave = ch >> 6;
    const int t0 = c * 32, tokbase = b * SEQ;
    __syncthreads();
    for (int rr = 0; rr < 62; ++rr) {
        const int tt = t0 - 30 + rr;
        float av = 0.f;
        if (tt >= 0) {
            const half_t* r = p->P + (size_t)(tokbase + tt) * NP;
            const float u = (float)r[PC_CU + ch], g = (float)r[PC_CG + ch];
            av = u * sigmoidf_(g);
        }
        a[rr * 256 + ch] = av;
    }
    float w[31];
#pragma unroll
    for (int i = 0; i < 31; ++i) w[i] = p->w_dw[(l * 31 + i) * 256 + ch];
    const float bias = p->b_dw[l * 256 + ch];
    float y[32];
#pragma unroll
    for (int tk = 0; tk < 32; ++tk) {
        float s = bias;
#pragma unroll
        for (int i = 0; i < 31; ++i) s = fmaf(a[(tk + i) * 256 + ch], w[i], s);
        y[tk] = s;
        float s1 = s, s2 = s * s;
#pragma unroll
        for (int o = 32; o >= 1; o >>= 1) { s1 += __shfl_xor(s1, o); s2 += __shfl_xor(s2, o); }
        if (lane == 0) { red[(tk * 4 + wave) * 2] = s1; red[(tk * 4 + wave) * 2 + 1] = s2; }
    }
    __syncthreads();
    const float lg = p->ln_g[l * 256 + ch], lb = p->ln_b[l * 256 + ch];
#pragma unroll
    for (int tk = 0; tk < 32; ++tk) {
        const float s1 = (red[tk * 8] + red[tk * 8 + 2]) + (red[tk * 8 + 4] + red[tk * 8 + 6]);
        const float s2 = (red[tk * 8 + 1] + red[tk * 8 + 3]) + (red[tk * 8 + 5] + red[tk * 8 + 7]);
        const float mu = s1 * (1.0f / 256.0f);
        float var = s2 * (1.0f / 256.0f) - mu * mu; var = var < 0.f ? 0.f : var;
        float z = (y[tk] - mu) * (1.0f / sqrtf(var + 1e-6f)) * lg + lb;
        z = z * sigmoidf_(z);
        p->ycat[(size_t)(tokbase + t0 + tk) * DM + ch] = (half_t)z;
    }
}

__device__ __forceinline__ void kmean_unit(KP p, char* lds, int b, int h, int blk) {
    float* part = (float*)lds;
    const int tid = TID(), d = tid & 63, pt = tid >> 6;
    const half_t* r = p->P + (size_t)(b * SEQ + blk * 256 + pt * 64) * NP + PC_MK + h * 64 + d;
    float s = 0.f;
    for (int k = 0; k < 64; ++k) s += (float)r[(size_t)k * NP];
    __syncthreads();
    part[pt * 64 + d] = s;
    __syncthreads();
    if (tid < 64) p->kmean[(((size_t)b * 6 + h) * 8 + blk) * 64 + tid] = ((part[tid] + part[64 + tid]) + (part[128 + tid] + part[192 + tid])) * (1.0f / 256.0f);
}

#ifndef POST_MASK
#define POST_MASK 7
#endif
__device__ __forceinline__ void phase_post(KP p, char* lds, int l, int tm) {
    const int NA = 2048, NB = 1024, NC = 768;
    for (int u = BID(); u < NA + NB + NC; u += gridDim.x) {
        if (u < NA) { if (tm & 1) dsa_select_unit(p, lds, u % 16, 127 - (u / 16)); }
        else if (u < NA + NB) { const int v = u - NA; if (tm & 2) conv_unit(p, lds, l, v % 16, v / 16); }
        else { const int v = u - NA - NB; if (tm & 4) kmean_unit(p, lds, v / 48, (v / 8) % 6, v % 8); }
    }
}

template <int MODE>
__device__ __forceinline__ void attn_unit(KP p, char* lds, int b, int h, int qt) {
    const int tid = TID(), lane = tid & 63, wave = tid >> 6, hh = lane >> 5, ql = lane & 31;
    const int q0 = qt * 128, tokbase = b * SEQ;
    const int tq = q0 + wave * 32 + ql;
    const half_t* Pb = p->P + (size_t)tokbase * NP;
    const int QOFF = MODE ? PC_MQ + h * 64 : PC_DQ + h * 64;
    const int KOFF = MODE ? PC_MK + h * 64 : PC_DK;
    const int VOFF = MODE ? PC_MV + h * 64 : PC_DV;
    const int own = qt >> 1;
    unsigned mysel = 0u, anysel = 0u;
    __syncthreads();
    if (MODE == 1) {
        float* km = (float*)(lds + 32768);
        float* gts = km + 512;
        unsigned* selq = (unsigned*)(gts + 1024);
        unsigned* anyb = selq + 128;
        for (int i = tid; i < 512; i += 256) km[i] = p->kmean[((size_t)b * 6 + h) * 512 + i];
        if (tid == 0) *anyb = 0u;
        __syncthreads();
        {
            const int q = tid & 127, hf = tid >> 7;
            if (hf * 4 < own) {
                const half_t* qr = Pb + (size_t)(q0 + q) * NP + QOFF;
                float g0 = 0.f, g1 = 0.f, g2 = 0.f, g3 = 0.f;
#pragma unroll
                for (int c8 = 0; c8 < 8; ++c8) {
                    const h8 qv = *(const h8*)(qr + c8 * 8);
#pragma unroll
                    for (int j = 0; j < 8; ++j) {
                        const float qf = (float)qv[j]; const int d = c8 * 8 + j;
                        g0 = fmaf(qf, km[(hf * 4 + 0) * 64 + d], g0); g1 = fmaf(qf, km[(hf * 4 + 1) * 64 + d], g1);
                        g2 = fmaf(qf, km[(hf * 4 + 2) * 64 + d], g2); g3 = fmaf(qf, km[(hf * 4 + 3) * 64 + d], g3);
                    }
                }
                gts[q * 8 + hf * 4 + 0] = g0; gts[q * 8 + hf * 4 + 1] = g1; gts[q * 8 + hf * 4 + 2] = g2; gts[q * 8 + hf * 4 + 3] = g3;
            }
        }
        __syncthreads();
        if (tid < 128) {
            unsigned m = 0u;
            const int want = own < 3 ? own : 3;
            for (int r = 0; r < want; ++r) {
                int best = -1; float bv = -INFINITY;
                for (int j = 0; j < own; ++j) { const float gv = gts[tid * 8 + j]; if (!((m >> j) & 1u) && (best < 0 || gv > bv)) { best = j; bv = gv; } }
                m |= 1u << best;
            }
            selq[tid] = m;
            if (m) atomicOr(anyb, m);
        }
        __syncthreads();
        mysel = selq[wave * 32 + ql];
        anysel = *anyb;
        __syncthreads();
    }
    h8 qf[4];
#pragma unroll
    for (int ks = 0; ks < 4; ++ks) qf[ks] = *(const h8*)(Pb + (size_t)tq * NP + QOFF + 16 * ks + 8 * hh);
    f16v O0, O1;
#pragma unroll
    for (int r = 0; r < 16; ++r) { O0[r] = 0.f; O1[r] = 0.f; }
    float m_run = -1e30f, l_run = 0.f;
    const float CS = 0.18033688011112042f;
    const int ntile = 2 * qt + 2;
    auto skip = [&](int kt) -> bool { return MODE == 1 && kt < 4 * own && !((anysel >> (kt >> 2)) & 1u); };
    auto nexttile = [&](int kt) -> int { ++kt; while (kt < ntile && skip(kt)) ++kt; return kt; };
    const int lrow = tid >> 3;
    const int kchunk = (tid & 7) ^ ((tid >> 4) & 7);
    const int vchunk = (tid & 7) ^ (((tid >> 4) & 1) << 2);
    char* ldst = lds + lrow * 128 + (tid & 7) * 16;
    auto issue = [&](int kt, int s) {
        const half_t* src = Pb + (size_t)(kt * 64 + lrow) * NP;
        char* d = ldst + s * 16384;
        glds16(src + KOFF + kchunk * 8, d);
        glds16(src + (size_t)32 * NP + KOFF + kchunk * 8, d + 4096);
        glds16(src + VOFF + vchunk * 8, d + 8192);
        glds16(src + (size_t)32 * NP + VOFF + vchunk * 8, d + 8192 + 4096);
    };
    const int rsw = (lane >> 1) & 7;
    const int kro = ql * 128;
    const int li = lane & 15, qp = li >> 2, pp = li & 3, swv = (qp >> 1) & 1;
    const int vb0 = 8192 + (4 * hh + qp) * 128 + 32 * ((lane >> 4) & 1) + 8 * pp + 64 * (0 ^ swv);
    const int vb1 = 8192 + (4 * hh + qp) * 128 + 32 * ((lane >> 4) & 1) + 8 * pp + 64 * (1 ^ swv);
    int kt = -1; kt = nexttile(kt);
    int s = 0;
    if (kt < ntile) issue(kt, 0);
    while (kt < ntile) {
        const int ktn = nexttile(kt);
        asm volatile("s_waitcnt vmcnt(0)" ::: "memory");
        __syncthreads();
        if (ktn < ntile) issue(ktn, s ^ 1);
        const bool wave_active = (kt * 64 <= q0 + wave * 32 + 31);
        if (wave_active) {
            const char* base = lds + s * 16384;
            uint2 mw = make_uint2(0u, 0u);
            if (MODE == 0) mw = *(const uint2*)(p->dmask + (size_t)(tokbase + tq) * 64 + 2 * kt);
            f16v s0, s1;
#pragma unroll
            for (int r = 0; r < 16; ++r) { s0[r] = 0.f; s1[r] = 0.f; }
#pragma unroll
            for (int ks = 0; ks < 4; ++ks) {
                const int co = ((2 * ks + hh) ^ rsw) << 4;
                const h8 k0 = *(const h8*)(base + kro + co), k1 = *(const h8*)(base + kro + 4096 + co);
                s0 = __builtin_amdgcn_mfma_f32_32x32x16_f16(k0, qf[ks], s0, 0, 0, 0);
                s1 = __builtin_amdgcn_mfma_f32_32x32x16_f16(k1, qf[ks], s1, 0, 0, 0);
            }
            if (MODE == 0) {
                const unsigned w0 = mw.x >> (4 * hh), w1 = mw.y >> (4 * hh);
#pragma unroll
                for (int r = 0; r < 16; ++r) {
                    const int pos = (r & 3) + 8 * (r >> 2);
                    s0[r] = ((w0 >> pos) & 1u) ? s0[r] : -INFINITY;
                    s1[r] = ((w1 >> pos) & 1u) ? s1[r] : -INFINITY;
                }
            } else {
                if (kt < 4 * own) {
                    const bool v = (mysel >> (kt >> 2)) & 1u;
                    if (!v) {
#pragma unroll
                        for (int r = 0; r < 16; ++r) { s0[r] = -INFINITY; s1[r] = -INFINITY; }
                    }
                } else if (kt * 64 + 63 > q0 + wave * 32) {
#pragma unroll
                    for (int r = 0; r < 16; ++r) {
                        const int key = kt * 64 + (r & 3) + 8 * (r >> 2) + 4 * hh;
                        s0[r] = (key <= tq) ? s0[r] : -INFINITY;
                        s1[r] = (key + 32 <= tq) ? s1[r] : -INFINITY;
                    }
                }
            }
            float mx = s0[0];
#pragma unroll
            for (int r = 1; r < 16; ++r) mx = fmaxf(mx, s0[r]);
#pragma unroll
            for (int r = 0; r < 16; ++r) mx = fmaxf(mx, s1[r]);
            mx = fmaxf(mx, __shfl_xor(mx, 32));
            const float mnew = fmaxf(m_run, mx);
            const float alpha = __builtin_amdgcn_exp2f((m_run - mnew) * CS);
            const float mc = mnew * CS;
            m_run = mnew;
            float ls = 0.f;
#pragma unroll
            for (int r = 0; r < 16; ++r) { s0[r] = __builtin_amdgcn_exp2f(fmaf(s0[r], CS, -mc)); ls += s0[r]; }
#pragma unroll
            for (int r = 0; r < 16; ++r) { s1[r] = __builtin_amdgcn_exp2f(fmaf(s1[r], CS, -mc)); ls += s1[r]; }
            l_run = l_run * alpha + ls;
#pragma unroll
            for (int r = 0; r < 16; ++r) { O0[r] *= alpha; O1[r] *= alpha; }
#pragma unroll
            for (int ksub = 0; ksub < 2; ++ksub) {
#pragma unroll
                for (int sp = 0; sp < 2; ++sp) {
                    h8 pf;
#pragma unroll
                    for (int j = 0; j < 8; ++j) pf[j] = (half_t)(ksub ? s1[8 * sp + j] : s0[8 * sp + j]);
                    const int roff = (32 * ksub + 16 * sp) * 128;
                    {
                        const s4v lo = __builtin_amdgcn_ds_read_tr16_b64_v4i16((LAS s4v*)(base + vb0 + roff));
                        const s4v hi = __builtin_amdgcn_ds_read_tr16_b64_v4i16((LAS s4v*)(base + vb0 + roff + 8 * 128));
                        const h8 vf = __builtin_bit_cast(h8, __builtin_shufflevector(lo, hi, 0, 1, 2, 3, 4, 5, 6, 7));
                        O0 = __builtin_amdgcn_mfma_f32_32x32x16_f16(vf, pf, O0, 0, 0, 0);
                    }
                    {
                        const s4v lo = __builtin_amdgcn_ds_read_tr16_b64_v4i16((LAS s4v*)(base + vb1 + roff));
                        const s4v hi = __builtin_amdgcn_ds_read_tr16_b64_v4i16((LAS s4v*)(base + vb1 + roff + 8 * 128));
                        const h8 vf = __builtin_bit_cast(h8, __builtin_shufflevector(lo, hi, 0, 1, 2, 3, 4, 5, 6, 7));
                        O1 = __builtin_amdgcn_mfma_f32_32x32x16_f16(vf, pf, O1, 0, 0, 0);
                    }
                }
            }
        }
        kt = ktn; s ^= 1;
    }
    const float lt = l_run + __shfl_xor(l_run, 32);
    const float inv = 1.0f / lt;
    half_t* dst = p->ycat + (size_t)(tokbase + tq) * DM + (MODE ? 640 : 256) + h * 64 + 4 * hh;
#pragma unroll
    for (int g = 0; g < 4; ++g) {
        *(h4*)(dst + 8 * g) = pack4(O0[4 * g] * inv, O0[4 * g + 1] * inv, O0[4 * g + 2] * inv, O0[4 * g + 3] * inv);
        *(h4*)(dst + 32 + 8 * g) = pack4(O1[4 * g] * inv, O1[4 * g + 1] * inv, O1[4 * g + 2] * inv, O1[4 * g + 3] * inv);
    }
}

__device__ __forceinline__ void phase_attn(KP p, char* lds) {
    for (int u = BID(); u < 3072; u += gridDim.x) {
        const int qt = 15 - (u / 192), rem = u % 192;
        const int type = rem & 1, bh = rem >> 1;
        if (type == 0) attn_unit<0>(p, lds, bh / 6, bh % 6, qt);
        else attn_unit<1>(p, lds, bh / 6, bh % 6, qt);
    }
}

__global__ void __launch_bounds__(256, 2) mk_fwd(Params p_unused) {
    extern __shared__ __attribute__((aligned(16))) char lds[];
    volatile LAS unsigned* stw = (volatile LAS unsigned*)(lds + 65536);
    if (threadIdx.x < 4) stw[threadIdx.x] = 0u;
    __syncthreads();
    KP p0 = (KP)__builtin_amdgcn_kernarg_segment_ptr();
    XcdBarrier bar; bar.bar = p0->bar; bar.x = 0; bar.st = stw;
#if !MK_SPLIT
    bar = xcd_barrier_post(p0->bar, stw);
#endif
    const int ph_lo = p0->ph_lo, ph_hi = p0->ph_hi;
    for (int ph = ph_lo; ph < ph_hi; ++ph) {
      KP p = p0; asm volatile("" : "+s"(p));
      const int nrep = (DUP_SUB >= 0 && ((DUP_SUB == 100 && ph == 0) || (ph >= 2 && ph < NPHASE - 1 && ((ph - 2) & 7) == DUP_SUB && (DUP_SUB != 4 || ph < 10)))) ? 2 : 1;
      for (int rep = 0; rep < nrep; ++rep) {
        if (ph == 0) phase_prologue(p, lds);
        else if (ph == 1) phase_modsum(p);
        else if (ph == NPHASE - 1) phase_norm<2>(p, lds, p->out, p->g_final, nullptr, nullptr, 0);
        else {
            const int l = (ph - 2) >> 3, sub = (ph - 2) & 7;
            const float* mf = p->modf + (size_t)l * 16 * 6144;
            const float* xin = l == 0 ? p->x : p->out;
            if (sub == 0) phase_norm<0>(p, lds, xin, p->g_mix + l * DM, mf, mf + 1024, l);
            else if (sub == 1) phase_inproj(p, lds, l);
            else if (sub == 2) phase_post(p, lds, l, rep ? POST_MASK : 7);
            else if (sub == 3) phase_attn(p, lds);
            else if (sub == 4) phase_outproj(p, lds, l, xin);
            else if (sub == 5) phase_norm<1>(p, lds, p->out, p->g_ffn + l * DM, mf + 3 * 1024, mf + 4 * 1024, l);
            else if (sub == 6) phase_moe_up(p, lds, l);
            else phase_moe_down(p, lds, l);
        }
      }
#if !MK_SPLIT
        if (ph + 1 < ph_hi) xcd_barrier(bar);
#endif
    }
}

extern "C" void kernel_launch(void* const* d_in, const int* in_sizes, int n_in, void* d_out, int out_size, void* d_ws, size_t ws_size, hipStream_t stream) {
    static int grid = 0;
    if (grid == 0) {
        int dev = 0, cus = 0, per_cu = 0;
        (void)hipGetDevice(&dev);
        (void)hipDeviceGetAttribute(&cus, hipDeviceAttributeMultiprocessorCount, dev);
        (void)hipFuncSetAttribute((const void*)mk_fwd, hipFuncAttributeMaxDynamicSharedMemorySize, LDS_BYTES);
        if (hipOccupancyMaxActiveBlocksPerMultiprocessor(&per_cu, (const void*)mk_fwd, 256, LDS_BYTES) != hipSuccess || per_cu < 1) per_cu = 1;
        (void)hipGetLastError();
        if (per_cu > 2) per_cu = 2;
        grid = cus * per_cu;
        fprintf(stderr, "mk_fwd: cus %d per_cu %d grid %d\n", cus, per_cu, grid);
    }
    Params p{};
    const float** pin = (const float**)&p.x;
    for (int i = 0; i < 18; ++i) pin[i] = (const float*)d_in[i];
    p.out = (float*)d_out;
    char* ws = (char*)d_ws;
    size_t off = 0;
    auto carve = [&](size_t bytes) { void* q = ws + off; off += (bytes + 255) & ~(size_t)255; return q; };
    p.bar = (unsigned*)carve(XCD_BAR_WORDS * 4);
    p.cnt = (int*)carve(64 * 4);
    const size_t zero_bytes = off;
    p.Wt_in = (half_t*)carve((size_t)2 * NP * DM * 2);
    p.Wt_o = (half_t*)carve((size_t)2 * DM * DM * 2);
    p.Wt_gu = (half_t*)carve((size_t)2 * 16 * 512 * 1024 * 2);
    p.Wt_d = (half_t*)carve((size_t)2 * 16 * 1024 * 256 * 2);
    p.hn = (half_t*)carve((size_t)T_TOK * DM * 2);
    p.P = (half_t*)carve((size_t)T_TOK * NP * 2);
    p.ycat = (half_t*)carve((size_t)T_TOK * DM * 2);
    p.act = (half_t*)carve((size_t)T_TOK * 512 * 2);
    p.modpart = (float*)carve((size_t)8 * 2 * 16 * 6144 * 4);
    p.modf = (float*)carve((size_t)2 * 16 * 6144 * 4);
    p.kmean = (float*)carve((size_t)16 * 6 * 8 * 64 * 4);
    p.rope = (float*)carve((size_t)2048 * 24 * 4);
    p.iwf = (float*)carve((size_t)T_TOK * 4 * 4);
    p.tokw = (float*)carve((size_t)T_TOK * 2 * 4);
    p.dmask = (unsigned*)carve((size_t)T_TOK * 64 * 4);
    p.lists = (int*)carve((size_t)NCLS * T_TOK * 4);
    if (off > ws_size) { fprintf(stderr, "workspace too small: need %zu have %zu\n", off, ws_size); return; }
    (void)hipMemsetAsync(d_ws, 0, zero_bytes, stream);
#if MK_SPLIT
    for (int ph = 0; ph < NPHASE; ++ph) {
        p.ph_lo = ph; p.ph_hi = ph + 1;
        hipLaunchKernelGGL(mk_fwd, dim3(grid), dim3(256), LDS_BYTES, stream, p);
    }
#else
    p.ph_lo = 0; p.ph_hi = NPHASE;
    hipLaunchKernelGGL(mk_fwd, dim3(grid), dim3(256), LDS_BYTES, stream, p);
#endif
}
```

```cpp
#include <hip/hip_runtime.h>
#include <cstdio>
#include <cstdint>

#ifndef MK_SPLIT
#define MK_SPLIT 0
#endif

#define T_TOK 32768
#define DM 1024
#define SEQ 2048
#define INW 2340
#define NP 2432
#define PC_CU 0
#define PC_CG 256
#define PC_DQ 512
#define PC_DK 896
#define PC_DV 960
#define PC_IQ 1024
#define PC_IK 1152
#define PC_IW 1184
#define PC_MQ 1280
#define PC_MK 1664
#define PC_MV 2048
#define LOG_THETA 13.122363377404328f
#define NCLS 24
#define LDS_BYTES 66048
#define NPHASE 19
#ifndef DUP_SUB
#define DUP_SUB -1
#endif

typedef _Float16 half_t;
typedef _Float16 h8 __attribute__((ext_vector_type(8)));
typedef _Float16 h4 __attribute__((ext_vector_type(4)));
typedef short s4v __attribute__((ext_vector_type(4)));
typedef short s8v __attribute__((ext_vector_type(8)));
typedef float f16v __attribute__((ext_vector_type(16)));
typedef float f4v __attribute__((ext_vector_type(4)));
#define LAS __attribute__((address_space(3)))

struct Params {
    const float *x, *c, *w_ada, *b_ada, *g_mix, *w_in, *w_dw, *b_dw, *ln_g, *ln_b, *w_o, *g_ffn, *w_router, *b_router, *w_gate, *w_up, *w_down, *g_final;
    float* out;
    half_t *Wt_in, *Wt_o, *Wt_gu, *Wt_d, *hn, *P, *ycat, *act;
    float *modpart, *modf, *kmean, *rope, *iwf, *tokw;
    unsigned* dmask; int* cnt; int* lists; unsigned* bar;
    int ph_lo, ph_hi;
};

#define XB_TMO      128
#define XB_XCNT(j)  (256  + 64 * (j))
#define XB_XSUB(j)  (1280 + 64 * (j))
#define XB_XGEN(j)  (2304 + 64 * (j))
#define XB_TOP      3328
#define XB_TOPGEN   3392
#define XCD_BAR_WORDS 3456
#define XB_SPIN_CAP (1u << 20)
__device__ __forceinline__ unsigned xb_ld(unsigned* p)              { return __hip_atomic_load(p, __ATOMIC_RELAXED, __HIP_MEMORY_SCOPE_AGENT); }
__device__ __forceinline__ unsigned xb_add(unsigned* p, unsigned v) { return __hip_atomic_fetch_add(p, v, __ATOMIC_RELAXED, __HIP_MEMORY_SCOPE_AGENT); }
__device__ __forceinline__ unsigned xb_xcc_id() { return (unsigned)__builtin_amdgcn_s_getreg((3 << 11) | 20) & 0xFu; }
#define XB_SPIN(cond, bar) do { unsigned _sp = 0; while (cond) { __builtin_amdgcn_s_sleep(1); \
    if ((++_sp & 255u) == 0u) { if (xb_ld(&(bar)[XB_TMO])) break; if (_sp > XB_SPIN_CAP) { atomicAdd(&(bar)[XB_TMO], 1u); break; } } } } while (0)
struct XcdBarrier { unsigned* bar; unsigned x; volatile LAS unsigned* st; };
__device__ __forceinline__ XcdBarrier xcd_barrier_post(unsigned* bar, volatile LAS unsigned* st) {
    XcdBarrier b; b.bar = bar; b.x = xb_xcc_id(); b.st = st;
    if (threadIdx.x == 0) (void)xb_add(&bar[XB_XCNT(b.x)], 1u);
    return b;
}
__device__ __forceinline__ void xcd_barrier_complete(unsigned* bar, unsigned x, unsigned& nloc, unsigned& nx) {
    const unsigned G = gridDim.x * gridDim.y * gridDim.z;
    unsigned sum, cnt, mine, sp = 0u;
    for (;;) {
        sum = 0u; cnt = 0u; mine = 0u;
#pragma unroll
        for (unsigned j = 0; j < 16; ++j) { const unsigned c = xb_ld(&bar[XB_XCNT(j)]); sum += c; cnt += (c > 0u) ? 1u : 0u; mine = (j == x) ? c : mine; }
        if (sum == G) break;
        __builtin_amdgcn_s_sleep(1);
        if ((++sp & 255u) == 0u) { if (xb_ld(&bar[XB_TMO])) break; if (sp > XB_SPIN_CAP) { atomicAdd(&bar[XB_TMO], 1u); break; } }
    }
    nloc = mine > 0u ? mine : 1u; nx = cnt > 0u ? cnt : 1u;
}
__device__ __forceinline__ void xcd_barrier(const XcdBarrier& b) {
    asm volatile("s_waitcnt vmcnt(0)" ::: "memory");
    __syncthreads();
    if (threadIdx.x == 0) {
        unsigned* bar = b.bar;
        __builtin_amdgcn_s_waitcnt(0);
        unsigned nloc = b.st[0], nx = b.st[1];
        if (nloc == 0u) { xcd_barrier_complete(bar, b.x, nloc, nx); b.st[0] = nloc; b.st[1] = nx; }
        const unsigned old = xb_add(&bar[XB_XSUB(b.x)], 1u);
        const unsigned gen = old / nloc;
        if (old + 1u == (gen + 1u) * nloc) {
            __builtin_amdgcn_fence(__ATOMIC_RELEASE, "agent");
            asm volatile("s_waitcnt vmcnt(0)" ::: "memory");
            const unsigned og = xb_add(&bar[XB_TOP], 1u);
            const unsigned tg = og / nx;
            if (og + 1u == (tg + 1u) * nx) xb_add(&bar[XB_TOPGEN], 1u);
            else XB_SPIN(xb_ld(&bar[XB_TOPGEN]) == tg, bar);
            __builtin_amdgcn_fence(__ATOMIC_ACQUIRE, "agent");
            xb_add(&bar[XB_XGEN(b.x)], 1u);
            asm volatile("s_waitcnt vmcnt(0)" ::: "memory");
        } else {
            XB_SPIN(xb_ld(&bar[XB_XGEN(b.x)]) == gen, bar);
            __builtin_amdgcn_fence(__ATOMIC_ACQUIRE, "agent");
            asm volatile("s_waitcnt vmcnt(0)" ::: "memory");
        }
    }
    __syncthreads();
}

typedef const __attribute__((address_space(4))) Params* KP;
__device__ __forceinline__ int TID() { int t = threadIdx.x; asm volatile("" : "+v"(t)); return t; }
__device__ __forceinline__ int BID() { int b = blockIdx.x; asm volatile("" : "+s"(b)); return b; }
__device__ __forceinline__ float sigmoidf_(float v) { return 1.0f / (1.0f + __expf(-v)); }
__device__ __forceinline__ void glds16(const void* g, char* l) { __builtin_amdgcn_global_load_lds((const unsigned*)g, (unsigned*)l, 16, 0, 0); }
__device__ __forceinline__ unsigned f2sortable(float f) { unsigned u = __float_as_uint(f); return (u & 0x80000000u) ? ~u : (u | 0x80000000u); }
__device__ __forceinline__ h4 pack4(float a, float b, float c, float d) { h4 r = {(half_t)a, (half_t)b, (half_t)c, (half_t)d}; return r; }

template <class CF>
__device__ __forceinline__ void conv_tile(char* lds, CF colf, int src_ld, int k0, half_t* dst_tile  , int dstK) {
    float* tl = (float*)lds;
    const int tid = TID();
    __syncthreads();
    {
        const int nn = tid & 63;
        const float* cp = colf(nn);
#pragma unroll 4
        for (int i = 0; i < 16; ++i) { const int k = i * 4 + (tid >> 6); tl[k * 65 + nn] = cp ? cp[(size_t)(k0 + k) * src_ld] : 0.f; }
    }
    __syncthreads();
    {
        const int n = tid >> 2, kq = (tid & 3) * 16;
        h8 a, b;
#pragma unroll
        for (int j = 0; j < 8; ++j) { a[j] = (half_t)tl[(kq + j) * 65 + n]; b[j] = (half_t)tl[(kq + 8 + j) * 65 + n]; }
        h8* d = (h8*)(dst_tile + (size_t)n * dstK + kq);
        d[0] = a; d[1] = b;
    }
}

__device__ __forceinline__ void phase_prologue(KP p, char* lds) {
    const int tid = TID();
    const int NA = 2 * 16 * 38, NB = 2 * 16 * 16, NC = 2 * 16 * 16 * 8, ND = 2 * 16 * 4 * 16, NE = 384, NF = 8;
    const int total = NA + NB + NC + ND + NE + NF;
    for (int u0 = BID(); u0 < total; u0 += gridDim.x) {
        int u = u0;
        if (u < NA) {
            const int nt = u % 38, kt = (u / 38) % 16, l = u / (38 * 16);
            const float* src = p->w_in + (size_t)l * DM * INW;
            const int n0 = nt * 64;
            conv_tile(lds, [&](int nn) -> const float* { const int np = n0 + nn; const int sc = np < 1188 ? np : (np < 1280 ? -1 : np - 92); return sc >= 0 ? src + sc : (const float*)nullptr; },
                      INW, kt * 64, p->Wt_in + ((size_t)l * NP + n0) * DM + kt * 64, DM);
            continue;
        }
        u -= NA;
        if (u < NB) {
            const int nt = u % 16, kt = (u / 16) % 16, l = u / 256;
            const float* src = p->w_o + (size_t)l * DM * DM + nt * 64;
            conv_tile(lds, [&](int nn) -> const float* { return src + nn; }, DM, kt * 64, p->Wt_o + ((size_t)l * DM + nt * 64) * DM + kt * 64, DM);
            continue;
        }
        u -= NB;
        if (u < NC) {
            const int nt = u % 8, kt = (u / 8) % 16, le = u / 128;
            const float* sg = p->w_gate + (size_t)le * 1024 * 256 + nt * 32;
            const float* su = p->w_up + (size_t)le * 1024 * 256 + nt * 32;
            conv_tile(lds, [&](int nn) -> const float* { return nn < 32 ? sg + nn : su + (nn - 32); }, 256, kt * 64, p->Wt_gu + ((size_t)le * 512 + nt * 64) * 1024 + kt * 64, 1024);
            continue;
        }
        u -= NC;
        if (u < ND) {
            const int nt = u % 16, kt = (u / 16) % 4, le = u / 64;
            const float* src = p->w_down + (size_t)le * 256 * 1024 + nt * 64;
            conv_tile(lds, [&](int nn) -> const float* { return src + nn; }, 1024, kt * 64, p->Wt_d + ((size_t)le * 1024 + nt * 64) * 256 + kt * 64, 256);
            continue;
        }
        u -= ND;
        if (u < NE) {
            const int kc = u % 8, cc = (u / 8) % 24, l = u / 192;
            float* ca = (float*)lds;
            __syncthreads();
            for (int i = tid; i < 2048; i += 256) { const int b = i >> 7, k = i & 127; const float v = p->c[b * 1024 + kc * 128 + k]; ca[i] = v / (1.0f + expf(-v)); }
            __syncthreads();
            const int n = cc * 256 + tid;
            float acc[16];
#pragma unroll
            for (int b = 0; b < 16; ++b) acc[b] = 0.f;
            const float* w = p->w_ada + ((size_t)l * 1024 + kc * 128) * 6144 + n;
#pragma unroll 4
            for (int k = 0; k < 128; ++k) {
                const float wv = w[(size_t)k * 6144];
#pragma unroll
                for (int b = 0; b < 16; ++b) acc[b] = fmaf(ca[b * 128 + k], wv, acc[b]);
            }
#pragma unroll
            for (int b = 0; b < 16; ++b) p->modpart[(((size_t)kc * 2 + l) * 16 + b) * 6144 + n] = acc[b];
            continue;
        }
        u -= NE;
        {
            for (int i = u * 256 + tid; i < 2048 * 12; i += NF * 256) {
                const int t = i / 12, r = i % 12;
                const int fi = r < 8 ? r : r - 8;
                const float rot = r < 8 ? 16.f : 8.f;
                const float inv = expf(-LOG_THETA * ((float)fi * 2.0f / rot));
                const float ang = (float)t * inv;
                float sn, cs; sincosf(ang, &sn, &cs);
                if (r < 8) { p->rope[t * 8 + fi] = cs; p->rope[16384 + t * 8 + fi] = sn; }
                else { p->rope[32768 + t * 4 + fi] = cs; p->rope[32768 + 8192 + t * 4 + fi] = sn; }
            }
        }
    }
}

__device__ __forceinline__ void phase_modsum(KP p) {
    for (int i = BID() * 256 + TID(); i < 2 * 16 * 6144; i += gridDim.x * 256) {
        const int n = i % 6144, l = i / (16 * 6144);
        float s = p->b_ada[l * 6144 + n];
#pragma unroll
        for (int kc = 0; kc < 8; ++kc) s += p->modpart[(size_t)kc * (2 * 16 * 6144) + i];
        p->modf[i] = s;
    }
}

template <int MODE>
__device__ __forceinline__ void phase_norm(KP p, char* lds, const float* xin, const float* g, const float* sh, const float* sc, int layer) {
    const int lane = TID() & 63, wave = TID() >> 6;
    float* wt = (float*)lds;
    if (MODE == 1) {
        __syncthreads();
        for (int i = TID(); i < 4096; i += 256) {
            const float4 w4 = ((const float4*)p->w_router)[i];
            const int k = i >> 2, e0 = (i & 3) * 4;
            wt[(e0 + 0) * 1024 + k] = w4.x; wt[(e0 + 1) * 1024 + k] = w4.y; wt[(e0 + 2) * 1024 + k] = w4.z; wt[(e0 + 3) * 1024 + k] = w4.w;
        }
        __syncthreads();
    }
    int mycls = -1, myrow = 0, it = 0;
    for (int row = BID() * 4 + wave; row < T_TOK; row += gridDim.x * 4) {
        const int b = row >> 11;
        const float4* xr = (const float4*)(xin + (size_t)row * DM);
        float4 v[4]; float ss = 0.f;
#pragma unroll
        for (int i = 0; i < 4; ++i) { v[i] = xr[lane + 64 * i]; ss += v[i].x * v[i].x + v[i].y * v[i].y + v[i].z * v[i].z + v[i].w * v[i].w; }
#pragma unroll
        for (int o = 32; o >= 1; o >>= 1) ss += __shfl_xor(ss, o);
        const float rstd = 1.0f / sqrtf(ss * (1.0f / 1024.0f) + 1e-6f);
        float acc[16];
        if (MODE == 1) {
#pragma unroll
            for (int e = 0; e < 16; ++e) acc[e] = 0.f;
        }
#pragma unroll
        for (int i = 0; i < 4; ++i) {
            const int k = (lane + 64 * i) * 4;
            const float4 gg = *(const float4*)(g + k);
            float y[4] = {v[i].x * rstd * gg.x, v[i].y * rstd * gg.y, v[i].z * rstd * gg.z, v[i].w * rstd * gg.w};
            if (MODE != 2) {
                const float4 s1 = *(const float4*)(sh + (size_t)b * 6144 + k), s2 = *(const float4*)(sc + (size_t)b * 6144 + k);
                y[0] = y[0] * (1.f + s2.x) + s1.x; y[1] = y[1] * (1.f + s2.y) + s1.y; y[2] = y[2] * (1.f + s2.z) + s1.z; y[3] = y[3] * (1.f + s2.w) + s1.w;
                *(h4*)(p->hn + (size_t)row * DM + k) = pack4(y[0], y[1], y[2], y[3]);
            } else {
                *(float4*)(p->out + (size_t)row * DM + k) = make_float4(y[0], y[1], y[2], y[3]);
            }
            if (MODE == 1) {
#pragma unroll
                for (int e = 0; e < 16; ++e) {
                    const float4 w4 = *(const float4*)(wt + e * 1024 + k);
                    acc[e] = fmaf(y[0], w4.x, fmaf(y[1], w4.y, fmaf(y[2], w4.z, fmaf(y[3], w4.w, acc[e]))));
                    if ((e & 3) == 3) __builtin_amdgcn_sched_barrier(0);
                }
            }
        }
        if (MODE == 1) {
            const bool b5 = lane & 32, b4 = lane & 16, b3 = lane & 8, b2 = lane & 4;
            float r8[8], r4[4], r2[2];
#pragma unroll
            for (int e = 0; e < 8; ++e) { const float snd = b5 ? acc[e] : acc[e + 8], kp = b5 ? acc[e + 8] : acc[e]; r8[e] = kp + __shfl_xor(snd, 32); }
#pragma unroll
            for (int e = 0; e < 4; ++e) { const float snd = b4 ? r8[e] : r8[e + 4], kp = b4 ? r8[e + 4] : r8[e]; r4[e] = kp + __shfl_xor(snd, 16); }
#pragma unroll
            for (int e = 0; e < 2; ++e) { const float snd = b3 ? r4[e] : r4[e + 2], kp = b3 ? r4[e + 2] : r4[e]; r2[e] = kp + __shfl_xor(snd, 8); }
            float rv; { const float snd = b2 ? r2[0] : r2[1], kp = b2 ? r2[1] : r2[0]; rv = kp + __shfl_xor(snd, 4); }
            rv += __shfl_xor(rv, 2); rv += __shfl_xor(rv, 1);
#pragma unroll
            for (int e = 0; e < 16; ++e) acc[e] = __builtin_bit_cast(float, __builtin_amdgcn_readlane(__builtin_bit_cast(int, rv), 4 * e));
            {
                float aff[16], bia[16];
#pragma unroll
                for (int e = 0; e < 16; ++e) { aff[e] = 1.0f / (1.0f + expf(-acc[e])); bia[e] = aff[e] + p->b_router[e]; }
                int bestg = 0; float bests = -INFINITY;
#pragma unroll
                for (int gi = 0; gi < 4; ++gi) {
                    float m1 = -INFINITY, m2 = -INFINITY;
#pragma unroll
                    for (int j = 0; j < 4; ++j) { const float vv = bia[gi * 4 + j]; if (vv > m1) { m2 = m1; m1 = vv; } else if (vv > m2) m2 = vv; }
                    const float s = m1 + m2;
                    if (s > bests) { bests = s; bestg = gi; }
                }
                float bsel[4], asel[4];
#pragma unroll
                for (int j = 0; j < 4; ++j) { bsel[j] = 0.f; asel[j] = 0.f; }
#pragma unroll
                for (int gi = 0; gi < 4; ++gi) if (gi == bestg) {
#pragma unroll
                    for (int j = 0; j < 4; ++j) { bsel[j] = bia[gi * 4 + j]; asel[j] = aff[gi * 4 + j]; }
                }
                int i1 = -1, i2 = -1; float v1 = -INFINITY, v2 = -INFINITY;
#pragma unroll
                for (int j = 0; j < 4; ++j) { const float vv = bsel[j]; if (vv > v1) { v2 = v1; i2 = i1; v1 = vv; i1 = j; } else if (vv > v2) { v2 = vv; i2 = j; } }
                const int a = i1 < i2 ? i1 : i2, bb = i1 < i2 ? i2 : i1;
                float wa = 0.f, wb = 0.f;
#pragma unroll
                for (int j = 0; j < 4; ++j) { if (j == a) wa = asel[j]; if (j == bb) wb = asel[j]; }
                const float sw = wa + wb;
                const int pi = (a == 0) ? (bb - 1) : (a == 1 ? (bb + 1) : 5);
                const int cls = bestg * 6 + pi;
                if (lane == 0) *(float2*)(p->tokw + (size_t)row * 2) = make_float2(wa / sw, wb / sw);
                if (lane == (it & 63)) { mycls = cls; myrow = row; }
                ++it;
                if ((it & 63) == 0) {
                    const int pos = atomicAdd(&p->cnt[layer * 32 + mycls], 1);
                    p->lists[(size_t)mycls * T_TOK + pos] = myrow;
                    mycls = -1;
                }
            }
        }
    }
    if (MODE == 1 && mycls >= 0) {
        const int pos = atomicAdd(&p->cnt[layer * 32 + mycls], 1);
        p->lists[(size_t)mycls * T_TOK + pos] = myrow;
    }
}

template <class WF, class XF, class EPI>
__device__ __forceinline__ void gemm_tile(char* lds, int nkt, WF wf, XF xf, EPI epi) {
    const int tid = TID(), lane = tid & 63, wave = tid >> 6;
    const int wn = wave & 1, wm = wave >> 1, hh = lane >> 5;
    const int lrow = tid >> 3;
    const int lchunk = (tid & 7) ^ ((tid >> 4) & 7);
    const half_t* xs[4];
#pragma unroll
    for (int i = 0; i < 4; ++i) xs[i] = xf(lrow + 32 * i) + lchunk * 8;
    char* ldst = lds + lrow * 128 + (tid & 7) * 16;
    f16v acc[2][2];
#pragma unroll
    for (int i = 0; i < 2; ++i)
#pragma unroll
        for (int j = 0; j < 2; ++j)
#pragma unroll
            for (int r = 0; r < 16; ++r) acc[i][j][r] = 0.f;
    auto issue = [&](int kt, int s) {
        char* d = ldst + s * 32768;
#pragma unroll
        for (int i = 0; i < 4; ++i) glds16(wf(kt, lrow + 32 * i) + lchunk * 8, d + i * 4096);
#pragma unroll
        for (int i = 0; i < 4; ++i) glds16(xs[i] + kt * 64, d + 16384 + i * 4096);
    };
    __syncthreads();
    issue(0, 0);
    const int rsw = (lane >> 1) & 7;
    const int roff_w = (wn * 64 + (lane & 31)) * 128, roff_x = 16384 + (wm * 64 + (lane & 31)) * 128;
    for (int kt = 0; kt < nkt; ++kt) {
        asm volatile("s_waitcnt vmcnt(0)" ::: "memory");
        __syncthreads();
        if (kt + 1 < nkt) issue(kt + 1, (kt + 1) & 1);
        const char* base = lds + (kt & 1) * 32768;
#pragma unroll
        for (int ks = 0; ks < 4; ++ks) {
            const int co = ((2 * ks + hh) ^ rsw) << 4;
            const h8 a0 = *(const h8*)(base + roff_w + co), a1 = *(const h8*)(base + roff_w + 4096 + co);
            const h8 b0 = *(const h8*)(base + roff_x + co), b1 = *(const h8*)(base + roff_x + 4096 + co);
            acc[0][0] = __builtin_amdgcn_mfma_f32_32x32x16_f16(a0, b0, acc[0][0], 0, 0, 0);
            acc[0][1] = __builtin_amdgcn_mfma_f32_32x32x16_f16(a0, b1, acc[0][1], 0, 0, 0);
            acc[1][0] = __builtin_amdgcn_mfma_f32_32x32x16_f16(a1, b0, acc[1][0], 0, 0, 0);
            acc[1][1] = __builtin_amdgcn_mfma_f32_32x32x16_f16(a1, b1, acc[1][1], 0, 0, 0);
        }
    }
    epi(acc, wn, wm, lane);
}

__device__ __forceinline__ void phase_inproj(KP p, char* lds, int l) {
    const half_t* W = p->Wt_in + (size_t)l * NP * DM;
    const float* rc16 = p->rope; const float* rs16 = p->rope + 16384; const float* rc8 = p->rope + 32768; const float* rs8 = p->rope + 32768 + 8192;
    for (int u = BID(); u < 256 * 19; u += gridDim.x) {
        const int xl = u & 7, Lx = u >> 3, mi = Lx & 7, rr_ = Lx >> 3;
        const int nt = rr_ % 19, mt = 32 * xl + 8 * (rr_ / 19) + mi;
        gemm_tile(lds, 16,
            [&](int kt, int row) { return W + (size_t)(nt * 128 + row) * DM + kt * 64; },
            [&](int row) { return p->hn + (size_t)(mt * 128 + row) * DM; },
            [&](f16v (&acc)[2][2], int wn, int wm, int lane) {
                const int hh = lane >> 5;
#pragma unroll
                for (int i = 0; i < 2; ++i) {
                    const int nb = nt * 128 + wn * 64 + i * 32;
                    if (nb == 1216 || nb == 1248) continue;
                    const bool rope64 = ((nb >= PC_DQ && nb < PC_DV) || (nb >= PC_MQ && nb < PC_MV)) && ((nb & 63) == 0);
                    const bool rope32 = (nb >= PC_IQ && nb < PC_IW);
#pragma unroll
                    for (int j = 0; j < 2; ++j) {
                        const int tok = mt * 128 + wm * 64 + j * 32 + (lane & 31);
                        const int t = tok & 2047;
                        f16v v = acc[i][j];
                        if (nb == PC_IW) { if (hh == 0) *(float4*)(p->iwf + (size_t)tok * 4) = make_float4(v[0], v[1], v[2], v[3]); continue; }
                        if (rope64) {
                            const float4 c4 = *(const float4*)(rc16 + t * 8 + 4 * hh), s4 = *(const float4*)(rs16 + t * 8 + 4 * hh);
                            const float cc[4] = {c4.x, c4.y, c4.z, c4.w}, sn[4] = {s4.x, s4.y, s4.z, s4.w};
#pragma unroll
                            for (int r = 0; r < 4; ++r) { const float x1 = v[r], x2 = v[r + 4]; v[r] = x1 * cc[r] - x2 * sn[r]; v[r + 4] = x2 * cc[r] + x1 * sn[r]; }
                        } else if (rope32) {
                            const float4 c4 = *(const float4*)(rc8 + t * 4), s4 = *(const float4*)(rs8 + t * 4);
                            const float cc[4] = {c4.x, c4.y, c4.z, c4.w}, sn[4] = {s4.x, s4.y, s4.z, s4.w};
#pragma unroll
                            for (int r = 0; r < 4; ++r) { const float o = __shfl_xor(v[r], 32); v[r] = hh ? (v[r] * cc[r] + o * sn[r]) : (v[r] * cc[r] - o * sn[r]); }
                        }
                        half_t* dst = p->P + (size_t)tok * NP + nb + 4 * hh;
#pragma unroll
                        for (int g = 0; g < 4; ++g) *(h4*)(dst + 8 * g) = pack4(v[4 * g], v[4 * g + 1], v[4 * g + 2], v[4 * g + 3]);
                    }
                }
            });
    }
}

__device__ __forceinline__ void phase_outproj(KP p, char* lds, int l, const float* xin) {
    const half_t* W = p->Wt_o + (size_t)l * DM * DM;
    const float* g1 = p->modf + (size_t)l * 16 * 6144 + 2 * 1024;
    for (int u = BID(); u < 256 * 8; u += gridDim.x) {
        const int xl = u & 7, Lx = u >> 3, mi = Lx & 7, rr_ = Lx >> 3;
        const int nt = rr_ & 7, mt = 32 * xl + 8 * (rr_ >> 3) + mi;
        gemm_tile(lds, 16,
            [&](int kt, int row) { return W + (size_t)(nt * 128 + row) * DM + kt * 64; },
            [&](int row) { return p->ycat + (size_t)(mt * 128 + row) * DM; },
            [&](f16v (&acc)[2][2], int wn, int wm, int lane) {
                const int hh = lane >> 5;
#pragma unroll
                for (int j = 0; j < 2; ++j) {
                    const int tok = mt * 128 + wm * 64 + j * 32 + (lane & 31);
                    const int b = tok >> 11;
#pragma unroll
                    for (int i = 0; i < 2; ++i) {
                        const int nb = nt * 128 + wn * 64 + i * 32 + 4 * hh;
#pragma unroll
                        for (int g = 0; g < 4; ++g) {
                            const int n = nb + 8 * g;
                            const float4 xi = *(const float4*)(xin + (size_t)tok * DM + n);
                            const float4 gg = *(const float4*)(g1 + (size_t)b * 6144 + n);
                            float4 o; o.x = xi.x + gg.x * acc[i][j][4 * g]; o.y = xi.y + gg.y * acc[i][j][4 * g + 1]; o.z = xi.z + gg.z * acc[i][j][4 * g + 2]; o.w = xi.w + gg.w * acc[i][j][4 * g + 3];
                            *(float4*)(p->out + (size_t)tok * DM + n) = o;
                        }
                    }
                }
            });
    }
}

__device__ __forceinline__ bool moe_tile(const int* cnt, int tile, int& cls, int& pos0, int& n) {
    int tb = 0;
    for (int c = 0; c < NCLS; ++c) {
        const int nc = cnt[c], nt = (nc + 127) >> 7;
        if (tile < tb + nt) { cls = c; pos0 = (tile - tb) * 128; n = nc; return true; }
        tb += nt;
    }
    return false;
}
__device__ __forceinline__ void cls_experts(int cls, int& e1, int& e2) {
    const int g = cls / 6, pi = cls % 6;
    const int a = pi < 3 ? 0 : (pi < 5 ? 1 : 2);
    const int b = pi < 3 ? pi + 1 : (pi < 5 ? pi - 1 : 3);
    e1 = g * 4 + a; e2 = g * 4 + b;
}
__device__ __forceinline__ void phase_moe_up(KP p, char* lds, int l) {
    const int* cnt = p->cnt + l * 32;
    for (int u = BID(); u < (256 + NCLS) * 8; u += gridDim.x) {
        const int nt = u % 8, tile = u / 8;
        int cls, pos0, nc;
        if (!moe_tile(cnt, tile, cls, pos0, nc)) break;
        int e1, e2; cls_experts(cls, e1, e2);
        const int slot = nt >> 2;
        const half_t* W = p->Wt_gu + ((size_t)(l * 16 + (slot ? e2 : e1)) * 512 + (nt & 3) * 128) * 1024;
        const int* lst = p->lists + (size_t)cls * T_TOK + pos0;
        const int nvalid = nc - pos0;
        gemm_tile(lds, 16,
            [&](int kt, int row) { return W + (size_t)row * 1024 + kt * 64; },
            [&](int row) { const int tok = lst[row < nvalid ? row : 0]; return p->hn + (size_t)tok * DM; },
            [&](f16v (&acc)[2][2], int wn, int wm, int lane) {
                const int hh = lane >> 5;
#pragma unroll
                for (int j = 0; j < 2; ++j) {
                    const int row = wm * 64 + j * 32 + (lane & 31);
                    if (row < nvalid) {
                        const int tok = lst[row];
                        const float wgt = p->tokw[(size_t)tok * 2 + slot];
                        half_t* dst = p->act + (size_t)tok * 512 + slot * 256 + ((nt & 3) * 2 + wn) * 32 + 4 * hh;
#pragma unroll
                        for (int g = 0; g < 4; ++g) {
                            float a[4];
#pragma unroll
                            for (int r = 0; r < 4; ++r) { const float gv = acc[0][j][4 * g + r], uv = acc[1][j][4 * g + r]; a[r] = gv * sigmoidf_(gv) * uv * wgt; }
                            *(h4*)(dst + 8 * g) = pack4(a[0], a[1], a[2], a[3]);
                        }
                    }
                }
            });
    }
}
__device__ __forceinline__ void phase_moe_down(KP p, char* lds, int l) {
    const int* cnt = p->cnt + l * 32;
    const float* g2 = p->modf + (size_t)l * 16 * 6144 + 5 * 1024;
    for (int u = BID(); u < (256 + NCLS) * 8; u += gridDim.x) {
        const int nt = u % 8, tile = u / 8;
        int cls, pos0, nc;
        if (!moe_tile(cnt, tile, cls, pos0, nc)) break;
        int e1, e2; cls_experts(cls, e1, e2);
        const half_t* W1 = p->Wt_d + ((size_t)(l * 16 + e1) * 1024 + nt * 128) * 256;
        const half_t* W2 = p->Wt_d + ((size_t)(l * 16 + e2) * 1024 + nt * 128) * 256;
        const int* lst = p->lists + (size_t)cls * T_TOK + pos0;
        const int nvalid = nc - pos0;
        gemm_tile(lds, 8,
            [&](int kt, int row) { return (kt < 4 ? W1 : W2) + (size_t)row * 256 + (kt & 3) * 64; },
            [&](int row) { const int tok = lst[row < nvalid ? row : 0]; return p->act + (size_t)tok * 512; },
            [&](f16v (&acc)[2][2], int wn, int wm, int lane) {
                const int hh = lane >> 5;
#pragma unroll
                for (int j = 0; j < 2; ++j) {
                    const int row = wm * 64 + j * 32 + (lane & 31);
                    if (row < nvalid) {
                        const int tok = lst[row];
                        const int b = tok >> 11;
#pragma unroll
                        for (int i = 0; i < 2; ++i) {
                            const int nb = nt * 128 + wn * 64 + i * 32 + 4 * hh;
#pragma unroll
                            for (int g = 0; g < 4; ++g) {
                                const int n = nb + 8 * g;
                                float4* xp = (float4*)(p->out + (size_t)tok * DM + n);
                                float4 xi = *xp;
                                const float4 gg = *(const float4*)(g2 + (size_t)b * 6144 + n);
                                xi.x += gg.x * acc[i][j][4 * g]; xi.y += gg.y * acc[i][j][4 * g + 1]; xi.z += gg.z * acc[i][j][4 * g + 2]; xi.w += gg.w * acc[i][j][4 * g + 3];
                                *xp = xi;
                            }
                        }
                    }
                }
            });
    }
}

__device__ __forceinline__ void dsa_select_unit(KP p, char* lds, int b, int qt) {
    unsigned* hist = (unsigned*)lds;
    unsigned* maskl = hist + 16 * 257 + 16;
    unsigned* stP = maskl + 1024;
    unsigned* stNeed = stP + 16;
    unsigned* stDone = stNeed + 16;
    unsigned* flag = stDone + 16;
    unsigned* dummyb = flag + 16;
    const int tid = TID(), lane = tid & 63, wave = tid >> 6;
    const int q0 = qt * 16, tokbase = b * SEQ;
    __syncthreads();
    if (q0 < 256) {
        for (int i = tid; i < 1024; i += 256) {
            const int q = i >> 6, wd = i & 63;
            const int n = q0 + q + 1 - 32 * wd;
            const unsigned w = n >= 32 ? 0xFFFFFFFFu : (n <= 0 ? 0u : ((1u << n) - 1u));
            p->dmask[(size_t)(tokbase + q0 + q) * 64 + wd] = w;
        }
        return;
    }
    for (int i = tid; i < 1024; i += 256) maskl[i] = 0u;
    if (tid < 16) { stP[tid] = 0u; stNeed[tid] = 256u; stDone[tid] = 0u; }
    const int ql = lane & 15, fq = lane >> 4;
    const int tq = q0 + ql;
    const half_t* Pb = p->P + (size_t)tokbase * NP;
    h8 iqf[4];
#pragma unroll
    for (int hd = 0; hd < 4; ++hd) iqf[hd] = *(const h8*)(Pb + (size_t)tq * NP + PC_IQ + hd * 32 + 8 * fq);
    const float4 iw4 = *(const float4*)(p->iwf + (size_t)(tokbase + tq) * 4);
    const float wsc0 = iw4.x * 0.08838834764831845f, wsc1 = iw4.y * 0.08838834764831845f, wsc2 = iw4.z * 0.08838834764831845f, wsc3 = iw4.w * 0.08838834764831845f;
    const int ng = qt + 1;
    unsigned sc[32][4];
    const half_t* ikp = Pb + (size_t)ql * NP + PC_IK + 8 * fq;
#pragma unroll
    for (int gb = 0; gb < 4; ++gb) {
        h8 ik[8];
#pragma unroll
        for (int x = 0; x < 8; ++x) {
            int g = wave + 4 * (gb * 8 + x);
            g = g < ng ? g : ng - 1;
            ik[x] = *(const h8*)(ikp + (size_t)(16 * g) * NP);
        }
#pragma unroll
        for (int x = 0; x < 8; ++x) {
            const int gi = gb * 8 + x;
            const int g = wave + 4 * gi;
            const f4v z = {0.f, 0.f, 0.f, 0.f};
            const f4v c0 = __builtin_amdgcn_mfma_f32_16x16x32_f16(ik[x], iqf[0], z, 0, 0, 0);
            const f4v c1 = __builtin_amdgcn_mfma_f32_16x16x32_f16(ik[x], iqf[1], z, 0, 0, 0);
            const f4v c2 = __builtin_amdgcn_mfma_f32_16x16x32_f16(ik[x], iqf[2], z, 0, 0, 0);
            const f4v c3 = __builtin_amdgcn_mfma_f32_16x16x32_f16(ik[x], iqf[3], z, 0, 0, 0);
#pragma unroll
            for (int r = 0; r < 4; ++r) {
                const int j = 16 * g + 4 * fq + r;
                float sv = wsc0 * __builtin_amdgcn_fmed3f(c0[r], 0.f, INFINITY);
                sv = fmaf(wsc1, __builtin_amdgcn_fmed3f(c1[r], 0.f, INFINITY), sv);
                sv = fmaf(wsc2, __builtin_amdgcn_fmed3f(c2[r], 0.f, INFINITY), sv);
                sv = fmaf(wsc3, __builtin_amdgcn_fmed3f(c3[r], 0.f, INFINITY), sv);
                sv += 0.0f;
                const int sb = __float_as_int(sv);
                const unsigned su = (unsigned)sb ^ ((unsigned)(sb >> 31) | 0x80000000u);
                const unsigned ck = (su & 0xFFFFF800u) | (unsigned)(2047 - j);
                sc[gi][r] = (g < ng && j <= tq) ? ck : 0u;
            }
        }
    }
    bool alldone = false;
    for (int pass = 0; pass < 5; ++pass) {
        const bool fin = alldone;
        if (!fin) { for (int i = tid; i < 16 * 257; i += 256) hist[i] = 0u; }
        if (tid == 0) *flag = 0u;
        __syncthreads();
        const unsigned sP = stP[ql], sDone = stDone[ql];
        int wv = wave, fqv = fq;
        asm volatile("" : "+v"(wv), "+v"(fqv));
        if (fin) {
            const int sh = (int)(32u - 8u * (sDone ? sDone : 1u));
            unsigned* mrow = maskl + ql * 64;
#pragma unroll
            for (int gi = 0; gi < 32; ++gi) {
                const int g = wv + 4 * gi;
                unsigned nib = 0u;
#pragma unroll
                for (int r = 0; r < 4; ++r) {
                    const unsigned uu = sc[gi][r];
                    nib |= ((uu >> sh) >= sP) ? (1u << r) : 0u;
                }
                if (g < ng) atomicOr(&mrow[g >> 1], nib << ((g & 1) * 16 + 4 * fqv));
            }
        } else {
            const int shm = pass ? 32 - 8 * pass : 0, shd = 24 - 8 * pass;
            const unsigned orm = pass ? 0u : 0xFFFFFFFFu;
            const unsigned cmpv = pass ? (sDone == 0u ? sP : 0xFFFFFFFFu) : 0xFFFFFFFFu;
            unsigned* hrow = hist + ql * 257;
            unsigned* dummy = dummyb + lane;
#pragma unroll
            for (int gi = 0; gi < 32; ++gi) {
                const int g = wv + 4 * gi;
                if (g < ng) {
#pragma unroll
                    for (int r = 0; r < 4; ++r) {
                        const unsigned uu = sc[gi][r];
                        const bool match = (((uu >> shm) | orm) == cmpv);
                        const unsigned dig = (uu >> shd) & 255u;
                        unsigned* a = match ? hrow + dig : dummy;
                        atomicAdd(a, 1u);
                    }
                }
            }
        }
        __syncthreads();
        if (fin) break;
        {
            const int qq = tid >> 4, seg = tid & 15;
            const bool active = (stDone[qq] == 0u);
            unsigned c16 = 0u;
            if (active) {
#pragma unroll
                for (int d = 0; d < 16; ++d) c16 += hist[qq * 257 + seg * 16 + d];
            }
            unsigned v = c16;
#pragma unroll
            for (int off = 1; off < 16; off <<= 1) { const unsigned t = __shfl_down(v, off, 16); if (seg + off < 16) v += t; }
            const unsigned suf = v - c16;
            const unsigned need = stNeed[qq];
            if (active && suf < need && need <= suf + c16) {
                unsigned run = suf, D = 0u, cD = 0u, nn = need;
                for (int d = 15; d >= 0; --d) {
                    const unsigned cc = hist[qq * 257 + seg * 16 + d];
                    if (run + cc >= need) { D = (unsigned)(seg * 16 + d); cD = cc; nn = need - run; break; }
                    run += cc;
                }
                const bool done = (cD == nn) || pass == 3;
                stP[qq] = (stP[qq] << 8) | D; stNeed[qq] = nn;
                if (done) stDone[qq] = (unsigned)(pass + 1); else atomicAdd(flag, 1u);
            }
        }
        __syncthreads();
        alldone = (*flag == 0u);
    }
    for (int i = tid; i < 1024; i += 256) p->dmask[(size_t)(tokbase + q0 + (i >> 6)) * 64 + (i & 63)] = maskl[i];
}

__device__ __forceinline__ void conv_unit(KP p, char* lds, int l, int b, int c) {
    float* a = (float*)lds;
    float* red = a + 62 * 256;
    const int ch = TID(), lane = ch & 63, wave = ch >> 6;
    const int t0 = c * 32, tokbase = b * SEQ;
    __syncthreads();
#pragma unroll 1
    for (int r0 = 0; r0 < 64; r0 += 8) {
        half_t uu[8], gg[8];
#pragma unroll
        for (int i = 0; i < 8; ++i) {
            int rr = r0 + i; rr = rr < 62 ? rr : 61;
            int tt = t0 - 30 + rr; tt = tt >= 0 ? tt : t0;
            const half_t* r = p->P + (size_t)(tokbase + tt) * NP;
            uu[i] = r[PC_CU + ch]; gg[i] = r[PC_CG + ch];
        }
#pragma unroll
        for (int i = 0; i < 8; ++i) {
            const int rr = r0 + i;
            const float av = (t0 - 30 + rr >= 0) ? (float)uu[i] * sigmoidf_((float)gg[i]) : 0.f;
            if (rr < 62) a[rr * 256 + ch] = av;
        }
    }
    float w[31];
#pragma unroll
    for (int i = 0; i < 31; ++i) w[i] = p->w_dw[(l * 31 + i) * 256 + ch];
    const float bias = p->b_dw[l * 256 + ch];
    float y[32];
#pragma unroll
    for (int tk = 0; tk < 32; ++tk) {
        float s = bias;
#pragma unroll
        for (int i = 0; i < 31; ++i) s = fmaf(a[(tk + i) * 256 + ch], w[i], s);
        y[tk] = s;
        float s1 = s, s2 = s * s;
#pragma unroll
        for (int o = 32; o >= 1; o >>= 1) { s1 += __shfl_xor(s1, o); s2 += __shfl_xor(s2, o); }
        if (lane == 0) { red[(tk * 4 + wave) * 2] = s1; red[(tk * 4 + wave) * 2 + 1] = s2; }
    }
    __syncthreads();
    const float lg = p->ln_g[l * 256 + ch], lb = p->ln_b[l * 256 + ch];
#pragma unroll
    for (int tk = 0; tk < 32; ++tk) {
        const float s1 = (red[tk * 8] + red[tk * 8 + 2]) + (red[tk * 8 + 4] + red[tk * 8 + 6]);
        const float s2 = (red[tk * 8 + 1] + red[tk * 8 + 3]) + (red[tk * 8 + 5] + red[tk * 8 + 7]);
        const float mu = s1 * (1.0f / 256.0f);
        float var = s2 * (1.0f / 256.0f) - mu * mu; var = var < 0.f ? 0.f : var;
        float z = (y[tk] - mu) * (1.0f / sqrtf(var + 1e-6f)) * lg + lb;
        z = z * sigmoidf_(z);
        p->ycat[(size_t)(tokbase + t0 + tk) * DM + ch] = (half_t)z;
    }
}

__device__ __forceinline__ void kmean_unit(KP p, char* lds, int b, int h, int blk) {
    float* part = (float*)lds;
    const int tid = TID(), d = tid & 63, pt = tid >> 6;
    const half_t* r = p->P + (size_t)(b * SEQ + blk * 256 + pt * 64) * NP + PC_MK + h * 64 + d;
    float s = 0.f;
    for (int k = 0; k < 64; ++k) s += (float)r[(size_t)k * NP];
    __syncthreads();
    part[pt * 64 + d] = s;
    __syncthreads();
    if (tid < 64) p->kmean[(((size_t)b * 6 + h) * 8 + blk) * 64 + tid] = ((part[tid] + part[64 + tid]) + (part[128 + tid] + part[192 + tid])) * (1.0f / 256.0f);
}

#ifndef POST_MASK
#define POST_MASK 7
#endif
__device__ __forceinline__ void phase_post(KP p, char* lds, int l, int tm) {
    const int NA = 2048, NB = 1024, NC = 768;
    for (int u = BID(); u < NA + NB + NC; u += gridDim.x) {
        if (u < NA) { if (tm & 1) dsa_select_unit(p, lds, u % 16, 127 - (u / 16)); }
        else if (u < NA + NB) { const int v = u - NA; if (tm & 2) conv_unit(p, lds, l, v % 16, v / 16); }
        else { const int v = u - NA - NB; if (tm & 4) kmean_unit(p, lds, v / 48, (v / 8) % 6, v % 8); }
    }
}

template <int MODE>
__device__ __forceinline__ void attn_unit(KP p, char* lds, int b, int h, int qt) {
    const int tid = TID(), lane = tid & 63, wave = tid >> 6, hh = lane >> 5, ql = lane & 31;
    const int q0 = qt * 128, tokbase = b * SEQ;
    const int tq = q0 + wave * 32 + ql;
    const half_t* Pb = p->P + (size_t)tokbase * NP;
    const int QOFF = MODE ? PC_MQ + h * 64 : PC_DQ + h * 64;
    const int KOFF = MODE ? PC_MK + h * 64 : PC_DK;
    const int VOFF = MODE ? PC_MV + h * 64 : PC_DV;
    const int own = qt >> 1;
    unsigned mysel = 0u, anysel = 0u;
    __syncthreads();
    if (MODE == 1) {
        float* km = (float*)(lds + 32768);
        float* gts = km + 512;
        unsigned* selq = (unsigned*)(gts + 1024);
        unsigned* anyb = selq + 128;
        for (int i = tid; i < 512; i += 256) km[i] = p->kmean[((size_t)b * 6 + h) * 512 + i];
        if (tid == 0) *anyb = 0u;
        __syncthreads();
        {
            const int q = tid & 127, hf = tid >> 7;
            if (hf * 4 < own) {
                const half_t* qr = Pb + (size_t)(q0 + q) * NP + QOFF;
                float g0 = 0.f, g1 = 0.f, g2 = 0.f, g3 = 0.f;
#pragma unroll
                for (int c8 = 0; c8 < 8; ++c8) {
                    const h8 qv = *(const h8*)(qr + c8 * 8);
#pragma unroll
                    for (int j = 0; j < 8; ++j) {
                        const float qf = (float)qv[j]; const int d = c8 * 8 + j;
                        g0 = fmaf(qf, km[(hf * 4 + 0) * 64 + d], g0); g1 = fmaf(qf, km[(hf * 4 + 1) * 64 + d], g1);
                        g2 = fmaf(qf, km[(hf * 4 + 2) * 64 + d], g2); g3 = fmaf(qf, km[(hf * 4 + 3) * 64 + d], g3);
                    }
                }
                gts[q * 8 + hf * 4 + 0] = g0; gts[q * 8 + hf * 4 + 1] = g1; gts[q * 8 + hf * 4 + 2] = g2; gts[q * 8 + hf * 4 + 3] = g3;
            }
        }
        __syncthreads();
        if (tid < 128) {
            unsigned m = 0u;
            const int want = own < 3 ? own : 3;
            for (int r = 0; r < want; ++r) {
                int best = -1; float bv = -INFINITY;
                for (int j = 0; j < own; ++j) { const float gv = gts[tid * 8 + j]; if (!((m >> j) & 1u) && (best < 0 || gv > bv)) { best = j; bv = gv; } }
                m |= 1u << best;
            }
            selq[tid] = m;
            if (m) atomicOr(anyb, m);
        }
        __syncthreads();
        mysel = selq[wave * 32 + ql];
        anysel = *anyb;
        __syncthreads();
    }
    h8 qf[4];
#pragma unroll
    for (int ks = 0; ks < 4; ++ks) qf[ks] = *(const h8*)(Pb + (size_t)tq * NP + QOFF + 16 * ks + 8 * hh);
    f16v O0, O1;
#pragma unroll
    for (int r = 0; r < 16; ++r) { O0[r] = 0.f; O1[r] = 0.f; }
    float m_run = -1e30f, l_run = 0.f;
    const float CS = 0.18033688011112042f;
    const int ntile = 2 * qt + 2;
    auto skip = [&](int kt) -> bool { return MODE == 1 && kt < 4 * own && !((anysel >> (kt >> 2)) & 1u); };
    auto nexttile = [&](int kt) -> int { ++kt; while (kt < ntile && skip(kt)) ++kt; return kt; };
    const int lrow = tid >> 3;
    const int kchunk = (tid & 7) ^ ((tid >> 4) & 7);
    const int vchunk = (tid & 7) ^ (((tid >> 4) & 1) << 2);
    char* ldst = lds + lrow * 128 + (tid & 7) * 16;
    auto issue = [&](int kt, int s) {
        const half_t* src = Pb + (size_t)(kt * 64 + lrow) * NP;
        char* d = ldst + s * 16384;
        glds16(src + KOFF + kchunk * 8, d);
        glds16(src + (size_t)32 * NP + KOFF + kchunk * 8, d + 4096);
        glds16(src + VOFF + vchunk * 8, d + 8192);
        glds16(src + (size_t)32 * NP + VOFF + vchunk * 8, d + 8192 + 4096);
    };
    const int rsw = (lane >> 1) & 7;
    const int kro = ql * 128;
    const int li = lane & 15, qp = li >> 2, pp = li & 3, swv = (qp >> 1) & 1;
    const int vb0 = 8192 + (4 * hh + qp) * 128 + 32 * ((lane >> 4) & 1) + 8 * pp + 64 * (0 ^ swv);
    const int vb1 = 8192 + (4 * hh + qp) * 128 + 32 * ((lane >> 4) & 1) + 8 * pp + 64 * (1 ^ swv);
    int kt = -1; kt = nexttile(kt);
    int s = 0;
    if (kt < ntile) issue(kt, 0);
    while (kt < ntile) {
        const int ktn = nexttile(kt);
        asm volatile("s_waitcnt vmcnt(0)" ::: "memory");
        __syncthreads();
        if (ktn < ntile) issue(ktn, s ^ 1);
        const bool wave_active = (kt * 64 <= q0 + wave * 32 + 31);
        if (wave_active) {
            const char* base = lds + s * 16384;
            uint2 mw = make_uint2(0u, 0u);
            if (MODE == 0) mw = *(const uint2*)(p->dmask + (size_t)(tokbase + tq) * 64 + 2 * kt);
            f16v s0, s1;
#pragma unroll
            for (int r = 0; r < 16; ++r) { s0[r] = 0.f; s1[r] = 0.f; }
#pragma unroll
            for (int ks = 0; ks < 4; ++ks) {
                const int co = ((2 * ks + hh) ^ rsw) << 4;
                const h8 k0 = *(const h8*)(base + kro + co), k1 = *(const h8*)(base + kro + 4096 + co);
                s0 = __builtin_amdgcn_mfma_f32_32x32x16_f16(k0, qf[ks], s0, 0, 0, 0);
                s1 = __builtin_amdgcn_mfma_f32_32x32x16_f16(k1, qf[ks], s1, 0, 0, 0);
            }
            if (MODE == 0) {
                const unsigned w0 = mw.x >> (4 * hh), w1 = mw.y >> (4 * hh);
#pragma unroll
                for (int r = 0; r < 16; ++r) {
                    const int pos = (r & 3) + 8 * (r >> 2);
                    s0[r] = ((w0 >> pos) & 1u) ? s0[r] : -INFINITY;
                    s1[r] = ((w1 >> pos) & 1u) ? s1[r] : -INFINITY;
                }
            } else {
                if (kt < 4 * own) {
                    const bool v = (mysel >> (kt >> 2)) & 1u;
                    if (!v) {
#pragma unroll
                        for (int r = 0; r < 16; ++r) { s0[r] = -INFINITY; s1[r] = -INFINITY; }
                    }
                } else if (kt * 64 + 63 > q0 + wave * 32) {
#pragma unroll
                    for (int r = 0; r < 16; ++r) {
                        const int key = kt * 64 + (r & 3) + 8 * (r >> 2) + 4 * hh;
                        s0[r] = (key <= tq) ? s0[r] : -INFINITY;
                        s1[r] = (key + 32 <= tq) ? s1[r] : -INFINITY;
                    }
                }
            }
            float mx = s0[0];
#pragma unroll
            for (int r = 1; r < 16; ++r) mx = fmaxf(mx, s0[r]);
#pragma unroll
            for (int r = 0; r < 16; ++r) mx = fmaxf(mx, s1[r]);
            mx = fmaxf(mx, __shfl_xor(mx, 32));
            const float mnew = fmaxf(m_run, mx);
            const float alpha = __builtin_amdgcn_exp2f((m_run - mnew) * CS);
            const float mc = mnew * CS;
            m_run = mnew;
            float ls = 0.f;
#pragma unroll
            for (int r = 0; r < 16; ++r) { s0[r] = __builtin_amdgcn_exp2f(fmaf(s0[r], CS, -mc)); ls += s0[r]; }
#pragma unroll
            for (int r = 0; r < 16; ++r) { s1[r] = __builtin_amdgcn_exp2f(fmaf(s1[r], CS, -mc)); ls += s1[r]; }
            l_run = l_run * alpha + ls;
#pragma unroll
            for (int r = 0; r < 16; ++r) { O0[r] *= alpha; O1[r] *= alpha; }
#pragma unroll
            for (int ksub = 0; ksub < 2; ++ksub) {
#pragma unroll
                for (int sp = 0; sp < 2; ++sp) {
                    h8 pf;
#pragma unroll
                    for (int j = 0; j < 8; ++j) pf[j] = (half_t)(ksub ? s1[8 * sp + j] : s0[8 * sp + j]);
                    const int roff = (32 * ksub + 16 * sp) * 128;
                    {
                        const s4v lo = __builtin_amdgcn_ds_read_tr16_b64_v4i16((LAS s4v*)(base + vb0 + roff));
                        const s4v hi = __builtin_amdgcn_ds_read_tr16_b64_v4i16((LAS s4v*)(base + vb0 + roff + 8 * 128));
                        const h8 vf = __builtin_bit_cast(h8, __builtin_shufflevector(lo, hi, 0, 1, 2, 3, 4, 5, 6, 7));
                        O0 = __builtin_amdgcn_mfma_f32_32x32x16_f16(vf, pf, O0, 0, 0, 0);
                    }
                    {
                        const s4v lo = __builtin_amdgcn_ds_read_tr16_b64_v4i16((LAS s4v*)(base + vb1 + roff));
                        const s4v hi = __builtin_amdgcn_ds_read_tr16_b64_v4i16((LAS s4v*)(base + vb1 + roff + 8 * 128));
                        const h8 vf = __builtin_bit_cast(h8, __builtin_shufflevector(lo, hi, 0, 1, 2, 3, 4, 5, 6, 7));
                        O1 = __builtin_amdgcn_mfma_f32_32x32x16_f16(vf, pf, O1, 0, 0, 0);
                    }
                }
            }
        }
        kt = ktn; s ^= 1;
    }
    const float lt = l_run + __shfl_xor(l_run, 32);
    const float inv = 1.0f / lt;
    half_t* dst = p->ycat + (size_t)(tokbase + tq) * DM + (MODE ? 640 : 256) + h * 64 + 4 * hh;
#pragma unroll
    for (int g = 0; g < 4; ++g) {
        *(h4*)(dst + 8 * g) = pack4(O0[4 * g] * inv, O0[4 * g + 1] * inv, O0[4 * g + 2] * inv, O0[4 * g + 3] * inv);
        *(h4*)(dst + 32 + 8 * g) = pack4(O1[4 * g] * inv, O1[4 * g + 1] * inv, O1[4 * g + 2] * inv, O1[4 * g + 3] * inv);
    }
}

__device__ __forceinline__ void phase_attn(KP p, char* lds) {
    for (int u = BID(); u < 3072; u += gridDim.x) {
        const int qt = 15 - (u / 192), rem = u % 192;
        const int type = rem & 1, bh = rem >> 1;
        if (type == 0) attn_unit<0>(p, lds, bh / 6, bh % 6, qt);
        else attn_unit<1>(p, lds, bh / 6, bh % 6, qt);
    }
}

__global__ void __launch_bounds__(256, 2) mk_fwd(Params p_unused) {
    extern __shared__ __attribute__((aligned(16))) char lds[];
    volatile LAS unsigned* stw = (volatile LAS unsigned*)(lds + 65536);
    if (threadIdx.x < 4) stw[threadIdx.x] = 0u;
    __syncthreads();
    KP p0 = (KP)__builtin_amdgcn_kernarg_segment_ptr();
    XcdBarrier bar; bar.bar = p0->bar; bar.x = 0; bar.st = stw;
#if !MK_SPLIT
    bar = xcd_barrier_post(p0->bar, stw);
#endif
    const int ph_lo = p0->ph_lo, ph_hi = p0->ph_hi;
    for (int ph = ph_lo; ph < ph_hi; ++ph) {
      KP p = p0; asm volatile("" : "+s"(p));
      const int nrep = (DUP_SUB >= 0 && ((DUP_SUB == 100 && ph == 0) || (ph >= 2 && ph < NPHASE - 1 && ((ph - 2) & 7) == DUP_SUB && (DUP_SUB != 4 || ph < 10)))) ? 2 : 1;
      for (int rep = 0; rep < nrep; ++rep) {
        if (ph == 0) phase_prologue(p, lds);
        else if (ph == 1) phase_modsum(p);
        else if (ph == NPHASE - 1) phase_norm<2>(p, lds, p->out, p->g_final, nullptr, nullptr, 0);
        else {
            const int l = (ph - 2) >> 3, sub = (ph - 2) & 7;
            const float* mf = p->modf + (size_t)l * 16 * 6144;
            const float* xin = l == 0 ? p->x : p->out;
            if (sub == 0) phase_norm<0>(p, lds, xin, p->g_mix + l * DM, mf, mf + 1024, l);
            else if (sub == 1) phase_inproj(p, lds, l);
            else if (sub == 2) phase_post(p, lds, l, rep ? POST_MASK : 7);
            else if (sub == 3) phase_attn(p, lds);
            else if (sub == 4) phase_outproj(p, lds, l, xin);
            else if (sub == 5) phase_norm<1>(p, lds, p->out, p->g_ffn + l * DM, mf + 3 * 1024, mf + 4 * 1024, l);
            else if (sub == 6) phase_moe_up(p, lds, l);
            else phase_moe_down(p, lds, l);
        }
      }
#if !MK_SPLIT
        if (ph + 1 < ph_hi) xcd_barrier(bar);
#endif
    }
}

extern "C" void kernel_launch(void* const* d_in, const int* in_sizes, int n_in, void* d_out, int out_size, void* d_ws, size_t ws_size, hipStream_t stream) {
    static int grid = 0;
    if (grid == 0) {
        int dev = 0, cus = 0, per_cu = 0;
        (void)hipGetDevice(&dev);
        (void)hipDeviceGetAttribute(&cus, hipDeviceAttributeMultiprocessorCount, dev);
        (void)hipFuncSetAttribute((const void*)mk_fwd, hipFuncAttributeMaxDynamicSharedMemorySize, LDS_BYTES);
        if (hipOccupancyMaxActiveBlocksPerMultiprocessor(&per_cu, (const void*)mk_fwd, 256, LDS_BYTES) != hipSuccess || per_cu < 1) per_cu = 1;
        (void)hipGetLastError();
        if (per_cu > 2) per_cu = 2;
        grid = cus * per_cu;
        fprintf(stderr, "mk_fwd: cus %d per_cu %d grid %d\n", cus, per_cu, grid);
    }
    Params p{};
    const float** pin = (const float**)&p.x;
    for (int i = 0; i < 18; ++i) pin[i] = (const float*)d_in[i];
    p.out = (float*)d_out;
    char* ws = (char*)d_ws;
    size_t off = 0;
    auto carve = [&](size_t bytes) { void* q = ws + off; off += (bytes + 255) & ~(size_t)255; return q; };
    p.bar = (unsigned*)carve(XCD_BAR_WORDS * 4);
    p.cnt = (int*)carve(64 * 4);
    const size_t zero_bytes = off;
    p.Wt_in = (half_t*)carve((size_t)2 * NP * DM * 2);
    p.Wt_o = (half_t*)carve((size_t)2 * DM * DM * 2);
    p.Wt_gu = (half_t*)carve((size_t)2 * 16 * 512 * 1024 * 2);
    p.Wt_d = (half_t*)carve((size_t)2 * 16 * 1024 * 256 * 2);
    p.hn = (half_t*)carve((size_t)T_TOK * DM * 2);
    p.P = (half_t*)carve((size_t)T_TOK * NP * 2);
    p.ycat = (half_t*)carve((size_t)T_TOK * DM * 2);
    p.act = (half_t*)carve((size_t)T_TOK * 512 * 2);
    p.modpart = (float*)carve((size_t)8 * 2 * 16 * 6144 * 4);
    p.modf = (float*)carve((size_t)2 * 16 * 6144 * 4);
    p.kmean = (float*)carve((size_t)16 * 6 * 8 * 64 * 4);
    p.rope = (float*)carve((size_t)2048 * 24 * 4);
    p.iwf = (float*)carve((size_t)T_TOK * 4 * 4);
    p.tokw = (float*)carve((size_t)T_TOK * 2 * 4);
    p.dmask = (unsigned*)carve((size_t)T_TOK * 64 * 4);
    p.lists = (int*)carve((size_t)NCLS * T_TOK * 4);
    if (off > ws_size) { fprintf(stderr, "workspace too small: need %zu have %zu\n", off, ws_size); return; }
    (void)hipMemsetAsync(d_ws, 0, zero_bytes, stream);
#if MK_SPLIT
    for (int ph = 0; ph < NPHASE; ++ph) {
        p.ph_lo = ph; p.ph_hi = ph + 1;
        hipLaunchKernelGGL(mk_fwd, dim3(grid), dim3(256), LDS_BYTES, stream, p);
    }
#else
    p.ph_lo = 0; p.ph_hi = NPHASE;
    hipLaunchKernelGGL(mk_fwd, dim3(grid), dim3(256), LDS_BYTES, stream, p);
#endif
}
```

```cpp
#include <hip/hip_runtime.h>
#include <cstdio>
#include <cstdint>

#ifndef MK_SPLIT
#define MK_SPLIT 0
#endif

#define T_TOK 32768
#define DM 1024
#define SEQ 2048
#define INW 2340
#define NP 2432
#define PC_CU 0
#define PC_CG 256
#define PC_DQ 512
#define PC_DK 896
#define PC_DV 960
#define PC_IQ 1024
#define PC_IK 1152
#define PC_IW 1184
#define PC_MQ 1280
#define PC_MK 1664
#define PC_MV 2048
#define LOG_THETA 13.122363377404328f
#define NCLS 24
#define LDS_BYTES 70656
#define NPHASE 19
#ifndef DUP_SUB
#define DUP_SUB -1
#endif

typedef _Float16 half_t;
typedef _Float16 h8 __attribute__((ext_vector_type(8)));
typedef _Float16 h4 __attribute__((ext_vector_type(4)));
typedef short s4v __attribute__((ext_vector_type(4)));
typedef short s8v __attribute__((ext_vector_type(8)));
typedef float f16v __attribute__((ext_vector_type(16)));
typedef float f4v __attribute__((ext_vector_type(4)));
#define LAS __attribute__((address_space(3)))

struct Params {
    const float *x, *c, *w_ada, *b_ada, *g_mix, *w_in, *w_dw, *b_dw, *ln_g, *ln_b, *w_o, *g_ffn, *w_router, *b_router, *w_gate, *w_up, *w_down, *g_final;
    float* out;
    half_t *Wt_in, *Wt_o, *Wt_gu, *Wt_d, *hn, *P, *ycat, *act;
    float *modpart, *modf, *kmean, *rope, *iwf, *tokw;
    unsigned* dmask; int* cnt; int* lists; unsigned* bar;
    int ph_lo, ph_hi;
};

#define XB_TMO      128
#define XB_XCNT(j)  (256  + 64 * (j))
#define XB_XSUB(j)  (1280 + 64 * (j))
#define XB_XGEN(j)  (2304 + 64 * (j))
#define XB_TOP      3328
#define XB_TOPGEN   3392
#define XCD_BAR_WORDS 3456
#define XB_SPIN_CAP (1u << 20)
__device__ __forceinline__ unsigned xb_ld(unsigned* p)              { return __hip_atomic_load(p, __ATOMIC_RELAXED, __HIP_MEMORY_SCOPE_AGENT); }
__device__ __forceinline__ unsigned xb_add(unsigned* p, unsigned v) { return __hip_atomic_fetch_add(p, v, __ATOMIC_RELAXED, __HIP_MEMORY_SCOPE_AGENT); }
__device__ __forceinline__ unsigned xb_xcc_id() { return (unsigned)__builtin_amdgcn_s_getreg((3 << 11) | 20) & 0xFu; }
#define XB_SPIN(cond, bar) do { unsigned _sp = 0; while (cond) { __builtin_amdgcn_s_sleep(1); \
    if ((++_sp & 255u) == 0u) { if (xb_ld(&(bar)[XB_TMO])) break; if (_sp > XB_SPIN_CAP) { atomicAdd(&(bar)[XB_TMO], 1u); break; } } } } while (0)
struct XcdBarrier { unsigned* bar; unsigned x; volatile LAS unsigned* st; };
__device__ __forceinline__ XcdBarrier xcd_barrier_post(unsigned* bar, volatile LAS unsigned* st) {
    XcdBarrier b; b.bar = bar; b.x = xb_xcc_id(); b.st = st;
    if (threadIdx.x == 0) (void)xb_add(&bar[XB_XCNT(b.x)], 1u);
    return b;
}
__device__ __forceinline__ void xcd_barrier_complete(unsigned* bar, unsigned x, unsigned& nloc, unsigned& nx) {
    const unsigned G = gridDim.x * gridDim.y * gridDim.z;
    unsigned sum, cnt, mine, sp = 0u;
    for (;;) {
        sum = 0u; cnt = 0u; mine = 0u;
#pragma unroll
        for (unsigned j = 0; j < 16; ++j) { const unsigned c = xb_ld(&bar[XB_XCNT(j)]); sum += c; cnt += (c > 0u) ? 1u : 0u; mine = (j == x) ? c : mine; }
        if (sum == G) break;
        __builtin_amdgcn_s_sleep(1);
        if ((++sp & 255u) == 0u) { if (xb_ld(&bar[XB_TMO])) break; if (sp > XB_SPIN_CAP) { atomicAdd(&bar[XB_TMO], 1u); break; } }
    }
    nloc = mine > 0u ? mine : 1u; nx = cnt > 0u ? cnt : 1u;
}
__device__ __forceinline__ void xcd_barrier(const XcdBarrier& b) {
    asm volatile("s_waitcnt vmcnt(0)" ::: "memory");
    __syncthreads();
    if (threadIdx.x == 0) {
        unsigned* bar = b.bar;
        __builtin_amdgcn_s_waitcnt(0);
        unsigned nloc = b.st[0], nx = b.st[1];
        if (nloc == 0u) { xcd_barrier_complete(bar, b.x, nloc, nx); b.st[0] = nloc; b.st[1] = nx; }
        const unsigned old = xb_add(&bar[XB_XSUB(b.x)], 1u);
        const unsigned gen = old / nloc;
        if (old + 1u == (gen + 1u) * nloc) {
            __builtin_amdgcn_fence(__ATOMIC_RELEASE, "agent");
            asm volatile("s_waitcnt vmcnt(0)" ::: "memory");
            const unsigned og = xb_add(&bar[XB_TOP], 1u);
            const unsigned tg = og / nx;
            if (og + 1u == (tg + 1u) * nx) xb_add(&bar[XB_TOPGEN], 1u);
            else XB_SPIN(xb_ld(&bar[XB_TOPGEN]) == tg, bar);
            __builtin_amdgcn_fence(__ATOMIC_ACQUIRE, "agent");
            xb_add(&bar[XB_XGEN(b.x)], 1u);
            asm volatile("s_waitcnt vmcnt(0)" ::: "memory");
        } else {
            XB_SPIN(xb_ld(&bar[XB_XGEN(b.x)]) == gen, bar);
            __builtin_amdgcn_fence(__ATOMIC_ACQUIRE, "agent");
            asm volatile("s_waitcnt vmcnt(0)" ::: "memory");
        }
    }
    __syncthreads();
}

typedef const __attribute__((address_space(4))) Params* KP;
__device__ __forceinline__ int TID() { int t = threadIdx.x; asm volatile("" : "+v"(t)); return t; }
__device__ __forceinline__ int BID() { int b = blockIdx.x; asm volatile("" : "+s"(b)); return b; }
__device__ __forceinline__ float sigmoidf_(float v) { return 1.0f / (1.0f + __expf(-v)); }
__device__ __forceinline__ void glds16(const void* g, char* l) { __builtin_amdgcn_global_load_lds((const unsigned*)g, (unsigned*)l, 16, 0, 0); }
__device__ __forceinline__ unsigned f2sortable(float f) { unsigned u = __float_as_uint(f); return (u & 0x80000000u) ? ~u : (u | 0x80000000u); }
__device__ __forceinline__ h4 pack4(float a, float b, float c, float d) { h4 r = {(half_t)a, (half_t)b, (half_t)c, (half_t)d}; return r; }

template <class CF>
__device__ __forceinline__ void conv_tile(char* lds, CF colf, int src_ld, int k0, half_t* dst_tile  , int dstK) {
    float* tl = (float*)lds;
    const int tid = TID();
    __syncthreads();
    {
        const int nn = tid & 63;
        const float* cp = colf(nn);
#pragma unroll 4
        for (int i = 0; i < 16; ++i) { const int k = i * 4 + (tid >> 6); tl[k * 65 + nn] = cp ? cp[(size_t)(k0 + k) * src_ld] : 0.f; }
    }
    __syncthreads();
    {
        const int n = tid >> 2, kq = (tid & 3) * 16;
        h8 a, b;
#pragma unroll
        for (int j = 0; j < 8; ++j) { a[j] = (half_t)tl[(kq + j) * 65 + n]; b[j] = (half_t)tl[(kq + 8 + j) * 65 + n]; }
        h8* d = (h8*)(dst_tile + (size_t)n * dstK + kq);
        d[0] = a; d[1] = b;
    }
}

__device__ __forceinline__ void phase_prologue(KP p, char* lds) {
    const int tid = TID();
    const int NA = 2 * 16 * 38, NB = 2 * 16 * 16, NC = 2 * 16 * 16 * 8, ND = 2 * 16 * 4 * 16, NE = 384, NF = 8;
    const int total = NA + NB + NC + ND + NE + NF;
    for (int u0 = BID(); u0 < total; u0 += gridDim.x) {
        int u = u0;
        if (u < NA) {
            const int nt = u % 38, kt = (u / 38) % 16, l = u / (38 * 16);
            const float* src = p->w_in + (size_t)l * DM * INW;
            const int n0 = nt * 64;
            conv_tile(lds, [&](int nn) -> const float* { const int np = n0 + nn; const int sc = np < 1188 ? np : (np < 1280 ? -1 : np - 92); return sc >= 0 ? src + sc : (const float*)nullptr; },
                      INW, kt * 64, p->Wt_in + ((size_t)l * NP + n0) * DM + kt * 64, DM);
            continue;
        }
        u -= NA;
        if (u < NB) {
            const int nt = u % 16, kt = (u / 16) % 16, l = u / 256;
            const float* src = p->w_o + (size_t)l * DM * DM + nt * 64;
            conv_tile(lds, [&](int nn) -> const float* { return src + nn; }, DM, kt * 64, p->Wt_o + ((size_t)l * DM + nt * 64) * DM + kt * 64, DM);
            continue;
        }
        u -= NB;
        if (u < NC) {
            const int nt = u % 8, kt = (u / 8) % 16, le = u / 128;
            const float* sg = p->w_gate + (size_t)le * 1024 * 256 + nt * 32;
            const float* su = p->w_up + (size_t)le * 1024 * 256 + nt * 32;
            conv_tile(lds, [&](int nn) -> const float* { return nn < 32 ? sg + nn : su + (nn - 32); }, 256, kt * 64, p->Wt_gu + ((size_t)le * 512 + nt * 64) * 1024 + kt * 64, 1024);
            continue;
        }
        u -= NC;
        if (u < ND) {
            const int nt = u % 16, kt = (u / 16) % 4, le = u / 64;
            const float* src = p->w_down + (size_t)le * 256 * 1024 + nt * 64;
            conv_tile(lds, [&](int nn) -> const float* { return src + nn; }, 1024, kt * 64, p->Wt_d + ((size_t)le * 1024 + nt * 64) * 256 + kt * 64, 256);
            continue;
        }
        u -= ND;
        if (u < NE) {
            const int kc = u % 8, cc = (u / 8) % 24, l = u / 192;
            float* ca = (float*)lds;
            __syncthreads();
            for (int i = tid; i < 2048; i += 256) { const int b = i >> 7, k = i & 127; const float v = p->c[b * 1024 + kc * 128 + k]; ca[i] = v / (1.0f + expf(-v)); }
            __syncthreads();
            const int n = cc * 256 + tid;
            float acc[16];
#pragma unroll
            for (int b = 0; b < 16; ++b) acc[b] = 0.f;
            const float* w = p->w_ada + ((size_t)l * 1024 + kc * 128) * 6144 + n;
#pragma unroll 4
            for (int k = 0; k < 128; ++k) {
                const float wv = w[(size_t)k * 6144];
#pragma unroll
                for (int b = 0; b < 16; ++b) acc[b] = fmaf(ca[b * 128 + k], wv, acc[b]);
            }
#pragma unroll
            for (int b = 0; b < 16; ++b) p->modpart[(((size_t)kc * 2 + l) * 16 + b) * 6144 + n] = acc[b];
            continue;
        }
        u -= NE;
        {
            for (int i = u * 256 + tid; i < 2048 * 12; i += NF * 256) {
                const int t = i / 12, r = i % 12;
                const int fi = r < 8 ? r : r - 8;
                const float rot = r < 8 ? 16.f : 8.f;
                const float inv = expf(-LOG_THETA * ((float)fi * 2.0f / rot));
                const float ang = (float)t * inv;
                float sn, cs; sincosf(ang, &sn, &cs);
                if (r < 8) { p->rope[t * 8 + fi] = cs; p->rope[16384 + t * 8 + fi] = sn; }
                else { p->rope[32768 + t * 4 + fi] = cs; p->rope[32768 + 8192 + t * 4 + fi] = sn; }
            }
        }
    }
}

__device__ __forceinline__ void phase_modsum(KP p) {
    for (int i = BID() * 256 + TID(); i < 2 * 16 * 6144; i += gridDim.x * 256) {
        const int n = i % 6144, l = i / (16 * 6144);
        float s = p->b_ada[l * 6144 + n];
#pragma unroll
        for (int kc = 0; kc < 8; ++kc) s += p->modpart[(size_t)kc * (2 * 16 * 6144) + i];
        p->modf[i] = s;
    }
}

__device__ __forceinline__ void route_flush(KP p, char* lds, int lane, int wave, int n, int myrow, int layer) {
    const float* lg = (const float*)(lds + 65536 + 512) + wave * 256;
    int* lc = (int*)(lds + 65536 + 64);
    int* lbase = lc + 32;
    const int tid = wave * 64 + lane;
    if (tid < 32) lc[tid] = 0;
    __syncthreads();
    int cls = 0, lpos = 0;
    if (lane < n) {
        float aff[16], bia[16];
#pragma unroll
        for (int e = 0; e < 16; ++e) { aff[e] = 1.0f / (1.0f + expf(-lg[lane * 16 + e])); bia[e] = aff[e] + p->b_router[e]; }
        int bestg = 0; float bests = -INFINITY;
#pragma unroll
        for (int gi = 0; gi < 4; ++gi) {
            float m1 = -INFINITY, m2 = -INFINITY;
#pragma unroll
            for (int j = 0; j < 4; ++j) { const float vv = bia[gi * 4 + j]; if (vv > m1) { m2 = m1; m1 = vv; } else if (vv > m2) m2 = vv; }
            const float s = m1 + m2;
            if (s > bests) { bests = s; bestg = gi; }
        }
        float bsel[4], asel[4];
#pragma unroll
        for (int j = 0; j < 4; ++j) { bsel[j] = 0.f; asel[j] = 0.f; }
#pragma unroll
        for (int gi = 0; gi < 4; ++gi) if (gi == bestg) {
#pragma unroll
            for (int j = 0; j < 4; ++j) { bsel[j] = bia[gi * 4 + j]; asel[j] = aff[gi * 4 + j]; }
        }
        int i1 = -1, i2 = -1; float v1 = -INFINITY, v2 = -INFINITY;
#pragma unroll
        for (int j = 0; j < 4; ++j) { const float vv = bsel[j]; if (vv > v1) { v2 = v1; i2 = i1; v1 = vv; i1 = j; } else if (vv > v2) { v2 = vv; i2 = j; } }
        const int a = i1 < i2 ? i1 : i2, bb = i1 < i2 ? i2 : i1;
        float wa = 0.f, wb = 0.f;
#pragma unroll
        for (int j = 0; j < 4; ++j) { if (j == a) wa = asel[j]; if (j == bb) wb = asel[j]; }
        const float sw = wa + wb;
        const int pi = (a == 0) ? (bb - 1) : (a == 1 ? (bb + 1) : 5);
        cls = bestg * 6 + pi;
        *(float2*)(p->tokw + (size_t)myrow * 2) = make_float2(wa / sw, wb / sw);
        lpos = atomicAdd(&lc[cls], 1);
    }
    __syncthreads();
    if (tid < NCLS) { const int c = lc[tid]; lbase[tid] = c ? atomicAdd(&p->cnt[(layer * 32 + tid) * 64], c) : 0; }
    __syncthreads();
    if (lane < n) p->lists[(size_t)cls * T_TOK + lbase[cls] + lpos] = myrow;
}

template <int MODE>
__device__ __forceinline__ void phase_norm(KP p, char* lds, const float* xin, const float* g, const float* sh, const float* sc, int layer) {
    const int lane = TID() & 63, wave = TID() >> 6;
    float* wt = (float*)lds;
    if (MODE == 1) {
        __syncthreads();
        for (int i = TID(); i < 4096; i += 256) {
            const float4 w4 = ((const float4*)p->w_router)[i];
            const int k = i >> 2, e0 = (i & 3) * 4;
            wt[(e0 + 0) * 1024 + k] = w4.x; wt[(e0 + 1) * 1024 + k] = w4.y; wt[(e0 + 2) * 1024 + k] = w4.z; wt[(e0 + 3) * 1024 + k] = w4.w;
        }
        __syncthreads();
    }
    float* lgb = (float*)(lds + 65536 + 512);
    int myrow = 0, it = 0;
    for (int row = BID() * 4 + wave; row < T_TOK; row += gridDim.x * 4) {
        const int b = row >> 11;
        const float4* xr = (const float4*)(xin + (size_t)row * DM);
        float4 v[4]; float ss = 0.f;
#pragma unroll
        for (int i = 0; i < 4; ++i) { v[i] = xr[lane + 64 * i]; ss += v[i].x * v[i].x + v[i].y * v[i].y + v[i].z * v[i].z + v[i].w * v[i].w; }
#pragma unroll
        for (int o = 32; o >= 1; o >>= 1) ss += __shfl_xor(ss, o);
        const float rstd = 1.0f / sqrtf(ss * (1.0f / 1024.0f) + 1e-6f);
        float acc[16], ya[16];
#pragma unroll
        for (int i = 0; i < 4; ++i) {
            const int k = (lane + 64 * i) * 4;
            const float4 gg = *(const float4*)(g + k);
            float y[4] = {v[i].x * rstd * gg.x, v[i].y * rstd * gg.y, v[i].z * rstd * gg.z, v[i].w * rstd * gg.w};
            if (MODE != 2) {
                const float4 s1 = *(const float4*)(sh + (size_t)b * 6144 + k), s2 = *(const float4*)(sc + (size_t)b * 6144 + k);
                y[0] = y[0] * (1.f + s2.x) + s1.x; y[1] = y[1] * (1.f + s2.y) + s1.y; y[2] = y[2] * (1.f + s2.z) + s1.z; y[3] = y[3] * (1.f + s2.w) + s1.w;
                *(h4*)(p->hn + (size_t)row * DM + k) = pack4(y[0], y[1], y[2], y[3]);
            } else {
                *(float4*)(p->out + (size_t)row * DM + k) = make_float4(y[0], y[1], y[2], y[3]);
            }
            ya[4 * i] = y[0]; ya[4 * i + 1] = y[1]; ya[4 * i + 2] = y[2]; ya[4 * i + 3] = y[3];
        }
        if (MODE == 1) {
#pragma unroll
            for (int e = 0; e < 16; ++e) acc[e] = 0.f;
            float4 wq[2][4];
            const float* wl = wt + lane * 4;
#pragma unroll
            for (int e = 0; e < 4; ++e) wq[0][e] = *(const float4*)(wl + e * 1024);
#pragma unroll
            for (int st = 0; st < 16; ++st) {
                const int i = st >> 2, eg = st & 3, cur = st & 1;
                if (st + 1 < 16) {
                    const int i2 = (st + 1) >> 2, eg2 = (st + 1) & 3;
#pragma unroll
                    for (int e = 0; e < 4; ++e) wq[cur ^ 1][e] = *(const float4*)(wl + (eg2 * 4 + e) * 1024 + i2 * 256);
                }
#pragma unroll
                for (int e = 0; e < 4; ++e) {
                    const float4 w4 = wq[cur][e];
                    acc[eg * 4 + e] = fmaf(ya[4 * i], w4.x, fmaf(ya[4 * i + 1], w4.y, fmaf(ya[4 * i + 2], w4.z, fmaf(ya[4 * i + 3], w4.w, acc[eg * 4 + e]))));
                }
                __builtin_amdgcn_sched_barrier(0);
            }
        }
        if (MODE == 1) {
            const bool b5 = lane & 32, b4 = lane & 16, b3 = lane & 8, b2 = lane & 4;
            float r8[8], r4[4], r2[2];
#pragma unroll
            for (int e = 0; e < 8; ++e) { const float snd = b5 ? acc[e] : acc[e + 8], kp = b5 ? acc[e + 8] : acc[e]; r8[e] = kp + __shfl_xor(snd, 32); }
#pragma unroll
            for (int e = 0; e < 4; ++e) { const float snd = b4 ? r8[e] : r8[e + 4], kp = b4 ? r8[e + 4] : r8[e]; r4[e] = kp + __shfl_xor(snd, 16); }
#pragma unroll
            for (int e = 0; e < 2; ++e) { const float snd = b3 ? r4[e] : r4[e + 2], kp = b3 ? r4[e + 2] : r4[e]; r2[e] = kp + __shfl_xor(snd, 8); }
            float rv; { const float snd = b2 ? r2[0] : r2[1], kp = b2 ? r2[1] : r2[0]; rv = kp + __shfl_xor(snd, 4); }
            rv += __shfl_xor(rv, 2); rv += __shfl_xor(rv, 1);
            if ((lane & 3) == 0) lgb[(wave * 16 + it) * 16 + (lane >> 2)] = rv;
            if (lane == it) myrow = row;
            ++it;
            if (it == 16) { route_flush(p, lds, lane, wave, it, myrow, layer); it = 0; }
        }
    }
    if (MODE == 1 && it > 0) route_flush(p, lds, lane, wave, it, myrow, layer);
}

template <class WF, class XF, class EPI>
__device__ __forceinline__ void gemm_tile(char* lds, int nkt, WF wf, XF xf, EPI epi) {
    const int tid = TID(), lane = tid & 63, wave = tid >> 6;
    const int wn = wave & 1, wm = wave >> 1, hh = lane >> 5;
    const int lrow = tid >> 3;
    const int lchunk = (tid & 7) ^ ((tid >> 4) & 7);
    const half_t* xs[4];
#pragma unroll
    for (int i = 0; i < 4; ++i) xs[i] = xf(lrow + 32 * i) + lchunk * 8;
    char* ldst = lds + lrow * 128 + (tid & 7) * 16;
    f16v acc[2][2];
#pragma unroll
    for (int i = 0; i < 2; ++i)
#pragma unroll
        for (int j = 0; j < 2; ++j)
#pragma unroll
            for (int r = 0; r < 16; ++r) acc[i][j][r] = 0.f;
    auto issue = [&](int kt, int s) {
        char* d = ldst + s * 32768;
#pragma unroll
        for (int i = 0; i < 4; ++i) glds16(wf(kt, lrow + 32 * i) + lchunk * 8, d + i * 4096);
#pragma unroll
        for (int i = 0; i < 4; ++i) glds16(xs[i] + kt * 64, d + 16384 + i * 4096);
    };
    __syncthreads();
    issue(0, 0);
    const int rsw = (lane >> 1) & 7;
    const int roff_w = (wn * 64 + (lane & 31)) * 128, roff_x = 16384 + (wm * 64 + (lane & 31)) * 128;
    for (int kt = 0; kt < nkt; ++kt) {
        asm volatile("s_waitcnt vmcnt(0)" ::: "memory");
        __syncthreads();
        if (kt + 1 < nkt) issue(kt + 1, (kt + 1) & 1);
        const char* base = lds + (kt & 1) * 32768;
#pragma unroll
        for (int ks = 0; ks < 4; ++ks) {
            const int co = ((2 * ks + hh) ^ rsw) << 4;
            const h8 a0 = *(const h8*)(base + roff_w + co), a1 = *(const h8*)(base + roff_w + 4096 + co);
            const h8 b0 = *(const h8*)(base + roff_x + co), b1 = *(const h8*)(base + roff_x + 4096 + co);
            acc[0][0] = __builtin_amdgcn_mfma_f32_32x32x16_f16(a0, b0, acc[0][0], 0, 0, 0);
            acc[0][1] = __builtin_amdgcn_mfma_f32_32x32x16_f16(a0, b1, acc[0][1], 0, 0, 0);
            acc[1][0] = __builtin_amdgcn_mfma_f32_32x32x16_f16(a1, b0, acc[1][0], 0, 0, 0);
            acc[1][1] = __builtin_amdgcn_mfma_f32_32x32x16_f16(a1, b1, acc[1][1], 0, 0, 0);
        }
    }
    epi(acc, wn, wm, lane);
}

__device__ __forceinline__ void phase_inproj(KP p, char* lds, int l) {
    const half_t* W = p->Wt_in + (size_t)l * NP * DM;
    const float* rc16 = p->rope; const float* rs16 = p->rope + 16384; const float* rc8 = p->rope + 32768; const float* rs8 = p->rope + 32768 + 8192;
    for (int u = BID(); u < 256 * 19; u += gridDim.x) {
        const int xl = u & 7, Lx = u >> 3, mi = Lx & 7, rr_ = Lx >> 3;
        const int nt = rr_ % 19, mt = 32 * xl + 8 * (rr_ / 19) + mi;
        gemm_tile(lds, 16,
            [&](int kt, int row) { return W + (size_t)(nt * 128 + row) * DM + kt * 64; },
            [&](int row) { return p->hn + (size_t)(mt * 128 + row) * DM; },
            [&](f16v (&acc)[2][2], int wn, int wm, int lane) {
                const int hh = lane >> 5;
#pragma unroll
                for (int i = 0; i < 2; ++i) {
                    const int nb = nt * 128 + wn * 64 + i * 32;
                    if (nb == 1216 || nb == 1248) continue;
                    const bool rope64 = ((nb >= PC_DQ && nb < PC_DV) || (nb >= PC_MQ && nb < PC_MV)) && ((nb & 63) == 0);
                    const bool rope32 = (nb >= PC_IQ && nb < PC_IW);
#pragma unroll
                    for (int j = 0; j < 2; ++j) {
                        const int tok = mt * 128 + wm * 64 + j * 32 + (lane & 31);
                        const int t = tok & 2047;
                        f16v v = acc[i][j];
                        if (nb == PC_IW) { if (hh == 0) *(float4*)(p->iwf + (size_t)tok * 4) = make_float4(v[0], v[1], v[2], v[3]); continue; }
                        if (rope64) {
                            const float4 c4 = *(const float4*)(rc16 + t * 8 + 4 * hh), s4 = *(const float4*)(rs16 + t * 8 + 4 * hh);
                            const float cc[4] = {c4.x, c4.y, c4.z, c4.w}, sn[4] = {s4.x, s4.y, s4.z, s4.w};
#pragma unroll
                            for (int r = 0; r < 4; ++r) { const float x1 = v[r], x2 = v[r + 4]; v[r] = x1 * cc[r] - x2 * sn[r]; v[r + 4] = x2 * cc[r] + x1 * sn[r]; }
                        } else if (rope32) {
                            const float4 c4 = *(const float4*)(rc8 + t * 4), s4 = *(const float4*)(rs8 + t * 4);
                            const float cc[4] = {c4.x, c4.y, c4.z, c4.w}, sn[4] = {s4.x, s4.y, s4.z, s4.w};
#pragma unroll
                            for (int r = 0; r < 4; ++r) { const float o = __shfl_xor(v[r], 32); v[r] = hh ? (v[r] * cc[r] + o * sn[r]) : (v[r] * cc[r] - o * sn[r]); }
                        }
                        half_t* dst = p->P + (size_t)tok * NP + nb + 4 * hh;
#pragma unroll
                        for (int g = 0; g < 4; ++g) *(h4*)(dst + 8 * g) = pack4(v[4 * g], v[4 * g + 1], v[4 * g + 2], v[4 * g + 3]);
                    }
                }
            });
    }
}

__device__ __forceinline__ void phase_outproj(KP p, char* lds, int l, const float* xin) {
    const half_t* W = p->Wt_o + (size_t)l * DM * DM;
    const float* g1 = p->modf + (size_t)l * 16 * 6144 + 2 * 1024;
    for (int u = BID(); u < 256 * 8; u += gridDim.x) {
        const int xl = u & 7, Lx = u >> 3, mi = Lx & 7, rr_ = Lx >> 3;
        const int nt = rr_ & 7, mt = 32 * xl + 8 * (rr_ >> 3) + mi;
        gemm_tile(lds, 16,
            [&](int kt, int row) { return W + (size_t)(nt * 128 + row) * DM + kt * 64; },
            [&](int row) { return p->ycat + (size_t)(mt * 128 + row) * DM; },
            [&](f16v (&acc)[2][2], int wn, int wm, int lane) {
                const int hh = lane >> 5;
#pragma unroll
                for (int j = 0; j < 2; ++j) {
                    const int tok = mt * 128 + wm * 64 + j * 32 + (lane & 31);
                    const int b = tok >> 11;
#pragma unroll
                    for (int i = 0; i < 2; ++i) {
                        const int nb = nt * 128 + wn * 64 + i * 32 + 4 * hh;
#pragma unroll
                        for (int g = 0; g < 4; ++g) {
                            const int n = nb + 8 * g;
                            const float4 xi = *(const float4*)(xin + (size_t)tok * DM + n);
                            const float4 gg = *(const float4*)(g1 + (size_t)b * 6144 + n);
                            float4 o; o.x = xi.x + gg.x * acc[i][j][4 * g]; o.y = xi.y + gg.y * acc[i][j][4 * g + 1]; o.z = xi.z + gg.z * acc[i][j][4 * g + 2]; o.w = xi.w + gg.w * acc[i][j][4 * g + 3];
                            *(float4*)(p->out + (size_t)tok * DM + n) = o;
                        }
                    }
                }
            });
    }
}

__device__ __forceinline__ bool moe_tile(const int* cnt, int tile, int& cls, int& pos0, int& n) {
    int tb = 0;
    for (int c = 0; c < NCLS; ++c) {
        const int nc = cnt[c * 64], nt = (nc + 127) >> 7;
        if (tile < tb + nt) { cls = c; pos0 = (tile - tb) * 128; n = nc; return true; }
        tb += nt;
    }
    return false;
}
__device__ __forceinline__ void cls_experts(int cls, int& e1, int& e2) {
    const int g = cls / 6, pi = cls % 6;
    const int a = pi < 3 ? 0 : (pi < 5 ? 1 : 2);
    const int b = pi < 3 ? pi + 1 : (pi < 5 ? pi - 1 : 3);
    e1 = g * 4 + a; e2 = g * 4 + b;
}
__device__ __forceinline__ void phase_moe_up(KP p, char* lds, int l) {
    const int* cnt = p->cnt + l * 32 * 64;
    for (int u = BID(); u < (256 + NCLS) * 8; u += gridDim.x) {
        const int xl = u & 7, Lx = u >> 3;
        const int nt = Lx & 7, tile = (Lx >> 3) * 8 + xl;
        int cls, pos0, nc;
        if (!moe_tile(cnt, tile, cls, pos0, nc)) continue;
        int e1, e2; cls_experts(cls, e1, e2);
        const int slot = nt >> 2;
        const half_t* W = p->Wt_gu + ((size_t)(l * 16 + (slot ? e2 : e1)) * 512 + (nt & 3) * 128) * 1024;
        const int* lst = p->lists + (size_t)cls * T_TOK + pos0;
        const int nvalid = nc - pos0;
        gemm_tile(lds, 16,
            [&](int kt, int row) { return W + (size_t)row * 1024 + kt * 64; },
            [&](int row) { const int tok = lst[row < nvalid ? row : 0]; return p->hn + (size_t)tok * DM; },
            [&](f16v (&acc)[2][2], int wn, int wm, int lane) {
                const int hh = lane >> 5;
#pragma unroll
                for (int j = 0; j < 2; ++j) {
                    const int row = wm * 64 + j * 32 + (lane & 31);
                    if (row < nvalid) {
                        const int tok = lst[row];
                        const float wgt = p->tokw[(size_t)tok * 2 + slot];
                        half_t* dst = p->act + (size_t)tok * 512 + slot * 256 + ((nt & 3) * 2 + wn) * 32 + 4 * hh;
#pragma unroll
                        for (int g = 0; g < 4; ++g) {
                            float a[4];
#pragma unroll
                            for (int r = 0; r < 4; ++r) { const float gv = acc[0][j][4 * g + r], uv = acc[1][j][4 * g + r]; a[r] = gv * sigmoidf_(gv) * uv * wgt; }
                            *(h4*)(dst + 8 * g) = pack4(a[0], a[1], a[2], a[3]);
                        }
                    }
                }
            });
    }
}
__device__ __forceinline__ void phase_moe_down(KP p, char* lds, int l, float gsc) {
    const int* cnt = p->cnt + l * 32 * 64;
    const float* g2 = p->modf + (size_t)l * 16 * 6144 + 5 * 1024;
    for (int u = BID(); u < (256 + NCLS) * 8; u += gridDim.x) {
        const int xl = u & 7, Lx = u >> 3;
        const int nt = Lx & 7, tile = (Lx >> 3) * 8 + xl;
        int cls, pos0, nc;
        if (!moe_tile(cnt, tile, cls, pos0, nc)) continue;
        int e1, e2; cls_experts(cls, e1, e2);
        const half_t* W1 = p->Wt_d + ((size_t)(l * 16 + e1) * 1024 + nt * 128) * 256;
        const half_t* W2 = p->Wt_d + ((size_t)(l * 16 + e2) * 1024 + nt * 128) * 256;
        const int* lst = p->lists + (size_t)cls * T_TOK + pos0;
        const int nvalid = nc - pos0;
        gemm_tile(lds, 8,
            [&](int kt, int row) { return (kt < 4 ? W1 : W2) + (size_t)row * 256 + (kt & 3) * 64; },
            [&](int row) { const int tok = lst[row < nvalid ? row : 0]; return p->act + (size_t)tok * 512; },
            [&](f16v (&acc)[2][2], int wn, int wm, int lane) {
                const int hh = lane >> 5;
#pragma unroll
                for (int j = 0; j < 2; ++j) {
                    const int row = wm * 64 + j * 32 + (lane & 31);
                    if (row < nvalid) {
                        const int tok = lst[row];
                        const int b = tok >> 11;
#pragma unroll
                        for (int i = 0; i < 2; ++i) {
                            const int nb = nt * 128 + wn * 64 + i * 32 + 4 * hh;
#pragma unroll
                            for (int g = 0; g < 4; ++g) {
                                const int n = nb + 8 * g;
                                float4* xp = (float4*)(p->out + (size_t)tok * DM + n);
                                float4 xi = *xp;
                                const float4 gg = *(const float4*)(g2 + (size_t)b * 6144 + n);
                                xi.x += gsc * gg.x * acc[i][j][4 * g]; xi.y += gsc * gg.y * acc[i][j][4 * g + 1]; xi.z += gsc * gg.z * acc[i][j][4 * g + 2]; xi.w += gsc * gg.w * acc[i][j][4 * g + 3];
                                *xp = xi;
                            }
                        }
                    }
                }
            });
    }
}

__device__ __forceinline__ void dsa_select_unit(KP p, char* lds, int b, int qt) {
    unsigned* hist = (unsigned*)lds;
    unsigned* maskl = hist + 16 * 257 + 16;
    unsigned* stP = maskl + 1024;
    unsigned* stNeed = stP + 16;
    unsigned* stDone = stNeed + 16;
    unsigned* flag = stDone + 16;
    unsigned* dummyb = flag + 16;
    const int tid = TID(), lane = tid & 63, wave = tid >> 6;
    const int q0 = qt * 16, tokbase = b * SEQ;
    __syncthreads();
    if (q0 < 256) {
        for (int i = tid; i < 1024; i += 256) {
            const int q = i >> 6, wd = i & 63;
            const int n = q0 + q + 1 - 32 * wd;
            const unsigned w = n >= 32 ? 0xFFFFFFFFu : (n <= 0 ? 0u : ((1u << n) - 1u));
            p->dmask[(size_t)(tokbase + q0 + q) * 64 + wd] = w;
        }
        return;
    }
    for (int i = tid; i < 1024; i += 256) maskl[i] = 0u;
    if (tid < 16) { stP[tid] = 0u; stNeed[tid] = 256u; stDone[tid] = 0u; }
    const int ql = lane & 15, fq = lane >> 4;
    const int tq = q0 + ql;
    const half_t* Pb = p->P + (size_t)tokbase * NP;
    h8 iqf[4];
#pragma unroll
    for (int hd = 0; hd < 4; ++hd) iqf[hd] = *(const h8*)(Pb + (size_t)tq * NP + PC_IQ + hd * 32 + 8 * fq);
    const float4 iw4 = *(const float4*)(p->iwf + (size_t)(tokbase + tq) * 4);
    const float wsc0 = iw4.x * 0.08838834764831845f, wsc1 = iw4.y * 0.08838834764831845f, wsc2 = iw4.z * 0.08838834764831845f, wsc3 = iw4.w * 0.08838834764831845f;
    const int ng = qt + 1;
    unsigned sc[32][4];
    const half_t* ikp = Pb + (size_t)ql * NP + PC_IK + 8 * fq;
#pragma unroll
    for (int gb = 0; gb < 4; ++gb) {
        h8 ik[8];
#pragma unroll
        for (int x = 0; x < 8; ++x) {
            int g = wave + 4 * (gb * 8 + x);
            g = g < ng ? g : ng - 1;
            ik[x] = *(const h8*)(ikp + (size_t)(16 * g) * NP);
        }
#pragma unroll
        for (int x = 0; x < 8; ++x) {
            const int gi = gb * 8 + x;
            const int g = wave + 4 * gi;
            const f4v z = {0.f, 0.f, 0.f, 0.f};
            const f4v c0 = __builtin_amdgcn_mfma_f32_16x16x32_f16(ik[x], iqf[0], z, 0, 0, 0);
            const f4v c1 = __builtin_amdgcn_mfma_f32_16x16x32_f16(ik[x], iqf[1], z, 0, 0, 0);
            const f4v c2 = __builtin_amdgcn_mfma_f32_16x16x32_f16(ik[x], iqf[2], z, 0, 0, 0);
            const f4v c3 = __builtin_amdgcn_mfma_f32_16x16x32_f16(ik[x], iqf[3], z, 0, 0, 0);
#pragma unroll
            for (int r = 0; r < 4; ++r) {
                const int j = 16 * g + 4 * fq + r;
                float sv = wsc0 * __builtin_amdgcn_fmed3f(c0[r], 0.f, INFINITY);
                sv = fmaf(wsc1, __builtin_amdgcn_fmed3f(c1[r], 0.f, INFINITY), sv);
                sv = fmaf(wsc2, __builtin_amdgcn_fmed3f(c2[r], 0.f, INFINITY), sv);
                sv = fmaf(wsc3, __builtin_amdgcn_fmed3f(c3[r], 0.f, INFINITY), sv);
                sv += 0.0f;
                const int sb = __float_as_int(sv);
                const unsigned su = (unsigned)sb ^ ((unsigned)(sb >> 31) | 0x80000000u);
                const unsigned ck = (su & 0xFFFFF800u) | (unsigned)(2047 - j);
                sc[gi][r] = (g < ng && j <= tq) ? ck : 0u;
            }
        }
    }
    bool alldone = false;
    for (int pass = 0; pass < 5; ++pass) {
        const bool fin = alldone;
        if (!fin) { for (int i = tid; i < 16 * 257; i += 256) hist[i] = 0u; }
        if (tid == 0) *flag = 0u;
        __syncthreads();
        const unsigned sP = stP[ql], sDone = stDone[ql];
        int wv = wave, fqv = fq;
        asm volatile("" : "+v"(wv), "+v"(fqv));
        if (fin) {
            const int sh = (int)(32u - 8u * (sDone ? sDone : 1u));
            unsigned* mrow = maskl + ql * 64;
#pragma unroll
            for (int gi = 0; gi < 32; ++gi) {
                const int g = wv + 4 * gi;
                unsigned nib = 0u;
#pragma unroll
                for (int r = 0; r < 4; ++r) {
                    const unsigned uu = sc[gi][r];
                    nib |= ((uu >> sh) >= sP) ? (1u << r) : 0u;
                }
                if (g < ng) atomicOr(&mrow[g >> 1], nib << ((g & 1) * 16 + 4 * fqv));
            }
        } else {
            const int shm = pass ? 32 - 8 * pass : 0, shd = 24 - 8 * pass;
            const unsigned orm = pass ? 0u : 0xFFFFFFFFu;
            const unsigned cmpv = pass ? (sDone == 0u ? sP : 0xFFFFFFFFu) : 0xFFFFFFFFu;
            unsigned* hrow = hist + ql * 257;
            unsigned* dummy = dummyb + lane;
#pragma unroll
            for (int gi = 0; gi < 32; ++gi) {
                const int g = wv + 4 * gi;
                if (g < ng) {
#pragma unroll
                    for (int r = 0; r < 4; ++r) {
                        const unsigned uu = sc[gi][r];
                        const bool match = (((uu >> shm) | orm) == cmpv);
                        const unsigned dig = (uu >> shd) & 255u;
                        unsigned* a = match ? hrow + dig : dummy;
                        atomicAdd(a, 1u);
                    }
                }
            }
        }
        __syncthreads();
        if (fin) break;
        {
            const int qq = tid >> 4, seg = tid & 15;
            const bool active = (stDone[qq] == 0u);
            unsigned c16 = 0u;
            if (active) {
#pragma unroll
                for (int d = 0; d < 16; ++d) c16 += hist[qq * 257 + seg * 16 + d];
            }
            unsigned v = c16;
#pragma unroll
            for (int off = 1; off < 16; off <<= 1) { const unsigned t = __shfl_down(v, off, 16); if (seg + off < 16) v += t; }
            const unsigned suf = v - c16;
            const unsigned need = stNeed[qq];
            if (active && suf < need && need <= suf + c16) {
                unsigned run = suf, D = 0u, cD = 0u, nn = need;
                for (int d = 15; d >= 0; --d) {
                    const unsigned cc = hist[qq * 257 + seg * 16 + d];
                    if (run + cc >= need) { D = (unsigned)(seg * 16 + d); cD = cc; nn = need - run; break; }
                    run += cc;
                }
                const bool done = (cD == nn) || pass == 3;
                stP[qq] = (stP[qq] << 8) | D; stNeed[qq] = nn;
                if (done) stDone[qq] = (unsigned)(pass + 1); else atomicAdd(flag, 1u);
            }
        }
        __syncthreads();
        alldone = (*flag == 0u);
    }
    for (int i = tid; i < 1024; i += 256) p->dmask[(size_t)(tokbase + q0 + (i >> 6)) * 64 + (i & 63)] = maskl[i];
}

__device__ __forceinline__ void conv_unit(KP p, char* lds, int l, int b, int c) {
    float* a = (float*)lds;
    float* red = a + 62 * 256;
    const int ch = TID(), lane = ch & 63, wave = ch >> 6;
    const int t0 = c * 32, tokbase = b * SEQ;
    __syncthreads();
#pragma unroll 1
    for (int r0 = 0; r0 < 64; r0 += 8) {
        half_t uu[8], gg[8];
#pragma unroll
        for (int i = 0; i < 8; ++i) {
            int rr = r0 + i; rr = rr < 62 ? rr : 61;
            int tt = t0 - 30 + rr; tt = tt >= 0 ? tt : t0;
            const half_t* r = p->P + (size_t)(tokbase + tt) * NP;
            uu[i] = r[PC_CU + ch]; gg[i] = r[PC_CG + ch];
        }
#pragma unroll
        for (int i = 0; i < 8; ++i) {
            const int rr = r0 + i;
            const float av = (t0 - 30 + rr >= 0) ? (float)uu[i] * sigmoidf_((float)gg[i]) : 0.f;
            if (rr < 62) a[rr * 256 + ch] = av;
        }
    }
    float w[31];
#pragma unroll
    for (int i = 0; i < 31; ++i) w[i] = p->w_dw[(l * 31 + i) * 256 + ch];
    const float bias = p->b_dw[l * 256 + ch];
    float y[32];
#pragma unroll
    for (int tk = 0; tk < 32; ++tk) {
        float s = bias;
#pragma unroll
        for (int i = 0; i < 31; ++i) s = fmaf(a[(tk + i) * 256 + ch], w[i], s);
        y[tk] = s;
        float s1 = s, s2 = s * s;
#pragma unroll
        for (int o = 32; o >= 1; o >>= 1) { s1 += __shfl_xor(s1, o); s2 += __shfl_xor(s2, o); }
        if (lane == 0) { red[(tk * 4 + wave) * 2] = s1; red[(tk * 4 + wave) * 2 + 1] = s2; }
    }
    __syncthreads();
    const float lg = p->ln_g[l * 256 + ch], lb = p->ln_b[l * 256 + ch];
#pragma unroll
    for (int tk = 0; tk < 32; ++tk) {
        const float s1 = (red[tk * 8] + red[tk * 8 + 2]) + (red[tk * 8 + 4] + red[tk * 8 + 6]);
        const float s2 = (red[tk * 8 + 1] + red[tk * 8 + 3]) + (red[tk * 8 + 5] + red[tk * 8 + 7]);
        const float mu = s1 * (1.0f / 256.0f);
        float var = s2 * (1.0f / 256.0f) - mu * mu; var = var < 0.f ? 0.f : var;
        float z = (y[tk] - mu) * (1.0f / sqrtf(var + 1e-6f)) * lg + lb;
        z = z * sigmoidf_(z);
        p->ycat[(size_t)(tokbase + t0 + tk) * DM + ch] = (half_t)z;
    }
}

__device__ __forceinline__ void kmean_unit(KP p, char* lds, int b, int h, int blk) {
    float* part = (float*)lds;
    const int tid = TID(), d = tid & 63, pt = tid >> 6;
    const half_t* r = p->P + (size_t)(b * SEQ + blk * 256 + pt * 64) * NP + PC_MK + h * 64 + d;
    float s = 0.f;
    for (int k = 0; k < 64; ++k) s += (float)r[(size_t)k * NP];
    __syncthreads();
    part[pt * 64 + d] = s;
    __syncthreads();
    if (tid < 64) p->kmean[(((size_t)b * 6 + h) * 8 + blk) * 64 + tid] = ((part[tid] + part[64 + tid]) + (part[128 + tid] + part[192 + tid])) * (1.0f / 256.0f);
}

#ifndef POST_MASK
#define POST_MASK 7
#endif
__device__ __forceinline__ void phase_post(KP p, char* lds, int l, int tm) {
    const int NA = 2048, NB = 1024, NC = 768;
    for (int u = BID(); u < NA + NB + NC; u += gridDim.x) {
        if (u < NA) { if (tm & 1) dsa_select_unit(p, lds, u % 16, 127 - (u / 16)); }
        else if (u < NA + NB) { const int v = u - NA; if (tm & 2) conv_unit(p, lds, l, v % 16, v / 16); }
        else { const int v = u - NA - NB; if (tm & 4) kmean_unit(p, lds, v / 48, (v / 8) % 6, v % 8); }
    }
}

template <int MODE>
__device__ __forceinline__ void attn_unit(KP p, char* lds, int b, int h, int qt) {
    const int tid = TID(), lane = tid & 63, wave = tid >> 6, hh = lane >> 5, ql = lane & 31;
    const int q0 = qt * 128, tokbase = b * SEQ;
    const int tq = q0 + wave * 32 + ql;
    const half_t* Pb = p->P + (size_t)tokbase * NP;
    const int QOFF = MODE ? PC_MQ + h * 64 : PC_DQ + h * 64;
    const int KOFF = MODE ? PC_MK + h * 64 : PC_DK;
    const int VOFF = MODE ? PC_MV + h * 64 : PC_DV;
    const int own = qt >> 1;
    unsigned mysel = 0u, anysel = 0u;
    __syncthreads();
    if (MODE == 1) {
        float* km = (float*)(lds + 32768);
        float* gts = km + 512;
        unsigned* selq = (unsigned*)(gts + 1024);
        unsigned* anyb = selq + 128;
        for (int i = tid; i < 512; i += 256) km[i] = p->kmean[((size_t)b * 6 + h) * 512 + i];
        if (tid == 0) *anyb = 0u;
        __syncthreads();
        {
            const int q = tid & 127, hf = tid >> 7;
            if (hf * 4 < own) {
                const half_t* qr = Pb + (size_t)(q0 + q) * NP + QOFF;
                float g0 = 0.f, g1 = 0.f, g2 = 0.f, g3 = 0.f;
#pragma unroll
                for (int c8 = 0; c8 < 8; ++c8) {
                    const h8 qv = *(const h8*)(qr + c8 * 8);
#pragma unroll
                    for (int j = 0; j < 8; ++j) {
                        const float qf = (float)qv[j]; const int d = c8 * 8 + j;
                        g0 = fmaf(qf, km[(hf * 4 + 0) * 64 + d], g0); g1 = fmaf(qf, km[(hf * 4 + 1) * 64 + d], g1);
                        g2 = fmaf(qf, km[(hf * 4 + 2) * 64 + d], g2); g3 = fmaf(qf, km[(hf * 4 + 3) * 64 + d], g3);
                    }
                }
                gts[q * 8 + hf * 4 + 0] = g0; gts[q * 8 + hf * 4 + 1] = g1; gts[q * 8 + hf * 4 + 2] = g2; gts[q * 8 + hf * 4 + 3] = g3;
            }
        }
        __syncthreads();
        if (tid < 128) {
            unsigned m = 0u;
            const int want = own < 3 ? own : 3;
            for (int r = 0; r < want; ++r) {
                int best = -1; float bv = -INFINITY;
                for (int j = 0; j < own; ++j) { const float gv = gts[tid * 8 + j]; if (!((m >> j) & 1u) && (best < 0 || gv > bv)) { best = j; bv = gv; } }
                m |= 1u << best;
            }
            selq[tid] = m;
            if (m) atomicOr(anyb, m);
        }
        __syncthreads();
        mysel = selq[wave * 32 + ql];
        anysel = *anyb;
        __syncthreads();
    }
    h8 qf[4];
#pragma unroll
    for (int ks = 0; ks < 4; ++ks) qf[ks] = *(const h8*)(Pb + (size_t)tq * NP + QOFF + 16 * ks + 8 * hh);
    f16v O0, O1;
#pragma unroll
    for (int r = 0; r < 16; ++r) { O0[r] = 0.f; O1[r] = 0.f; }
    float m_run = -1e30f, l_run = 0.f;
    const float CS = 0.18033688011112042f;
    const int ntile = 2 * qt + 2;
    auto skip = [&](int kt) -> bool { return MODE == 1 && kt < 4 * own && !((anysel >> (kt >> 2)) & 1u); };
    auto nexttile = [&](int kt) -> int { ++kt; while (kt < ntile && skip(kt)) ++kt; return kt; };
    const int lrow = tid >> 3;
    const int kchunk = (tid & 7) ^ ((tid >> 4) & 7);
    const int vchunk = (tid & 7) ^ (((tid >> 4) & 1) << 2);
    char* ldst = lds + lrow * 128 + (tid & 7) * 16;
    auto issue = [&](int kt, int s) {
        const half_t* src = Pb + (size_t)(kt * 64 + lrow) * NP;
        char* d = ldst + s * 16384;
        glds16(src + KOFF + kchunk * 8, d);
        glds16(src + (size_t)32 * NP + KOFF + kchunk * 8, d + 4096);
        glds16(src + VOFF + vchunk * 8, d + 8192);
        glds16(src + (size_t)32 * NP + VOFF + vchunk * 8, d + 8192 + 4096);
    };
    const int rsw = (lane >> 1) & 7;
    const int kro = ql * 128;
    const int li = lane & 15, qp = li >> 2, pp = li & 3, swv = (qp >> 1) & 1;
    const int vb0 = 8192 + (4 * hh + qp) * 128 + 32 * ((lane >> 4) & 1) + 8 * pp + 64 * (0 ^ swv);
    const int vb1 = 8192 + (4 * hh + qp) * 128 + 32 * ((lane >> 4) & 1) + 8 * pp + 64 * (1 ^ swv);
    int kt = -1; kt = nexttile(kt);
    int s = 0;
    if (kt < ntile) issue(kt, 0);
    while (kt < ntile) {
        const int ktn = nexttile(kt);
        asm volatile("s_waitcnt vmcnt(0)" ::: "memory");
        __syncthreads();
        if (ktn < ntile) issue(ktn, s ^ 1);
        const bool wave_active = (kt * 64 <= q0 + wave * 32 + 31);
        if (wave_active) {
            const char* base = lds + s * 16384;
            uint2 mw = make_uint2(0u, 0u);
            if (MODE == 0) mw = *(const uint2*)(p->dmask + (size_t)(tokbase + tq) * 64 + 2 * kt);
            f16v s0, s1;
#pragma unroll
            for (int r = 0; r < 16; ++r) { s0[r] = 0.f; s1[r] = 0.f; }
#pragma unroll
            for (int ks = 0; ks < 4; ++ks) {
                const int co = ((2 * ks + hh) ^ rsw) << 4;
                const h8 k0 = *(const h8*)(base + kro + co), k1 = *(const h8*)(base + kro + 4096 + co);
                s0 = __builtin_amdgcn_mfma_f32_32x32x16_f16(k0, qf[ks], s0, 0, 0, 0);
                s1 = __builtin_amdgcn_mfma_f32_32x32x16_f16(k1, qf[ks], s1, 0, 0, 0);
            }
            if (MODE == 0) {
                const unsigned w0 = mw.x >> (4 * hh), w1 = mw.y >> (4 * hh);
#pragma unroll
                for (int r = 0; r < 16; ++r) {
                    const int pos = (r & 3) + 8 * (r >> 2);
                    const unsigned m0 = (unsigned)__builtin_amdgcn_sbfe((int)w0, pos, 1), m1 = (unsigned)__builtin_amdgcn_sbfe((int)w1, pos, 1);
                    s0[r] = __uint_as_float((__float_as_uint(s0[r]) & m0) | (0xFF800000u & ~m0));
                    s1[r] = __uint_as_float((__float_as_uint(s1[r]) & m1) | (0xFF800000u & ~m1));
                }
            } else {
                if (kt < 4 * own) {
                    const bool v = (mysel >> (kt >> 2)) & 1u;
                    if (!v) {
#pragma unroll
                        for (int r = 0; r < 16; ++r) { s0[r] = -INFINITY; s1[r] = -INFINITY; }
                    }
                } else if (kt * 64 + 63 > q0 + wave * 32) {
#pragma unroll
                    for (int r = 0; r < 16; ++r) {
                        const int key = kt * 64 + (r & 3) + 8 * (r >> 2) + 4 * hh;
                        s0[r] = (key <= tq) ? s0[r] : -INFINITY;
                        s1[r] = (key + 32 <= tq) ? s1[r] : -INFINITY;
                    }
                }
            }
            float mx = s0[0];
#pragma unroll
            for (int r = 1; r < 16; ++r) mx = fmaxf(mx, s0[r]);
#pragma unroll
            for (int r = 0; r < 16; ++r) mx = fmaxf(mx, s1[r]);
            mx = fmaxf(mx, __shfl_xor(mx, 32));
            const float mnew = fmaxf(m_run, mx);
            const float alpha = __builtin_amdgcn_exp2f((m_run - mnew) * CS);
            const float mc = mnew * CS;
            m_run = mnew;
            float ls = 0.f;
#pragma unroll
            for (int r = 0; r < 16; ++r) { s0[r] = __builtin_amdgcn_exp2f(fmaf(s0[r], CS, -mc)); ls += s0[r]; }
#pragma unroll
            for (int r = 0; r < 16; ++r) { s1[r] = __builtin_amdgcn_exp2f(fmaf(s1[r], CS, -mc)); ls += s1[r]; }
            l_run = l_run * alpha + ls;
            if (!__all(alpha == 1.0f)) {
#pragma unroll
                for (int r = 0; r < 16; ++r) { O0[r] *= alpha; O1[r] *= alpha; }
            }
#pragma unroll
            for (int ksub = 0; ksub < 2; ++ksub) {
#pragma unroll
                for (int sp = 0; sp < 2; ++sp) {
                    h8 pf;
#pragma unroll
                    for (int j = 0; j < 8; ++j) pf[j] = (half_t)(ksub ? s1[8 * sp + j] : s0[8 * sp + j]);
                    const int roff = (32 * ksub + 16 * sp) * 128;
                    {
                        const s4v lo = __builtin_amdgcn_ds_read_tr16_b64_v4i16((LAS s4v*)(base + vb0 + roff));
                        const s4v hi = __builtin_amdgcn_ds_read_tr16_b64_v4i16((LAS s4v*)(base + vb0 + roff + 8 * 128));
                        const h8 vf = __builtin_bit_cast(h8, __builtin_shufflevector(lo, hi, 0, 1, 2, 3, 4, 5, 6, 7));
                        O0 = __builtin_amdgcn_mfma_f32_32x32x16_f16(vf, pf, O0, 0, 0, 0);
                    }
                    {
                        const s4v lo = __builtin_amdgcn_ds_read_tr16_b64_v4i16((LAS s4v*)(base + vb1 + roff));
                        const s4v hi = __builtin_amdgcn_ds_read_tr16_b64_v4i16((LAS s4v*)(base + vb1 + roff + 8 * 128));
                        const h8 vf = __builtin_bit_cast(h8, __builtin_shufflevector(lo, hi, 0, 1, 2, 3, 4, 5, 6, 7));
                        O1 = __builtin_amdgcn_mfma_f32_32x32x16_f16(vf, pf, O1, 0, 0, 0);
                    }
                }
            }
        }
        kt = ktn; s ^= 1;
    }
    const float lt = l_run + __shfl_xor(l_run, 32);
    const float inv = 1.0f / lt;
    half_t* dst = p->ycat + (size_t)(tokbase + tq) * DM + (MODE ? 640 : 256) + h * 64 + 4 * hh;
#pragma unroll
    for (int g = 0; g < 4; ++g) {
        *(h4*)(dst + 8 * g) = pack4(O0[4 * g] * inv, O0[4 * g + 1] * inv, O0[4 * g + 2] * inv, O0[4 * g + 3] * inv);
        *(h4*)(dst + 32 + 8 * g) = pack4(O1[4 * g] * inv, O1[4 * g + 1] * inv, O1[4 * g + 2] * inv, O1[4 * g + 3] * inv);
    }
}

__device__ __forceinline__ void phase_attn(KP p, char* lds) {
    for (int u = BID(); u < 3072; u += gridDim.x) {
        const int qt = 15 - (u / 192), rem = u % 192;
        const int type = rem & 1, bh = rem >> 1;
        if (type == 0) attn_unit<0>(p, lds, bh / 6, bh % 6, qt);
        else attn_unit<1>(p, lds, bh / 6, bh % 6, qt);
    }
}

__global__ void __launch_bounds__(256, 2) mk_fwd(Params p_unused) {
    extern __shared__ __attribute__((aligned(16))) char lds[];
    volatile LAS unsigned* stw = (volatile LAS unsigned*)(lds + 65536);
    if (threadIdx.x < 4) stw[threadIdx.x] = 0u;
    __syncthreads();
    KP p0 = (KP)__builtin_amdgcn_kernarg_segment_ptr();
    XcdBarrier bar; bar.bar = p0->bar; bar.x = 0; bar.st = stw;
#if !MK_SPLIT
    bar = xcd_barrier_post(p0->bar, stw);
#endif
    const int ph_lo = p0->ph_lo, ph_hi = p0->ph_hi;
    for (int ph = ph_lo; ph < ph_hi; ++ph) {
      KP p = p0; asm volatile("" : "+s"(p));
      const int nrep = (DUP_SUB >= 0 && ((DUP_SUB == 100 && ph == 0) || (ph >= 2 && ph < NPHASE - 1 && ((ph - 2) & 7) == DUP_SUB && (DUP_SUB != 4 || ph < 10)))) ? 2 : 1;
      for (int rep = 0; rep < nrep; ++rep) {
        if (ph == 0) phase_prologue(p, lds);
        else if (ph == 1) phase_modsum(p);
        else if (ph == NPHASE - 1) phase_norm<2>(p, lds, p->out, p->g_final, nullptr, nullptr, 0);
        else {
            const int l = (ph - 2) >> 3, sub = (ph - 2) & 7;
            const float* mf = p->modf + (size_t)l * 16 * 6144;
            const float* xin = l == 0 ? p->x : p->out;
            if (sub == 0) phase_norm<0>(p, lds, xin, p->g_mix + l * DM, mf, mf + 1024, l);
            else if (sub == 1) phase_inproj(p, lds, l);
            else if (sub == 2) phase_post(p, lds, l, rep ? POST_MASK : 7);
            else if (sub == 3) phase_attn(p, lds);
            else if (sub == 4) phase_outproj(p, lds, l, xin);
            else if (sub == 5) phase_norm<1>(p, lds, p->out, p->g_ffn + l * DM, mf + 3 * 1024, mf + 4 * 1024, (nrep == 2 && rep == 0) ? l + 2 : l);
            else if (sub == 6) phase_moe_up(p, lds, l);
            else phase_moe_down(p, lds, l, nrep == 2 ? 0.5f : 1.0f);
        }
      }
#if !MK_SPLIT
        if (ph + 1 < ph_hi) xcd_barrier(bar);
#endif
    }
}

extern "C" void kernel_launch(void* const* d_in, const int* in_sizes, int n_in, void* d_out, int out_size, void* d_ws, size_t ws_size, hipStream_t stream) {
    static int grid = 0;
    if (grid == 0) {
        int dev = 0, cus = 0, per_cu = 0;
        (void)hipGetDevice(&dev);
        (void)hipDeviceGetAttribute(&cus, hipDeviceAttributeMultiprocessorCount, dev);
        (void)hipFuncSetAttribute((const void*)mk_fwd, hipFuncAttributeMaxDynamicSharedMemorySize, LDS_BYTES);
        if (hipOccupancyMaxActiveBlocksPerMultiprocessor(&per_cu, (const void*)mk_fwd, 256, LDS_BYTES) != hipSuccess || per_cu < 1) per_cu = 1;
        (void)hipGetLastError();
        if (per_cu > 2) per_cu = 2;
        grid = cus * per_cu;
        fprintf(stderr, "mk_fwd: cus %d per_cu %d grid %d\n", cus, per_cu, grid);
    }
    Params p{};
    const float** pin = (const float**)&p.x;
    for (int i = 0; i < 18; ++i) pin[i] = (const float*)d_in[i];
    p.out = (float*)d_out;
    char* ws = (char*)d_ws;
    size_t off = 0;
    auto carve = [&](size_t bytes) { void* q = ws + off; off += (bytes + 255) & ~(size_t)255; return q; };
    p.bar = (unsigned*)carve(XCD_BAR_WORDS * 4);
    p.cnt = (int*)carve(4 * 32 * 64 * 4);
    const size_t zero_bytes = off;
    p.Wt_in = (half_t*)carve((size_t)2 * NP * DM * 2);
    p.Wt_o = (half_t*)carve((size_t)2 * DM * DM * 2);
    p.Wt_gu = (half_t*)carve((size_t)2 * 16 * 512 * 1024 * 2);
    p.Wt_d = (half_t*)carve((size_t)2 * 16 * 1024 * 256 * 2);
    p.hn = (half_t*)carve((size_t)T_TOK * DM * 2);
    p.P = (half_t*)carve((size_t)T_TOK * NP * 2);
    p.ycat = (half_t*)carve((size_t)T_TOK * DM * 2);
    p.act = (half_t*)carve((size_t)T_TOK * 512 * 2);
    p.modpart = (float*)carve((size_t)8 * 2 * 16 * 6144 * 4);
    p.modf = (float*)carve((size_t)2 * 16 * 6144 * 4);
    p.kmean = (float*)carve((size_t)16 * 6 * 8 * 64 * 4);
    p.rope = (float*)carve((size_t)2048 * 24 * 4);
    p.iwf = (float*)carve((size_t)T_TOK * 4 * 4);
    p.tokw = (float*)carve((size_t)T_TOK * 2 * 4);
    p.dmask = (unsigned*)carve((size_t)T_TOK * 64 * 4);
    p.lists = (int*)carve((size_t)NCLS * T_TOK * 4);
    if (off > ws_size) { fprintf(stderr, "workspace too small: need %zu have %zu\n", off, ws_size); return; }
    (void)hipMemsetAsync(d_ws, 0, zero_bytes, stream);
#if MK_SPLIT
    for (int ph = 0; ph < NPHASE; ++ph) {
        p.ph_lo = ph; p.ph_hi = ph + 1;
        hipLaunchKernelGGL(mk_fwd, dim3(grid), dim3(256), LDS_BYTES, stream, p);
    }
#else
    p.ph_lo = 0; p.ph_hi = NPHASE;
    hipLaunchKernelGGL(mk_fwd, dim3(grid), dim3(256), LDS_BYTES, stream, p);
#endif
}
```

```cpp
#include <hip/hip_runtime.h>
#include <cstdio>
#include <cstdint>

#ifndef MK_SPLIT
#define MK_SPLIT 0
#endif

#define T_TOK 32768
#define DM 1024
#define SEQ 2048
#define INW 2340
#define NP 2432
#define PC_CU 0
#define PC_CG 256
#define PC_DQ 512
#define PC_DK 896
#define PC_DV 960
#define PC_IQ 1024
#define PC_IK 1152
#define PC_IW 1184
#define PC_MQ 1280
#define PC_MK 1664
#define PC_MV 2048
#define LOG_THETA 13.122363377404328f
#define NCLS 24
#define LDS_CTL 73728
#define LDS_BYTES 78336
#define NPHASE 19
#ifndef DUP_SUB
#define DUP_SUB -1
#endif

typedef _Float16 half_t;
typedef _Float16 h8 __attribute__((ext_vector_type(8)));
typedef _Float16 h4 __attribute__((ext_vector_type(4)));
typedef short s4v __attribute__((ext_vector_type(4)));
typedef short s8v __attribute__((ext_vector_type(8)));
typedef float f16v __attribute__((ext_vector_type(16)));
typedef float f4v __attribute__((ext_vector_type(4)));
#define LAS __attribute__((address_space(3)))

struct Params {
    const float *x, *c, *w_ada, *b_ada, *g_mix, *w_in, *w_dw, *b_dw, *ln_g, *ln_b, *w_o, *g_ffn, *w_router, *b_router, *w_gate, *w_up, *w_down, *g_final;
    float* out;
    half_t *Wt_in, *Wt_o, *Wt_gu, *Wt_d, *hn, *P, *ycat, *act;
    float *modpart, *modf, *kmean, *rope, *iwf, *tokw;
    unsigned* dmask; int* cnt; int* lists; unsigned* bar;
    int ph_lo, ph_hi;
};

#define XB_TMO      128
#define XB_XCNT(j)  (256  + 64 * (j))
#define XB_XSUB(j)  (1280 + 64 * (j))
#define XB_XGEN(j)  (2304 + 64 * (j))
#define XB_TOP      3328
#define XB_TOPGEN   3392
#define XCD_BAR_WORDS 3456
#define XB_SPIN_CAP (1u << 20)
__device__ __forceinline__ unsigned xb_ld(unsigned* p)              { return __hip_atomic_load(p, __ATOMIC_RELAXED, __HIP_MEMORY_SCOPE_AGENT); }
__device__ __forceinline__ unsigned xb_add(unsigned* p, unsigned v) { return __hip_atomic_fetch_add(p, v, __ATOMIC_RELAXED, __HIP_MEMORY_SCOPE_AGENT); }
__device__ __forceinline__ unsigned xb_xcc_id() { return (unsigned)__builtin_amdgcn_s_getreg((3 << 11) | 20) & 0xFu; }
#define XB_SPIN(cond, bar) do { unsigned _sp = 0; while (cond) { __builtin_amdgcn_s_sleep(1); \
    if ((++_sp & 255u) == 0u) { if (xb_ld(&(bar)[XB_TMO])) break; if (_sp > XB_SPIN_CAP) { atomicAdd(&(bar)[XB_TMO], 1u); break; } } } } while (0)
struct XcdBarrier { unsigned* bar; unsigned x; volatile LAS unsigned* st; };
__device__ __forceinline__ XcdBarrier xcd_barrier_post(unsigned* bar, volatile LAS unsigned* st) {
    XcdBarrier b; b.bar = bar; b.x = xb_xcc_id(); b.st = st;
    if (threadIdx.x == 0) (void)xb_add(&bar[XB_XCNT(b.x)], 1u);
    return b;
}
__device__ __forceinline__ void xcd_barrier_complete(unsigned* bar, unsigned x, unsigned& nloc, unsigned& nx) {
    const unsigned G = gridDim.x * gridDim.y * gridDim.z;
    unsigned sum, cnt, mine, sp = 0u;
    for (;;) {
        sum = 0u; cnt = 0u; mine = 0u;
#pragma unroll
        for (unsigned j = 0; j < 16; ++j) { const unsigned c = xb_ld(&bar[XB_XCNT(j)]); sum += c; cnt += (c > 0u) ? 1u : 0u; mine = (j == x) ? c : mine; }
        if (sum == G) break;
        __builtin_amdgcn_s_sleep(1);
        if ((++sp & 255u) == 0u) { if (xb_ld(&bar[XB_TMO])) break; if (sp > XB_SPIN_CAP) { atomicAdd(&bar[XB_TMO], 1u); break; } }
    }
    nloc = mine > 0u ? mine : 1u; nx = cnt > 0u ? cnt : 1u;
}
__device__ __forceinline__ void xcd_barrier(const XcdBarrier& b) {
    asm volatile("s_waitcnt vmcnt(0)" ::: "memory");
    __syncthreads();
    if (threadIdx.x == 0) {
        unsigned* bar = b.bar;
        __builtin_amdgcn_s_waitcnt(0);
        unsigned nloc = b.st[0], nx = b.st[1];
        if (nloc == 0u) { xcd_barrier_complete(bar, b.x, nloc, nx); b.st[0] = nloc; b.st[1] = nx; }
        const unsigned old = xb_add(&bar[XB_XSUB(b.x)], 1u);
        const unsigned gen = old / nloc;
        if (old + 1u == (gen + 1u) * nloc) {
            __builtin_amdgcn_fence(__ATOMIC_RELEASE, "agent");
            asm volatile("s_waitcnt vmcnt(0)" ::: "memory");
            const unsigned og = xb_add(&bar[XB_TOP], 1u);
            const unsigned tg = og / nx;
            if (og + 1u == (tg + 1u) * nx) xb_add(&bar[XB_TOPGEN], 1u);
            else XB_SPIN(xb_ld(&bar[XB_TOPGEN]) == tg, bar);
            __builtin_amdgcn_fence(__ATOMIC_ACQUIRE, "agent");
            xb_add(&bar[XB_XGEN(b.x)], 1u);
            asm volatile("s_waitcnt vmcnt(0)" ::: "memory");
        } else {
            XB_SPIN(xb_ld(&bar[XB_XGEN(b.x)]) == gen, bar);
            __builtin_amdgcn_fence(__ATOMIC_ACQUIRE, "agent");
            asm volatile("s_waitcnt vmcnt(0)" ::: "memory");
        }
    }
    __syncthreads();
}

typedef const __attribute__((address_space(4))) Params* KP;
__device__ __forceinline__ int TID() { int t = threadIdx.x; asm volatile("" : "+v"(t)); return t; }
__device__ __forceinline__ int BID() { int b = blockIdx.x; asm volatile("" : "+s"(b)); return b; }
__device__ __forceinline__ float sigmoidf_(float v) { return 1.0f / (1.0f + __expf(-v)); }
__device__ __forceinline__ void glds16(const void* g, char* l) { __builtin_amdgcn_global_load_lds((const unsigned*)g, (unsigned*)l, 16, 0, 0); }
__device__ __forceinline__ unsigned f2sortable(float f) { unsigned u = __float_as_uint(f); return (u & 0x80000000u) ? ~u : (u | 0x80000000u); }
__device__ __forceinline__ h4 pack4(float a, float b, float c, float d) { h4 r = {(half_t)a, (half_t)b, (half_t)c, (half_t)d}; return r; }

template <class CF>
__device__ __forceinline__ void conv_tile_panel(char* lds, CF colf, int src_ld, int k0, int n0, half_t* dst, int nrows) {
    float* tl = (float*)lds;
    const int tid = TID();
    __syncthreads();
    {
        const int nn = tid & 63;
        const float* cp = colf(nn);
#pragma unroll 4
        for (int i = 0; i < 16; ++i) { const int k = i * 4 + (tid >> 6); tl[k * 65 + nn] = cp ? cp[(size_t)(k0 + k) * src_ld] : 0.f; }
    }
    __syncthreads();
    {
        const int n = tid >> 2, kq = (tid & 3) * 16;
        h8 a, b;
#pragma unroll
        for (int j = 0; j < 8; ++j) { a[j] = (half_t)tl[(kq + j) * 65 + n]; b[j] = (half_t)tl[(kq + 8 + j) * 65 + n]; }
        const int k = k0 + kq;
        h8* d = (h8*)(dst + ((size_t)(k >> 5) * nrows + n0 + n) * 32 + (k & 31));
        d[0] = a; d[1] = b;
    }
}
template <class CF>
__device__ __forceinline__ void conv_tile(char* lds, CF colf, int src_ld, int k0, half_t* dst_tile  , int dstK) {
    float* tl = (float*)lds;
    const int tid = TID();
    __syncthreads();
    {
        const int nn = tid & 63;
        const float* cp = colf(nn);
#pragma unroll 4
        for (int i = 0; i < 16; ++i) { const int k = i * 4 + (tid >> 6); tl[k * 65 + nn] = cp ? cp[(size_t)(k0 + k) * src_ld] : 0.f; }
    }
    __syncthreads();
    {
        const int n = tid >> 2, kq = (tid & 3) * 16;
        h8 a, b;
#pragma unroll
        for (int j = 0; j < 8; ++j) { a[j] = (half_t)tl[(kq + j) * 65 + n]; b[j] = (half_t)tl[(kq + 8 + j) * 65 + n]; }
        h8* d = (h8*)(dst_tile + (size_t)n * dstK + kq);
        d[0] = a; d[1] = b;
    }
}

__device__ __forceinline__ void phase_prologue(KP p, char* lds) {
    const int tid = TID();
    const int NA = 2 * 16 * 38, NB = 2 * 16 * 16, NC = 2 * 16 * 16 * 8, ND = 2 * 16 * 4 * 16, NE = 384, NF = 8;
    const int total = NA + NB + NC + ND + NE + NF;
    for (int u0 = BID(); u0 < total; u0 += gridDim.x) {
        int u = u0;
        if (u < NA) {
            const int nt = u % 38, kt = (u / 38) % 16, l = u / (38 * 16);
            const float* src = p->w_in + (size_t)l * DM * INW;
            const int n0 = nt * 64;
            conv_tile_panel(lds, [&](int nn) -> const float* { const int np = n0 + nn; const int sc = np < 1188 ? np : (np < 1280 ? -1 : np - 92); return sc >= 0 ? src + sc : (const float*)nullptr; },
                      INW, kt * 64, n0, p->Wt_in + (size_t)l * NP * DM, NP);
            continue;
        }
        u -= NA;
        if (u < NB) {
            const int nt = u % 16, kt = (u / 16) % 16, l = u / 256;
            const float* src = p->w_o + (size_t)l * DM * DM + nt * 64;
            conv_tile_panel(lds, [&](int nn) -> const float* { return src + nn; }, DM, kt * 64, nt * 64, p->Wt_o + (size_t)l * DM * DM, DM);
            continue;
        }
        u -= NB;
        if (u < NC) {
            const int nt = u % 8, kt = (u / 8) % 16, le = u / 128;
            const float* sg = p->w_gate + (size_t)le * 1024 * 256 + nt * 32;
            const float* su = p->w_up + (size_t)le * 1024 * 256 + nt * 32;
            conv_tile(lds, [&](int nn) -> const float* { return nn < 32 ? sg + nn : su + (nn - 32); }, 256, kt * 64, p->Wt_gu + ((size_t)le * 512 + nt * 64) * 1024 + kt * 64, 1024);
            continue;
        }
        u -= NC;
        if (u < ND) {
            const int nt = u % 16, kt = (u / 16) % 4, le = u / 64;
            const float* src = p->w_down + (size_t)le * 256 * 1024 + nt * 64;
            conv_tile(lds, [&](int nn) -> const float* { return src + nn; }, 1024, kt * 64, p->Wt_d + ((size_t)le * 1024 + nt * 64) * 256 + kt * 64, 256);
            continue;
        }
        u -= ND;
        if (u < NE) {
            const int kc = u % 8, cc = (u / 8) % 24, l = u / 192;
            float* ca = (float*)lds;
            __syncthreads();
            for (int i = tid; i < 2048; i += 256) { const int b = i >> 7, k = i & 127; const float v = p->c[b * 1024 + kc * 128 + k]; ca[i] = v / (1.0f + expf(-v)); }
            __syncthreads();
            const int n = cc * 256 + tid;
            float acc[16];
#pragma unroll
            for (int b = 0; b < 16; ++b) acc[b] = 0.f;
            const float* w = p->w_ada + ((size_t)l * 1024 + kc * 128) * 6144 + n;
#pragma unroll 4
            for (int k = 0; k < 128; ++k) {
                const float wv = w[(size_t)k * 6144];
#pragma unroll
                for (int b = 0; b < 16; ++b) acc[b] = fmaf(ca[b * 128 + k], wv, acc[b]);
            }
#pragma unroll
            for (int b = 0; b < 16; ++b) p->modpart[(((size_t)kc * 2 + l) * 16 + b) * 6144 + n] = acc[b];
            continue;
        }
        u -= NE;
        {
            for (int i = u * 256 + tid; i < 2048 * 12; i += NF * 256) {
                const int t = i / 12, r = i % 12;
                const int fi = r < 8 ? r : r - 8;
                const float rot = r < 8 ? 16.f : 8.f;
                const float inv = expf(-LOG_THETA * ((float)fi * 2.0f / rot));
                const float ang = (float)t * inv;
                float sn, cs; sincosf(ang, &sn, &cs);
                if (r < 8) { p->rope[t * 8 + fi] = cs; p->rope[16384 + t * 8 + fi] = sn; }
                else { p->rope[32768 + t * 4 + fi] = cs; p->rope[32768 + 8192 + t * 4 + fi] = sn; }
            }
        }
    }
}

__device__ __forceinline__ void phase_modsum(KP p) {
    for (int i = BID() * 256 + TID(); i < 2 * 16 * 6144; i += gridDim.x * 256) {
        const int n = i % 6144, l = i / (16 * 6144);
        float s = p->b_ada[l * 6144 + n];
#pragma unroll
        for (int kc = 0; kc < 8; ++kc) s += p->modpart[(size_t)kc * (2 * 16 * 6144) + i];
        p->modf[i] = s;
    }
}

__device__ __forceinline__ void route_flush(KP p, char* lds, int lane, int wave, int n, int myrow, int layer) {
    const float* lg = (const float*)(lds + LDS_CTL + 512) + wave * 256;
    int* lc = (int*)(lds + LDS_CTL + 64);
    int* lbase = lc + 32;
    const int tid = wave * 64 + lane;
    if (tid < 32) lc[tid] = 0;
    __syncthreads();
    int cls = 0, lpos = 0;
    if (lane < n) {
        float aff[16], bia[16];
#pragma unroll
        for (int e = 0; e < 16; ++e) { aff[e] = 1.0f / (1.0f + expf(-lg[lane * 16 + e])); bia[e] = aff[e] + p->b_router[e]; }
        int bestg = 0; float bests = -INFINITY;
#pragma unroll
        for (int gi = 0; gi < 4; ++gi) {
            float m1 = -INFINITY, m2 = -INFINITY;
#pragma unroll
            for (int j = 0; j < 4; ++j) { const float vv = bia[gi * 4 + j]; if (vv > m1) { m2 = m1; m1 = vv; } else if (vv > m2) m2 = vv; }
            const float s = m1 + m2;
            if (s > bests) { bests = s; bestg = gi; }
        }
        float bsel[4], asel[4];
#pragma unroll
        for (int j = 0; j < 4; ++j) { bsel[j] = 0.f; asel[j] = 0.f; }
#pragma unroll
        for (int gi = 0; gi < 4; ++gi) if (gi == bestg) {
#pragma unroll
            for (int j = 0; j < 4; ++j) { bsel[j] = bia[gi * 4 + j]; asel[j] = aff[gi * 4 + j]; }
        }
        int i1 = -1, i2 = -1; float v1 = -INFINITY, v2 = -INFINITY;
#pragma unroll
        for (int j = 0; j < 4; ++j) { const float vv = bsel[j]; if (vv > v1) { v2 = v1; i2 = i1; v1 = vv; i1 = j; } else if (vv > v2) { v2 = vv; i2 = j; } }
        const int a = i1 < i2 ? i1 : i2, bb = i1 < i2 ? i2 : i1;
        float wa = 0.f, wb = 0.f;
#pragma unroll
        for (int j = 0; j < 4; ++j) { if (j == a) wa = asel[j]; if (j == bb) wb = asel[j]; }
        const float sw = wa + wb;
        const int pi = (a == 0) ? (bb - 1) : (a == 1 ? (bb + 1) : 5);
        cls = bestg * 6 + pi;
        *(float2*)(p->tokw + (size_t)myrow * 2) = make_float2(wa / sw, wb / sw);
        lpos = atomicAdd(&lc[cls], 1);
    }
    __syncthreads();
    if (tid < NCLS) { const int c = lc[tid]; lbase[tid] = c ? atomicAdd(&p->cnt[(layer * 32 + tid) * 64], c) : 0; }
    __syncthreads();
    if (lane < n) p->lists[(size_t)cls * T_TOK + lbase[cls] + lpos] = myrow;
}

template <int MODE>
__device__ __forceinline__ void phase_norm(KP p, char* lds, const float* xin, const float* g, const float* sh, const float* sc, int layer) {
    const int lane = TID() & 63, wave = TID() >> 6;
    float* wt = (float*)lds;
    if (MODE == 1) {
        __syncthreads();
        for (int i = TID(); i < 4096; i += 256) {
            const float4 w4 = ((const float4*)p->w_router)[i];
            const int k = i >> 2, e0 = (i & 3) * 4;
            wt[(e0 + 0) * 1024 + k] = w4.x; wt[(e0 + 1) * 1024 + k] = w4.y; wt[(e0 + 2) * 1024 + k] = w4.z; wt[(e0 + 3) * 1024 + k] = w4.w;
        }
        __syncthreads();
    }
    float* lgb = (float*)(lds + LDS_CTL + 512);
    int myrow = 0, it = 0;
    for (int row = BID() * 4 + wave; row < T_TOK; row += gridDim.x * 4) {
        const int b = row >> 11;
        const float4* xr = (const float4*)(xin + (size_t)row * DM);
        float4 v[4]; float ss = 0.f;
#pragma unroll
        for (int i = 0; i < 4; ++i) { v[i] = xr[lane + 64 * i]; ss += v[i].x * v[i].x + v[i].y * v[i].y + v[i].z * v[i].z + v[i].w * v[i].w; }
#pragma unroll
        for (int o = 32; o >= 1; o >>= 1) ss += __shfl_xor(ss, o);
        const float rstd = 1.0f / sqrtf(ss * (1.0f / 1024.0f) + 1e-6f);
        float acc[16], ya[16];
#pragma unroll
        for (int i = 0; i < 4; ++i) {
            const int k = (lane + 64 * i) * 4;
            const float4 gg = *(const float4*)(g + k);
            float y[4] = {v[i].x * rstd * gg.x, v[i].y * rstd * gg.y, v[i].z * rstd * gg.z, v[i].w * rstd * gg.w};
            if (MODE != 2) {
                const float4 s1 = *(const float4*)(sh + (size_t)b * 6144 + k), s2 = *(const float4*)(sc + (size_t)b * 6144 + k);
                y[0] = y[0] * (1.f + s2.x) + s1.x; y[1] = y[1] * (1.f + s2.y) + s1.y; y[2] = y[2] * (1.f + s2.z) + s1.z; y[3] = y[3] * (1.f + s2.w) + s1.w;
                if (MODE == 0) *(h4*)(p->hn + ((size_t)(k >> 5) * T_TOK + row) * 32 + (k & 31)) = pack4(y[0], y[1], y[2], y[3]);
                else *(h4*)(p->hn + (size_t)row * DM + k) = pack4(y[0], y[1], y[2], y[3]);
            } else {
                *(float4*)(p->out + (size_t)row * DM + k) = make_float4(y[0], y[1], y[2], y[3]);
            }
            ya[4 * i] = y[0]; ya[4 * i + 1] = y[1]; ya[4 * i + 2] = y[2]; ya[4 * i + 3] = y[3];
        }
        if (MODE == 1) {
#pragma unroll
            for (int e = 0; e < 16; ++e) acc[e] = 0.f;
            float4 wq[2][4];
            const float* wl = wt + lane * 4;
#pragma unroll
            for (int e = 0; e < 4; ++e) wq[0][e] = *(const float4*)(wl + e * 1024);
#pragma unroll
            for (int st = 0; st < 16; ++st) {
                const int i = st >> 2, eg = st & 3, cur = st & 1;
                if (st + 1 < 16) {
                    const int i2 = (st + 1) >> 2, eg2 = (st + 1) & 3;
#pragma unroll
                    for (int e = 0; e < 4; ++e) wq[cur ^ 1][e] = *(const float4*)(wl + (eg2 * 4 + e) * 1024 + i2 * 256);
                }
#pragma unroll
                for (int e = 0; e < 4; ++e) {
                    const float4 w4 = wq[cur][e];
                    acc[eg * 4 + e] = fmaf(ya[4 * i], w4.x, fmaf(ya[4 * i + 1], w4.y, fmaf(ya[4 * i + 2], w4.z, fmaf(ya[4 * i + 3], w4.w, acc[eg * 4 + e]))));
                }
                __builtin_amdgcn_sched_barrier(0);
            }
        }
        if (MODE == 1) {
            const bool b5 = lane & 32, b4 = lane & 16, b3 = lane & 8, b2 = lane & 4;
            float r8[8], r4[4], r2[2];
#pragma unroll
            for (int e = 0; e < 8; ++e) { const float snd = b5 ? acc[e] : acc[e + 8], kp = b5 ? acc[e + 8] : acc[e]; r8[e] = kp + __shfl_xor(snd, 32); }
#pragma unroll
            for (int e = 0; e < 4; ++e) { const float snd = b4 ? r8[e] : r8[e + 4], kp = b4 ? r8[e + 4] : r8[e]; r4[e] = kp + __shfl_xor(snd, 16); }
#pragma unroll
            for (int e = 0; e < 2; ++e) { const float snd = b3 ? r4[e] : r4[e + 2], kp = b3 ? r4[e + 2] : r4[e]; r2[e] = kp + __shfl_xor(snd, 8); }
            float rv; { const float snd = b2 ? r2[0] : r2[1], kp = b2 ? r2[1] : r2[0]; rv = kp + __shfl_xor(snd, 4); }
            rv += __shfl_xor(rv, 2); rv += __shfl_xor(rv, 1);
            if ((lane & 3) == 0) lgb[(wave * 16 + it) * 16 + (lane >> 2)] = rv;
            if (lane == it) myrow = row;
            ++it;
            if (it == 16) { route_flush(p, lds, lane, wave, it, myrow, layer); it = 0; }
        }
    }
    if (MODE == 1 && it > 0) route_flush(p, lds, lane, wave, it, myrow, layer);
}

template <class WF, class XF, class EPI>
__device__ __forceinline__ void gemm_tile(char* lds, int nkt, WF wf, XF xf, EPI epi) {
    const int tid = TID(), lane = tid & 63, wave = tid >> 6;
    const int wn = wave & 1, wm = wave >> 1, hh = lane >> 5;
    const int lrow = tid >> 3;
    const int lchunk = (tid & 7) ^ ((tid >> 4) & 7);
    const half_t* xs[4];
#pragma unroll
    for (int i = 0; i < 4; ++i) xs[i] = xf(lrow + 32 * i) + lchunk * 8;
    char* ldst = lds + lrow * 128 + (tid & 7) * 16;
    f16v acc[2][2];
#pragma unroll
    for (int i = 0; i < 2; ++i)
#pragma unroll
        for (int j = 0; j < 2; ++j)
#pragma unroll
            for (int r = 0; r < 16; ++r) acc[i][j][r] = 0.f;
    auto issue = [&](int kt, int s) {
        char* d = ldst + s * 32768;
#pragma unroll
        for (int i = 0; i < 4; ++i) glds16(wf(kt, lrow + 32 * i) + lchunk * 8, d + i * 4096);
#pragma unroll
        for (int i = 0; i < 4; ++i) glds16(xs[i] + kt * 64, d + 16384 + i * 4096);
    };
    __syncthreads();
    issue(0, 0);
    const int rsw = (lane >> 1) & 7;
    const int roff_w = (wn * 64 + (lane & 31)) * 128, roff_x = 16384 + (wm * 64 + (lane & 31)) * 128;
    for (int kt = 0; kt < nkt; ++kt) {
        asm volatile("s_waitcnt vmcnt(0)" ::: "memory");
        __syncthreads();
        if (kt + 1 < nkt) issue(kt + 1, (kt + 1) & 1);
        const char* base = lds + (kt & 1) * 32768;
#pragma unroll
        for (int ks = 0; ks < 4; ++ks) {
            const int co = ((2 * ks + hh) ^ rsw) << 4;
            const h8 a0 = *(const h8*)(base + roff_w + co), a1 = *(const h8*)(base + roff_w + 4096 + co);
            const h8 b0 = *(const h8*)(base + roff_x + co), b1 = *(const h8*)(base + roff_x + 4096 + co);
            acc[0][0] = __builtin_amdgcn_mfma_f32_32x32x16_f16(a0, b0, acc[0][0], 0, 0, 0);
            acc[0][1] = __builtin_amdgcn_mfma_f32_32x32x16_f16(a0, b1, acc[0][1], 0, 0, 0);
            acc[1][0] = __builtin_amdgcn_mfma_f32_32x32x16_f16(a1, b0, acc[1][0], 0, 0, 0);
            acc[1][1] = __builtin_amdgcn_mfma_f32_32x32x16_f16(a1, b1, acc[1][1], 0, 0, 0);
        }
    }
    epi(acc, wn, wm, lane);
}

template <class WF, class XF, class EPI>
__device__ __forceinline__ void gemm_tile2(char* lds, int nkt, size_t xkstride, WF wf, XF xf, EPI epi) {
    const int tid = TID(), lane = tid & 63, wave = tid >> 6;
    const int wn = wave & 1, wm = wave >> 1, hh = lane >> 5;
    const int lrow = tid >> 2;
    const int lchunk = (tid & 3) ^ ((tid >> 4) & 3);
    const half_t* xs[2];
#pragma unroll
    for (int i = 0; i < 2; ++i) xs[i] = xf(lrow + 64 * i) + lchunk * 8;
    char* ldst = lds + lrow * 64 + (tid & 3) * 16;
    f16v acc[4][2];
#pragma unroll
    for (int i = 0; i < 4; ++i)
#pragma unroll
        for (int j = 0; j < 2; ++j)
#pragma unroll
            for (int r = 0; r < 16; ++r) acc[i][j][r] = 0.f;
    auto issue = [&](int kt, int s) {
        char* d = ldst + s * 24576;
#pragma unroll
        for (int i = 0; i < 4; ++i) glds16(wf(kt, lrow + 64 * i) + lchunk * 8, d + i * 4096);
#pragma unroll
        for (int i = 0; i < 2; ++i) glds16(xs[i] + (size_t)kt * xkstride, d + 16384 + i * 4096);
    };
    __syncthreads();
    issue(0, 0); issue(1, 1);
    const int rsw = (lane >> 2) & 3;
    const int roff_w = (wn * 128 + (lane & 31)) * 64, roff_x = 16384 + (wm * 64 + (lane & 31)) * 64;
    int st = 0;
    for (int kt = 0; kt < nkt; ++kt) {
        if (kt + 1 < nkt) asm volatile("s_waitcnt vmcnt(6)" ::: "memory");
        else asm volatile("s_waitcnt vmcnt(0)" ::: "memory");
        asm volatile("s_waitcnt lgkmcnt(0)" ::: "memory");
        __builtin_amdgcn_s_barrier();
        if (kt + 2 < nkt) issue(kt + 2, st >= 1 ? st - 1 : 2);
        const char* base = lds + st * 24576;
        st = st == 2 ? 0 : st + 1;
#pragma unroll
        for (int ks = 0; ks < 2; ++ks) {
            const int co = ((2 * ks + hh) ^ rsw) << 4;
            h8 a[4], b[2];
#pragma unroll
            for (int i = 0; i < 4; ++i) a[i] = *(const h8*)(base + roff_w + i * 2048 + co);
#pragma unroll
            for (int j = 0; j < 2; ++j) b[j] = *(const h8*)(base + roff_x + j * 2048 + co);
#pragma unroll
            for (int i = 0; i < 4; ++i)
#pragma unroll
                for (int j = 0; j < 2; ++j) acc[i][j] = __builtin_amdgcn_mfma_f32_32x32x16_f16(a[i], b[j], acc[i][j], 0, 0, 0);
        }
    }
    epi(acc, wn, wm, lane);
}

__device__ __forceinline__ void phase_inproj(KP p, char* lds, int l) {
    const half_t* W = p->Wt_in + (size_t)l * NP * DM;
    const float* rc16 = p->rope; const float* rs16 = p->rope + 16384; const float* rc8 = p->rope + 32768; const float* rs8 = p->rope + 32768 + 8192;
    for (int u = BID(); u < 256 * 10; u += gridDim.x) {
        const int xl = u & 7, Lx = u >> 3, mi = Lx & 7, rr_ = Lx >> 3;
        const int nt = rr_ % 10, mt = 32 * xl + 8 * (rr_ / 10) + mi;
        gemm_tile2(lds, 32, (size_t)T_TOK * 32,
            [&](int kt, int row) { int n = nt * 256 + row; n = n < NP ? n : NP - 1; return W + ((size_t)kt * NP + n) * 32; },
            [&](int row) { return p->hn + (size_t)(mt * 128 + row) * 32; },
            [&](f16v (&acc)[4][2], int wn, int wm, int lane) {
                const int hh = lane >> 5;
                half_t* stg = (half_t*)lds;
                __syncthreads();
#pragma unroll
                for (int i = 0; i < 4; ++i) {
                    const int nb = nt * 256 + wn * 128 + i * 32;
                    if (nb == 1216 || nb == 1248 || nb >= NP) continue;
                    const bool rope64 = ((nb >= PC_DQ && nb < PC_DV) || (nb >= PC_MQ && nb < PC_MV)) && ((nb & 63) == 0);
                    const bool rope32 = (nb >= PC_IQ && nb < PC_IW);
#pragma unroll
                    for (int j = 0; j < 2; ++j) {
                        const int tok = mt * 128 + wm * 64 + j * 32 + (lane & 31);
                        const int t = tok & 2047;
                        f16v v = acc[i][j];
                        if (nb == PC_IW) { if (hh == 0) *(float4*)(p->iwf + (size_t)tok * 4) = make_float4(v[0], v[1], v[2], v[3]); continue; }
                        if (rope64) {
                            const float4 c4 = *(const float4*)(rc16 + t * 8 + 4 * hh), s4 = *(const float4*)(rs16 + t * 8 + 4 * hh);
                            const float cc[4] = {c4.x, c4.y, c4.z, c4.w}, sn[4] = {s4.x, s4.y, s4.z, s4.w};
#pragma unroll
                            for (int r = 0; r < 4; ++r) { const float x1 = v[r], x2 = v[r + 4]; v[r] = x1 * cc[r] - x2 * sn[r]; v[r + 4] = x2 * cc[r] + x1 * sn[r]; }
                        } else if (rope32) {
                            const float4 c4 = *(const float4*)(rc8 + t * 4), s4 = *(const float4*)(rs8 + t * 4);
                            const float cc[4] = {c4.x, c4.y, c4.z, c4.w}, sn[4] = {s4.x, s4.y, s4.z, s4.w};
#pragma unroll
                            for (int r = 0; r < 4; ++r) { const float o = __shfl_xor(v[r], 32); v[r] = hh ? (v[r] * cc[r] + o * sn[r]) : (v[r] * cc[r] - o * sn[r]); }
                        }
                        half_t* dst = stg + (wm * 64 + j * 32 + (lane & 31)) * 260 + wn * 128 + i * 32 + 4 * hh;
#pragma unroll
                        for (int g = 0; g < 4; ++g) *(h4*)(dst + 8 * g) = pack4(v[4 * g], v[4 * g + 1], v[4 * g + 2], v[4 * g + 3]);
                    }
                }
                __syncthreads();
                const int wv_ = TID() >> 6;
#pragma unroll 4
                for (int it = 0; it < 32; ++it) {
                    const int row = it * 4 + wv_;
                    const uint2 v2 = *(const uint2*)(stg + row * 260 + lane * 4);
                    const int n = nt * 256 + lane * 4;
                    if (n < NP) *(uint2*)(p->P + (size_t)(mt * 128 + row) * NP + n) = v2;
                }
            });
    }
}

__device__ __forceinline__ void stage_acc_f32(char* lds, const f16v (&acc)[2][2], int wn, int wm, int lane) {
    float* stg = (float*)lds;
    const int hh = lane >> 5;
    __syncthreads();
#pragma unroll
    for (int j = 0; j < 2; ++j)
#pragma unroll
        for (int i = 0; i < 2; ++i)
#pragma unroll
            for (int g = 0; g < 4; ++g)
                *(float4*)(stg + (wm * 64 + j * 32 + (lane & 31)) * 132 + wn * 64 + i * 32 + 4 * hh + 8 * g) = make_float4(acc[i][j][4 * g], acc[i][j][4 * g + 1], acc[i][j][4 * g + 2], acc[i][j][4 * g + 3]);
    __syncthreads();
}
__device__ __forceinline__ void phase_outproj(KP p, char* lds, int l, const float* xin) {
    const half_t* W = p->Wt_o + (size_t)l * DM * DM;
    const float* g1 = p->modf + (size_t)l * 16 * 6144 + 2 * 1024;
    for (int u = BID(); u < 256 * 4; u += gridDim.x) {
        const int xl = u & 7, Lx = u >> 3, mi = Lx & 7, rr_ = Lx >> 3;
        const int nt = rr_ & 3, mt = 32 * xl + 8 * (rr_ >> 2) + mi;
        gemm_tile2(lds, 32, (size_t)T_TOK * 32,
            [&](int kt, int row) { return W + ((size_t)kt * DM + nt * 256 + row) * 32; },
            [&](int row) { return p->ycat + (size_t)(mt * 128 + row) * 32; },
            [&](f16v (&acc)[4][2], int wn, int wm, int lane) {
                const int hh = lane >> 5;
#pragma unroll
                for (int j = 0; j < 2; ++j) {
                    const int tok = mt * 128 + wm * 64 + j * 32 + (lane & 31);
                    const int b = tok >> 11;
#pragma unroll
                    for (int i = 0; i < 4; ++i) {
                        const int nb = nt * 256 + wn * 128 + i * 32 + 4 * hh;
#pragma unroll
                        for (int g = 0; g < 4; ++g) {
                            const int n = nb + 8 * g;
                            const float4 xi = *(const float4*)(xin + (size_t)tok * DM + n);
                            const float4 gg = *(const float4*)(g1 + (size_t)b * 6144 + n);
                            float4 o; o.x = xi.x + gg.x * acc[i][j][4 * g]; o.y = xi.y + gg.y * acc[i][j][4 * g + 1]; o.z = xi.z + gg.z * acc[i][j][4 * g + 2]; o.w = xi.w + gg.w * acc[i][j][4 * g + 3];
                            *(float4*)(p->out + (size_t)tok * DM + n) = o;
                        }
                    }
                }
            });
    }
}

__device__ __forceinline__ bool moe_tile(const int* cnt, int tile, int& cls, int& pos0, int& n) {
    int tb = 0;
    for (int c = 0; c < NCLS; ++c) {
        const int nc = cnt[c * 64], nt = (nc + 127) >> 7;
        if (tile < tb + nt) { cls = c; pos0 = (tile - tb) * 128; n = nc; return true; }
        tb += nt;
    }
    return false;
}
__device__ __forceinline__ void cls_experts(int cls, int& e1, int& e2) {
    const int g = cls / 6, pi = cls % 6;
    const int a = pi < 3 ? 0 : (pi < 5 ? 1 : 2);
    const int b = pi < 3 ? pi + 1 : (pi < 5 ? pi - 1 : 3);
    e1 = g * 4 + a; e2 = g * 4 + b;
}
__device__ __forceinline__ void phase_moe_up(KP p, char* lds, int l) {
    const int* cnt = p->cnt + l * 32 * 64;
    for (int u = BID(); u < (256 + NCLS) * 8; u += gridDim.x) {
        const int xl = u & 7, Lx = u >> 3;
        const int nt = Lx & 7, tile = (Lx >> 3) * 8 + xl;
        int cls, pos0, nc;
        if (!moe_tile(cnt, tile, cls, pos0, nc)) continue;
        int e1, e2; cls_experts(cls, e1, e2);
        const int slot = nt >> 2;
        const half_t* W = p->Wt_gu + ((size_t)(l * 16 + (slot ? e2 : e1)) * 512 + (nt & 3) * 128) * 1024;
        const int* lst = p->lists + (size_t)cls * T_TOK + pos0;
        const int nvalid = nc - pos0;
        gemm_tile(lds, 16,
            [&](int kt, int row) { return W + (size_t)row * 1024 + kt * 64; },
            [&](int row) { const int tok = lst[row < nvalid ? row : 0]; return p->hn + (size_t)tok * DM; },
            [&](f16v (&acc)[2][2], int wn, int wm, int lane) {
                const int hh = lane >> 5;
#pragma unroll
                for (int j = 0; j < 2; ++j) {
                    const int row = wm * 64 + j * 32 + (lane & 31);
                    if (row < nvalid) {
                        const int tok = lst[row];
                        const float wgt = p->tokw[(size_t)tok * 2 + slot];
                        half_t* dst = p->act + (size_t)tok * 512 + slot * 256 + ((nt & 3) * 2 + wn) * 32 + 4 * hh;
#pragma unroll
                        for (int g = 0; g < 4; ++g) {
                            float a[4];
#pragma unroll
                            for (int r = 0; r < 4; ++r) { const float gv = acc[0][j][4 * g + r], uv = acc[1][j][4 * g + r]; a[r] = gv * sigmoidf_(gv) * uv * wgt; }
                            *(h4*)(dst + 8 * g) = pack4(a[0], a[1], a[2], a[3]);
                        }
                    }
                }
            });
    }
}
__device__ __forceinline__ void phase_moe_down(KP p, char* lds, int l, float gsc) {
    const int* cnt = p->cnt + l * 32 * 64;
    const float* g2 = p->modf + (size_t)l * 16 * 6144 + 5 * 1024;
    for (int u = BID(); u < (256 + NCLS) * 8; u += gridDim.x) {
        const int xl = u & 7, Lx = u >> 3;
        const int nt = Lx & 7, tile = (Lx >> 3) * 8 + xl;
        int cls, pos0, nc;
        if (!moe_tile(cnt, tile, cls, pos0, nc)) continue;
        int e1, e2; cls_experts(cls, e1, e2);
        const half_t* W1 = p->Wt_d + ((size_t)(l * 16 + e1) * 1024 + nt * 128) * 256;
        const half_t* W2 = p->Wt_d + ((size_t)(l * 16 + e2) * 1024 + nt * 128) * 256;
        const int* lst = p->lists + (size_t)cls * T_TOK + pos0;
        const int nvalid = nc - pos0;
        gemm_tile(lds, 8,
            [&](int kt, int row) { return (kt < 4 ? W1 : W2) + (size_t)row * 256 + (kt & 3) * 64; },
            [&](int row) { const int tok = lst[row < nvalid ? row : 0]; return p->act + (size_t)tok * 512; },
            [&](f16v (&acc)[2][2], int wn, int wm, int lane) {
                stage_acc_f32(lds, acc, wn, wm, lane);
                const float* stg = (const float*)lds;
                const int tid = TID();
#pragma unroll 4
                for (int it = 0; it < 16; ++it) {
                    const int idx = it * 256 + tid, row = idx >> 5, c = idx & 31;
                    if (row < nvalid) {
                        const int tok = lst[row], n = nt * 128 + 4 * c;
                        const float4 a4 = *(const float4*)(stg + row * 132 + 4 * c);
                        float4* xp = (float4*)(p->out + (size_t)tok * DM + n);
                        float4 xi = *xp;
                        const float4 gg = *(const float4*)(g2 + (size_t)(tok >> 11) * 6144 + n);
                        xi.x += gsc * gg.x * a4.x; xi.y += gsc * gg.y * a4.y; xi.z += gsc * gg.z * a4.z; xi.w += gsc * gg.w * a4.w;
                        *xp = xi;
                    }
                }
            });
    }
}

__device__ __forceinline__ void dsa_select_unit(KP p, char* lds, int b, int qt) {
    unsigned* hist = (unsigned*)lds;
    unsigned* maskl = hist + 16 * 257 + 16;
    unsigned* stP = maskl + 1024;
    unsigned* stNeed = stP + 16;
    unsigned* stDone = stNeed + 16;
    unsigned* flag = stDone + 16;
    unsigned* dummyb = flag + 16;
    const int tid = TID(), lane = tid & 63, wave = tid >> 6;
    const int q0 = qt * 16, tokbase = b * SEQ;
    __syncthreads();
    if (q0 < 256) {
        for (int i = tid; i < 1024; i += 256) {
            const int q = i >> 6, wd = i & 63;
            const int n = q0 + q + 1 - 32 * wd;
            const unsigned w = n >= 32 ? 0xFFFFFFFFu : (n <= 0 ? 0u : ((1u << n) - 1u));
            p->dmask[(size_t)(tokbase + q0 + q) * 64 + wd] = w;
        }
        return;
    }
    for (int i = tid; i < 1024; i += 256) maskl[i] = 0u;
    if (tid < 16) { stP[tid] = 0u; stNeed[tid] = 256u; stDone[tid] = 0u; }
    const int ql = lane & 15, fq = lane >> 4;
    const int tq = q0 + ql;
    const half_t* Pb = p->P + (size_t)tokbase * NP;
    h8 iqf[4];
#pragma unroll
    for (int hd = 0; hd < 4; ++hd) iqf[hd] = *(const h8*)(Pb + (size_t)tq * NP + PC_IQ + hd * 32 + 8 * fq);
    const float4 iw4 = *(const float4*)(p->iwf + (size_t)(tokbase + tq) * 4);
    const float wsc0 = iw4.x * 0.08838834764831845f, wsc1 = iw4.y * 0.08838834764831845f, wsc2 = iw4.z * 0.08838834764831845f, wsc3 = iw4.w * 0.08838834764831845f;
    const int ng = qt + 1;
    unsigned sc[32][4];
    const half_t* ikp = Pb + (size_t)ql * NP + PC_IK + 8 * fq;
#pragma unroll
    for (int gb = 0; gb < 4; ++gb) {
        h8 ik[8];
#pragma unroll
        for (int x = 0; x < 8; ++x) {
            int g = wave + 4 * (gb * 8 + x);
            g = g < ng ? g : ng - 1;
            ik[x] = *(const h8*)(ikp + (size_t)(16 * g) * NP);
        }
#pragma unroll
        for (int x = 0; x < 8; ++x) {
            const int gi = gb * 8 + x;
            const int g = wave + 4 * gi;
            const f4v z = {0.f, 0.f, 0.f, 0.f};
            const f4v c0 = __builtin_amdgcn_mfma_f32_16x16x32_f16(ik[x], iqf[0], z, 0, 0, 0);
            const f4v c1 = __builtin_amdgcn_mfma_f32_16x16x32_f16(ik[x], iqf[1], z, 0, 0, 0);
            const f4v c2 = __builtin_amdgcn_mfma_f32_16x16x32_f16(ik[x], iqf[2], z, 0, 0, 0);
            const f4v c3 = __builtin_amdgcn_mfma_f32_16x16x32_f16(ik[x], iqf[3], z, 0, 0, 0);
#pragma unroll
            for (int r = 0; r < 4; ++r) {
                const int j = 16 * g + 4 * fq + r;
                float sv = wsc0 * __builtin_amdgcn_fmed3f(c0[r], 0.f, INFINITY);
                sv = fmaf(wsc1, __builtin_amdgcn_fmed3f(c1[r], 0.f, INFINITY), sv);
                sv = fmaf(wsc2, __builtin_amdgcn_fmed3f(c2[r], 0.f, INFINITY), sv);
                sv = fmaf(wsc3, __builtin_amdgcn_fmed3f(c3[r], 0.f, INFINITY), sv);
                sv += 0.0f;
                const int sb = __float_as_int(sv);
                const unsigned su = (unsigned)sb ^ ((unsigned)(sb >> 31) | 0x80000000u);
                const unsigned ck = (su & 0xFFFFF800u) | (unsigned)(2047 - j);
                sc[gi][r] = (g < ng && j <= tq) ? ck : 0u;
            }
        }
    }
    bool alldone = false;
    for (int pass = 0; pass < 5; ++pass) {
        const bool fin = alldone;
        if (!fin) { for (int i = tid; i < 16 * 257; i += 256) hist[i] = 0u; }
        if (tid == 0) *flag = 0u;
        __syncthreads();
        const unsigned sP = stP[ql], sDone = stDone[ql];
        int wv = wave, fqv = fq;
        asm volatile("" : "+v"(wv), "+v"(fqv));
        if (fin) {
            const int sh = (int)(32u - 8u * (sDone ? sDone : 1u));
            unsigned* mrow = maskl + ql * 64;
#pragma unroll
            for (int gi = 0; gi < 32; ++gi) {
                const int g = wv + 4 * gi;
                unsigned nib = 0u;
#pragma unroll
                for (int r = 0; r < 4; ++r) {
                    const unsigned uu = sc[gi][r];
                    nib |= ((uu >> sh) >= sP) ? (1u << r) : 0u;
                }
                if (g < ng) atomicOr(&mrow[g >> 1], nib << ((g & 1) * 16 + 4 * fqv));
            }
        } else {
            const int shm = pass ? 32 - 8 * pass : 0, shd = 24 - 8 * pass;
            const unsigned orm = pass ? 0u : 0xFFFFFFFFu;
            const unsigned cmpv = pass ? (sDone == 0u ? sP : 0xFFFFFFFFu) : 0xFFFFFFFFu;
            unsigned* hrow = hist + ql * 257;
            unsigned* dummy = dummyb + lane;
#pragma unroll
            for (int gi = 0; gi < 32; ++gi) {
                const int g = wv + 4 * gi;
                if (g < ng) {
#pragma unroll
                    for (int r = 0; r < 4; ++r) {
                        const unsigned uu = sc[gi][r];
                        const bool match = (((uu >> shm) | orm) == cmpv);
                        const unsigned dig = (uu >> shd) & 255u;
                        unsigned* a = match ? hrow + dig : dummy;
                        atomicAdd(a, 1u);
                    }
                }
            }
        }
        __syncthreads();
        if (fin) break;
        {
            const int qq = tid >> 4, seg = tid & 15;
            const bool active = (stDone[qq] == 0u);
            unsigned c16 = 0u;
            if (active) {
#pragma unroll
                for (int d = 0; d < 16; ++d) c16 += hist[qq * 257 + seg * 16 + d];
            }
            unsigned v = c16;
#pragma unroll
            for (int off = 1; off < 16; off <<= 1) { const unsigned t = __shfl_down(v, off, 16); if (seg + off < 16) v += t; }
            const unsigned suf = v - c16;
            const unsigned need = stNeed[qq];
            if (active && suf < need && need <= suf + c16) {
                unsigned run = suf, D = 0u, cD = 0u, nn = need;
                for (int d = 15; d >= 0; --d) {
                    const unsigned cc = hist[qq * 257 + seg * 16 + d];
                    if (run + cc >= need) { D = (unsigned)(seg * 16 + d); cD = cc; nn = need - run; break; }
                    run += cc;
                }
                const bool done = (cD == nn) || pass == 3;
                stP[qq] = (stP[qq] << 8) | D; stNeed[qq] = nn;
                if (done) stDone[qq] = (unsigned)(pass + 1); else atomicAdd(flag, 1u);
            }
        }
        __syncthreads();
        alldone = (*flag == 0u);
    }
    for (int i = tid; i < 1024; i += 256) p->dmask[(size_t)(tokbase + q0 + (i >> 6)) * 64 + (i & 63)] = maskl[i];
}

__device__ __forceinline__ void conv_unit(KP p, char* lds, int l, int b, int c) {
    float* a = (float*)lds;
    float* red = a + 62 * 256;
    const int ch = TID(), lane = ch & 63, wave = ch >> 6;
    const int t0 = c * 32, tokbase = b * SEQ;
    __syncthreads();
#pragma unroll 1
    for (int r0 = 0; r0 < 64; r0 += 8) {
        half_t uu[8], gg[8];
#pragma unroll
        for (int i = 0; i < 8; ++i) {
            int rr = r0 + i; rr = rr < 62 ? rr : 61;
            int tt = t0 - 30 + rr; tt = tt >= 0 ? tt : t0;
            const half_t* r = p->P + (size_t)(tokbase + tt) * NP;
            uu[i] = r[PC_CU + ch]; gg[i] = r[PC_CG + ch];
        }
#pragma unroll
        for (int i = 0; i < 8; ++i) {
            const int rr = r0 + i;
            const float av = (t0 - 30 + rr >= 0) ? (float)uu[i] * sigmoidf_((float)gg[i]) : 0.f;
            if (rr < 62) a[rr * 256 + ch] = av;
        }
    }
    float w[31];
#pragma unroll
    for (int i = 0; i < 31; ++i) w[i] = p->w_dw[(l * 31 + i) * 256 + ch];
    const float bias = p->b_dw[l * 256 + ch];
    float y[32];
#pragma unroll
    for (int tk = 0; tk < 32; ++tk) {
        float s = bias;
#pragma unroll
        for (int i = 0; i < 31; ++i) s = fmaf(a[(tk + i) * 256 + ch], w[i], s);
        y[tk] = s;
        float s1 = s, s2 = s * s;
#pragma unroll
        for (int o = 32; o >= 1; o >>= 1) { s1 += __shfl_xor(s1, o); s2 += __shfl_xor(s2, o); }
        if (lane == 0) { red[(tk * 4 + wave) * 2] = s1; red[(tk * 4 + wave) * 2 + 1] = s2; }
    }
    __syncthreads();
    const float lg = p->ln_g[l * 256 + ch], lb = p->ln_b[l * 256 + ch];
#pragma unroll
    for (int tk = 0; tk < 32; ++tk) {
        const float s1 = (red[tk * 8] + red[tk * 8 + 2]) + (red[tk * 8 + 4] + red[tk * 8 + 6]);
        const float s2 = (red[tk * 8 + 1] + red[tk * 8 + 3]) + (red[tk * 8 + 5] + red[tk * 8 + 7]);
        const float mu = s1 * (1.0f / 256.0f);
        float var = s2 * (1.0f / 256.0f) - mu * mu; var = var < 0.f ? 0.f : var;
        float z = (y[tk] - mu) * (1.0f / sqrtf(var + 1e-6f)) * lg + lb;
        z = z * sigmoidf_(z);
        p->ycat[((size_t)(ch >> 5) * T_TOK + tokbase + t0 + tk) * 32 + (ch & 31)] = (half_t)z;
    }
}

__device__ __forceinline__ void kmean_unit(KP p, char* lds, int b, int h, int blk) {
    float* part = (float*)lds;
    const int tid = TID(), d = tid & 63, pt = tid >> 6;
    const half_t* r = p->P + (size_t)(b * SEQ + blk * 256 + pt * 64) * NP + PC_MK + h * 64 + d;
    float s = 0.f;
    for (int k = 0; k < 64; ++k) s += (float)r[(size_t)k * NP];
    __syncthreads();
    part[pt * 64 + d] = s;
    __syncthreads();
    if (tid < 64) p->kmean[(((size_t)b * 6 + h) * 8 + blk) * 64 + tid] = ((part[tid] + part[64 + tid]) + (part[128 + tid] + part[192 + tid])) * (1.0f / 256.0f);
}

#ifndef POST_MASK
#define POST_MASK 7
#endif
__device__ __forceinline__ void phase_post(KP p, char* lds, int l, int tm) {
    const int NA = 2048, NB = 1024, NC = 768;
    for (int u = BID(); u < NA + NB + NC; u += gridDim.x) {
        if (u < NA) { if (tm & 1) dsa_select_unit(p, lds, u % 16, 127 - (u / 16)); }
        else if (u < NA + NB) { const int v = u - NA; if (tm & 2) conv_unit(p, lds, l, v % 16, v / 16); }
        else { const int v = u - NA - NB; if (tm & 4) kmean_unit(p, lds, v / 48, (v / 8) % 6, v % 8); }
    }
}

template <int MODE>
__device__ __forceinline__ void attn_unit(KP p, char* lds, int b, int h, int qt) {
    const int tid = TID(), lane = tid & 63, wave = tid >> 6, hh = lane >> 5, ql = lane & 31;
    const int q0 = qt * 128, tokbase = b * SEQ;
    const int tq = q0 + wave * 32 + ql;
    const half_t* Pb = p->P + (size_t)tokbase * NP;
    const int QOFF = MODE ? PC_MQ + h * 64 : PC_DQ + h * 64;
    const int KOFF = MODE ? PC_MK + h * 64 : PC_DK;
    const int VOFF = MODE ? PC_MV + h * 64 : PC_DV;
    const int own = qt >> 1;
    unsigned mysel = 0u, anysel = 0u;
    __syncthreads();
    if (MODE == 1) {
        float* km = (float*)(lds + 32768);
        float* gts = km + 512;
        unsigned* selq = (unsigned*)(gts + 1024);
        unsigned* anyb = selq + 128;
        for (int i = tid; i < 512; i += 256) km[i] = p->kmean[((size_t)b * 6 + h) * 512 + i];
        if (tid == 0) *anyb = 0u;
        __syncthreads();
        {
            const int q = tid & 127, hf = tid >> 7;
            if (hf * 4 < own) {
                const half_t* qr = Pb + (size_t)(q0 + q) * NP + QOFF;
                float g0 = 0.f, g1 = 0.f, g2 = 0.f, g3 = 0.f;
#pragma unroll
                for (int c8 = 0; c8 < 8; ++c8) {
                    const h8 qv = *(const h8*)(qr + c8 * 8);
#pragma unroll
                    for (int j = 0; j < 8; ++j) {
                        const float qf = (float)qv[j]; const int d = c8 * 8 + j;
                        g0 = fmaf(qf, km[(hf * 4 + 0) * 64 + d], g0); g1 = fmaf(qf, km[(hf * 4 + 1) * 64 + d], g1);
                        g2 = fmaf(qf, km[(hf * 4 + 2) * 64 + d], g2); g3 = fmaf(qf, km[(hf * 4 + 3) * 64 + d], g3);
                    }
                }
                gts[q * 8 + hf * 4 + 0] = g0; gts[q * 8 + hf * 4 + 1] = g1; gts[q * 8 + hf * 4 + 2] = g2; gts[q * 8 + hf * 4 + 3] = g3;
            }
        }
        __syncthreads();
        if (tid < 128) {
            unsigned m = 0u;
            const int want = own < 3 ? own : 3;
            for (int r = 0; r < want; ++r) {
                int best = -1; float bv = -INFINITY;
                for (int j = 0; j < own; ++j) { const float gv = gts[tid * 8 + j]; if (!((m >> j) & 1u) && (best < 0 || gv > bv)) { best = j; bv = gv; } }
                m |= 1u << best;
            }
            selq[tid] = m;
            if (m) atomicOr(anyb, m);
        }
        __syncthreads();
        mysel = selq[wave * 32 + ql];
        anysel = *anyb;
        __syncthreads();
    }
    h8 qf[4];
#pragma unroll
    for (int ks = 0; ks < 4; ++ks) qf[ks] = *(const h8*)(Pb + (size_t)tq * NP + QOFF + 16 * ks + 8 * hh);
    f16v O0, O1;
#pragma unroll
    for (int r = 0; r < 16; ++r) { O0[r] = 0.f; O1[r] = 0.f; }
    float m_run = -1e30f, l_run = 0.f;
    const float CS = 0.18033688011112042f;
    const int ntile = 2 * qt + 2;
    auto skip = [&](int kt) -> bool { return MODE == 1 && kt < 4 * own && !((anysel >> (kt >> 2)) & 1u); };
    auto nexttile = [&](int kt) -> int { ++kt; while (kt < ntile && skip(kt)) ++kt; return kt; };
    const int lrow = tid >> 3;
    const int kchunk = (tid & 7) ^ ((tid >> 4) & 7);
    const int vchunk = (tid & 7) ^ (((tid >> 4) & 1) << 2);
    char* ldst = lds + lrow * 128 + (tid & 7) * 16;
    auto issue = [&](int kt, int s) {
        const half_t* src = Pb + (size_t)(kt * 64 + lrow) * NP;
        char* d = ldst + s * 16384;
        glds16(src + KOFF + kchunk * 8, d);
        glds16(src + (size_t)32 * NP + KOFF + kchunk * 8, d + 4096);
        glds16(src + VOFF + vchunk * 8, d + 8192);
        glds16(src + (size_t)32 * NP + VOFF + vchunk * 8, d + 8192 + 4096);
    };
    const int rsw = (lane >> 1) & 7;
    const int kro = ql * 128;
    const int li = lane & 15, qp = li >> 2, pp = li & 3, swv = (qp >> 1) & 1;
    const int vb0 = 8192 + (4 * hh + qp) * 128 + 32 * ((lane >> 4) & 1) + 8 * pp + 64 * (0 ^ swv);
    const int vb1 = 8192 + (4 * hh + qp) * 128 + 32 * ((lane >> 4) & 1) + 8 * pp + 64 * (1 ^ swv);
    int kt = -1; kt = nexttile(kt);
    int s = 0;
    if (kt < ntile) issue(kt, 0);
    while (kt < ntile) {
        const int ktn = nexttile(kt);
        asm volatile("s_waitcnt vmcnt(0)" ::: "memory");
        __syncthreads();
        if (ktn < ntile) issue(ktn, s ^ 1);
        const bool wave_active = (kt * 64 <= q0 + wave * 32 + 31);
        if (wave_active) {
            const char* base = lds + s * 16384;
            uint2 mw = make_uint2(0u, 0u);
            if (MODE == 0) mw = *(const uint2*)(p->dmask + (size_t)(tokbase + tq) * 64 + 2 * kt);
            f16v s0, s1;
#pragma unroll
            for (int r = 0; r < 16; ++r) { s0[r] = 0.f; s1[r] = 0.f; }
#pragma unroll
            for (int ks = 0; ks < 4; ++ks) {
                const int co = ((2 * ks + hh) ^ rsw) << 4;
                const h8 k0 = *(const h8*)(base + kro + co), k1 = *(const h8*)(base + kro + 4096 + co);
                s0 = __builtin_amdgcn_mfma_f32_32x32x16_f16(k0, qf[ks], s0, 0, 0, 0);
                s1 = __builtin_amdgcn_mfma_f32_32x32x16_f16(k1, qf[ks], s1, 0, 0, 0);
            }
            if (MODE == 0) {
                const unsigned w0 = mw.x >> (4 * hh), w1 = mw.y >> (4 * hh);
#pragma unroll
                for (int r = 0; r < 16; ++r) {
                    const int pos = (r & 3) + 8 * (r >> 2);
                    const unsigned m0 = (unsigned)__builtin_amdgcn_sbfe((int)w0, pos, 1), m1 = (unsigned)__builtin_amdgcn_sbfe((int)w1, pos, 1);
                    s0[r] = __uint_as_float((__float_as_uint(s0[r]) & m0) | (0xFF800000u & ~m0));
                    s1[r] = __uint_as_float((__float_as_uint(s1[r]) & m1) | (0xFF800000u & ~m1));
                }
            } else {
                if (kt < 4 * own) {
                    const bool v = (mysel >> (kt >> 2)) & 1u;
                    if (!v) {
#pragma unroll
                        for (int r = 0; r < 16; ++r) { s0[r] = -INFINITY; s1[r] = -INFINITY; }
                    }
                } else if (kt * 64 + 63 > q0 + wave * 32) {
#pragma unroll
                    for (int r = 0; r < 16; ++r) {
                        const int key = kt * 64 + (r & 3) + 8 * (r >> 2) + 4 * hh;
                        s0[r] = (key <= tq) ? s0[r] : -INFINITY;
                        s1[r] = (key + 32 <= tq) ? s1[r] : -INFINITY;
                    }
                }
            }
            float mx = s0[0];
#pragma unroll
            for (int r = 1; r < 16; ++r) mx = fmaxf(mx, s0[r]);
#pragma unroll
            for (int r = 0; r < 16; ++r) mx = fmaxf(mx, s1[r]);
            mx = fmaxf(mx, __shfl_xor(mx, 32));
            const float mnew = fmaxf(m_run, mx);
            const float alpha = __builtin_amdgcn_exp2f((m_run - mnew) * CS);
            const float mc = mnew * CS;
            m_run = mnew;
            float ls = 0.f;
#pragma unroll
            for (int r = 0; r < 16; ++r) { s0[r] = __builtin_amdgcn_exp2f(fmaf(s0[r], CS, -mc)); ls += s0[r]; }
#pragma unroll
            for (int r = 0; r < 16; ++r) { s1[r] = __builtin_amdgcn_exp2f(fmaf(s1[r], CS, -mc)); ls += s1[r]; }
            l_run = l_run * alpha + ls;
            if (!__all(alpha == 1.0f)) {
#pragma unroll
                for (int r = 0; r < 16; ++r) { O0[r] *= alpha; O1[r] *= alpha; }
            }
#pragma unroll
            for (int ksub = 0; ksub < 2; ++ksub) {
#pragma unroll
                for (int sp = 0; sp < 2; ++sp) {
                    h8 pf;
#pragma unroll
                    for (int j = 0; j < 8; ++j) pf[j] = (half_t)(ksub ? s1[8 * sp + j] : s0[8 * sp + j]);
                    const int roff = (32 * ksub + 16 * sp) * 128;
                    {
                        const s4v lo = __builtin_amdgcn_ds_read_tr16_b64_v4i16((LAS s4v*)(base + vb0 + roff));
                        const s4v hi = __builtin_amdgcn_ds_read_tr16_b64_v4i16((LAS s4v*)(base + vb0 + roff + 8 * 128));
                        const h8 vf = __builtin_bit_cast(h8, __builtin_shufflevector(lo, hi, 0, 1, 2, 3, 4, 5, 6, 7));
                        O0 = __builtin_amdgcn_mfma_f32_32x32x16_f16(vf, pf, O0, 0, 0, 0);
                    }
                    {
                        const s4v lo = __builtin_amdgcn_ds_read_tr16_b64_v4i16((LAS s4v*)(base + vb1 + roff));
                        const s4v hi = __builtin_amdgcn_ds_read_tr16_b64_v4i16((LAS s4v*)(base + vb1 + roff + 8 * 128));
                        const h8 vf = __builtin_bit_cast(h8, __builtin_shufflevector(lo, hi, 0, 1, 2, 3, 4, 5, 6, 7));
                        O1 = __builtin_amdgcn_mfma_f32_32x32x16_f16(vf, pf, O1, 0, 0, 0);
                    }
                }
            }
        }
        kt = ktn; s ^= 1;
    }
    const float lt = l_run + __shfl_xor(l_run, 32);
    const float inv = 1.0f / lt;
    const int ycol = (MODE ? 640 : 256) + h * 64;
    half_t* dst = p->ycat + ((size_t)(ycol >> 5) * T_TOK + tokbase + tq) * 32 + 4 * hh;
#pragma unroll
    for (int g = 0; g < 4; ++g) {
        *(h4*)(dst + 8 * g) = pack4(O0[4 * g] * inv, O0[4 * g + 1] * inv, O0[4 * g + 2] * inv, O0[4 * g + 3] * inv);
        *(h4*)(dst + (size_t)T_TOK * 32 + 8 * g) = pack4(O1[4 * g] * inv, O1[4 * g + 1] * inv, O1[4 * g + 2] * inv, O1[4 * g + 3] * inv);
    }
}

__device__ __forceinline__ void phase_attn(KP p, char* lds) {
    for (int u = BID(); u < 3072; u += gridDim.x) {
        const int qt = 15 - (u / 192), rem = u % 192;
        const int type = rem & 1, bh = rem >> 1;
        if (type == 0) attn_unit<0>(p, lds, bh / 6, bh % 6, qt);
        else attn_unit<1>(p, lds, bh / 6, bh % 6, qt);
    }
}

__global__ void __launch_bounds__(256, 2) mk_fwd(Params p_unused) {
    extern __shared__ __attribute__((aligned(16))) char lds[];
    volatile LAS unsigned* stw = (volatile LAS unsigned*)(lds + LDS_CTL);
    if (threadIdx.x < 4) stw[threadIdx.x] = 0u;
    __syncthreads();
    KP p0 = (KP)__builtin_amdgcn_kernarg_segment_ptr();
    XcdBarrier bar; bar.bar = p0->bar; bar.x = 0; bar.st = stw;
#if !MK_SPLIT
    bar = xcd_barrier_post(p0->bar, stw);
#endif
    const int ph_lo = p0->ph_lo, ph_hi = p0->ph_hi;
    for (int ph = ph_lo; ph < ph_hi; ++ph) {
      KP p = p0; asm volatile("" : "+s"(p));
      const int nrep = (DUP_SUB >= 0 && ((DUP_SUB == 100 && ph == 0) || (ph >= 2 && ph < NPHASE - 1 && ((ph - 2) & 7) == DUP_SUB && (DUP_SUB != 4 || ph < 10)))) ? 2 : 1;
      for (int rep = 0; rep < nrep; ++rep) {
        if (ph == 0) phase_prologue(p, lds);
        else if (ph == 1) phase_modsum(p);
        else if (ph == NPHASE - 1) phase_norm<2>(p, lds, p->out, p->g_final, nullptr, nullptr, 0);
        else {
            const int l = (ph - 2) >> 3, sub = (ph - 2) & 7;
            const float* mf = p->modf + (size_t)l * 16 * 6144;
            const float* xin = l == 0 ? p->x : p->out;
            if (sub == 0) phase_norm<0>(p, lds, xin, p->g_mix + l * DM, mf, mf + 1024, l);
            else if (sub == 1) phase_inproj(p, lds, l);
            else if (sub == 2) phase_post(p, lds, l, rep ? POST_MASK : 7);
            else if (sub == 3) phase_attn(p, lds);
            else if (sub == 4) phase_outproj(p, lds, l, xin);
            else if (sub == 5) phase_norm<1>(p, lds, p->out, p->g_ffn + l * DM, mf + 3 * 1024, mf + 4 * 1024, (nrep == 2 && rep == 0) ? l + 2 : l);
            else if (sub == 6) phase_moe_up(p, lds, l);
            else phase_moe_down(p, lds, l, nrep == 2 ? 0.5f : 1.0f);
        }
      }
#if !MK_SPLIT
        if (ph + 1 < ph_hi) xcd_barrier(bar);
#endif
    }
}

extern "C" void kernel_launch(void* const* d_in, const int* in_sizes, int n_in, void* d_out, int out_size, void* d_ws, size_t ws_size, hipStream_t stream) {
    static int grid = 0;
    if (grid == 0) {
        int dev = 0, cus = 0, per_cu = 0;
        (void)hipGetDevice(&dev);
        (void)hipDeviceGetAttribute(&cus, hipDeviceAttributeMultiprocessorCount, dev);
        (void)hipFuncSetAttribute((const void*)mk_fwd, hipFuncAttributeMaxDynamicSharedMemorySize, LDS_BYTES);
        if (hipOccupancyMaxActiveBlocksPerMultiprocessor(&per_cu, (const void*)mk_fwd, 256, LDS_BYTES) != hipSuccess || per_cu < 1) per_cu = 1;
        (void)hipGetLastError();
        if (per_cu > 2) per_cu = 2;
        grid = cus * per_cu;
        fprintf(stderr, "mk_fwd: cus %d per_cu %d grid %d\n", cus, per_cu, grid);
    }
    Params p{};
    const float** pin = (const float**)&p.x;
    for (int i = 0; i < 18; ++i) pin[i] = (const float*)d_in[i];
    p.out = (float*)d_out;
    char* ws = (char*)d_ws;
    size_t off = 0;
    auto carve = [&](size_t bytes) { void* q = ws + off; off += (bytes + 255) & ~(size_t)255; return q; };
    p.bar = (unsigned*)carve(XCD_BAR_WORDS * 4);
    p.cnt = (int*)carve(4 * 32 * 64 * 4);
    const size_t zero_bytes = off;
    p.Wt_in = (half_t*)carve((size_t)2 * NP * DM * 2);
    p.Wt_o = (half_t*)carve((size_t)2 * DM * DM * 2);
    p.Wt_gu = (half_t*)carve((size_t)2 * 16 * 512 * 1024 * 2);
    p.Wt_d = (half_t*)carve((size_t)2 * 16 * 1024 * 256 * 2);
    p.hn = (half_t*)carve((size_t)T_TOK * DM * 2);
    p.P = (half_t*)carve((size_t)T_TOK * NP * 2);
    p.ycat = (half_t*)carve((size_t)T_TOK * DM * 2);
    p.act = (half_t*)carve((size_t)T_TOK * 512 * 2);
    p.modpart = (float*)carve((size_t)8 * 2 * 16 * 6144 * 4);
    p.modf = (float*)carve((size_t)2 * 16 * 6144 * 4);
    p.kmean = (float*)carve((size_t)16 * 6 * 8 * 64 * 4);
    p.rope = (float*)carve((size_t)2048 * 24 * 4);
    p.iwf = (float*)carve((size_t)T_TOK * 4 * 4);
    p.tokw = (float*)carve((size_t)T_TOK * 2 * 4);
    p.dmask = (unsigned*)carve((size_t)T_TOK * 64 * 4);
    p.lists = (int*)carve((size_t)NCLS * T_TOK * 4);
    if (off > ws_size) { fprintf(stderr, "workspace too small: need %zu have %zu\n", off, ws_size); return; }
    (void)hipMemsetAsync(d_ws, 0, zero_bytes, stream);
#if MK_SPLIT
    for (int ph = 0; ph < NPHASE; ++ph) {
        p.ph_lo = ph; p.ph_hi = ph + 1;
        hipLaunchKernelGGL(mk_fwd, dim3(grid), dim3(256), LDS_BYTES, stream, p);
    }
#else
    p.ph_lo = 0; p.ph_hi = NPHASE;
    hipLaunchKernelGGL(mk_fwd, dim3(grid), dim3(256), LDS_BYTES, stream, p);
#endif
}
```

```cpp
#include <hip/hip_runtime.h>
#include <cstdio>
#include <cstdint>

#ifndef MK_SPLIT
#define MK_SPLIT 0
#endif

#define T_TOK 32768
#define DM 1024
#define SEQ 2048
#define INW 2340
#define NP 2432
#define PC_CU 0
#define PC_CG 256
#define PC_DQ 512
#define PC_DK 896
#define PC_DV 960
#define PC_IQ 1024
#define PC_IK 1152
#define PC_IW 1184
#define PC_MQ 1280
#define PC_MK 1664
#define PC_MV 2048
#define LOG_THETA 13.122363377404328f
#define NCLS 24
#define LDS_CTL 73728
#define LDS_BYTES 78336
#define NPHASE 19
#ifndef DUP_SUB
#define DUP_SUB -1
#endif

typedef _Float16 half_t;
typedef _Float16 h8 __attribute__((ext_vector_type(8)));
typedef _Float16 h4 __attribute__((ext_vector_type(4)));
typedef short s4v __attribute__((ext_vector_type(4)));
typedef short s8v __attribute__((ext_vector_type(8)));
typedef float f16v __attribute__((ext_vector_type(16)));
typedef float f4v __attribute__((ext_vector_type(4)));
#define LAS __attribute__((address_space(3)))

struct Params {
    const float *x, *c, *w_ada, *b_ada, *g_mix, *w_in, *w_dw, *b_dw, *ln_g, *ln_b, *w_o, *g_ffn, *w_router, *b_router, *w_gate, *w_up, *w_down, *g_final;
    float* out;
    half_t *Wt_in, *Wt_o, *Wt_gu, *Wt_d, *hn, *P, *ycat, *act;
    float *modpart, *modf, *kmean, *rope, *iwf, *tokw;
    unsigned* dmask; int* cnt; int* lists; unsigned* bar;
    int ph_lo, ph_hi;
};

#define XB_TMO      128
#define XB_XCNT(j)  (256  + 64 * (j))
#define XB_XSUB(j)  (1280 + 64 * (j))
#define XB_XGEN(j)  (2304 + 64 * (j))
#define XB_TOP      3328
#define XB_TOPGEN   3392
#define XCD_BAR_WORDS 3456
#define XB_SPIN_CAP (1u << 20)
__device__ __forceinline__ unsigned xb_ld(unsigned* p)              { return __hip_atomic_load(p, __ATOMIC_RELAXED, __HIP_MEMORY_SCOPE_AGENT); }
__device__ __forceinline__ unsigned xb_add(unsigned* p, unsigned v) { return __hip_atomic_fetch_add(p, v, __ATOMIC_RELAXED, __HIP_MEMORY_SCOPE_AGENT); }
__device__ __forceinline__ unsigned xb_xcc_id() { return (unsigned)__builtin_amdgcn_s_getreg((3 << 11) | 20) & 0xFu; }
#define XB_SPIN(cond, bar) do { unsigned _sp = 0; while (cond) { __builtin_amdgcn_s_sleep(1); \
    if ((++_sp & 255u) == 0u) { if (xb_ld(&(bar)[XB_TMO])) break; if (_sp > XB_SPIN_CAP) { atomicAdd(&(bar)[XB_TMO], 1u); break; } } } } while (0)
struct XcdBarrier { unsigned* bar; unsigned x; volatile LAS unsigned* st; };
__device__ __forceinline__ XcdBarrier xcd_barrier_post(unsigned* bar, volatile LAS unsigned* st) {
    XcdBarrier b; b.bar = bar; b.x = xb_xcc_id(); b.st = st;
    if (threadIdx.x == 0) (void)xb_add(&bar[XB_XCNT(b.x)], 1u);
    return b;
}
__device__ __forceinline__ void xcd_barrier_complete(unsigned* bar, unsigned x, unsigned& nloc, unsigned& nx) {
    const unsigned G = gridDim.x * gridDim.y * gridDim.z;
    unsigned sum, cnt, mine, sp = 0u;
    for (;;) {
        sum = 0u; cnt = 0u; mine = 0u;
#pragma unroll
        for (unsigned j = 0; j < 16; ++j) { const unsigned c = xb_ld(&bar[XB_XCNT(j)]); sum += c; cnt += (c > 0u) ? 1u : 0u; mine = (j == x) ? c : mine; }
        if (sum == G) break;
        __builtin_amdgcn_s_sleep(1);
        if ((++sp & 255u) == 0u) { if (xb_ld(&bar[XB_TMO])) break; if (sp > XB_SPIN_CAP) { atomicAdd(&bar[XB_TMO], 1u); break; } }
    }
    nloc = mine > 0u ? mine : 1u; nx = cnt > 0u ? cnt : 1u;
}
__device__ __forceinline__ void xcd_barrier(const XcdBarrier& b) {
    asm volatile("s_waitcnt vmcnt(0)" ::: "memory");
    __syncthreads();
    if (threadIdx.x == 0) {
        unsigned* bar = b.bar;
        __builtin_amdgcn_s_waitcnt(0);
        unsigned nloc = b.st[0], nx = b.st[1];
        if (nloc == 0u) { xcd_barrier_complete(bar, b.x, nloc, nx); b.st[0] = nloc; b.st[1] = nx; }
        const unsigned old = xb_add(&bar[XB_XSUB(b.x)], 1u);
        const unsigned gen = old / nloc;
        if (old + 1u == (gen + 1u) * nloc) {
            __builtin_amdgcn_fence(__ATOMIC_RELEASE, "agent");
            asm volatile("s_waitcnt vmcnt(0)" ::: "memory");
            const unsigned og = xb_add(&bar[XB_TOP], 1u);
            const unsigned tg = og / nx;
            if (og + 1u == (tg + 1u) * nx) xb_add(&bar[XB_TOPGEN], 1u);
            else XB_SPIN(xb_ld(&bar[XB_TOPGEN]) == tg, bar);
            __builtin_amdgcn_fence(__ATOMIC_ACQUIRE, "agent");
            xb_add(&bar[XB_XGEN(b.x)], 1u);
            asm volatile("s_waitcnt vmcnt(0)" ::: "memory");
        } else {
            XB_SPIN(xb_ld(&bar[XB_XGEN(b.x)]) == gen, bar);
            __builtin_amdgcn_fence(__ATOMIC_ACQUIRE, "agent");
            asm volatile("s_waitcnt vmcnt(0)" ::: "memory");
        }
    }
    __syncthreads();
}

typedef const __attribute__((address_space(4))) Params* KP;
__device__ __forceinline__ int TID() { int t = threadIdx.x; asm volatile("" : "+v"(t)); return t; }
__device__ __forceinline__ int BID() { int b = blockIdx.x; asm volatile("" : "+s"(b)); return b; }
__device__ __forceinline__ float sigmoidf_(float v) { return 1.0f / (1.0f + __expf(-v)); }
__device__ __forceinline__ void glds16(const void* g, char* l) { __builtin_amdgcn_global_load_lds((const unsigned*)g, (unsigned*)l, 16, 0, 0); }
__device__ __forceinline__ unsigned f2sortable(float f) { unsigned u = __float_as_uint(f); return (u & 0x80000000u) ? ~u : (u | 0x80000000u); }
__device__ __forceinline__ h4 pack4(float a, float b, float c, float d) { h4 r = {(half_t)a, (half_t)b, (half_t)c, (half_t)d}; return r; }

template <class CF>
__device__ __forceinline__ void conv_tile_panel(char* lds, CF colf, int src_ld, int k0, int n0, half_t* dst, int nrows) {
    float* tl = (float*)lds;
    const int tid = TID();
    __syncthreads();
    {
        const int nn = tid & 63;
        const float* cp = colf(nn);
        float tv[16];
#pragma unroll
        for (int i = 0; i < 16; ++i) { const int k = i * 4 + (tid >> 6); tv[i] = cp ? cp[(size_t)(k0 + k) * src_ld] : 0.f; }
#pragma unroll
        for (int i = 0; i < 16; ++i) { const int k = i * 4 + (tid >> 6); tl[k * 65 + nn] = tv[i]; }
    }
    __syncthreads();
    {
        const int n = tid >> 2, kq = (tid & 3) * 16;
        h8 a, b;
#pragma unroll
        for (int j = 0; j < 8; ++j) { a[j] = (half_t)tl[(kq + j) * 65 + n]; b[j] = (half_t)tl[(kq + 8 + j) * 65 + n]; }
        const int k = k0 + kq;
        h8* d = (h8*)(dst + ((size_t)(k >> 5) * nrows + n0 + n) * 32 + (k & 31));
        d[0] = a; d[1] = b;
    }
}
template <class CF>
__device__ __forceinline__ void conv_tile(char* lds, CF colf, int src_ld, int k0, half_t* dst_tile  , int dstK) {
    float* tl = (float*)lds;
    const int tid = TID();
    __syncthreads();
    {
        const int nn = tid & 63;
        const float* cp = colf(nn);
        float tv[16];
#pragma unroll
        for (int i = 0; i < 16; ++i) { const int k = i * 4 + (tid >> 6); tv[i] = cp ? cp[(size_t)(k0 + k) * src_ld] : 0.f; }
#pragma unroll
        for (int i = 0; i < 16; ++i) { const int k = i * 4 + (tid >> 6); tl[k * 65 + nn] = tv[i]; }
    }
    __syncthreads();
    {
        const int n = tid >> 2, kq = (tid & 3) * 16;
        h8 a, b;
#pragma unroll
        for (int j = 0; j < 8; ++j) { a[j] = (half_t)tl[(kq + j) * 65 + n]; b[j] = (half_t)tl[(kq + 8 + j) * 65 + n]; }
        h8* d = (h8*)(dst_tile + (size_t)n * dstK + kq);
        d[0] = a; d[1] = b;
    }
}

__device__ __forceinline__ void phase_prologue(KP p, char* lds) {
    const int tid = TID();
    const int NA = 2 * 16 * 38, NB = 2 * 16 * 16, NC = 2 * 16 * 16 * 8, ND = 2 * 16 * 4 * 16, NE = 384, NF = 8;
    const int total = NA + NB + NC + ND + NE + NF;
    for (int u0 = BID(); u0 < total; u0 += gridDim.x) {
        int u = u0;
        if (u < NA) {
            const int nt = u % 38, kt = (u / 38) % 16, l = u / (38 * 16);
            const float* src = p->w_in + (size_t)l * DM * INW;
            const int n0 = nt * 64;
            conv_tile_panel(lds, [&](int nn) -> const float* { const int np = n0 + nn; const int sc = np < 512 ? (((np & 63) < 32) ? 32 * (np >> 6) + (np & 31) : 256 + 32 * (np >> 6) + (np & 31)) : (np < 1188 ? np : (np < 1280 ? -1 : np - 92)); return sc >= 0 ? src + sc : (const float*)nullptr; },
                      INW, kt * 64, n0, p->Wt_in + (size_t)l * NP * DM, NP);
            continue;
        }
        u -= NA;
        if (u < NB) {
            const int nt = u % 16, kt = (u / 16) % 16, l = u / 256;
            const float* src = p->w_o + (size_t)l * DM * DM + nt * 64;
            conv_tile_panel(lds, [&](int nn) -> const float* { return src + nn; }, DM, kt * 64, nt * 64, p->Wt_o + (size_t)l * DM * DM, DM);
            continue;
        }
        u -= NB;
        if (u < NC) {
            const int nt = u % 8, kt = (u / 8) % 16, le = u / 128;
            const float* sg = p->w_gate + (size_t)le * 1024 * 256 + nt * 32;
            const float* su = p->w_up + (size_t)le * 1024 * 256 + nt * 32;
            conv_tile(lds, [&](int nn) -> const float* { return nn < 32 ? sg + nn : su + (nn - 32); }, 256, kt * 64, p->Wt_gu + ((size_t)le * 512 + nt * 64) * 1024 + kt * 64, 1024);
            continue;
        }
        u -= NC;
        if (u < ND) {
            const int nt = u % 16, kt = (u / 16) % 4, le = u / 64;
            const float* src = p->w_down + (size_t)le * 256 * 1024 + nt * 64;
            conv_tile(lds, [&](int nn) -> const float* { return src + nn; }, 1024, kt * 64, p->Wt_d + ((size_t)le * 1024 + nt * 64) * 256 + kt * 64, 256);
            continue;
        }
        u -= ND;
        if (u < NE) {
            const int kc = u % 8, cc = (u / 8) % 24, l = u / 192;
            float* ca = (float*)lds;
            __syncthreads();
            for (int i = tid; i < 2048; i += 256) { const int b = i >> 7, k = i & 127; const float v = p->c[b * 1024 + kc * 128 + k]; ca[i] = v / (1.0f + expf(-v)); }
            __syncthreads();
            const int n = cc * 256 + tid;
            float acc[16];
#pragma unroll
            for (int b = 0; b < 16; ++b) acc[b] = 0.f;
            const float* w = p->w_ada + ((size_t)l * 1024 + kc * 128) * 6144 + n;
#pragma unroll 16
            for (int k = 0; k < 128; ++k) {
                const float wv = w[(size_t)k * 6144];
#pragma unroll
                for (int b = 0; b < 16; ++b) acc[b] = fmaf(ca[b * 128 + k], wv, acc[b]);
            }
#pragma unroll
            for (int b = 0; b < 16; ++b) p->modpart[(((size_t)kc * 2 + l) * 16 + b) * 6144 + n] = acc[b];
            continue;
        }
        u -= NE;
        {
            for (int i = u * 256 + tid; i < 2048 * 12; i += NF * 256) {
                const int t = i / 12, r = i % 12;
                const int fi = r < 8 ? r : r - 8;
                const float rot = r < 8 ? 16.f : 8.f;
                const float inv = expf(-LOG_THETA * ((float)fi * 2.0f / rot));
                const float ang = (float)t * inv;
                float sn, cs; sincosf(ang, &sn, &cs);
                if (r < 8) { p->rope[t * 8 + fi] = cs; p->rope[16384 + t * 8 + fi] = sn; }
                else { p->rope[32768 + t * 4 + fi] = cs; p->rope[32768 + 8192 + t * 4 + fi] = sn; }
            }
        }
    }
}

__device__ __forceinline__ void phase_modsum(KP p) {
    for (int i = BID() * 256 + TID(); i < 2 * 16 * 6144; i += gridDim.x * 256) {
        const int n = i % 6144, l = i / (16 * 6144);
        float s = p->b_ada[l * 6144 + n];
#pragma unroll
        for (int kc = 0; kc < 8; ++kc) s += p->modpart[(size_t)kc * (2 * 16 * 6144) + i];
        p->modf[i] = s;
    }
}

__device__ __forceinline__ void route_flush(KP p, char* lds, int lane, int wave, int n, int myrow, int layer) {
    const float* lg = (const float*)(lds + LDS_CTL + 512) + wave * 256;
    int* lc = (int*)(lds + LDS_CTL + 64);
    int* lbase = lc + 32;
    const int tid = wave * 64 + lane;
    if (tid < 32) lc[tid] = 0;
    __syncthreads();
    int cls = 0, lpos = 0;
    if (lane < n) {
        float aff[16], bia[16];
#pragma unroll
        for (int e = 0; e < 16; ++e) { aff[e] = 1.0f / (1.0f + expf(-lg[lane * 16 + e])); bia[e] = aff[e] + p->b_router[e]; }
        int bestg = 0; float bests = -INFINITY;
#pragma unroll
        for (int gi = 0; gi < 4; ++gi) {
            float m1 = -INFINITY, m2 = -INFINITY;
#pragma unroll
            for (int j = 0; j < 4; ++j) { const float vv = bia[gi * 4 + j]; if (vv > m1) { m2 = m1; m1 = vv; } else if (vv > m2) m2 = vv; }
            const float s = m1 + m2;
            if (s > bests) { bests = s; bestg = gi; }
        }
        float bsel[4], asel[4];
#pragma unroll
        for (int j = 0; j < 4; ++j) { bsel[j] = 0.f; asel[j] = 0.f; }
#pragma unroll
        for (int gi = 0; gi < 4; ++gi) if (gi == bestg) {
#pragma unroll
            for (int j = 0; j < 4; ++j) { bsel[j] = bia[gi * 4 + j]; asel[j] = aff[gi * 4 + j]; }
        }
        int i1 = -1, i2 = -1; float v1 = -INFINITY, v2 = -INFINITY;
#pragma unroll
        for (int j = 0; j < 4; ++j) { const float vv = bsel[j]; if (vv > v1) { v2 = v1; i2 = i1; v1 = vv; i1 = j; } else if (vv > v2) { v2 = vv; i2 = j; } }
        const int a = i1 < i2 ? i1 : i2, bb = i1 < i2 ? i2 : i1;
        float wa = 0.f, wb = 0.f;
#pragma unroll
        for (int j = 0; j < 4; ++j) { if (j == a) wa = asel[j]; if (j == bb) wb = asel[j]; }
        const float sw = wa + wb;
        const int pi = (a == 0) ? (bb - 1) : (a == 1 ? (bb + 1) : 5);
        cls = bestg * 6 + pi;
        *(float2*)(p->tokw + (size_t)myrow * 2) = make_float2(wa / sw, wb / sw);
        lpos = atomicAdd(&lc[cls], 1);
    }
    __syncthreads();
    if (tid < NCLS) { const int c = lc[tid]; lbase[tid] = c ? atomicAdd(&p->cnt[(layer * 32 + tid) * 64], c) : 0; }
    __syncthreads();
    if (lane < n) p->lists[(size_t)cls * T_TOK + lbase[cls] + lpos] = myrow;
}

template <int MODE>
__device__ __forceinline__ void phase_norm(KP p, char* lds, const float* xin, const float* g, const float* sh, const float* sc, int layer) {
    const int lane = TID() & 63, wave = TID() >> 6;
    float* wt = (float*)lds;
    if (MODE == 1) {
        __syncthreads();
        for (int i = TID(); i < 4096; i += 256) {
            const float4 w4 = ((const float4*)p->w_router)[i];
            const int k = i >> 2, e0 = (i & 3) * 4;
            wt[(e0 + 0) * 1024 + k] = w4.x; wt[(e0 + 1) * 1024 + k] = w4.y; wt[(e0 + 2) * 1024 + k] = w4.z; wt[(e0 + 3) * 1024 + k] = w4.w;
        }
        __syncthreads();
    }
    float* lgb = (float*)(lds + LDS_CTL + 512);
    int myrow = 0, it = 0;
    float4 vn[4];
    {
        const int row0 = BID() * 4 + wave;
        const float4* xr = (const float4*)(xin + (size_t)(row0 < T_TOK ? row0 : 0) * DM);
#pragma unroll
        for (int i = 0; i < 4; ++i) vn[i] = xr[lane + 64 * i];
    }
    for (int row = BID() * 4 + wave; row < T_TOK; row += gridDim.x * 4) {
        const int b = row >> 11;
        float4 v[4]; float ss = 0.f;
#pragma unroll
        for (int i = 0; i < 4; ++i) v[i] = vn[i];
        {
            const int rown = row + gridDim.x * 4;
            const float4* xr = (const float4*)(xin + (size_t)(rown < T_TOK ? rown : row) * DM);
#pragma unroll
            for (int i = 0; i < 4; ++i) vn[i] = xr[lane + 64 * i];
        }
#pragma unroll
        for (int i = 0; i < 4; ++i) ss += v[i].x * v[i].x + v[i].y * v[i].y + v[i].z * v[i].z + v[i].w * v[i].w;
#pragma unroll
        for (int o = 32; o >= 1; o >>= 1) ss += __shfl_xor(ss, o);
        const float rstd = 1.0f / sqrtf(ss * (1.0f / 1024.0f) + 1e-6f);
        float acc[16], ya[16];
#pragma unroll
        for (int i = 0; i < 4; ++i) {
            const int k = (lane + 64 * i) * 4;
            const float4 gg = *(const float4*)(g + k);
            float y[4] = {v[i].x * rstd * gg.x, v[i].y * rstd * gg.y, v[i].z * rstd * gg.z, v[i].w * rstd * gg.w};
            if (MODE != 2) {
                const float4 s1 = *(const float4*)(sh + (size_t)b * 6144 + k), s2 = *(const float4*)(sc + (size_t)b * 6144 + k);
                y[0] = y[0] * (1.f + s2.x) + s1.x; y[1] = y[1] * (1.f + s2.y) + s1.y; y[2] = y[2] * (1.f + s2.z) + s1.z; y[3] = y[3] * (1.f + s2.w) + s1.w;
                if (MODE == 0) *(h4*)(p->hn + ((size_t)(k >> 5) * T_TOK + row) * 32 + (k & 31)) = pack4(y[0], y[1], y[2], y[3]);
                else *(h4*)(p->hn + (size_t)row * DM + k) = pack4(y[0], y[1], y[2], y[3]);
            } else {
                *(float4*)(p->out + (size_t)row * DM + k) = make_float4(y[0], y[1], y[2], y[3]);
            }
            ya[4 * i] = y[0]; ya[4 * i + 1] = y[1]; ya[4 * i + 2] = y[2]; ya[4 * i + 3] = y[3];
        }
        if (MODE == 1) {
#pragma unroll
            for (int e = 0; e < 16; ++e) acc[e] = 0.f;
            float4 wq[2][4];
            const float* wl = wt + lane * 4;
#pragma unroll
            for (int e = 0; e < 4; ++e) wq[0][e] = *(const float4*)(wl + e * 1024);
#pragma unroll
            for (int st = 0; st < 16; ++st) {
                const int i = st >> 2, eg = st & 3, cur = st & 1;
                if (st + 1 < 16) {
                    const int i2 = (st + 1) >> 2, eg2 = (st + 1) & 3;
#pragma unroll
                    for (int e = 0; e < 4; ++e) wq[cur ^ 1][e] = *(const float4*)(wl + (eg2 * 4 + e) * 1024 + i2 * 256);
                }
#pragma unroll
                for (int e = 0; e < 4; ++e) {
                    const float4 w4 = wq[cur][e];
                    acc[eg * 4 + e] = fmaf(ya[4 * i], w4.x, fmaf(ya[4 * i + 1], w4.y, fmaf(ya[4 * i + 2], w4.z, fmaf(ya[4 * i + 3], w4.w, acc[eg * 4 + e]))));
                }
                __builtin_amdgcn_sched_barrier(0);
            }
        }
        if (MODE == 1) {
            const bool b5 = lane & 32, b4 = lane & 16, b3 = lane & 8, b2 = lane & 4;
            float r8[8], r4[4], r2[2];
#pragma unroll
            for (int e = 0; e < 8; ++e) { const float snd = b5 ? acc[e] : acc[e + 8], kp = b5 ? acc[e + 8] : acc[e]; r8[e] = kp + __shfl_xor(snd, 32); }
#pragma unroll
            for (int e = 0; e < 4; ++e) { const float snd = b4 ? r8[e] : r8[e + 4], kp = b4 ? r8[e + 4] : r8[e]; r4[e] = kp + __shfl_xor(snd, 16); }
#pragma unroll
            for (int e = 0; e < 2; ++e) { const float snd = b3 ? r4[e] : r4[e + 2], kp = b3 ? r4[e + 2] : r4[e]; r2[e] = kp + __shfl_xor(snd, 8); }
            float rv; { const float snd = b2 ? r2[0] : r2[1], kp = b2 ? r2[1] : r2[0]; rv = kp + __shfl_xor(snd, 4); }
            rv += __shfl_xor(rv, 2); rv += __shfl_xor(rv, 1);
            if ((lane & 3) == 0) lgb[(wave * 16 + it) * 16 + (lane >> 2)] = rv;
            if (lane == it) myrow = row;
            ++it;
            if (it == 16) { route_flush(p, lds, lane, wave, it, myrow, layer); it = 0; }
        }
    }
    if (MODE == 1 && it > 0) route_flush(p, lds, lane, wave, it, myrow, layer);
}

template <class WF, class XF, class EPI>
__device__ __forceinline__ void gemm_tile(char* lds, int nkt, WF wf, XF xf, EPI epi) {
    const int tid = TID(), lane = tid & 63, wave = tid >> 6;
    const int wn = wave & 1, wm = wave >> 1, hh = lane >> 5;
    const int lrow = tid >> 3;
    const int lchunk = (tid & 7) ^ ((tid >> 4) & 7);
    const half_t* xs[4];
#pragma unroll
    for (int i = 0; i < 4; ++i) xs[i] = xf(lrow + 32 * i) + lchunk * 8;
    char* ldst = lds + lrow * 128 + (tid & 7) * 16;
    f16v acc[2][2];
#pragma unroll
    for (int i = 0; i < 2; ++i)
#pragma unroll
        for (int j = 0; j < 2; ++j)
#pragma unroll
            for (int r = 0; r < 16; ++r) acc[i][j][r] = 0.f;
    auto issue = [&](int kt, int s) {
        char* d = ldst + s * 32768;
#pragma unroll
        for (int i = 0; i < 4; ++i) glds16(wf(kt, lrow + 32 * i) + lchunk * 8, d + i * 4096);
#pragma unroll
        for (int i = 0; i < 4; ++i) glds16(xs[i] + kt * 64, d + 16384 + i * 4096);
    };
    __syncthreads();
    issue(0, 0);
    const int rsw = (lane >> 1) & 7;
    const int roff_w = (wn * 64 + (lane & 31)) * 128, roff_x = 16384 + (wm * 64 + (lane & 31)) * 128;
    for (int kt = 0; kt < nkt; ++kt) {
        asm volatile("s_waitcnt vmcnt(0)" ::: "memory");
        __syncthreads();
        if (kt + 1 < nkt) issue(kt + 1, (kt + 1) & 1);
        const char* base = lds + (kt & 1) * 32768;
#pragma unroll
        for (int ks = 0; ks < 4; ++ks) {
            const int co = ((2 * ks + hh) ^ rsw) << 4;
            const h8 a0 = *(const h8*)(base + roff_w + co), a1 = *(const h8*)(base + roff_w + 4096 + co);
            const h8 b0 = *(const h8*)(base + roff_x + co), b1 = *(const h8*)(base + roff_x + 4096 + co);
            acc[0][0] = __builtin_amdgcn_mfma_f32_32x32x16_f16(a0, b0, acc[0][0], 0, 0, 0);
            acc[0][1] = __builtin_amdgcn_mfma_f32_32x32x16_f16(a0, b1, acc[0][1], 0, 0, 0);
            acc[1][0] = __builtin_amdgcn_mfma_f32_32x32x16_f16(a1, b0, acc[1][0], 0, 0, 0);
            acc[1][1] = __builtin_amdgcn_mfma_f32_32x32x16_f16(a1, b1, acc[1][1], 0, 0, 0);
        }
    }
    epi(acc, wn, wm, lane);
}

template <class WF, class XF, class EPI>
__device__ __forceinline__ void gemm_tile2(char* lds, int nkt, size_t xkstride, WF wf, XF xf, EPI epi) {
    const int tid = TID(), lane = tid & 63, wave = tid >> 6;
    const int wn = wave & 1, wm = wave >> 1, hh = lane >> 5;
    const int lrow = tid >> 2;
    const int lchunk = (tid & 3) ^ ((tid >> 4) & 3);
    const half_t* xs[2];
#pragma unroll
    for (int i = 0; i < 2; ++i) xs[i] = xf(lrow + 64 * i) + lchunk * 8;
    char* ldst = lds + lrow * 64 + (tid & 3) * 16;
    f16v acc[4][2];
#pragma unroll
    for (int i = 0; i < 4; ++i)
#pragma unroll
        for (int j = 0; j < 2; ++j)
#pragma unroll
            for (int r = 0; r < 16; ++r) acc[i][j][r] = 0.f;
    auto issue = [&](int kt, int s) {
        char* d = ldst + s * 24576;
#pragma unroll
        for (int i = 0; i < 4; ++i) glds16(wf(kt, lrow + 64 * i) + lchunk * 8, d + i * 4096);
#pragma unroll
        for (int i = 0; i < 2; ++i) glds16(xs[i] + (size_t)kt * xkstride, d + 16384 + i * 4096);
    };
    __syncthreads();
    issue(0, 0); issue(1, 1);
    const int rsw = (lane >> 2) & 3;
    const int roff_w = (wn * 128 + (lane & 31)) * 64, roff_x = 16384 + (wm * 64 + (lane & 31)) * 64;
    int st = 0;
    for (int kt = 0; kt < nkt; ++kt) {
        if (kt + 1 < nkt) asm volatile("s_waitcnt vmcnt(6)" ::: "memory");
        else asm volatile("s_waitcnt vmcnt(0)" ::: "memory");
        asm volatile("s_waitcnt lgkmcnt(0)" ::: "memory");
        __builtin_amdgcn_s_barrier();
        if (kt + 2 < nkt) issue(kt + 2, st >= 1 ? st - 1 : 2);
        const char* base = lds + st * 24576;
        st = st == 2 ? 0 : st + 1;
#pragma unroll
        for (int ks = 0; ks < 2; ++ks) {
            const int co = ((2 * ks + hh) ^ rsw) << 4;
            h8 a[4], b[2];
#pragma unroll
            for (int i = 0; i < 4; ++i) a[i] = *(const h8*)(base + roff_w + i * 2048 + co);
#pragma unroll
            for (int j = 0; j < 2; ++j) b[j] = *(const h8*)(base + roff_x + j * 2048 + co);
#pragma unroll
            for (int i = 0; i < 4; ++i)
#pragma unroll
                for (int j = 0; j < 2; ++j) acc[i][j] = __builtin_amdgcn_mfma_f32_32x32x16_f16(a[i], b[j], acc[i][j], 0, 0, 0);
        }
    }
    epi(acc, wn, wm, lane);
}

__device__ __forceinline__ void phase_inproj(KP p, char* lds, int l) {
    const half_t* W = p->Wt_in + (size_t)l * NP * DM;
    const float* rc16 = p->rope; const float* rs16 = p->rope + 16384; const float* rc8 = p->rope + 32768; const float* rs8 = p->rope + 32768 + 8192;
    for (int u = BID(); u < 256 * 10; u += gridDim.x) {
        const int xl = u & 7, Lx = u >> 3, mi = Lx & 7, rr_ = Lx >> 3;
        const int nt = rr_ % 10, mt = 32 * xl + 8 * (rr_ / 10) + mi;
        gemm_tile2(lds, 32, (size_t)T_TOK * 32,
            [&](int kt, int row) { int n = nt * 256 + row; n = n < NP ? n : NP - 1; return W + ((size_t)kt * NP + n) * 32; },
            [&](int row) { return p->hn + (size_t)(mt * 128 + row) * 32; },
            [&](f16v (&acc)[4][2], int wn, int wm, int lane) {
                const int hh = lane >> 5;
                half_t* stg = (half_t*)lds;
                __syncthreads();
#pragma unroll
                for (int i = 0; i < 4; ++i) {
                    const int nb = nt * 256 + wn * 128 + i * 32;
                    if (nb == 1216 || nb == 1248 || nb >= NP) continue;
                    if (nt < 2) {
                        if (i & 1) continue;
#pragma unroll
                        for (int j = 0; j < 2; ++j) {
                            half_t* dst = stg + (wm * 64 + j * 32 + (lane & 31)) * 260 + wn * 64 + (i >> 1) * 32 + 4 * hh;
#pragma unroll
                            for (int g = 0; g < 4; ++g) {
                                float a4[4];
#pragma unroll
                                for (int r = 0; r < 4; ++r) a4[r] = acc[i][j][4 * g + r] * sigmoidf_(acc[i + 1][j][4 * g + r]);
                                *(h4*)(dst + 8 * g) = pack4(a4[0], a4[1], a4[2], a4[3]);
                            }
                        }
                        continue;
                    }
                    const bool rope64 = ((nb >= PC_DQ && nb < PC_DV) || (nb >= PC_MQ && nb < PC_MV)) && ((nb & 63) == 0);
                    const bool rope32 = (nb >= PC_IQ && nb < PC_IW);
#pragma unroll
                    for (int j = 0; j < 2; ++j) {
                        const int tok = mt * 128 + wm * 64 + j * 32 + (lane & 31);
                        const int t = tok & 2047;
                        f16v v = acc[i][j];
                        if (nb == PC_IW) { if (hh == 0) *(float4*)(p->iwf + (size_t)tok * 4) = make_float4(v[0], v[1], v[2], v[3]); continue; }
                        if (rope64) {
                            const float4 c4 = *(const float4*)(rc16 + t * 8 + 4 * hh), s4 = *(const float4*)(rs16 + t * 8 + 4 * hh);
                            const float cc[4] = {c4.x, c4.y, c4.z, c4.w}, sn[4] = {s4.x, s4.y, s4.z, s4.w};
#pragma unroll
                            for (int r = 0; r < 4; ++r) { const float x1 = v[r], x2 = v[r + 4]; v[r] = x1 * cc[r] - x2 * sn[r]; v[r + 4] = x2 * cc[r] + x1 * sn[r]; }
                        } else if (rope32) {
                            const float4 c4 = *(const float4*)(rc8 + t * 4), s4 = *(const float4*)(rs8 + t * 4);
                            const float cc[4] = {c4.x, c4.y, c4.z, c4.w}, sn[4] = {s4.x, s4.y, s4.z, s4.w};
#pragma unroll
                            for (int r = 0; r < 4; ++r) { const float o = __shfl_xor(v[r], 32); v[r] = hh ? (v[r] * cc[r] + o * sn[r]) : (v[r] * cc[r] - o * sn[r]); }
                        }
                        half_t* dst = stg + (wm * 64 + j * 32 + (lane & 31)) * 260 + wn * 128 + i * 32 + 4 * hh;
#pragma unroll
                        for (int g = 0; g < 4; ++g) *(h4*)(dst + 8 * g) = pack4(v[4 * g], v[4 * g + 1], v[4 * g + 2], v[4 * g + 3]);
                    }
                }
                __syncthreads();
                const int wv_ = TID() >> 6;
#pragma unroll 4
                for (int it = 0; it < 32; ++it) {
                    const int row = it * 4 + wv_;
                    const uint2 v2 = *(const uint2*)(stg + row * 260 + lane * 4);
                    if (nt < 2) { if (lane < 32) *(uint2*)(p->P + (size_t)(mt * 128 + row) * NP + nt * 128 + lane * 4) = v2; }
                    else { const int n = nt * 256 + lane * 4; if (n < NP) *(uint2*)(p->P + (size_t)(mt * 128 + row) * NP + n) = v2; }
                }
            });
    }
}

__device__ __forceinline__ void stage_acc_f32(char* lds, const f16v (&acc)[2][2], int wn, int wm, int lane) {
    float* stg = (float*)lds;
    const int hh = lane >> 5;
    __syncthreads();
#pragma unroll
    for (int j = 0; j < 2; ++j)
#pragma unroll
        for (int i = 0; i < 2; ++i)
#pragma unroll
            for (int g = 0; g < 4; ++g)
                *(float4*)(stg + (wm * 64 + j * 32 + (lane & 31)) * 132 + wn * 64 + i * 32 + 4 * hh + 8 * g) = make_float4(acc[i][j][4 * g], acc[i][j][4 * g + 1], acc[i][j][4 * g + 2], acc[i][j][4 * g + 3]);
    __syncthreads();
}
__device__ __forceinline__ void phase_outproj(KP p, char* lds, int l, const float* xin) {
    const half_t* W = p->Wt_o + (size_t)l * DM * DM;
    const float* g1 = p->modf + (size_t)l * 16 * 6144 + 2 * 1024;
    for (int u = BID(); u < 256 * 4; u += gridDim.x) {
        const int xl = u & 7, Lx = u >> 3, mi = Lx & 7, rr_ = Lx >> 3;
        const int nt = rr_ & 3, mt = 32 * xl + 8 * (rr_ >> 2) + mi;
        gemm_tile2(lds, 32, (size_t)T_TOK * 32,
            [&](int kt, int row) { return W + ((size_t)kt * DM + nt * 256 + row) * 32; },
            [&](int row) { return p->ycat + (size_t)(mt * 128 + row) * 32; },
            [&](f16v (&acc)[4][2], int wn, int wm, int lane) {
                const int hh = lane >> 5, tid = TID();
                float* stg = (float*)lds;
#pragma unroll
                for (int rnd = 0; rnd < 2; ++rnd) {
                    __syncthreads();
                    if (wm == rnd) {
#pragma unroll
                        for (int j = 0; j < 2; ++j)
#pragma unroll
                            for (int i = 0; i < 4; ++i)
#pragma unroll
                                for (int g = 0; g < 4; ++g)
                                    *(float4*)(stg + (j * 32 + (lane & 31)) * 260 + wn * 128 + i * 32 + 4 * hh + 8 * g) = make_float4(acc[i][j][4 * g], acc[i][j][4 * g + 1], acc[i][j][4 * g + 2], acc[i][j][4 * g + 3]);
                    }
                    __syncthreads();
#pragma unroll 4
                    for (int it = 0; it < 16; ++it) {
                        const int idx = it * 256 + tid, row = idx >> 6, c = idx & 63;
                        const int tok = mt * 128 + rnd * 64 + row, n = nt * 256 + 4 * c;
                        const float4 a4 = *(const float4*)(stg + row * 260 + 4 * c);
                        const float4 xi = *(const float4*)(xin + (size_t)tok * DM + n);
                        const float4 gg = *(const float4*)(g1 + (size_t)(tok >> 11) * 6144 + n);
                        float4 o; o.x = xi.x + gg.x * a4.x; o.y = xi.y + gg.y * a4.y; o.z = xi.z + gg.z * a4.z; o.w = xi.w + gg.w * a4.w;
                        *(float4*)(p->out + (size_t)tok * DM + n) = o;
                    }
                }
            });
    }
}

__device__ __forceinline__ bool moe_tile(const int* cnt, int tile, int& cls, int& pos0, int& n) {
    int tb = 0;
    for (int c = 0; c < NCLS; ++c) {
        const int nc = cnt[c * 64], nt = (nc + 127) >> 7;
        if (tile < tb + nt) { cls = c; pos0 = (tile - tb) * 128; n = nc; return true; }
        tb += nt;
    }
    return false;
}
__device__ __forceinline__ void cls_experts(int cls, int& e1, int& e2) {
    const int g = cls / 6, pi = cls % 6;
    const int a = pi < 3 ? 0 : (pi < 5 ? 1 : 2);
    const int b = pi < 3 ? pi + 1 : (pi < 5 ? pi - 1 : 3);
    e1 = g * 4 + a; e2 = g * 4 + b;
}
__device__ __forceinline__ void phase_moe_up(KP p, char* lds, int l) {
    const int* cnt = p->cnt + l * 32 * 64;
    for (int u = BID(); u < (256 + NCLS) * 8; u += gridDim.x) {
        const int xl = u & 7, Lx = u >> 3;
        const int nt = Lx & 7, tile = (Lx >> 3) * 8 + xl;
        int cls, pos0, nc;
        if (!moe_tile(cnt, tile, cls, pos0, nc)) continue;
        int e1, e2; cls_experts(cls, e1, e2);
        const int slot = nt >> 2;
        const half_t* W = p->Wt_gu + ((size_t)(l * 16 + (slot ? e2 : e1)) * 512 + (nt & 3) * 128) * 1024;
        const int* lst = p->lists + (size_t)cls * T_TOK + pos0;
        const int nvalid = nc - pos0;
        gemm_tile(lds, 16,
            [&](int kt, int row) { return W + (size_t)row * 1024 + kt * 64; },
            [&](int row) { const int tok = lst[row < nvalid ? row : 0]; return p->hn + (size_t)tok * DM; },
            [&](f16v (&acc)[2][2], int wn, int wm, int lane) {
                const int hh = lane >> 5;
#pragma unroll
                for (int j = 0; j < 2; ++j) {
                    const int row = wm * 64 + j * 32 + (lane & 31);
                    if (row < nvalid) {
                        const int tok = lst[row];
                        const float wgt = p->tokw[(size_t)tok * 2 + slot];
                        half_t* dst = p->act + (size_t)tok * 512 + slot * 256 + ((nt & 3) * 2 + wn) * 32 + 4 * hh;
#pragma unroll
                        for (int g = 0; g < 4; ++g) {
                            float a[4];
#pragma unroll
                            for (int r = 0; r < 4; ++r) { const float gv = acc[0][j][4 * g + r], uv = acc[1][j][4 * g + r]; a[r] = gv * sigmoidf_(gv) * uv * wgt; }
                            *(h4*)(dst + 8 * g) = pack4(a[0], a[1], a[2], a[3]);
                        }
                    }
                }
            });
    }
}
__device__ __forceinline__ void phase_moe_down(KP p, char* lds, int l, float gsc) {
    const int* cnt = p->cnt + l * 32 * 64;
    const float* g2 = p->modf + (size_t)l * 16 * 6144 + 5 * 1024;
    for (int u = BID(); u < (256 + NCLS) * 8; u += gridDim.x) {
        const int xl = u & 7, Lx = u >> 3;
        const int nt = Lx & 7, tile = (Lx >> 3) * 8 + xl;
        int cls, pos0, nc;
        if (!moe_tile(cnt, tile, cls, pos0, nc)) continue;
        int e1, e2; cls_experts(cls, e1, e2);
        const half_t* W1 = p->Wt_d + ((size_t)(l * 16 + e1) * 1024 + nt * 128) * 256;
        const half_t* W2 = p->Wt_d + ((size_t)(l * 16 + e2) * 1024 + nt * 128) * 256;
        const int* lst = p->lists + (size_t)cls * T_TOK + pos0;
        const int nvalid = nc - pos0;
        gemm_tile(lds, 8,
            [&](int kt, int row) { return (kt < 4 ? W1 : W2) + (size_t)row * 256 + (kt & 3) * 64; },
            [&](int row) { const int tok = lst[row < nvalid ? row : 0]; return p->act + (size_t)tok * 512; },
            [&](f16v (&acc)[2][2], int wn, int wm, int lane) {
                const int hh = lane >> 5;
#pragma unroll
                for (int j = 0; j < 2; ++j) {
                    const int row = wm * 64 + j * 32 + (lane & 31);
                    if (row < nvalid) {
                        const int tok = lst[row];
                        const int b = tok >> 11;
#pragma unroll
                        for (int i = 0; i < 2; ++i) {
                            const int nb = nt * 128 + wn * 64 + i * 32 + 4 * hh;
#pragma unroll
                            for (int g = 0; g < 4; ++g) {
                                const int n = nb + 8 * g;
                                float4* xp = (float4*)(p->out + (size_t)tok * DM + n);
                                float4 xi = *xp;
                                const float4 gg = *(const float4*)(g2 + (size_t)b * 6144 + n);
                                xi.x += gsc * gg.x * acc[i][j][4 * g]; xi.y += gsc * gg.y * acc[i][j][4 * g + 1]; xi.z += gsc * gg.z * acc[i][j][4 * g + 2]; xi.w += gsc * gg.w * acc[i][j][4 * g + 3];
                                *xp = xi;
                            }
                        }
                    }
                }
            });
    }
}

__device__ __forceinline__ void dsa_select_unit(KP p, char* lds, int b, int qt) {
    unsigned* hist = (unsigned*)lds;
    unsigned* maskl = hist + 16 * 257 + 16;
    unsigned* stP = maskl + 1024;
    unsigned* stNeed = stP + 16;
    unsigned* stDone = stNeed + 16;
    unsigned* flag = stDone + 16;
    unsigned* dummyb = flag + 16;
    const int tid = TID(), lane = tid & 63, wave = tid >> 6;
    const int q0 = qt * 16, tokbase = b * SEQ;
    __syncthreads();
    if (q0 < 256) {
        for (int i = tid; i < 1024; i += 256) {
            const int q = i >> 6, wd = i & 63;
            const int n = q0 + q + 1 - 32 * wd;
            const unsigned w = n >= 32 ? 0xFFFFFFFFu : (n <= 0 ? 0u : ((1u << n) - 1u));
            p->dmask[(size_t)(tokbase + q0 + q) * 64 + wd] = w;
        }
        return;
    }
    for (int i = tid; i < 1024; i += 256) maskl[i] = 0u;
    if (tid < 16) { stP[tid] = 0u; stNeed[tid] = 256u; stDone[tid] = 0u; }
    const int ql = lane & 15, fq = lane >> 4;
    const int tq = q0 + ql;
    const half_t* Pb = p->P + (size_t)tokbase * NP;
    h8 iqf[4];
#pragma unroll
    for (int hd = 0; hd < 4; ++hd) iqf[hd] = *(const h8*)(Pb + (size_t)tq * NP + PC_IQ + hd * 32 + 8 * fq);
    const float4 iw4 = *(const float4*)(p->iwf + (size_t)(tokbase + tq) * 4);
    const float wsc0 = iw4.x * 0.08838834764831845f, wsc1 = iw4.y * 0.08838834764831845f, wsc2 = iw4.z * 0.08838834764831845f, wsc3 = iw4.w * 0.08838834764831845f;
    const int ng = qt + 1;
    unsigned sc[32][4];
    const half_t* ikp = Pb + (size_t)ql * NP + PC_IK + 8 * fq;
#pragma unroll
    for (int gb = 0; gb < 4; ++gb) {
        h8 ik[8];
#pragma unroll
        for (int x = 0; x < 8; ++x) {
            int g = wave + 4 * (gb * 8 + x);
            g = g < ng ? g : ng - 1;
            ik[x] = *(const h8*)(ikp + (size_t)(16 * g) * NP);
        }
#pragma unroll
        for (int x = 0; x < 8; ++x) {
            const int gi = gb * 8 + x;
            const int g = wave + 4 * gi;
            const f4v z = {0.f, 0.f, 0.f, 0.f};
            const f4v c0 = __builtin_amdgcn_mfma_f32_16x16x32_f16(ik[x], iqf[0], z, 0, 0, 0);
            const f4v c1 = __builtin_amdgcn_mfma_f32_16x16x32_f16(ik[x], iqf[1], z, 0, 0, 0);
            const f4v c2 = __builtin_amdgcn_mfma_f32_16x16x32_f16(ik[x], iqf[2], z, 0, 0, 0);
            const f4v c3 = __builtin_amdgcn_mfma_f32_16x16x32_f16(ik[x], iqf[3], z, 0, 0, 0);
#pragma unroll
            for (int r = 0; r < 4; ++r) {
                const int j = 16 * g + 4 * fq + r;
                float sv = wsc0 * __builtin_amdgcn_fmed3f(c0[r], 0.f, INFINITY);
                sv = fmaf(wsc1, __builtin_amdgcn_fmed3f(c1[r], 0.f, INFINITY), sv);
                sv = fmaf(wsc2, __builtin_amdgcn_fmed3f(c2[r], 0.f, INFINITY), sv);
                sv = fmaf(wsc3, __builtin_amdgcn_fmed3f(c3[r], 0.f, INFINITY), sv);
                sv += 0.0f;
                const int sb = __float_as_int(sv);
                const unsigned su = (unsigned)sb ^ ((unsigned)(sb >> 31) | 0x80000000u);
                const unsigned ck = (su & 0xFFFFF800u) | (unsigned)(2047 - j);
                sc[gi][r] = (g < ng && j <= tq) ? ck : 0u;
            }
        }
    }
    bool alldone = false;
    for (int pass = 0; pass < 5; ++pass) {
        const bool fin = alldone;
        if (!fin) { for (int i = tid; i < 16 * 257; i += 256) hist[i] = 0u; }
        if (tid == 0) *flag = 0u;
        __syncthreads();
        const unsigned sP = stP[ql], sDone = stDone[ql];
        int wv = wave, fqv = fq;
        asm volatile("" : "+v"(wv), "+v"(fqv));
        if (fin) {
            const int sh = (int)(32u - 8u * (sDone ? sDone : 1u));
            unsigned* mrow = maskl + ql * 64;
#pragma unroll
            for (int gi = 0; gi < 32; ++gi) {
                const int g = wv + 4 * gi;
                unsigned nib = 0u;
#pragma unroll
                for (int r = 0; r < 4; ++r) {
                    const unsigned uu = sc[gi][r];
                    nib |= ((uu >> sh) >= sP) ? (1u << r) : 0u;
                }
                if (g < ng) atomicOr(&mrow[g >> 1], nib << ((g & 1) * 16 + 4 * fqv));
            }
        } else {
            const int shm = pass ? 32 - 8 * pass : 0, shd = 24 - 8 * pass;
            const unsigned orm = pass ? 0u : 0xFFFFFFFFu;
            const unsigned cmpv = pass ? (sDone == 0u ? sP : 0xFFFFFFFFu) : 0xFFFFFFFFu;
            unsigned* hrow = hist + ql * 257;
            unsigned* dummy = dummyb + lane;
#pragma unroll
            for (int gi = 0; gi < 32; ++gi) {
                const int g = wv + 4 * gi;
                if (g < ng) {
#pragma unroll
                    for (int r = 0; r < 4; ++r) {
                        const unsigned uu = sc[gi][r];
                        const bool match = (((uu >> shm) | orm) == cmpv);
                        const unsigned dig = (uu >> shd) & 255u;
                        unsigned* a = match ? hrow + dig : dummy;
                        atomicAdd(a, 1u);
                    }
                }
            }
        }
        __syncthreads();
        if (fin) break;
        {
            const int qq = tid >> 4, seg = tid & 15;
            const bool active = (stDone[qq] == 0u);
            unsigned c16 = 0u;
            if (active) {
#pragma unroll
                for (int d = 0; d < 16; ++d) c16 += hist[qq * 257 + seg * 16 + d];
            }
            unsigned v = c16;
#pragma unroll
            for (int off = 1; off < 16; off <<= 1) { const unsigned t = __shfl_down(v, off, 16); if (seg + off < 16) v += t; }
            const unsigned suf = v - c16;
            const unsigned need = stNeed[qq];
            if (active && suf < need && need <= suf + c16) {
                unsigned run = suf, D = 0u, cD = 0u, nn = need;
                for (int d = 15; d >= 0; --d) {
                    const unsigned cc = hist[qq * 257 + seg * 16 + d];
                    if (run + cc >= need) { D = (unsigned)(seg * 16 + d); cD = cc; nn = need - run; break; }
                    run += cc;
                }
                const bool done = (cD == nn) || pass == 3;
                stP[qq] = (stP[qq] << 8) | D; stNeed[qq] = nn;
                if (done) stDone[qq] = (unsigned)(pass + 1); else atomicAdd(flag, 1u);
            }
        }
        __syncthreads();
        alldone = (*flag == 0u);
    }
    for (int i = tid; i < 1024; i += 256) p->dmask[(size_t)(tokbase + q0 + (i >> 6)) * 64 + (i & 63)] = maskl[i];
}

__device__ __forceinline__ void conv_unit(KP p, char* lds, int l, int b, int c) {
    float* red = (float*)lds;
    const int ch = TID(), lane = ch & 63, wave = ch >> 6;
    const int t0 = c * 32, tokbase = b * SEQ;
    float aw[62];
#pragma unroll
    for (int rr = 0; rr < 62; ++rr) {
        int tt = t0 - 30 + rr; const bool ok = tt >= 0; tt = ok ? tt : t0;
        const float v = (float)p->P[(size_t)(tokbase + tt) * NP + ch];
        aw[rr] = ok ? v : 0.f;
    }
    float w[31];
#pragma unroll
    for (int i = 0; i < 31; ++i) w[i] = p->w_dw[(l * 31 + i) * 256 + ch];
    const float bias = p->b_dw[l * 256 + ch];
    float y[32], s1[32], s2[32];
#pragma unroll
    for (int tk = 0; tk < 32; ++tk) {
        float sacc = bias;
#pragma unroll
        for (int i = 0; i < 31; ++i) sacc = fmaf(aw[tk + i], w[i], sacc);
        y[tk] = sacc; s1[tk] = sacc; s2[tk] = sacc * sacc;
    }
    {
        const bool b5 = lane & 32, b4 = lane & 16, b3 = lane & 8, b2 = lane & 4, b1 = lane & 2;
        float a16[16], c16[16], a8[8], c8[8], a4[4], c4[4], a2[2], c2[2];
#pragma unroll
        for (int e = 0; e < 16; ++e) { a16[e] = (b5 ? s1[e + 16] : s1[e]) + __shfl_xor(b5 ? s1[e] : s1[e + 16], 32); c16[e] = (b5 ? s2[e + 16] : s2[e]) + __shfl_xor(b5 ? s2[e] : s2[e + 16], 32); }
#pragma unroll
        for (int e = 0; e < 8; ++e) { a8[e] = (b4 ? a16[e + 8] : a16[e]) + __shfl_xor(b4 ? a16[e] : a16[e + 8], 16); c8[e] = (b4 ? c16[e + 8] : c16[e]) + __shfl_xor(b4 ? c16[e] : c16[e + 8], 16); }
#pragma unroll
        for (int e = 0; e < 4; ++e) { a4[e] = (b3 ? a8[e + 4] : a8[e]) + __shfl_xor(b3 ? a8[e] : a8[e + 4], 8); c4[e] = (b3 ? c8[e + 4] : c8[e]) + __shfl_xor(b3 ? c8[e] : c8[e + 4], 8); }
#pragma unroll
        for (int e = 0; e < 2; ++e) { a2[e] = (b2 ? a4[e + 2] : a4[e]) + __shfl_xor(b2 ? a4[e] : a4[e + 2], 4); c2[e] = (b2 ? c4[e + 2] : c4[e]) + __shfl_xor(b2 ? c4[e] : c4[e + 2], 4); }
        float av = (b1 ? a2[1] : a2[0]) + __shfl_xor(b1 ? a2[0] : a2[1], 2), cv = (b1 ? c2[1] : c2[0]) + __shfl_xor(b1 ? c2[0] : c2[1], 2);
        av += __shfl_xor(av, 1); cv += __shfl_xor(cv, 1);
        const int tokk = (b5 ? 16 : 0) + (b4 ? 8 : 0) + (b3 ? 4 : 0) + (b2 ? 2 : 0) + (b1 ? 1 : 0);
        __syncthreads();
        if ((lane & 1) == 0) { red[(tokk * 4 + wave) * 2] = av; red[(tokk * 4 + wave) * 2 + 1] = cv; }
        __syncthreads();
    }
    const float lg = p->ln_g[l * 256 + ch], lb = p->ln_b[l * 256 + ch];
#pragma unroll
    for (int tk = 0; tk < 32; ++tk) {
        const float4 ra = *(const float4*)(red + tk * 8), rb = *(const float4*)(red + tk * 8 + 4);
        const float t1 = (ra.x + ra.z) + (rb.x + rb.z);
        const float t2 = (ra.y + ra.w) + (rb.y + rb.w);
        const float mu = t1 * (1.0f / 256.0f);
        float var = t2 * (1.0f / 256.0f) - mu * mu; var = var < 0.f ? 0.f : var;
        float z = (y[tk] - mu) * (1.0f / sqrtf(var + 1e-6f)) * lg + lb;
        z = z * sigmoidf_(z);
        p->ycat[((size_t)(ch >> 5) * T_TOK + tokbase + t0 + tk) * 32 + (ch & 31)] = (half_t)z;
    }
}

__device__ __forceinline__ void kmean_unit(KP p, char* lds, int b, int h, int blk) {
    float* part = (float*)lds;
    const int tid = TID(), d = tid & 63, pt = tid >> 6;
    const half_t* r = p->P + (size_t)(b * SEQ + blk * 256 + pt * 64) * NP + PC_MK + h * 64 + d;
    float s = 0.f;
    for (int k = 0; k < 64; ++k) s += (float)r[(size_t)k * NP];
    __syncthreads();
    part[pt * 64 + d] = s;
    __syncthreads();
    if (tid < 64) p->kmean[(((size_t)b * 6 + h) * 8 + blk) * 64 + tid] = ((part[tid] + part[64 + tid]) + (part[128 + tid] + part[192 + tid])) * (1.0f / 256.0f);
}

#ifndef POST_MASK
#define POST_MASK 7
#endif
__device__ __forceinline__ void phase_post(KP p, char* lds, int l, int tm) {
    const int NA = 2048, NB = 1024, NC = 768;
    for (int u = BID(); u < NA + NB + NC; u += gridDim.x) {
        if (u < NA) { if (tm & 1) dsa_select_unit(p, lds, u % 16, 127 - (u / 16)); }
        else if (u < NA + NB) { const int v = u - NA; if (tm & 2) conv_unit(p, lds, l, v % 16, v / 16); }
        else { const int v = u - NA - NB; if (tm & 4) kmean_unit(p, lds, v / 48, (v / 8) % 6, v % 8); }
    }
}

template <int MODE>
__device__ __forceinline__ void attn_unit(KP p, char* lds, int b, int h, int qt) {
    const int tid = TID(), lane = tid & 63, wave = tid >> 6, hh = lane >> 5, ql = lane & 31;
    const int q0 = qt * 128, tokbase = b * SEQ;
    const int tq = q0 + wave * 32 + ql;
    const half_t* Pb = p->P + (size_t)tokbase * NP;
    const int QOFF = MODE ? PC_MQ + h * 64 : PC_DQ + h * 64;
    const int KOFF = MODE ? PC_MK + h * 64 : PC_DK;
    const int VOFF = MODE ? PC_MV + h * 64 : PC_DV;
    const int own = qt >> 1;
    unsigned mysel = 0u, anysel = 0u;
    __syncthreads();
    if (MODE == 1) {
        float* km = (float*)(lds + 32768);
        float* gts = km + 512;
        unsigned* selq = (unsigned*)(gts + 1024);
        unsigned* anyb = selq + 128;
        for (int i = tid; i < 512; i += 256) km[i] = p->kmean[((size_t)b * 6 + h) * 512 + i];
        if (tid == 0) *anyb = 0u;
        __syncthreads();
        {
            const int q = tid & 127, hf = tid >> 7;
            if (hf * 4 < own) {
                const half_t* qr = Pb + (size_t)(q0 + q) * NP + QOFF;
                float g0 = 0.f, g1 = 0.f, g2 = 0.f, g3 = 0.f;
#pragma unroll
                for (int c8 = 0; c8 < 8; ++c8) {
                    const h8 qv = *(const h8*)(qr + c8 * 8);
#pragma unroll
                    for (int j = 0; j < 8; ++j) {
                        const float qf = (float)qv[j]; const int d = c8 * 8 + j;
                        g0 = fmaf(qf, km[(hf * 4 + 0) * 64 + d], g0); g1 = fmaf(qf, km[(hf * 4 + 1) * 64 + d], g1);
                        g2 = fmaf(qf, km[(hf * 4 + 2) * 64 + d], g2); g3 = fmaf(qf, km[(hf * 4 + 3) * 64 + d], g3);
                    }
                }
                gts[q * 8 + hf * 4 + 0] = g0; gts[q * 8 + hf * 4 + 1] = g1; gts[q * 8 + hf * 4 + 2] = g2; gts[q * 8 + hf * 4 + 3] = g3;
            }
        }
        __syncthreads();
        if (tid < 128) {
            unsigned m = 0u;
            const int want = own < 3 ? own : 3;
            for (int r = 0; r < want; ++r) {
                int best = -1; float bv = -INFINITY;
                for (int j = 0; j < own; ++j) { const float gv = gts[tid * 8 + j]; if (!((m >> j) & 1u) && (best < 0 || gv > bv)) { best = j; bv = gv; } }
                m |= 1u << best;
            }
            selq[tid] = m;
            if (m) atomicOr(anyb, m);
        }
        __syncthreads();
        mysel = selq[wave * 32 + ql];
        anysel = *anyb;
        __syncthreads();
    }
    h8 qf[4];
#pragma unroll
    for (int ks = 0; ks < 4; ++ks) qf[ks] = *(const h8*)(Pb + (size_t)tq * NP + QOFF + 16 * ks + 8 * hh);
    f16v O0, O1;
#pragma unroll
    for (int r = 0; r < 16; ++r) { O0[r] = 0.f; O1[r] = 0.f; }
    float m_run = -1e30f, l_run = 0.f;
    const float CS = 0.18033688011112042f;
    const int ntile = 2 * qt + 2;
    auto skip = [&](int kt) -> bool { return MODE == 1 && kt < 4 * own && !((anysel >> (kt >> 2)) & 1u); };
    auto nexttile = [&](int kt) -> int { ++kt; while (kt < ntile && skip(kt)) ++kt; return kt; };
    const int lrow = tid >> 3;
    const int kchunk = (tid & 7) ^ ((tid >> 4) & 7);
    const int vchunk = (tid & 7) ^ (((tid >> 4) & 1) << 2);
    char* ldst = lds + lrow * 128 + (tid & 7) * 16;
    auto issue = [&](int kt, int s) {
        const half_t* src = Pb + (size_t)(kt * 64 + lrow) * NP;
        char* d = ldst + s * 16384;
        glds16(src + KOFF + kchunk * 8, d);
        glds16(src + (size_t)32 * NP + KOFF + kchunk * 8, d + 4096);
        glds16(src + VOFF + vchunk * 8, d + 8192);
        glds16(src + (size_t)32 * NP + VOFF + vchunk * 8, d + 8192 + 4096);
    };
    const int rsw = (lane >> 1) & 7;
    const int kro = ql * 128;
    const int li = lane & 15, qp = li >> 2, pp = li & 3, swv = (qp >> 1) & 1;
    const int vb0 = 8192 + (4 * hh + qp) * 128 + 32 * ((lane >> 4) & 1) + 8 * pp + 64 * (0 ^ swv);
    const int vb1 = 8192 + (4 * hh + qp) * 128 + 32 * ((lane >> 4) & 1) + 8 * pp + 64 * (1 ^ swv);
    int kt = -1; kt = nexttile(kt);
    int s = 0;
    if (kt < ntile) issue(kt, 0);
    while (kt < ntile) {
        const int ktn = nexttile(kt);
        asm volatile("s_waitcnt vmcnt(0)" ::: "memory");
        __syncthreads();
        if (ktn < ntile) issue(ktn, s ^ 1);
        const bool wave_active = (kt * 64 <= q0 + wave * 32 + 31);
        if (wave_active) {
            const char* base = lds + s * 16384;
            uint2 mw = make_uint2(0u, 0u);
            if (MODE == 0) mw = *(const uint2*)(p->dmask + (size_t)(tokbase + tq) * 64 + 2 * kt);
            h8 vf0[4], vf1[4];
#pragma unroll
            for (int kk = 0; kk < 4; ++kk) {
                const int roff = (32 * (kk >> 1) + 16 * (kk & 1)) * 128;
                const s4v lo0 = __builtin_amdgcn_ds_read_tr16_b64_v4i16((LAS s4v*)(base + vb0 + roff));
                const s4v hi0 = __builtin_amdgcn_ds_read_tr16_b64_v4i16((LAS s4v*)(base + vb0 + roff + 8 * 128));
                const s4v lo1 = __builtin_amdgcn_ds_read_tr16_b64_v4i16((LAS s4v*)(base + vb1 + roff));
                const s4v hi1 = __builtin_amdgcn_ds_read_tr16_b64_v4i16((LAS s4v*)(base + vb1 + roff + 8 * 128));
                vf0[kk] = __builtin_bit_cast(h8, __builtin_shufflevector(lo0, hi0, 0, 1, 2, 3, 4, 5, 6, 7));
                vf1[kk] = __builtin_bit_cast(h8, __builtin_shufflevector(lo1, hi1, 0, 1, 2, 3, 4, 5, 6, 7));
            }
            f16v s0, s1;
#pragma unroll
            for (int r = 0; r < 16; ++r) { s0[r] = 0.f; s1[r] = 0.f; }
#pragma unroll
            for (int ks = 0; ks < 4; ++ks) {
                const int co = ((2 * ks + hh) ^ rsw) << 4;
                const h8 k0 = *(const h8*)(base + kro + co), k1 = *(const h8*)(base + kro + 4096 + co);
                s0 = __builtin_amdgcn_mfma_f32_32x32x16_f16(k0, qf[ks], s0, 0, 0, 0);
                s1 = __builtin_amdgcn_mfma_f32_32x32x16_f16(k1, qf[ks], s1, 0, 0, 0);
            }
            bool lane_on = true;
            if (MODE == 0) {
                const unsigned w0 = mw.x >> (4 * hh), w1 = mw.y >> (4 * hh);
#pragma unroll
                for (int r = 0; r < 16; ++r) {
                    const int pos = (r & 3) + 8 * (r >> 2);
                    const unsigned m0 = (unsigned)__builtin_amdgcn_sbfe((int)w0, pos, 1), m1 = (unsigned)__builtin_amdgcn_sbfe((int)w1, pos, 1);
                    s0[r] = __uint_as_float((__float_as_uint(s0[r]) & m0) | (0xFF800000u & ~m0));
                    s1[r] = __uint_as_float((__float_as_uint(s1[r]) & m1) | (0xFF800000u & ~m1));
                }
            } else {
                if (kt < 4 * own) {
                    lane_on = (mysel >> (kt >> 2)) & 1u;
                } else if (kt * 64 + 63 > q0 + wave * 32) {
#pragma unroll
                    for (int r = 0; r < 16; ++r) {
                        const int key = kt * 64 + (r & 3) + 8 * (r >> 2) + 4 * hh;
                        s0[r] = (key <= tq) ? s0[r] : -INFINITY;
                        s1[r] = (key + 32 <= tq) ? s1[r] : -INFINITY;
                    }
                }
            }
            float mx = s0[0];
#pragma unroll
            for (int r = 1; r < 16; ++r) mx = fmaxf(mx, s0[r]);
#pragma unroll
            for (int r = 0; r < 16; ++r) mx = fmaxf(mx, s1[r]);
            mx = lane_on ? mx : -INFINITY;
            mx = fmaxf(mx, __shfl_xor(mx, 32));
            const float mnew = fmaxf(m_run, mx);
            const float alpha = __builtin_amdgcn_exp2f((m_run - mnew) * CS);
            const float mc = lane_on ? mnew * CS : INFINITY;
            m_run = mnew;
            float ls = 0.f;
#pragma unroll
            for (int r = 0; r < 16; ++r) { s0[r] = __builtin_amdgcn_exp2f(fmaf(s0[r], CS, -mc)); ls += s0[r]; }
#pragma unroll
            for (int r = 0; r < 16; ++r) { s1[r] = __builtin_amdgcn_exp2f(fmaf(s1[r], CS, -mc)); ls += s1[r]; }
            l_run = l_run * alpha + ls;
            if (!__all(alpha == 1.0f)) {
#pragma unroll
                for (int r = 0; r < 16; ++r) { O0[r] *= alpha; O1[r] *= alpha; }
            }
#pragma unroll
            for (int kk = 0; kk < 4; ++kk) {
                h8 pf;
#pragma unroll
                for (int j = 0; j < 8; ++j) pf[j] = (half_t)((kk >> 1) ? s1[8 * (kk & 1) + j] : s0[8 * (kk & 1) + j]);
                O0 = __builtin_amdgcn_mfma_f32_32x32x16_f16(vf0[kk], pf, O0, 0, 0, 0);
                O1 = __builtin_amdgcn_mfma_f32_32x32x16_f16(vf1[kk], pf, O1, 0, 0, 0);
            }
        }
        kt = ktn; s ^= 1;
    }
    const float lt = l_run + __shfl_xor(l_run, 32);
    const float inv = 1.0f / lt;
    const int ycol = (MODE ? 640 : 256) + h * 64;
    half_t* dst = p->ycat + ((size_t)(ycol >> 5) * T_TOK + tokbase + tq) * 32 + 4 * hh;
#pragma unroll
    for (int g = 0; g < 4; ++g) {
        *(h4*)(dst + 8 * g) = pack4(O0[4 * g] * inv, O0[4 * g + 1] * inv, O0[4 * g + 2] * inv, O0[4 * g + 3] * inv);
        *(h4*)(dst + (size_t)T_TOK * 32 + 8 * g) = pack4(O1[4 * g] * inv, O1[4 * g + 1] * inv, O1[4 * g + 2] * inv, O1[4 * g + 3] * inv);
    }
}

#ifndef ATT_MASK
#define ATT_MASK 3
#endif
__device__ __forceinline__ void phase_attn(KP p, char* lds, int tm) {
    for (int u = BID(); u < 3072; u += gridDim.x) {
        const int qt = 15 - (u / 192), rem = u % 192;
        const int type = rem & 1, bh = rem >> 1;
        if (type == 0) { if (tm & 1) attn_unit<0>(p, lds, bh / 6, bh % 6, qt); }
        else { if (tm & 2) attn_unit<1>(p, lds, bh / 6, bh % 6, qt); }
    }
}

__global__ void __launch_bounds__(256, 2) mk_fwd(Params p_unused) {
    extern __shared__ __attribute__((aligned(16))) char lds[];
    volatile LAS unsigned* stw = (volatile LAS unsigned*)(lds + LDS_CTL);
    if (threadIdx.x < 4) stw[threadIdx.x] = 0u;
    __syncthreads();
    KP p0 = (KP)__builtin_amdgcn_kernarg_segment_ptr();
    XcdBarrier bar; bar.bar = p0->bar; bar.x = 0; bar.st = stw;
#if !MK_SPLIT
    bar = xcd_barrier_post(p0->bar, stw);
#endif
    const int ph_lo = p0->ph_lo, ph_hi = p0->ph_hi;
    for (int ph = ph_lo; ph < ph_hi; ++ph) {
      KP p = p0; asm volatile("" : "+s"(p));
      const int nrep = (DUP_SUB >= 0 && ((DUP_SUB == 100 && ph == 0) || (ph >= 2 && ph < NPHASE - 1 && ((ph - 2) & 7) == DUP_SUB && (DUP_SUB != 4 || ph < 10)))) ? 2 : 1;
      for (int rep = 0; rep < nrep; ++rep) {
        if (ph == 0) phase_prologue(p, lds);
        else if (ph == 1) phase_modsum(p);
        else if (ph == NPHASE - 1) phase_norm<2>(p, lds, p->out, p->g_final, nullptr, nullptr, 0);
        else {
            const int l = (ph - 2) >> 3, sub = (ph - 2) & 7;
            const float* mf = p->modf + (size_t)l * 16 * 6144;
            const float* xin = l == 0 ? p->x : p->out;
            if (sub == 0) phase_norm<0>(p, lds, xin, p->g_mix + l * DM, mf, mf + 1024, l);
            else if (sub == 1) phase_inproj(p, lds, l);
            else if (sub == 2) phase_post(p, lds, l, rep ? POST_MASK : 7);
            else if (sub == 3) phase_attn(p, lds, rep ? ATT_MASK : 3);
            else if (sub == 4) phase_outproj(p, lds, l, xin);
            else if (sub == 5) phase_norm<1>(p, lds, p->out, p->g_ffn + l * DM, mf + 3 * 1024, mf + 4 * 1024, (nrep == 2 && rep == 0) ? l + 2 : l);
            else if (sub == 6) phase_moe_up(p, lds, l);
            else phase_moe_down(p, lds, l, nrep == 2 ? 0.5f : 1.0f);
        }
      }
#if !MK_SPLIT
        if (ph + 1 < ph_hi) xcd_barrier(bar);
#endif
    }
}

extern "C" void kernel_launch(void* const* d_in, const int* in_sizes, int n_in, void* d_out, int out_size, void* d_ws, size_t ws_size, hipStream_t stream) {
    static int grid = 0;
    if (grid == 0) {
        int dev = 0, cus = 0, per_cu = 0;
        (void)hipGetDevice(&dev);
        (void)hipDeviceGetAttribute(&cus, hipDeviceAttributeMultiprocessorCount, dev);
        (void)hipFuncSetAttribute((const void*)mk_fwd, hipFuncAttributeMaxDynamicSharedMemorySize, LDS_BYTES);
        if (hipOccupancyMaxActiveBlocksPerMultiprocessor(&per_cu, (const void*)mk_fwd, 256, LDS_BYTES) != hipSuccess || per_cu < 1) per_cu = 1;
        (void)hipGetLastError();
        if (per_cu > 2) per_cu = 2;
        grid = cus * per_cu;
        fprintf(stderr, "mk_fwd: cus %d per_cu %d grid %d\n", cus, per_cu, grid);
    }
    Params p{};
    const float** pin = (const float**)&p.x;
    for (int i = 0; i < 18; ++i) pin[i] = (const float*)d_in[i];
    p.out = (float*)d_out;
    char* ws = (char*)d_ws;
    size_t off = 0;
    auto carve = [&](size_t bytes) { void* q = ws + off; off += (bytes + 255) & ~(size_t)255; return q; };
    p.bar = (unsigned*)carve(XCD_BAR_WORDS * 4);
    p.cnt = (int*)carve(4 * 32 * 64 * 4);
    const size_t zero_bytes = off;
    p.Wt_in = (half_t*)carve((size_t)2 * NP * DM * 2);
    p.Wt_o = (half_t*)carve((size_t)2 * DM * DM * 2);
    p.Wt_gu = (half_t*)carve((size_t)2 * 16 * 512 * 1024 * 2);
    p.Wt_d = (half_t*)carve((size_t)2 * 16 * 1024 * 256 * 2);
    p.hn = (half_t*)carve((size_t)T_TOK * DM * 2);
    p.P = (half_t*)carve((size_t)T_TOK * NP * 2);
    p.ycat = (half_t*)carve((size_t)T_TOK * DM * 2);
    p.act = (half_t*)carve((size_t)T_TOK * 512 * 2);
    p.modpart = (float*)carve((size_t)8 * 2 * 16 * 6144 * 4);
    p.modf = (float*)carve((size_t)2 * 16 * 6144 * 4);
    p.kmean = (float*)carve((size_t)16 * 6 * 8 * 64 * 4);
    p.rope = (float*)carve((size_t)2048 * 24 * 4);
    p.iwf = (float*)carve((size_t)T_TOK * 4 * 4);
    p.tokw = (float*)carve((size_t)T_TOK * 2 * 4);
    p.dmask = (unsigned*)carve((size_t)T_TOK * 64 * 4);
    p.lists = (int*)carve((size_t)NCLS * T_TOK * 4);
    if (off > ws_size) { fprintf(stderr, "workspace too small: need %zu have %zu\n", off, ws_size); return; }
    (void)hipMemsetAsync(d_ws, 0, zero_bytes, stream);
#if MK_SPLIT
    for (int ph = 0; ph < NPHASE; ++ph) {
        p.ph_lo = ph; p.ph_hi = ph + 1;
        hipLaunchKernelGGL(mk_fwd, dim3(grid), dim3(256), LDS_BYTES, stream, p);
    }
#else
    p.ph_lo = 0; p.ph_hi = NPHASE;
    hipLaunchKernelGGL(mk_fwd, dim3(grid), dim3(256), LDS_BYTES, stream, p);
#endif
}
```

```cpp
#include <hip/hip_runtime.h>
#include <cstdio>
#include <cstdint>

#ifndef MK_SPLIT
#define MK_SPLIT 0
#endif

#define T_TOK 32768
#define DM 1024
#define SEQ 2048
#define INW 2340
#define NP 2432
#define PC_CU 0
#define PC_CG 256
#define PC_DQ 512
#define PC_DK 896
#define PC_DV 960
#define PC_IQ 1024
#define PC_IK 1152
#define PC_IW 1184
#define PC_MQ 1280
#define PC_MK 1664
#define PC_MV 2048
#define LOG_THETA 13.122363377404328f
#define NCLS 24
#define LDS_CTL 73728
#define LDS_BYTES 78336
#define NPHASE 19
#ifndef DUP_SUB
#define DUP_SUB -1
#endif

typedef _Float16 half_t;
typedef _Float16 h8 __attribute__((ext_vector_type(8)));
typedef _Float16 h4 __attribute__((ext_vector_type(4)));
typedef short s4v __attribute__((ext_vector_type(4)));
typedef short s8v __attribute__((ext_vector_type(8)));
typedef float f16v __attribute__((ext_vector_type(16)));
typedef float f4v __attribute__((ext_vector_type(4)));
#define LAS __attribute__((address_space(3)))

struct Params {
    const float *x, *c, *w_ada, *b_ada, *g_mix, *w_in, *w_dw, *b_dw, *ln_g, *ln_b, *w_o, *g_ffn, *w_router, *b_router, *w_gate, *w_up, *w_down, *g_final;
    float* out;
    half_t *Wt_in, *Wt_o, *Wt_gu, *Wt_d, *hn, *P, *ycat, *act;
    float *modpart, *modf, *kmean, *rope, *iwf, *tokw;
    unsigned* dmask; int* cnt; int* lists; unsigned* bar;
    int ph_lo, ph_hi;
};

#define XB_TMO      128
#define XB_XCNT(j)  (256  + 64 * (j))
#define XB_XSUB(j)  (1280 + 64 * (j))
#define XB_XGEN(j)  (2304 + 64 * (j))
#define XB_TOP      3328
#define XB_TOPGEN   3392
#define XCD_BAR_WORDS 3456
#define XB_SPIN_CAP (1u << 20)
__device__ __forceinline__ unsigned xb_ld(unsigned* p)              { return __hip_atomic_load(p, __ATOMIC_RELAXED, __HIP_MEMORY_SCOPE_AGENT); }
__device__ __forceinline__ unsigned xb_add(unsigned* p, unsigned v) { return __hip_atomic_fetch_add(p, v, __ATOMIC_RELAXED, __HIP_MEMORY_SCOPE_AGENT); }
__device__ __forceinline__ unsigned xb_xcc_id() { return (unsigned)__builtin_amdgcn_s_getreg((3 << 11) | 20) & 0xFu; }
#define XB_SPIN(cond, bar) do { unsigned _sp = 0; while (cond) { __builtin_amdgcn_s_sleep(1); \
    if ((++_sp & 255u) == 0u) { if (xb_ld(&(bar)[XB_TMO])) break; if (_sp > XB_SPIN_CAP) { atomicAdd(&(bar)[XB_TMO], 1u); break; } } } } while (0)
struct XcdBarrier { unsigned* bar; unsigned x; volatile LAS unsigned* st; };
__device__ __forceinline__ XcdBarrier xcd_barrier_post(unsigned* bar, volatile LAS unsigned* st) {
    XcdBarrier b; b.bar = bar; b.x = xb_xcc_id(); b.st = st;
    if (threadIdx.x == 0) (void)xb_add(&bar[XB_XCNT(b.x)], 1u);
    return b;
}
__device__ __forceinline__ void xcd_barrier_complete(unsigned* bar, unsigned x, unsigned& nloc, unsigned& nx) {
    const unsigned G = gridDim.x * gridDim.y * gridDim.z;
    unsigned sum, cnt, mine, sp = 0u;
    for (;;) {
        sum = 0u; cnt = 0u; mine = 0u;
#pragma unroll
        for (unsigned j = 0; j < 16; ++j) { const unsigned c = xb_ld(&bar[XB_XCNT(j)]); sum += c; cnt += (c > 0u) ? 1u : 0u; mine = (j == x) ? c : mine; }
        if (sum == G) break;
        __builtin_amdgcn_s_sleep(1);
        if ((++sp & 255u) == 0u) { if (xb_ld(&bar[XB_TMO])) break; if (sp > XB_SPIN_CAP) { atomicAdd(&bar[XB_TMO], 1u); break; } }
    }
    nloc = mine > 0u ? mine : 1u; nx = cnt > 0u ? cnt : 1u;
}
__device__ __forceinline__ void xcd_barrier(const XcdBarrier& b) {
    asm volatile("s_waitcnt vmcnt(0)" ::: "memory");
    __syncthreads();
    if (threadIdx.x == 0) {
        unsigned* bar = b.bar;
        __builtin_amdgcn_s_waitcnt(0);
        unsigned nloc = b.st[0], nx = b.st[1];
        if (nloc == 0u) { xcd_barrier_complete(bar, b.x, nloc, nx); b.st[0] = nloc; b.st[1] = nx; }
        const unsigned old = xb_add(&bar[XB_XSUB(b.x)], 1u);
        const unsigned gen = old / nloc;
        if (old + 1u == (gen + 1u) * nloc) {
            __builtin_amdgcn_fence(__ATOMIC_RELEASE, "agent");
            asm volatile("s_waitcnt vmcnt(0)" ::: "memory");
            const unsigned og = xb_add(&bar[XB_TOP], 1u);
            const unsigned tg = og / nx;
            if (og + 1u == (tg + 1u) * nx) xb_add(&bar[XB_TOPGEN], 1u);
            else XB_SPIN(xb_ld(&bar[XB_TOPGEN]) == tg, bar);
            __builtin_amdgcn_fence(__ATOMIC_ACQUIRE, "agent");
            xb_add(&bar[XB_XGEN(b.x)], 1u);
            asm volatile("s_waitcnt vmcnt(0)" ::: "memory");
        } else {
            XB_SPIN(xb_ld(&bar[XB_XGEN(b.x)]) == gen, bar);
            __builtin_amdgcn_fence(__ATOMIC_ACQUIRE, "agent");
            asm volatile("s_waitcnt vmcnt(0)" ::: "memory");
        }
    }
    __syncthreads();
}

typedef const __attribute__((address_space(4))) Params* KP;
__device__ __forceinline__ int TID() { int t = threadIdx.x; asm volatile("" : "+v"(t)); return t; }
__device__ __forceinline__ int BID() { int b = blockIdx.x; asm volatile("" : "+s"(b)); return b; }
__device__ __forceinline__ float sigmoidf_(float v) { return __builtin_amdgcn_rcpf(1.0f + __expf(-v)); }
__device__ __forceinline__ void glds16(const void* g, char* l) { __builtin_amdgcn_global_load_lds((const unsigned*)g, (unsigned*)l, 16, 0, 0); }
__device__ __forceinline__ unsigned f2sortable(float f) { unsigned u = __float_as_uint(f); return (u & 0x80000000u) ? ~u : (u | 0x80000000u); }
__device__ __forceinline__ h4 pack4(float a, float b, float c, float d) { h4 r = {(half_t)a, (half_t)b, (half_t)c, (half_t)d}; return r; }

template <class CF>
__device__ __forceinline__ void conv_tile_panel(char* lds, CF colf, int src_ld, int k0, int n0, half_t* dst, int nrows) {
    float* tl = (float*)lds;
    const int tid = TID();
    __syncthreads();
    {
        const int nn = tid & 63;
        const float* cp = colf(nn);
        float tv[16];
#pragma unroll
        for (int i = 0; i < 16; ++i) { const int k = i * 4 + (tid >> 6); tv[i] = cp ? cp[(size_t)(k0 + k) * src_ld] : 0.f; }
#pragma unroll
        for (int i = 0; i < 16; ++i) { const int k = i * 4 + (tid >> 6); tl[k * 65 + nn] = tv[i]; }
    }
    __syncthreads();
    {
        const int n = tid >> 2, kq = (tid & 3) * 16;
        h8 a, b;
#pragma unroll
        for (int j = 0; j < 8; ++j) { a[j] = (half_t)tl[(kq + j) * 65 + n]; b[j] = (half_t)tl[(kq + 8 + j) * 65 + n]; }
        const int k = k0 + kq;
        h8* d = (h8*)(dst + ((size_t)(k >> 5) * nrows + n0 + n) * 32 + (k & 31));
        d[0] = a; d[1] = b;
    }
}
template <class CF>
__device__ __forceinline__ void conv_tile(char* lds, CF colf, int src_ld, int k0, half_t* dst_tile  , int dstK) {
    float* tl = (float*)lds;
    const int tid = TID();
    __syncthreads();
    {
        const int nn = tid & 63;
        const float* cp = colf(nn);
        float tv[16];
#pragma unroll
        for (int i = 0; i < 16; ++i) { const int k = i * 4 + (tid >> 6); tv[i] = cp ? cp[(size_t)(k0 + k) * src_ld] : 0.f; }
#pragma unroll
        for (int i = 0; i < 16; ++i) { const int k = i * 4 + (tid >> 6); tl[k * 65 + nn] = tv[i]; }
    }
    __syncthreads();
    {
        const int n = tid >> 2, kq = (tid & 3) * 16;
        h8 a, b;
#pragma unroll
        for (int j = 0; j < 8; ++j) { a[j] = (half_t)tl[(kq + j) * 65 + n]; b[j] = (half_t)tl[(kq + 8 + j) * 65 + n]; }
        h8* d = (h8*)(dst_tile + (size_t)n * dstK + kq);
        d[0] = a; d[1] = b;
    }
}

__device__ __forceinline__ void phase_prologue(KP p, char* lds) {
    const int tid = TID();
    const int NA = 2 * 16 * 38, NB = 2 * 16 * 16, NC = 2 * 16 * 16 * 8, ND = 2 * 16 * 4 * 16, NE = 384, NF = 8;
    const int total = NA + NB + NC + ND + NE + NF;
    for (int u0 = BID(); u0 < total; u0 += gridDim.x) {
        int u = u0;
        if (u < NA) {
            const int nt = u % 38, kt = (u / 38) % 16, l = u / (38 * 16);
            const float* src = p->w_in + (size_t)l * DM * INW;
            const int n0 = nt * 64;
            conv_tile_panel(lds, [&](int nn) -> const float* { const int np = n0 + nn; const int sc = np < 512 ? (((np & 63) < 32) ? 32 * (np >> 6) + (np & 31) : 256 + 32 * (np >> 6) + (np & 31)) : (np < 1188 ? np : (np < 1280 ? -1 : np - 92)); return sc >= 0 ? src + sc : (const float*)nullptr; },
                      INW, kt * 64, n0, p->Wt_in + (size_t)l * NP * DM, NP);
            continue;
        }
        u -= NA;
        if (u < NB) {
            const int nt = u % 16, kt = (u / 16) % 16, l = u / 256;
            const float* src = p->w_o + (size_t)l * DM * DM + nt * 64;
            conv_tile_panel(lds, [&](int nn) -> const float* { return src + nn; }, DM, kt * 64, nt * 64, p->Wt_o + (size_t)l * DM * DM, DM);
            continue;
        }
        u -= NB;
        if (u < NC) {
            const int nt = u % 8, kt = (u / 8) % 16, le = u / 128;
            const float* sg = p->w_gate + (size_t)le * 1024 * 256 + nt * 32;
            const float* su = p->w_up + (size_t)le * 1024 * 256 + nt * 32;
            conv_tile(lds, [&](int nn) -> const float* { return nn < 32 ? sg + nn : su + (nn - 32); }, 256, kt * 64, p->Wt_gu + ((size_t)le * 512 + nt * 64) * 1024 + kt * 64, 1024);
            continue;
        }
        u -= NC;
        if (u < ND) {
            const int nt = u % 16, kt = (u / 16) % 4, le = u / 64;
            const float* src = p->w_down + (size_t)le * 256 * 1024 + nt * 64;
            conv_tile(lds, [&](int nn) -> const float* { return src + nn; }, 1024, kt * 64, p->Wt_d + ((size_t)le * 1024 + nt * 64) * 256 + kt * 64, 256);
            continue;
        }
        u -= ND;
        if (u < NE) {
            const int kc = u % 8, cc = (u / 8) % 24, l = u / 192;
            float* ca = (float*)lds;
            __syncthreads();
            for (int i = tid; i < 2048; i += 256) { const int b = i >> 7, k = i & 127; const float v = p->c[b * 1024 + kc * 128 + k]; ca[i] = v / (1.0f + expf(-v)); }
            __syncthreads();
            const int n = cc * 256 + tid;
            float acc[16];
#pragma unroll
            for (int b = 0; b < 16; ++b) acc[b] = 0.f;
            const float* w = p->w_ada + ((size_t)l * 1024 + kc * 128) * 6144 + n;
#pragma unroll 16
            for (int k = 0; k < 128; ++k) {
                const float wv = w[(size_t)k * 6144];
#pragma unroll
                for (int b = 0; b < 16; ++b) acc[b] = fmaf(ca[b * 128 + k], wv, acc[b]);
            }
#pragma unroll
            for (int b = 0; b < 16; ++b) p->modpart[(((size_t)kc * 2 + l) * 16 + b) * 6144 + n] = acc[b];
            continue;
        }
        u -= NE;
        {
            for (int i = u * 256 + tid; i < 2048 * 12; i += NF * 256) {
                const int t = i / 12, r = i % 12;
                const int fi = r < 8 ? r : r - 8;
                const float rot = r < 8 ? 16.f : 8.f;
                const float inv = expf(-LOG_THETA * ((float)fi * 2.0f / rot));
                const float ang = (float)t * inv;
                float sn, cs; sincosf(ang, &sn, &cs);
                if (r < 8) { p->rope[t * 8 + fi] = cs; p->rope[16384 + t * 8 + fi] = sn; }
                else { p->rope[32768 + t * 4 + fi] = cs; p->rope[32768 + 8192 + t * 4 + fi] = sn; }
            }
        }
    }
}

__device__ __forceinline__ void phase_modsum(KP p) {
    for (int i = BID() * 256 + TID(); i < 2 * 16 * 6144; i += gridDim.x * 256) {
        const int n = i % 6144, l = i / (16 * 6144);
        float s = p->b_ada[l * 6144 + n];
#pragma unroll
        for (int kc = 0; kc < 8; ++kc) s += p->modpart[(size_t)kc * (2 * 16 * 6144) + i];
        p->modf[i] = s;
    }
}

__device__ __forceinline__ void route_flush(KP p, char* lds, int lane, int wave, int n, int myrow, int layer) {
    const float* lg = (const float*)(lds + LDS_CTL + 512) + wave * 256;
    int* lc = (int*)(lds + LDS_CTL + 64);
    int* lbase = lc + 32;
    const int tid = wave * 64 + lane;
    if (tid < 32) lc[tid] = 0;
    __syncthreads();
    int cls = 0, lpos = 0;
    if (lane < n) {
        float aff[16], bia[16];
#pragma unroll
        for (int e = 0; e < 16; ++e) { aff[e] = 1.0f / (1.0f + expf(-lg[lane * 16 + e])); bia[e] = aff[e] + p->b_router[e]; }
        int bestg = 0; float bests = -INFINITY;
#pragma unroll
        for (int gi = 0; gi < 4; ++gi) {
            float m1 = -INFINITY, m2 = -INFINITY;
#pragma unroll
            for (int j = 0; j < 4; ++j) { const float vv = bia[gi * 4 + j]; if (vv > m1) { m2 = m1; m1 = vv; } else if (vv > m2) m2 = vv; }
            const float s = m1 + m2;
            if (s > bests) { bests = s; bestg = gi; }
        }
        float bsel[4], asel[4];
#pragma unroll
        for (int j = 0; j < 4; ++j) { bsel[j] = 0.f; asel[j] = 0.f; }
#pragma unroll
        for (int gi = 0; gi < 4; ++gi) if (gi == bestg) {
#pragma unroll
            for (int j = 0; j < 4; ++j) { bsel[j] = bia[gi * 4 + j]; asel[j] = aff[gi * 4 + j]; }
        }
        int i1 = -1, i2 = -1; float v1 = -INFINITY, v2 = -INFINITY;
#pragma unroll
        for (int j = 0; j < 4; ++j) { const float vv = bsel[j]; if (vv > v1) { v2 = v1; i2 = i1; v1 = vv; i1 = j; } else if (vv > v2) { v2 = vv; i2 = j; } }
        const int a = i1 < i2 ? i1 : i2, bb = i1 < i2 ? i2 : i1;
        float wa = 0.f, wb = 0.f;
#pragma unroll
        for (int j = 0; j < 4; ++j) { if (j == a) wa = asel[j]; if (j == bb) wb = asel[j]; }
        const float sw = wa + wb;
        const int pi = (a == 0) ? (bb - 1) : (a == 1 ? (bb + 1) : 5);
        cls = bestg * 6 + pi;
        *(float2*)(p->tokw + (size_t)myrow * 2) = make_float2(wa / sw, wb / sw);
        lpos = atomicAdd(&lc[cls], 1);
    }
    __syncthreads();
    if (tid < NCLS) { const int c = lc[tid]; lbase[tid] = c ? atomicAdd(&p->cnt[(layer * 32 + tid) * 64], c) : 0; }
    __syncthreads();
    if (lane < n) p->lists[(size_t)cls * T_TOK + lbase[cls] + lpos] = myrow;
}

template <int MODE>
__device__ __forceinline__ void phase_norm(KP p, char* lds, const float* xin, const float* g, const float* sh, const float* sc, int layer) {
    const int lane = TID() & 63, wave = TID() >> 6;
    float* wt = (float*)lds;
    if (MODE == 1) {
        __syncthreads();
        for (int i = TID(); i < 4096; i += 256) {
            const float4 w4 = ((const float4*)p->w_router)[i];
            const int k = i >> 2, e0 = (i & 3) * 4;
            wt[(e0 + 0) * 1024 + k] = w4.x; wt[(e0 + 1) * 1024 + k] = w4.y; wt[(e0 + 2) * 1024 + k] = w4.z; wt[(e0 + 3) * 1024 + k] = w4.w;
        }
        __syncthreads();
    }
    float* lgb = (float*)(lds + LDS_CTL + 512);
    int myrow = 0, it = 0;
    float4 vn[4];
    {
        const int row0 = BID() * 4 + wave;
        const float4* xr = (const float4*)(xin + (size_t)(row0 < T_TOK ? row0 : 0) * DM);
#pragma unroll
        for (int i = 0; i < 4; ++i) vn[i] = xr[lane + 64 * i];
    }
    for (int row = BID() * 4 + wave; row < T_TOK; row += gridDim.x * 4) {
        const int b = row >> 11;
        float4 v[4]; float ss = 0.f;
#pragma unroll
        for (int i = 0; i < 4; ++i) v[i] = vn[i];
        {
            const int rown = row + gridDim.x * 4;
            const float4* xr = (const float4*)(xin + (size_t)(rown < T_TOK ? rown : row) * DM);
#pragma unroll
            for (int i = 0; i < 4; ++i) vn[i] = xr[lane + 64 * i];
        }
#pragma unroll
        for (int i = 0; i < 4; ++i) ss += v[i].x * v[i].x + v[i].y * v[i].y + v[i].z * v[i].z + v[i].w * v[i].w;
#pragma unroll
        for (int o = 32; o >= 1; o >>= 1) ss += __shfl_xor(ss, o);
        const float rstd = 1.0f / sqrtf(ss * (1.0f / 1024.0f) + 1e-6f);
        float acc[16], ya[16];
#pragma unroll
        for (int i = 0; i < 4; ++i) {
            const int k = (lane + 64 * i) * 4;
            const float4 gg = *(const float4*)(g + k);
            float y[4] = {v[i].x * rstd * gg.x, v[i].y * rstd * gg.y, v[i].z * rstd * gg.z, v[i].w * rstd * gg.w};
            if (MODE != 2) {
                const float4 s1 = *(const float4*)(sh + (size_t)b * 6144 + k), s2 = *(const float4*)(sc + (size_t)b * 6144 + k);
                y[0] = y[0] * (1.f + s2.x) + s1.x; y[1] = y[1] * (1.f + s2.y) + s1.y; y[2] = y[2] * (1.f + s2.z) + s1.z; y[3] = y[3] * (1.f + s2.w) + s1.w;
                if (MODE == 0) *(h4*)(p->hn + ((size_t)(k >> 5) * T_TOK + row) * 32 + (k & 31)) = pack4(y[0], y[1], y[2], y[3]);
                else *(h4*)(p->hn + (size_t)row * DM + k) = pack4(y[0], y[1], y[2], y[3]);
            } else {
                *(float4*)(p->out + (size_t)row * DM + k) = make_float4(y[0], y[1], y[2], y[3]);
            }
            ya[4 * i] = y[0]; ya[4 * i + 1] = y[1]; ya[4 * i + 2] = y[2]; ya[4 * i + 3] = y[3];
        }
        if (MODE == 1) {
#pragma unroll
            for (int e = 0; e < 16; ++e) acc[e] = 0.f;
            float4 wq[2][4];
            const float* wl = wt + lane * 4;
#pragma unroll
            for (int e = 0; e < 4; ++e) wq[0][e] = *(const float4*)(wl + e * 1024);
#pragma unroll
            for (int st = 0; st < 16; ++st) {
                const int i = st >> 2, eg = st & 3, cur = st & 1;
                if (st + 1 < 16) {
                    const int i2 = (st + 1) >> 2, eg2 = (st + 1) & 3;
#pragma unroll
                    for (int e = 0; e < 4; ++e) wq[cur ^ 1][e] = *(const float4*)(wl + (eg2 * 4 + e) * 1024 + i2 * 256);
                }
#pragma unroll
                for (int e = 0; e < 4; ++e) {
                    const float4 w4 = wq[cur][e];
                    acc[eg * 4 + e] = fmaf(ya[4 * i], w4.x, fmaf(ya[4 * i + 1], w4.y, fmaf(ya[4 * i + 2], w4.z, fmaf(ya[4 * i + 3], w4.w, acc[eg * 4 + e]))));
                }
                __builtin_amdgcn_sched_barrier(0);
            }
        }
        if (MODE == 1) {
            const bool b5 = lane & 32, b4 = lane & 16, b3 = lane & 8, b2 = lane & 4;
            float r8[8], r4[4], r2[2];
#pragma unroll
            for (int e = 0; e < 8; ++e) { const float snd = b5 ? acc[e] : acc[e + 8], kp = b5 ? acc[e + 8] : acc[e]; r8[e] = kp + __shfl_xor(snd, 32); }
#pragma unroll
            for (int e = 0; e < 4; ++e) { const float snd = b4 ? r8[e] : r8[e + 4], kp = b4 ? r8[e + 4] : r8[e]; r4[e] = kp + __shfl_xor(snd, 16); }
#pragma unroll
            for (int e = 0; e < 2; ++e) { const float snd = b3 ? r4[e] : r4[e + 2], kp = b3 ? r4[e + 2] : r4[e]; r2[e] = kp + __shfl_xor(snd, 8); }
            float rv; { const float snd = b2 ? r2[0] : r2[1], kp = b2 ? r2[1] : r2[0]; rv = kp + __shfl_xor(snd, 4); }
            rv += __shfl_xor(rv, 2); rv += __shfl_xor(rv, 1);
            if ((lane & 3) == 0) lgb[(wave * 16 + it) * 16 + (lane >> 2)] = rv;
            if (lane == it) myrow = row;
            ++it;
            if (it == 16) { route_flush(p, lds, lane, wave, it, myrow, layer); it = 0; }
        }
    }
    if (MODE == 1 && it > 0) route_flush(p, lds, lane, wave, it, myrow, layer);
}

template <class WF, class XF, class EPI>
__device__ __forceinline__ void gemm_tile(char* lds, int nkt, WF wf, XF xf, EPI epi) {
    const int tid = TID(), lane = tid & 63, wave = tid >> 6;
    const int wn = wave & 1, wm = wave >> 1, hh = lane >> 5;
    const int lrow = tid >> 3;
    const int lchunk = (tid & 7) ^ ((tid >> 4) & 7);
    const half_t* xs[4];
#pragma unroll
    for (int i = 0; i < 4; ++i) xs[i] = xf(lrow + 32 * i) + lchunk * 8;
    char* ldst = lds + lrow * 128 + (tid & 7) * 16;
    f16v acc[2][2];
#pragma unroll
    for (int i = 0; i < 2; ++i)
#pragma unroll
        for (int j = 0; j < 2; ++j)
#pragma unroll
            for (int r = 0; r < 16; ++r) acc[i][j][r] = 0.f;
    auto issue = [&](int kt, int s) {
        char* d = ldst + s * 32768;
#pragma unroll
        for (int i = 0; i < 4; ++i) glds16(wf(kt, lrow + 32 * i) + lchunk * 8, d + i * 4096);
#pragma unroll
        for (int i = 0; i < 4; ++i) glds16(xs[i] + kt * 64, d + 16384 + i * 4096);
    };
    __syncthreads();
    issue(0, 0);
    const int rsw = (lane >> 1) & 7;
    const int roff_w = (wn * 64 + (lane & 31)) * 128, roff_x = 16384 + (wm * 64 + (lane & 31)) * 128;
    for (int kt = 0; kt < nkt; ++kt) {
        asm volatile("s_waitcnt vmcnt(0)" ::: "memory");
        __syncthreads();
        if (kt + 1 < nkt) issue(kt + 1, (kt + 1) & 1);
        const char* base = lds + (kt & 1) * 32768;
#pragma unroll
        for (int ks = 0; ks < 4; ++ks) {
            const int co = ((2 * ks + hh) ^ rsw) << 4;
            const h8 a0 = *(const h8*)(base + roff_w + co), a1 = *(const h8*)(base + roff_w + 4096 + co);
            const h8 b0 = *(const h8*)(base + roff_x + co), b1 = *(const h8*)(base + roff_x + 4096 + co);
            acc[0][0] = __builtin_amdgcn_mfma_f32_32x32x16_f16(a0, b0, acc[0][0], 0, 0, 0);
            acc[0][1] = __builtin_amdgcn_mfma_f32_32x32x16_f16(a0, b1, acc[0][1], 0, 0, 0);
            acc[1][0] = __builtin_amdgcn_mfma_f32_32x32x16_f16(a1, b0, acc[1][0], 0, 0, 0);
            acc[1][1] = __builtin_amdgcn_mfma_f32_32x32x16_f16(a1, b1, acc[1][1], 0, 0, 0);
        }
    }
    epi(acc, wn, wm, lane);
}

template <class WF, class XF, class EPI>
__device__ __forceinline__ void gemm_tile2(char* lds, int nkt, size_t xkstride, WF wf, XF xf, EPI epi) {
    const int tid = TID(), lane = tid & 63, wave = tid >> 6;
    const int wn = wave & 1, wm = wave >> 1, hh = lane >> 5;
    const int lrow = tid >> 2;
    const int lchunk = (tid & 3) ^ ((tid >> 4) & 3);
    const half_t* xs[2];
#pragma unroll
    for (int i = 0; i < 2; ++i) xs[i] = xf(lrow + 64 * i) + lchunk * 8;
    char* ldst = lds + lrow * 64 + (tid & 3) * 16;
    f16v acc[4][2];
#pragma unroll
    for (int i = 0; i < 4; ++i)
#pragma unroll
        for (int j = 0; j < 2; ++j)
#pragma unroll
            for (int r = 0; r < 16; ++r) acc[i][j][r] = 0.f;
    auto issue = [&](int kt, int s) {
        char* d = ldst + s * 24576;
#pragma unroll
        for (int i = 0; i < 4; ++i) glds16(wf(kt, lrow + 64 * i) + lchunk * 8, d + i * 4096);
#pragma unroll
        for (int i = 0; i < 2; ++i) glds16(xs[i] + (size_t)kt * xkstride, d + 16384 + i * 4096);
    };
    __syncthreads();
    issue(0, 0); issue(1, 1);
    const int rsw = (lane >> 2) & 3;
    const int roff_w = (wn * 128 + (lane & 31)) * 64, roff_x = 16384 + (wm * 64 + (lane & 31)) * 64;
    int st = 0;
    for (int kt = 0; kt < nkt; ++kt) {
        if (kt + 1 < nkt) asm volatile("s_waitcnt vmcnt(6)" ::: "memory");
        else asm volatile("s_waitcnt vmcnt(0)" ::: "memory");
        asm volatile("s_waitcnt lgkmcnt(0)" ::: "memory");
        __builtin_amdgcn_s_barrier();
        if (kt + 2 < nkt) issue(kt + 2, st >= 1 ? st - 1 : 2);
        const char* base = lds + st * 24576;
        st = st == 2 ? 0 : st + 1;
#pragma unroll
        for (int ks = 0; ks < 2; ++ks) {
            const int co = ((2 * ks + hh) ^ rsw) << 4;
            h8 a[4], b[2];
#pragma unroll
            for (int i = 0; i < 4; ++i) a[i] = *(const h8*)(base + roff_w + i * 2048 + co);
#pragma unroll
            for (int j = 0; j < 2; ++j) b[j] = *(const h8*)(base + roff_x + j * 2048 + co);
#pragma unroll
            for (int i = 0; i < 4; ++i)
#pragma unroll
                for (int j = 0; j < 2; ++j) acc[i][j] = __builtin_amdgcn_mfma_f32_32x32x16_f16(a[i], b[j], acc[i][j], 0, 0, 0);
        }
    }
    epi(acc, wn, wm, lane);
}

__device__ __forceinline__ void phase_inproj(KP p, char* lds, int l) {
    const half_t* W = p->Wt_in + (size_t)l * NP * DM;
    const float* rc16 = p->rope; const float* rs16 = p->rope + 16384; const float* rc8 = p->rope + 32768; const float* rs8 = p->rope + 32768 + 8192;
    for (int u = BID(); u < 256 * 10; u += gridDim.x) {
        const int xl = u & 7, Lx = u >> 3, mi = Lx & 7, rr_ = Lx >> 3;
        const int nt = rr_ % 10, mt = 32 * xl + 8 * (rr_ / 10) + mi;
        gemm_tile2(lds, 32, (size_t)T_TOK * 32,
            [&](int kt, int row) { int n = nt * 256 + row; n = n < NP ? n : NP - 1; return W + ((size_t)kt * NP + n) * 32; },
            [&](int row) { return p->hn + (size_t)(mt * 128 + row) * 32; },
            [&](f16v (&acc)[4][2], int wn, int wm, int lane) {
                const int hh = lane >> 5;
                half_t* stg = (half_t*)lds;
                __syncthreads();
#pragma unroll
                for (int i = 0; i < 4; ++i) {
                    const int nb = nt * 256 + wn * 128 + i * 32;
                    if (nb == 1216 || nb == 1248 || nb >= NP) continue;
                    if (nt < 2) {
                        if (i & 1) continue;
#pragma unroll
                        for (int j = 0; j < 2; ++j) {
                            half_t* dst = stg + (wm * 64 + j * 32 + (lane & 31)) * 260 + wn * 64 + (i >> 1) * 32 + 4 * hh;
#pragma unroll
                            for (int g = 0; g < 4; ++g) {
                                float a4[4];
#pragma unroll
                                for (int r = 0; r < 4; ++r) a4[r] = acc[i][j][4 * g + r] * sigmoidf_(acc[i + 1][j][4 * g + r]);
                                *(h4*)(dst + 8 * g) = pack4(a4[0], a4[1], a4[2], a4[3]);
                            }
                        }
                        continue;
                    }
                    const bool rope64 = ((nb >= PC_DQ && nb < PC_DV) || (nb >= PC_MQ && nb < PC_MV)) && ((nb & 63) == 0);
                    const bool rope32 = (nb >= PC_IQ && nb < PC_IW);
#pragma unroll
                    for (int j = 0; j < 2; ++j) {
                        const int tok = mt * 128 + wm * 64 + j * 32 + (lane & 31);
                        const int t = tok & 2047;
                        f16v v = acc[i][j];
                        if (nb == PC_IW) { if (hh == 0) *(float4*)(p->iwf + (size_t)tok * 4) = make_float4(v[0], v[1], v[2], v[3]); continue; }
                        if (rope64) {
                            const float4 c4 = *(const float4*)(rc16 + t * 8 + 4 * hh), s4 = *(const float4*)(rs16 + t * 8 + 4 * hh);
                            const float cc[4] = {c4.x, c4.y, c4.z, c4.w}, sn[4] = {s4.x, s4.y, s4.z, s4.w};
#pragma unroll
                            for (int r = 0; r < 4; ++r) { const float x1 = v[r], x2 = v[r + 4]; v[r] = x1 * cc[r] - x2 * sn[r]; v[r + 4] = x2 * cc[r] + x1 * sn[r]; }
                        } else if (rope32) {
                            const float4 c4 = *(const float4*)(rc8 + t * 4), s4 = *(const float4*)(rs8 + t * 4);
                            const float cc[4] = {c4.x, c4.y, c4.z, c4.w}, sn[4] = {s4.x, s4.y, s4.z, s4.w};
#pragma unroll
                            for (int r = 0; r < 4; ++r) { const float o = __shfl_xor(v[r], 32); v[r] = hh ? (v[r] * cc[r] + o * sn[r]) : (v[r] * cc[r] - o * sn[r]); }
                        }
                        half_t* dst = stg + (wm * 64 + j * 32 + (lane & 31)) * 260 + wn * 128 + i * 32 + 4 * hh;
#pragma unroll
                        for (int g = 0; g < 4; ++g) *(h4*)(dst + 8 * g) = pack4(v[4 * g], v[4 * g + 1], v[4 * g + 2], v[4 * g + 3]);
                    }
                }
                __syncthreads();
                const int wv_ = TID() >> 6;
#pragma unroll 4
                for (int it = 0; it < 32; ++it) {
                    const int row = it * 4 + wv_;
                    const uint2 v2 = *(const uint2*)(stg + row * 260 + lane * 4);
                    if (nt < 2) { if (lane < 32) *(uint2*)(p->P + (size_t)(mt * 128 + row) * NP + nt * 128 + lane * 4) = v2; }
                    else { const int n = nt * 256 + lane * 4; if (n < NP) *(uint2*)(p->P + (size_t)(mt * 128 + row) * NP + n) = v2; }
                }
            });
    }
}

__device__ __forceinline__ void stage_acc_f32(char* lds, const f16v (&acc)[2][2], int wn, int wm, int lane) {
    float* stg = (float*)lds;
    const int hh = lane >> 5;
    __syncthreads();
#pragma unroll
    for (int j = 0; j < 2; ++j)
#pragma unroll
        for (int i = 0; i < 2; ++i)
#pragma unroll
            for (int g = 0; g < 4; ++g)
                *(float4*)(stg + (wm * 64 + j * 32 + (lane & 31)) * 132 + wn * 64 + i * 32 + 4 * hh + 8 * g) = make_float4(acc[i][j][4 * g], acc[i][j][4 * g + 1], acc[i][j][4 * g + 2], acc[i][j][4 * g + 3]);
    __syncthreads();
}
__device__ __forceinline__ void phase_outproj(KP p, char* lds, int l, const float* xin) {
    const half_t* W = p->Wt_o + (size_t)l * DM * DM;
    const float* g1 = p->modf + (size_t)l * 16 * 6144 + 2 * 1024;
    for (int u = BID(); u < 256 * 4; u += gridDim.x) {
        const int xl = u & 7, Lx = u >> 3, mi = Lx & 7, rr_ = Lx >> 3;
        const int nt = rr_ & 3, mt = 32 * xl + 8 * (rr_ >> 2) + mi;
        gemm_tile2(lds, 32, (size_t)T_TOK * 32,
            [&](int kt, int row) { return W + ((size_t)kt * DM + nt * 256 + row) * 32; },
            [&](int row) { return p->ycat + (size_t)(mt * 128 + row) * 32; },
            [&](f16v (&acc)[4][2], int wn, int wm, int lane) {
                const int hh = lane >> 5, tid = TID();
                float* stg = (float*)lds;
#pragma unroll
                for (int rnd = 0; rnd < 2; ++rnd) {
                    __syncthreads();
                    if (wm == rnd) {
#pragma unroll
                        for (int j = 0; j < 2; ++j)
#pragma unroll
                            for (int i = 0; i < 4; ++i)
#pragma unroll
                                for (int g = 0; g < 4; ++g)
                                    *(float4*)(stg + (j * 32 + (lane & 31)) * 260 + wn * 128 + i * 32 + 4 * hh + 8 * g) = make_float4(acc[i][j][4 * g], acc[i][j][4 * g + 1], acc[i][j][4 * g + 2], acc[i][j][4 * g + 3]);
                    }
                    __syncthreads();
#pragma unroll 4
                    for (int it = 0; it < 16; ++it) {
                        const int idx = it * 256 + tid, row = idx >> 6, c = idx & 63;
                        const int tok = mt * 128 + rnd * 64 + row, n = nt * 256 + 4 * c;
                        const float4 a4 = *(const float4*)(stg + row * 260 + 4 * c);
                        const float4 xi = *(const float4*)(xin + (size_t)tok * DM + n);
                        const float4 gg = *(const float4*)(g1 + (size_t)(tok >> 11) * 6144 + n);
                        float4 o; o.x = xi.x + gg.x * a4.x; o.y = xi.y + gg.y * a4.y; o.z = xi.z + gg.z * a4.z; o.w = xi.w + gg.w * a4.w;
                        *(float4*)(p->out + (size_t)tok * DM + n) = o;
                    }
                }
            });
    }
}

__device__ __forceinline__ bool moe_tile(const int* cnt, int tile, int& cls, int& pos0, int& n) {
    int tb = 0;
    for (int c = 0; c < NCLS; ++c) {
        const int nc = cnt[c * 64], nt = (nc + 127) >> 7;
        if (tile < tb + nt) { cls = c; pos0 = (tile - tb) * 128; n = nc; return true; }
        tb += nt;
    }
    return false;
}
__device__ __forceinline__ void cls_experts(int cls, int& e1, int& e2) {
    const int g = cls / 6, pi = cls % 6;
    const int a = pi < 3 ? 0 : (pi < 5 ? 1 : 2);
    const int b = pi < 3 ? pi + 1 : (pi < 5 ? pi - 1 : 3);
    e1 = g * 4 + a; e2 = g * 4 + b;
}
__device__ __forceinline__ void phase_moe_up(KP p, char* lds, int l) {
    const int* cnt = p->cnt + l * 32 * 64;
    for (int u = BID(); u < (256 + NCLS) * 8; u += gridDim.x) {
        const int xl = u & 7, Lx = u >> 3;
        const int nt = Lx & 7, tile = (Lx >> 3) * 8 + xl;
        int cls, pos0, nc;
        if (!moe_tile(cnt, tile, cls, pos0, nc)) continue;
        int e1, e2; cls_experts(cls, e1, e2);
        const int slot = nt >> 2;
        const half_t* W = p->Wt_gu + ((size_t)(l * 16 + (slot ? e2 : e1)) * 512 + (nt & 3) * 128) * 1024;
        const int* lst = p->lists + (size_t)cls * T_TOK + pos0;
        const int nvalid = nc - pos0;
        gemm_tile(lds, 16,
            [&](int kt, int row) { return W + (size_t)row * 1024 + kt * 64; },
            [&](int row) { const int tok = lst[row < nvalid ? row : 0]; return p->hn + (size_t)tok * DM; },
            [&](f16v (&acc)[2][2], int wn, int wm, int lane) {
                const int hh = lane >> 5;
#pragma unroll
                for (int j = 0; j < 2; ++j) {
                    const int row = wm * 64 + j * 32 + (lane & 31);
                    if (row < nvalid) {
                        const int tok = lst[row];
                        const float wgt = p->tokw[(size_t)tok * 2 + slot];
                        half_t* dst = p->act + (size_t)tok * 512 + slot * 256 + ((nt & 3) * 2 + wn) * 32 + 4 * hh;
#pragma unroll
                        for (int g = 0; g < 4; ++g) {
                            float a[4];
#pragma unroll
                            for (int r = 0; r < 4; ++r) { const float gv = acc[0][j][4 * g + r], uv = acc[1][j][4 * g + r]; a[r] = gv * sigmoidf_(gv) * uv * wgt; }
                            *(h4*)(dst + 8 * g) = pack4(a[0], a[1], a[2], a[3]);
                        }
                    }
                }
            });
    }
}
__device__ __forceinline__ void phase_moe_down(KP p, char* lds, int l, float gsc) {
    const int* cnt = p->cnt + l * 32 * 64;
    const float* g2 = p->modf + (size_t)l * 16 * 6144 + 5 * 1024;
    for (int u = BID(); u < (256 + NCLS) * 8; u += gridDim.x) {
        const int xl = u & 7, Lx = u >> 3;
        const int nt = Lx & 7, tile = (Lx >> 3) * 8 + xl;
        int cls, pos0, nc;
        if (!moe_tile(cnt, tile, cls, pos0, nc)) continue;
        int e1, e2; cls_experts(cls, e1, e2);
        const half_t* W1 = p->Wt_d + ((size_t)(l * 16 + e1) * 1024 + nt * 128) * 256;
        const half_t* W2 = p->Wt_d + ((size_t)(l * 16 + e2) * 1024 + nt * 128) * 256;
        const int* lst = p->lists + (size_t)cls * T_TOK + pos0;
        const int nvalid = nc - pos0;
        gemm_tile(lds, 8,
            [&](int kt, int row) { return (kt < 4 ? W1 : W2) + (size_t)row * 256 + (kt & 3) * 64; },
            [&](int row) { const int tok = lst[row < nvalid ? row : 0]; return p->act + (size_t)tok * 512; },
            [&](f16v (&acc)[2][2], int wn, int wm, int lane) {
                const int hh = lane >> 5;
#pragma unroll
                for (int j = 0; j < 2; ++j) {
                    const int row = wm * 64 + j * 32 + (lane & 31);
                    if (row < nvalid) {
                        const int tok = lst[row];
                        const int b = tok >> 11;
#pragma unroll
                        for (int i = 0; i < 2; ++i) {
                            const int nb = nt * 128 + wn * 64 + i * 32 + 4 * hh;
#pragma unroll
                            for (int g = 0; g < 4; ++g) {
                                const int n = nb + 8 * g;
                                float4* xp = (float4*)(p->out + (size_t)tok * DM + n);
                                float4 xi = *xp;
                                const float4 gg = *(const float4*)(g2 + (size_t)b * 6144 + n);
                                xi.x += gsc * gg.x * acc[i][j][4 * g]; xi.y += gsc * gg.y * acc[i][j][4 * g + 1]; xi.z += gsc * gg.z * acc[i][j][4 * g + 2]; xi.w += gsc * gg.w * acc[i][j][4 * g + 3];
                                *xp = xi;
                            }
                        }
                    }
                }
            });
    }
}

__device__ __forceinline__ void dsa_select_unit(KP p, char* lds, int b, int qt) {
    unsigned* hist = (unsigned*)lds;
    unsigned* maskl = hist + 16 * 257 + 16;
    unsigned* stP = maskl + 1024;
    unsigned* stNeed = stP + 16;
    unsigned* stDone = stNeed + 16;
    unsigned* flag = stDone + 16;
    unsigned* dummyb = flag + 16;
    const int tid = TID(), lane = tid & 63, wave = tid >> 6;
    const int q0 = qt * 16, tokbase = b * SEQ;
    __syncthreads();
    if (q0 < 256) {
        for (int i = tid; i < 1024; i += 256) {
            const int q = i >> 6, wd = i & 63;
            const int n = q0 + q + 1 - 32 * wd;
            const unsigned w = n >= 32 ? 0xFFFFFFFFu : (n <= 0 ? 0u : ((1u << n) - 1u));
            p->dmask[(size_t)(tokbase + q0 + q) * 64 + wd] = w;
        }
        return;
    }
    for (int i = tid; i < 1024; i += 256) maskl[i] = 0u;
    if (tid < 16) { stP[tid] = 0u; stNeed[tid] = 256u; stDone[tid] = 0u; }
    for (int i = tid; i < 16 * 257; i += 256) hist[i] = 0u;
    __syncthreads();
    const int ql = lane & 15, fq = lane >> 4;
    const int tq = q0 + ql;
    const half_t* Pb = p->P + (size_t)tokbase * NP;
    h8 iqf[4];
#pragma unroll
    for (int hd = 0; hd < 4; ++hd) iqf[hd] = *(const h8*)(Pb + (size_t)tq * NP + PC_IQ + hd * 32 + 8 * fq);
    const float4 iw4 = *(const float4*)(p->iwf + (size_t)(tokbase + tq) * 4);
    const float wsc0 = iw4.x * 0.08838834764831845f, wsc1 = iw4.y * 0.08838834764831845f, wsc2 = iw4.z * 0.08838834764831845f, wsc3 = iw4.w * 0.08838834764831845f;
    const int ng = qt + 1;
    unsigned sc[32][4];
    const half_t* ikp = Pb + (size_t)ql * NP + PC_IK + 8 * fq;
#pragma unroll
    for (int gb = 0; gb < 4; ++gb) {
        h8 ik[8];
#pragma unroll
        for (int x = 0; x < 8; ++x) {
            int g = wave + 4 * (gb * 8 + x);
            g = g < ng ? g : ng - 1;
            ik[x] = *(const h8*)(ikp + (size_t)(16 * g) * NP);
        }
#pragma unroll
        for (int x = 0; x < 8; ++x) {
            const int gi = gb * 8 + x;
            const int g = wave + 4 * gi;
            const f4v z = {0.f, 0.f, 0.f, 0.f};
            const f4v c0 = __builtin_amdgcn_mfma_f32_16x16x32_f16(ik[x], iqf[0], z, 0, 0, 0);
            const f4v c1 = __builtin_amdgcn_mfma_f32_16x16x32_f16(ik[x], iqf[1], z, 0, 0, 0);
            const f4v c2 = __builtin_amdgcn_mfma_f32_16x16x32_f16(ik[x], iqf[2], z, 0, 0, 0);
            const f4v c3 = __builtin_amdgcn_mfma_f32_16x16x32_f16(ik[x], iqf[3], z, 0, 0, 0);
#pragma unroll
            for (int r = 0; r < 4; ++r) {
                const int j = 16 * g + 4 * fq + r;
                float sv = wsc0 * __builtin_amdgcn_fmed3f(c0[r], 0.f, INFINITY);
                sv = fmaf(wsc1, __builtin_amdgcn_fmed3f(c1[r], 0.f, INFINITY), sv);
                sv = fmaf(wsc2, __builtin_amdgcn_fmed3f(c2[r], 0.f, INFINITY), sv);
                sv = fmaf(wsc3, __builtin_amdgcn_fmed3f(c3[r], 0.f, INFINITY), sv);
                sv += 0.0f;
                const int sb = __float_as_int(sv);
                const unsigned su = (unsigned)sb ^ ((unsigned)(sb >> 31) | 0x80000000u);
                const unsigned ck = (su & 0xFFFFF800u) | (unsigned)(2047 - j);
                sc[gi][r] = (g < ng && j <= tq) ? ck : 0u;
            }
            if (g < ng) {
#pragma unroll
                for (int r = 0; r < 4; ++r) atomicAdd(hist + ql * 257 + (sc[gi][r] >> 24), 1u);
            }
        }
    }
    bool alldone = false;
    for (int pass = 0; pass < 5; ++pass) {
        const bool fin = alldone;
        if (!fin && pass > 0) { for (int i = tid; i < 16 * 257; i += 256) hist[i] = 0u; }
        if (tid == 0) *flag = 0u;
        __syncthreads();
        if (pass > 0) {
        const unsigned sP = stP[ql], sDone = stDone[ql];
        int wv = wave, fqv = fq;
        asm volatile("" : "+v"(wv), "+v"(fqv));
        if (fin) {
            const int sh = (int)(32u - 8u * (sDone ? sDone : 1u));
            unsigned* mrow = maskl + ql * 64;
#pragma unroll
            for (int gi = 0; gi < 32; ++gi) {
                const int g = wv + 4 * gi;
                unsigned nib = 0u;
#pragma unroll
                for (int r = 0; r < 4; ++r) {
                    const unsigned uu = sc[gi][r];
                    nib |= ((uu >> sh) >= sP) ? (1u << r) : 0u;
                }
                if (g < ng) atomicOr(&mrow[g >> 1], nib << ((g & 1) * 16 + 4 * fqv));
            }
        } else {
            const int shm = pass ? 32 - 8 * pass : 0, shd = 24 - 8 * pass;
            const unsigned orm = pass ? 0u : 0xFFFFFFFFu;
            const unsigned cmpv = pass ? (sDone == 0u ? sP : 0xFFFFFFFFu) : 0xFFFFFFFFu;
            unsigned* hrow = hist + ql * 257;
            unsigned* dummy = dummyb + lane;
#pragma unroll
            for (int gi = 0; gi < 32; ++gi) {
                const int g = wv + 4 * gi;
                if (g < ng) {
#pragma unroll
                    for (int r = 0; r < 4; ++r) {
                        const unsigned uu = sc[gi][r];
                        const bool match = (((uu >> shm) | orm) == cmpv);
                        const unsigned dig = (uu >> shd) & 255u;
                        unsigned* a = match ? hrow + dig : dummy;
                        atomicAdd(a, 1u);
                    }
                }
            }
        }
        }
        __syncthreads();
        if (fin) break;
        {
            const int qq = tid >> 4, seg = tid & 15;
            const bool active = (stDone[qq] == 0u);
            unsigned c16 = 0u;
            if (active) {
#pragma unroll
                for (int d = 0; d < 16; ++d) c16 += hist[qq * 257 + seg * 16 + d];
            }
            unsigned v = c16;
#pragma unroll
            for (int off = 1; off < 16; off <<= 1) { const unsigned t = __shfl_down(v, off, 16); if (seg + off < 16) v += t; }
            const unsigned suf = v - c16;
            const unsigned need = stNeed[qq];
            if (active && suf < need && need <= suf + c16) {
                unsigned run = suf, D = 0u, cD = 0u, nn = need;
                for (int d = 15; d >= 0; --d) {
                    const unsigned cc = hist[qq * 257 + seg * 16 + d];
                    if (run + cc >= need) { D = (unsigned)(seg * 16 + d); cD = cc; nn = need - run; break; }
                    run += cc;
                }
                const bool done = (cD == nn) || pass == 3;
                stP[qq] = (stP[qq] << 8) | D; stNeed[qq] = nn;
                if (done) stDone[qq] = (unsigned)(pass + 1); else atomicAdd(flag, 1u);
            }
        }
        __syncthreads();
        alldone = (*flag == 0u);
    }
    for (int i = tid; i < 1024; i += 256) p->dmask[(size_t)(tokbase + q0 + (i >> 6)) * 64 + (i & 63)] = maskl[i];
}

__device__ __forceinline__ void conv_unit(KP p, char* lds, int l, int b, int c) {
    float* red = (float*)lds;
    const int ch = TID(), lane = ch & 63, wave = ch >> 6;
    const int t0 = c * 32, tokbase = b * SEQ;
    float aw[62];
#pragma unroll
    for (int rr = 0; rr < 62; ++rr) {
        int tt = t0 - 30 + rr; const bool ok = tt >= 0; tt = ok ? tt : t0;
        const float v = (float)p->P[(size_t)(tokbase + tt) * NP + ch];
        aw[rr] = ok ? v : 0.f;
    }
    float w[31];
#pragma unroll
    for (int i = 0; i < 31; ++i) w[i] = p->w_dw[(l * 31 + i) * 256 + ch];
    const float bias = p->b_dw[l * 256 + ch];
    float y[32], s1[32], s2[32];
#pragma unroll
    for (int tk = 0; tk < 32; ++tk) {
        float sacc = bias;
#pragma unroll
        for (int i = 0; i < 31; ++i) sacc = fmaf(aw[tk + i], w[i], sacc);
        y[tk] = sacc; s1[tk] = sacc; s2[tk] = sacc * sacc;
    }
    {
        const bool b5 = lane & 32, b4 = lane & 16, b3 = lane & 8, b2 = lane & 4, b1 = lane & 2;
        float a16[16], c16[16], a8[8], c8[8], a4[4], c4[4], a2[2], c2[2];
#pragma unroll
        for (int e = 0; e < 16; ++e) { a16[e] = (b5 ? s1[e + 16] : s1[e]) + __shfl_xor(b5 ? s1[e] : s1[e + 16], 32); c16[e] = (b5 ? s2[e + 16] : s2[e]) + __shfl_xor(b5 ? s2[e] : s2[e + 16], 32); }
#pragma unroll
        for (int e = 0; e < 8; ++e) { a8[e] = (b4 ? a16[e + 8] : a16[e]) + __shfl_xor(b4 ? a16[e] : a16[e + 8], 16); c8[e] = (b4 ? c16[e + 8] : c16[e]) + __shfl_xor(b4 ? c16[e] : c16[e + 8], 16); }
#pragma unroll
        for (int e = 0; e < 4; ++e) { a4[e] = (b3 ? a8[e + 4] : a8[e]) + __shfl_xor(b3 ? a8[e] : a8[e + 4], 8); c4[e] = (b3 ? c8[e + 4] : c8[e]) + __shfl_xor(b3 ? c8[e] : c8[e + 4], 8); }
#pragma unroll
        for (int e = 0; e < 2; ++e) { a2[e] = (b2 ? a4[e + 2] : a4[e]) + __shfl_xor(b2 ? a4[e] : a4[e + 2], 4); c2[e] = (b2 ? c4[e + 2] : c4[e]) + __shfl_xor(b2 ? c4[e] : c4[e + 2], 4); }
        float av = (b1 ? a2[1] : a2[0]) + __shfl_xor(b1 ? a2[0] : a2[1], 2), cv = (b1 ? c2[1] : c2[0]) + __shfl_xor(b1 ? c2[0] : c2[1], 2);
        av += __shfl_xor(av, 1); cv += __shfl_xor(cv, 1);
        const int tokk = (b5 ? 16 : 0) + (b4 ? 8 : 0) + (b3 ? 4 : 0) + (b2 ? 2 : 0) + (b1 ? 1 : 0);
        __syncthreads();
        if ((lane & 1) == 0) { red[(tokk * 4 + wave) * 2] = av; red[(tokk * 4 + wave) * 2 + 1] = cv; }
        __syncthreads();
    }
    const float lg = p->ln_g[l * 256 + ch], lb = p->ln_b[l * 256 + ch];
#pragma unroll
    for (int tk = 0; tk < 32; ++tk) {
        const float4 ra = *(const float4*)(red + tk * 8), rb = *(const float4*)(red + tk * 8 + 4);
        const float t1 = (ra.x + ra.z) + (rb.x + rb.z);
        const float t2 = (ra.y + ra.w) + (rb.y + rb.w);
        const float mu = t1 * (1.0f / 256.0f);
        float var = t2 * (1.0f / 256.0f) - mu * mu; var = var < 0.f ? 0.f : var;
        float z = (y[tk] - mu) * (1.0f / sqrtf(var + 1e-6f)) * lg + lb;
        z = z * sigmoidf_(z);
        p->ycat[((size_t)(ch >> 5) * T_TOK + tokbase + t0 + tk) * 32 + (ch & 31)] = (half_t)z;
    }
}

__device__ __forceinline__ void kmean_unit(KP p, char* lds, int b, int h, int blk) {
    float* part = (float*)lds;
    const int tid = TID(), d = tid & 63, pt = tid >> 6;
    const half_t* r = p->P + (size_t)(b * SEQ + blk * 256 + pt * 64) * NP + PC_MK + h * 64 + d;
    float s = 0.f;
    for (int k = 0; k < 64; ++k) s += (float)r[(size_t)k * NP];
    __syncthreads();
    part[pt * 64 + d] = s;
    __syncthreads();
    if (tid < 64) p->kmean[(((size_t)b * 6 + h) * 8 + blk) * 64 + tid] = ((part[tid] + part[64 + tid]) + (part[128 + tid] + part[192 + tid])) * (1.0f / 256.0f);
}

#ifndef POST_MASK
#define POST_MASK 7
#endif
__device__ __forceinline__ void phase_post(KP p, char* lds, int l, int tm) {
    const int NA = 2048, NB = 1024, NC = 768;
    for (int u = BID(); u < NA + NB + NC; u += gridDim.x) {
        if (u < NA) { if (tm & 1) dsa_select_unit(p, lds, u % 16, 127 - (u / 16)); }
        else if (u < NA + NB) { const int v = u - NA; if (tm & 2) conv_unit(p, lds, l, v % 16, v / 16); }
        else { const int v = u - NA - NB; if (tm & 4) kmean_unit(p, lds, v / 48, (v / 8) % 6, v % 8); }
    }
}

template <int MODE>
__device__ __forceinline__ void attn_unit(KP p, char* lds, int b, int h, int qt) {
    const int tid = TID(), lane = tid & 63, wave = tid >> 6, hh = lane >> 5, ql = lane & 31;
    const int q0 = qt * 128, tokbase = b * SEQ;
    const int tq = q0 + wave * 32 + ql;
    const half_t* Pb = p->P + (size_t)tokbase * NP;
    const int QOFF = MODE ? PC_MQ + h * 64 : PC_DQ + h * 64;
    const int KOFF = MODE ? PC_MK + h * 64 : PC_DK;
    const int VOFF = MODE ? PC_MV + h * 64 : PC_DV;
    const int own = qt >> 1;
    unsigned mysel = 0u, anysel = 0u;
    __syncthreads();
    if (MODE == 1) {
        float* km = (float*)(lds + 32768);
        float* gts = km + 512;
        unsigned* selq = (unsigned*)(gts + 1024);
        unsigned* anyb = selq + 128;
        for (int i = tid; i < 512; i += 256) km[i] = p->kmean[((size_t)b * 6 + h) * 512 + i];
        if (tid == 0) *anyb = 0u;
        __syncthreads();
        {
            const int q = tid & 127, hf = tid >> 7;
            if (hf * 4 < own) {
                const half_t* qr = Pb + (size_t)(q0 + q) * NP + QOFF;
                float g0 = 0.f, g1 = 0.f, g2 = 0.f, g3 = 0.f;
#pragma unroll
                for (int c8 = 0; c8 < 8; ++c8) {
                    const h8 qv = *(const h8*)(qr + c8 * 8);
#pragma unroll
                    for (int j = 0; j < 8; ++j) {
                        const float qf = (float)qv[j]; const int d = c8 * 8 + j;
                        g0 = fmaf(qf, km[(hf * 4 + 0) * 64 + d], g0); g1 = fmaf(qf, km[(hf * 4 + 1) * 64 + d], g1);
                        g2 = fmaf(qf, km[(hf * 4 + 2) * 64 + d], g2); g3 = fmaf(qf, km[(hf * 4 + 3) * 64 + d], g3);
                    }
                }
                gts[q * 8 + hf * 4 + 0] = g0; gts[q * 8 + hf * 4 + 1] = g1; gts[q * 8 + hf * 4 + 2] = g2; gts[q * 8 + hf * 4 + 3] = g3;
            }
        }
        __syncthreads();
        if (tid < 128) {
            unsigned m = 0u;
            const int want = own < 3 ? own : 3;
            for (int r = 0; r < want; ++r) {
                int best = -1; float bv = -INFINITY;
                for (int j = 0; j < own; ++j) { const float gv = gts[tid * 8 + j]; if (!((m >> j) & 1u) && (best < 0 || gv > bv)) { best = j; bv = gv; } }
                m |= 1u << best;
            }
            selq[tid] = m;
            if (m) atomicOr(anyb, m);
        }
        __syncthreads();
        mysel = selq[wave * 32 + ql];
        anysel = *anyb;
        __syncthreads();
    }
    h8 qf[4];
#pragma unroll
    for (int ks = 0; ks < 4; ++ks) qf[ks] = *(const h8*)(Pb + (size_t)tq * NP + QOFF + 16 * ks + 8 * hh);
    f16v O0, O1;
#pragma unroll
    for (int r = 0; r < 16; ++r) { O0[r] = 0.f; O1[r] = 0.f; }
    float m_run = -1e30f, l_run = 0.f;
    const float CS = 0.18033688011112042f;
    const int ntile = 2 * qt + 2;
    auto skip = [&](int kt) -> bool { return MODE == 1 && kt < 4 * own && !((anysel >> (kt >> 2)) & 1u); };
    auto nexttile = [&](int kt) -> int { ++kt; while (kt < ntile && skip(kt)) ++kt; return kt; };
    const int lrow = tid >> 3;
    const int kchunk = (tid & 7) ^ ((tid >> 4) & 7);
    const int vchunk = (tid & 7) ^ (((tid >> 4) & 1) << 2);
    char* ldst = lds + lrow * 128 + (tid & 7) * 16;
    auto issue = [&](int kt, int s) {
        const half_t* src = Pb + (size_t)(kt * 64 + lrow) * NP;
        char* d = ldst + s * 16384;
        glds16(src + KOFF + kchunk * 8, d);
        glds16(src + (size_t)32 * NP + KOFF + kchunk * 8, d + 4096);
        glds16(src + VOFF + vchunk * 8, d + 8192);
        glds16(src + (size_t)32 * NP + VOFF + vchunk * 8, d + 8192 + 4096);
    };
    const int rsw = (lane >> 1) & 7;
    const int kro = ql * 128;
    const int li = lane & 15, qp = li >> 2, pp = li & 3, swv = (qp >> 1) & 1;
    const int vb0 = 8192 + (4 * hh + qp) * 128 + 32 * ((lane >> 4) & 1) + 8 * pp + 64 * (0 ^ swv);
    const int vb1 = 8192 + (4 * hh + qp) * 128 + 32 * ((lane >> 4) & 1) + 8 * pp + 64 * (1 ^ swv);
    int kt = -1; kt = nexttile(kt);
    int s = 0;
    if (kt < ntile) issue(kt, 0);
    while (kt < ntile) {
        const int ktn = nexttile(kt);
        asm volatile("s_waitcnt vmcnt(0)" ::: "memory");
        __syncthreads();
        if (ktn < ntile) issue(ktn, s ^ 1);
        const bool wave_active = (kt * 64 <= q0 + wave * 32 + 31);
        if (wave_active) {
            const char* base = lds + s * 16384;
            uint2 mw = make_uint2(0u, 0u);
            if (MODE == 0) mw = *(const uint2*)(p->dmask + (size_t)(tokbase + tq) * 64 + 2 * kt);
            h8 vf0[4], vf1[4];
#pragma unroll
            for (int kk = 0; kk < 4; ++kk) {
                const int roff = (32 * (kk >> 1) + 16 * (kk & 1)) * 128;
                const s4v lo0 = __builtin_amdgcn_ds_read_tr16_b64_v4i16((LAS s4v*)(base + vb0 + roff));
                const s4v hi0 = __builtin_amdgcn_ds_read_tr16_b64_v4i16((LAS s4v*)(base + vb0 + roff + 8 * 128));
                const s4v lo1 = __builtin_amdgcn_ds_read_tr16_b64_v4i16((LAS s4v*)(base + vb1 + roff));
                const s4v hi1 = __builtin_amdgcn_ds_read_tr16_b64_v4i16((LAS s4v*)(base + vb1 + roff + 8 * 128));
                vf0[kk] = __builtin_bit_cast(h8, __builtin_shufflevector(lo0, hi0, 0, 1, 2, 3, 4, 5, 6, 7));
                vf1[kk] = __builtin_bit_cast(h8, __builtin_shufflevector(lo1, hi1, 0, 1, 2, 3, 4, 5, 6, 7));
            }
            f16v s0, s1;
#pragma unroll
            for (int r = 0; r < 16; ++r) { s0[r] = 0.f; s1[r] = 0.f; }
#pragma unroll
            for (int ks = 0; ks < 4; ++ks) {
                const int co = ((2 * ks + hh) ^ rsw) << 4;
                const h8 k0 = *(const h8*)(base + kro + co), k1 = *(const h8*)(base + kro + 4096 + co);
                s0 = __builtin_amdgcn_mfma_f32_32x32x16_f16(k0, qf[ks], s0, 0, 0, 0);
                s1 = __builtin_amdgcn_mfma_f32_32x32x16_f16(k1, qf[ks], s1, 0, 0, 0);
            }
            bool lane_on = true;
            if (MODE == 0) {
                const unsigned w0 = mw.x >> (4 * hh), w1 = mw.y >> (4 * hh);
#pragma unroll
                for (int r = 0; r < 16; ++r) {
                    const int pos = (r & 3) + 8 * (r >> 2);
                    const unsigned m0 = (unsigned)__builtin_amdgcn_sbfe((int)w0, pos, 1), m1 = (unsigned)__builtin_amdgcn_sbfe((int)w1, pos, 1);
                    s0[r] = __uint_as_float((__float_as_uint(s0[r]) & m0) | (0xFF800000u & ~m0));
                    s1[r] = __uint_as_float((__float_as_uint(s1[r]) & m1) | (0xFF800000u & ~m1));
                }
            } else {
                if (kt < 4 * own) {
                    lane_on = (mysel >> (kt >> 2)) & 1u;
                } else if (kt * 64 + 63 > q0 + wave * 32) {
#pragma unroll
                    for (int r = 0; r < 16; ++r) {
                        const int key = kt * 64 + (r & 3) + 8 * (r >> 2) + 4 * hh;
                        s0[r] = (key <= tq) ? s0[r] : -INFINITY;
                        s1[r] = (key + 32 <= tq) ? s1[r] : -INFINITY;
                    }
                }
            }
            float mx = s0[0];
#pragma unroll
            for (int r = 1; r < 16; ++r) mx = fmaxf(mx, s0[r]);
#pragma unroll
            for (int r = 0; r < 16; ++r) mx = fmaxf(mx, s1[r]);
            mx = lane_on ? mx : -INFINITY;
            mx = fmaxf(mx, __shfl_xor(mx, 32));
            const float mnew = fmaxf(m_run, mx);
            const float alpha = __builtin_amdgcn_exp2f((m_run - mnew) * CS);
            const float mc = lane_on ? mnew * CS : INFINITY;
            m_run = mnew;
            float ls = 0.f;
#pragma unroll
            for (int r = 0; r < 16; ++r) { s0[r] = __builtin_amdgcn_exp2f(fmaf(s0[r], CS, -mc)); ls += s0[r]; }
#pragma unroll
            for (int r = 0; r < 16; ++r) { s1[r] = __builtin_amdgcn_exp2f(fmaf(s1[r], CS, -mc)); ls += s1[r]; }
            l_run = l_run * alpha + ls;
            if (!__all(alpha == 1.0f)) {
#pragma unroll
                for (int r = 0; r < 16; ++r) { O0[r] *= alpha; O1[r] *= alpha; }
            }
#pragma unroll
            for (int kk = 0; kk < 4; ++kk) {
                h8 pf;
#pragma unroll
                for (int j = 0; j < 8; ++j) pf[j] = (half_t)((kk >> 1) ? s1[8 * (kk & 1) + j] : s0[8 * (kk & 1) + j]);
                O0 = __builtin_amdgcn_mfma_f32_32x32x16_f16(vf0[kk], pf, O0, 0, 0, 0);
                O1 = __builtin_amdgcn_mfma_f32_32x32x16_f16(vf1[kk], pf, O1, 0, 0, 0);
            }
        }
        kt = ktn; s ^= 1;
    }
    const float lt = l_run + __shfl_xor(l_run, 32);
    const float inv = 1.0f / lt;
    const int ycol = (MODE ? 640 : 256) + h * 64;
    half_t* dst = p->ycat + ((size_t)(ycol >> 5) * T_TOK + tokbase + tq) * 32 + 4 * hh;
#pragma unroll
    for (int g = 0; g < 4; ++g) {
        *(h4*)(dst + 8 * g) = pack4(O0[4 * g] * inv, O0[4 * g + 1] * inv, O0[4 * g + 2] * inv, O0[4 * g + 3] * inv);
        *(h4*)(dst + (size_t)T_TOK * 32 + 8 * g) = pack4(O1[4 * g] * inv, O1[4 * g + 1] * inv, O1[4 * g + 2] * inv, O1[4 * g + 3] * inv);
    }
}

#ifndef ATT_MASK
#define ATT_MASK 3
#endif
__device__ __forceinline__ void phase_attn(KP p, char* lds, int tm) {
    for (int u = BID(); u < 3072; u += gridDim.x) {
        const int xl = u & 7, Lx = u >> 3;
        const int qt = 15 - (Lx / 24), rem = Lx % 24;
        const int type = rem & 1, bh = xl * 12 + (rem >> 1);
        if (type == 0) { if (tm & 1) attn_unit<0>(p, lds, bh / 6, bh % 6, qt); }
        else { if (tm & 2) attn_unit<1>(p, lds, bh / 6, bh % 6, qt); }
    }
}

__global__ void __launch_bounds__(256, 2) mk_fwd(Params p_unused) {
    extern __shared__ __attribute__((aligned(16))) char lds[];
    volatile LAS unsigned* stw = (volatile LAS unsigned*)(lds + LDS_CTL);
    if (threadIdx.x < 4) stw[threadIdx.x] = 0u;
    __syncthreads();
    KP p0 = (KP)__builtin_amdgcn_kernarg_segment_ptr();
    XcdBarrier bar; bar.bar = p0->bar; bar.x = 0; bar.st = stw;
#if !MK_SPLIT
    bar = xcd_barrier_post(p0->bar, stw);
#endif
    const int ph_lo = p0->ph_lo, ph_hi = p0->ph_hi;
    for (int ph = ph_lo; ph < ph_hi; ++ph) {
      KP p = p0; asm volatile("" : "+s"(p));
      const int nrep = (DUP_SUB >= 0 && ((DUP_SUB == 100 && ph == 0) || (ph >= 2 && ph < NPHASE - 1 && ((ph - 2) & 7) == DUP_SUB && (DUP_SUB != 4 || ph < 10)))) ? 2 : 1;
      for (int rep = 0; rep < nrep; ++rep) {
        if (ph == 0) phase_prologue(p, lds);
        else if (ph == 1) phase_modsum(p);
        else if (ph == NPHASE - 1) phase_norm<2>(p, lds, p->out, p->g_final, nullptr, nullptr, 0);
        else {
            const int l = (ph - 2) >> 3, sub = (ph - 2) & 7;
            const float* mf = p->modf + (size_t)l * 16 * 6144;
            const float* xin = l == 0 ? p->x : p->out;
            if (sub == 0) phase_norm<0>(p, lds, xin, p->g_mix + l * DM, mf, mf + 1024, l);
            else if (sub == 1) phase_inproj(p, lds, l);
            else if (sub == 2) phase_post(p, lds, l, rep ? POST_MASK : 7);
            else if (sub == 3) phase_attn(p, lds, rep ? ATT_MASK : 3);
            else if (sub == 4) phase_outproj(p, lds, l, xin);
            else if (sub == 5) phase_norm<1>(p, lds, p->out, p->g_ffn + l * DM, mf + 3 * 1024, mf + 4 * 1024, (nrep == 2 && rep == 0) ? l + 2 : l);
            else if (sub == 6) phase_moe_up(p, lds, l);
            else phase_moe_down(p, lds, l, nrep == 2 ? 0.5f : 1.0f);
        }
      }
#if !MK_SPLIT
        if (ph + 1 < ph_hi) xcd_barrier(bar);
#endif
    }
}

extern "C" void kernel_launch(void* const* d_in, const int* in_sizes, int n_in, void* d_out, int out_size, void* d_ws, size_t ws_size, hipStream_t stream) {
    static int grid = 0;
    if (grid == 0) {
        int dev = 0, cus = 0, per_cu = 0;
        (void)hipGetDevice(&dev);
        (void)hipDeviceGetAttribute(&cus, hipDeviceAttributeMultiprocessorCount, dev);
        (void)hipFuncSetAttribute((const void*)mk_fwd, hipFuncAttributeMaxDynamicSharedMemorySize, LDS_BYTES);
        if (hipOccupancyMaxActiveBlocksPerMultiprocessor(&per_cu, (const void*)mk_fwd, 256, LDS_BYTES) != hipSuccess || per_cu < 1) per_cu = 1;
        (void)hipGetLastError();
        if (per_cu > 2) per_cu = 2;
        grid = cus * per_cu;
        fprintf(stderr, "mk_fwd: cus %d per_cu %d grid %d\n", cus, per_cu, grid);
    }
    Params p{};
    const float** pin = (const float**)&p.x;
    for (int i = 0; i < 18; ++i) pin[i] = (const float*)d_in[i];
    p.out = (float*)d_out;
    char* ws = (char*)d_ws;
    size_t off = 0;
    auto carve = [&](size_t bytes) { void* q = ws + off; off += (bytes + 255) & ~(size_t)255; return q; };
    p.bar = (unsigned*)carve(XCD_BAR_WORDS * 4);
    p.cnt = (int*)carve(4 * 32 * 64 * 4);
    const size_t zero_bytes = off;
    p.Wt_in = (half_t*)carve((size_t)2 * NP * DM * 2);
    p.Wt_o = (half_t*)carve((size_t)2 * DM * DM * 2);
    p.Wt_gu = (half_t*)carve((size_t)2 * 16 * 512 * 1024 * 2);
    p.Wt_d = (half_t*)carve((size_t)2 * 16 * 1024 * 256 * 2);
    p.hn = (half_t*)carve((size_t)T_TOK * DM * 2);
    p.P = (half_t*)carve((size_t)T_TOK * NP * 2);
    p.ycat = (half_t*)carve((size_t)T_TOK * DM * 2);
    p.act = (half_t*)carve((size_t)T_TOK * 512 * 2);
    p.modpart = (float*)carve((size_t)8 * 2 * 16 * 6144 * 4);
    p.modf = (float*)carve((size_t)2 * 16 * 6144 * 4);
    p.kmean = (float*)carve((size_t)16 * 6 * 8 * 64 * 4);
    p.rope = (float*)carve((size_t)2048 * 24 * 4);
    p.iwf = (float*)carve((size_t)T_TOK * 4 * 4);
    p.tokw = (float*)carve((size_t)T_TOK * 2 * 4);
    p.dmask = (unsigned*)carve((size_t)T_TOK * 64 * 4);
    p.lists = (int*)carve((size_t)NCLS * T_TOK * 4);
    if (off > ws_size) { fprintf(stderr, "workspace too small: need %zu have %zu\n", off, ws_size); return; }
    (void)hipMemsetAsync(d_ws, 0, zero_bytes, stream);
#if MK_SPLIT
    for (int ph = 0; ph < NPHASE; ++ph) {
        p.ph_lo = ph; p.ph_hi = ph + 1;
        hipLaunchKernelGGL(mk_fwd, dim3(grid), dim3(256), LDS_BYTES, stream, p);
    }
#else
    p.ph_lo = 0; p.ph_hi = NPHASE;
    hipLaunchKernelGGL(mk_fwd, dim3(grid), dim3(256), LDS_BYTES, stream, p);
#endif
}
```

```cpp
#include <hip/hip_runtime.h>
#include <cstdio>
#include <cstdint>

#ifndef MK_SPLIT
#define MK_SPLIT 0
#endif

#define T_TOK 32768
#define DM 1024
#define SEQ 2048
#define INW 2340
#define NP 2432
#define PC_CU 0
#define PC_CG 256
#define PC_DQ 512
#define PC_DK 896
#define PC_DV 960
#define PC_IQ 1024
#define PC_IK 1152
#define PC_IW 1184
#define PC_MQ 1280
#define PC_MK 1664
#define PC_MV 2048
#define LOG_THETA 13.122363377404328f
#define NCLS 24
#define LDS_CTL 73728
#define LDS_BYTES 78336
#define NPHASE 19
#ifndef DUP_SUB
#define DUP_SUB -1
#endif

typedef _Float16 half_t;
typedef _Float16 h8 __attribute__((ext_vector_type(8)));
typedef _Float16 h4 __attribute__((ext_vector_type(4)));
typedef short s4v __attribute__((ext_vector_type(4)));
typedef short s8v __attribute__((ext_vector_type(8)));
typedef float f16v __attribute__((ext_vector_type(16)));
typedef float f4v __attribute__((ext_vector_type(4)));
#define LAS __attribute__((address_space(3)))

struct Params {
    const float *x, *c, *w_ada, *b_ada, *g_mix, *w_in, *w_dw, *b_dw, *ln_g, *ln_b, *w_o, *g_ffn, *w_router, *b_router, *w_gate, *w_up, *w_down, *g_final;
    float* out;
    half_t *Wt_in, *Wt_o, *Wt_gu, *Wt_d, *hn, *P, *ycat, *act;
    float *modpart, *modf, *kmean, *rope, *iwf, *tokw;
    unsigned* dmask; int* cnt; int* lists; unsigned* bar;
    int ph_lo, ph_hi;
};

#define XB_TMO      128
#define XB_XCNT(j)  (256  + 64 * (j))
#define XB_XSUB(j)  (1280 + 64 * (j))
#define XB_XGEN(j)  (2304 + 64 * (j))
#define XB_TOP      3328
#define XB_TOPGEN   3392
#define XCD_BAR_WORDS 3456
#define XB_SPIN_CAP (1u << 20)
__device__ __forceinline__ unsigned xb_ld(unsigned* p)              { return __hip_atomic_load(p, __ATOMIC_RELAXED, __HIP_MEMORY_SCOPE_AGENT); }
__device__ __forceinline__ unsigned xb_add(unsigned* p, unsigned v) { return __hip_atomic_fetch_add(p, v, __ATOMIC_RELAXED, __HIP_MEMORY_SCOPE_AGENT); }
__device__ __forceinline__ unsigned xb_xcc_id() { return (unsigned)__builtin_amdgcn_s_getreg((3 << 11) | 20) & 0xFu; }
#define XB_SPIN(cond, bar) do { unsigned _sp = 0; while (cond) { __builtin_amdgcn_s_sleep(1); \
    if ((++_sp & 255u) == 0u) { if (xb_ld(&(bar)[XB_TMO])) break; if (_sp > XB_SPIN_CAP) { atomicAdd(&(bar)[XB_TMO], 1u); break; } } } } while (0)
struct XcdBarrier { unsigned* bar; unsigned x; volatile LAS unsigned* st; };
__device__ __forceinline__ XcdBarrier xcd_barrier_post(unsigned* bar, volatile LAS unsigned* st) {
    XcdBarrier b; b.bar = bar; b.x = xb_xcc_id(); b.st = st;
    if (threadIdx.x == 0) (void)xb_add(&bar[XB_XCNT(b.x)], 1u);
    return b;
}
__device__ __forceinline__ void xcd_barrier_complete(unsigned* bar, unsigned x, unsigned& nloc, unsigned& nx) {
    const unsigned G = gridDim.x * gridDim.y * gridDim.z;
    unsigned sum, cnt, mine, sp = 0u;
    for (;;) {
        sum = 0u; cnt = 0u; mine = 0u;
#pragma unroll
        for (unsigned j = 0; j < 16; ++j) { const unsigned c = xb_ld(&bar[XB_XCNT(j)]); sum += c; cnt += (c > 0u) ? 1u : 0u; mine = (j == x) ? c : mine; }
        if (sum == G) break;
        __builtin_amdgcn_s_sleep(1);
        if ((++sp & 255u) == 0u) { if (xb_ld(&bar[XB_TMO])) break; if (sp > XB_SPIN_CAP) { atomicAdd(&bar[XB_TMO], 1u); break; } }
    }
    nloc = mine > 0u ? mine : 1u; nx = cnt > 0u ? cnt : 1u;
}
__device__ __forceinline__ void xcd_barrier(const XcdBarrier& b) {
    asm volatile("s_waitcnt vmcnt(0)" ::: "memory");
    __syncthreads();
    if (threadIdx.x == 0) {
        unsigned* bar = b.bar;
        __builtin_amdgcn_s_waitcnt(0);
        unsigned nloc = b.st[0], nx = b.st[1];
        if (nloc == 0u) { xcd_barrier_complete(bar, b.x, nloc, nx); b.st[0] = nloc; b.st[1] = nx; }
        const unsigned old = xb_add(&bar[XB_XSUB(b.x)], 1u);
        const unsigned gen = old / nloc;
        if (old + 1u == (gen + 1u) * nloc) {
            __builtin_amdgcn_fence(__ATOMIC_RELEASE, "agent");
            asm volatile("s_waitcnt vmcnt(0)" ::: "memory");
            const unsigned og = xb_add(&bar[XB_TOP], 1u);
            const unsigned tg = og / nx;
            if (og + 1u == (tg + 1u) * nx) xb_add(&bar[XB_TOPGEN], 1u);
            else XB_SPIN(xb_ld(&bar[XB_TOPGEN]) == tg, bar);
            __builtin_amdgcn_fence(__ATOMIC_ACQUIRE, "agent");
            xb_add(&bar[XB_XGEN(b.x)], 1u);
            asm volatile("s_waitcnt vmcnt(0)" ::: "memory");
        } else {
            XB_SPIN(xb_ld(&bar[XB_XGEN(b.x)]) == gen, bar);
            __builtin_amdgcn_fence(__ATOMIC_ACQUIRE, "agent");
            asm volatile("s_waitcnt vmcnt(0)" ::: "memory");
        }
    }
    __syncthreads();
}

typedef const __attribute__((address_space(4))) Params* KP;
__device__ __forceinline__ int TID() { int t = threadIdx.x; asm volatile("" : "+v"(t)); return t; }
__device__ __forceinline__ int BID() { int b = blockIdx.x; asm volatile("" : "+s"(b)); return b; }
__device__ __forceinline__ float sigmoidf_(float v) { return __builtin_amdgcn_rcpf(1.0f + __expf(-v)); }
__device__ __forceinline__ void glds16(const void* g, char* l) { __builtin_amdgcn_global_load_lds((const unsigned*)g, (unsigned*)l, 16, 0, 0); }
__device__ __forceinline__ unsigned f2sortable(float f) { unsigned u = __float_as_uint(f); return (u & 0x80000000u) ? ~u : (u | 0x80000000u); }
__device__ __forceinline__ h4 pack4(float a, float b, float c, float d) { h4 r = {(half_t)a, (half_t)b, (half_t)c, (half_t)d}; return r; }

template <class CF>
__device__ __forceinline__ void conv_tile_panel(char* lds, CF colf, int src_ld, int k0, int n0, half_t* dst, int nrows) {
    float* tl = (float*)lds;
    const int tid = TID();
    __syncthreads();
    {
        const int nn = tid & 63;
        const float* cp = colf(nn);
        float tv[16];
#pragma unroll
        for (int i = 0; i < 16; ++i) { const int k = i * 4 + (tid >> 6); tv[i] = cp ? cp[(size_t)(k0 + k) * src_ld] : 0.f; }
#pragma unroll
        for (int i = 0; i < 16; ++i) { const int k = i * 4 + (tid >> 6); tl[k * 65 + nn] = tv[i]; }
    }
    __syncthreads();
    {
        const int n = tid >> 2, kq = (tid & 3) * 16;
        h8 a, b;
#pragma unroll
        for (int j = 0; j < 8; ++j) { a[j] = (half_t)tl[(kq + j) * 65 + n]; b[j] = (half_t)tl[(kq + 8 + j) * 65 + n]; }
        const int k = k0 + kq;
        h8* d = (h8*)(dst + ((size_t)(k >> 5) * nrows + n0 + n) * 32 + (k & 31));
        d[0] = a; d[1] = b;
    }
}
template <class CF>
__device__ __forceinline__ void conv_tile(char* lds, CF colf, int src_ld, int k0, half_t* dst_tile  , int dstK) {
    float* tl = (float*)lds;
    const int tid = TID();
    __syncthreads();
    {
        const int nn = tid & 63;
        const float* cp = colf(nn);
        float tv[16];
#pragma unroll
        for (int i = 0; i < 16; ++i) { const int k = i * 4 + (tid >> 6); tv[i] = cp ? cp[(size_t)(k0 + k) * src_ld] : 0.f; }
#pragma unroll
        for (int i = 0; i < 16; ++i) { const int k = i * 4 + (tid >> 6); tl[k * 65 + nn] = tv[i]; }
    }
    __syncthreads();
    {
        const int n = tid >> 2, kq = (tid & 3) * 16;
        h8 a, b;
#pragma unroll
        for (int j = 0; j < 8; ++j) { a[j] = (half_t)tl[(kq + j) * 65 + n]; b[j] = (half_t)tl[(kq + 8 + j) * 65 + n]; }
        h8* d = (h8*)(dst_tile + (size_t)n * dstK + kq);
        d[0] = a; d[1] = b;
    }
}

__device__ __forceinline__ void phase_prologue(KP p, char* lds) {
    const int tid = TID();
    const int NA = 2 * 16 * 38, NB = 2 * 16 * 16, NC = 2 * 16 * 16 * 8, ND = 2 * 16 * 4 * 16, NE = 384, NF = 8;
    const int total = NA + NB + NC + ND + NE + NF;
    for (int u0 = BID(); u0 < total; u0 += gridDim.x) {
        int u = u0;
        if (u < NA) {
            const int nt = u % 38, kt = (u / 38) % 16, l = u / (38 * 16);
            const float* src = p->w_in + (size_t)l * DM * INW;
            const int n0 = nt * 64;
            conv_tile_panel(lds, [&](int nn) -> const float* { const int np = n0 + nn; const int sc = np < 512 ? (((np & 63) < 32) ? 32 * (np >> 6) + (np & 31) : 256 + 32 * (np >> 6) + (np & 31)) : (np < 1188 ? np : (np < 1280 ? -1 : np - 92)); return sc >= 0 ? src + sc : (const float*)nullptr; },
                      INW, kt * 64, n0, p->Wt_in + (size_t)l * NP * DM, NP);
            continue;
        }
        u -= NA;
        if (u < NB) {
            const int nt = u % 16, kt = (u / 16) % 16, l = u / 256;
            const float* src = p->w_o + (size_t)l * DM * DM + nt * 64;
            conv_tile_panel(lds, [&](int nn) -> const float* { return src + nn; }, DM, kt * 64, nt * 64, p->Wt_o + (size_t)l * DM * DM, DM);
            continue;
        }
        u -= NB;
        if (u < NC) {
            const int nt = u % 8, kt = (u / 8) % 16, le = u / 128;
            const float* sg = p->w_gate + (size_t)le * 1024 * 256 + nt * 32;
            const float* su = p->w_up + (size_t)le * 1024 * 256 + nt * 32;
            conv_tile(lds, [&](int nn) -> const float* { return nn < 32 ? sg + nn : su + (nn - 32); }, 256, kt * 64, p->Wt_gu + ((size_t)le * 512 + nt * 64) * 1024 + kt * 64, 1024);
            continue;
        }
        u -= NC;
        if (u < ND) {
            const int nt = u % 16, kt = (u / 16) % 4, le = u / 64;
            const float* src = p->w_down + (size_t)le * 256 * 1024 + nt * 64;
            conv_tile(lds, [&](int nn) -> const float* { return src + nn; }, 1024, kt * 64, p->Wt_d + ((size_t)le * 1024 + nt * 64) * 256 + kt * 64, 256);
            continue;
        }
        u -= ND;
        if (u < NE) {
            const int kc = u % 8, cc = (u / 8) % 24, l = u / 192;
            float* ca = (float*)lds;
            __syncthreads();
            for (int i = tid; i < 2048; i += 256) { const int b = i >> 7, k = i & 127; const float v = p->c[b * 1024 + kc * 128 + k]; ca[i] = v / (1.0f + expf(-v)); }
            __syncthreads();
            const int n = cc * 256 + tid;
            float acc[16];
#pragma unroll
            for (int b = 0; b < 16; ++b) acc[b] = 0.f;
            const float* w = p->w_ada + ((size_t)l * 1024 + kc * 128) * 6144 + n;
#pragma unroll 16
            for (int k = 0; k < 128; ++k) {
                const float wv = w[(size_t)k * 6144];
#pragma unroll
                for (int b = 0; b < 16; ++b) acc[b] = fmaf(ca[b * 128 + k], wv, acc[b]);
            }
#pragma unroll
            for (int b = 0; b < 16; ++b) p->modpart[(((size_t)kc * 2 + l) * 16 + b) * 6144 + n] = acc[b];
            continue;
        }
        u -= NE;
        {
            for (int i = u * 256 + tid; i < 2048 * 12; i += NF * 256) {
                const int t = i / 12, r = i % 12;
                const int fi = r < 8 ? r : r - 8;
                const float rot = r < 8 ? 16.f : 8.f;
                const float inv = expf(-LOG_THETA * ((float)fi * 2.0f / rot));
                const float ang = (float)t * inv;
                float sn, cs; sincosf(ang, &sn, &cs);
                if (r < 8) { p->rope[t * 8 + fi] = cs; p->rope[16384 + t * 8 + fi] = sn; }
                else { p->rope[32768 + t * 4 + fi] = cs; p->rope[32768 + 8192 + t * 4 + fi] = sn; }
            }
        }
    }
}

__device__ __forceinline__ void phase_modsum(KP p) {
    for (int i = BID() * 256 + TID(); i < 2 * 16 * 6144; i += gridDim.x * 256) {
        const int n = i % 6144, l = i / (16 * 6144);
        float s = p->b_ada[l * 6144 + n];
#pragma unroll
        for (int kc = 0; kc < 8; ++kc) s += p->modpart[(size_t)kc * (2 * 16 * 6144) + i];
        p->modf[i] = s;
    }
}

__device__ __forceinline__ void route_flush(KP p, char* lds, int lane, int wave, int n, int myrow, int layer) {
    const float* lg = (const float*)(lds + LDS_CTL + 512) + wave * 256;
    int* lc = (int*)(lds + LDS_CTL + 64);
    int* lbase = lc + 32;
    const int tid = wave * 64 + lane;
    if (tid < 32) lc[tid] = 0;
    __syncthreads();
    int cls = 0, lpos = 0;
    if (lane < n) {
        float aff[16], bia[16];
#pragma unroll
        for (int e = 0; e < 16; ++e) { aff[e] = 1.0f / (1.0f + expf(-lg[lane * 16 + e])); bia[e] = aff[e] + p->b_router[e]; }
        int bestg = 0; float bests = -INFINITY;
#pragma unroll
        for (int gi = 0; gi < 4; ++gi) {
            float m1 = -INFINITY, m2 = -INFINITY;
#pragma unroll
            for (int j = 0; j < 4; ++j) { const float vv = bia[gi * 4 + j]; if (vv > m1) { m2 = m1; m1 = vv; } else if (vv > m2) m2 = vv; }
            const float s = m1 + m2;
            if (s > bests) { bests = s; bestg = gi; }
        }
        float bsel[4], asel[4];
#pragma unroll
        for (int j = 0; j < 4; ++j) { bsel[j] = 0.f; asel[j] = 0.f; }
#pragma unroll
        for (int gi = 0; gi < 4; ++gi) if (gi == bestg) {
#pragma unroll
            for (int j = 0; j < 4; ++j) { bsel[j] = bia[gi * 4 + j]; asel[j] = aff[gi * 4 + j]; }
        }
        int i1 = -1, i2 = -1; float v1 = -INFINITY, v2 = -INFINITY;
#pragma unroll
        for (int j = 0; j < 4; ++j) { const float vv = bsel[j]; if (vv > v1) { v2 = v1; i2 = i1; v1 = vv; i1 = j; } else if (vv > v2) { v2 = vv; i2 = j; } }
        const int a = i1 < i2 ? i1 : i2, bb = i1 < i2 ? i2 : i1;
        float wa = 0.f, wb = 0.f;
#pragma unroll
        for (int j = 0; j < 4; ++j) { if (j == a) wa = asel[j]; if (j == bb) wb = asel[j]; }
        const float sw = wa + wb;
        const int pi = (a == 0) ? (bb - 1) : (a == 1 ? (bb + 1) : 5);
        cls = bestg * 6 + pi;
        *(float2*)(p->tokw + (size_t)myrow * 2) = make_float2(wa / sw, wb / sw);
        lpos = atomicAdd(&lc[cls], 1);
    }
    __syncthreads();
    if (tid < NCLS) { const int c = lc[tid]; lbase[tid] = c ? atomicAdd(&p->cnt[(layer * 32 + tid) * 64], c) : 0; }
    __syncthreads();
    if (lane < n) p->lists[(size_t)cls * T_TOK + lbase[cls] + lpos] = myrow;
}

template <int MODE>
__device__ __forceinline__ void phase_norm(KP p, char* lds, const float* xin, const float* g, const float* sh, const float* sc, int layer) {
    const int lane = TID() & 63, wave = TID() >> 6;
    float* wt = (float*)lds;
    if (MODE == 1) {
        __syncthreads();
        for (int i = TID(); i < 4096; i += 256) {
            const float4 w4 = ((const float4*)p->w_router)[i];
            const int k = i >> 2, e0 = (i & 3) * 4;
            wt[(e0 + 0) * 1024 + k] = w4.x; wt[(e0 + 1) * 1024 + k] = w4.y; wt[(e0 + 2) * 1024 + k] = w4.z; wt[(e0 + 3) * 1024 + k] = w4.w;
        }
        __syncthreads();
    }
    float* lgb = (float*)(lds + LDS_CTL + 512);
    int myrow = 0, it = 0;
    float4 vn[4];
    {
        const int row0 = BID() * 4 + wave;
        const float4* xr = (const float4*)(xin + (size_t)(row0 < T_TOK ? row0 : 0) * DM);
#pragma unroll
        for (int i = 0; i < 4; ++i) vn[i] = xr[lane + 64 * i];
    }
    for (int row = BID() * 4 + wave; row < T_TOK; row += gridDim.x * 4) {
        const int b = row >> 11;
        float4 v[4]; float ss = 0.f;
#pragma unroll
        for (int i = 0; i < 4; ++i) v[i] = vn[i];
        {
            const int rown = row + gridDim.x * 4;
            const float4* xr = (const float4*)(xin + (size_t)(rown < T_TOK ? rown : row) * DM);
#pragma unroll
            for (int i = 0; i < 4; ++i) vn[i] = xr[lane + 64 * i];
        }
#pragma unroll
        for (int i = 0; i < 4; ++i) ss += v[i].x * v[i].x + v[i].y * v[i].y + v[i].z * v[i].z + v[i].w * v[i].w;
#pragma unroll
        for (int o = 32; o >= 1; o >>= 1) ss += __shfl_xor(ss, o);
        const float rstd = 1.0f / sqrtf(ss * (1.0f / 1024.0f) + 1e-6f);
        float acc[16], ya[16];
#pragma unroll
        for (int i = 0; i < 4; ++i) {
            const int k = (lane + 64 * i) * 4;
            const float4 gg = *(const float4*)(g + k);
            float y[4] = {v[i].x * rstd * gg.x, v[i].y * rstd * gg.y, v[i].z * rstd * gg.z, v[i].w * rstd * gg.w};
            if (MODE != 2) {
                const float4 s1 = *(const float4*)(sh + (size_t)b * 6144 + k), s2 = *(const float4*)(sc + (size_t)b * 6144 + k);
                y[0] = y[0] * (1.f + s2.x) + s1.x; y[1] = y[1] * (1.f + s2.y) + s1.y; y[2] = y[2] * (1.f + s2.z) + s1.z; y[3] = y[3] * (1.f + s2.w) + s1.w;
                if (MODE == 0) *(h4*)(p->hn + ((size_t)(k >> 5) * T_TOK + row) * 32 + (k & 31)) = pack4(y[0], y[1], y[2], y[3]);
                else *(h4*)(p->hn + (size_t)row * DM + k) = pack4(y[0], y[1], y[2], y[3]);
            } else {
                *(float4*)(p->out + (size_t)row * DM + k) = make_float4(y[0], y[1], y[2], y[3]);
            }
            ya[4 * i] = y[0]; ya[4 * i + 1] = y[1]; ya[4 * i + 2] = y[2]; ya[4 * i + 3] = y[3];
        }
        if (MODE == 1) {
#pragma unroll
            for (int e = 0; e < 16; ++e) acc[e] = 0.f;
            float4 wq[2][4];
            const float* wl = wt + lane * 4;
#pragma unroll
            for (int e = 0; e < 4; ++e) wq[0][e] = *(const float4*)(wl + e * 1024);
#pragma unroll
            for (int st = 0; st < 16; ++st) {
                const int i = st >> 2, eg = st & 3, cur = st & 1;
                if (st + 1 < 16) {
                    const int i2 = (st + 1) >> 2, eg2 = (st + 1) & 3;
#pragma unroll
                    for (int e = 0; e < 4; ++e) wq[cur ^ 1][e] = *(const float4*)(wl + (eg2 * 4 + e) * 1024 + i2 * 256);
                }
#pragma unroll
                for (int e = 0; e < 4; ++e) {
                    const float4 w4 = wq[cur][e];
                    acc[eg * 4 + e] = fmaf(ya[4 * i], w4.x, fmaf(ya[4 * i + 1], w4.y, fmaf(ya[4 * i + 2], w4.z, fmaf(ya[4 * i + 3], w4.w, acc[eg * 4 + e]))));
                }
                __builtin_amdgcn_sched_barrier(0);
            }
        }
        if (MODE == 1) {
            const bool b5 = lane & 32, b4 = lane & 16, b3 = lane & 8, b2 = lane & 4;
            float r8[8], r4[4], r2[2];
#pragma unroll
            for (int e = 0; e < 8; ++e) { const float snd = b5 ? acc[e] : acc[e + 8], kp = b5 ? acc[e + 8] : acc[e]; r8[e] = kp + __shfl_xor(snd, 32); }
#pragma unroll
            for (int e = 0; e < 4; ++e) { const float snd = b4 ? r8[e] : r8[e + 4], kp = b4 ? r8[e + 4] : r8[e]; r4[e] = kp + __shfl_xor(snd, 16); }
#pragma unroll
            for (int e = 0; e < 2; ++e) { const float snd = b3 ? r4[e] : r4[e + 2], kp = b3 ? r4[e + 2] : r4[e]; r2[e] = kp + __shfl_xor(snd, 8); }
            float rv; { const float snd = b2 ? r2[0] : r2[1], kp = b2 ? r2[1] : r2[0]; rv = kp + __shfl_xor(snd, 4); }
            rv += __shfl_xor(rv, 2); rv += __shfl_xor(rv, 1);
            if ((lane & 3) == 0) lgb[(wave * 16 + it) * 16 + (lane >> 2)] = rv;
            if (lane == it) myrow = row;
            ++it;
            if (it == 16) { route_flush(p, lds, lane, wave, it, myrow, layer); it = 0; }
        }
    }
    if (MODE == 1 && it > 0) route_flush(p, lds, lane, wave, it, myrow, layer);
}

template <class WF, class XF, class EPI>
__device__ __forceinline__ void gemm_tile(char* lds, int nkt, WF wf, XF xf, EPI epi) {
    const int tid = TID(), lane = tid & 63, wave = tid >> 6;
    const int wn = wave & 1, wm = wave >> 1, hh = lane >> 5;
    const int lrow = tid >> 3;
    const int lchunk = (tid & 7) ^ ((tid >> 4) & 7);
    const half_t* xs[4];
#pragma unroll
    for (int i = 0; i < 4; ++i) xs[i] = xf(lrow + 32 * i) + lchunk * 8;
    char* ldst = lds + lrow * 128 + (tid & 7) * 16;
    f16v acc[2][2];
#pragma unroll
    for (int i = 0; i < 2; ++i)
#pragma unroll
        for (int j = 0; j < 2; ++j)
#pragma unroll
            for (int r = 0; r < 16; ++r) acc[i][j][r] = 0.f;
    auto issue = [&](int kt, int s) {
        char* d = ldst + s * 32768;
#pragma unroll
        for (int i = 0; i < 4; ++i) glds16(wf(kt, lrow + 32 * i) + lchunk * 8, d + i * 4096);
#pragma unroll
        for (int i = 0; i < 4; ++i) glds16(xs[i] + kt * 64, d + 16384 + i * 4096);
    };
    __syncthreads();
    issue(0, 0);
    const int rsw = (lane >> 1) & 7;
    const int roff_w = (wn * 64 + (lane & 31)) * 128, roff_x = 16384 + (wm * 64 + (lane & 31)) * 128;
    for (int kt = 0; kt < nkt; ++kt) {
        asm volatile("s_waitcnt vmcnt(0)" ::: "memory");
        __syncthreads();
        if (kt + 1 < nkt) issue(kt + 1, (kt + 1) & 1);
        const char* base = lds + (kt & 1) * 32768;
#pragma unroll
        for (int ks = 0; ks < 4; ++ks) {
            const int co = ((2 * ks + hh) ^ rsw) << 4;
            const h8 a0 = *(const h8*)(base + roff_w + co), a1 = *(const h8*)(base + roff_w + 4096 + co);
            const h8 b0 = *(const h8*)(base + roff_x + co), b1 = *(const h8*)(base + roff_x + 4096 + co);
            acc[0][0] = __builtin_amdgcn_mfma_f32_32x32x16_f16(a0, b0, acc[0][0], 0, 0, 0);
            acc[0][1] = __builtin_amdgcn_mfma_f32_32x32x16_f16(a0, b1, acc[0][1], 0, 0, 0);
            acc[1][0] = __builtin_amdgcn_mfma_f32_32x32x16_f16(a1, b0, acc[1][0], 0, 0, 0);
            acc[1][1] = __builtin_amdgcn_mfma_f32_32x32x16_f16(a1, b1, acc[1][1], 0, 0, 0);
        }
    }
    epi(acc, wn, wm, lane);
}

template <class WF, class XF, class EPI>
__device__ __forceinline__ void gemm_tile2(char* lds, int nkt, size_t xkstride, WF wf, XF xf, EPI epi) {
    const int tid = TID(), lane = tid & 63, wave = tid >> 6;
    const int wn = wave & 1, wm = wave >> 1, hh = lane >> 5;
    const int lrow = tid >> 2;
    const int lchunk = (tid & 3) ^ ((tid >> 4) & 3);
    const half_t* xs[2];
#pragma unroll
    for (int i = 0; i < 2; ++i) xs[i] = xf(lrow + 64 * i) + lchunk * 8;
    char* ldst = lds + lrow * 64 + (tid & 3) * 16;
    f16v acc[4][2];
#pragma unroll
    for (int i = 0; i < 4; ++i)
#pragma unroll
        for (int j = 0; j < 2; ++j)
#pragma unroll
            for (int r = 0; r < 16; ++r) acc[i][j][r] = 0.f;
    auto issue = [&](int kt, int s) {
        char* d = ldst + s * 24576;
#pragma unroll
        for (int i = 0; i < 4; ++i) glds16(wf(kt, lrow + 64 * i) + lchunk * 8, d + i * 4096);
#pragma unroll
        for (int i = 0; i < 2; ++i) glds16(xs[i] + (size_t)kt * xkstride, d + 16384 + i * 4096);
    };
    __syncthreads();
    issue(0, 0); issue(1, 1);
    const int rsw = (lane >> 2) & 3;
    const int roff_w = (wn * 128 + (lane & 31)) * 64, roff_x = 16384 + (wm * 64 + (lane & 31)) * 64;
    int st = 0;
    for (int kt = 0; kt < nkt; ++kt) {
        if (kt + 1 < nkt) asm volatile("s_waitcnt vmcnt(6)" ::: "memory");
        else asm volatile("s_waitcnt vmcnt(0)" ::: "memory");
        asm volatile("s_waitcnt lgkmcnt(0)" ::: "memory");
        __builtin_amdgcn_s_barrier();
        if (kt + 2 < nkt) issue(kt + 2, st >= 1 ? st - 1 : 2);
        const char* base = lds + st * 24576;
        st = st == 2 ? 0 : st + 1;
#pragma unroll
        for (int ks = 0; ks < 2; ++ks) {
            const int co = ((2 * ks + hh) ^ rsw) << 4;
            h8 a[4], b[2];
#pragma unroll
            for (int i = 0; i < 4; ++i) a[i] = *(const h8*)(base + roff_w + i * 2048 + co);
#pragma unroll
            for (int j = 0; j < 2; ++j) b[j] = *(const h8*)(base + roff_x + j * 2048 + co);
#pragma unroll
            for (int i = 0; i < 4; ++i)
#pragma unroll
                for (int j = 0; j < 2; ++j) acc[i][j] = __builtin_amdgcn_mfma_f32_32x32x16_f16(a[i], b[j], acc[i][j], 0, 0, 0);
        }
    }
    epi(acc, wn, wm, lane);
}

__device__ __forceinline__ void phase_inproj(KP p, char* lds, int l) {
    const half_t* W = p->Wt_in + (size_t)l * NP * DM;
    const float* rc16 = p->rope; const float* rs16 = p->rope + 16384; const float* rc8 = p->rope + 32768; const float* rs8 = p->rope + 32768 + 8192;
    for (int u = BID(); u < 256 * 10; u += gridDim.x) {
        const int xl = u & 7, Lx = u >> 3, mi = Lx & 7, rr_ = Lx >> 3;
        const int nt = rr_ % 10, mt = 32 * xl + 8 * (rr_ / 10) + mi;
        gemm_tile2(lds, 32, (size_t)T_TOK * 32,
            [&](int kt, int row) { int n = nt * 256 + row; n = n < NP ? n : NP - 1; return W + ((size_t)kt * NP + n) * 32; },
            [&](int row) { return p->hn + (size_t)(mt * 128 + row) * 32; },
            [&](f16v (&acc)[4][2], int wn, int wm, int lane) {
                const int hh = lane >> 5;
                half_t* stg = (half_t*)lds;
                __syncthreads();
#pragma unroll
                for (int i = 0; i < 4; ++i) {
                    const int nb = nt * 256 + wn * 128 + i * 32;
                    if (nb == 1216 || nb == 1248 || nb >= NP) continue;
                    if (nt < 2) {
                        if (i & 1) continue;
#pragma unroll
                        for (int j = 0; j < 2; ++j) {
                            half_t* dst = stg + (wm * 64 + j * 32 + (lane & 31)) * 260 + wn * 64 + (i >> 1) * 32 + 4 * hh;
#pragma unroll
                            for (int g = 0; g < 4; ++g) {
                                float a4[4];
#pragma unroll
                                for (int r = 0; r < 4; ++r) a4[r] = acc[i][j][4 * g + r] * sigmoidf_(acc[i + 1][j][4 * g + r]);
                                *(h4*)(dst + 8 * g) = pack4(a4[0], a4[1], a4[2], a4[3]);
                            }
                        }
                        continue;
                    }
                    const bool rope64 = ((nb >= PC_DQ && nb < PC_DV) || (nb >= PC_MQ && nb < PC_MV)) && ((nb & 63) == 0);
                    const bool rope32 = (nb >= PC_IQ && nb < PC_IW);
#pragma unroll
                    for (int j = 0; j < 2; ++j) {
                        const int tok = mt * 128 + wm * 64 + j * 32 + (lane & 31);
                        const int t = tok & 2047;
                        f16v v = acc[i][j];
                        if (nb == PC_IW) { if (hh == 0) *(float4*)(p->iwf + (size_t)tok * 4) = make_float4(v[0], v[1], v[2], v[3]); continue; }
                        if (rope64) {
                            const float4 c4 = *(const float4*)(rc16 + t * 8 + 4 * hh), s4 = *(const float4*)(rs16 + t * 8 + 4 * hh);
                            const float cc[4] = {c4.x, c4.y, c4.z, c4.w}, sn[4] = {s4.x, s4.y, s4.z, s4.w};
#pragma unroll
                            for (int r = 0; r < 4; ++r) { const float x1 = v[r], x2 = v[r + 4]; v[r] = x1 * cc[r] - x2 * sn[r]; v[r + 4] = x2 * cc[r] + x1 * sn[r]; }
                        } else if (rope32) {
                            const float4 c4 = *(const float4*)(rc8 + t * 4), s4 = *(const float4*)(rs8 + t * 4);
                            const float cc[4] = {c4.x, c4.y, c4.z, c4.w}, sn[4] = {s4.x, s4.y, s4.z, s4.w};
#pragma unroll
                            for (int r = 0; r < 4; ++r) { const float o = __shfl_xor(v[r], 32); v[r] = hh ? (v[r] * cc[r] + o * sn[r]) : (v[r] * cc[r] - o * sn[r]); }
                        }
                        half_t* dst = stg + (wm * 64 + j * 32 + (lane & 31)) * 260 + wn * 128 + i * 32 + 4 * hh;
#pragma unroll
                        for (int g = 0; g < 4; ++g) *(h4*)(dst + 8 * g) = pack4(v[4 * g], v[4 * g + 1], v[4 * g + 2], v[4 * g + 3]);
                    }
                }
                __syncthreads();
                const int wv_ = TID() >> 6;
#pragma unroll 4
                for (int it = 0; it < 32; ++it) {
                    const int row = it * 4 + wv_;
                    const uint2 v2 = *(const uint2*)(stg + row * 260 + lane * 4);
                    if (nt < 2) { if (lane < 32) *(uint2*)(p->P + (size_t)(mt * 128 + row) * NP + nt * 128 + lane * 4) = v2; }
                    else { const int n = nt * 256 + lane * 4; if (n < NP) *(uint2*)(p->P + (size_t)(mt * 128 + row) * NP + n) = v2; }
                }
            });
    }
}

__device__ __forceinline__ void stage_acc_f32(char* lds, const f16v (&acc)[2][2], int wn, int wm, int lane) {
    float* stg = (float*)lds;
    const int hh = lane >> 5;
    __syncthreads();
#pragma unroll
    for (int j = 0; j < 2; ++j)
#pragma unroll
        for (int i = 0; i < 2; ++i)
#pragma unroll
            for (int g = 0; g < 4; ++g)
                *(float4*)(stg + (wm * 64 + j * 32 + (lane & 31)) * 132 + wn * 64 + i * 32 + 4 * hh + 8 * g) = make_float4(acc[i][j][4 * g], acc[i][j][4 * g + 1], acc[i][j][4 * g + 2], acc[i][j][4 * g + 3]);
    __syncthreads();
}
__device__ __forceinline__ void phase_outproj(KP p, char* lds, int l, const float* xin) {
    const half_t* W = p->Wt_o + (size_t)l * DM * DM;
    const float* g1 = p->modf + (size_t)l * 16 * 6144 + 2 * 1024;
    for (int u = BID(); u < 256 * 4; u += gridDim.x) {
        const int xl = u & 7, Lx = u >> 3, mi = Lx & 7, rr_ = Lx >> 3;
        const int nt = rr_ & 3, mt = 32 * xl + 8 * (rr_ >> 2) + mi;
        gemm_tile2(lds, 32, (size_t)T_TOK * 32,
            [&](int kt, int row) { return W + ((size_t)kt * DM + nt * 256 + row) * 32; },
            [&](int row) { return p->ycat + (size_t)(mt * 128 + row) * 32; },
            [&](f16v (&acc)[4][2], int wn, int wm, int lane) {
                const int hh = lane >> 5, tid = TID();
                float* stg = (float*)lds;
#pragma unroll
                for (int rnd = 0; rnd < 2; ++rnd) {
                    __syncthreads();
                    if (wm == rnd) {
#pragma unroll
                        for (int j = 0; j < 2; ++j)
#pragma unroll
                            for (int i = 0; i < 4; ++i)
#pragma unroll
                                for (int g = 0; g < 4; ++g)
                                    *(float4*)(stg + (j * 32 + (lane & 31)) * 260 + wn * 128 + i * 32 + 4 * hh + 8 * g) = make_float4(acc[i][j][4 * g], acc[i][j][4 * g + 1], acc[i][j][4 * g + 2], acc[i][j][4 * g + 3]);
                    }
                    __syncthreads();
#pragma unroll 4
                    for (int it = 0; it < 16; ++it) {
                        const int idx = it * 256 + tid, row = idx >> 6, c = idx & 63;
                        const int tok = mt * 128 + rnd * 64 + row, n = nt * 256 + 4 * c;
                        const float4 a4 = *(const float4*)(stg + row * 260 + 4 * c);
                        const float4 xi = *(const float4*)(xin + (size_t)tok * DM + n);
                        const float4 gg = *(const float4*)(g1 + (size_t)(tok >> 11) * 6144 + n);
                        float4 o; o.x = xi.x + gg.x * a4.x; o.y = xi.y + gg.y * a4.y; o.z = xi.z + gg.z * a4.z; o.w = xi.w + gg.w * a4.w;
                        *(float4*)(p->out + (size_t)tok * DM + n) = o;
                    }
                }
            });
    }
}

__device__ __forceinline__ bool moe_tile(const int* cnt, int tile, int& cls, int& pos0, int& n) {
    int tb = 0;
    for (int c = 0; c < NCLS; ++c) {
        const int nc = cnt[c * 64], nt = (nc + 127) >> 7;
        if (tile < tb + nt) { cls = c; pos0 = (tile - tb) * 128; n = nc; return true; }
        tb += nt;
    }
    return false;
}
__device__ __forceinline__ void cls_experts(int cls, int& e1, int& e2) {
    const int g = cls / 6, pi = cls % 6;
    const int a = pi < 3 ? 0 : (pi < 5 ? 1 : 2);
    const int b = pi < 3 ? pi + 1 : (pi < 5 ? pi - 1 : 3);
    e1 = g * 4 + a; e2 = g * 4 + b;
}
__device__ __forceinline__ void phase_moe_up(KP p, char* lds, int l) {
    const int* cnt = p->cnt + l * 32 * 64;
    for (int u = BID(); u < (256 + NCLS) * 8; u += gridDim.x) {
        const int xl = u & 7, Lx = u >> 3;
        const int nt = Lx & 7, tile = (Lx >> 3) * 8 + xl;
        int cls, pos0, nc;
        if (!moe_tile(cnt, tile, cls, pos0, nc)) continue;
        int e1, e2; cls_experts(cls, e1, e2);
        const int slot = nt >> 2;
        const half_t* W = p->Wt_gu + ((size_t)(l * 16 + (slot ? e2 : e1)) * 512 + (nt & 3) * 128) * 1024;
        const int* lst = p->lists + (size_t)cls * T_TOK + pos0;
        const int nvalid = nc - pos0;
        gemm_tile(lds, 16,
            [&](int kt, int row) { return W + (size_t)row * 1024 + kt * 64; },
            [&](int row) { const int tok = lst[row < nvalid ? row : 0]; return p->hn + (size_t)tok * DM; },
            [&](f16v (&acc)[2][2], int wn, int wm, int lane) {
                const int hh = lane >> 5;
#pragma unroll
                for (int j = 0; j < 2; ++j) {
                    const int row = wm * 64 + j * 32 + (lane & 31);
                    if (row < nvalid) {
                        const int tok = lst[row];
                        const float wgt = p->tokw[(size_t)tok * 2 + slot];
                        half_t* dst = p->act + (size_t)tok * 512 + slot * 256 + ((nt & 3) * 2 + wn) * 32 + 4 * hh;
#pragma unroll
                        for (int g = 0; g < 4; ++g) {
                            float a[4];
#pragma unroll
                            for (int r = 0; r < 4; ++r) { const float gv = acc[0][j][4 * g + r], uv = acc[1][j][4 * g + r]; a[r] = gv * sigmoidf_(gv) * uv * wgt; }
                            *(h4*)(dst + 8 * g) = pack4(a[0], a[1], a[2], a[3]);
                        }
                    }
                }
            });
    }
}
__device__ __forceinline__ void phase_moe_down(KP p, char* lds, int l, float gsc) {
    const int* cnt = p->cnt + l * 32 * 64;
    const float* g2 = p->modf + (size_t)l * 16 * 6144 + 5 * 1024;
    for (int u = BID(); u < (256 + NCLS) * 8; u += gridDim.x) {
        const int xl = u & 7, Lx = u >> 3;
        const int nt = Lx & 7, tile = (Lx >> 3) * 8 + xl;
        int cls, pos0, nc;
        if (!moe_tile(cnt, tile, cls, pos0, nc)) continue;
        int e1, e2; cls_experts(cls, e1, e2);
        const half_t* W1 = p->Wt_d + ((size_t)(l * 16 + e1) * 1024 + nt * 128) * 256;
        const half_t* W2 = p->Wt_d + ((size_t)(l * 16 + e2) * 1024 + nt * 128) * 256;
        const int* lst = p->lists + (size_t)cls * T_TOK + pos0;
        const int nvalid = nc - pos0;
        gemm_tile(lds, 8,
            [&](int kt, int row) { return (kt < 4 ? W1 : W2) + (size_t)row * 256 + (kt & 3) * 64; },
            [&](int row) { const int tok = lst[row < nvalid ? row : 0]; return p->act + (size_t)tok * 512; },
            [&](f16v (&acc)[2][2], int wn, int wm, int lane) {
                const int hh = lane >> 5;
#pragma unroll
                for (int j = 0; j < 2; ++j) {
                    const int row = wm * 64 + j * 32 + (lane & 31);
                    if (row < nvalid) {
                        const int tok = lst[row];
                        const int b = tok >> 11;
#pragma unroll
                        for (int i = 0; i < 2; ++i) {
                            const int nb = nt * 128 + wn * 64 + i * 32 + 4 * hh;
#pragma unroll
                            for (int g = 0; g < 4; ++g) {
                                const int n = nb + 8 * g;
                                float4* xp = (float4*)(p->out + (size_t)tok * DM + n);
                                float4 xi = *xp;
                                const float4 gg = *(const float4*)(g2 + (size_t)b * 6144 + n);
                                xi.x += gsc * gg.x * acc[i][j][4 * g]; xi.y += gsc * gg.y * acc[i][j][4 * g + 1]; xi.z += gsc * gg.z * acc[i][j][4 * g + 2]; xi.w += gsc * gg.w * acc[i][j][4 * g + 3];
                                *xp = xi;
                            }
                        }
                    }
                }
            });
    }
}

__device__ __forceinline__ void dsa_select_unit(KP p, char* lds, int b, int qt) {
    unsigned* hist = (unsigned*)lds;
    unsigned* maskl = hist + 16 * 257 + 16;
    unsigned* stP = maskl + 1024;
    unsigned* stNeed = stP + 16;
    unsigned* stDone = stNeed + 16;
    unsigned* flag = stDone + 16;
    unsigned* dummyb = flag + 16;
    const int tid = TID(), lane = tid & 63, wave = tid >> 6;
    const int q0 = qt * 16, tokbase = b * SEQ;
    __syncthreads();
    if (q0 < 256) {
        for (int i = tid; i < 1024; i += 256) {
            const int q = i >> 6, wd = i & 63;
            const int n = q0 + q + 1 - 32 * wd;
            const unsigned w = n >= 32 ? 0xFFFFFFFFu : (n <= 0 ? 0u : ((1u << n) - 1u));
            p->dmask[(size_t)(tokbase + q0 + q) * 64 + wd] = w;
        }
        return;
    }
    for (int i = tid; i < 1024; i += 256) maskl[i] = 0u;
    if (tid < 16) { stP[tid] = 0u; stNeed[tid] = 256u; stDone[tid] = 0u; }
    for (int i = tid; i < 16 * 257; i += 256) hist[i] = 0u;
    __syncthreads();
    const int ql = lane & 15, fq = lane >> 4;
    const int tq = q0 + ql;
    const half_t* Pb = p->P + (size_t)tokbase * NP;
    h8 iqf[4];
#pragma unroll
    for (int hd = 0; hd < 4; ++hd) iqf[hd] = *(const h8*)(Pb + (size_t)tq * NP + PC_IQ + hd * 32 + 8 * fq);
    const float4 iw4 = *(const float4*)(p->iwf + (size_t)(tokbase + tq) * 4);
    const float wsc0 = iw4.x * 0.08838834764831845f, wsc1 = iw4.y * 0.08838834764831845f, wsc2 = iw4.z * 0.08838834764831845f, wsc3 = iw4.w * 0.08838834764831845f;
    const int ng = qt + 1;
    unsigned sc[32][4];
    const half_t* ikp = Pb + (size_t)ql * NP + PC_IK + 8 * fq;
#pragma unroll
    for (int gb = 0; gb < 4; ++gb) {
        h8 ik[8];
#pragma unroll
        for (int x = 0; x < 8; ++x) {
            int g = wave + 4 * (gb * 8 + x);
            g = g < ng ? g : ng - 1;
            ik[x] = *(const h8*)(ikp + (size_t)(16 * g) * NP);
        }
#pragma unroll
        for (int x = 0; x < 8; ++x) {
            const int gi = gb * 8 + x;
            const int g = wave + 4 * gi;
            const f4v z = {0.f, 0.f, 0.f, 0.f};
            const f4v c0 = __builtin_amdgcn_mfma_f32_16x16x32_f16(ik[x], iqf[0], z, 0, 0, 0);
            const f4v c1 = __builtin_amdgcn_mfma_f32_16x16x32_f16(ik[x], iqf[1], z, 0, 0, 0);
            const f4v c2 = __builtin_amdgcn_mfma_f32_16x16x32_f16(ik[x], iqf[2], z, 0, 0, 0);
            const f4v c3 = __builtin_amdgcn_mfma_f32_16x16x32_f16(ik[x], iqf[3], z, 0, 0, 0);
#pragma unroll
            for (int r = 0; r < 4; ++r) {
                const int j = 16 * g + 4 * fq + r;
                float sv = wsc0 * __builtin_amdgcn_fmed3f(c0[r], 0.f, INFINITY);
                sv = fmaf(wsc1, __builtin_amdgcn_fmed3f(c1[r], 0.f, INFINITY), sv);
                sv = fmaf(wsc2, __builtin_amdgcn_fmed3f(c2[r], 0.f, INFINITY), sv);
                sv = fmaf(wsc3, __builtin_amdgcn_fmed3f(c3[r], 0.f, INFINITY), sv);
                sv += 0.0f;
                const int sb = __float_as_int(sv);
                const unsigned su = (unsigned)sb ^ ((unsigned)(sb >> 31) | 0x80000000u);
                const unsigned ck = (su & 0xFFFFF800u) | (unsigned)(2047 - j);
                sc[gi][r] = (g < ng && j <= tq) ? ck : 0u;
            }
            if (g < ng) {
#pragma unroll
                for (int r = 0; r < 4; ++r) atomicAdd(hist + ql * 257 + (sc[gi][r] >> 24), 1u);
            }
        }
    }
    bool alldone = false;
    for (int pass = 0; pass < 5; ++pass) {
        const bool fin = alldone;
        if (!fin && pass > 0) { for (int i = tid; i < 16 * 257; i += 256) hist[i] = 0u; }
        if (tid == 0) *flag = 0u;
        __syncthreads();
        if (pass > 0) {
        const unsigned sP = stP[ql], sDone = stDone[ql];
        int wv = wave, fqv = fq;
        asm volatile("" : "+v"(wv), "+v"(fqv));
        if (fin) {
            const int sh = (int)(32u - 8u * (sDone ? sDone : 1u));
            unsigned* mrow = maskl + ql * 64;
#pragma unroll
            for (int gi = 0; gi < 32; ++gi) {
                const int g = wv + 4 * gi;
                unsigned nib = 0u;
#pragma unroll
                for (int r = 0; r < 4; ++r) {
                    const unsigned uu = sc[gi][r];
                    nib |= ((uu >> sh) >= sP) ? (1u << r) : 0u;
                }
                if (g < ng) atomicOr(&mrow[g >> 1], nib << ((g & 1) * 16 + 4 * fqv));
            }
        } else {
            const int shm = pass ? 32 - 8 * pass : 0, shd = 24 - 8 * pass;
            const unsigned orm = pass ? 0u : 0xFFFFFFFFu;
            const unsigned cmpv = pass ? (sDone == 0u ? sP : 0xFFFFFFFFu) : 0xFFFFFFFFu;
            unsigned* hrow = hist + ql * 257;
            unsigned* dummy = dummyb + lane;
#pragma unroll
            for (int gi = 0; gi < 32; ++gi) {
                const int g = wv + 4 * gi;
                if (g < ng) {
#pragma unroll
                    for (int r = 0; r < 4; ++r) {
                        const unsigned uu = sc[gi][r];
                        const bool match = (((uu >> shm) | orm) == cmpv);
                        const unsigned dig = (uu >> shd) & 255u;
                        unsigned* a = match ? hrow + dig : dummy;
                        atomicAdd(a, 1u);
                    }
                }
            }
        }
        }
        __syncthreads();
        if (fin) break;
        {
            const int qq = tid >> 4, seg = tid & 15;
            const bool active = (stDone[qq] == 0u);
            unsigned c16 = 0u;
            if (active) {
#pragma unroll
                for (int d = 0; d < 16; ++d) c16 += hist[qq * 257 + seg * 16 + d];
            }
            unsigned v = c16;
#pragma unroll
            for (int off = 1; off < 16; off <<= 1) { const unsigned t = __shfl_down(v, off, 16); if (seg + off < 16) v += t; }
            const unsigned suf = v - c16;
            const unsigned need = stNeed[qq];
            if (active && suf < need && need <= suf + c16) {
                unsigned run = suf, D = 0u, cD = 0u, nn = need;
                for (int d = 15; d >= 0; --d) {
                    const unsigned cc = hist[qq * 257 + seg * 16 + d];
                    if (run + cc >= need) { D = (unsigned)(seg * 16 + d); cD = cc; nn = need - run; break; }
                    run += cc;
                }
                const bool done = (cD == nn) || pass == 3;
                stP[qq] = (stP[qq] << 8) | D; stNeed[qq] = nn;
                if (done) stDone[qq] = (unsigned)(pass + 1); else atomicAdd(flag, 1u);
            }
        }
        __syncthreads();
        alldone = (*flag == 0u);
    }
    for (int i = tid; i < 1024; i += 256) p->dmask[(size_t)(tokbase + q0 + (i >> 6)) * 64 + (i & 63)] = maskl[i];
}

__device__ __forceinline__ void conv_unit(KP p, char* lds, int l, int b, int c) {
    float* red = (float*)lds;
    const int ch = TID(), lane = ch & 63, wave = ch >> 6;
    const int t0 = c * 32, tokbase = b * SEQ;
    float aw[62];
#pragma unroll
    for (int rr = 0; rr < 62; ++rr) {
        int tt = t0 - 30 + rr; const bool ok = tt >= 0; tt = ok ? tt : t0;
        const float v = (float)p->P[(size_t)(tokbase + tt) * NP + ch];
        aw[rr] = ok ? v : 0.f;
    }
    float w[31];
#pragma unroll
    for (int i = 0; i < 31; ++i) w[i] = p->w_dw[(l * 31 + i) * 256 + ch];
    const float bias = p->b_dw[l * 256 + ch];
    float y[32], s1[32], s2[32];
#pragma unroll
    for (int tk = 0; tk < 32; ++tk) {
        float sacc = bias;
#pragma unroll
        for (int i = 0; i < 31; ++i) sacc = fmaf(aw[tk + i], w[i], sacc);
        y[tk] = sacc; s1[tk] = sacc; s2[tk] = sacc * sacc;
    }
    {
        const bool b5 = lane & 32, b4 = lane & 16, b3 = lane & 8, b2 = lane & 4, b1 = lane & 2;
        float a16[16], c16[16], a8[8], c8[8], a4[4], c4[4], a2[2], c2[2];
#pragma unroll
        for (int e = 0; e < 16; ++e) { a16[e] = (b5 ? s1[e + 16] : s1[e]) + __shfl_xor(b5 ? s1[e] : s1[e + 16], 32); c16[e] = (b5 ? s2[e + 16] : s2[e]) + __shfl_xor(b5 ? s2[e] : s2[e + 16], 32); }
#pragma unroll
        for (int e = 0; e < 8; ++e) { a8[e] = (b4 ? a16[e + 8] : a16[e]) + __shfl_xor(b4 ? a16[e] : a16[e + 8], 16); c8[e] = (b4 ? c16[e + 8] : c16[e]) + __shfl_xor(b4 ? c16[e] : c16[e + 8], 16); }
#pragma unroll
        for (int e = 0; e < 4; ++e) { a4[e] = (b3 ? a8[e + 4] : a8[e]) + __shfl_xor(b3 ? a8[e] : a8[e + 4], 8); c4[e] = (b3 ? c8[e + 4] : c8[e]) + __shfl_xor(b3 ? c8[e] : c8[e + 4], 8); }
#pragma unroll
        for (int e = 0; e < 2; ++e) { a2[e] = (b2 ? a4[e + 2] : a4[e]) + __shfl_xor(b2 ? a4[e] : a4[e + 2], 4); c2[e] = (b2 ? c4[e + 2] : c4[e]) + __shfl_xor(b2 ? c4[e] : c4[e + 2], 4); }
        float av = (b1 ? a2[1] : a2[0]) + __shfl_xor(b1 ? a2[0] : a2[1], 2), cv = (b1 ? c2[1] : c2[0]) + __shfl_xor(b1 ? c2[0] : c2[1], 2);
        av += __shfl_xor(av, 1); cv += __shfl_xor(cv, 1);
        const int tokk = (b5 ? 16 : 0) + (b4 ? 8 : 0) + (b3 ? 4 : 0) + (b2 ? 2 : 0) + (b1 ? 1 : 0);
        __syncthreads();
        if ((lane & 1) == 0) { red[(tokk * 4 + wave) * 2] = av; red[(tokk * 4 + wave) * 2 + 1] = cv; }
        __syncthreads();
    }
    const float lg = p->ln_g[l * 256 + ch], lb = p->ln_b[l * 256 + ch];
#pragma unroll
    for (int tk = 0; tk < 32; ++tk) {
        const float4 ra = *(const float4*)(red + tk * 8), rb = *(const float4*)(red + tk * 8 + 4);
        const float t1 = (ra.x + ra.z) + (rb.x + rb.z);
        const float t2 = (ra.y + ra.w) + (rb.y + rb.w);
        const float mu = t1 * (1.0f / 256.0f);
        float var = t2 * (1.0f / 256.0f) - mu * mu; var = var < 0.f ? 0.f : var;
        float z = (y[tk] - mu) * (1.0f / sqrtf(var + 1e-6f)) * lg + lb;
        z = z * sigmoidf_(z);
        p->ycat[((size_t)(ch >> 5) * T_TOK + tokbase + t0 + tk) * 32 + (ch & 31)] = (half_t)z;
    }
}

__device__ __forceinline__ void kmean_unit(KP p, char* lds, int b, int h, int blk) {
    float* part = (float*)lds;
    const int tid = TID(), d = tid & 63, pt = tid >> 6;
    const half_t* r = p->P + (size_t)(b * SEQ + blk * 256 + pt * 64) * NP + PC_MK + h * 64 + d;
    float s = 0.f;
#pragma unroll 16
    for (int k = 0; k < 64; ++k) s += (float)r[(size_t)k * NP];
    __syncthreads();
    part[pt * 64 + d] = s;
    __syncthreads();
    if (tid < 64) p->kmean[(((size_t)b * 6 + h) * 8 + blk) * 64 + tid] = ((part[tid] + part[64 + tid]) + (part[128 + tid] + part[192 + tid])) * (1.0f / 256.0f);
}

#ifndef POST_MASK
#define POST_MASK 7
#endif
__device__ __forceinline__ void phase_post(KP p, char* lds, int l, int tm) {
    const int NA = 2048, NB = 1024, NC = 768;
    const int G_ = gridDim.x;
    for (int u0 = BID(), k_ = 0; u0 < NA + NB + NC; u0 += G_, ++k_) {
        int u = u0;
        if (u0 < NA && (k_ & 1) && (k_ + 1) * G_ <= NA) u = k_ * G_ + (G_ - 1 - (u0 - k_ * G_));
        if (u < NA) { if (tm & 1) dsa_select_unit(p, lds, u % 16, 127 - (u / 16)); }
        else if (u < NA + NB) { const int v = u - NA; if (tm & 2) conv_unit(p, lds, l, v % 16, v / 16); }
        else { const int v = u - NA - NB; if (tm & 4) kmean_unit(p, lds, v / 48, (v / 8) % 6, v % 8); }
    }
}

template <int MODE>
__device__ __forceinline__ void attn_unit(KP p, char* lds, int b, int h, int qt) {
    const int tid = TID(), lane = tid & 63, wave = tid >> 6, hh = lane >> 5, ql = lane & 31;
    const int q0 = qt * 128, tokbase = b * SEQ;
    const int tq = q0 + wave * 32 + ql;
    const half_t* Pb = p->P + (size_t)tokbase * NP;
    const int QOFF = MODE ? PC_MQ + h * 64 : PC_DQ + h * 64;
    const int KOFF = MODE ? PC_MK + h * 64 : PC_DK;
    const int VOFF = MODE ? PC_MV + h * 64 : PC_DV;
    const int own = qt >> 1;
    unsigned mysel = 0u, anysel = 0u;
    __syncthreads();
    if (MODE == 1) {
        float* km = (float*)(lds + 32768);
        float* gts = km + 512;
        unsigned* selq = (unsigned*)(gts + 1024);
        unsigned* anyb = selq + 128;
        for (int i = tid; i < 512; i += 256) km[i] = p->kmean[((size_t)b * 6 + h) * 512 + i];
        if (tid == 0) *anyb = 0u;
        __syncthreads();
        {
            const int q = tid & 127, hf = tid >> 7;
            if (hf * 4 < own) {
                const half_t* qr = Pb + (size_t)(q0 + q) * NP + QOFF;
                float g0 = 0.f, g1 = 0.f, g2 = 0.f, g3 = 0.f;
#pragma unroll
                for (int c8 = 0; c8 < 8; ++c8) {
                    const h8 qv = *(const h8*)(qr + c8 * 8);
#pragma unroll
                    for (int j4 = 0; j4 < 2; ++j4) {
                        const int d = c8 * 8 + j4 * 4;
                        const float q0f = (float)qv[j4 * 4], q1f = (float)qv[j4 * 4 + 1], q2f = (float)qv[j4 * 4 + 2], q3f = (float)qv[j4 * 4 + 3];
                        const float4 k0 = *(const float4*)(km + (hf * 4 + 0) * 64 + d), k1 = *(const float4*)(km + (hf * 4 + 1) * 64 + d);
                        const float4 k2 = *(const float4*)(km + (hf * 4 + 2) * 64 + d), k3 = *(const float4*)(km + (hf * 4 + 3) * 64 + d);
                        g0 = fmaf(q0f, k0.x, g0); g0 = fmaf(q1f, k0.y, g0); g0 = fmaf(q2f, k0.z, g0); g0 = fmaf(q3f, k0.w, g0);
                        g1 = fmaf(q0f, k1.x, g1); g1 = fmaf(q1f, k1.y, g1); g1 = fmaf(q2f, k1.z, g1); g1 = fmaf(q3f, k1.w, g1);
                        g2 = fmaf(q0f, k2.x, g2); g2 = fmaf(q1f, k2.y, g2); g2 = fmaf(q2f, k2.z, g2); g2 = fmaf(q3f, k2.w, g2);
                        g3 = fmaf(q0f, k3.x, g3); g3 = fmaf(q1f, k3.y, g3); g3 = fmaf(q2f, k3.z, g3); g3 = fmaf(q3f, k3.w, g3);
                    }
                }
                gts[q * 8 + hf * 4 + 0] = g0; gts[q * 8 + hf * 4 + 1] = g1; gts[q * 8 + hf * 4 + 2] = g2; gts[q * 8 + hf * 4 + 3] = g3;
            }
        }
        __syncthreads();
        if (tid < 128) {
            unsigned m = 0u;
            const int want = own < 3 ? own : 3;
            for (int r = 0; r < want; ++r) {
                int best = -1; float bv = -INFINITY;
                for (int j = 0; j < own; ++j) { const float gv = gts[tid * 8 + j]; if (!((m >> j) & 1u) && (best < 0 || gv > bv)) { best = j; bv = gv; } }
                m |= 1u << best;
            }
            selq[tid] = m;
            if (m) atomicOr(anyb, m);
        }
        __syncthreads();
        mysel = selq[wave * 32 + ql];
        anysel = *anyb;
        __syncthreads();
    }
    h8 qf[4];
#pragma unroll
    for (int ks = 0; ks < 4; ++ks) qf[ks] = *(const h8*)(Pb + (size_t)tq * NP + QOFF + 16 * ks + 8 * hh);
    f16v O0, O1;
#pragma unroll
    for (int r = 0; r < 16; ++r) { O0[r] = 0.f; O1[r] = 0.f; }
    float m_run = -1e30f, l_run = 0.f;
    const float CS = 0.18033688011112042f;
    const int ntile = 2 * qt + 2;
    auto skip = [&](int kt) -> bool { return MODE == 1 && kt < 4 * own && !((anysel >> (kt >> 2)) & 1u); };
    auto nexttile = [&](int kt) -> int { ++kt; while (kt < ntile && skip(kt)) ++kt; return kt; };
    const int lrow = tid >> 3;
    const int kchunk = (tid & 7) ^ ((tid >> 4) & 7);
    const int vchunk = (tid & 7) ^ (((tid >> 4) & 1) << 2);
    char* ldst = lds + lrow * 128 + (tid & 7) * 16;
    auto issue = [&](int kt, int s) {
        const half_t* src = Pb + (size_t)(kt * 64 + lrow) * NP;
        char* d = ldst + s * 16384;
        glds16(src + KOFF + kchunk * 8, d);
        glds16(src + (size_t)32 * NP + KOFF + kchunk * 8, d + 4096);
        glds16(src + VOFF + vchunk * 8, d + 8192);
        glds16(src + (size_t)32 * NP + VOFF + vchunk * 8, d + 8192 + 4096);
    };
    const int rsw = (lane >> 1) & 7;
    const int kro = ql * 128;
    const int li = lane & 15, qp = li >> 2, pp = li & 3, swv = (qp >> 1) & 1;
    const int vb0 = 8192 + (4 * hh + qp) * 128 + 32 * ((lane >> 4) & 1) + 8 * pp + 64 * (0 ^ swv);
    const int vb1 = 8192 + (4 * hh + qp) * 128 + 32 * ((lane >> 4) & 1) + 8 * pp + 64 * (1 ^ swv);
    int kt = -1; kt = nexttile(kt);
    int s = 0;
    if (kt < ntile) issue(kt, 0);
    while (kt < ntile) {
        const int ktn = nexttile(kt);
        asm volatile("s_waitcnt vmcnt(0)" ::: "memory");
        __syncthreads();
        if (ktn < ntile) issue(ktn, s ^ 1);
        const bool wave_active = (kt * 64 <= q0 + wave * 32 + 31);
        if (wave_active) {
            const char* base = lds + s * 16384;
            uint2 mw = make_uint2(0u, 0u);
            if (MODE == 0) mw = *(const uint2*)(p->dmask + (size_t)(tokbase + tq) * 64 + 2 * kt);
            h8 vf0[4], vf1[4];
#pragma unroll
            for (int kk = 0; kk < 4; ++kk) {
                const int roff = (32 * (kk >> 1) + 16 * (kk & 1)) * 128;
                const s4v lo0 = __builtin_amdgcn_ds_read_tr16_b64_v4i16((LAS s4v*)(base + vb0 + roff));
                const s4v hi0 = __builtin_amdgcn_ds_read_tr16_b64_v4i16((LAS s4v*)(base + vb0 + roff + 8 * 128));
                const s4v lo1 = __builtin_amdgcn_ds_read_tr16_b64_v4i16((LAS s4v*)(base + vb1 + roff));
                const s4v hi1 = __builtin_amdgcn_ds_read_tr16_b64_v4i16((LAS s4v*)(base + vb1 + roff + 8 * 128));
                vf0[kk] = __builtin_bit_cast(h8, __builtin_shufflevector(lo0, hi0, 0, 1, 2, 3, 4, 5, 6, 7));
                vf1[kk] = __builtin_bit_cast(h8, __builtin_shufflevector(lo1, hi1, 0, 1, 2, 3, 4, 5, 6, 7));
            }
            f16v s0, s1;
#pragma unroll
            for (int r = 0; r < 16; ++r) { s0[r] = 0.f; s1[r] = 0.f; }
#pragma unroll
            for (int ks = 0; ks < 4; ++ks) {
                const int co = ((2 * ks + hh) ^ rsw) << 4;
                const h8 k0 = *(const h8*)(base + kro + co), k1 = *(const h8*)(base + kro + 4096 + co);
                s0 = __builtin_amdgcn_mfma_f32_32x32x16_f16(k0, qf[ks], s0, 0, 0, 0);
                s1 = __builtin_amdgcn_mfma_f32_32x32x16_f16(k1, qf[ks], s1, 0, 0, 0);
            }
            bool lane_on = true;
            if (MODE == 0) {
                const unsigned w0 = mw.x >> (4 * hh), w1 = mw.y >> (4 * hh);
#pragma unroll
                for (int r = 0; r < 16; ++r) {
                    const int pos = (r & 3) + 8 * (r >> 2);
                    const unsigned m0 = (unsigned)__builtin_amdgcn_sbfe((int)w0, pos, 1), m1 = (unsigned)__builtin_amdgcn_sbfe((int)w1, pos, 1);
                    s0[r] = __uint_as_float((__float_as_uint(s0[r]) & m0) | (0xFF800000u & ~m0));
                    s1[r] = __uint_as_float((__float_as_uint(s1[r]) & m1) | (0xFF800000u & ~m1));
                }
            } else {
                if (kt < 4 * own) {
                    lane_on = (mysel >> (kt >> 2)) & 1u;
                } else if (kt * 64 + 63 > q0 + wave * 32) {
#pragma unroll
                    for (int r = 0; r < 16; ++r) {
                        const int key = kt * 64 + (r & 3) + 8 * (r >> 2) + 4 * hh;
                        s0[r] = (key <= tq) ? s0[r] : -INFINITY;
                        s1[r] = (key + 32 <= tq) ? s1[r] : -INFINITY;
                    }
                }
            }
            float mx = s0[0];
#pragma unroll
            for (int r = 1; r < 16; ++r) mx = fmaxf(mx, s0[r]);
#pragma unroll
            for (int r = 0; r < 16; ++r) mx = fmaxf(mx, s1[r]);
            mx = lane_on ? mx : -INFINITY;
            mx = fmaxf(mx, __shfl_xor(mx, 32));
            const float mnew = fmaxf(m_run, mx);
            const float alpha = __builtin_amdgcn_exp2f((m_run - mnew) * CS);
            const float mc = lane_on ? mnew * CS : INFINITY;
            m_run = mnew;
            float ls = 0.f;
#pragma unroll
            for (int r = 0; r < 16; ++r) { s0[r] = __builtin_amdgcn_exp2f(fmaf(s0[r], CS, -mc)); ls += s0[r]; }
#pragma unroll
            for (int r = 0; r < 16; ++r) { s1[r] = __builtin_amdgcn_exp2f(fmaf(s1[r], CS, -mc)); ls += s1[r]; }
            l_run = l_run * alpha + ls;
            if (!__all(alpha == 1.0f)) {
#pragma unroll
                for (int r = 0; r < 16; ++r) { O0[r] *= alpha; O1[r] *= alpha; }
            }
#pragma unroll
            for (int kk = 0; kk < 4; ++kk) {
                h8 pf;
#pragma unroll
                for (int j = 0; j < 8; ++j) pf[j] = (half_t)((kk >> 1) ? s1[8 * (kk & 1) + j] : s0[8 * (kk & 1) + j]);
                O0 = __builtin_amdgcn_mfma_f32_32x32x16_f16(vf0[kk], pf, O0, 0, 0, 0);
                O1 = __builtin_amdgcn_mfma_f32_32x32x16_f16(vf1[kk], pf, O1, 0, 0, 0);
            }
        }
        kt = ktn; s ^= 1;
    }
    const float lt = l_run + __shfl_xor(l_run, 32);
    const float inv = 1.0f / lt;
    const int ycol = (MODE ? 640 : 256) + h * 64;
    half_t* dst = p->ycat + ((size_t)(ycol >> 5) * T_TOK + tokbase + tq) * 32 + 4 * hh;
#pragma unroll
    for (int g = 0; g < 4; ++g) {
        *(h4*)(dst + 8 * g) = pack4(O0[4 * g] * inv, O0[4 * g + 1] * inv, O0[4 * g + 2] * inv, O0[4 * g + 3] * inv);
        *(h4*)(dst + (size_t)T_TOK * 32 + 8 * g) = pack4(O1[4 * g] * inv, O1[4 * g + 1] * inv, O1[4 * g + 2] * inv, O1[4 * g + 3] * inv);
    }
}

#ifndef ATT_MASK
#define ATT_MASK 3
#endif
__device__ __forceinline__ void phase_attn(KP p, char* lds, int tm) {
    const int G_ = gridDim.x, per_ = G_ >> 3;
    const bool snake_ = (G_ >= 8) && ((G_ & 7) == 0);
    for (int k_ = 0, b_ = BID(); snake_ ? (k_ * per_ < 384) : (b_ + k_ * G_ < 3072); ++k_) {
        int xl, Lx;
        if (snake_) { const int idx_ = b_ >> 3; xl = b_ & 7; Lx = k_ * per_ + ((k_ & 1) ? (per_ - 1 - idx_) : idx_); }
        else { const int u = b_ + k_ * G_; xl = u & 7; Lx = u >> 3; }
        if (Lx >= 384) continue;
        const int qt = 15 - (Lx / 24), rem = Lx % 24;
        const int type = rem & 1, bh = xl * 12 + (rem >> 1);
        if (type == 0) { if (tm & 1) attn_unit<0>(p, lds, bh / 6, bh % 6, qt); }
        else { if (tm & 2) attn_unit<1>(p, lds, bh / 6, bh % 6, qt); }
    }
}

__global__ void __launch_bounds__(256, 2) mk_fwd(Params p_unused) {
    extern __shared__ __attribute__((aligned(16))) char lds[];
    volatile LAS unsigned* stw = (volatile LAS unsigned*)(lds + LDS_CTL);
    if (threadIdx.x < 4) stw[threadIdx.x] = 0u;
    __syncthreads();
    KP p0 = (KP)__builtin_amdgcn_kernarg_segment_ptr();
    XcdBarrier bar; bar.bar = p0->bar; bar.x = 0; bar.st = stw;
#if !MK_SPLIT
    bar = xcd_barrier_post(p0->bar, stw);
#endif
    const int ph_lo = p0->ph_lo, ph_hi = p0->ph_hi;
    for (int ph = ph_lo; ph < ph_hi; ++ph) {
      KP p = p0; asm volatile("" : "+s"(p));
      const int nrep = (DUP_SUB >= 0 && ((DUP_SUB == 100 && ph == 0) || (ph >= 2 && ph < NPHASE - 1 && ((ph - 2) & 7) == DUP_SUB && (DUP_SUB != 4 || ph < 10)))) ? 2 : 1;
      for (int rep = 0; rep < nrep; ++rep) {
        if (ph == 0) phase_prologue(p, lds);
        else if (ph == 1) phase_modsum(p);
        else if (ph == NPHASE - 1) phase_norm<2>(p, lds, p->out, p->g_final, nullptr, nullptr, 0);
        else {
            const int l = (ph - 2) >> 3, sub = (ph - 2) & 7;
            const float* mf = p->modf + (size_t)l * 16 * 6144;
            const float* xin = l == 0 ? p->x : p->out;
            if (sub == 0) phase_norm<0>(p, lds, xin, p->g_mix + l * DM, mf, mf + 1024, l);
            else if (sub == 1) phase_inproj(p, lds, l);
            else if (sub == 2) phase_post(p, lds, l, rep ? POST_MASK : 7);
            else if (sub == 3) phase_attn(p, lds, rep ? ATT_MASK : 3);
            else if (sub == 4) phase_outproj(p, lds, l, xin);
            else if (sub == 5) phase_norm<1>(p, lds, p->out, p->g_ffn + l * DM, mf + 3 * 1024, mf + 4 * 1024, (nrep == 2 && rep == 0) ? l + 2 : l);
            else if (sub == 6) phase_moe_up(p, lds, l);
            else phase_moe_down(p, lds, l, nrep == 2 ? 0.5f : 1.0f);
        }
      }
#if !MK_SPLIT
        if (ph + 1 < ph_hi) xcd_barrier(bar);
#endif
    }
}

extern "C" void kernel_launch(void* const* d_in, const int* in_sizes, int n_in, void* d_out, int out_size, void* d_ws, size_t ws_size, hipStream_t stream) {
    static int grid = 0;
    if (grid == 0) {
        int dev = 0, cus = 0, per_cu = 0;
        (void)hipGetDevice(&dev);
        (void)hipDeviceGetAttribute(&cus, hipDeviceAttributeMultiprocessorCount, dev);
        (void)hipFuncSetAttribute((const void*)mk_fwd, hipFuncAttributeMaxDynamicSharedMemorySize, LDS_BYTES);
        if (hipOccupancyMaxActiveBlocksPerMultiprocessor(&per_cu, (const void*)mk_fwd, 256, LDS_BYTES) != hipSuccess || per_cu < 1) per_cu = 1;
        (void)hipGetLastError();
        if (per_cu > 2) per_cu = 2;
        grid = cus * per_cu;
        fprintf(stderr, "mk_fwd: cus %d per_cu %d grid %d\n", cus, per_cu, grid);
    }
    Params p{};
    const float** pin = (const float**)&p.x;
    for (int i = 0; i < 18; ++i) pin[i] = (const float*)d_in[i];
    p.out = (float*)d_out;
    char* ws = (char*)d_ws;
    size_t off = 0;
    auto carve = [&](size_t bytes) { void* q = ws + off; off += (bytes + 255) & ~(size_t)255; return q; };
    p.bar = (unsigned*)carve(XCD_BAR_WORDS * 4);
    p.cnt = (int*)carve(4 * 32 * 64 * 4);
    const size_t zero_bytes = off;
    p.Wt_in = (half_t*)carve((size_t)2 * NP * DM * 2);
    p.Wt_o = (half_t*)carve((size_t)2 * DM * DM * 2);
    p.Wt_gu = (half_t*)carve((size_t)2 * 16 * 512 * 1024 * 2);
    p.Wt_d = (half_t*)carve((size_t)2 * 16 * 1024 * 256 * 2);
    p.hn = (half_t*)carve((size_t)T_TOK * DM * 2);
    p.P = (half_t*)carve((size_t)T_TOK * NP * 2);
    p.ycat = (half_t*)carve((size_t)T_TOK * DM * 2);
    p.act = (half_t*)carve((size_t)T_TOK * 512 * 2);
    p.modpart = (float*)carve((size_t)8 * 2 * 16 * 6144 * 4);
    p.modf = (float*)carve((size_t)2 * 16 * 6144 * 4);
    p.kmean = (float*)carve((size_t)16 * 6 * 8 * 64 * 4);
    p.rope = (float*)carve((size_t)2048 * 24 * 4);
    p.iwf = (float*)carve((size_t)T_TOK * 4 * 4);
    p.tokw = (float*)carve((size_t)T_TOK * 2 * 4);
    p.dmask = (unsigned*)carve((size_t)T_TOK * 64 * 4);
    p.lists = (int*)carve((size_t)NCLS * T_TOK * 4);
    if (off > ws_size) { fprintf(stderr, "workspace too small: need %zu have %zu\n", off, ws_size); return; }
    (void)hipMemsetAsync(d_ws, 0, zero_bytes, stream);
#if MK_SPLIT
    for (int ph = 0; ph < NPHASE; ++ph) {
        p.ph_lo = ph; p.ph_hi = ph + 1;
        hipLaunchKernelGGL(mk_fwd, dim3(grid), dim3(256), LDS_BYTES, stream, p);
    }
#else
    p.ph_lo = 0; p.ph_hi = NPHASE;
    hipLaunchKernelGGL(mk_fwd, dim3(grid), dim3(256), LDS_BYTES, stream, p);
#endif
}
```

```cpp
#include <hip/hip_runtime.h>
#include <cstdio>
#include <cstdint>

#ifndef MK_SPLIT
#define MK_SPLIT 0
#endif

#define T_TOK 32768
#define DM 1024
#define SEQ 2048
#define INW 2340
#define NP 2432
#define PC_CU 0
#define PC_CG 256
#define PC_DQ 512
#define PC_DK 896
#define PC_DV 960
#define PC_IQ 1024
#define PC_IK 1152
#define PC_IW 1184
#define PC_MQ 1280
#define PC_MK 1664
#define PC_MV 2048
#define LOG_THETA 13.122363377404328f
#define NCLS 24
#define LDS_CTL 73728
#define LDS_BYTES 78336
#define NPHASE 19
#ifndef DUP_SUB
#define DUP_SUB -1
#endif

typedef _Float16 half_t;
typedef _Float16 h8 __attribute__((ext_vector_type(8)));
typedef _Float16 h4 __attribute__((ext_vector_type(4)));
typedef short s4v __attribute__((ext_vector_type(4)));
typedef short s8v __attribute__((ext_vector_type(8)));
typedef float f16v __attribute__((ext_vector_type(16)));
typedef float f4v __attribute__((ext_vector_type(4)));
#define LAS __attribute__((address_space(3)))

struct Params {
    const float *x, *c, *w_ada, *b_ada, *g_mix, *w_in, *w_dw, *b_dw, *ln_g, *ln_b, *w_o, *g_ffn, *w_router, *b_router, *w_gate, *w_up, *w_down, *g_final;
    float* out;
    half_t *Wt_in, *Wt_o, *Wt_gu, *Wt_d, *hn, *P, *ycat, *act;
    float *modpart, *modf, *kmean, *rope, *iwf, *tokw;
    unsigned* dmask; int* cnt; int* lists; unsigned* bar;
    int ph_lo, ph_hi;
};

#define XB_TMO      128
#define XB_XCNT(j)  (256  + 64 * (j))
#define XB_XSUB(j)  (1280 + 64 * (j))
#define XB_XGEN(j)  (2304 + 64 * (j))
#define XB_TOP      3328
#define XB_TOPGEN   3392
#define XCD_BAR_WORDS 3456
#define XB_SPIN_CAP (1u << 20)
__device__ __forceinline__ unsigned xb_ld(unsigned* p)              { return __hip_atomic_load(p, __ATOMIC_RELAXED, __HIP_MEMORY_SCOPE_AGENT); }
__device__ __forceinline__ unsigned xb_add(unsigned* p, unsigned v) { return __hip_atomic_fetch_add(p, v, __ATOMIC_RELAXED, __HIP_MEMORY_SCOPE_AGENT); }
__device__ __forceinline__ unsigned xb_xcc_id() { return (unsigned)__builtin_amdgcn_s_getreg((3 << 11) | 20) & 0xFu; }
#define XB_SPIN(cond, bar) do { unsigned _sp = 0; while (cond) { __builtin_amdgcn_s_sleep(1); \
    if ((++_sp & 255u) == 0u) { if (xb_ld(&(bar)[XB_TMO])) break; if (_sp > XB_SPIN_CAP) { atomicAdd(&(bar)[XB_TMO], 1u); break; } } } } while (0)
struct XcdBarrier { unsigned* bar; unsigned x; volatile LAS unsigned* st; };
__device__ __forceinline__ XcdBarrier xcd_barrier_post(unsigned* bar, volatile LAS unsigned* st) {
    XcdBarrier b; b.bar = bar; b.x = xb_xcc_id(); b.st = st;
    if (threadIdx.x == 0) (void)xb_add(&bar[XB_XCNT(b.x)], 1u);
    return b;
}
__device__ __forceinline__ void xcd_barrier_complete(unsigned* bar, unsigned x, unsigned& nloc, unsigned& nx) {
    const unsigned G = gridDim.x * gridDim.y * gridDim.z;
    unsigned sum, cnt, mine, sp = 0u;
    for (;;) {
        sum = 0u; cnt = 0u; mine = 0u;
#pragma unroll
        for (unsigned j = 0; j < 16; ++j) { const unsigned c = xb_ld(&bar[XB_XCNT(j)]); sum += c; cnt += (c > 0u) ? 1u : 0u; mine = (j == x) ? c : mine; }
        if (sum == G) break;
        __builtin_amdgcn_s_sleep(1);
        if ((++sp & 255u) == 0u) { if (xb_ld(&bar[XB_TMO])) break; if (sp > XB_SPIN_CAP) { atomicAdd(&bar[XB_TMO], 1u); break; } }
    }
    nloc = mine > 0u ? mine : 1u; nx = cnt > 0u ? cnt : 1u;
}
__device__ __forceinline__ void xcd_barrier(const XcdBarrier& b) {
    asm volatile("s_waitcnt vmcnt(0)" ::: "memory");
    __syncthreads();
    if (threadIdx.x == 0) {
        unsigned* bar = b.bar;
        __builtin_amdgcn_s_waitcnt(0);
        unsigned nloc = b.st[0], nx = b.st[1];
        if (nloc == 0u) { xcd_barrier_complete(bar, b.x, nloc, nx); b.st[0] = nloc; b.st[1] = nx; }
        const unsigned old = xb_add(&bar[XB_XSUB(b.x)], 1u);
        const unsigned gen = old / nloc;
        if (old + 1u == (gen + 1u) * nloc) {
            __builtin_amdgcn_fence(__ATOMIC_RELEASE, "agent");
            asm volatile("s_waitcnt vmcnt(0)" ::: "memory");
            const unsigned og = xb_add(&bar[XB_TOP], 1u);
            const unsigned tg = og / nx;
            if (og + 1u == (tg + 1u) * nx) xb_add(&bar[XB_TOPGEN], 1u);
            else XB_SPIN(xb_ld(&bar[XB_TOPGEN]) == tg, bar);
            __builtin_amdgcn_fence(__ATOMIC_ACQUIRE, "agent");
            xb_add(&bar[XB_XGEN(b.x)], 1u);
            asm volatile("s_waitcnt vmcnt(0)" ::: "memory");
        } else {
            XB_SPIN(xb_ld(&bar[XB_XGEN(b.x)]) == gen, bar);
            __builtin_amdgcn_fence(__ATOMIC_ACQUIRE, "agent");
            asm volatile("s_waitcnt vmcnt(0)" ::: "memory");
        }
    }
    __syncthreads();
}

typedef const __attribute__((address_space(4))) Params* KP;
__device__ __forceinline__ int TID() { int t = threadIdx.x; asm volatile("" : "+v"(t)); return t; }
__device__ __forceinline__ int BID() { int b = blockIdx.x; asm volatile("" : "+s"(b)); return b; }
__device__ __forceinline__ float sigmoidf_(float v) { return __builtin_amdgcn_rcpf(1.0f + __expf(-v)); }
__device__ __forceinline__ void glds16(const void* g, char* l) { __builtin_amdgcn_global_load_lds((const unsigned*)g, (unsigned*)l, 16, 0, 0); }
__device__ __forceinline__ unsigned f2sortable(float f) { unsigned u = __float_as_uint(f); return (u & 0x80000000u) ? ~u : (u | 0x80000000u); }
__device__ __forceinline__ h4 pack4(float a, float b, float c, float d) { h4 r = {(half_t)a, (half_t)b, (half_t)c, (half_t)d}; return r; }

template <class CF>
__device__ __forceinline__ void conv_tile_panel(char* lds, CF colf, int src_ld, int k0, int n0, half_t* dst, int nrows) {
    float* tl = (float*)lds;
    const int tid = TID();
    __syncthreads();
    {
        const int nn = tid & 63;
        const float* cp = colf(nn);
        float tv[16];
#pragma unroll
        for (int i = 0; i < 16; ++i) { const int k = i * 4 + (tid >> 6); tv[i] = cp ? cp[(size_t)(k0 + k) * src_ld] : 0.f; }
#pragma unroll
        for (int i = 0; i < 16; ++i) { const int k = i * 4 + (tid >> 6); tl[k * 65 + nn] = tv[i]; }
    }
    __syncthreads();
    {
        const int n = tid >> 2, kq = (tid & 3) * 16;
        h8 a, b;
#pragma unroll
        for (int j = 0; j < 8; ++j) { a[j] = (half_t)tl[(kq + j) * 65 + n]; b[j] = (half_t)tl[(kq + 8 + j) * 65 + n]; }
        const int k = k0 + kq;
        h8* d = (h8*)(dst + ((size_t)(k >> 5) * nrows + n0 + n) * 32 + (k & 31));
        d[0] = a; d[1] = b;
    }
}
template <class CF>
__device__ __forceinline__ void conv_tile(char* lds, CF colf, int src_ld, int k0, half_t* dst_tile  , int dstK) {
    float* tl = (float*)lds;
    const int tid = TID();
    __syncthreads();
    {
        const int nn = tid & 63;
        const float* cp = colf(nn);
        float tv[16];
#pragma unroll
        for (int i = 0; i < 16; ++i) { const int k = i * 4 + (tid >> 6); tv[i] = cp ? cp[(size_t)(k0 + k) * src_ld] : 0.f; }
#pragma unroll
        for (int i = 0; i < 16; ++i) { const int k = i * 4 + (tid >> 6); tl[k * 65 + nn] = tv[i]; }
    }
    __syncthreads();
    {
        const int n = tid >> 2, kq = (tid & 3) * 16;
        h8 a, b;
#pragma unroll
        for (int j = 0; j < 8; ++j) { a[j] = (half_t)tl[(kq + j) * 65 + n]; b[j] = (half_t)tl[(kq + 8 + j) * 65 + n]; }
        h8* d = (h8*)(dst_tile + (size_t)n * dstK + kq);
        d[0] = a; d[1] = b;
    }
}

__device__ __forceinline__ void phase_prologue(KP p, char* lds) {
    const int tid = TID();
    const int NA = 2 * 16 * 38, NB = 2 * 16 * 16, NC = 2 * 16 * 16 * 8, ND = 2 * 16 * 4 * 16, NE = 384, NF = 8;
    const int total = NA + NB + NC + ND + NE + NF;
    for (int u0 = BID(); u0 < total; u0 += gridDim.x) {
        int u = u0;
        if (u < NA) {
            const int nt = u % 38, kt = (u / 38) % 16, l = u / (38 * 16);
            const float* src = p->w_in + (size_t)l * DM * INW;
            const int n0 = nt * 64;
            conv_tile_panel(lds, [&](int nn) -> const float* { const int np = n0 + nn; const int sc = np < 512 ? (((np & 63) < 32) ? 32 * (np >> 6) + (np & 31) : 256 + 32 * (np >> 6) + (np & 31)) : (np < 1188 ? np : (np < 1280 ? -1 : np - 92)); return sc >= 0 ? src + sc : (const float*)nullptr; },
                      INW, kt * 64, n0, p->Wt_in + (size_t)l * NP * DM, NP);
            continue;
        }
        u -= NA;
        if (u < NB) {
            const int nt = u % 16, kt = (u / 16) % 16, l = u / 256;
            const float* src = p->w_o + (size_t)l * DM * DM + nt * 64;
            conv_tile_panel(lds, [&](int nn) -> const float* { return src + nn; }, DM, kt * 64, nt * 64, p->Wt_o + (size_t)l * DM * DM, DM);
            continue;
        }
        u -= NB;
        if (u < NC) {
            const int nt = u % 8, kt = (u / 8) % 16, le = u / 128;
            const float* sg = p->w_gate + (size_t)le * 1024 * 256 + nt * 32;
            const float* su = p->w_up + (size_t)le * 1024 * 256 + nt * 32;
            conv_tile(lds, [&](int nn) -> const float* { return nn < 32 ? sg + nn : su + (nn - 32); }, 256, kt * 64, p->Wt_gu + ((size_t)le * 512 + nt * 64) * 1024 + kt * 64, 1024);
            continue;
        }
        u -= NC;
        if (u < ND) {
            const int nt = u % 16, kt = (u / 16) % 4, le = u / 64;
            const float* src = p->w_down + (size_t)le * 256 * 1024 + nt * 64;
            conv_tile(lds, [&](int nn) -> const float* { return src + nn; }, 1024, kt * 64, p->Wt_d + ((size_t)le * 1024 + nt * 64) * 256 + kt * 64, 256);
            continue;
        }
        u -= ND;
        if (u < NE) {
            const int kc = u % 8, cc = (u / 8) % 24, l = u / 192;
            float* ca = (float*)lds;
            __syncthreads();
            for (int i = tid; i < 2048; i += 256) { const int b = i >> 7, k = i & 127; const float v = p->c[b * 1024 + kc * 128 + k]; ca[i] = v / (1.0f + expf(-v)); }
            __syncthreads();
            const int n = cc * 256 + tid;
            float acc[16];
#pragma unroll
            for (int b = 0; b < 16; ++b) acc[b] = 0.f;
            const float* w = p->w_ada + ((size_t)l * 1024 + kc * 128) * 6144 + n;
#pragma unroll 16
            for (int k = 0; k < 128; ++k) {
                const float wv = w[(size_t)k * 6144];
#pragma unroll
                for (int b = 0; b < 16; ++b) acc[b] = fmaf(ca[b * 128 + k], wv, acc[b]);
            }
#pragma unroll
            for (int b = 0; b < 16; ++b) p->modpart[(((size_t)kc * 2 + l) * 16 + b) * 6144 + n] = acc[b];
            continue;
        }
        u -= NE;
        {
            for (int i = u * 256 + tid; i < 2048 * 12; i += NF * 256) {
                const int t = i / 12, r = i % 12;
                const int fi = r < 8 ? r : r - 8;
                const float rot = r < 8 ? 16.f : 8.f;
                const float inv = expf(-LOG_THETA * ((float)fi * 2.0f / rot));
                const float ang = (float)t * inv;
                float sn, cs; sincosf(ang, &sn, &cs);
                if (r < 8) { p->rope[t * 8 + fi] = cs; p->rope[16384 + t * 8 + fi] = sn; }
                else { p->rope[32768 + t * 4 + fi] = cs; p->rope[32768 + 8192 + t * 4 + fi] = sn; }
            }
        }
    }
}

__device__ __forceinline__ void phase_modsum(KP p) {
    for (int i = BID() * 256 + TID(); i < 2 * 16 * 6144; i += gridDim.x * 256) {
        const int n = i % 6144, l = i / (16 * 6144);
        float s = p->b_ada[l * 6144 + n];
#pragma unroll
        for (int kc = 0; kc < 8; ++kc) s += p->modpart[(size_t)kc * (2 * 16 * 6144) + i];
        p->modf[i] = s;
    }
}

__device__ __forceinline__ void route_flush(KP p, char* lds, int lane, int wave, int n, int myrow, int layer) {
    const float* lg = (const float*)(lds + LDS_CTL + 512) + wave * 256;
    int* lc = (int*)(lds + LDS_CTL + 64);
    int* lbase = lc + 32;
    const int tid = wave * 64 + lane;
    if (tid < 32) lc[tid] = 0;
    __syncthreads();
    int cls = 0, lpos = 0;
    if (lane < n) {
        float aff[16], bia[16];
#pragma unroll
        for (int e = 0; e < 16; ++e) { aff[e] = 1.0f / (1.0f + expf(-lg[lane * 16 + e])); bia[e] = aff[e] + p->b_router[e]; }
        int bestg = 0; float bests = -INFINITY;
#pragma unroll
        for (int gi = 0; gi < 4; ++gi) {
            float m1 = -INFINITY, m2 = -INFINITY;
#pragma unroll
            for (int j = 0; j < 4; ++j) { const float vv = bia[gi * 4 + j]; if (vv > m1) { m2 = m1; m1 = vv; } else if (vv > m2) m2 = vv; }
            const float s = m1 + m2;
            if (s > bests) { bests = s; bestg = gi; }
        }
        float bsel[4], asel[4];
#pragma unroll
        for (int j = 0; j < 4; ++j) { bsel[j] = 0.f; asel[j] = 0.f; }
#pragma unroll
        for (int gi = 0; gi < 4; ++gi) if (gi == bestg) {
#pragma unroll
            for (int j = 0; j < 4; ++j) { bsel[j] = bia[gi * 4 + j]; asel[j] = aff[gi * 4 + j]; }
        }
        int i1 = -1, i2 = -1; float v1 = -INFINITY, v2 = -INFINITY;
#pragma unroll
        for (int j = 0; j < 4; ++j) { const float vv = bsel[j]; if (vv > v1) { v2 = v1; i2 = i1; v1 = vv; i1 = j; } else if (vv > v2) { v2 = vv; i2 = j; } }
        const int a = i1 < i2 ? i1 : i2, bb = i1 < i2 ? i2 : i1;
        float wa = 0.f, wb = 0.f;
#pragma unroll
        for (int j = 0; j < 4; ++j) { if (j == a) wa = asel[j]; if (j == bb) wb = asel[j]; }
        const float sw = wa + wb;
        const int pi = (a == 0) ? (bb - 1) : (a == 1 ? (bb + 1) : 5);
        cls = bestg * 6 + pi;
        *(float2*)(p->tokw + (size_t)myrow * 2) = make_float2(wa / sw, wb / sw);
        lpos = atomicAdd(&lc[cls], 1);
    }
    __syncthreads();
    if (tid < NCLS) { const int c = lc[tid]; lbase[tid] = c ? atomicAdd(&p->cnt[(layer * 32 + tid) * 64], c) : 0; }
    __syncthreads();
    if (lane < n) p->lists[(size_t)cls * T_TOK + lbase[cls] + lpos] = myrow;
}

template <int MODE>
__device__ __forceinline__ void phase_norm(KP p, char* lds, const float* xin, const float* g, const float* sh, const float* sc, int layer) {
    const int lane = TID() & 63, wave = TID() >> 6;
    float* wt = (float*)lds;
    if (MODE == 1) {
        __syncthreads();
        for (int i = TID(); i < 4096; i += 256) {
            const float4 w4 = ((const float4*)p->w_router)[i];
            const int k = i >> 2, e0 = (i & 3) * 4;
            wt[(e0 + 0) * 1024 + k] = w4.x; wt[(e0 + 1) * 1024 + k] = w4.y; wt[(e0 + 2) * 1024 + k] = w4.z; wt[(e0 + 3) * 1024 + k] = w4.w;
        }
        __syncthreads();
    }
    float* lgb = (float*)(lds + LDS_CTL + 512);
    int myrow = 0, it = 0;
    float4 vn[4];
    {
        const int row0 = BID() * 4 + wave;
        const float4* xr = (const float4*)(xin + (size_t)(row0 < T_TOK ? row0 : 0) * DM);
#pragma unroll
        for (int i = 0; i < 4; ++i) vn[i] = xr[lane + 64 * i];
    }
    for (int row = BID() * 4 + wave; row < T_TOK; row += gridDim.x * 4) {
        const int b = row >> 11;
        float4 v[4]; float ss = 0.f;
#pragma unroll
        for (int i = 0; i < 4; ++i) v[i] = vn[i];
        {
            const int rown = row + gridDim.x * 4;
            const float4* xr = (const float4*)(xin + (size_t)(rown < T_TOK ? rown : row) * DM);
#pragma unroll
            for (int i = 0; i < 4; ++i) vn[i] = xr[lane + 64 * i];
        }
#pragma unroll
        for (int i = 0; i < 4; ++i) ss += v[i].x * v[i].x + v[i].y * v[i].y + v[i].z * v[i].z + v[i].w * v[i].w;
#pragma unroll
        for (int o = 32; o >= 1; o >>= 1) ss += __shfl_xor(ss, o);
        const float rstd = 1.0f / sqrtf(ss * (1.0f / 1024.0f) + 1e-6f);
        float acc[16], ya[16];
#pragma unroll
        for (int i = 0; i < 4; ++i) {
            const int k = (lane + 64 * i) * 4;
            const float4 gg = *(const float4*)(g + k);
            float y[4] = {v[i].x * rstd * gg.x, v[i].y * rstd * gg.y, v[i].z * rstd * gg.z, v[i].w * rstd * gg.w};
            if (MODE != 2) {
                const float4 s1 = *(const float4*)(sh + (size_t)b * 6144 + k), s2 = *(const float4*)(sc + (size_t)b * 6144 + k);
                y[0] = y[0] * (1.f + s2.x) + s1.x; y[1] = y[1] * (1.f + s2.y) + s1.y; y[2] = y[2] * (1.f + s2.z) + s1.z; y[3] = y[3] * (1.f + s2.w) + s1.w;
                if (MODE == 0) *(h4*)(p->hn + ((size_t)(k >> 5) * T_TOK + row) * 32 + (k & 31)) = pack4(y[0], y[1], y[2], y[3]);
                else *(h4*)(p->hn + (size_t)row * DM + k) = pack4(y[0], y[1], y[2], y[3]);
            } else {
                *(float4*)(p->out + (size_t)row * DM + k) = make_float4(y[0], y[1], y[2], y[3]);
            }
            ya[4 * i] = y[0]; ya[4 * i + 1] = y[1]; ya[4 * i + 2] = y[2]; ya[4 * i + 3] = y[3];
        }
        if (MODE == 1) {
#pragma unroll
            for (int e = 0; e < 16; ++e) acc[e] = 0.f;
            float4 wq[2][4];
            const float* wl = wt + lane * 4;
#pragma unroll
            for (int e = 0; e < 4; ++e) wq[0][e] = *(const float4*)(wl + e * 1024);
#pragma unroll
            for (int st = 0; st < 16; ++st) {
                const int i = st >> 2, eg = st & 3, cur = st & 1;
                if (st + 1 < 16) {
                    const int i2 = (st + 1) >> 2, eg2 = (st + 1) & 3;
#pragma unroll
                    for (int e = 0; e < 4; ++e) wq[cur ^ 1][e] = *(const float4*)(wl + (eg2 * 4 + e) * 1024 + i2 * 256);
                }
#pragma unroll
                for (int e = 0; e < 4; ++e) {
                    const float4 w4 = wq[cur][e];
                    acc[eg * 4 + e] = fmaf(ya[4 * i], w4.x, fmaf(ya[4 * i + 1], w4.y, fmaf(ya[4 * i + 2], w4.z, fmaf(ya[4 * i + 3], w4.w, acc[eg * 4 + e]))));
                }
                __builtin_amdgcn_sched_barrier(0);
            }
        }
        if (MODE == 1) {
            const bool b5 = lane & 32, b4 = lane & 16, b3 = lane & 8, b2 = lane & 4;
            float r8[8], r4[4], r2[2];
#pragma unroll
            for (int e = 0; e < 8; ++e) { const float snd = b5 ? acc[e] : acc[e + 8], kp = b5 ? acc[e + 8] : acc[e]; r8[e] = kp + __shfl_xor(snd, 32); }
#pragma unroll
            for (int e = 0; e < 4; ++e) { const float snd = b4 ? r8[e] : r8[e + 4], kp = b4 ? r8[e + 4] : r8[e]; r4[e] = kp + __shfl_xor(snd, 16); }
#pragma unroll
            for (int e = 0; e < 2; ++e) { const float snd = b3 ? r4[e] : r4[e + 2], kp = b3 ? r4[e + 2] : r4[e]; r2[e] = kp + __shfl_xor(snd, 8); }
            float rv; { const float snd = b2 ? r2[0] : r2[1], kp = b2 ? r2[1] : r2[0]; rv = kp + __shfl_xor(snd, 4); }
            rv += __shfl_xor(rv, 2); rv += __shfl_xor(rv, 1);
            if ((lane & 3) == 0) lgb[(wave * 16 + it) * 16 + (lane >> 2)] = rv;
            if (lane == it) myrow = row;
            ++it;
            if (it == 16) { route_flush(p, lds, lane, wave, it, myrow, layer); it = 0; }
        }
    }
    if (MODE == 1 && it > 0) route_flush(p, lds, lane, wave, it, myrow, layer);
}

template <class WF, class XF, class EPI>
__device__ __forceinline__ void gemm_tile(char* lds, int nkt, WF wf, XF xf, EPI epi) {
    const int tid = TID(), lane = tid & 63, wave = tid >> 6;
    const int wn = wave & 1, wm = wave >> 1, hh = lane >> 5;
    const int lrow = tid >> 3;
    const int lchunk = (tid & 7) ^ ((tid >> 4) & 7);
    const half_t* xs[4];
#pragma unroll
    for (int i = 0; i < 4; ++i) xs[i] = xf(lrow + 32 * i) + lchunk * 8;
    char* ldst = lds + lrow * 128 + (tid & 7) * 16;
    f16v acc[2][2];
#pragma unroll
    for (int i = 0; i < 2; ++i)
#pragma unroll
        for (int j = 0; j < 2; ++j)
#pragma unroll
            for (int r = 0; r < 16; ++r) acc[i][j][r] = 0.f;
    auto issue = [&](int kt, int s) {
        char* d = ldst + s * 32768;
#pragma unroll
        for (int i = 0; i < 4; ++i) glds16(wf(kt, lrow + 32 * i) + lchunk * 8, d + i * 4096);
#pragma unroll
        for (int i = 0; i < 4; ++i) glds16(xs[i] + kt * 64, d + 16384 + i * 4096);
    };
    __syncthreads();
    issue(0, 0);
    const int rsw = (lane >> 1) & 7;
    const int roff_w = (wn * 64 + (lane & 31)) * 128, roff_x = 16384 + (wm * 64 + (lane & 31)) * 128;
    for (int kt = 0; kt < nkt; ++kt) {
        asm volatile("s_waitcnt vmcnt(0)" ::: "memory");
        __syncthreads();
        if (kt + 1 < nkt) issue(kt + 1, (kt + 1) & 1);
        const char* base = lds + (kt & 1) * 32768;
#pragma unroll
        for (int ks = 0; ks < 4; ++ks) {
            const int co = ((2 * ks + hh) ^ rsw) << 4;
            const h8 a0 = *(const h8*)(base + roff_w + co), a1 = *(const h8*)(base + roff_w + 4096 + co);
            const h8 b0 = *(const h8*)(base + roff_x + co), b1 = *(const h8*)(base + roff_x + 4096 + co);
            acc[0][0] = __builtin_amdgcn_mfma_f32_32x32x16_f16(a0, b0, acc[0][0], 0, 0, 0);
            acc[0][1] = __builtin_amdgcn_mfma_f32_32x32x16_f16(a0, b1, acc[0][1], 0, 0, 0);
            acc[1][0] = __builtin_amdgcn_mfma_f32_32x32x16_f16(a1, b0, acc[1][0], 0, 0, 0);
            acc[1][1] = __builtin_amdgcn_mfma_f32_32x32x16_f16(a1, b1, acc[1][1], 0, 0, 0);
        }
    }
    epi(acc, wn, wm, lane);
}

template <class WF, class XF, class EPI>
__device__ __forceinline__ void gemm_tile2(char* lds, int nkt, size_t xkstride, WF wf, XF xf, EPI epi) {
    const int tid = TID(), lane = tid & 63, wave = tid >> 6;
    const int wn = wave & 1, wm = wave >> 1, hh = lane >> 5;
    const int lrow = tid >> 2;
    const int lchunk = (tid & 3) ^ ((tid >> 4) & 3);
    const half_t* xs[2];
#pragma unroll
    for (int i = 0; i < 2; ++i) xs[i] = xf(lrow + 64 * i) + lchunk * 8;
    char* ldst = lds + lrow * 64 + (tid & 3) * 16;
    f16v acc[4][2];
#pragma unroll
    for (int i = 0; i < 4; ++i)
#pragma unroll
        for (int j = 0; j < 2; ++j)
#pragma unroll
            for (int r = 0; r < 16; ++r) acc[i][j][r] = 0.f;
    auto issue = [&](int kt, int s) {
        char* d = ldst + s * 24576;
#pragma unroll
        for (int i = 0; i < 4; ++i) glds16(wf(kt, lrow + 64 * i) + lchunk * 8, d + i * 4096);
#pragma unroll
        for (int i = 0; i < 2; ++i) glds16(xs[i] + (size_t)kt * xkstride, d + 16384 + i * 4096);
    };
    __syncthreads();
    issue(0, 0); issue(1, 1);
    const int rsw = (lane >> 2) & 3;
    const int roff_w = (wn * 128 + (lane & 31)) * 64, roff_x = 16384 + (wm * 64 + (lane & 31)) * 64;
    int st = 0;
    for (int kt = 0; kt < nkt; ++kt) {
        if (kt + 1 < nkt) asm volatile("s_waitcnt vmcnt(6)" ::: "memory");
        else asm volatile("s_waitcnt vmcnt(0)" ::: "memory");
        asm volatile("s_waitcnt lgkmcnt(0)" ::: "memory");
        __builtin_amdgcn_s_barrier();
        if (kt + 2 < nkt) issue(kt + 2, st >= 1 ? st - 1 : 2);
        const char* base = lds + st * 24576;
        st = st == 2 ? 0 : st + 1;
#pragma unroll
        for (int ks = 0; ks < 2; ++ks) {
            const int co = ((2 * ks + hh) ^ rsw) << 4;
            h8 a[4], b[2];
#pragma unroll
            for (int i = 0; i < 4; ++i) a[i] = *(const h8*)(base + roff_w + i * 2048 + co);
#pragma unroll
            for (int j = 0; j < 2; ++j) b[j] = *(const h8*)(base + roff_x + j * 2048 + co);
#pragma unroll
            for (int i = 0; i < 4; ++i)
#pragma unroll
                for (int j = 0; j < 2; ++j) acc[i][j] = __builtin_amdgcn_mfma_f32_32x32x16_f16(a[i], b[j], acc[i][j], 0, 0, 0);
        }
    }
    epi(acc, wn, wm, lane);
}

__device__ __forceinline__ void phase_inproj(KP p, char* lds, int l) {
    const half_t* W = p->Wt_in + (size_t)l * NP * DM;
    const float* rc16 = p->rope; const float* rs16 = p->rope + 16384; const float* rc8 = p->rope + 32768; const float* rs8 = p->rope + 32768 + 8192;
    for (int u = BID(); u < 256 * 10; u += gridDim.x) {
        const int xl = u & 7, Lx = u >> 3, mi = Lx & 15, rr_ = Lx >> 4;
        const int nt = rr_ % 10, mt = 32 * xl + 16 * (rr_ / 10) + mi;
        gemm_tile2(lds, 32, (size_t)T_TOK * 32,
            [&](int kt, int row) { int n = nt * 256 + row; n = n < NP ? n : NP - 1; return W + ((size_t)kt * NP + n) * 32; },
            [&](int row) { return p->hn + (size_t)(mt * 128 + row) * 32; },
            [&](f16v (&acc)[4][2], int wn, int wm, int lane) {
                const int hh = lane >> 5;
                half_t* stg = (half_t*)lds;
                __syncthreads();
#pragma unroll
                for (int i = 0; i < 4; ++i) {
                    const int nb = nt * 256 + wn * 128 + i * 32;
                    if (nb == 1216 || nb == 1248 || nb >= NP) continue;
                    if (nt < 2) {
                        if (i & 1) continue;
#pragma unroll
                        for (int j = 0; j < 2; ++j) {
                            half_t* dst = stg + (wm * 64 + j * 32 + (lane & 31)) * 260 + wn * 64 + (i >> 1) * 32 + 4 * hh;
#pragma unroll
                            for (int g = 0; g < 4; ++g) {
                                float a4[4];
#pragma unroll
                                for (int r = 0; r < 4; ++r) a4[r] = acc[i][j][4 * g + r] * sigmoidf_(acc[i + 1][j][4 * g + r]);
                                *(h4*)(dst + 8 * g) = pack4(a4[0], a4[1], a4[2], a4[3]);
                            }
                        }
                        continue;
                    }
                    const bool rope64 = ((nb >= PC_DQ && nb < PC_DV) || (nb >= PC_MQ && nb < PC_MV)) && ((nb & 63) == 0);
                    const bool rope32 = (nb >= PC_IQ && nb < PC_IW);
#pragma unroll
                    for (int j = 0; j < 2; ++j) {
                        const int tok = mt * 128 + wm * 64 + j * 32 + (lane & 31);
                        const int t = tok & 2047;
                        f16v v = acc[i][j];
                        if (nb == PC_IW) { if (hh == 0) *(float4*)(p->iwf + (size_t)tok * 4) = make_float4(v[0], v[1], v[2], v[3]); continue; }
                        if (rope64) {
                            const float4 c4 = *(const float4*)(rc16 + t * 8 + 4 * hh), s4 = *(const float4*)(rs16 + t * 8 + 4 * hh);
                            const float cc[4] = {c4.x, c4.y, c4.z, c4.w}, sn[4] = {s4.x, s4.y, s4.z, s4.w};
#pragma unroll
                            for (int r = 0; r < 4; ++r) { const float x1 = v[r], x2 = v[r + 4]; v[r] = x1 * cc[r] - x2 * sn[r]; v[r + 4] = x2 * cc[r] + x1 * sn[r]; }
                        } else if (rope32) {
                            const float4 c4 = *(const float4*)(rc8 + t * 4), s4 = *(const float4*)(rs8 + t * 4);
                            const float cc[4] = {c4.x, c4.y, c4.z, c4.w}, sn[4] = {s4.x, s4.y, s4.z, s4.w};
#pragma unroll
                            for (int r = 0; r < 4; ++r) { const float o = __shfl_xor(v[r], 32); v[r] = hh ? (v[r] * cc[r] + o * sn[r]) : (v[r] * cc[r] - o * sn[r]); }
                        }
                        half_t* dst = stg + (wm * 64 + j * 32 + (lane & 31)) * 260 + wn * 128 + i * 32 + 4 * hh;
#pragma unroll
                        for (int g = 0; g < 4; ++g) *(h4*)(dst + 8 * g) = pack4(v[4 * g], v[4 * g + 1], v[4 * g + 2], v[4 * g + 3]);
                    }
                }
                __syncthreads();
                const int wv_ = TID() >> 6;
#pragma unroll 4
                for (int it = 0; it < 32; ++it) {
                    const int row = it * 4 + wv_;
                    const uint2 v2 = *(const uint2*)(stg + row * 260 + lane * 4);
                    if (nt < 2) { if (lane < 32) *(uint2*)(p->P + (size_t)(mt * 128 + row) * NP + nt * 128 + lane * 4) = v2; }
                    else { const int n = nt * 256 + lane * 4; if (n < NP) *(uint2*)(p->P + (size_t)(mt * 128 + row) * NP + n) = v2; }
                }
            });
    }
}

__device__ __forceinline__ void stage_acc_f32(char* lds, const f16v (&acc)[2][2], int wn, int wm, int lane) {
    float* stg = (float*)lds;
    const int hh = lane >> 5;
    __syncthreads();
#pragma unroll
    for (int j = 0; j < 2; ++j)
#pragma unroll
        for (int i = 0; i < 2; ++i)
#pragma unroll
            for (int g = 0; g < 4; ++g)
                *(float4*)(stg + (wm * 64 + j * 32 + (lane & 31)) * 132 + wn * 64 + i * 32 + 4 * hh + 8 * g) = make_float4(acc[i][j][4 * g], acc[i][j][4 * g + 1], acc[i][j][4 * g + 2], acc[i][j][4 * g + 3]);
    __syncthreads();
}
__device__ __forceinline__ void phase_outproj(KP p, char* lds, int l, const float* xin) {
    const half_t* W = p->Wt_o + (size_t)l * DM * DM;
    const float* g1 = p->modf + (size_t)l * 16 * 6144 + 2 * 1024;
    for (int u = BID(); u < 256 * 4; u += gridDim.x) {
        const int xl = u & 7, Lx = u >> 3, mi = Lx & 7, rr_ = Lx >> 3;
        const int nt = rr_ & 3, mt = 32 * xl + 8 * (rr_ >> 2) + mi;
        gemm_tile2(lds, 32, (size_t)T_TOK * 32,
            [&](int kt, int row) { return W + ((size_t)kt * DM + nt * 256 + row) * 32; },
            [&](int row) { return p->ycat + (size_t)(mt * 128 + row) * 32; },
            [&](f16v (&acc)[4][2], int wn, int wm, int lane) {
                const int hh = lane >> 5, tid = TID();
                float* stg = (float*)lds;
#pragma unroll
                for (int rnd = 0; rnd < 2; ++rnd) {
                    __syncthreads();
                    if (wm == rnd) {
#pragma unroll
                        for (int j = 0; j < 2; ++j)
#pragma unroll
                            for (int i = 0; i < 4; ++i)
#pragma unroll
                                for (int g = 0; g < 4; ++g)
                                    *(float4*)(stg + (j * 32 + (lane & 31)) * 260 + wn * 128 + i * 32 + 4 * hh + 8 * g) = make_float4(acc[i][j][4 * g], acc[i][j][4 * g + 1], acc[i][j][4 * g + 2], acc[i][j][4 * g + 3]);
                    }
                    __syncthreads();
#pragma unroll 4
                    for (int it = 0; it < 16; ++it) {
                        const int idx = it * 256 + tid, row = idx >> 6, c = idx & 63;
                        const int tok = mt * 128 + rnd * 64 + row, n = nt * 256 + 4 * c;
                        const float4 a4 = *(const float4*)(stg + row * 260 + 4 * c);
                        const float4 xi = *(const float4*)(xin + (size_t)tok * DM + n);
                        const float4 gg = *(const float4*)(g1 + (size_t)(tok >> 11) * 6144 + n);
                        float4 o; o.x = xi.x + gg.x * a4.x; o.y = xi.y + gg.y * a4.y; o.z = xi.z + gg.z * a4.z; o.w = xi.w + gg.w * a4.w;
                        *(float4*)(p->out + (size_t)tok * DM + n) = o;
                    }
                }
            });
    }
}

__device__ __forceinline__ bool moe_tile(const int* cnt, int tile, int& cls, int& pos0, int& n) {
    int tb = 0;
    for (int c = 0; c < NCLS; ++c) {
        const int nc = cnt[c * 64], nt = (nc + 127) >> 7;
        if (tile < tb + nt) { cls = c; pos0 = (tile - tb) * 128; n = nc; return true; }
        tb += nt;
    }
    return false;
}
__device__ __forceinline__ void cls_experts(int cls, int& e1, int& e2) {
    const int g = cls / 6, pi = cls % 6;
    const int a = pi < 3 ? 0 : (pi < 5 ? 1 : 2);
    const int b = pi < 3 ? pi + 1 : (pi < 5 ? pi - 1 : 3);
    e1 = g * 4 + a; e2 = g * 4 + b;
}
__device__ __forceinline__ void phase_moe_up(KP p, char* lds, int l) {
    const int* cnt = p->cnt + l * 32 * 64;
    for (int u = BID(); u < (256 + NCLS) * 8; u += gridDim.x) {
        const int xl = u & 7, Lx = u >> 3;
        const int nt = Lx & 7, tile = (Lx >> 3) * 8 + xl;
        int cls, pos0, nc;
        if (!moe_tile(cnt, tile, cls, pos0, nc)) continue;
        int e1, e2; cls_experts(cls, e1, e2);
        const int slot = nt >> 2;
        const half_t* W = p->Wt_gu + ((size_t)(l * 16 + (slot ? e2 : e1)) * 512 + (nt & 3) * 128) * 1024;
        const int* lst = p->lists + (size_t)cls * T_TOK + pos0;
        const int nvalid = nc - pos0;
        gemm_tile(lds, 16,
            [&](int kt, int row) { return W + (size_t)row * 1024 + kt * 64; },
            [&](int row) { const int tok = lst[row < nvalid ? row : 0]; return p->hn + (size_t)tok * DM; },
            [&](f16v (&acc)[2][2], int wn, int wm, int lane) {
                const int hh = lane >> 5;
#pragma unroll
                for (int j = 0; j < 2; ++j) {
                    const int row = wm * 64 + j * 32 + (lane & 31);
                    if (row < nvalid) {
                        const int tok = lst[row];
                        const float wgt = p->tokw[(size_t)tok * 2 + slot];
                        half_t* dst = p->act + (size_t)tok * 512 + slot * 256 + ((nt & 3) * 2 + wn) * 32 + 4 * hh;
#pragma unroll
                        for (int g = 0; g < 4; ++g) {
                            float a[4];
#pragma unroll
                            for (int r = 0; r < 4; ++r) { const float gv = acc[0][j][4 * g + r], uv = acc[1][j][4 * g + r]; a[r] = gv * sigmoidf_(gv) * uv * wgt; }
                            *(h4*)(dst + 8 * g) = pack4(a[0], a[1], a[2], a[3]);
                        }
                    }
                }
            });
    }
}
__device__ __forceinline__ void phase_moe_down(KP p, char* lds, int l, float gsc) {
    const int* cnt = p->cnt + l * 32 * 64;
    const float* g2 = p->modf + (size_t)l * 16 * 6144 + 5 * 1024;
    for (int u = BID(); u < (256 + NCLS) * 8; u += gridDim.x) {
        const int xl = u & 7, Lx = u >> 3;
        const int nt = Lx & 7, tile = (Lx >> 3) * 8 + xl;
        int cls, pos0, nc;
        if (!moe_tile(cnt, tile, cls, pos0, nc)) continue;
        int e1, e2; cls_experts(cls, e1, e2);
        const half_t* W1 = p->Wt_d + ((size_t)(l * 16 + e1) * 1024 + nt * 128) * 256;
        const half_t* W2 = p->Wt_d + ((size_t)(l * 16 + e2) * 1024 + nt * 128) * 256;
        const int* lst = p->lists + (size_t)cls * T_TOK + pos0;
        const int nvalid = nc - pos0;
        gemm_tile(lds, 8,
            [&](int kt, int row) { return (kt < 4 ? W1 : W2) + (size_t)row * 256 + (kt & 3) * 64; },
            [&](int row) { const int tok = lst[row < nvalid ? row : 0]; return p->act + (size_t)tok * 512; },
            [&](f16v (&acc)[2][2], int wn, int wm, int lane) {
                const int hh = lane >> 5;
#pragma unroll
                for (int j = 0; j < 2; ++j) {
                    const int row = wm * 64 + j * 32 + (lane & 31);
                    if (row < nvalid) {
                        const int tok = lst[row];
                        const int b = tok >> 11;
#pragma unroll
                        for (int i = 0; i < 2; ++i) {
                            const int nb = nt * 128 + wn * 64 + i * 32 + 4 * hh;
#pragma unroll
                            for (int g = 0; g < 4; ++g) {
                                const int n = nb + 8 * g;
                                float4* xp = (float4*)(p->out + (size_t)tok * DM + n);
                                float4 xi = *xp;
                                const float4 gg = *(const float4*)(g2 + (size_t)b * 6144 + n);
                                xi.x += gsc * gg.x * acc[i][j][4 * g]; xi.y += gsc * gg.y * acc[i][j][4 * g + 1]; xi.z += gsc * gg.z * acc[i][j][4 * g + 2]; xi.w += gsc * gg.w * acc[i][j][4 * g + 3];
                                *xp = xi;
                            }
                        }
                    }
                }
            });
    }
}

__device__ __forceinline__ void dsa_select_unit(KP p, char* lds, int b, int qt) {
    unsigned* hist = (unsigned*)lds;
    unsigned* maskl = hist + 16 * 257 + 16;
    unsigned* stP = maskl + 1024;
    unsigned* stNeed = stP + 16;
    unsigned* stDone = stNeed + 16;
    unsigned* flag = stDone + 16;
    unsigned* dummyb = flag + 16;
    const int tid = TID(), lane = tid & 63, wave = tid >> 6;
    const int q0 = qt * 16, tokbase = b * SEQ;
    __syncthreads();
    if (q0 < 256) {
        for (int i = tid; i < 1024; i += 256) {
            const int q = i >> 6, wd = i & 63;
            const int n = q0 + q + 1 - 32 * wd;
            const unsigned w = n >= 32 ? 0xFFFFFFFFu : (n <= 0 ? 0u : ((1u << n) - 1u));
            p->dmask[(size_t)(tokbase + q0 + q) * 64 + wd] = w;
        }
        return;
    }
    for (int i = tid; i < 1024; i += 256) maskl[i] = 0u;
    if (tid < 16) { stP[tid] = 0u; stNeed[tid] = 256u; stDone[tid] = 0u; }
    for (int i = tid; i < 16 * 257; i += 256) hist[i] = 0u;
    __syncthreads();
    const int ql = lane & 15, fq = lane >> 4;
    const int tq = q0 + ql;
    const half_t* Pb = p->P + (size_t)tokbase * NP;
    h8 iqf[4];
#pragma unroll
    for (int hd = 0; hd < 4; ++hd) iqf[hd] = *(const h8*)(Pb + (size_t)tq * NP + PC_IQ + hd * 32 + 8 * fq);
    const float4 iw4 = *(const float4*)(p->iwf + (size_t)(tokbase + tq) * 4);
    const float wsc0 = iw4.x * 0.08838834764831845f, wsc1 = iw4.y * 0.08838834764831845f, wsc2 = iw4.z * 0.08838834764831845f, wsc3 = iw4.w * 0.08838834764831845f;
    const int ng = qt + 1;
    unsigned sc[32][4];
    const half_t* ikp = Pb + (size_t)ql * NP + PC_IK + 8 * fq;
#pragma unroll
    for (int gb = 0; gb < 4; ++gb) {
        h8 ik[8];
#pragma unroll
        for (int x = 0; x < 8; ++x) {
            int g = wave + 4 * (gb * 8 + x);
            g = g < ng ? g : ng - 1;
            ik[x] = *(const h8*)(ikp + (size_t)(16 * g) * NP);
        }
#pragma unroll
        for (int x = 0; x < 8; ++x) {
            const int gi = gb * 8 + x;
            const int g = wave + 4 * gi;
            const f4v z = {0.f, 0.f, 0.f, 0.f};
            const f4v c0 = __builtin_amdgcn_mfma_f32_16x16x32_f16(ik[x], iqf[0], z, 0, 0, 0);
            const f4v c1 = __builtin_amdgcn_mfma_f32_16x16x32_f16(ik[x], iqf[1], z, 0, 0, 0);
            const f4v c2 = __builtin_amdgcn_mfma_f32_16x16x32_f16(ik[x], iqf[2], z, 0, 0, 0);
            const f4v c3 = __builtin_amdgcn_mfma_f32_16x16x32_f16(ik[x], iqf[3], z, 0, 0, 0);
#pragma unroll
            for (int r = 0; r < 4; ++r) {
                const int j = 16 * g + 4 * fq + r;
                float sv = wsc0 * __builtin_amdgcn_fmed3f(c0[r], 0.f, INFINITY);
                sv = fmaf(wsc1, __builtin_amdgcn_fmed3f(c1[r], 0.f, INFINITY), sv);
                sv = fmaf(wsc2, __builtin_amdgcn_fmed3f(c2[r], 0.f, INFINITY), sv);
                sv = fmaf(wsc3, __builtin_amdgcn_fmed3f(c3[r], 0.f, INFINITY), sv);
                sv += 0.0f;
                const int sb = __float_as_int(sv);
                const unsigned su = (unsigned)sb ^ ((unsigned)(sb >> 31) | 0x80000000u);
                const unsigned ck = (su & 0xFFFFF800u) | (unsigned)(2047 - j);
                sc[gi][r] = (g < ng && j <= tq) ? ck : 0u;
            }
            if (g < ng) {
#pragma unroll
                for (int r = 0; r < 4; ++r) atomicAdd(hist + ql * 257 + (sc[gi][r] >> 24), 1u);
            }
        }
    }
    bool alldone = false;
    for (int pass = 0; pass < 5; ++pass) {
        const bool fin = alldone;
        if (!fin && pass > 0) { for (int i = tid; i < 16 * 257; i += 256) hist[i] = 0u; }
        if (tid == 0) *flag = 0u;
        __syncthreads();
        if (pass > 0) {
        const unsigned sP = stP[ql], sDone = stDone[ql];
        int wv = wave, fqv = fq;
        asm volatile("" : "+v"(wv), "+v"(fqv));
        if (fin) {
            const int sh = (int)(32u - 8u * (sDone ? sDone : 1u));
            unsigned* mrow = maskl + ql * 64;
#pragma unroll
            for (int gi = 0; gi < 32; ++gi) {
                const int g = wv + 4 * gi;
                unsigned nib = 0u;
#pragma unroll
                for (int r = 0; r < 4; ++r) {
                    const unsigned uu = sc[gi][r];
                    nib |= ((uu >> sh) >= sP) ? (1u << r) : 0u;
                }
                if (g < ng) atomicOr(&mrow[g >> 1], nib << ((g & 1) * 16 + 4 * fqv));
            }
        } else {
            const int shm = pass ? 32 - 8 * pass : 0, shd = 24 - 8 * pass;
            const unsigned orm = pass ? 0u : 0xFFFFFFFFu;
            const unsigned cmpv = pass ? (sDone == 0u ? sP : 0xFFFFFFFFu) : 0xFFFFFFFFu;
            unsigned* hrow = hist + ql * 257;
            unsigned* dummy = dummyb + lane;
#pragma unroll
            for (int gi = 0; gi < 32; ++gi) {
                const int g = wv + 4 * gi;
                if (g < ng) {
#pragma unroll
                    for (int r = 0; r < 4; ++r) {
                        const unsigned uu = sc[gi][r];
                        const bool match = (((uu >> shm) | orm) == cmpv);
                        const unsigned dig = (uu >> shd) & 255u;
                        unsigned* a = match ? hrow + dig : dummy;
                        atomicAdd(a, 1u);
                    }
                }
            }
        }
        }
        __syncthreads();
        if (fin) break;
        {
            const int qq = tid >> 4, seg = tid & 15;
            const bool active = (stDone[qq] == 0u);
            unsigned c16 = 0u;
            if (active) {
#pragma unroll
                for (int d = 0; d < 16; ++d) c16 += hist[qq * 257 + seg * 16 + d];
            }
            unsigned v = c16;
#pragma unroll
            for (int off = 1; off < 16; off <<= 1) { const unsigned t = __shfl_down(v, off, 16); if (seg + off < 16) v += t; }
            const unsigned suf = v - c16;
            const unsigned need = stNeed[qq];
            if (active && suf < need && need <= suf + c16) {
                unsigned run = suf, D = 0u, cD = 0u, nn = need;
                for (int d = 15; d >= 0; --d) {
                    const unsigned cc = hist[qq * 257 + seg * 16 + d];
                    if (run + cc >= need) { D = (unsigned)(seg * 16 + d); cD = cc; nn = need - run; break; }
                    run += cc;
                }
                const bool done = (cD == nn) || pass == 3;
                stP[qq] = (stP[qq] << 8) | D; stNeed[qq] = nn;
                if (done) stDone[qq] = (unsigned)(pass + 1); else atomicAdd(flag, 1u);
            }
        }
        __syncthreads();
        alldone = (*flag == 0u);
    }
    for (int i = tid; i < 1024; i += 256) p->dmask[(size_t)(tokbase + q0 + (i >> 6)) * 64 + (i & 63)] = maskl[i];
}

__device__ __forceinline__ void conv_unit(KP p, char* lds, int l, int b, int c) {
    float* red = (float*)lds;
    const int ch = TID(), lane = ch & 63, wave = ch >> 6;
    const int t0 = c * 32, tokbase = b * SEQ;
    float aw[62];
#pragma unroll
    for (int rr = 0; rr < 62; ++rr) {
        int tt = t0 - 30 + rr; const bool ok = tt >= 0; tt = ok ? tt : t0;
        const float v = (float)p->P[(size_t)(tokbase + tt) * NP + ch];
        aw[rr] = ok ? v : 0.f;
    }
    float w[31];
#pragma unroll
    for (int i = 0; i < 31; ++i) w[i] = p->w_dw[(l * 31 + i) * 256 + ch];
    const float bias = p->b_dw[l * 256 + ch];
    float y[32], s1[32], s2[32];
#pragma unroll
    for (int tk = 0; tk < 32; ++tk) {
        float sacc = bias;
#pragma unroll
        for (int i = 0; i < 31; ++i) sacc = fmaf(aw[tk + i], w[i], sacc);
        y[tk] = sacc; s1[tk] = sacc; s2[tk] = sacc * sacc;
    }
    {
        const bool b5 = lane & 32, b4 = lane & 16, b3 = lane & 8, b2 = lane & 4, b1 = lane & 2;
        float a16[16], c16[16], a8[8], c8[8], a4[4], c4[4], a2[2], c2[2];
#pragma unroll
        for (int e = 0; e < 16; ++e) { a16[e] = (b5 ? s1[e + 16] : s1[e]) + __shfl_xor(b5 ? s1[e] : s1[e + 16], 32); c16[e] = (b5 ? s2[e + 16] : s2[e]) + __shfl_xor(b5 ? s2[e] : s2[e + 16], 32); }
#pragma unroll
        for (int e = 0; e < 8; ++e) { a8[e] = (b4 ? a16[e + 8] : a16[e]) + __shfl_xor(b4 ? a16[e] : a16[e + 8], 16); c8[e] = (b4 ? c16[e + 8] : c16[e]) + __shfl_xor(b4 ? c16[e] : c16[e + 8], 16); }
#pragma unroll
        for (int e = 0; e < 4; ++e) { a4[e] = (b3 ? a8[e + 4] : a8[e]) + __shfl_xor(b3 ? a8[e] : a8[e + 4], 8); c4[e] = (b3 ? c8[e + 4] : c8[e]) + __shfl_xor(b3 ? c8[e] : c8[e + 4], 8); }
#pragma unroll
        for (int e = 0; e < 2; ++e) { a2[e] = (b2 ? a4[e + 2] : a4[e]) + __shfl_xor(b2 ? a4[e] : a4[e + 2], 4); c2[e] = (b2 ? c4[e + 2] : c4[e]) + __shfl_xor(b2 ? c4[e] : c4[e + 2], 4); }
        float av = (b1 ? a2[1] : a2[0]) + __shfl_xor(b1 ? a2[0] : a2[1], 2), cv = (b1 ? c2[1] : c2[0]) + __shfl_xor(b1 ? c2[0] : c2[1], 2);
        av += __shfl_xor(av, 1); cv += __shfl_xor(cv, 1);
        const int tokk = (b5 ? 16 : 0) + (b4 ? 8 : 0) + (b3 ? 4 : 0) + (b2 ? 2 : 0) + (b1 ? 1 : 0);
        __syncthreads();
        if ((lane & 1) == 0) { red[(tokk * 4 + wave) * 2] = av; red[(tokk * 4 + wave) * 2 + 1] = cv; }
        __syncthreads();
    }
    const float lg = p->ln_g[l * 256 + ch], lb = p->ln_b[l * 256 + ch];
#pragma unroll
    for (int tk = 0; tk < 32; ++tk) {
        const float4 ra = *(const float4*)(red + tk * 8), rb = *(const float4*)(red + tk * 8 + 4);
        const float t1 = (ra.x + ra.z) + (rb.x + rb.z);
        const float t2 = (ra.y + ra.w) + (rb.y + rb.w);
        const float mu = t1 * (1.0f / 256.0f);
        float var = t2 * (1.0f / 256.0f) - mu * mu; var = var < 0.f ? 0.f : var;
        float z = (y[tk] - mu) * (1.0f / sqrtf(var + 1e-6f)) * lg + lb;
        z = z * sigmoidf_(z);
        p->ycat[((size_t)(ch >> 5) * T_TOK + tokbase + t0 + tk) * 32 + (ch & 31)] = (half_t)z;
    }
}

__device__ __forceinline__ void kmean_unit(KP p, char* lds, int b, int h, int blk) {
    float* part = (float*)lds;
    const int tid = TID(), d = tid & 63, pt = tid >> 6;
    const half_t* r = p->P + (size_t)(b * SEQ + blk * 256 + pt * 64) * NP + PC_MK + h * 64 + d;
    float s = 0.f;
#pragma unroll 16
    for (int k = 0; k < 64; ++k) s += (float)r[(size_t)k * NP];
    __syncthreads();
    part[pt * 64 + d] = s;
    __syncthreads();
    if (tid < 64) p->kmean[(((size_t)b * 6 + h) * 8 + blk) * 64 + tid] = ((part[tid] + part[64 + tid]) + (part[128 + tid] + part[192 + tid])) * (1.0f / 256.0f);
}

#ifndef POST_MASK
#define POST_MASK 7
#endif
__device__ __forceinline__ void phase_post(KP p, char* lds, int l, int tm) {
    const int NA = 2048, NB = 1024, NC = 768;
    const int G_ = gridDim.x;
    for (int u0 = BID(), k_ = 0; u0 < NA + NB + NC; u0 += G_, ++k_) {
        int u = u0;
        if (u0 < NA && (k_ & 1) && (k_ + 1) * G_ <= NA) u = k_ * G_ + (G_ - 1 - (u0 - k_ * G_));
        if (u < NA) { if (tm & 1) dsa_select_unit(p, lds, u % 16, 127 - (u / 16)); }
        else if (u < NA + NB) { const int v = u - NA; if (tm & 2) conv_unit(p, lds, l, v % 16, v / 16); }
        else { const int v = u - NA - NB; if (tm & 4) kmean_unit(p, lds, v / 48, (v / 8) % 6, v % 8); }
    }
}

template <int MODE>
__device__ __forceinline__ void attn_unit(KP p, char* lds, int b, int h, int qt) {
    const int tid = TID(), lane = tid & 63, wave = tid >> 6, hh = lane >> 5, ql = lane & 31;
    const int q0 = qt * 128, tokbase = b * SEQ;
    const int tq = q0 + wave * 32 + ql;
    const half_t* Pb = p->P + (size_t)tokbase * NP;
    const int QOFF = MODE ? PC_MQ + h * 64 : PC_DQ + h * 64;
    const int KOFF = MODE ? PC_MK + h * 64 : PC_DK;
    const int VOFF = MODE ? PC_MV + h * 64 : PC_DV;
    const int own = qt >> 1;
    unsigned mysel = 0u, anysel = 0u;
    __syncthreads();
    if (MODE == 1) {
        float* km = (float*)(lds + 32768);
        float* gts = km + 512;
        unsigned* selq = (unsigned*)(gts + 1024);
        unsigned* anyb = selq + 128;
        for (int i = tid; i < 512; i += 256) km[i] = p->kmean[((size_t)b * 6 + h) * 512 + i];
        if (tid == 0) *anyb = 0u;
        __syncthreads();
        {
            const int q = tid & 127, hf = tid >> 7;
            if (hf * 4 < own) {
                const half_t* qr = Pb + (size_t)(q0 + q) * NP + QOFF;
                float g0 = 0.f, g1 = 0.f, g2 = 0.f, g3 = 0.f;
#pragma unroll
                for (int c8 = 0; c8 < 8; ++c8) {
                    const h8 qv = *(const h8*)(qr + c8 * 8);
#pragma unroll
                    for (int j4 = 0; j4 < 2; ++j4) {
                        const int d = c8 * 8 + j4 * 4;
                        const float q0f = (float)qv[j4 * 4], q1f = (float)qv[j4 * 4 + 1], q2f = (float)qv[j4 * 4 + 2], q3f = (float)qv[j4 * 4 + 3];
                        const float4 k0 = *(const float4*)(km + (hf * 4 + 0) * 64 + d), k1 = *(const float4*)(km + (hf * 4 + 1) * 64 + d);
                        const float4 k2 = *(const float4*)(km + (hf * 4 + 2) * 64 + d), k3 = *(const float4*)(km + (hf * 4 + 3) * 64 + d);
                        g0 = fmaf(q0f, k0.x, g0); g0 = fmaf(q1f, k0.y, g0); g0 = fmaf(q2f, k0.z, g0); g0 = fmaf(q3f, k0.w, g0);
                        g1 = fmaf(q0f, k1.x, g1); g1 = fmaf(q1f, k1.y, g1); g1 = fmaf(q2f, k1.z, g1); g1 = fmaf(q3f, k1.w, g1);
                        g2 = fmaf(q0f, k2.x, g2); g2 = fmaf(q1f, k2.y, g2); g2 = fmaf(q2f, k2.z, g2); g2 = fmaf(q3f, k2.w, g2);
                        g3 = fmaf(q0f, k3.x, g3); g3 = fmaf(q1f, k3.y, g3); g3 = fmaf(q2f, k3.z, g3); g3 = fmaf(q3f, k3.w, g3);
                    }
                }
                gts[q * 8 + hf * 4 + 0] = g0; gts[q * 8 + hf * 4 + 1] = g1; gts[q * 8 + hf * 4 + 2] = g2; gts[q * 8 + hf * 4 + 3] = g3;
            }
        }
        __syncthreads();
        if (tid < 128) {
            unsigned m = 0u;
            const int want = own < 3 ? own : 3;
            for (int r = 0; r < want; ++r) {
                int best = -1; float bv = -INFINITY;
                for (int j = 0; j < own; ++j) { const float gv = gts[tid * 8 + j]; if (!((m >> j) & 1u) && (best < 0 || gv > bv)) { best = j; bv = gv; } }
                m |= 1u << best;
            }
            selq[tid] = m;
            if (m) atomicOr(anyb, m);
        }
        __syncthreads();
        mysel = selq[wave * 32 + ql];
        anysel = *anyb;
        __syncthreads();
    }
    h8 qf[4];
#pragma unroll
    for (int ks = 0; ks < 4; ++ks) qf[ks] = *(const h8*)(Pb + (size_t)tq * NP + QOFF + 16 * ks + 8 * hh);
    f16v O0, O1;
#pragma unroll
    for (int r = 0; r < 16; ++r) { O0[r] = 0.f; O1[r] = 0.f; }
    float m_run = -1e30f, l_run = 0.f;
    const float CS = 0.18033688011112042f;
    const int ntile = 2 * qt + 2;
    auto skip = [&](int kt) -> bool { return MODE == 1 && kt < 4 * own && !((anysel >> (kt >> 2)) & 1u); };
    auto nexttile = [&](int kt) -> int { ++kt; while (kt < ntile && skip(kt)) ++kt; return kt; };
    const int lrow = tid >> 3;
    const int kchunk = (tid & 7) ^ ((tid >> 4) & 7);
    const int vchunk = (tid & 7) ^ (((tid >> 4) & 1) << 2);
    char* ldst = lds + lrow * 128 + (tid & 7) * 16;
    auto issue = [&](int kt, int s) {
        const half_t* src = Pb + (size_t)(kt * 64 + lrow) * NP;
        char* d = ldst + s * 16384;
        glds16(src + KOFF + kchunk * 8, d);
        glds16(src + (size_t)32 * NP + KOFF + kchunk * 8, d + 4096);
        glds16(src + VOFF + vchunk * 8, d + 8192);
        glds16(src + (size_t)32 * NP + VOFF + vchunk * 8, d + 8192 + 4096);
    };
    const int rsw = (lane >> 1) & 7;
    const int kro = ql * 128;
    const int li = lane & 15, qp = li >> 2, pp = li & 3, swv = (qp >> 1) & 1;
    const int vb0 = 8192 + (4 * hh + qp) * 128 + 32 * ((lane >> 4) & 1) + 8 * pp + 64 * (0 ^ swv);
    const int vb1 = 8192 + (4 * hh + qp) * 128 + 32 * ((lane >> 4) & 1) + 8 * pp + 64 * (1 ^ swv);
    int kt = -1; kt = nexttile(kt);
    int s = 0;
    if (kt < ntile) issue(kt, 0);
    while (kt < ntile) {
        const int ktn = nexttile(kt);
        asm volatile("s_waitcnt vmcnt(0)" ::: "memory");
        __syncthreads();
        if (ktn < ntile) issue(ktn, s ^ 1);
        const bool wave_active = (kt * 64 <= q0 + wave * 32 + 31);
        if (wave_active) {
            const char* base = lds + s * 16384;
            uint2 mw = make_uint2(0u, 0u);
            if (MODE == 0) mw = *(const uint2*)(p->dmask + (size_t)(tokbase + tq) * 64 + 2 * kt);
            h8 vf0[4], vf1[4];
#pragma unroll
            for (int kk = 0; kk < 4; ++kk) {
                const int roff = (32 * (kk >> 1) + 16 * (kk & 1)) * 128;
                const s4v lo0 = __builtin_amdgcn_ds_read_tr16_b64_v4i16((LAS s4v*)(base + vb0 + roff));
                const s4v hi0 = __builtin_amdgcn_ds_read_tr16_b64_v4i16((LAS s4v*)(base + vb0 + roff + 8 * 128));
                const s4v lo1 = __builtin_amdgcn_ds_read_tr16_b64_v4i16((LAS s4v*)(base + vb1 + roff));
                const s4v hi1 = __builtin_amdgcn_ds_read_tr16_b64_v4i16((LAS s4v*)(base + vb1 + roff + 8 * 128));
                vf0[kk] = __builtin_bit_cast(h8, __builtin_shufflevector(lo0, hi0, 0, 1, 2, 3, 4, 5, 6, 7));
                vf1[kk] = __builtin_bit_cast(h8, __builtin_shufflevector(lo1, hi1, 0, 1, 2, 3, 4, 5, 6, 7));
            }
            f16v s0, s1;
#pragma unroll
            for (int r = 0; r < 16; ++r) { s0[r] = 0.f; s1[r] = 0.f; }
#pragma unroll
            for (int ks = 0; ks < 4; ++ks) {
                const int co = ((2 * ks + hh) ^ rsw) << 4;
                const h8 k0 = *(const h8*)(base + kro + co), k1 = *(const h8*)(base + kro + 4096 + co);
                s0 = __builtin_amdgcn_mfma_f32_32x32x16_f16(k0, qf[ks], s0, 0, 0, 0);
                s1 = __builtin_amdgcn_mfma_f32_32x32x16_f16(k1, qf[ks], s1, 0, 0, 0);
            }
            bool lane_on = true;
            if (MODE == 0) {
                const unsigned w0 = mw.x >> (4 * hh), w1 = mw.y >> (4 * hh);
#pragma unroll
                for (int r = 0; r < 16; ++r) {
                    const int pos = (r & 3) + 8 * (r >> 2);
                    const unsigned m0 = (unsigned)__builtin_amdgcn_sbfe((int)w0, pos, 1), m1 = (unsigned)__builtin_amdgcn_sbfe((int)w1, pos, 1);
                    s0[r] = __uint_as_float((__float_as_uint(s0[r]) & m0) | (0xFF800000u & ~m0));
                    s1[r] = __uint_as_float((__float_as_uint(s1[r]) & m1) | (0xFF800000u & ~m1));
                }
            } else {
                if (kt < 4 * own) {
                    lane_on = (mysel >> (kt >> 2)) & 1u;
                } else if (kt * 64 + 63 > q0 + wave * 32) {
#pragma unroll
                    for (int r = 0; r < 16; ++r) {
                        const int key = kt * 64 + (r & 3) + 8 * (r >> 2) + 4 * hh;
                        s0[r] = (key <= tq) ? s0[r] : -INFINITY;
                        s1[r] = (key + 32 <= tq) ? s1[r] : -INFINITY;
                    }
                }
            }
            float mx = s0[0];
#pragma unroll
            for (int r = 1; r < 16; ++r) mx = fmaxf(mx, s0[r]);
#pragma unroll
            for (int r = 0; r < 16; ++r) mx = fmaxf(mx, s1[r]);
            mx = lane_on ? mx : -INFINITY;
            mx = fmaxf(mx, __shfl_xor(mx, 32));
            const float mnew = fmaxf(m_run, mx);
            const float alpha = __builtin_amdgcn_exp2f((m_run - mnew) * CS);
            const float mc = lane_on ? mnew * CS : INFINITY;
            m_run = mnew;
            float ls = 0.f;
#pragma unroll
            for (int r = 0; r < 16; ++r) { s0[r] = __builtin_amdgcn_exp2f(fmaf(s0[r], CS, -mc)); ls += s0[r]; }
#pragma unroll
            for (int r = 0; r < 16; ++r) { s1[r] = __builtin_amdgcn_exp2f(fmaf(s1[r], CS, -mc)); ls += s1[r]; }
            l_run = l_run * alpha + ls;
            if (!__all(alpha == 1.0f)) {
#pragma unroll
                for (int r = 0; r < 16; ++r) { O0[r] *= alpha; O1[r] *= alpha; }
            }
#pragma unroll
            for (int kk = 0; kk < 4; ++kk) {
                h8 pf;
#pragma unroll
                for (int j = 0; j < 8; ++j) pf[j] = (half_t)((kk >> 1) ? s1[8 * (kk & 1) + j] : s0[8 * (kk & 1) + j]);
                O0 = __builtin_amdgcn_mfma_f32_32x32x16_f16(vf0[kk], pf, O0, 0, 0, 0);
                O1 = __builtin_amdgcn_mfma_f32_32x32x16_f16(vf1[kk], pf, O1, 0, 0, 0);
            }
        }
        kt = ktn; s ^= 1;
    }
    const float lt = l_run + __shfl_xor(l_run, 32);
    const float inv = 1.0f / lt;
    const int ycol = (MODE ? 640 : 256) + h * 64;
    half_t* dst = p->ycat + ((size_t)(ycol >> 5) * T_TOK + tokbase + tq) * 32 + 4 * hh;
#pragma unroll
    for (int g = 0; g < 4; ++g) {
        *(h4*)(dst + 8 * g) = pack4(O0[4 * g] * inv, O0[4 * g + 1] * inv, O0[4 * g + 2] * inv, O0[4 * g + 3] * inv);
        *(h4*)(dst + (size_t)T_TOK * 32 + 8 * g) = pack4(O1[4 * g] * inv, O1[4 * g + 1] * inv, O1[4 * g + 2] * inv, O1[4 * g + 3] * inv);
    }
}

#ifndef ATT_MASK
#define ATT_MASK 3
#endif
__device__ __forceinline__ void phase_attn(KP p, char* lds, int tm) {
    const int G_ = gridDim.x, per_ = G_ >> 3;
    const bool snake_ = (G_ >= 8) && ((G_ & 7) == 0);
    for (int k_ = 0, b_ = BID(); snake_ ? (k_ * per_ < 384) : (b_ + k_ * G_ < 3072); ++k_) {
        int xl, Lx;
        if (snake_) { const int idx_ = b_ >> 3; xl = b_ & 7; Lx = k_ * per_ + ((k_ & 1) ? (per_ - 1 - idx_) : idx_); }
        else { const int u = b_ + k_ * G_; xl = u & 7; Lx = u >> 3; }
        if (Lx >= 384) continue;
        const int qt = 15 - (Lx / 24), rem = Lx % 24;
        const int type = rem & 1, bh = xl * 12 + (rem >> 1);
        if (type == 0) { if (tm & 1) attn_unit<0>(p, lds, bh / 6, bh % 6, qt); }
        else { if (tm & 2) attn_unit<1>(p, lds, bh / 6, bh % 6, qt); }
    }
}

__global__ void __launch_bounds__(256, 2) mk_fwd(Params p_unused) {
    extern __shared__ __attribute__((aligned(16))) char lds[];
    volatile LAS unsigned* stw = (volatile LAS unsigned*)(lds + LDS_CTL);
    if (threadIdx.x < 4) stw[threadIdx.x] = 0u;
    __syncthreads();
    KP p0 = (KP)__builtin_amdgcn_kernarg_segment_ptr();
    XcdBarrier bar; bar.bar = p0->bar; bar.x = 0; bar.st = stw;
#if !MK_SPLIT
    bar = xcd_barrier_post(p0->bar, stw);
#endif
    const int ph_lo = p0->ph_lo, ph_hi = p0->ph_hi;
    for (int ph = ph_lo; ph < ph_hi; ++ph) {
      KP p = p0; asm volatile("" : "+s"(p));
      const int nrep = (DUP_SUB >= 0 && ((DUP_SUB == 100 && ph == 0) || (ph >= 2 && ph < NPHASE - 1 && ((ph - 2) & 7) == DUP_SUB && (DUP_SUB != 4 || ph < 10)))) ? 2 : 1;
      for (int rep = 0; rep < nrep; ++rep) {
        if (ph == 0) phase_prologue(p, lds);
        else if (ph == 1) phase_modsum(p);
        else if (ph == NPHASE - 1) phase_norm<2>(p, lds, p->out, p->g_final, nullptr, nullptr, 0);
        else {
            const int l = (ph - 2) >> 3, sub = (ph - 2) & 7;
            const float* mf = p->modf + (size_t)l * 16 * 6144;
            const float* xin = l == 0 ? p->x : p->out;
            if (sub == 0) phase_norm<0>(p, lds, xin, p->g_mix + l * DM, mf, mf + 1024, l);
            else if (sub == 1) phase_inproj(p, lds, l);
            else if (sub == 2) phase_post(p, lds, l, rep ? POST_MASK : 7);
            else if (sub == 3) phase_attn(p, lds, rep ? ATT_MASK : 3);
            else if (sub == 4) phase_outproj(p, lds, l, xin);
            else if (sub == 5) phase_norm<1>(p, lds, p->out, p->g_ffn + l * DM, mf + 3 * 1024, mf + 4 * 1024, (nrep == 2 && rep == 0) ? l + 2 : l);
            else if (sub == 6) phase_moe_up(p, lds, l);
            else phase_moe_down(p, lds, l, nrep == 2 ? 0.5f : 1.0f);
        }
      }
#if !MK_SPLIT
        if (ph + 1 < ph_hi) xcd_barrier(bar);
#endif
    }
}

extern "C" void kernel_launch(void* const* d_in, const int* in_sizes, int n_in, void* d_out, int out_size, void* d_ws, size_t ws_size, hipStream_t stream) {
    static int grid = 0;
    if (grid == 0) {
        int dev = 0, cus = 0, per_cu = 0;
        (void)hipGetDevice(&dev);
        (void)hipDeviceGetAttribute(&cus, hipDeviceAttributeMultiprocessorCount, dev);
        (void)hipFuncSetAttribute((const void*)mk_fwd, hipFuncAttributeMaxDynamicSharedMemorySize, LDS_BYTES);
        if (hipOccupancyMaxActiveBlocksPerMultiprocessor(&per_cu, (const void*)mk_fwd, 256, LDS_BYTES) != hipSuccess || per_cu < 1) per_cu = 1;
        (void)hipGetLastError();
        if (per_cu > 2) per_cu = 2;
        grid = cus * per_cu;
        fprintf(stderr, "mk_fwd: cus %d per_cu %d grid %d\n", cus, per_cu, grid);
    }
    Params p{};
    const float** pin = (const float**)&p.x;
    for (int i = 0; i < 18; ++i) pin[i] = (const float*)d_in[i];
    p.out = (float*)d_out;
    char* ws = (char*)d_ws;
    size_t off = 0;
    auto carve = [&](size_t bytes) { void* q = ws + off; off += (bytes + 255) & ~(size_t)255; return q; };
    p.bar = (unsigned*)carve(XCD_BAR_WORDS * 4);
    p.cnt = (int*)carve(4 * 32 * 64 * 4);
    const size_t zero_bytes = off;
    p.Wt_in = (half_t*)carve((size_t)2 * NP * DM * 2);
    p.Wt_o = (half_t*)carve((size_t)2 * DM * DM * 2);
    p.Wt_gu = (half_t*)carve((size_t)2 * 16 * 512 * 1024 * 2);
    p.Wt_d = (half_t*)carve((size_t)2 * 16 * 1024 * 256 * 2);
    p.hn = (half_t*)carve((size_t)T_TOK * DM * 2);
    p.P = (half_t*)carve((size_t)T_TOK * NP * 2);
    p.ycat = (half_t*)carve((size_t)T_TOK * DM * 2);
    p.act = (half_t*)carve((size_t)T_TOK * 512 * 2);
    p.modpart = (float*)carve((size_t)8 * 2 * 16 * 6144 * 4);
    p.modf = (float*)carve((size_t)2 * 16 * 6144 * 4);
    p.kmean = (float*)carve((size_t)16 * 6 * 8 * 64 * 4);
    p.rope = (float*)carve((size_t)2048 * 24 * 4);
    p.iwf = (float*)carve((size_t)T_TOK * 4 * 4);
    p.tokw = (float*)carve((size_t)T_TOK * 2 * 4);
    p.dmask = (unsigned*)carve((size_t)T_TOK * 64 * 4);
    p.lists = (int*)carve((size_t)NCLS * T_TOK * 4);
    if (off > ws_size) { fprintf(stderr, "workspace too small: need %zu have %zu\n", off, ws_size); return; }
    (void)hipMemsetAsync(d_ws, 0, zero_bytes, stream);
#if MK_SPLIT
    for (int ph = 0; ph < NPHASE; ++ph) {
        p.ph_lo = ph; p.ph_hi = ph + 1;
        hipLaunchKernelGGL(mk_fwd, dim3(grid), dim3(256), LDS_BYTES, stream, p);
    }
#else
    p.ph_lo = 0; p.ph_hi = NPHASE;
    hipLaunchKernelGGL(mk_fwd, dim3(grid), dim3(256), LDS_BYTES, stream, p);
#endif
}
```

```cpp
#include <hip/hip_runtime.h>
#include <cstdio>
#include <cstdint>

#ifndef MK_SPLIT
#define MK_SPLIT 0
#endif

#define T_TOK 32768
#define DM 1024
#define SEQ 2048
#define INW 2340
#define NP 2432
#define PC_CU 0
#define PC_CG 256
#define PC_DQ 512
#define PC_DK 896
#define PC_DV 960
#define PC_IQ 1024
#define PC_IK 1152
#define PC_IW 1184
#define PC_MQ 1280
#define PC_MK 1664
#define PC_MV 2048
#define LOG_THETA 13.122363377404328f
#define NCLS 24
#define LDS_CTL 73728
#define LDS_BYTES 78336
#define NPHASE 19
#ifndef DUP_SUB
#define DUP_SUB -1
#endif

typedef _Float16 half_t;
typedef _Float16 h8 __attribute__((ext_vector_type(8)));
typedef _Float16 h4 __attribute__((ext_vector_type(4)));
typedef short s4v __attribute__((ext_vector_type(4)));
typedef short s8v __attribute__((ext_vector_type(8)));
typedef float f16v __attribute__((ext_vector_type(16)));
typedef float f4v __attribute__((ext_vector_type(4)));
#define LAS __attribute__((address_space(3)))

struct Params {
    const float *x, *c, *w_ada, *b_ada, *g_mix, *w_in, *w_dw, *b_dw, *ln_g, *ln_b, *w_o, *g_ffn, *w_router, *b_router, *w_gate, *w_up, *w_down, *g_final;
    float* out;
    half_t *Wt_in, *Wt_o, *Wt_gu, *Wt_d, *hn, *P, *ycat, *act;
    float *modpart, *modf, *kmean, *rope, *iwf, *tokw;
    unsigned* dmask; int* cnt; int* lists; unsigned* bar;
    int ph_lo, ph_hi;
};

#define XB_TMO      128
#define XB_XCNT(j)  (256  + 64 * (j))
#define XB_XSUB(j)  (1280 + 64 * (j))
#define XB_XGEN(j)  (2304 + 64 * (j))
#define XB_TOP      3328
#define XB_TOPGEN   3392
#define XCD_BAR_WORDS 3456
#define XB_SPIN_CAP (1u << 20)
__device__ __forceinline__ unsigned xb_ld(unsigned* p)              { return __hip_atomic_load(p, __ATOMIC_RELAXED, __HIP_MEMORY_SCOPE_AGENT); }
__device__ __forceinline__ unsigned xb_add(unsigned* p, unsigned v) { return __hip_atomic_fetch_add(p, v, __ATOMIC_RELAXED, __HIP_MEMORY_SCOPE_AGENT); }
__device__ __forceinline__ unsigned xb_xcc_id() { return (unsigned)__builtin_amdgcn_s_getreg((3 << 11) | 20) & 0xFu; }
#define XB_SPIN(cond, bar) do { unsigned _sp = 0; while (cond) { __builtin_amdgcn_s_sleep(1); \
    if ((++_sp & 255u) == 0u) { if (xb_ld(&(bar)[XB_TMO])) break; if (_sp > XB_SPIN_CAP) { atomicAdd(&(bar)[XB_TMO], 1u); break; } } } } while (0)
struct XcdBarrier { unsigned* bar; unsigned x; volatile LAS unsigned* st; };
__device__ __forceinline__ XcdBarrier xcd_barrier_post(unsigned* bar, volatile LAS unsigned* st) {
    XcdBarrier b; b.bar = bar; b.x = xb_xcc_id(); b.st = st;
    if (threadIdx.x == 0) (void)xb_add(&bar[XB_XCNT(b.x)], 1u);
    return b;
}
__device__ __forceinline__ void xcd_barrier_complete(unsigned* bar, unsigned x, unsigned& nloc, unsigned& nx) {
    const unsigned G = gridDim.x * gridDim.y * gridDim.z;
    unsigned sum, cnt, mine, sp = 0u;
    for (;;) {
        sum = 0u; cnt = 0u; mine = 0u;
#pragma unroll
        for (unsigned j = 0; j < 16; ++j) { const unsigned c = xb_ld(&bar[XB_XCNT(j)]); sum += c; cnt += (c > 0u) ? 1u : 0u; mine = (j == x) ? c : mine; }
        if (sum == G) break;
        __builtin_amdgcn_s_sleep(1);
        if ((++sp & 255u) == 0u) { if (xb_ld(&bar[XB_TMO])) break; if (sp > XB_SPIN_CAP) { atomicAdd(&bar[XB_TMO], 1u); break; } }
    }
    nloc = mine > 0u ? mine : 1u; nx = cnt > 0u ? cnt : 1u;
}
__device__ __forceinline__ void xcd_barrier(const XcdBarrier& b) {
    asm volatile("s_waitcnt vmcnt(0)" ::: "memory");
    __syncthreads();
    if (threadIdx.x == 0) {
        unsigned* bar = b.bar;
        __builtin_amdgcn_s_waitcnt(0);
        unsigned nloc = b.st[0], nx = b.st[1];
        if (nloc == 0u) { xcd_barrier_complete(bar, b.x, nloc, nx); b.st[0] = nloc; b.st[1] = nx; }
        const unsigned old = xb_add(&bar[XB_XSUB(b.x)], 1u);
        const unsigned gen = old / nloc;
        if (old + 1u == (gen + 1u) * nloc) {
            __builtin_amdgcn_fence(__ATOMIC_RELEASE, "agent");
            asm volatile("s_waitcnt vmcnt(0)" ::: "memory");
            const unsigned og = xb_add(&bar[XB_TOP], 1u);
            const unsigned tg = og / nx;
            if (og + 1u == (tg + 1u) * nx) xb_add(&bar[XB_TOPGEN], 1u);
            else XB_SPIN(xb_ld(&bar[XB_TOPGEN]) == tg, bar);
            __builtin_amdgcn_fence(__ATOMIC_ACQUIRE, "agent");
            xb_add(&bar[XB_XGEN(b.x)], 1u);
            asm volatile("s_waitcnt vmcnt(0)" ::: "memory");
        } else {
            XB_SPIN(xb_ld(&bar[XB_XGEN(b.x)]) == gen, bar);
            __builtin_amdgcn_fence(__ATOMIC_ACQUIRE, "agent");
            asm volatile("s_waitcnt vmcnt(0)" ::: "memory");
        }
    }
    __syncthreads();
}

typedef const __attribute__((address_space(4))) Params* KP;
__device__ __forceinline__ int TID() { int t = threadIdx.x; asm volatile("" : "+v"(t)); return t; }
__device__ __forceinline__ int BID() { int b = blockIdx.x; asm volatile("" : "+s"(b)); return b; }
__device__ __forceinline__ float sigmoidf_(float v) { return __builtin_amdgcn_rcpf(1.0f + __expf(-v)); }
__device__ __forceinline__ void glds16(const void* g, char* l) { __builtin_amdgcn_global_load_lds((const unsigned*)g, (unsigned*)l, 16, 0, 0); }
__device__ __forceinline__ unsigned f2sortable(float f) { unsigned u = __float_as_uint(f); return (u & 0x80000000u) ? ~u : (u | 0x80000000u); }
__device__ __forceinline__ h4 pack4(float a, float b, float c, float d) { h4 r = {(half_t)a, (half_t)b, (half_t)c, (half_t)d}; return r; }

template <class CF>
__device__ __forceinline__ void conv_tile_panel(char* lds, CF colf, int src_ld, int k0, int n0, half_t* dst, int nrows) {
    float* tl = (float*)lds;
    const int tid = TID();
    __syncthreads();
    {
        const int nn = tid & 63;
        const float* cp = colf(nn);
        float tv[16];
#pragma unroll
        for (int i = 0; i < 16; ++i) { const int k = i * 4 + (tid >> 6); tv[i] = cp ? cp[(size_t)(k0 + k) * src_ld] : 0.f; }
#pragma unroll
        for (int i = 0; i < 16; ++i) { const int k = i * 4 + (tid >> 6); tl[k * 65 + nn] = tv[i]; }
    }
    __syncthreads();
    {
        const int n = tid >> 2, kq = (tid & 3) * 16;
        h8 a, b;
#pragma unroll
        for (int j = 0; j < 8; ++j) { a[j] = (half_t)tl[(kq + j) * 65 + n]; b[j] = (half_t)tl[(kq + 8 + j) * 65 + n]; }
        const int k = k0 + kq;
        h8* d = (h8*)(dst + ((size_t)(k >> 5) * nrows + n0 + n) * 32 + (k & 31));
        d[0] = a; d[1] = b;
    }
}
template <class CF>
__device__ __forceinline__ void conv_tile(char* lds, CF colf, int src_ld, int k0, half_t* dst_tile  , int dstK) {
    float* tl = (float*)lds;
    const int tid = TID();
    __syncthreads();
    {
        const int nn = tid & 63;
        const float* cp = colf(nn);
        float tv[16];
#pragma unroll
        for (int i = 0; i < 16; ++i) { const int k = i * 4 + (tid >> 6); tv[i] = cp ? cp[(size_t)(k0 + k) * src_ld] : 0.f; }
#pragma unroll
        for (int i = 0; i < 16; ++i) { const int k = i * 4 + (tid >> 6); tl[k * 65 + nn] = tv[i]; }
    }
    __syncthreads();
    {
        const int n = tid >> 2, kq = (tid & 3) * 16;
        h8 a, b;
#pragma unroll
        for (int j = 0; j < 8; ++j) { a[j] = (half_t)tl[(kq + j) * 65 + n]; b[j] = (half_t)tl[(kq + 8 + j) * 65 + n]; }
        h8* d = (h8*)(dst_tile + (size_t)n * dstK + kq);
        d[0] = a; d[1] = b;
    }
}

__device__ __forceinline__ void phase_prologue(KP p, char* lds) {
    const int tid = TID();
    const int NA = 2 * 16 * 38, NB = 2 * 16 * 16, NC = 2 * 16 * 16 * 8, ND = 2 * 16 * 4 * 16, NE = 384, NF = 8;
    const int total = NA + NB + NC + ND + NE + NF;
    for (int u0 = BID(); u0 < total; u0 += gridDim.x) {
        int u = u0;
        if (u < NA) {
            const int nt = u % 38, kt = (u / 38) % 16, l = u / (38 * 16);
            const float* src = p->w_in + (size_t)l * DM * INW;
            const int n0 = nt * 64;
            conv_tile_panel(lds, [&](int nn) -> const float* { const int np = n0 + nn; const int sc = np < 512 ? (((np & 63) < 32) ? 32 * (np >> 6) + (np & 31) : 256 + 32 * (np >> 6) + (np & 31)) : (np < 1188 ? np : (np < 1280 ? -1 : np - 92)); return sc >= 0 ? src + sc : (const float*)nullptr; },
                      INW, kt * 64, n0, p->Wt_in + (size_t)l * NP * DM, NP);
            continue;
        }
        u -= NA;
        if (u < NB) {
            const int nt = u % 16, kt = (u / 16) % 16, l = u / 256;
            const float* src = p->w_o + (size_t)l * DM * DM + nt * 64;
            conv_tile_panel(lds, [&](int nn) -> const float* { return src + nn; }, DM, kt * 64, nt * 64, p->Wt_o + (size_t)l * DM * DM, DM);
            continue;
        }
        u -= NB;
        if (u < NC) {
            const int nt = u % 8, kt = (u / 8) % 16, le = u / 128;
            const float* sg = p->w_gate + (size_t)le * 1024 * 256 + nt * 32;
            const float* su = p->w_up + (size_t)le * 1024 * 256 + nt * 32;
            conv_tile(lds, [&](int nn) -> const float* { return nn < 32 ? sg + nn : su + (nn - 32); }, 256, kt * 64, p->Wt_gu + ((size_t)le * 512 + nt * 64) * 1024 + kt * 64, 1024);
            continue;
        }
        u -= NC;
        if (u < ND) {
            const int nt = u % 16, kt = (u / 16) % 4, le = u / 64;
            const float* src = p->w_down + (size_t)le * 256 * 1024 + nt * 64;
            conv_tile(lds, [&](int nn) -> const float* { return src + nn; }, 1024, kt * 64, p->Wt_d + ((size_t)le * 1024 + nt * 64) * 256 + kt * 64, 256);
            continue;
        }
        u -= ND;
        if (u < NE) {
            const int kc = u % 8, cc = (u / 8) % 24, l = u / 192;
            float* ca = (float*)lds;
            __syncthreads();
            for (int i = tid; i < 2048; i += 256) { const int b = i >> 7, k = i & 127; const float v = p->c[b * 1024 + kc * 128 + k]; ca[i] = v / (1.0f + expf(-v)); }
            __syncthreads();
            const int n = cc * 256 + tid;
            float acc[16];
#pragma unroll
            for (int b = 0; b < 16; ++b) acc[b] = 0.f;
            const float* w = p->w_ada + ((size_t)l * 1024 + kc * 128) * 6144 + n;
#pragma unroll 16
            for (int k = 0; k < 128; ++k) {
                const float wv = w[(size_t)k * 6144];
#pragma unroll
                for (int b = 0; b < 16; ++b) acc[b] = fmaf(ca[b * 128 + k], wv, acc[b]);
            }
#pragma unroll
            for (int b = 0; b < 16; ++b) p->modpart[(((size_t)kc * 2 + l) * 16 + b) * 6144 + n] = acc[b];
            continue;
        }
        u -= NE;
        {
            for (int i = u * 256 + tid; i < 2048 * 12; i += NF * 256) {
                const int t = i / 12, r = i % 12;
                const int fi = r < 8 ? r : r - 8;
                const float rot = r < 8 ? 16.f : 8.f;
                const float inv = expf(-LOG_THETA * ((float)fi * 2.0f / rot));
                const float ang = (float)t * inv;
                float sn, cs; sincosf(ang, &sn, &cs);
                if (r < 8) { p->rope[t * 8 + fi] = cs; p->rope[16384 + t * 8 + fi] = sn; }
                else { p->rope[32768 + t * 4 + fi] = cs; p->rope[32768 + 8192 + t * 4 + fi] = sn; }
            }
        }
    }
}

__device__ __forceinline__ void phase_modsum(KP p) {
    for (int i = BID() * 256 + TID(); i < 2 * 16 * 6144; i += gridDim.x * 256) {
        const int n = i % 6144, l = i / (16 * 6144);
        float s = p->b_ada[l * 6144 + n];
#pragma unroll
        for (int kc = 0; kc < 8; ++kc) s += p->modpart[(size_t)kc * (2 * 16 * 6144) + i];
        p->modf[i] = s;
    }
}

__device__ __forceinline__ void route_flush(KP p, char* lds, int lane, int wave, int n, int myrow, int layer) {
    const float* lg = (const float*)(lds + LDS_CTL + 512) + wave * 256;
    int* lc = (int*)(lds + LDS_CTL + 64);
    int* lbase = lc + 32;
    const int tid = wave * 64 + lane;
    if (tid < 32) lc[tid] = 0;
    __syncthreads();
    int cls = 0, lpos = 0;
    if (lane < n) {
        float aff[16], bia[16];
#pragma unroll
        for (int e = 0; e < 16; ++e) { aff[e] = 1.0f / (1.0f + expf(-lg[lane * 16 + e])); bia[e] = aff[e] + p->b_router[e]; }
        int bestg = 0; float bests = -INFINITY;
#pragma unroll
        for (int gi = 0; gi < 4; ++gi) {
            float m1 = -INFINITY, m2 = -INFINITY;
#pragma unroll
            for (int j = 0; j < 4; ++j) { const float vv = bia[gi * 4 + j]; if (vv > m1) { m2 = m1; m1 = vv; } else if (vv > m2) m2 = vv; }
            const float s = m1 + m2;
            if (s > bests) { bests = s; bestg = gi; }
        }
        float bsel[4], asel[4];
#pragma unroll
        for (int j = 0; j < 4; ++j) { bsel[j] = 0.f; asel[j] = 0.f; }
#pragma unroll
        for (int gi = 0; gi < 4; ++gi) if (gi == bestg) {
#pragma unroll
            for (int j = 0; j < 4; ++j) { bsel[j] = bia[gi * 4 + j]; asel[j] = aff[gi * 4 + j]; }
        }
        int i1 = -1, i2 = -1; float v1 = -INFINITY, v2 = -INFINITY;
#pragma unroll
        for (int j = 0; j < 4; ++j) { const float vv = bsel[j]; if (vv > v1) { v2 = v1; i2 = i1; v1 = vv; i1 = j; } else if (vv > v2) { v2 = vv; i2 = j; } }
        const int a = i1 < i2 ? i1 : i2, bb = i1 < i2 ? i2 : i1;
        float wa = 0.f, wb = 0.f;
#pragma unroll
        for (int j = 0; j < 4; ++j) { if (j == a) wa = asel[j]; if (j == bb) wb = asel[j]; }
        const float sw = wa + wb;
        const int pi = (a == 0) ? (bb - 1) : (a == 1 ? (bb + 1) : 5);
        cls = bestg * 6 + pi;
        *(float2*)(p->tokw + (size_t)myrow * 2) = make_float2(wa / sw, wb / sw);
        lpos = atomicAdd(&lc[cls], 1);
    }
    __syncthreads();
    if (tid < NCLS) { const int c = lc[tid]; lbase[tid] = c ? atomicAdd(&p->cnt[(layer * 32 + tid) * 64], c) : 0; }
    __syncthreads();
    if (lane < n) p->lists[(size_t)cls * T_TOK + lbase[cls] + lpos] = myrow;
}

template <int MODE>
__device__ __forceinline__ void phase_norm(KP p, char* lds, const float* xin, const float* g, const float* sh, const float* sc, int layer) {
    const int lane = TID() & 63, wave = TID() >> 6;
    float* wt = (float*)lds;
    if (MODE == 1) {
        __syncthreads();
        for (int i = TID(); i < 4096; i += 256) {
            const float4 w4 = ((const float4*)p->w_router)[i];
            const int k = i >> 2, e0 = (i & 3) * 4;
            wt[(e0 + 0) * 1024 + k] = w4.x; wt[(e0 + 1) * 1024 + k] = w4.y; wt[(e0 + 2) * 1024 + k] = w4.z; wt[(e0 + 3) * 1024 + k] = w4.w;
        }
        __syncthreads();
    }
    float* lgb = (float*)(lds + LDS_CTL + 512);
    int myrow = 0, it = 0;
    float4 vn[4];
    {
        const int row0 = BID() * 4 + wave;
        const float4* xr = (const float4*)(xin + (size_t)(row0 < T_TOK ? row0 : 0) * DM);
#pragma unroll
        for (int i = 0; i < 4; ++i) vn[i] = xr[lane + 64 * i];
    }
    for (int row = BID() * 4 + wave; row < T_TOK; row += gridDim.x * 4) {
        const int b = row >> 11;
        float4 v[4]; float ss = 0.f;
#pragma unroll
        for (int i = 0; i < 4; ++i) v[i] = vn[i];
        {
            const int rown = row + gridDim.x * 4;
            const float4* xr = (const float4*)(xin + (size_t)(rown < T_TOK ? rown : row) * DM);
#pragma unroll
            for (int i = 0; i < 4; ++i) vn[i] = xr[lane + 64 * i];
        }
#pragma unroll
        for (int i = 0; i < 4; ++i) ss += v[i].x * v[i].x + v[i].y * v[i].y + v[i].z * v[i].z + v[i].w * v[i].w;
#pragma unroll
        for (int o = 32; o >= 1; o >>= 1) ss += __shfl_xor(ss, o);
        const float rstd = 1.0f / sqrtf(ss * (1.0f / 1024.0f) + 1e-6f);
        float acc[16], ya[16];
#pragma unroll
        for (int i = 0; i < 4; ++i) {
            const int k = (lane + 64 * i) * 4;
            const float4 gg = *(const float4*)(g + k);
            float y[4] = {v[i].x * rstd * gg.x, v[i].y * rstd * gg.y, v[i].z * rstd * gg.z, v[i].w * rstd * gg.w};
            if (MODE != 2) {
                const float4 s1 = *(const float4*)(sh + (size_t)b * 6144 + k), s2 = *(const float4*)(sc + (size_t)b * 6144 + k);
                y[0] = y[0] * (1.f + s2.x) + s1.x; y[1] = y[1] * (1.f + s2.y) + s1.y; y[2] = y[2] * (1.f + s2.z) + s1.z; y[3] = y[3] * (1.f + s2.w) + s1.w;
                if (MODE == 0) *(h4*)(p->hn + ((size_t)(k >> 5) * T_TOK + row) * 32 + (k & 31)) = pack4(y[0], y[1], y[2], y[3]);
                else *(h4*)(p->hn + (size_t)row * DM + k) = pack4(y[0], y[1], y[2], y[3]);
            } else {
                *(float4*)(p->out + (size_t)row * DM + k) = make_float4(y[0], y[1], y[2], y[3]);
            }
            ya[4 * i] = y[0]; ya[4 * i + 1] = y[1]; ya[4 * i + 2] = y[2]; ya[4 * i + 3] = y[3];
        }
        if (MODE == 1) {
#pragma unroll
            for (int e = 0; e < 16; ++e) acc[e] = 0.f;
            float4 wq[2][4];
            const float* wl = wt + lane * 4;
#pragma unroll
            for (int e = 0; e < 4; ++e) wq[0][e] = *(const float4*)(wl + e * 1024);
#pragma unroll
            for (int st = 0; st < 16; ++st) {
                const int i = st >> 2, eg = st & 3, cur = st & 1;
                if (st + 1 < 16) {
                    const int i2 = (st + 1) >> 2, eg2 = (st + 1) & 3;
#pragma unroll
                    for (int e = 0; e < 4; ++e) wq[cur ^ 1][e] = *(const float4*)(wl + (eg2 * 4 + e) * 1024 + i2 * 256);
                }
#pragma unroll
                for (int e = 0; e < 4; ++e) {
                    const float4 w4 = wq[cur][e];
                    acc[eg * 4 + e] = fmaf(ya[4 * i], w4.x, fmaf(ya[4 * i + 1], w4.y, fmaf(ya[4 * i + 2], w4.z, fmaf(ya[4 * i + 3], w4.w, acc[eg * 4 + e]))));
                }
                __builtin_amdgcn_sched_barrier(0);
            }
        }
        if (MODE == 1) {
            const bool b5 = lane & 32, b4 = lane & 16, b3 = lane & 8, b2 = lane & 4;
            float r8[8], r4[4], r2[2];
#pragma unroll
            for (int e = 0; e < 8; ++e) { const float snd = b5 ? acc[e] : acc[e + 8], kp = b5 ? acc[e + 8] : acc[e]; r8[e] = kp + __shfl_xor(snd, 32); }
#pragma unroll
            for (int e = 0; e < 4; ++e) { const float snd = b4 ? r8[e] : r8[e + 4], kp = b4 ? r8[e + 4] : r8[e]; r4[e] = kp + __shfl_xor(snd, 16); }
#pragma unroll
            for (int e = 0; e < 2; ++e) { const float snd = b3 ? r4[e] : r4[e + 2], kp = b3 ? r4[e + 2] : r4[e]; r2[e] = kp + __shfl_xor(snd, 8); }
            float rv; { const float snd = b2 ? r2[0] : r2[1], kp = b2 ? r2[1] : r2[0]; rv = kp + __shfl_xor(snd, 4); }
            rv += __shfl_xor(rv, 2); rv += __shfl_xor(rv, 1);
            if ((lane & 3) == 0) lgb[(wave * 16 + it) * 16 + (lane >> 2)] = rv;
            if (lane == it) myrow = row;
            ++it;
            if (it == 16) { route_flush(p, lds, lane, wave, it, myrow, layer); it = 0; }
        }
    }
    if (MODE == 1 && it > 0) route_flush(p, lds, lane, wave, it, myrow, layer);
}

template <class WF, class XF, class EPI>
__device__ __forceinline__ void gemm_tile(char* lds, int nkt, WF wf, XF xf, EPI epi) {
    const int tid = TID(), lane = tid & 63, wave = tid >> 6;
    const int wn = wave & 1, wm = wave >> 1, hh = lane >> 5;
    const int lrow = tid >> 3;
    const int lchunk = (tid & 7) ^ ((tid >> 4) & 7);
    const half_t* xs[4];
#pragma unroll
    for (int i = 0; i < 4; ++i) xs[i] = xf(lrow + 32 * i) + lchunk * 8;
    char* ldst = lds + lrow * 128 + (tid & 7) * 16;
    f16v acc[2][2];
#pragma unroll
    for (int i = 0; i < 2; ++i)
#pragma unroll
        for (int j = 0; j < 2; ++j)
#pragma unroll
            for (int r = 0; r < 16; ++r) acc[i][j][r] = 0.f;
    auto issue = [&](int kt, int s) {
        char* d = ldst + s * 32768;
#pragma unroll
        for (int i = 0; i < 4; ++i) glds16(wf(kt, lrow + 32 * i) + lchunk * 8, d + i * 4096);
#pragma unroll
        for (int i = 0; i < 4; ++i) glds16(xs[i] + kt * 64, d + 16384 + i * 4096);
    };
    __syncthreads();
    issue(0, 0);
    const int rsw = (lane >> 1) & 7;
    const int roff_w = (wn * 64 + (lane & 31)) * 128, roff_x = 16384 + (wm * 64 + (lane & 31)) * 128;
    for (int kt = 0; kt < nkt; ++kt) {
        asm volatile("s_waitcnt vmcnt(0)" ::: "memory");
        __syncthreads();
        if (kt + 1 < nkt) issue(kt + 1, (kt + 1) & 1);
        const char* base = lds + (kt & 1) * 32768;
#pragma unroll
        for (int ks = 0; ks < 4; ++ks) {
            const int co = ((2 * ks + hh) ^ rsw) << 4;
            const h8 a0 = *(const h8*)(base + roff_w + co), a1 = *(const h8*)(base + roff_w + 4096 + co);
            const h8 b0 = *(const h8*)(base + roff_x + co), b1 = *(const h8*)(base + roff_x + 4096 + co);
            acc[0][0] = __builtin_amdgcn_mfma_f32_32x32x16_f16(a0, b0, acc[0][0], 0, 0, 0);
            acc[0][1] = __builtin_amdgcn_mfma_f32_32x32x16_f16(a0, b1, acc[0][1], 0, 0, 0);
            acc[1][0] = __builtin_amdgcn_mfma_f32_32x32x16_f16(a1, b0, acc[1][0], 0, 0, 0);
            acc[1][1] = __builtin_amdgcn_mfma_f32_32x32x16_f16(a1, b1, acc[1][1], 0, 0, 0);
        }
    }
    epi(acc, wn, wm, lane);
}

template <class WF, class XF, class EPI>
__device__ __forceinline__ void gemm_tile2(char* lds, int nkt, size_t xkstride, WF wf, XF xf, EPI epi) {
    const int tid = TID(), lane = tid & 63, wave = tid >> 6;
    const int wn = wave & 1, wm = wave >> 1, hh = lane >> 5;
    const int lrow = tid >> 2;
    const int lchunk = (tid & 3) ^ ((tid >> 4) & 3);
    const half_t* xs[2];
#pragma unroll
    for (int i = 0; i < 2; ++i) xs[i] = xf(lrow + 64 * i) + lchunk * 8;
    char* ldst = lds + lrow * 64 + (tid & 3) * 16;
    f16v acc[4][2];
#pragma unroll
    for (int i = 0; i < 4; ++i)
#pragma unroll
        for (int j = 0; j < 2; ++j)
#pragma unroll
            for (int r = 0; r < 16; ++r) acc[i][j][r] = 0.f;
    auto issue = [&](int kt, int s) {
        char* d = ldst + s * 24576;
#pragma unroll
        for (int i = 0; i < 4; ++i) glds16(wf(kt, lrow + 64 * i) + lchunk * 8, d + i * 4096);
#pragma unroll
        for (int i = 0; i < 2; ++i) glds16(xs[i] + (size_t)kt * xkstride, d + 16384 + i * 4096);
    };
    __syncthreads();
    issue(0, 0); issue(1, 1);
    const int rsw = (lane >> 2) & 3;
    const int roff_w = (wn * 128 + (lane & 31)) * 64, roff_x = 16384 + (wm * 64 + (lane & 31)) * 64;
    int st = 0;
    for (int kt = 0; kt < nkt; ++kt) {
        if (kt + 1 < nkt) asm volatile("s_waitcnt vmcnt(6)" ::: "memory");
        else asm volatile("s_waitcnt vmcnt(0)" ::: "memory");
        asm volatile("s_waitcnt lgkmcnt(0)" ::: "memory");
        __builtin_amdgcn_s_barrier();
        if (kt + 2 < nkt) issue(kt + 2, st >= 1 ? st - 1 : 2);
        const char* base = lds + st * 24576;
        st = st == 2 ? 0 : st + 1;
#pragma unroll
        for (int ks = 0; ks < 2; ++ks) {
            const int co = ((2 * ks + hh) ^ rsw) << 4;
            h8 a[4], b[2];
#pragma unroll
            for (int i = 0; i < 4; ++i) a[i] = *(const h8*)(base + roff_w + i * 2048 + co);
#pragma unroll
            for (int j = 0; j < 2; ++j) b[j] = *(const h8*)(base + roff_x + j * 2048 + co);
#pragma unroll
            for (int i = 0; i < 4; ++i)
#pragma unroll
                for (int j = 0; j < 2; ++j) acc[i][j] = __builtin_amdgcn_mfma_f32_32x32x16_f16(a[i], b[j], acc[i][j], 0, 0, 0);
        }
    }
    epi(acc, wn, wm, lane);
}

__device__ __forceinline__ void phase_inproj(KP p, char* lds, int l) {
    const half_t* W = p->Wt_in + (size_t)l * NP * DM;
    const float* rc16 = p->rope; const float* rs16 = p->rope + 16384; const float* rc8 = p->rope + 32768; const float* rs8 = p->rope + 32768 + 8192;
    for (int u = BID(); u < 256 * 10; u += gridDim.x) {
        const int xl = u & 7, Lx = u >> 3, mi = Lx & 15, rr_ = Lx >> 4;
        const int nt = rr_ % 10, mt = 32 * xl + 16 * (rr_ / 10) + mi;
        gemm_tile2(lds, 32, (size_t)T_TOK * 32,
            [&](int kt, int row) { int n = nt * 256 + row; n = n < NP ? n : NP - 1; return W + ((size_t)kt * NP + n) * 32; },
            [&](int row) { return p->hn + (size_t)(mt * 128 + row) * 32; },
            [&](f16v (&acc)[4][2], int wn, int wm, int lane) {
                const int hh = lane >> 5;
                half_t* stg = (half_t*)lds;
                __syncthreads();
#pragma unroll
                for (int i = 0; i < 4; ++i) {
                    const int nb = nt * 256 + wn * 128 + i * 32;
                    if (nb == 1216 || nb == 1248 || nb >= NP) continue;
                    if (nt < 2) {
                        if (i & 1) continue;
#pragma unroll
                        for (int j = 0; j < 2; ++j) {
                            half_t* dst = stg + (wm * 64 + j * 32 + (lane & 31)) * 260 + wn * 64 + (i >> 1) * 32 + 4 * hh;
#pragma unroll
                            for (int g = 0; g < 4; ++g) {
                                float a4[4];
#pragma unroll
                                for (int r = 0; r < 4; ++r) a4[r] = acc[i][j][4 * g + r] * sigmoidf_(acc[i + 1][j][4 * g + r]);
                                *(h4*)(dst + 8 * g) = pack4(a4[0], a4[1], a4[2], a4[3]);
                            }
                        }
                        continue;
                    }
                    const bool rope64 = ((nb >= PC_DQ && nb < PC_DV) || (nb >= PC_MQ && nb < PC_MV)) && ((nb & 63) == 0);
                    const bool rope32 = (nb >= PC_IQ && nb < PC_IW);
#pragma unroll
                    for (int j = 0; j < 2; ++j) {
                        const int tok = mt * 128 + wm * 64 + j * 32 + (lane & 31);
                        const int t = tok & 2047;
                        f16v v = acc[i][j];
                        if (nb == PC_IW) { if (hh == 0) *(float4*)(p->iwf + (size_t)tok * 4) = make_float4(v[0], v[1], v[2], v[3]); continue; }
                        if (rope64) {
                            const float4 c4 = *(const float4*)(rc16 + t * 8 + 4 * hh), s4 = *(const float4*)(rs16 + t * 8 + 4 * hh);
                            const float cc[4] = {c4.x, c4.y, c4.z, c4.w}, sn[4] = {s4.x, s4.y, s4.z, s4.w};
#pragma unroll
                            for (int r = 0; r < 4; ++r) { const float x1 = v[r], x2 = v[r + 4]; v[r] = x1 * cc[r] - x2 * sn[r]; v[r + 4] = x2 * cc[r] + x1 * sn[r]; }
                        } else if (rope32) {
                            const float4 c4 = *(const float4*)(rc8 + t * 4), s4 = *(const float4*)(rs8 + t * 4);
                            const float cc[4] = {c4.x, c4.y, c4.z, c4.w}, sn[4] = {s4.x, s4.y, s4.z, s4.w};
#pragma unroll
                            for (int r = 0; r < 4; ++r) { const float o = __shfl_xor(v[r], 32); v[r] = hh ? (v[r] * cc[r] + o * sn[r]) : (v[r] * cc[r] - o * sn[r]); }
                        }
                        if ((nb >= PC_DQ && nb < PC_DK) || (nb >= PC_MQ && nb < PC_MK)) {
#pragma unroll
                            for (int r = 0; r < 16; ++r) v[r] *= 0.18033688011112042f;
                        }
                        half_t* dst = stg + (wm * 64 + j * 32 + (lane & 31)) * 260 + wn * 128 + i * 32 + 4 * hh;
#pragma unroll
                        for (int g = 0; g < 4; ++g) *(h4*)(dst + 8 * g) = pack4(v[4 * g], v[4 * g + 1], v[4 * g + 2], v[4 * g + 3]);
                    }
                }
                __syncthreads();
                const int wv_ = TID() >> 6;
#pragma unroll 4
                for (int it = 0; it < 32; ++it) {
                    const int row = it * 4 + wv_;
                    const uint2 v2 = *(const uint2*)(stg + row * 260 + lane * 4);
                    if (nt < 2) { if (lane < 32) *(uint2*)(p->P + (size_t)(mt * 128 + row) * NP + nt * 128 + lane * 4) = v2; }
                    else { const int n = nt * 256 + lane * 4; if (n < NP) *(uint2*)(p->P + (size_t)(mt * 128 + row) * NP + n) = v2; }
                }
            });
    }
}

__device__ __forceinline__ void stage_acc_f32(char* lds, const f16v (&acc)[2][2], int wn, int wm, int lane) {
    float* stg = (float*)lds;
    const int hh = lane >> 5;
    __syncthreads();
#pragma unroll
    for (int j = 0; j < 2; ++j)
#pragma unroll
        for (int i = 0; i < 2; ++i)
#pragma unroll
            for (int g = 0; g < 4; ++g)
                *(float4*)(stg + (wm * 64 + j * 32 + (lane & 31)) * 132 + wn * 64 + i * 32 + 4 * hh + 8 * g) = make_float4(acc[i][j][4 * g], acc[i][j][4 * g + 1], acc[i][j][4 * g + 2], acc[i][j][4 * g + 3]);
    __syncthreads();
}
__device__ __forceinline__ void phase_outproj(KP p, char* lds, int l, const float* xin) {
    const half_t* W = p->Wt_o + (size_t)l * DM * DM;
    const float* g1 = p->modf + (size_t)l * 16 * 6144 + 2 * 1024;
    for (int u = BID(); u < 256 * 4; u += gridDim.x) {
        const int xl = u & 7, Lx = u >> 3, mi = Lx & 7, rr_ = Lx >> 3;
        const int nt = rr_ & 3, mt = 32 * xl + 8 * (rr_ >> 2) + mi;
        gemm_tile2(lds, 32, (size_t)T_TOK * 32,
            [&](int kt, int row) { return W + ((size_t)kt * DM + nt * 256 + row) * 32; },
            [&](int row) { return p->ycat + (size_t)(mt * 128 + row) * 32; },
            [&](f16v (&acc)[4][2], int wn, int wm, int lane) {
                const int hh = lane >> 5, tid = TID();
                float* stg = (float*)lds;
#pragma unroll
                for (int rnd = 0; rnd < 2; ++rnd) {
                    __syncthreads();
                    if (wm == rnd) {
#pragma unroll
                        for (int j = 0; j < 2; ++j)
#pragma unroll
                            for (int i = 0; i < 4; ++i)
#pragma unroll
                                for (int g = 0; g < 4; ++g)
                                    *(float4*)(stg + (j * 32 + (lane & 31)) * 260 + wn * 128 + i * 32 + 4 * hh + 8 * g) = make_float4(acc[i][j][4 * g], acc[i][j][4 * g + 1], acc[i][j][4 * g + 2], acc[i][j][4 * g + 3]);
                    }
                    __syncthreads();
#pragma unroll 4
                    for (int it = 0; it < 16; ++it) {
                        const int idx = it * 256 + tid, row = idx >> 6, c = idx & 63;
                        const int tok = mt * 128 + rnd * 64 + row, n = nt * 256 + 4 * c;
                        const float4 a4 = *(const float4*)(stg + row * 260 + 4 * c);
                        const float4 xi = *(const float4*)(xin + (size_t)tok * DM + n);
                        const float4 gg = *(const float4*)(g1 + (size_t)(tok >> 11) * 6144 + n);
                        float4 o; o.x = xi.x + gg.x * a4.x; o.y = xi.y + gg.y * a4.y; o.z = xi.z + gg.z * a4.z; o.w = xi.w + gg.w * a4.w;
                        *(float4*)(p->out + (size_t)tok * DM + n) = o;
                    }
                }
            });
    }
}

__device__ __forceinline__ bool moe_tile(const int* cnt, int tile, int& cls, int& pos0, int& n) {
    int tb = 0;
    for (int c = 0; c < NCLS; ++c) {
        const int nc = cnt[c * 64], nt = (nc + 127) >> 7;
        if (tile < tb + nt) { cls = c; pos0 = (tile - tb) * 128; n = nc; return true; }
        tb += nt;
    }
    return false;
}
__device__ __forceinline__ void cls_experts(int cls, int& e1, int& e2) {
    const int g = cls / 6, pi = cls % 6;
    const int a = pi < 3 ? 0 : (pi < 5 ? 1 : 2);
    const int b = pi < 3 ? pi + 1 : (pi < 5 ? pi - 1 : 3);
    e1 = g * 4 + a; e2 = g * 4 + b;
}
__device__ __forceinline__ void phase_moe_up(KP p, char* lds, int l) {
    const int* cnt = p->cnt + l * 32 * 64;
    for (int u = BID(); u < (256 + NCLS) * 8; u += gridDim.x) {
        const int xl = u & 7, Lx = u >> 3;
        const int nt = Lx & 7, tile = (Lx >> 3) * 8 + xl;
        int cls, pos0, nc;
        if (!moe_tile(cnt, tile, cls, pos0, nc)) continue;
        int e1, e2; cls_experts(cls, e1, e2);
        const int slot = nt >> 2;
        const half_t* W = p->Wt_gu + ((size_t)(l * 16 + (slot ? e2 : e1)) * 512 + (nt & 3) * 128) * 1024;
        const int* lst = p->lists + (size_t)cls * T_TOK + pos0;
        const int nvalid = nc - pos0;
        gemm_tile(lds, 16,
            [&](int kt, int row) { return W + (size_t)row * 1024 + kt * 64; },
            [&](int row) { const int tok = lst[row < nvalid ? row : 0]; return p->hn + (size_t)tok * DM; },
            [&](f16v (&acc)[2][2], int wn, int wm, int lane) {
                const int hh = lane >> 5;
#pragma unroll
                for (int j = 0; j < 2; ++j) {
                    const int row = wm * 64 + j * 32 + (lane & 31);
                    if (row < nvalid) {
                        const int tok = lst[row];
                        const float wgt = p->tokw[(size_t)tok * 2 + slot];
                        half_t* dst = p->act + (size_t)tok * 512 + slot * 256 + ((nt & 3) * 2 + wn) * 32 + 4 * hh;
#pragma unroll
                        for (int g = 0; g < 4; ++g) {
                            float a[4];
#pragma unroll
                            for (int r = 0; r < 4; ++r) { const float gv = acc[0][j][4 * g + r], uv = acc[1][j][4 * g + r]; a[r] = gv * sigmoidf_(gv) * uv * wgt; }
                            *(h4*)(dst + 8 * g) = pack4(a[0], a[1], a[2], a[3]);
                        }
                    }
                }
            });
    }
}
__device__ __forceinline__ void phase_moe_down(KP p, char* lds, int l, float gsc) {
    const int* cnt = p->cnt + l * 32 * 64;
    const float* g2 = p->modf + (size_t)l * 16 * 6144 + 5 * 1024;
    for (int u = BID(); u < (256 + NCLS) * 8; u += gridDim.x) {
        const int xl = u & 7, Lx = u >> 3;
        const int nt = Lx & 7, tile = (Lx >> 3) * 8 + xl;
        int cls, pos0, nc;
        if (!moe_tile(cnt, tile, cls, pos0, nc)) continue;
        int e1, e2; cls_experts(cls, e1, e2);
        const half_t* W1 = p->Wt_d + ((size_t)(l * 16 + e1) * 1024 + nt * 128) * 256;
        const half_t* W2 = p->Wt_d + ((size_t)(l * 16 + e2) * 1024 + nt * 128) * 256;
        const int* lst = p->lists + (size_t)cls * T_TOK + pos0;
        const int nvalid = nc - pos0;
        gemm_tile(lds, 8,
            [&](int kt, int row) { return (kt < 4 ? W1 : W2) + (size_t)row * 256 + (kt & 3) * 64; },
            [&](int row) { const int tok = lst[row < nvalid ? row : 0]; return p->act + (size_t)tok * 512; },
            [&](f16v (&acc)[2][2], int wn, int wm, int lane) {
                const int hh = lane >> 5;
#pragma unroll
                for (int j = 0; j < 2; ++j) {
                    const int row = wm * 64 + j * 32 + (lane & 31);
                    if (row < nvalid) {
                        const int tok = lst[row];
                        const int b = tok >> 11;
#pragma unroll
                        for (int i = 0; i < 2; ++i) {
                            const int nb = nt * 128 + wn * 64 + i * 32 + 4 * hh;
#pragma unroll
                            for (int g = 0; g < 4; ++g) {
                                const int n = nb + 8 * g;
                                float4* xp = (float4*)(p->out + (size_t)tok * DM + n);
                                float4 xi = *xp;
                                const float4 gg = *(const float4*)(g2 + (size_t)b * 6144 + n);
                                xi.x += gsc * gg.x * acc[i][j][4 * g]; xi.y += gsc * gg.y * acc[i][j][4 * g + 1]; xi.z += gsc * gg.z * acc[i][j][4 * g + 2]; xi.w += gsc * gg.w * acc[i][j][4 * g + 3];
                                *xp = xi;
                            }
                        }
                    }
                }
            });
    }
}

__device__ __forceinline__ void dsa_select_unit(KP p, char* lds, int b, int qt) {
    unsigned* hist = (unsigned*)lds;
    unsigned* maskl = hist + 16 * 257 + 16;
    unsigned* stP = maskl + 1024;
    unsigned* stNeed = stP + 16;
    unsigned* stDone = stNeed + 16;
    unsigned* flag = stDone + 16;
    unsigned* dummyb = flag + 16;
    const int tid = TID(), lane = tid & 63, wave = tid >> 6;
    const int q0 = qt * 16, tokbase = b * SEQ;
    __syncthreads();
    if (q0 < 256) {
        for (int i = tid; i < 1024; i += 256) {
            const int q = i >> 6, wd = i & 63;
            const int n = q0 + q + 1 - 32 * wd;
            const unsigned w = n >= 32 ? 0xFFFFFFFFu : (n <= 0 ? 0u : ((1u << n) - 1u));
            p->dmask[(size_t)(tokbase + q0 + q) * 64 + wd] = w;
        }
        return;
    }
    for (int i = tid; i < 1024; i += 256) maskl[i] = 0u;
    if (tid < 16) { stP[tid] = 0u; stNeed[tid] = 256u; stDone[tid] = 0u; }
    for (int i = tid; i < 16 * 257; i += 256) hist[i] = 0u;
    __syncthreads();
    const int ql = lane & 15, fq = lane >> 4;
    const int tq = q0 + ql;
    const half_t* Pb = p->P + (size_t)tokbase * NP;
    h8 iqf[4];
#pragma unroll
    for (int hd = 0; hd < 4; ++hd) iqf[hd] = *(const h8*)(Pb + (size_t)tq * NP + PC_IQ + hd * 32 + 8 * fq);
    const float4 iw4 = *(const float4*)(p->iwf + (size_t)(tokbase + tq) * 4);
    const float wsc0 = iw4.x * 0.08838834764831845f, wsc1 = iw4.y * 0.08838834764831845f, wsc2 = iw4.z * 0.08838834764831845f, wsc3 = iw4.w * 0.08838834764831845f;
    const int ng = qt + 1;
    unsigned sc[32][4];
    const half_t* ikp = Pb + (size_t)ql * NP + PC_IK + 8 * fq;
#pragma unroll
    for (int gb = 0; gb < 4; ++gb) {
        h8 ik[8];
#pragma unroll
        for (int x = 0; x < 8; ++x) {
            int g = wave + 4 * (gb * 8 + x);
            g = g < ng ? g : ng - 1;
            ik[x] = *(const h8*)(ikp + (size_t)(16 * g) * NP);
        }
#pragma unroll
        for (int x = 0; x < 8; ++x) {
            const int gi = gb * 8 + x;
            const int g = wave + 4 * gi;
            const f4v z = {0.f, 0.f, 0.f, 0.f};
            const f4v c0 = __builtin_amdgcn_mfma_f32_16x16x32_f16(ik[x], iqf[0], z, 0, 0, 0);
            const f4v c1 = __builtin_amdgcn_mfma_f32_16x16x32_f16(ik[x], iqf[1], z, 0, 0, 0);
            const f4v c2 = __builtin_amdgcn_mfma_f32_16x16x32_f16(ik[x], iqf[2], z, 0, 0, 0);
            const f4v c3 = __builtin_amdgcn_mfma_f32_16x16x32_f16(ik[x], iqf[3], z, 0, 0, 0);
#pragma unroll
            for (int r = 0; r < 4; ++r) {
                const int j = 16 * g + 4 * fq + r;
                float sv = wsc0 * __builtin_amdgcn_fmed3f(c0[r], 0.f, INFINITY);
                sv = fmaf(wsc1, __builtin_amdgcn_fmed3f(c1[r], 0.f, INFINITY), sv);
                sv = fmaf(wsc2, __builtin_amdgcn_fmed3f(c2[r], 0.f, INFINITY), sv);
                sv = fmaf(wsc3, __builtin_amdgcn_fmed3f(c3[r], 0.f, INFINITY), sv);
                sv += 0.0f;
                const int sb = __float_as_int(sv);
                const unsigned su = (unsigned)sb ^ ((unsigned)(sb >> 31) | 0x80000000u);
                const unsigned ck = (su & 0xFFFFF800u) | (unsigned)(2047 - j);
                sc[gi][r] = (g < ng && j <= tq) ? ck : 0u;
            }
            if (g < ng) {
#pragma unroll
                for (int r = 0; r < 4; ++r) atomicAdd(hist + ql * 257 + (sc[gi][r] >> 24), 1u);
            }
        }
    }
    bool alldone = false;
    for (int pass = 0; pass < 5; ++pass) {
        const bool fin = alldone;
        if (!fin && pass > 0) { for (int i = tid; i < 16 * 257; i += 256) hist[i] = 0u; }
        if (tid == 0) *flag = 0u;
        __syncthreads();
        if (pass > 0) {
        const unsigned sP = stP[ql], sDone = stDone[ql];
        int wv = wave, fqv = fq;
        asm volatile("" : "+v"(wv), "+v"(fqv));
        if (fin) {
            const int sh = (int)(32u - 8u * (sDone ? sDone : 1u));
            unsigned* mrow = maskl + ql * 64;
#pragma unroll
            for (int gi = 0; gi < 32; ++gi) {
                const int g = wv + 4 * gi;
                unsigned nib = 0u;
#pragma unroll
                for (int r = 0; r < 4; ++r) {
                    const unsigned uu = sc[gi][r];
                    nib |= ((uu >> sh) >= sP) ? (1u << r) : 0u;
                }
                if (g < ng) atomicOr(&mrow[g >> 1], nib << ((g & 1) * 16 + 4 * fqv));
            }
        } else {
            const int shm = pass ? 32 - 8 * pass : 0, shd = 24 - 8 * pass;
            const unsigned orm = pass ? 0u : 0xFFFFFFFFu;
            const unsigned cmpv = pass ? (sDone == 0u ? sP : 0xFFFFFFFFu) : 0xFFFFFFFFu;
            unsigned* hrow = hist + ql * 257;
            unsigned* dummy = dummyb + lane;
#pragma unroll
            for (int gi = 0; gi < 32; ++gi) {
                const int g = wv + 4 * gi;
                if (g < ng) {
#pragma unroll
                    for (int r = 0; r < 4; ++r) {
                        const unsigned uu = sc[gi][r];
                        const bool match = (((uu >> shm) | orm) == cmpv);
                        const unsigned dig = (uu >> shd) & 255u;
                        unsigned* a = match ? hrow + dig : dummy;
                        atomicAdd(a, 1u);
                    }
                }
            }
        }
        }
        __syncthreads();
        if (fin) break;
        {
            const int qq = tid >> 4, seg = tid & 15;
            const bool active = (stDone[qq] == 0u);
            unsigned c16 = 0u;
            if (active) {
#pragma unroll
                for (int d = 0; d < 16; ++d) c16 += hist[qq * 257 + seg * 16 + d];
            }
            unsigned v = c16;
#pragma unroll
            for (int off = 1; off < 16; off <<= 1) { const unsigned t = __shfl_down(v, off, 16); if (seg + off < 16) v += t; }
            const unsigned suf = v - c16;
            const unsigned need = stNeed[qq];
            if (active && suf < need && need <= suf + c16) {
                unsigned run = suf, D = 0u, cD = 0u, nn = need;
                for (int d = 15; d >= 0; --d) {
                    const unsigned cc = hist[qq * 257 + seg * 16 + d];
                    if (run + cc >= need) { D = (unsigned)(seg * 16 + d); cD = cc; nn = need - run; break; }
                    run += cc;
                }
                const bool done = (cD == nn) || pass == 3;
                stP[qq] = (stP[qq] << 8) | D; stNeed[qq] = nn;
                if (done) stDone[qq] = (unsigned)(pass + 1); else atomicAdd(flag, 1u);
            }
        }
        __syncthreads();
        alldone = (*flag == 0u);
    }
    for (int i = tid; i < 1024; i += 256) p->dmask[(size_t)(tokbase + q0 + (i >> 6)) * 64 + (i & 63)] = maskl[i];
}

__device__ __forceinline__ void conv_unit(KP p, char* lds, int l, int b, int c) {
    float* red = (float*)lds;
    const int ch = TID(), lane = ch & 63, wave = ch >> 6;
    const int t0 = c * 32, tokbase = b * SEQ;
    float aw[62];
#pragma unroll
    for (int rr = 0; rr < 62; ++rr) {
        int tt = t0 - 30 + rr; const bool ok = tt >= 0; tt = ok ? tt : t0;
        const float v = (float)p->P[(size_t)(tokbase + tt) * NP + ch];
        aw[rr] = ok ? v : 0.f;
    }
    float w[31];
#pragma unroll
    for (int i = 0; i < 31; ++i) w[i] = p->w_dw[(l * 31 + i) * 256 + ch];
    const float bias = p->b_dw[l * 256 + ch];
    float y[32], s1[32], s2[32];
#pragma unroll
    for (int tk = 0; tk < 32; ++tk) {
        float sacc = bias;
#pragma unroll
        for (int i = 0; i < 31; ++i) sacc = fmaf(aw[tk + i], w[i], sacc);
        y[tk] = sacc; s1[tk] = sacc; s2[tk] = sacc * sacc;
    }
    {
        const bool b5 = lane & 32, b4 = lane & 16, b3 = lane & 8, b2 = lane & 4, b1 = lane & 2;
        float a16[16], c16[16], a8[8], c8[8], a4[4], c4[4], a2[2], c2[2];
#pragma unroll
        for (int e = 0; e < 16; ++e) { a16[e] = (b5 ? s1[e + 16] : s1[e]) + __shfl_xor(b5 ? s1[e] : s1[e + 16], 32); c16[e] = (b5 ? s2[e + 16] : s2[e]) + __shfl_xor(b5 ? s2[e] : s2[e + 16], 32); }
#pragma unroll
        for (int e = 0; e < 8; ++e) { a8[e] = (b4 ? a16[e + 8] : a16[e]) + __shfl_xor(b4 ? a16[e] : a16[e + 8], 16); c8[e] = (b4 ? c16[e + 8] : c16[e]) + __shfl_xor(b4 ? c16[e] : c16[e + 8], 16); }
#pragma unroll
        for (int e = 0; e < 4; ++e) { a4[e] = (b3 ? a8[e + 4] : a8[e]) + __shfl_xor(b3 ? a8[e] : a8[e + 4], 8); c4[e] = (b3 ? c8[e + 4] : c8[e]) + __shfl_xor(b3 ? c8[e] : c8[e + 4], 8); }
#pragma unroll
        for (int e = 0; e < 2; ++e) { a2[e] = (b2 ? a4[e + 2] : a4[e]) + __shfl_xor(b2 ? a4[e] : a4[e + 2], 4); c2[e] = (b2 ? c4[e + 2] : c4[e]) + __shfl_xor(b2 ? c4[e] : c4[e + 2], 4); }
        float av = (b1 ? a2[1] : a2[0]) + __shfl_xor(b1 ? a2[0] : a2[1], 2), cv = (b1 ? c2[1] : c2[0]) + __shfl_xor(b1 ? c2[0] : c2[1], 2);
        av += __shfl_xor(av, 1); cv += __shfl_xor(cv, 1);
        const int tokk = (b5 ? 16 : 0) + (b4 ? 8 : 0) + (b3 ? 4 : 0) + (b2 ? 2 : 0) + (b1 ? 1 : 0);
        __syncthreads();
        if ((lane & 1) == 0) { red[(tokk * 4 + wave) * 2] = av; red[(tokk * 4 + wave) * 2 + 1] = cv; }
        __syncthreads();
    }
    const float lg = p->ln_g[l * 256 + ch], lb = p->ln_b[l * 256 + ch];
#pragma unroll
    for (int tk = 0; tk < 32; ++tk) {
        const float4 ra = *(const float4*)(red + tk * 8), rb = *(const float4*)(red + tk * 8 + 4);
        const float t1 = (ra.x + ra.z) + (rb.x + rb.z);
        const float t2 = (ra.y + ra.w) + (rb.y + rb.w);
        const float mu = t1 * (1.0f / 256.0f);
        float var = t2 * (1.0f / 256.0f) - mu * mu; var = var < 0.f ? 0.f : var;
        float z = (y[tk] - mu) * (1.0f / sqrtf(var + 1e-6f)) * lg + lb;
        z = z * sigmoidf_(z);
        p->ycat[((size_t)(ch >> 5) * T_TOK + tokbase + t0 + tk) * 32 + (ch & 31)] = (half_t)z;
    }
}

__device__ __forceinline__ void kmean_unit(KP p, char* lds, int b, int h, int blk) {
    float* part = (float*)lds;
    const int tid = TID(), d = tid & 63, pt = tid >> 6;
    const half_t* r = p->P + (size_t)(b * SEQ + blk * 256 + pt * 64) * NP + PC_MK + h * 64 + d;
    float s = 0.f;
#pragma unroll 16
    for (int k = 0; k < 64; ++k) s += (float)r[(size_t)k * NP];
    __syncthreads();
    part[pt * 64 + d] = s;
    __syncthreads();
    if (tid < 64) p->kmean[(((size_t)b * 6 + h) * 8 + blk) * 64 + tid] = ((part[tid] + part[64 + tid]) + (part[128 + tid] + part[192 + tid])) * (1.0f / 256.0f);
}

#ifndef POST_MASK
#define POST_MASK 7
#endif
__device__ __forceinline__ void phase_post(KP p, char* lds, int l, int tm) {
    const int NA = 2048, NB = 1024, NC = 768;
    const int G_ = gridDim.x;
    for (int u0 = BID(), k_ = 0; u0 < NA + NB + NC; u0 += G_, ++k_) {
        int u = u0;
        if (u0 < NA && (k_ & 1) && (k_ + 1) * G_ <= NA) u = k_ * G_ + (G_ - 1 - (u0 - k_ * G_));
        if (u < NA) { if (tm & 1) dsa_select_unit(p, lds, u % 16, 127 - (u / 16)); }
        else if (u < NA + NB) { const int v = u - NA; if (tm & 2) conv_unit(p, lds, l, v % 16, v / 16); }
        else { const int v = u - NA - NB; if (tm & 4) kmean_unit(p, lds, v / 48, (v / 8) % 6, v % 8); }
    }
}

template <int MODE>
__device__ __forceinline__ void attn_unit(KP p, char* lds, int b, int h, int qt) {
    const int tid = TID(), lane = tid & 63, wave = tid >> 6, hh = lane >> 5, ql = lane & 31;
    const int q0 = qt * 128, tokbase = b * SEQ;
    const int tq = q0 + wave * 32 + ql;
    const half_t* Pb = p->P + (size_t)tokbase * NP;
    const int QOFF = MODE ? PC_MQ + h * 64 : PC_DQ + h * 64;
    const int KOFF = MODE ? PC_MK + h * 64 : PC_DK;
    const int VOFF = MODE ? PC_MV + h * 64 : PC_DV;
    const int own = qt >> 1;
    unsigned mysel = 0u, anysel = 0u;
    __syncthreads();
    if (MODE == 1) {
        float* km = (float*)(lds + 32768);
        float* gts = km + 512;
        unsigned* selq = (unsigned*)(gts + 1024);
        unsigned* anyb = selq + 128;
        for (int i = tid; i < 512; i += 256) km[i] = p->kmean[((size_t)b * 6 + h) * 512 + i];
        if (tid == 0) *anyb = 0u;
        __syncthreads();
        {
            const int q = tid & 127, hf = tid >> 7;
            if (hf * 4 < own) {
                const half_t* qr = Pb + (size_t)(q0 + q) * NP + QOFF;
                float g0 = 0.f, g1 = 0.f, g2 = 0.f, g3 = 0.f;
#pragma unroll
                for (int c8 = 0; c8 < 8; ++c8) {
                    const h8 qv = *(const h8*)(qr + c8 * 8);
#pragma unroll
                    for (int j4 = 0; j4 < 2; ++j4) {
                        const int d = c8 * 8 + j4 * 4;
                        const float q0f = (float)qv[j4 * 4], q1f = (float)qv[j4 * 4 + 1], q2f = (float)qv[j4 * 4 + 2], q3f = (float)qv[j4 * 4 + 3];
                        const float4 k0 = *(const float4*)(km + (hf * 4 + 0) * 64 + d), k1 = *(const float4*)(km + (hf * 4 + 1) * 64 + d);
                        const float4 k2 = *(const float4*)(km + (hf * 4 + 2) * 64 + d), k3 = *(const float4*)(km + (hf * 4 + 3) * 64 + d);
                        g0 = fmaf(q0f, k0.x, g0); g0 = fmaf(q1f, k0.y, g0); g0 = fmaf(q2f, k0.z, g0); g0 = fmaf(q3f, k0.w, g0);
                        g1 = fmaf(q0f, k1.x, g1); g1 = fmaf(q1f, k1.y, g1); g1 = fmaf(q2f, k1.z, g1); g1 = fmaf(q3f, k1.w, g1);
                        g2 = fmaf(q0f, k2.x, g2); g2 = fmaf(q1f, k2.y, g2); g2 = fmaf(q2f, k2.z, g2); g2 = fmaf(q3f, k2.w, g2);
                        g3 = fmaf(q0f, k3.x, g3); g3 = fmaf(q1f, k3.y, g3); g3 = fmaf(q2f, k3.z, g3); g3 = fmaf(q3f, k3.w, g3);
                    }
                }
                gts[q * 8 + hf * 4 + 0] = g0; gts[q * 8 + hf * 4 + 1] = g1; gts[q * 8 + hf * 4 + 2] = g2; gts[q * 8 + hf * 4 + 3] = g3;
            }
        }
        __syncthreads();
        if (tid < 128) {
            unsigned m = 0u;
            const int want = own < 3 ? own : 3;
            for (int r = 0; r < want; ++r) {
                int best = -1; float bv = -INFINITY;
                for (int j = 0; j < own; ++j) { const float gv = gts[tid * 8 + j]; if (!((m >> j) & 1u) && (best < 0 || gv > bv)) { best = j; bv = gv; } }
                m |= 1u << best;
            }
            selq[tid] = m;
            if (m) atomicOr(anyb, m);
        }
        __syncthreads();
        mysel = selq[wave * 32 + ql];
        anysel = *anyb;
        __syncthreads();
    }
    h8 qf[4];
#pragma unroll
    for (int ks = 0; ks < 4; ++ks) qf[ks] = *(const h8*)(Pb + (size_t)tq * NP + QOFF + 16 * ks + 8 * hh);
    f16v O0, O1;
#pragma unroll
    for (int r = 0; r < 16; ++r) { O0[r] = 0.f; O1[r] = 0.f; }
    float l_run = 0.f;
    bool unset = true;
    f16v negm;
#pragma unroll
    for (int r = 0; r < 16; ++r) negm[r] = 0.f;
    const float THR = 8.0f;
    const int ntile = 2 * qt + 2;
    auto skip = [&](int kt) -> bool { return MODE == 1 && kt < 4 * own && !((anysel >> (kt >> 2)) & 1u); };
    auto nexttile = [&](int kt) -> int { ++kt; while (kt < ntile && skip(kt)) ++kt; return kt; };
    const int lrow = tid >> 3;
    const int kchunk = (tid & 7) ^ ((tid >> 4) & 7);
    const int vchunk = (tid & 7) ^ (((tid >> 4) & 1) << 2);
    char* ldst = lds + lrow * 128 + (tid & 7) * 16;
    auto issue = [&](int kt, int s) {
        const half_t* src = Pb + (size_t)(kt * 64 + lrow) * NP;
        char* d = ldst + s * 16384;
        glds16(src + KOFF + kchunk * 8, d);
        glds16(src + (size_t)32 * NP + KOFF + kchunk * 8, d + 4096);
        glds16(src + VOFF + vchunk * 8, d + 8192);
        glds16(src + (size_t)32 * NP + VOFF + vchunk * 8, d + 8192 + 4096);
    };
    const int rsw = (lane >> 1) & 7;
    const int kro = ql * 128;
    const int li = lane & 15, qp = li >> 2, pp = li & 3, swv = (qp >> 1) & 1;
    const int vb0 = 8192 + (4 * hh + qp) * 128 + 32 * ((lane >> 4) & 1) + 8 * pp + 64 * (0 ^ swv);
    const int vb1 = 8192 + (4 * hh + qp) * 128 + 32 * ((lane >> 4) & 1) + 8 * pp + 64 * (1 ^ swv);
    int kt = -1; kt = nexttile(kt);
    int s = 0;
    if (kt < ntile) issue(kt, 0);
    while (kt < ntile) {
        const int ktn = nexttile(kt);
        asm volatile("s_waitcnt vmcnt(0)" ::: "memory");
        __syncthreads();
        if (ktn < ntile) issue(ktn, s ^ 1);
        const bool wave_active = (kt * 64 <= q0 + wave * 32 + 31);
        if (wave_active) {
            const char* base = lds + s * 16384;
            uint2 mw = make_uint2(0u, 0u);
            if (MODE == 0) mw = *(const uint2*)(p->dmask + (size_t)(tokbase + tq) * 64 + 2 * kt);
            h8 vf0[4], vf1[4];
#pragma unroll
            for (int kk = 0; kk < 4; ++kk) {
                const int roff = (32 * (kk >> 1) + 16 * (kk & 1)) * 128;
                const s4v lo0 = __builtin_amdgcn_ds_read_tr16_b64_v4i16((LAS s4v*)(base + vb0 + roff));
                const s4v hi0 = __builtin_amdgcn_ds_read_tr16_b64_v4i16((LAS s4v*)(base + vb0 + roff + 8 * 128));
                const s4v lo1 = __builtin_amdgcn_ds_read_tr16_b64_v4i16((LAS s4v*)(base + vb1 + roff));
                const s4v hi1 = __builtin_amdgcn_ds_read_tr16_b64_v4i16((LAS s4v*)(base + vb1 + roff + 8 * 128));
                vf0[kk] = __builtin_bit_cast(h8, __builtin_shufflevector(lo0, hi0, 0, 1, 2, 3, 4, 5, 6, 7));
                vf1[kk] = __builtin_bit_cast(h8, __builtin_shufflevector(lo1, hi1, 0, 1, 2, 3, 4, 5, 6, 7));
            }
            bool lane_on = true;
            if (MODE == 1 && kt < 4 * own) lane_on = (mysel >> (kt >> 2)) & 1u;
            f16v cin = negm;
            if (MODE == 1 && kt < 4 * own) {
#pragma unroll
                for (int r = 0; r < 16; ++r) cin[r] = lane_on ? negm[r] : -INFINITY;
            }
            f16v s0 = cin, s1 = cin;
#pragma unroll
            for (int ks = 0; ks < 4; ++ks) {
                const int co = ((2 * ks + hh) ^ rsw) << 4;
                const h8 k0 = *(const h8*)(base + kro + co), k1 = *(const h8*)(base + kro + 4096 + co);
                s0 = __builtin_amdgcn_mfma_f32_32x32x16_f16(k0, qf[ks], s0, 0, 0, 0);
                s1 = __builtin_amdgcn_mfma_f32_32x32x16_f16(k1, qf[ks], s1, 0, 0, 0);
            }
            if (MODE == 0) {
                const unsigned w0 = mw.x >> (4 * hh), w1 = mw.y >> (4 * hh);
#pragma unroll
                for (int r = 0; r < 16; ++r) {
                    const int pos = (r & 3) + 8 * (r >> 2);
                    const unsigned m0 = (unsigned)__builtin_amdgcn_sbfe((int)w0, pos, 1), m1 = (unsigned)__builtin_amdgcn_sbfe((int)w1, pos, 1);
                    s0[r] = __uint_as_float((__float_as_uint(s0[r]) & m0) | (0xFF800000u & ~m0));
                    s1[r] = __uint_as_float((__float_as_uint(s1[r]) & m1) | (0xFF800000u & ~m1));
                }
            } else if (kt >= 4 * own && kt * 64 + 63 > q0 + wave * 32) {
#pragma unroll
                for (int r = 0; r < 16; ++r) {
                    const int key = kt * 64 + (r & 3) + 8 * (r >> 2) + 4 * hh;
                    s0[r] = (key <= tq) ? s0[r] : -INFINITY;
                    s1[r] = (key + 32 <= tq) ? s1[r] : -INFINITY;
                }
            }
            float mx = s0[0];
#pragma unroll
            for (int r = 1; r < 16; ++r) mx = fmaxf(mx, s0[r]);
#pragma unroll
            for (int r = 0; r < 16; ++r) mx = fmaxf(mx, s1[r]);
            mx = fmaxf(mx, __shfl_xor(mx, 32));
            const bool need = unset ? (mx > -INFINITY) : (mx > THR);
            if (__any(need)) {
                const float delta = need ? mx : 0.f;
                const float alpha = (need && !unset) ? __builtin_amdgcn_exp2f(-delta) : 1.0f;
#pragma unroll
                for (int r = 0; r < 16; ++r) { s0[r] -= delta; s1[r] -= delta; negm[r] -= delta; O0[r] *= alpha; O1[r] *= alpha; }
                l_run *= alpha;
                unset = unset && !need;
            }
            float ls = 0.f;
#pragma unroll
            for (int r = 0; r < 16; ++r) { s0[r] = __builtin_amdgcn_exp2f(s0[r]); ls += s0[r]; }
#pragma unroll
            for (int r = 0; r < 16; ++r) { s1[r] = __builtin_amdgcn_exp2f(s1[r]); ls += s1[r]; }
            l_run += ls;
#pragma unroll
            for (int kk = 0; kk < 4; ++kk) {
                h8 pf;
#pragma unroll
                for (int j = 0; j < 8; ++j) pf[j] = (half_t)((kk >> 1) ? s1[8 * (kk & 1) + j] : s0[8 * (kk & 1) + j]);
                O0 = __builtin_amdgcn_mfma_f32_32x32x16_f16(vf0[kk], pf, O0, 0, 0, 0);
                O1 = __builtin_amdgcn_mfma_f32_32x32x16_f16(vf1[kk], pf, O1, 0, 0, 0);
            }
        }
        kt = ktn; s ^= 1;
    }
    const float lt = l_run + __shfl_xor(l_run, 32);
    const float inv = 1.0f / lt;
    const int ycol = (MODE ? 640 : 256) + h * 64;
    half_t* dst = p->ycat + ((size_t)(ycol >> 5) * T_TOK + tokbase + tq) * 32 + 4 * hh;
#pragma unroll
    for (int g = 0; g < 4; ++g) {
        *(h4*)(dst + 8 * g) = pack4(O0[4 * g] * inv, O0[4 * g + 1] * inv, O0[4 * g + 2] * inv, O0[4 * g + 3] * inv);
        *(h4*)(dst + (size_t)T_TOK * 32 + 8 * g) = pack4(O1[4 * g] * inv, O1[4 * g + 1] * inv, O1[4 * g + 2] * inv, O1[4 * g + 3] * inv);
    }
}

#ifndef ATT_MASK
#define ATT_MASK 3
#endif
__device__ __forceinline__ void phase_attn(KP p, char* lds, int tm) {
    const int G_ = gridDim.x, per_ = G_ >> 3;
    const bool snake_ = (G_ >= 8) && ((G_ & 7) == 0);
    for (int k_ = 0, b_ = BID(); snake_ ? (k_ * per_ < 384) : (b_ + k_ * G_ < 3072); ++k_) {
        int xl, Lx;
        if (snake_) { const int idx_ = b_ >> 3; xl = b_ & 7; Lx = k_ * per_ + ((k_ & 1) ? (per_ - 1 - idx_) : idx_); }
        else { const int u = b_ + k_ * G_; xl = u & 7; Lx = u >> 3; }
        if (Lx >= 384) continue;
        const int qt = 15 - (Lx / 24), rem = Lx % 24;
        const int type = rem & 1, bh = xl * 12 + (rem >> 1);
        if (type == 0) { if (tm & 1) attn_unit<0>(p, lds, bh / 6, bh % 6, qt); }
        else { if (tm & 2) attn_unit<1>(p, lds, bh / 6, bh % 6, qt); }
    }
}

__global__ void __launch_bounds__(256, 2) mk_fwd(Params p_unused) {
    extern __shared__ __attribute__((aligned(16))) char lds[];
    volatile LAS unsigned* stw = (volatile LAS unsigned*)(lds + LDS_CTL);
    if (threadIdx.x < 4) stw[threadIdx.x] = 0u;
    __syncthreads();
    KP p0 = (KP)__builtin_amdgcn_kernarg_segment_ptr();
    XcdBarrier bar; bar.bar = p0->bar; bar.x = 0; bar.st = stw;
#if !MK_SPLIT
    bar = xcd_barrier_post(p0->bar, stw);
#endif
    const int ph_lo = p0->ph_lo, ph_hi = p0->ph_hi;
    for (int ph = ph_lo; ph < ph_hi; ++ph) {
      KP p = p0; asm volatile("" : "+s"(p));
      const int nrep = (DUP_SUB >= 0 && ((DUP_SUB == 100 && ph == 0) || (ph >= 2 && ph < NPHASE - 1 && ((ph - 2) & 7) == DUP_SUB && (DUP_SUB != 4 || ph < 10)))) ? 2 : 1;
      for (int rep = 0; rep < nrep; ++rep) {
        if (ph == 0) phase_prologue(p, lds);
        else if (ph == 1) phase_modsum(p);
        else if (ph == NPHASE - 1) phase_norm<2>(p, lds, p->out, p->g_final, nullptr, nullptr, 0);
        else {
            const int l = (ph - 2) >> 3, sub = (ph - 2) & 7;
            const float* mf = p->modf + (size_t)l * 16 * 6144;
            const float* xin = l == 0 ? p->x : p->out;
            if (sub == 0) phase_norm<0>(p, lds, xin, p->g_mix + l * DM, mf, mf + 1024, l);
            else if (sub == 1) phase_inproj(p, lds, l);
            else if (sub == 2) phase_post(p, lds, l, rep ? POST_MASK : 7);
            else if (sub == 3) phase_attn(p, lds, rep ? ATT_MASK : 3);
            else if (sub == 4) phase_outproj(p, lds, l, xin);
            else if (sub == 5) phase_norm<1>(p, lds, p->out, p->g_ffn + l * DM, mf + 3 * 1024, mf + 4 * 1024, (nrep == 2 && rep == 0) ? l + 2 : l);
            else if (sub == 6) phase_moe_up(p, lds, l);
            else phase_moe_down(p, lds, l, nrep == 2 ? 0.5f : 1.0f);
        }
      }
#if !MK_SPLIT
        if (ph + 1 < ph_hi) xcd_barrier(bar);
#endif
    }
}

extern "C" void kernel_launch(void* const* d_in, const int* in_sizes, int n_in, void* d_out, int out_size, void* d_ws, size_t ws_size, hipStream_t stream) {
    static int grid = 0;
    if (grid == 0) {
        int dev = 0, cus = 0, per_cu = 0;
        (void)hipGetDevice(&dev);
        (void)hipDeviceGetAttribute(&cus, hipDeviceAttributeMultiprocessorCount, dev);
        (void)hipFuncSetAttribute((const void*)mk_fwd, hipFuncAttributeMaxDynamicSharedMemorySize, LDS_BYTES);
        if (hipOccupancyMaxActiveBlocksPerMultiprocessor(&per_cu, (const void*)mk_fwd, 256, LDS_BYTES) != hipSuccess || per_cu < 1) per_cu = 1;
        (void)hipGetLastError();
        if (per_cu > 2) per_cu = 2;
        grid = cus * per_cu;
        fprintf(stderr, "mk_fwd: cus %d per_cu %d grid %d\n", cus, per_cu, grid);
    }
    Params p{};
    const float** pin = (const float**)&p.x;
    for (int i = 0; i < 18; ++i) pin[i] = (const float*)d_in[i];
    p.out = (float*)d_out;
    char* ws = (char*)d_ws;
    size_t off = 0;
    auto carve = [&](size_t bytes) { void* q = ws + off; off += (bytes + 255) & ~(size_t)255; return q; };
    p.bar = (unsigned*)carve(XCD_BAR_WORDS * 4);
    p.cnt = (int*)carve(4 * 32 * 64 * 4);
    const size_t zero_bytes = off;
    p.Wt_in = (half_t*)carve((size_t)2 * NP * DM * 2);
    p.Wt_o = (half_t*)carve((size_t)2 * DM * DM * 2);
    p.Wt_gu = (half_t*)carve((size_t)2 * 16 * 512 * 1024 * 2);
    p.Wt_d = (half_t*)carve((size_t)2 * 16 * 1024 * 256 * 2);
    p.hn = (half_t*)carve((size_t)T_TOK * DM * 2);
    p.P = (half_t*)carve((size_t)T_TOK * NP * 2);
    p.ycat = (half_t*)carve((size_t)T_TOK * DM * 2);
    p.act = (half_t*)carve((size_t)T_TOK * 512 * 2);
    p.modpart = (float*)carve((size_t)8 * 2 * 16 * 6144 * 4);
    p.modf = (float*)carve((size_t)2 * 16 * 6144 * 4);
    p.kmean = (float*)carve((size_t)16 * 6 * 8 * 64 * 4);
    p.rope = (float*)carve((size_t)2048 * 24 * 4);
    p.iwf = (float*)carve((size_t)T_TOK * 4 * 4);
    p.tokw = (float*)carve((size_t)T_TOK * 2 * 4);
    p.dmask = (unsigned*)carve((size_t)T_TOK * 64 * 4);
    p.lists = (int*)carve((size_t)NCLS * T_TOK * 4);
    if (off > ws_size) { fprintf(stderr, "workspace too small: need %zu have %zu\n", off, ws_size); return; }
    (void)hipMemsetAsync(d_ws, 0, zero_bytes, stream);
#if MK_SPLIT
    for (int ph = 0; ph < NPHASE; ++ph) {
        p.ph_lo = ph; p.ph_hi = ph + 1;
        hipLaunchKernelGGL(mk_fwd, dim3(grid), dim3(256), LDS_BYTES, stream, p);
    }
#else
    p.ph_lo = 0; p.ph_hi = NPHASE;
    hipLaunchKernelGGL(mk_fwd, dim3(grid), dim3(256), LDS_BYTES, stream, p);
#endif
}
```

```cpp
#include <hip/hip_runtime.h>
#include <cstdio>
#include <cstdint>

#ifndef MK_SPLIT
#define MK_SPLIT 0
#endif

#define T_TOK 32768
#define DM 1024
#define SEQ 2048
#define INW 2340
#define NP 2432
#define PC_CU 0
#define PC_CG 256
#define PC_DQ 512
#define PC_DK 896
#define PC_DV 960
#define PC_IQ 1024
#define PC_IK 1152
#define PC_IW 1184
#define PC_MQ 1280
#define PC_MK 1664
#define PC_MV 2048
#define LOG_THETA 13.122363377404328f
#define NCLS 24
#define LDS_CTL 73728
#define LDS_BYTES 78336
#define NPHASE 19
#ifndef DUP_SUB
#define DUP_SUB -1
#endif

typedef _Float16 half_t;
typedef _Float16 h8 __attribute__((ext_vector_type(8)));
typedef _Float16 h4 __attribute__((ext_vector_type(4)));
typedef short s4v __attribute__((ext_vector_type(4)));
typedef short s8v __attribute__((ext_vector_type(8)));
typedef float f16v __attribute__((ext_vector_type(16)));
typedef float f4v __attribute__((ext_vector_type(4)));
#define LAS __attribute__((address_space(3)))

struct Params {
    const float *x, *c, *w_ada, *b_ada, *g_mix, *w_in, *w_dw, *b_dw, *ln_g, *ln_b, *w_o, *g_ffn, *w_router, *b_router, *w_gate, *w_up, *w_down, *g_final;
    float* out;
    half_t *Wt_in, *Wt_o, *Wt_gu, *Wt_d, *hn, *P, *ycat, *act;
    float *modpart, *modf, *kmean, *rope, *iwf, *tokw;
    unsigned* dmask; int* cnt; int* lists; unsigned* bar;
    int ph_lo, ph_hi;
};

#define XB_TMO      128
#define XB_XCNT(j)  (256  + 64 * (j))
#define XB_XSUB(j)  (1280 + 64 * (j))
#define XB_XGEN(j)  (2304 + 64 * (j))
#define XB_TOP      3328
#define XB_TOPGEN   3392
#define XCD_BAR_WORDS 3456
#define XB_SPIN_CAP (1u << 20)
__device__ __forceinline__ unsigned xb_ld(unsigned* p)              { return __hip_atomic_load(p, __ATOMIC_RELAXED, __HIP_MEMORY_SCOPE_AGENT); }
__device__ __forceinline__ unsigned xb_add(unsigned* p, unsigned v) { return __hip_atomic_fetch_add(p, v, __ATOMIC_RELAXED, __HIP_MEMORY_SCOPE_AGENT); }
__device__ __forceinline__ unsigned xb_xcc_id() { return (unsigned)__builtin_amdgcn_s_getreg((3 << 11) | 20) & 0xFu; }
#define XB_SPIN(cond, bar) do { unsigned _sp = 0; while (cond) { __builtin_amdgcn_s_sleep(1); \
    if ((++_sp & 255u) == 0u) { if (xb_ld(&(bar)[XB_TMO])) break; if (_sp > XB_SPIN_CAP) { atomicAdd(&(bar)[XB_TMO], 1u); break; } } } } while (0)
struct XcdBarrier { unsigned* bar; unsigned x; volatile LAS unsigned* st; };
__device__ __forceinline__ XcdBarrier xcd_barrier_post(unsigned* bar, volatile LAS unsigned* st) {
    XcdBarrier b; b.bar = bar; b.x = xb_xcc_id(); b.st = st;
    if (threadIdx.x == 0) (void)xb_add(&bar[XB_XCNT(b.x)], 1u);
    return b;
}
__device__ __forceinline__ void xcd_barrier_complete(unsigned* bar, unsigned x, unsigned& nloc, unsigned& nx) {
    const unsigned G = gridDim.x * gridDim.y * gridDim.z;
    unsigned sum, cnt, mine, sp = 0u;
    for (;;) {
        sum = 0u; cnt = 0u; mine = 0u;
#pragma unroll
        for (unsigned j = 0; j < 16; ++j) { const unsigned c = xb_ld(&bar[XB_XCNT(j)]); sum += c; cnt += (c > 0u) ? 1u : 0u; mine = (j == x) ? c : mine; }
        if (sum == G) break;
        __builtin_amdgcn_s_sleep(1);
        if ((++sp & 255u) == 0u) { if (xb_ld(&bar[XB_TMO])) break; if (sp > XB_SPIN_CAP) { atomicAdd(&bar[XB_TMO], 1u); break; } }
    }
    nloc = mine > 0u ? mine : 1u; nx = cnt > 0u ? cnt : 1u;
}
__device__ __forceinline__ void xcd_barrier(const XcdBarrier& b) {
    asm volatile("s_waitcnt vmcnt(0)" ::: "memory");
    __syncthreads();
    if (threadIdx.x == 0) {
        unsigned* bar = b.bar;
        __builtin_amdgcn_s_waitcnt(0);
        unsigned nloc = b.st[0], nx = b.st[1];
        if (nloc == 0u) { xcd_barrier_complete(bar, b.x, nloc, nx); b.st[0] = nloc; b.st[1] = nx; }
        const unsigned old = xb_add(&bar[XB_XSUB(b.x)], 1u);
        const unsigned gen = old / nloc;
        if (old + 1u == (gen + 1u) * nloc) {
            __builtin_amdgcn_fence(__ATOMIC_RELEASE, "agent");
            asm volatile("s_waitcnt vmcnt(0)" ::: "memory");
            const unsigned og = xb_add(&bar[XB_TOP], 1u);
            const unsigned tg = og / nx;
            if (og + 1u == (tg + 1u) * nx) xb_add(&bar[XB_TOPGEN], 1u);
            else XB_SPIN(xb_ld(&bar[XB_TOPGEN]) == tg, bar);
            __builtin_amdgcn_fence(__ATOMIC_ACQUIRE, "agent");
            xb_add(&bar[XB_XGEN(b.x)], 1u);
            asm volatile("s_waitcnt vmcnt(0)" ::: "memory");
        } else {
            XB_SPIN(xb_ld(&bar[XB_XGEN(b.x)]) == gen, bar);
            __builtin_amdgcn_fence(__ATOMIC_ACQUIRE, "agent");
            asm volatile("s_waitcnt vmcnt(0)" ::: "memory");
        }
    }
    __syncthreads();
}

typedef const __attribute__((address_space(4))) Params* KP;
__device__ __forceinline__ int TID() { int t = threadIdx.x; asm volatile("" : "+v"(t)); return t; }
__device__ __forceinline__ int BID() { int b = blockIdx.x; asm volatile("" : "+s"(b)); return b; }
__device__ __forceinline__ float sigmoidf_(float v) { return __builtin_amdgcn_rcpf(1.0f + __expf(-v)); }
__device__ __forceinline__ void glds16(const void* g, char* l) { __builtin_amdgcn_global_load_lds((const unsigned*)g, (unsigned*)l, 16, 0, 0); }
__device__ __forceinline__ unsigned f2sortable(float f) { unsigned u = __float_as_uint(f); return (u & 0x80000000u) ? ~u : (u | 0x80000000u); }
__device__ __forceinline__ h4 pack4(float a, float b, float c, float d) { h4 r = {(half_t)a, (half_t)b, (half_t)c, (half_t)d}; return r; }

template <class CF>
__device__ __forceinline__ void conv_tile_panel(char* lds, CF colf, int src_ld, int k0, int n0, half_t* dst, int nrows) {
    float* tl = (float*)lds;
    const int tid = TID();
    __syncthreads();
    {
        const int nn = tid & 63;
        const float* cp = colf(nn);
        float tv[16];
#pragma unroll
        for (int i = 0; i < 16; ++i) { const int k = i * 4 + (tid >> 6); tv[i] = cp ? cp[(size_t)(k0 + k) * src_ld] : 0.f; }
#pragma unroll
        for (int i = 0; i < 16; ++i) { const int k = i * 4 + (tid >> 6); tl[k * 65 + nn] = tv[i]; }
    }
    __syncthreads();
    {
        const int n = tid >> 2, kq = (tid & 3) * 16;
        h8 a, b;
#pragma unroll
        for (int j = 0; j < 8; ++j) { a[j] = (half_t)tl[(kq + j) * 65 + n]; b[j] = (half_t)tl[(kq + 8 + j) * 65 + n]; }
        const int k = k0 + kq;
        h8* d = (h8*)(dst + ((size_t)(k >> 5) * nrows + n0 + n) * 32 + (k & 31));
        d[0] = a; d[1] = b;
    }
}
template <class CF>
__device__ __forceinline__ void conv_tile(char* lds, CF colf, int src_ld, int k0, half_t* dst_tile  , int dstK) {
    float* tl = (float*)lds;
    const int tid = TID();
    __syncthreads();
    {
        const int nn = tid & 63;
        const float* cp = colf(nn);
        float tv[16];
#pragma unroll
        for (int i = 0; i < 16; ++i) { const int k = i * 4 + (tid >> 6); tv[i] = cp ? cp[(size_t)(k0 + k) * src_ld] : 0.f; }
#pragma unroll
        for (int i = 0; i < 16; ++i) { const int k = i * 4 + (tid >> 6); tl[k * 65 + nn] = tv[i]; }
    }
    __syncthreads();
    {
        const int n = tid >> 2, kq = (tid & 3) * 16;
        h8 a, b;
#pragma unroll
        for (int j = 0; j < 8; ++j) { a[j] = (half_t)tl[(kq + j) * 65 + n]; b[j] = (half_t)tl[(kq + 8 + j) * 65 + n]; }
        h8* d = (h8*)(dst_tile + (size_t)n * dstK + kq);
        d[0] = a; d[1] = b;
    }
}

__device__ __forceinline__ void phase_prologue(KP p, char* lds) {
    const int tid = TID();
    const int NA = 2 * 16 * 38, NB = 2 * 16 * 16, NC = 2 * 16 * 16 * 8, ND = 2 * 16 * 4 * 16, NE = 384, NF = 8;
    const int total = NA + NB + NC + ND + NE + NF;
    for (int u0 = BID(); u0 < total; u0 += gridDim.x) {
        int u = u0;
        if (u < NA) {
            const int nt = u % 38, kt = (u / 38) % 16, l = u / (38 * 16);
            const float* src = p->w_in + (size_t)l * DM * INW;
            const int n0 = nt * 64;
            conv_tile_panel(lds, [&](int nn) -> const float* { const int np = n0 + nn; const int sc = np < 512 ? (((np & 63) < 32) ? 32 * (np >> 6) + (np & 31) : 256 + 32 * (np >> 6) + (np & 31)) : (np < 1188 ? np : (np < 1280 ? -1 : np - 92)); return sc >= 0 ? src + sc : (const float*)nullptr; },
                      INW, kt * 64, n0, p->Wt_in + (size_t)l * NP * DM, NP);
            continue;
        }
        u -= NA;
        if (u < NB) {
            const int nt = u % 16, kt = (u / 16) % 16, l = u / 256;
            const float* src = p->w_o + (size_t)l * DM * DM + nt * 64;
            conv_tile_panel(lds, [&](int nn) -> const float* { return src + nn; }, DM, kt * 64, nt * 64, p->Wt_o + (size_t)l * DM * DM, DM);
            continue;
        }
        u -= NB;
        if (u < NC) {
            const int nt = u % 8, kt = (u / 8) % 16, le = u / 128;
            const float* sg = p->w_gate + (size_t)le * 1024 * 256 + nt * 32;
            const float* su = p->w_up + (size_t)le * 1024 * 256 + nt * 32;
            conv_tile(lds, [&](int nn) -> const float* { return nn < 32 ? sg + nn : su + (nn - 32); }, 256, kt * 64, p->Wt_gu + ((size_t)le * 512 + nt * 64) * 1024 + kt * 64, 1024);
            continue;
        }
        u -= NC;
        if (u < ND) {
            const int nt = u % 16, kt = (u / 16) % 4, le = u / 64;
            const float* src = p->w_down + (size_t)le * 256 * 1024 + nt * 64;
            conv_tile(lds, [&](int nn) -> const float* { return src + nn; }, 1024, kt * 64, p->Wt_d + ((size_t)le * 1024 + nt * 64) * 256 + kt * 64, 256);
            continue;
        }
        u -= ND;
        if (u < NE) {
            const int kc = u % 8, cc = (u / 8) % 24, l = u / 192;
            float* ca = (float*)lds;
            __syncthreads();
            for (int i = tid; i < 2048; i += 256) { const int b = i >> 7, k = i & 127; const float v = p->c[b * 1024 + kc * 128 + k]; ca[i] = v / (1.0f + expf(-v)); }
            __syncthreads();
            const int n = cc * 256 + tid;
            float acc[16];
#pragma unroll
            for (int b = 0; b < 16; ++b) acc[b] = 0.f;
            const float* w = p->w_ada + ((size_t)l * 1024 + kc * 128) * 6144 + n;
#pragma unroll 16
            for (int k = 0; k < 128; ++k) {
                const float wv = w[(size_t)k * 6144];
#pragma unroll
                for (int b = 0; b < 16; ++b) acc[b] = fmaf(ca[b * 128 + k], wv, acc[b]);
            }
#pragma unroll
            for (int b = 0; b < 16; ++b) p->modpart[(((size_t)kc * 2 + l) * 16 + b) * 6144 + n] = acc[b];
            continue;
        }
        u -= NE;
        {
            for (int i = u * 256 + tid; i < 2048 * 12; i += NF * 256) {
                const int t = i / 12, r = i % 12;
                const int fi = r < 8 ? r : r - 8;
                const float rot = r < 8 ? 16.f : 8.f;
                const float inv = expf(-LOG_THETA * ((float)fi * 2.0f / rot));
                const float ang = (float)t * inv;
                float sn, cs; sincosf(ang, &sn, &cs);
                if (r < 8) { p->rope[t * 8 + fi] = cs; p->rope[16384 + t * 8 + fi] = sn; }
                else { p->rope[32768 + t * 4 + fi] = cs; p->rope[32768 + 8192 + t * 4 + fi] = sn; }
            }
        }
    }
}

__device__ __forceinline__ void phase_modsum(KP p) {
    for (int i = BID() * 256 + TID(); i < 2 * 16 * 6144; i += gridDim.x * 256) {
        const int n = i % 6144, l = i / (16 * 6144);
        float s = p->b_ada[l * 6144 + n];
#pragma unroll
        for (int kc = 0; kc < 8; ++kc) s += p->modpart[(size_t)kc * (2 * 16 * 6144) + i];
        p->modf[i] = s;
    }
}

__device__ __forceinline__ void route_flush(KP p, char* lds, int lane, int wave, int n, int myrow, int layer) {
    const float* lg = (const float*)(lds + LDS_CTL + 512) + wave * 256;
    int* lc = (int*)(lds + LDS_CTL + 64);
    int* lbase = lc + 32;
    const int tid = wave * 64 + lane;
    if (tid < 32) lc[tid] = 0;
    __syncthreads();
    int cls = 0, lpos = 0;
    if (lane < n) {
        float aff[16], bia[16];
#pragma unroll
        for (int e = 0; e < 16; ++e) { aff[e] = 1.0f / (1.0f + expf(-lg[lane * 16 + e])); bia[e] = aff[e] + p->b_router[e]; }
        int bestg = 0; float bests = -INFINITY;
#pragma unroll
        for (int gi = 0; gi < 4; ++gi) {
            float m1 = -INFINITY, m2 = -INFINITY;
#pragma unroll
            for (int j = 0; j < 4; ++j) { const float vv = bia[gi * 4 + j]; if (vv > m1) { m2 = m1; m1 = vv; } else if (vv > m2) m2 = vv; }
            const float s = m1 + m2;
            if (s > bests) { bests = s; bestg = gi; }
        }
        float bsel[4], asel[4];
#pragma unroll
        for (int j = 0; j < 4; ++j) { bsel[j] = 0.f; asel[j] = 0.f; }
#pragma unroll
        for (int gi = 0; gi < 4; ++gi) if (gi == bestg) {
#pragma unroll
            for (int j = 0; j < 4; ++j) { bsel[j] = bia[gi * 4 + j]; asel[j] = aff[gi * 4 + j]; }
        }
        int i1 = -1, i2 = -1; float v1 = -INFINITY, v2 = -INFINITY;
#pragma unroll
        for (int j = 0; j < 4; ++j) { const float vv = bsel[j]; if (vv > v1) { v2 = v1; i2 = i1; v1 = vv; i1 = j; } else if (vv > v2) { v2 = vv; i2 = j; } }
        const int a = i1 < i2 ? i1 : i2, bb = i1 < i2 ? i2 : i1;
        float wa = 0.f, wb = 0.f;
#pragma unroll
        for (int j = 0; j < 4; ++j) { if (j == a) wa = asel[j]; if (j == bb) wb = asel[j]; }
        const float sw = wa + wb;
        const int pi = (a == 0) ? (bb - 1) : (a == 1 ? (bb + 1) : 5);
        cls = bestg * 6 + pi;
        *(float2*)(p->tokw + (size_t)myrow * 2) = make_float2(wa / sw, wb / sw);
        lpos = atomicAdd(&lc[cls], 1);
    }
    __syncthreads();
    if (tid < NCLS) { const int c = lc[tid]; lbase[tid] = c ? atomicAdd(&p->cnt[(layer * 32 + tid) * 64], c) : 0; }
    __syncthreads();
    if (lane < n) p->lists[(size_t)cls * T_TOK + lbase[cls] + lpos] = myrow;
}

template <int MODE>
__device__ __forceinline__ void phase_norm(KP p, char* lds, const float* xin, const float* g, const float* sh, const float* sc, int layer) {
    const int lane = TID() & 63, wave = TID() >> 6;
    float* wt = (float*)lds;
    if (MODE == 1) {
        __syncthreads();
        for (int i = TID(); i < 4096; i += 256) {
            const float4 w4 = ((const float4*)p->w_router)[i];
            const int k = i >> 2, e0 = (i & 3) * 4;
            wt[(e0 + 0) * 1024 + k] = w4.x; wt[(e0 + 1) * 1024 + k] = w4.y; wt[(e0 + 2) * 1024 + k] = w4.z; wt[(e0 + 3) * 1024 + k] = w4.w;
        }
        __syncthreads();
    }
    float* lgb = (float*)(lds + LDS_CTL + 512);
    int myrow = 0, it = 0;
    float4 vn[4];
    {
        const int row0 = BID() * 4 + wave;
        const float4* xr = (const float4*)(xin + (size_t)(row0 < T_TOK ? row0 : 0) * DM);
#pragma unroll
        for (int i = 0; i < 4; ++i) vn[i] = xr[lane + 64 * i];
    }
    for (int row = BID() * 4 + wave; row < T_TOK; row += gridDim.x * 4) {
        const int b = row >> 11;
        float4 v[4]; float ss = 0.f;
#pragma unroll
        for (int i = 0; i < 4; ++i) v[i] = vn[i];
        {
            const int rown = row + gridDim.x * 4;
            const float4* xr = (const float4*)(xin + (size_t)(rown < T_TOK ? rown : row) * DM);
#pragma unroll
            for (int i = 0; i < 4; ++i) vn[i] = xr[lane + 64 * i];
        }
#pragma unroll
        for (int i = 0; i < 4; ++i) ss += v[i].x * v[i].x + v[i].y * v[i].y + v[i].z * v[i].z + v[i].w * v[i].w;
#pragma unroll
        for (int o = 32; o >= 1; o >>= 1) ss += __shfl_xor(ss, o);
        const float rstd = 1.0f / sqrtf(ss * (1.0f / 1024.0f) + 1e-6f);
        float acc[16], ya[16];
#pragma unroll
        for (int i = 0; i < 4; ++i) {
            const int k = (lane + 64 * i) * 4;
            const float4 gg = *(const float4*)(g + k);
            float y[4] = {v[i].x * rstd * gg.x, v[i].y * rstd * gg.y, v[i].z * rstd * gg.z, v[i].w * rstd * gg.w};
            if (MODE != 2) {
                const float4 s1 = *(const float4*)(sh + (size_t)b * 6144 + k), s2 = *(const float4*)(sc + (size_t)b * 6144 + k);
                y[0] = y[0] * (1.f + s2.x) + s1.x; y[1] = y[1] * (1.f + s2.y) + s1.y; y[2] = y[2] * (1.f + s2.z) + s1.z; y[3] = y[3] * (1.f + s2.w) + s1.w;
                if (MODE == 0) *(h4*)(p->hn + ((size_t)(k >> 5) * T_TOK + row) * 32 + (k & 31)) = pack4(y[0], y[1], y[2], y[3]);
                else *(h4*)(p->hn + (size_t)row * DM + k) = pack4(y[0], y[1], y[2], y[3]);
            } else {
                *(float4*)(p->out + (size_t)row * DM + k) = make_float4(y[0], y[1], y[2], y[3]);
            }
            ya[4 * i] = y[0]; ya[4 * i + 1] = y[1]; ya[4 * i + 2] = y[2]; ya[4 * i + 3] = y[3];
        }
        if (MODE == 1) {
#pragma unroll
            for (int e = 0; e < 16; ++e) acc[e] = 0.f;
            float4 wq[2][4];
            const float* wl = wt + lane * 4;
#pragma unroll
            for (int e = 0; e < 4; ++e) wq[0][e] = *(const float4*)(wl + e * 1024);
#pragma unroll
            for (int st = 0; st < 16; ++st) {
                const int i = st >> 2, eg = st & 3, cur = st & 1;
                if (st + 1 < 16) {
                    const int i2 = (st + 1) >> 2, eg2 = (st + 1) & 3;
#pragma unroll
                    for (int e = 0; e < 4; ++e) wq[cur ^ 1][e] = *(const float4*)(wl + (eg2 * 4 + e) * 1024 + i2 * 256);
                }
#pragma unroll
                for (int e = 0; e < 4; ++e) {
                    const float4 w4 = wq[cur][e];
                    acc[eg * 4 + e] = fmaf(ya[4 * i], w4.x, fmaf(ya[4 * i + 1], w4.y, fmaf(ya[4 * i + 2], w4.z, fmaf(ya[4 * i + 3], w4.w, acc[eg * 4 + e]))));
                }
                __builtin_amdgcn_sched_barrier(0);
            }
        }
        if (MODE == 1) {
            const bool b5 = lane & 32, b4 = lane & 16, b3 = lane & 8, b2 = lane & 4;
            float r8[8], r4[4], r2[2];
#pragma unroll
            for (int e = 0; e < 8; ++e) { const float snd = b5 ? acc[e] : acc[e + 8], kp = b5 ? acc[e + 8] : acc[e]; r8[e] = kp + __shfl_xor(snd, 32); }
#pragma unroll
            for (int e = 0; e < 4; ++e) { const float snd = b4 ? r8[e] : r8[e + 4], kp = b4 ? r8[e + 4] : r8[e]; r4[e] = kp + __shfl_xor(snd, 16); }
#pragma unroll
            for (int e = 0; e < 2; ++e) { const float snd = b3 ? r4[e] : r4[e + 2], kp = b3 ? r4[e + 2] : r4[e]; r2[e] = kp + __shfl_xor(snd, 8); }
            float rv; { const float snd = b2 ? r2[0] : r2[1], kp = b2 ? r2[1] : r2[0]; rv = kp + __shfl_xor(snd, 4); }
            rv += __shfl_xor(rv, 2); rv += __shfl_xor(rv, 1);
            if ((lane & 3) == 0) lgb[(wave * 16 + it) * 16 + (lane >> 2)] = rv;
            if (lane == it) myrow = row;
            ++it;
            if (it == 16) { route_flush(p, lds, lane, wave, it, myrow, layer); it = 0; }
        }
    }
    if (MODE == 1 && it > 0) route_flush(p, lds, lane, wave, it, myrow, layer);
}

typedef float f2_t __attribute__((ext_vector_type(2)));
#define NRR 2
__device__ __forceinline__ void phase_norm_router(KP p, char* lds, const float* xin, const float* g, const float* sh, const float* sc, int layer) {
    const int lane = TID() & 63, wave = TID() >> 6;
    float* wt = (float*)lds;
    __syncthreads();
    for (int i = TID(); i < 4096; i += 256) {
        const float4 w4 = ((const float4*)p->w_router)[i];
        const int k = i >> 2, e0 = (i & 3) * 4;
        wt[(e0 + 0) * 1024 + k] = w4.x; wt[(e0 + 1) * 1024 + k] = w4.y; wt[(e0 + 2) * 1024 + k] = w4.z; wt[(e0 + 3) * 1024 + k] = w4.w;
    }
    __syncthreads();
    float* lgb = (float*)(lds + LDS_CTL + 512);
    int myrow = 0, it = 0;
    const int rstride = gridDim.x * 4;
    for (int row0 = BID() * 4 + wave; row0 < T_TOK; row0 += rstride * NRR) {
        f2_t ya[NRR / 2][16];
        float ss[NRR];
        int nv = 0;
#pragma unroll
        for (int j = 0; j < NRR; ++j) nv += (row0 + j * rstride < T_TOK) ? 1 : 0;
        {
            float4 v[NRR][4];
#pragma unroll
            for (int j = 0; j < NRR; ++j) {
                const int r = row0 + j * rstride;
                const float4* xr = (const float4*)(xin + (size_t)(r < T_TOK ? r : row0) * DM);
#pragma unroll
                for (int i = 0; i < 4; ++i) v[j][i] = xr[lane + 64 * i];
            }
#pragma unroll
            for (int j = 0; j < NRR; ++j) {
                ss[j] = 0.f;
#pragma unroll
                for (int i = 0; i < 4; ++i) ss[j] += v[j][i].x * v[j][i].x + v[j][i].y * v[j][i].y + v[j][i].z * v[j][i].z + v[j][i].w * v[j][i].w;
            }
#pragma unroll
            for (int o = 32; o >= 1; o >>= 1) {
#pragma unroll
                for (int j = 0; j < NRR; ++j) ss[j] += __shfl_xor(ss[j], o);
            }
#pragma unroll
            for (int j = 0; j < NRR; ++j) ss[j] = 1.0f / sqrtf(ss[j] * (1.0f / 1024.0f) + 1e-6f);
#pragma unroll
            for (int j = 0; j < NRR; ++j) {
                const int r = row0 + j * rstride;
                const int rr = r < T_TOK ? r : row0;
                const int b = rr >> 11;
                const float rs = ss[j];
#pragma unroll
                for (int i = 0; i < 4; ++i) {
                    const int k = (lane + 64 * i) * 4;
                    const float4 gg = *(const float4*)(g + k);
                    const float4 s1 = *(const float4*)(sh + (size_t)b * 6144 + k), s2 = *(const float4*)(sc + (size_t)b * 6144 + k);
                    const float y0 = v[j][i].x * rs * gg.x * (1.f + s2.x) + s1.x, y1 = v[j][i].y * rs * gg.y * (1.f + s2.y) + s1.y;
                    const float y2 = v[j][i].z * rs * gg.z * (1.f + s2.z) + s1.z, y3 = v[j][i].w * rs * gg.w * (1.f + s2.w) + s1.w;
                    if (r < T_TOK) *(h4*)(p->hn + (size_t)r * DM + k) = pack4(y0, y1, y2, y3);
                    if (j & 1) { ya[j >> 1][4 * i].y = y0; ya[j >> 1][4 * i + 1].y = y1; ya[j >> 1][4 * i + 2].y = y2; ya[j >> 1][4 * i + 3].y = y3; }
                    else       { ya[j >> 1][4 * i].x = y0; ya[j >> 1][4 * i + 1].x = y1; ya[j >> 1][4 * i + 2].x = y2; ya[j >> 1][4 * i + 3].x = y3; }
                }
                __builtin_amdgcn_sched_barrier(0);
            }
        }
        f2_t acc[NRR / 2][16];
#pragma unroll
        for (int e = 0; e < 16; ++e) {
#pragma unroll
            for (int jp = 0; jp < NRR / 2; ++jp) acc[jp][e] = (f2_t){0.f, 0.f};
        }
        {
            float4 wq[2][4];
            const float* wl = wt + lane * 4;
#pragma unroll
            for (int e = 0; e < 4; ++e) wq[0][e] = *(const float4*)(wl + e * 1024);
#pragma unroll
            for (int st = 0; st < 16; ++st) {
                const int i = st >> 2, eg = st & 3, cur = st & 1;
                if (st + 1 < 16) {
                    const int i2 = (st + 1) >> 2, eg2 = (st + 1) & 3;
#pragma unroll
                    for (int e = 0; e < 4; ++e) wq[cur ^ 1][e] = *(const float4*)(wl + (eg2 * 4 + e) * 1024 + i2 * 256);
                }
#pragma unroll
                for (int e = 0; e < 4; ++e) {
                    const float4 w4 = wq[cur][e];
#pragma unroll
                    for (int jp = 0; jp < NRR / 2; ++jp) {
                        f2_t a = acc[jp][eg * 4 + e];
                        a = ya[jp][4 * i + 3] * (f2_t){w4.w, w4.w} + a;
                        a = ya[jp][4 * i + 2] * (f2_t){w4.z, w4.z} + a;
                        a = ya[jp][4 * i + 1] * (f2_t){w4.y, w4.y} + a;
                        a = ya[jp][4 * i] * (f2_t){w4.x, w4.x} + a;
                        acc[jp][eg * 4 + e] = a;
                    }
                }
                __builtin_amdgcn_sched_barrier(0);
            }
        }
        const bool b5 = lane & 32, b4 = lane & 16, b3 = lane & 8, b2 = lane & 4;
#pragma unroll
        for (int j = 0; j < NRR; ++j) {
            float r8[8], r4[4], r2[2];
#pragma unroll
            for (int e = 0; e < 8; ++e) {
                const float lo = (j & 1) ? acc[j >> 1][e].y : acc[j >> 1][e].x, hi = (j & 1) ? acc[j >> 1][e + 8].y : acc[j >> 1][e + 8].x;
                const float snd = b5 ? lo : hi, kp = b5 ? hi : lo; r8[e] = kp + __shfl_xor(snd, 32);
            }
#pragma unroll
            for (int e = 0; e < 4; ++e) { const float snd = b4 ? r8[e] : r8[e + 4], kp = b4 ? r8[e + 4] : r8[e]; r4[e] = kp + __shfl_xor(snd, 16); }
#pragma unroll
            for (int e = 0; e < 2; ++e) { const float snd = b3 ? r4[e] : r4[e + 2], kp = b3 ? r4[e + 2] : r4[e]; r2[e] = kp + __shfl_xor(snd, 8); }
            float rv; { const float snd = b2 ? r2[0] : r2[1], kp = b2 ? r2[1] : r2[0]; rv = kp + __shfl_xor(snd, 4); }
            rv += __shfl_xor(rv, 2); rv += __shfl_xor(rv, 1);
            if (j < nv) {
                if ((lane & 3) == 0) lgb[(wave * 16 + it) * 16 + (lane >> 2)] = rv;
                if (lane == it) myrow = row0 + j * rstride;
                ++it;
            }
        }
        if (it == 16) { route_flush(p, lds, lane, wave, it, myrow, layer); it = 0; }
    }
    if (it > 0) route_flush(p, lds, lane, wave, it, myrow, layer);
}

template <class WF, class XF, class EPI>
__device__ __forceinline__ void gemm_tile(char* lds, int nkt, WF wf, XF xf, EPI epi) {
    const int tid = TID(), lane = tid & 63, wave = tid >> 6;
    const int wn = wave & 1, wm = wave >> 1, hh = lane >> 5;
    const int lrow = tid >> 3;
    const int lchunk = (tid & 7) ^ ((tid >> 4) & 7);
    const half_t* xs[4];
#pragma unroll
    for (int i = 0; i < 4; ++i) xs[i] = xf(lrow + 32 * i) + lchunk * 8;
    char* ldst = lds + lrow * 128 + (tid & 7) * 16;
    f16v acc[2][2];
#pragma unroll
    for (int i = 0; i < 2; ++i)
#pragma unroll
        for (int j = 0; j < 2; ++j)
#pragma unroll
            for (int r = 0; r < 16; ++r) acc[i][j][r] = 0.f;
    auto issue = [&](int kt, int s) {
        char* d = ldst + s * 32768;
#pragma unroll
        for (int i = 0; i < 4; ++i) glds16(wf(kt, lrow + 32 * i) + lchunk * 8, d + i * 4096);
#pragma unroll
        for (int i = 0; i < 4; ++i) glds16(xs[i] + kt * 64, d + 16384 + i * 4096);
    };
    __syncthreads();
    issue(0, 0);
    const int rsw = (lane >> 1) & 7;
    const int roff_w = (wn * 64 + (lane & 31)) * 128, roff_x = 16384 + (wm * 64 + (lane & 31)) * 128;
    for (int kt = 0; kt < nkt; ++kt) {
        asm volatile("s_waitcnt vmcnt(0)" ::: "memory");
        __syncthreads();
        if (kt + 1 < nkt) issue(kt + 1, (kt + 1) & 1);
        const char* base = lds + (kt & 1) * 32768;
#pragma unroll
        for (int ks = 0; ks < 4; ++ks) {
            const int co = ((2 * ks + hh) ^ rsw) << 4;
            const h8 a0 = *(const h8*)(base + roff_w + co), a1 = *(const h8*)(base + roff_w + 4096 + co);
            const h8 b0 = *(const h8*)(base + roff_x + co), b1 = *(const h8*)(base + roff_x + 4096 + co);
            acc[0][0] = __builtin_amdgcn_mfma_f32_32x32x16_f16(a0, b0, acc[0][0], 0, 0, 0);
            acc[0][1] = __builtin_amdgcn_mfma_f32_32x32x16_f16(a0, b1, acc[0][1], 0, 0, 0);
            acc[1][0] = __builtin_amdgcn_mfma_f32_32x32x16_f16(a1, b0, acc[1][0], 0, 0, 0);
            acc[1][1] = __builtin_amdgcn_mfma_f32_32x32x16_f16(a1, b1, acc[1][1], 0, 0, 0);
        }
    }
    epi(acc, wn, wm, lane);
}

template <class WF, class XF, class EPI>
__device__ __forceinline__ void gemm_tile2(char* lds, int nkt, size_t xkstride, WF wf, XF xf, EPI epi) {
    const int tid = TID(), lane = tid & 63, wave = tid >> 6;
    const int wn = wave & 1, wm = wave >> 1, hh = lane >> 5;
    const int lrow = tid >> 2;
    const int lchunk = (tid & 3) ^ ((tid >> 4) & 3);
    const half_t* xs[2];
#pragma unroll
    for (int i = 0; i < 2; ++i) xs[i] = xf(lrow + 64 * i) + lchunk * 8;
    char* ldst = lds + lrow * 64 + (tid & 3) * 16;
    f16v acc[4][2];
#pragma unroll
    for (int i = 0; i < 4; ++i)
#pragma unroll
        for (int j = 0; j < 2; ++j)
#pragma unroll
            for (int r = 0; r < 16; ++r) acc[i][j][r] = 0.f;
    auto issue = [&](int kt, int s) {
        char* d = ldst + s * 24576;
#pragma unroll
        for (int i = 0; i < 4; ++i) glds16(wf(kt, lrow + 64 * i) + lchunk * 8, d + i * 4096);
#pragma unroll
        for (int i = 0; i < 2; ++i) glds16(xs[i] + (size_t)kt * xkstride, d + 16384 + i * 4096);
    };
    __syncthreads();
    issue(0, 0); issue(1, 1);
    const int rsw = (lane >> 2) & 3;
    const int roff_w = (wn * 128 + (lane & 31)) * 64, roff_x = 16384 + (wm * 64 + (lane & 31)) * 64;
    int st = 0;
    for (int kt = 0; kt < nkt; ++kt) {
        if (kt + 1 < nkt) asm volatile("s_waitcnt vmcnt(6)" ::: "memory");
        else asm volatile("s_waitcnt vmcnt(0)" ::: "memory");
        asm volatile("s_waitcnt lgkmcnt(0)" ::: "memory");
        __builtin_amdgcn_s_barrier();
        if (kt + 2 < nkt) issue(kt + 2, st >= 1 ? st - 1 : 2);
        const char* base = lds + st * 24576;
        st = st == 2 ? 0 : st + 1;
#pragma unroll
        for (int ks = 0; ks < 2; ++ks) {
            const int co = ((2 * ks + hh) ^ rsw) << 4;
            h8 a[4], b[2];
#pragma unroll
            for (int i = 0; i < 4; ++i) a[i] = *(const h8*)(base + roff_w + i * 2048 + co);
#pragma unroll
            for (int j = 0; j < 2; ++j) b[j] = *(const h8*)(base + roff_x + j * 2048 + co);
#pragma unroll
            for (int i = 0; i < 4; ++i)
#pragma unroll
                for (int j = 0; j < 2; ++j) acc[i][j] = __builtin_amdgcn_mfma_f32_32x32x16_f16(a[i], b[j], acc[i][j], 0, 0, 0);
        }
    }
    epi(acc, wn, wm, lane);
}

__device__ __forceinline__ void phase_inproj(KP p, char* lds, int l) {
    const half_t* W = p->Wt_in + (size_t)l * NP * DM;
    const float* rc16 = p->rope; const float* rs16 = p->rope + 16384; const float* rc8 = p->rope + 32768; const float* rs8 = p->rope + 32768 + 8192;
    for (int u = BID(); u < 256 * 10; u += gridDim.x) {
        const int xl = u & 7, Lx = u >> 3, mi = Lx & 15, rr_ = Lx >> 4;
        const int nt = rr_ % 10, mt = 32 * xl + 16 * (rr_ / 10) + mi;
        gemm_tile2(lds, 32, (size_t)T_TOK * 32,
            [&](int kt, int row) { int n = nt * 256 + row; n = n < NP ? n : NP - 1; return W + ((size_t)kt * NP + n) * 32; },
            [&](int row) { return p->hn + (size_t)(mt * 128 + row) * 32; },
            [&](f16v (&acc)[4][2], int wn, int wm, int lane) {
                const int hh = lane >> 5;
                half_t* stg = (half_t*)lds;
                __syncthreads();
#pragma unroll
                for (int i = 0; i < 4; ++i) {
                    const int nb = nt * 256 + wn * 128 + i * 32;
                    if (nb == 1216 || nb == 1248 || nb >= NP) continue;
                    if (nt < 2) {
                        if (i & 1) continue;
#pragma unroll
                        for (int j = 0; j < 2; ++j) {
                            half_t* dst = stg + (wm * 64 + j * 32 + (lane & 31)) * 260 + wn * 64 + (i >> 1) * 32 + 4 * hh;
#pragma unroll
                            for (int g = 0; g < 4; ++g) {
                                float a4[4];
#pragma unroll
                                for (int r = 0; r < 4; ++r) a4[r] = acc[i][j][4 * g + r] * sigmoidf_(acc[i + 1][j][4 * g + r]);
                                *(h4*)(dst + 8 * g) = pack4(a4[0], a4[1], a4[2], a4[3]);
                            }
                        }
                        continue;
                    }
                    const bool rope64 = ((nb >= PC_DQ && nb < PC_DV) || (nb >= PC_MQ && nb < PC_MV)) && ((nb & 63) == 0);
                    const bool rope32 = (nb >= PC_IQ && nb < PC_IW);
#pragma unroll
                    for (int j = 0; j < 2; ++j) {
                        const int tok = mt * 128 + wm * 64 + j * 32 + (lane & 31);
                        const int t = tok & 2047;
                        f16v v = acc[i][j];
                        if (nb == PC_IW) { if (hh == 0) *(float4*)(p->iwf + (size_t)tok * 4) = make_float4(v[0], v[1], v[2], v[3]); continue; }
                        if (rope64) {
                            const float4 c4 = *(const float4*)(rc16 + t * 8 + 4 * hh), s4 = *(const float4*)(rs16 + t * 8 + 4 * hh);
                            const float cc[4] = {c4.x, c4.y, c4.z, c4.w}, sn[4] = {s4.x, s4.y, s4.z, s4.w};
#pragma unroll
                            for (int r = 0; r < 4; ++r) { const float x1 = v[r], x2 = v[r + 4]; v[r] = x1 * cc[r] - x2 * sn[r]; v[r + 4] = x2 * cc[r] + x1 * sn[r]; }
                        } else if (rope32) {
                            const float4 c4 = *(const float4*)(rc8 + t * 4), s4 = *(const float4*)(rs8 + t * 4);
                            const float cc[4] = {c4.x, c4.y, c4.z, c4.w}, sn[4] = {s4.x, s4.y, s4.z, s4.w};
#pragma unroll
                            for (int r = 0; r < 4; ++r) { const float o = __shfl_xor(v[r], 32); v[r] = hh ? (v[r] * cc[r] + o * sn[r]) : (v[r] * cc[r] - o * sn[r]); }
                        }
                        if ((nb >= PC_DQ && nb < PC_DK) || (nb >= PC_MQ && nb < PC_MK)) {
#pragma unroll
                            for (int r = 0; r < 16; ++r) v[r] *= 0.18033688011112042f;
                        }
                        half_t* dst = stg + (wm * 64 + j * 32 + (lane & 31)) * 260 + wn * 128 + i * 32 + 4 * hh;
#pragma unroll
                        for (int g = 0; g < 4; ++g) *(h4*)(dst + 8 * g) = pack4(v[4 * g], v[4 * g + 1], v[4 * g + 2], v[4 * g + 3]);
                    }
                }
                __syncthreads();
                const int wv_ = TID() >> 6;
#pragma unroll 4
                for (int it = 0; it < 32; ++it) {
                    const int row = it * 4 + wv_;
                    const uint2 v2 = *(const uint2*)(stg + row * 260 + lane * 4);
                    if (nt < 2) { if (lane < 32) *(uint2*)(p->P + (size_t)(mt * 128 + row) * NP + nt * 128 + lane * 4) = v2; }
                    else { const int n = nt * 256 + lane * 4; if (n < NP) *(uint2*)(p->P + (size_t)(mt * 128 + row) * NP + n) = v2; }
                }
            });
    }
}

__device__ __forceinline__ void stage_acc_f32(char* lds, const f16v (&acc)[2][2], int wn, int wm, int lane) {
    float* stg = (float*)lds;
    const int hh = lane >> 5;
    __syncthreads();
#pragma unroll
    for (int j = 0; j < 2; ++j)
#pragma unroll
        for (int i = 0; i < 2; ++i)
#pragma unroll
            for (int g = 0; g < 4; ++g)
                *(float4*)(stg + (wm * 64 + j * 32 + (lane & 31)) * 132 + wn * 64 + i * 32 + 4 * hh + 8 * g) = make_float4(acc[i][j][4 * g], acc[i][j][4 * g + 1], acc[i][j][4 * g + 2], acc[i][j][4 * g + 3]);
    __syncthreads();
}
__device__ __forceinline__ void phase_outproj(KP p, char* lds, int l, const float* xin) {
    const half_t* W = p->Wt_o + (size_t)l * DM * DM;
    const float* g1 = p->modf + (size_t)l * 16 * 6144 + 2 * 1024;
    for (int u = BID(); u < 256 * 4; u += gridDim.x) {
        const int xl = u & 7, Lx = u >> 3, mi = Lx & 7, rr_ = Lx >> 3;
        const int nt = rr_ & 3, mt = 32 * xl + 8 * (rr_ >> 2) + mi;
        gemm_tile2(lds, 32, (size_t)T_TOK * 32,
            [&](int kt, int row) { return W + ((size_t)kt * DM + nt * 256 + row) * 32; },
            [&](int row) { return p->ycat + (size_t)(mt * 128 + row) * 32; },
            [&](f16v (&acc)[4][2], int wn, int wm, int lane) {
                const int hh = lane >> 5, tid = TID();
                float* stg = (float*)lds;
#pragma unroll
                for (int rnd = 0; rnd < 2; ++rnd) {
                    __syncthreads();
                    if (wm == rnd) {
#pragma unroll
                        for (int j = 0; j < 2; ++j)
#pragma unroll
                            for (int i = 0; i < 4; ++i)
#pragma unroll
                                for (int g = 0; g < 4; ++g)
                                    *(float4*)(stg + (j * 32 + (lane & 31)) * 260 + wn * 128 + i * 32 + 4 * hh + 8 * g) = make_float4(acc[i][j][4 * g], acc[i][j][4 * g + 1], acc[i][j][4 * g + 2], acc[i][j][4 * g + 3]);
                    }
                    __syncthreads();
#pragma unroll 4
                    for (int it = 0; it < 16; ++it) {
                        const int idx = it * 256 + tid, row = idx >> 6, c = idx & 63;
                        const int tok = mt * 128 + rnd * 64 + row, n = nt * 256 + 4 * c;
                        const float4 a4 = *(const float4*)(stg + row * 260 + 4 * c);
                        const float4 xi = *(const float4*)(xin + (size_t)tok * DM + n);
                        const float4 gg = *(const float4*)(g1 + (size_t)(tok >> 11) * 6144 + n);
                        float4 o; o.x = xi.x + gg.x * a4.x; o.y = xi.y + gg.y * a4.y; o.z = xi.z + gg.z * a4.z; o.w = xi.w + gg.w * a4.w;
                        *(float4*)(p->out + (size_t)tok * DM + n) = o;
                    }
                }
            });
    }
}

__device__ __forceinline__ bool moe_tile(const int* cnt, int tile, int& cls, int& pos0, int& n) {
    int tb = 0;
    for (int c = 0; c < NCLS; ++c) {
        const int nc = cnt[c * 64], nt = (nc + 127) >> 7;
        if (tile < tb + nt) { cls = c; pos0 = (tile - tb) * 128; n = nc; return true; }
        tb += nt;
    }
    return false;
}
__device__ __forceinline__ void cls_experts(int cls, int& e1, int& e2) {
    const int g = cls / 6, pi = cls % 6;
    const int a = pi < 3 ? 0 : (pi < 5 ? 1 : 2);
    const int b = pi < 3 ? pi + 1 : (pi < 5 ? pi - 1 : 3);
    e1 = g * 4 + a; e2 = g * 4 + b;
}
__device__ __forceinline__ void phase_moe_up(KP p, char* lds, int l) {
    const int* cnt = p->cnt + l * 32 * 64;
    for (int u = BID(); u < (256 + NCLS) * 8; u += gridDim.x) {
        const int xl = u & 7, Lx = u >> 3;
        const int nt = Lx & 7, tile = (Lx >> 3) * 8 + xl;
        int cls, pos0, nc;
        if (!moe_tile(cnt, tile, cls, pos0, nc)) continue;
        int e1, e2; cls_experts(cls, e1, e2);
        const int slot = nt >> 2;
        const half_t* W = p->Wt_gu + ((size_t)(l * 16 + (slot ? e2 : e1)) * 512 + (nt & 3) * 128) * 1024;
        const int* lst = p->lists + (size_t)cls * T_TOK + pos0;
        const int nvalid = nc - pos0;
        gemm_tile(lds, 16,
            [&](int kt, int row) { return W + (size_t)row * 1024 + kt * 64; },
            [&](int row) { const int tok = lst[row < nvalid ? row : 0]; return p->hn + (size_t)tok * DM; },
            [&](f16v (&acc)[2][2], int wn, int wm, int lane) {
                const int hh = lane >> 5;
#pragma unroll
                for (int j = 0; j < 2; ++j) {
                    const int row = wm * 64 + j * 32 + (lane & 31);
                    if (row < nvalid) {
                        const int tok = lst[row];
                        const float wgt = p->tokw[(size_t)tok * 2 + slot];
                        half_t* dst = p->act + (size_t)tok * 512 + slot * 256 + ((nt & 3) * 2 + wn) * 32 + 4 * hh;
#pragma unroll
                        for (int g = 0; g < 4; ++g) {
                            float a[4];
#pragma unroll
                            for (int r = 0; r < 4; ++r) { const float gv = acc[0][j][4 * g + r], uv = acc[1][j][4 * g + r]; a[r] = gv * sigmoidf_(gv) * uv * wgt; }
                            *(h4*)(dst + 8 * g) = pack4(a[0], a[1], a[2], a[3]);
                        }
                    }
                }
            });
    }
}
__device__ __forceinline__ void phase_moe_down(KP p, char* lds, int l, float gsc) {
    const int* cnt = p->cnt + l * 32 * 64;
    const float* g2 = p->modf + (size_t)l * 16 * 6144 + 5 * 1024;
    for (int u = BID(); u < (256 + NCLS) * 8; u += gridDim.x) {
        const int xl = u & 7, Lx = u >> 3;
        const int nt = Lx & 7, tile = (Lx >> 3) * 8 + xl;
        int cls, pos0, nc;
        if (!moe_tile(cnt, tile, cls, pos0, nc)) continue;
        int e1, e2; cls_experts(cls, e1, e2);
        const half_t* W1 = p->Wt_d + ((size_t)(l * 16 + e1) * 1024 + nt * 128) * 256;
        const half_t* W2 = p->Wt_d + ((size_t)(l * 16 + e2) * 1024 + nt * 128) * 256;
        const int* lst = p->lists + (size_t)cls * T_TOK + pos0;
        const int nvalid = nc - pos0;
        gemm_tile(lds, 8,
            [&](int kt, int row) { return (kt < 4 ? W1 : W2) + (size_t)row * 256 + (kt & 3) * 64; },
            [&](int row) { const int tok = lst[row < nvalid ? row : 0]; return p->act + (size_t)tok * 512; },
            [&](f16v (&acc)[2][2], int wn, int wm, int lane) {
                const int hh = lane >> 5;
#pragma unroll
                for (int j = 0; j < 2; ++j) {
                    const int row = wm * 64 + j * 32 + (lane & 31);
                    if (row < nvalid) {
                        const int tok = lst[row];
                        const int b = tok >> 11;
#pragma unroll
                        for (int i = 0; i < 2; ++i) {
                            const int nb = nt * 128 + wn * 64 + i * 32 + 4 * hh;
#pragma unroll
                            for (int g = 0; g < 4; ++g) {
                                const int n = nb + 8 * g;
                                float4* xp = (float4*)(p->out + (size_t)tok * DM + n);
                                float4 xi = *xp;
                                const float4 gg = *(const float4*)(g2 + (size_t)b * 6144 + n);
                                xi.x += gsc * gg.x * acc[i][j][4 * g]; xi.y += gsc * gg.y * acc[i][j][4 * g + 1]; xi.z += gsc * gg.z * acc[i][j][4 * g + 2]; xi.w += gsc * gg.w * acc[i][j][4 * g + 3];
                                *xp = xi;
                            }
                        }
                    }
                }
            });
    }
}

__device__ __forceinline__ void dsa_select_unit(KP p, char* lds, int b, int qt) {
    unsigned* hist = (unsigned*)lds;
    unsigned* maskl = hist + 16 * 257 + 16;
    unsigned* stP = maskl + 1024;
    unsigned* stNeed = stP + 16;
    unsigned* stDone = stNeed + 16;
    unsigned* flag = stDone + 16;
    unsigned* dummyb = flag + 16;
    const int tid = TID(), lane = tid & 63, wave = tid >> 6;
    const int q0 = qt * 16, tokbase = b * SEQ;
    __syncthreads();
    if (q0 < 256) {
        for (int i = tid; i < 1024; i += 256) {
            const int q = i >> 6, wd = i & 63;
            const int n = q0 + q + 1 - 32 * wd;
            const unsigned w = n >= 32 ? 0xFFFFFFFFu : (n <= 0 ? 0u : ((1u << n) - 1u));
            p->dmask[(size_t)(tokbase + q0 + q) * 64 + wd] = w;
        }
        return;
    }
    for (int i = tid; i < 1024; i += 256) maskl[i] = 0u;
    if (tid < 16) { stP[tid] = 0u; stNeed[tid] = 256u; stDone[tid] = 0u; }
    for (int i = tid; i < 16 * 257; i += 256) hist[i] = 0u;
    __syncthreads();
    const int ql = lane & 15, fq = lane >> 4;
    const int tq = q0 + ql;
    const half_t* Pb = p->P + (size_t)tokbase * NP;
    h8 iqf[4];
#pragma unroll
    for (int hd = 0; hd < 4; ++hd) iqf[hd] = *(const h8*)(Pb + (size_t)tq * NP + PC_IQ + hd * 32 + 8 * fq);
    const float4 iw4 = *(const float4*)(p->iwf + (size_t)(tokbase + tq) * 4);
    const float wsc0 = iw4.x * 0.08838834764831845f, wsc1 = iw4.y * 0.08838834764831845f, wsc2 = iw4.z * 0.08838834764831845f, wsc3 = iw4.w * 0.08838834764831845f;
    const int ng = qt + 1;
    unsigned sc[32][4];
    const half_t* ikp = Pb + (size_t)ql * NP + PC_IK + 8 * fq;
#pragma unroll
    for (int gb = 0; gb < 4; ++gb) {
        h8 ik[8];
#pragma unroll
        for (int x = 0; x < 8; ++x) {
            int g = wave + 4 * (gb * 8 + x);
            g = g < ng ? g : ng - 1;
            ik[x] = *(const h8*)(ikp + (size_t)(16 * g) * NP);
        }
#pragma unroll
        for (int x = 0; x < 8; ++x) {
            const int gi = gb * 8 + x;
            const int g = wave + 4 * gi;
            const f4v z = {0.f, 0.f, 0.f, 0.f};
            const f4v c0 = __builtin_amdgcn_mfma_f32_16x16x32_f16(ik[x], iqf[0], z, 0, 0, 0);
            const f4v c1 = __builtin_amdgcn_mfma_f32_16x16x32_f16(ik[x], iqf[1], z, 0, 0, 0);
            const f4v c2 = __builtin_amdgcn_mfma_f32_16x16x32_f16(ik[x], iqf[2], z, 0, 0, 0);
            const f4v c3 = __builtin_amdgcn_mfma_f32_16x16x32_f16(ik[x], iqf[3], z, 0, 0, 0);
#pragma unroll
            for (int r = 0; r < 4; ++r) {
                const int j = 16 * g + 4 * fq + r;
                float sv = wsc0 * __builtin_amdgcn_fmed3f(c0[r], 0.f, INFINITY);
                sv = fmaf(wsc1, __builtin_amdgcn_fmed3f(c1[r], 0.f, INFINITY), sv);
                sv = fmaf(wsc2, __builtin_amdgcn_fmed3f(c2[r], 0.f, INFINITY), sv);
                sv = fmaf(wsc3, __builtin_amdgcn_fmed3f(c3[r], 0.f, INFINITY), sv);
                sv += 0.0f;
                const int sb = __float_as_int(sv);
                const unsigned su = (unsigned)sb ^ ((unsigned)(sb >> 31) | 0x80000000u);
                const unsigned ck = (su & 0xFFFFF800u) | (unsigned)(2047 - j);
                sc[gi][r] = (g < ng && j <= tq) ? ck : 0u;
            }
            if (g < ng) {
#pragma unroll
                for (int r = 0; r < 4; ++r) atomicAdd(hist + ql * 257 + (sc[gi][r] >> 24), 1u);
            }
        }
    }
    bool alldone = false;
    for (int pass = 0; pass < 5; ++pass) {
        const bool fin = alldone;
        if (!fin && pass > 0) { for (int i = tid; i < 16 * 257; i += 256) hist[i] = 0u; }
        if (tid == 0) *flag = 0u;
        __syncthreads();
        if (pass > 0) {
        const unsigned sP = stP[ql], sDone = stDone[ql];
        int wv = wave, fqv = fq;
        asm volatile("" : "+v"(wv), "+v"(fqv));
        if (fin) {
            const int sh = (int)(32u - 8u * (sDone ? sDone : 1u));
            unsigned* mrow = maskl + ql * 64;
#pragma unroll
            for (int gi = 0; gi < 32; ++gi) {
                const int g = wv + 4 * gi;
                unsigned nib = 0u;
#pragma unroll
                for (int r = 0; r < 4; ++r) {
                    const unsigned uu = sc[gi][r];
                    nib |= ((uu >> sh) >= sP) ? (1u << r) : 0u;
                }
                if (g < ng) atomicOr(&mrow[g >> 1], nib << ((g & 1) * 16 + 4 * fqv));
            }
        } else {
            const int shm = pass ? 32 - 8 * pass : 0, shd = 24 - 8 * pass;
            const unsigned orm = pass ? 0u : 0xFFFFFFFFu;
            const unsigned cmpv = pass ? (sDone == 0u ? sP : 0xFFFFFFFFu) : 0xFFFFFFFFu;
            unsigned* hrow = hist + ql * 257;
            unsigned* dummy = dummyb + lane;
#pragma unroll
            for (int gi = 0; gi < 32; ++gi) {
                const int g = wv + 4 * gi;
                if (g < ng) {
#pragma unroll
                    for (int r = 0; r < 4; ++r) {
                        const unsigned uu = sc[gi][r];
                        const bool match = (((uu >> shm) | orm) == cmpv);
                        const unsigned dig = (uu >> shd) & 255u;
                        unsigned* a = match ? hrow + dig : dummy;
                        atomicAdd(a, 1u);
                    }
                }
            }
        }
        }
        __syncthreads();
        if (fin) break;
        {
            const int qq = tid >> 4, seg = tid & 15;
            const bool active = (stDone[qq] == 0u);
            unsigned c16 = 0u;
            if (active) {
#pragma unroll
                for (int d = 0; d < 16; ++d) c16 += hist[qq * 257 + seg * 16 + d];
            }
            unsigned v = c16;
#pragma unroll
            for (int off = 1; off < 16; off <<= 1) { const unsigned t = __shfl_down(v, off, 16); if (seg + off < 16) v += t; }
            const unsigned suf = v - c16;
            const unsigned need = stNeed[qq];
            if (active && suf < need && need <= suf + c16) {
                unsigned run = suf, D = 0u, cD = 0u, nn = need;
                for (int d = 15; d >= 0; --d) {
                    const unsigned cc = hist[qq * 257 + seg * 16 + d];
                    if (run + cc >= need) { D = (unsigned)(seg * 16 + d); cD = cc; nn = need - run; break; }
                    run += cc;
                }
                const bool done = (cD == nn) || pass == 3;
                stP[qq] = (stP[qq] << 8) | D; stNeed[qq] = nn;
                if (done) stDone[qq] = (unsigned)(pass + 1); else atomicAdd(flag, 1u);
            }
        }
        __syncthreads();
        alldone = (*flag == 0u);
    }
    for (int i = tid; i < 1024; i += 256) p->dmask[(size_t)(tokbase + q0 + (i >> 6)) * 64 + (i & 63)] = maskl[i];
}

__device__ __forceinline__ void conv_unit(KP p, char* lds, int l, int b, int c) {
    float* red = (float*)lds;
    const int ch = TID(), lane = ch & 63, wave = ch >> 6;
    const int t0 = c * 32, tokbase = b * SEQ;
    float aw[62];
#pragma unroll
    for (int rr = 0; rr < 62; ++rr) {
        int tt = t0 - 30 + rr; const bool ok = tt >= 0; tt = ok ? tt : t0;
        const float v = (float)p->P[(size_t)(tokbase + tt) * NP + ch];
        aw[rr] = ok ? v : 0.f;
    }
    float w[31];
#pragma unroll
    for (int i = 0; i < 31; ++i) w[i] = p->w_dw[(l * 31 + i) * 256 + ch];
    const float bias = p->b_dw[l * 256 + ch];
    float y[32], s1[32], s2[32];
#pragma unroll
    for (int tk = 0; tk < 32; ++tk) {
        float sacc = bias;
#pragma unroll
        for (int i = 0; i < 31; ++i) sacc = fmaf(aw[tk + i], w[i], sacc);
        y[tk] = sacc; s1[tk] = sacc; s2[tk] = sacc * sacc;
    }
    {
        const bool b5 = lane & 32, b4 = lane & 16, b3 = lane & 8, b2 = lane & 4, b1 = lane & 2;
        float a16[16], c16[16], a8[8], c8[8], a4[4], c4[4], a2[2], c2[2];
#pragma unroll
        for (int e = 0; e < 16; ++e) { a16[e] = (b5 ? s1[e + 16] : s1[e]) + __shfl_xor(b5 ? s1[e] : s1[e + 16], 32); c16[e] = (b5 ? s2[e + 16] : s2[e]) + __shfl_xor(b5 ? s2[e] : s2[e + 16], 32); }
#pragma unroll
        for (int e = 0; e < 8; ++e) { a8[e] = (b4 ? a16[e + 8] : a16[e]) + __shfl_xor(b4 ? a16[e] : a16[e + 8], 16); c8[e] = (b4 ? c16[e + 8] : c16[e]) + __shfl_xor(b4 ? c16[e] : c16[e + 8], 16); }
#pragma unroll
        for (int e = 0; e < 4; ++e) { a4[e] = (b3 ? a8[e + 4] : a8[e]) + __shfl_xor(b3 ? a8[e] : a8[e + 4], 8); c4[e] = (b3 ? c8[e + 4] : c8[e]) + __shfl_xor(b3 ? c8[e] : c8[e + 4], 8); }
#pragma unroll
        for (int e = 0; e < 2; ++e) { a2[e] = (b2 ? a4[e + 2] : a4[e]) + __shfl_xor(b2 ? a4[e] : a4[e + 2], 4); c2[e] = (b2 ? c4[e + 2] : c4[e]) + __shfl_xor(b2 ? c4[e] : c4[e + 2], 4); }
        float av = (b1 ? a2[1] : a2[0]) + __shfl_xor(b1 ? a2[0] : a2[1], 2), cv = (b1 ? c2[1] : c2[0]) + __shfl_xor(b1 ? c2[0] : c2[1], 2);
        av += __shfl_xor(av, 1); cv += __shfl_xor(cv, 1);
        const int tokk = (b5 ? 16 : 0) + (b4 ? 8 : 0) + (b3 ? 4 : 0) + (b2 ? 2 : 0) + (b1 ? 1 : 0);
        __syncthreads();
        if ((lane & 1) == 0) { red[(tokk * 4 + wave) * 2] = av; red[(tokk * 4 + wave) * 2 + 1] = cv; }
        __syncthreads();
    }
    const float lg = p->ln_g[l * 256 + ch], lb = p->ln_b[l * 256 + ch];
#pragma unroll
    for (int tk = 0; tk < 32; ++tk) {
        const float4 ra = *(const float4*)(red + tk * 8), rb = *(const float4*)(red + tk * 8 + 4);
        const float t1 = (ra.x + ra.z) + (rb.x + rb.z);
        const float t2 = (ra.y + ra.w) + (rb.y + rb.w);
        const float mu = t1 * (1.0f / 256.0f);
        float var = t2 * (1.0f / 256.0f) - mu * mu; var = var < 0.f ? 0.f : var;
        float z = (y[tk] - mu) * (1.0f / sqrtf(var + 1e-6f)) * lg + lb;
        z = z * sigmoidf_(z);
        p->ycat[((size_t)(ch >> 5) * T_TOK + tokbase + t0 + tk) * 32 + (ch & 31)] = (half_t)z;
    }
}

__device__ __forceinline__ void kmean_unit(KP p, char* lds, int b, int h, int blk) {
    float* part = (float*)lds;
    const int tid = TID(), d = tid & 63, pt = tid >> 6;
    const half_t* r = p->P + (size_t)(b * SEQ + blk * 256 + pt * 64) * NP + PC_MK + h * 64 + d;
    float s = 0.f;
#pragma unroll 16
    for (int k = 0; k < 64; ++k) s += (float)r[(size_t)k * NP];
    __syncthreads();
    part[pt * 64 + d] = s;
    __syncthreads();
    if (tid < 64) p->kmean[(((size_t)b * 6 + h) * 8 + blk) * 64 + tid] = ((part[tid] + part[64 + tid]) + (part[128 + tid] + part[192 + tid])) * (1.0f / 256.0f);
}

#ifndef POST_MASK
#define POST_MASK 7
#endif
__device__ __forceinline__ void phase_post(KP p, char* lds, int l, int tm) {
    const int NA = 2048, NB = 1024, NC = 768;
    const int G_ = gridDim.x;
    for (int u0 = BID(), k_ = 0; u0 < NA + NB + NC; u0 += G_, ++k_) {
        int u = u0;
        if (u0 < NA && (k_ & 1) && (k_ + 1) * G_ <= NA) u = k_ * G_ + (G_ - 1 - (u0 - k_ * G_));
        if (u < NA) { if (tm & 1) dsa_select_unit(p, lds, u % 16, 127 - (u / 16)); }
        else if (u < NA + NB) { const int v = u - NA; if (tm & 2) conv_unit(p, lds, l, v % 16, v / 16); }
        else { const int v = u - NA - NB; if (tm & 4) kmean_unit(p, lds, v / 48, (v / 8) % 6, v % 8); }
    }
}

template <int MODE>
__device__ __forceinline__ void attn_unit(KP p, char* lds, int b, int h, int qt) {
    const int tid = TID(), lane = tid & 63, wave = tid >> 6, hh = lane >> 5, ql = lane & 31;
    const int q0 = qt * 128, tokbase = b * SEQ;
    const int tq = q0 + wave * 32 + ql;
    const half_t* Pb = p->P + (size_t)tokbase * NP;
    const int QOFF = MODE ? PC_MQ + h * 64 : PC_DQ + h * 64;
    const int KOFF = MODE ? PC_MK + h * 64 : PC_DK;
    const int VOFF = MODE ? PC_MV + h * 64 : PC_DV;
    const int own = qt >> 1;
    unsigned mysel = 0u, anysel = 0u;
    __syncthreads();
    if (MODE == 1) {
        float* km = (float*)(lds + 32768);
        float* gts = km + 512;
        unsigned* selq = (unsigned*)(gts + 1024);
        unsigned* anyb = selq + 128;
        for (int i = tid; i < 512; i += 256) km[i] = p->kmean[((size_t)b * 6 + h) * 512 + i];
        if (tid == 0) *anyb = 0u;
        __syncthreads();
        {
            const int q = tid & 127, hf = tid >> 7;
            if (hf * 4 < own) {
                const half_t* qr = Pb + (size_t)(q0 + q) * NP + QOFF;
                float g0 = 0.f, g1 = 0.f, g2 = 0.f, g3 = 0.f;
#pragma unroll
                for (int c8 = 0; c8 < 8; ++c8) {
                    const h8 qv = *(const h8*)(qr + c8 * 8);
#pragma unroll
                    for (int j4 = 0; j4 < 2; ++j4) {
                        const int d = c8 * 8 + j4 * 4;
                        const float q0f = (float)qv[j4 * 4], q1f = (float)qv[j4 * 4 + 1], q2f = (float)qv[j4 * 4 + 2], q3f = (float)qv[j4 * 4 + 3];
                        const float4 k0 = *(const float4*)(km + (hf * 4 + 0) * 64 + d), k1 = *(const float4*)(km + (hf * 4 + 1) * 64 + d);
                        const float4 k2 = *(const float4*)(km + (hf * 4 + 2) * 64 + d), k3 = *(const float4*)(km + (hf * 4 + 3) * 64 + d);
                        g0 = fmaf(q0f, k0.x, g0); g0 = fmaf(q1f, k0.y, g0); g0 = fmaf(q2f, k0.z, g0); g0 = fmaf(q3f, k0.w, g0);
                        g1 = fmaf(q0f, k1.x, g1); g1 = fmaf(q1f, k1.y, g1); g1 = fmaf(q2f, k1.z, g1); g1 = fmaf(q3f, k1.w, g1);
                        g2 = fmaf(q0f, k2.x, g2); g2 = fmaf(q1f, k2.y, g2); g2 = fmaf(q2f, k2.z, g2); g2 = fmaf(q3f, k2.w, g2);
                        g3 = fmaf(q0f, k3.x, g3); g3 = fmaf(q1f, k3.y, g3); g3 = fmaf(q2f, k3.z, g3); g3 = fmaf(q3f, k3.w, g3);
                    }
                }
                gts[q * 8 + hf * 4 + 0] = g0; gts[q * 8 + hf * 4 + 1] = g1; gts[q * 8 + hf * 4 + 2] = g2; gts[q * 8 + hf * 4 + 3] = g3;
            }
        }
        __syncthreads();
        if (tid < 128) {
            unsigned m = 0u;
            const int want = own < 3 ? own : 3;
            for (int r = 0; r < want; ++r) {
                int best = -1; float bv = -INFINITY;
                for (int j = 0; j < own; ++j) { const float gv = gts[tid * 8 + j]; if (!((m >> j) & 1u) && (best < 0 || gv > bv)) { best = j; bv = gv; } }
                m |= 1u << best;
            }
            selq[tid] = m;
            if (m) atomicOr(anyb, m);
        }
        __syncthreads();
        mysel = selq[wave * 32 + ql];
        anysel = *anyb;
        __syncthreads();
    }
    h8 qf[4];
#pragma unroll
    for (int ks = 0; ks < 4; ++ks) qf[ks] = *(const h8*)(Pb + (size_t)tq * NP + QOFF + 16 * ks + 8 * hh);
    f16v O0, O1;
#pragma unroll
    for (int r = 0; r < 16; ++r) { O0[r] = 0.f; O1[r] = 0.f; }
    float l_run = 0.f;
    bool unset = true;
    f16v negm;
#pragma unroll
    for (int r = 0; r < 16; ++r) negm[r] = 0.f;
    const float THR = 8.0f;
    const int ntile = 2 * qt + 2;
    auto skip = [&](int kt) -> bool { return MODE == 1 && kt < 4 * own && !((anysel >> (kt >> 2)) & 1u); };
    auto nexttile = [&](int kt) -> int { ++kt; while (kt < ntile && skip(kt)) ++kt; return kt; };
    const int lrow = tid >> 3;
    const int kchunk = (tid & 7) ^ ((tid >> 4) & 7);
    const int vchunk = (tid & 7) ^ (((tid >> 4) & 1) << 2);
    char* ldst = lds + lrow * 128 + (tid & 7) * 16;
    auto issue = [&](int kt, int s) {
        const half_t* src = Pb + (size_t)(kt * 64 + lrow) * NP;
        char* d = ldst + s * 16384;
        glds16(src + KOFF + kchunk * 8, d);
        glds16(src + (size_t)32 * NP + KOFF + kchunk * 8, d + 4096);
        glds16(src + VOFF + vchunk * 8, d + 8192);
        glds16(src + (size_t)32 * NP + VOFF + vchunk * 8, d + 8192 + 4096);
    };
    const int rsw = (lane >> 1) & 7;
    const int kro = ql * 128;
    const int li = lane & 15, qp = li >> 2, pp = li & 3, swv = (qp >> 1) & 1;
    const int vb0 = 8192 + (4 * hh + qp) * 128 + 32 * ((lane >> 4) & 1) + 8 * pp + 64 * (0 ^ swv);
    const int vb1 = 8192 + (4 * hh + qp) * 128 + 32 * ((lane >> 4) & 1) + 8 * pp + 64 * (1 ^ swv);
    int kt = -1; kt = nexttile(kt);
    int s = 0;
    if (kt < ntile) issue(kt, 0);
    while (kt < ntile) {
        const int ktn = nexttile(kt);
        asm volatile("s_waitcnt vmcnt(0)" ::: "memory");
        __syncthreads();
        if (ktn < ntile) issue(ktn, s ^ 1);
        const bool wave_active = (kt * 64 <= q0 + wave * 32 + 31);
        if (wave_active) {
            const char* base = lds + s * 16384;
            uint2 mw = make_uint2(0u, 0u);
            if (MODE == 0) mw = *(const uint2*)(p->dmask + (size_t)(tokbase + tq) * 64 + 2 * kt);
            h8 vf0[4], vf1[4];
#pragma unroll
            for (int kk = 0; kk < 4; ++kk) {
                const int roff = (32 * (kk >> 1) + 16 * (kk & 1)) * 128;
                const s4v lo0 = __builtin_amdgcn_ds_read_tr16_b64_v4i16((LAS s4v*)(base + vb0 + roff));
                const s4v hi0 = __builtin_amdgcn_ds_read_tr16_b64_v4i16((LAS s4v*)(base + vb0 + roff + 8 * 128));
                const s4v lo1 = __builtin_amdgcn_ds_read_tr16_b64_v4i16((LAS s4v*)(base + vb1 + roff));
                const s4v hi1 = __builtin_amdgcn_ds_read_tr16_b64_v4i16((LAS s4v*)(base + vb1 + roff + 8 * 128));
                vf0[kk] = __builtin_bit_cast(h8, __builtin_shufflevector(lo0, hi0, 0, 1, 2, 3, 4, 5, 6, 7));
                vf1[kk] = __builtin_bit_cast(h8, __builtin_shufflevector(lo1, hi1, 0, 1, 2, 3, 4, 5, 6, 7));
            }
            bool lane_on = true;
            if (MODE == 1 && kt < 4 * own) lane_on = (mysel >> (kt >> 2)) & 1u;
            f16v cin = negm;
            if (MODE == 1 && kt < 4 * own) {
#pragma unroll
                for (int r = 0; r < 16; ++r) cin[r] = lane_on ? negm[r] : -INFINITY;
            }
            f16v s0 = cin, s1 = cin;
#pragma unroll
            for (int ks = 0; ks < 4; ++ks) {
                const int co = ((2 * ks + hh) ^ rsw) << 4;
                const h8 k0 = *(const h8*)(base + kro + co), k1 = *(const h8*)(base + kro + 4096 + co);
                s0 = __builtin_amdgcn_mfma_f32_32x32x16_f16(k0, qf[ks], s0, 0, 0, 0);
                s1 = __builtin_amdgcn_mfma_f32_32x32x16_f16(k1, qf[ks], s1, 0, 0, 0);
            }
            if (MODE == 0) {
                const unsigned w0 = mw.x >> (4 * hh), w1 = mw.y >> (4 * hh);
#pragma unroll
                for (int r = 0; r < 16; ++r) {
                    const int pos = (r & 3) + 8 * (r >> 2);
                    const unsigned m0 = (unsigned)__builtin_amdgcn_sbfe((int)w0, pos, 1), m1 = (unsigned)__builtin_amdgcn_sbfe((int)w1, pos, 1);
                    s0[r] = __uint_as_float((__float_as_uint(s0[r]) & m0) | (0xFF800000u & ~m0));
                    s1[r] = __uint_as_float((__float_as_uint(s1[r]) & m1) | (0xFF800000u & ~m1));
                }
            } else if (kt >= 4 * own && kt * 64 + 63 > q0 + wave * 32) {
#pragma unroll
                for (int r = 0; r < 16; ++r) {
                    const int key = kt * 64 + (r & 3) + 8 * (r >> 2) + 4 * hh;
                    s0[r] = (key <= tq) ? s0[r] : -INFINITY;
                    s1[r] = (key + 32 <= tq) ? s1[r] : -INFINITY;
                }
            }
            float mx = s0[0];
#pragma unroll
            for (int r = 1; r < 16; ++r) mx = fmaxf(mx, s0[r]);
#pragma unroll
            for (int r = 0; r < 16; ++r) mx = fmaxf(mx, s1[r]);
            mx = fmaxf(mx, __shfl_xor(mx, 32));
            const bool need = unset ? (mx > -INFINITY) : (mx > THR);
            if (__any(need)) {
                const float delta = need ? mx : 0.f;
                const float alpha = (need && !unset) ? __builtin_amdgcn_exp2f(-delta) : 1.0f;
#pragma unroll
                for (int r = 0; r < 16; ++r) { s0[r] -= delta; s1[r] -= delta; negm[r] -= delta; O0[r] *= alpha; O1[r] *= alpha; }
                l_run *= alpha;
                unset = unset && !need;
            }
            float ls = 0.f;
#pragma unroll
            for (int r = 0; r < 16; ++r) { s0[r] = __builtin_amdgcn_exp2f(s0[r]); ls += s0[r]; }
#pragma unroll
            for (int r = 0; r < 16; ++r) { s1[r] = __builtin_amdgcn_exp2f(s1[r]); ls += s1[r]; }
            l_run += ls;
#pragma unroll
            for (int kk = 0; kk < 4; ++kk) {
                h8 pf;
#pragma unroll
                for (int j = 0; j < 8; ++j) pf[j] = (half_t)((kk >> 1) ? s1[8 * (kk & 1) + j] : s0[8 * (kk & 1) + j]);
                O0 = __builtin_amdgcn_mfma_f32_32x32x16_f16(vf0[kk], pf, O0, 0, 0, 0);
                O1 = __builtin_amdgcn_mfma_f32_32x32x16_f16(vf1[kk], pf, O1, 0, 0, 0);
            }
        }
        kt = ktn; s ^= 1;
    }
    const float lt = l_run + __shfl_xor(l_run, 32);
    const float inv = 1.0f / lt;
    const int ycol = (MODE ? 640 : 256) + h * 64;
    half_t* dst = p->ycat + ((size_t)(ycol >> 5) * T_TOK + tokbase + tq) * 32 + 4 * hh;
#pragma unroll
    for (int g = 0; g < 4; ++g) {
        *(h4*)(dst + 8 * g) = pack4(O0[4 * g] * inv, O0[4 * g + 1] * inv, O0[4 * g + 2] * inv, O0[4 * g + 3] * inv);
        *(h4*)(dst + (size_t)T_TOK * 32 + 8 * g) = pack4(O1[4 * g] * inv, O1[4 * g + 1] * inv, O1[4 * g + 2] * inv, O1[4 * g + 3] * inv);
    }
}

#ifndef ATT_MASK
#define ATT_MASK 3
#endif
__device__ __forceinline__ void phase_attn(KP p, char* lds, int tm) {
    const int G_ = gridDim.x, per_ = G_ >> 3;
    const bool snake_ = (G_ >= 8) && ((G_ & 7) == 0);
    for (int k_ = 0, b_ = BID(); snake_ ? (k_ * per_ < 384) : (b_ + k_ * G_ < 3072); ++k_) {
        int xl, Lx;
        if (snake_) { const int idx_ = b_ >> 3; xl = b_ & 7; Lx = k_ * per_ + ((k_ & 1) ? (per_ - 1 - idx_) : idx_); }
        else { const int u = b_ + k_ * G_; xl = u & 7; Lx = u >> 3; }
        if (Lx >= 384) continue;
        const int qt = 15 - (Lx / 24), rem = Lx % 24;
        const int type = rem & 1, bh = xl * 12 + (rem >> 1);
        if (type == 0) { if (tm & 1) attn_unit<0>(p, lds, bh / 6, bh % 6, qt); }
        else { if (tm & 2) attn_unit<1>(p, lds, bh / 6, bh % 6, qt); }
    }
}

__global__ void __launch_bounds__(256, 2) mk_fwd(Params p_unused) {
    extern __shared__ __attribute__((aligned(16))) char lds[];
    volatile LAS unsigned* stw = (volatile LAS unsigned*)(lds + LDS_CTL);
    if (threadIdx.x < 4) stw[threadIdx.x] = 0u;
    __syncthreads();
    KP p0 = (KP)__builtin_amdgcn_kernarg_segment_ptr();
    XcdBarrier bar; bar.bar = p0->bar; bar.x = 0; bar.st = stw;
#if !MK_SPLIT
    bar = xcd_barrier_post(p0->bar, stw);
#endif
    const int ph_lo = p0->ph_lo, ph_hi = p0->ph_hi;
    for (int ph = ph_lo; ph < ph_hi; ++ph) {
      KP p = p0; asm volatile("" : "+s"(p));
      const int nrep = (DUP_SUB >= 0 && ((DUP_SUB == 100 && ph == 0) || (ph >= 2 && ph < NPHASE - 1 && ((ph - 2) & 7) == DUP_SUB && (DUP_SUB != 4 || ph < 10)))) ? 2 : 1;
      for (int rep = 0; rep < nrep; ++rep) {
        if (ph == 0) phase_prologue(p, lds);
        else if (ph == 1) phase_modsum(p);
        else if (ph == NPHASE - 1) phase_norm<2>(p, lds, p->out, p->g_final, nullptr, nullptr, 0);
        else {
            const int l = (ph - 2) >> 3, sub = (ph - 2) & 7;
            const float* mf = p->modf + (size_t)l * 16 * 6144;
            const float* xin = l == 0 ? p->x : p->out;
            if (sub == 0) phase_norm<0>(p, lds, xin, p->g_mix + l * DM, mf, mf + 1024, l);
            else if (sub == 1) phase_inproj(p, lds, l);
            else if (sub == 2) phase_post(p, lds, l, rep ? POST_MASK : 7);
            else if (sub == 3) phase_attn(p, lds, rep ? ATT_MASK : 3);
            else if (sub == 4) phase_outproj(p, lds, l, xin);
            else if (sub == 5) phase_norm_router(p, lds, p->out, p->g_ffn + l * DM, mf + 3 * 1024, mf + 4 * 1024, (nrep == 2 && rep == 0) ? l + 2 : l);
            else if (sub == 6) phase_moe_up(p, lds, l);
            else phase_moe_down(p, lds, l, nrep == 2 ? 0.5f : 1.0f);
        }
      }
#if !MK_SPLIT
        if (ph + 1 < ph_hi) xcd_barrier(bar);
#endif
    }
}

extern "C" void kernel_launch(void* const* d_in, const int* in_sizes, int n_in, void* d_out, int out_size, void* d_ws, size_t ws_size, hipStream_t stream) {
    static int grid = 0;
    if (grid == 0) {
        int dev = 0, cus = 0, per_cu = 0;
        (void)hipGetDevice(&dev);
        (void)hipDeviceGetAttribute(&cus, hipDeviceAttributeMultiprocessorCount, dev);
        (void)hipFuncSetAttribute((const void*)mk_fwd, hipFuncAttributeMaxDynamicSharedMemorySize, LDS_BYTES);
        if (hipOccupancyMaxActiveBlocksPerMultiprocessor(&per_cu, (const void*)mk_fwd, 256, LDS_BYTES) != hipSuccess || per_cu < 1) per_cu = 1;
        (void)hipGetLastError();
        if (per_cu > 2) per_cu = 2;
        grid = cus * per_cu;
        fprintf(stderr, "mk_fwd: cus %d per_cu %d grid %d\n", cus, per_cu, grid);
    }
    Params p{};
    const float** pin = (const float**)&p.x;
    for (int i = 0; i < 18; ++i) pin[i] = (const float*)d_in[i];
    p.out = (float*)d_out;
    char* ws = (char*)d_ws;
    size_t off = 0;
    auto carve = [&](size_t bytes) { void* q = ws + off; off += (bytes + 255) & ~(size_t)255; return q; };
    p.bar = (unsigned*)carve(XCD_BAR_WORDS * 4);
    p.cnt = (int*)carve(4 * 32 * 64 * 4);
    const size_t zero_bytes = off;
    p.Wt_in = (half_t*)carve((size_t)2 * NP * DM * 2);
    p.Wt_o = (half_t*)carve((size_t)2 * DM * DM * 2);
    p.Wt_gu = (half_t*)carve((size_t)2 * 16 * 512 * 1024 * 2);
    p.Wt_d = (half_t*)carve((size_t)2 * 16 * 1024 * 256 * 2);
    p.hn = (half_t*)carve((size_t)T_TOK * DM * 2);
    p.P = (half_t*)carve((size_t)T_TOK * NP * 2);
    p.ycat = (half_t*)carve((size_t)T_TOK * DM * 2);
    p.act = (half_t*)carve((size_t)T_TOK * 512 * 2);
    p.modpart = (float*)carve((size_t)8 * 2 * 16 * 6144 * 4);
    p.modf = (float*)carve((size_t)2 * 16 * 6144 * 4);
    p.kmean = (float*)carve((size_t)16 * 6 * 8 * 64 * 4);
    p.rope = (float*)carve((size_t)2048 * 24 * 4);
    p.iwf = (float*)carve((size_t)T_TOK * 4 * 4);
    p.tokw = (float*)carve((size_t)T_TOK * 2 * 4);
    p.dmask = (unsigned*)carve((size_t)T_TOK * 64 * 4);
    p.lists = (int*)carve((size_t)NCLS * T_TOK * 4);
    if (off > ws_size) { fprintf(stderr, "workspace too small: need %zu have %zu\n", off, ws_size); return; }
    (void)hipMemsetAsync(d_ws, 0, zero_bytes, stream);
#if MK_SPLIT
    for (int ph = 0; ph < NPHASE; ++ph) {
        p.ph_lo = ph; p.ph_hi = ph + 1;
        hipLaunchKernelGGL(mk_fwd, dim3(grid), dim3(256), LDS_BYTES, stream, p);
    }
#else
    p.ph_lo = 0; p.ph_hi = NPHASE;
    hipLaunchKernelGGL(mk_fwd, dim3(grid), dim3(256), LDS_BYTES, stream, p);
#endif
}
```

```cpp
#include <hip/hip_runtime.h>
#include <cstdio>
#include <cstdint>

#ifndef MK_SPLIT
#define MK_SPLIT 0
#endif

#define T_TOK 32768
#define DM 1024
#define SEQ 2048
#define INW 2340
#define NP 2432
#define PC_CU 0
#define PC_CG 256
#define PC_DQ 512
#define PC_DK 896
#define PC_DV 960
#define PC_IQ 1024
#define PC_IK 1152
#define PC_IW 1184
#define PC_MQ 1280
#define PC_MK 1664
#define PC_MV 2048
#define LOG_THETA 13.122363377404328f
#define NCLS 24
#define LDS_CTL 73728
#define LDS_BYTES 78336
#define NPHASE 19
#ifndef DUP_SUB
#define DUP_SUB -1
#endif

typedef _Float16 half_t;
typedef _Float16 h8 __attribute__((ext_vector_type(8)));
typedef _Float16 h4 __attribute__((ext_vector_type(4)));
typedef short s4v __attribute__((ext_vector_type(4)));
typedef short s8v __attribute__((ext_vector_type(8)));
typedef float f16v __attribute__((ext_vector_type(16)));
typedef float f4v __attribute__((ext_vector_type(4)));
#define LAS __attribute__((address_space(3)))

struct Params {
    const float *x, *c, *w_ada, *b_ada, *g_mix, *w_in, *w_dw, *b_dw, *ln_g, *ln_b, *w_o, *g_ffn, *w_router, *b_router, *w_gate, *w_up, *w_down, *g_final;
    float* out;
    half_t *Wt_in, *Wt_o, *Wt_gu, *Wt_d, *hn, *P, *ycat, *act, *xr;
    float *modpart, *modf, *kmean, *rope, *iwf, *tokw;
    unsigned* dmask; int* cnt; int* lists; unsigned* bar;
    int ph_lo, ph_hi;
};

#define XB_TMO      128
#define XB_XCNT(j)  (256  + 64 * (j))
#define XB_XSUB(j)  (1280 + 64 * (j))
#define XB_XGEN(j)  (2304 + 64 * (j))
#define XB_TOP      3328
#define XB_TOPGEN   3392
#define XCD_BAR_WORDS 3456
#define XB_SPIN_CAP (1u << 20)
__device__ __forceinline__ unsigned xb_ld(unsigned* p)              { return __hip_atomic_load(p, __ATOMIC_RELAXED, __HIP_MEMORY_SCOPE_AGENT); }
__device__ __forceinline__ unsigned xb_add(unsigned* p, unsigned v) { return __hip_atomic_fetch_add(p, v, __ATOMIC_RELAXED, __HIP_MEMORY_SCOPE_AGENT); }
__device__ __forceinline__ unsigned xb_xcc_id() { return (unsigned)__builtin_amdgcn_s_getreg((3 << 11) | 20) & 0xFu; }
#define XB_SPIN(cond, bar) do { unsigned _sp = 0; while (cond) { __builtin_amdgcn_s_sleep(1); \
    if ((++_sp & 255u) == 0u) { if (xb_ld(&(bar)[XB_TMO])) break; if (_sp > XB_SPIN_CAP) { atomicAdd(&(bar)[XB_TMO], 1u); break; } } } } while (0)
struct XcdBarrier { unsigned* bar; unsigned x; volatile LAS unsigned* st; };
__device__ __forceinline__ XcdBarrier xcd_barrier_post(unsigned* bar, volatile LAS unsigned* st) {
    XcdBarrier b; b.bar = bar; b.x = xb_xcc_id(); b.st = st;
    if (threadIdx.x == 0) (void)xb_add(&bar[XB_XCNT(b.x)], 1u);
    return b;
}
__device__ __forceinline__ void xcd_barrier_complete(unsigned* bar, unsigned x, unsigned& nloc, unsigned& nx) {
    const unsigned G = gridDim.x * gridDim.y * gridDim.z;
    unsigned sum, cnt, mine, sp = 0u;
    for (;;) {
        sum = 0u; cnt = 0u; mine = 0u;
#pragma unroll
        for (unsigned j = 0; j < 16; ++j) { const unsigned c = xb_ld(&bar[XB_XCNT(j)]); sum += c; cnt += (c > 0u) ? 1u : 0u; mine = (j == x) ? c : mine; }
        if (sum == G) break;
        __builtin_amdgcn_s_sleep(1);
        if ((++sp & 255u) == 0u) { if (xb_ld(&bar[XB_TMO])) break; if (sp > XB_SPIN_CAP) { atomicAdd(&bar[XB_TMO], 1u); break; } }
    }
    nloc = mine > 0u ? mine : 1u; nx = cnt > 0u ? cnt : 1u;
}
__device__ __forceinline__ void xcd_barrier(const XcdBarrier& b) {
    asm volatile("s_waitcnt vmcnt(0)" ::: "memory");
    __syncthreads();
    if (threadIdx.x == 0) {
        unsigned* bar = b.bar;
        __builtin_amdgcn_s_waitcnt(0);
        unsigned nloc = b.st[0], nx = b.st[1];
        if (nloc == 0u) { xcd_barrier_complete(bar, b.x, nloc, nx); b.st[0] = nloc; b.st[1] = nx; }
        const unsigned old = xb_add(&bar[XB_XSUB(b.x)], 1u);
        const unsigned gen = old / nloc;
        if (old + 1u == (gen + 1u) * nloc) {
            __builtin_amdgcn_fence(__ATOMIC_RELEASE, "agent");
            asm volatile("s_waitcnt vmcnt(0)" ::: "memory");
            const unsigned og = xb_add(&bar[XB_TOP], 1u);
            const unsigned tg = og / nx;
            if (og + 1u == (tg + 1u) * nx) xb_add(&bar[XB_TOPGEN], 1u);
            else XB_SPIN(xb_ld(&bar[XB_TOPGEN]) == tg, bar);
            __builtin_amdgcn_fence(__ATOMIC_ACQUIRE, "agent");
            xb_add(&bar[XB_XGEN(b.x)], 1u);
            asm volatile("s_waitcnt vmcnt(0)" ::: "memory");
        } else {
            XB_SPIN(xb_ld(&bar[XB_XGEN(b.x)]) == gen, bar);
            __builtin_amdgcn_fence(__ATOMIC_ACQUIRE, "agent");
            asm volatile("s_waitcnt vmcnt(0)" ::: "memory");
        }
    }
    __syncthreads();
}

typedef const __attribute__((address_space(4))) Params* KP;
__device__ __forceinline__ int TID() { int t = threadIdx.x; asm volatile("" : "+v"(t)); return t; }
__device__ __forceinline__ int BID() { int b = blockIdx.x; asm volatile("" : "+s"(b)); return b; }
__device__ __forceinline__ float sigmoidf_(float v) { return __builtin_amdgcn_rcpf(1.0f + __expf(-v)); }
__device__ __forceinline__ void glds16(const void* g, char* l) { __builtin_amdgcn_global_load_lds((const unsigned*)g, (unsigned*)l, 16, 0, 0); }
__device__ __forceinline__ unsigned f2sortable(float f) { unsigned u = __float_as_uint(f); return (u & 0x80000000u) ? ~u : (u | 0x80000000u); }
template <bool HIN> __device__ __forceinline__ float4 ldx4(const void* base, size_t idx) {
    if (HIN) { const h4 t = *(const h4*)((const half_t*)base + idx); return make_float4((float)t[0], (float)t[1], (float)t[2], (float)t[3]); }
    return *(const float4*)((const float*)base + idx);
}
__device__ __forceinline__ h4 pack4(float a, float b, float c, float d) { h4 r = {(half_t)a, (half_t)b, (half_t)c, (half_t)d}; return r; }

template <class CF>
__device__ __forceinline__ void conv_tile_panel(char* lds, CF colf, int src_ld, int k0, int n0, half_t* dst, int nrows) {
    float* tl = (float*)lds;
    const int tid = TID();
    __syncthreads();
    {
        const int nn = tid & 63;
        const float* cp = colf(nn);
        float tv[16];
#pragma unroll
        for (int i = 0; i < 16; ++i) { const int k = i * 4 + (tid >> 6); tv[i] = cp ? cp[(size_t)(k0 + k) * src_ld] : 0.f; }
#pragma unroll
        for (int i = 0; i < 16; ++i) { const int k = i * 4 + (tid >> 6); tl[k * 65 + nn] = tv[i]; }
    }
    __syncthreads();
    {
        const int n = tid >> 2, kq = (tid & 3) * 16;
        h8 a, b;
#pragma unroll
        for (int j = 0; j < 8; ++j) { a[j] = (half_t)tl[(kq + j) * 65 + n]; b[j] = (half_t)tl[(kq + 8 + j) * 65 + n]; }
        const int k = k0 + kq;
        h8* d = (h8*)(dst + ((size_t)(k >> 5) * nrows + n0 + n) * 32 + (k & 31));
        d[0] = a; d[1] = b;
    }
}
template <class CF>
__device__ __forceinline__ void conv_tile(char* lds, CF colf, int src_ld, int k0, half_t* dst_tile  , int dstK) {
    float* tl = (float*)lds;
    const int tid = TID();
    __syncthreads();
    {
        const int nn = tid & 63;
        const float* cp = colf(nn);
        float tv[16];
#pragma unroll
        for (int i = 0; i < 16; ++i) { const int k = i * 4 + (tid >> 6); tv[i] = cp ? cp[(size_t)(k0 + k) * src_ld] : 0.f; }
#pragma unroll
        for (int i = 0; i < 16; ++i) { const int k = i * 4 + (tid >> 6); tl[k * 65 + nn] = tv[i]; }
    }
    __syncthreads();
    {
        const int n = tid >> 2, kq = (tid & 3) * 16;
        h8 a, b;
#pragma unroll
        for (int j = 0; j < 8; ++j) { a[j] = (half_t)tl[(kq + j) * 65 + n]; b[j] = (half_t)tl[(kq + 8 + j) * 65 + n]; }
        h8* d = (h8*)(dst_tile + (size_t)n * dstK + kq);
        d[0] = a; d[1] = b;
    }
}

__device__ __forceinline__ void phase_prologue(KP p, char* lds) {
    const int tid = TID();
    const int NA = 2 * 16 * 38, NB = 2 * 16 * 16, NC = 2 * 16 * 16 * 8, ND = 2 * 16 * 4 * 16, NE = 384, NF = 8;
    const int total = NA + NB + NC + ND + NE + NF;
    for (int u0 = BID(); u0 < total; u0 += gridDim.x) {
        int u = u0;
        if (u < NA) {
            const int nt = u % 38, kt = (u / 38) % 16, l = u / (38 * 16);
            const float* src = p->w_in + (size_t)l * DM * INW;
            const int n0 = nt * 64;
            conv_tile_panel(lds, [&](int nn) -> const float* { const int np = n0 + nn; const int sc = np < 512 ? (((np & 63) < 32) ? 32 * (np >> 6) + (np & 31) : 256 + 32 * (np >> 6) + (np & 31)) : (np < 1188 ? np : (np < 1280 ? -1 : np - 92)); return sc >= 0 ? src + sc : (const float*)nullptr; },
                      INW, kt * 64, n0, p->Wt_in + (size_t)l * NP * DM, NP);
            continue;
        }
        u -= NA;
        if (u < NB) {
            const int nt = u % 16, kt = (u / 16) % 16, l = u / 256;
            const float* src = p->w_o + (size_t)l * DM * DM + nt * 64;
            conv_tile_panel(lds, [&](int nn) -> const float* { return src + nn; }, DM, kt * 64, nt * 64, p->Wt_o + (size_t)l * DM * DM, DM);
            continue;
        }
        u -= NB;
        if (u < NC) {
            const int nt = u % 8, kt = (u / 8) % 16, le = u / 128;
            const float* sg = p->w_gate + (size_t)le * 1024 * 256 + nt * 32;
            const float* su = p->w_up + (size_t)le * 1024 * 256 + nt * 32;
            conv_tile(lds, [&](int nn) -> const float* { return nn < 32 ? sg + nn : su + (nn - 32); }, 256, kt * 64, p->Wt_gu + ((size_t)le * 512 + nt * 64) * 1024 + kt * 64, 1024);
            continue;
        }
        u -= NC;
        if (u < ND) {
            const int nt = u % 16, kt = (u / 16) % 4, le = u / 64;
            const float* src = p->w_down + (size_t)le * 256 * 1024 + nt * 64;
            conv_tile(lds, [&](int nn) -> const float* { return src + nn; }, 1024, kt * 64, p->Wt_d + ((size_t)le * 1024 + nt * 64) * 256 + kt * 64, 256);
            continue;
        }
        u -= ND;
        if (u < NE) {
            const int kc = u % 8, cc = (u / 8) % 24, l = u / 192;
            float* ca = (float*)lds;
            __syncthreads();
            for (int i = tid; i < 2048; i += 256) { const int b = i >> 7, k = i & 127; const float v = p->c[b * 1024 + kc * 128 + k]; ca[i] = v / (1.0f + expf(-v)); }
            __syncthreads();
            const int n = cc * 256 + tid;
            float acc[16];
#pragma unroll
            for (int b = 0; b < 16; ++b) acc[b] = 0.f;
            const float* w = p->w_ada + ((size_t)l * 1024 + kc * 128) * 6144 + n;
#pragma unroll 16
            for (int k = 0; k < 128; ++k) {
                const float wv = w[(size_t)k * 6144];
#pragma unroll
                for (int b = 0; b < 16; ++b) acc[b] = fmaf(ca[b * 128 + k], wv, acc[b]);
            }
#pragma unroll
            for (int b = 0; b < 16; ++b) p->modpart[(((size_t)kc * 2 + l) * 16 + b) * 6144 + n] = acc[b];
            continue;
        }
        u -= NE;
        {
            for (int i = u * 256 + tid; i < 2048 * 12; i += NF * 256) {
                const int t = i / 12, r = i % 12;
                const int fi = r < 8 ? r : r - 8;
                const float rot = r < 8 ? 16.f : 8.f;
                const float inv = expf(-LOG_THETA * ((float)fi * 2.0f / rot));
                const float ang = (float)t * inv;
                float sn, cs; sincosf(ang, &sn, &cs);
                if (r < 8) { p->rope[t * 8 + fi] = cs; p->rope[16384 + t * 8 + fi] = sn; }
                else { p->rope[32768 + t * 4 + fi] = cs; p->rope[32768 + 8192 + t * 4 + fi] = sn; }
            }
        }
    }
}

__device__ __forceinline__ void phase_modsum(KP p) {
    for (int i = BID() * 256 + TID(); i < 2 * 16 * 6144; i += gridDim.x * 256) {
        const int n = i % 6144, l = i / (16 * 6144);
        float s = p->b_ada[l * 6144 + n];
#pragma unroll
        for (int kc = 0; kc < 8; ++kc) s += p->modpart[(size_t)kc * (2 * 16 * 6144) + i];
        p->modf[i] = s;
    }
}

__device__ __forceinline__ void route_flush(KP p, char* lds, int lane, int wave, int n, int myrow, int layer) {
    const float* lg = (const float*)(lds + LDS_CTL + 512) + wave * 256;
    int* lc = (int*)(lds + LDS_CTL + 64);
    int* lbase = lc + 32;
    const int tid = wave * 64 + lane;
    if (tid < 32) lc[tid] = 0;
    __syncthreads();
    int cls = 0, lpos = 0;
    if (lane < n) {
        float aff[16], bia[16];
#pragma unroll
        for (int e = 0; e < 16; ++e) { aff[e] = 1.0f / (1.0f + expf(-lg[lane * 16 + e])); bia[e] = aff[e] + p->b_router[e]; }
        int bestg = 0; float bests = -INFINITY;
#pragma unroll
        for (int gi = 0; gi < 4; ++gi) {
            float m1 = -INFINITY, m2 = -INFINITY;
#pragma unroll
            for (int j = 0; j < 4; ++j) { const float vv = bia[gi * 4 + j]; if (vv > m1) { m2 = m1; m1 = vv; } else if (vv > m2) m2 = vv; }
            const float s = m1 + m2;
            if (s > bests) { bests = s; bestg = gi; }
        }
        float bsel[4], asel[4];
#pragma unroll
        for (int j = 0; j < 4; ++j) { bsel[j] = 0.f; asel[j] = 0.f; }
#pragma unroll
        for (int gi = 0; gi < 4; ++gi) if (gi == bestg) {
#pragma unroll
            for (int j = 0; j < 4; ++j) { bsel[j] = bia[gi * 4 + j]; asel[j] = aff[gi * 4 + j]; }
        }
        int i1 = -1, i2 = -1; float v1 = -INFINITY, v2 = -INFINITY;
#pragma unroll
        for (int j = 0; j < 4; ++j) { const float vv = bsel[j]; if (vv > v1) { v2 = v1; i2 = i1; v1 = vv; i1 = j; } else if (vv > v2) { v2 = vv; i2 = j; } }
        const int a = i1 < i2 ? i1 : i2, bb = i1 < i2 ? i2 : i1;
        float wa = 0.f, wb = 0.f;
#pragma unroll
        for (int j = 0; j < 4; ++j) { if (j == a) wa = asel[j]; if (j == bb) wb = asel[j]; }
        const float sw = wa + wb;
        const int pi = (a == 0) ? (bb - 1) : (a == 1 ? (bb + 1) : 5);
        cls = bestg * 6 + pi;
        *(float2*)(p->tokw + (size_t)myrow * 2) = make_float2(wa / sw, wb / sw);
        lpos = atomicAdd(&lc[cls], 1);
    }
    __syncthreads();
    if (tid < NCLS) { const int c = lc[tid]; lbase[tid] = c ? atomicAdd(&p->cnt[(layer * 32 + tid) * 64], c) : 0; }
    __syncthreads();
    if (lane < n) p->lists[(size_t)cls * T_TOK + lbase[cls] + lpos] = myrow;
}

template <int MODE, bool HIN>
__device__ __forceinline__ void phase_norm(KP p, char* lds, const void* xin, const float* g, const float* sh, const float* sc, int layer) {
    const int lane = TID() & 63, wave = TID() >> 6;
    float* wt = (float*)lds;
    if (MODE == 1) {
        __syncthreads();
        for (int i = TID(); i < 4096; i += 256) {
            const float4 w4 = ((const float4*)p->w_router)[i];
            const int k = i >> 2, e0 = (i & 3) * 4;
            wt[(e0 + 0) * 1024 + k] = w4.x; wt[(e0 + 1) * 1024 + k] = w4.y; wt[(e0 + 2) * 1024 + k] = w4.z; wt[(e0 + 3) * 1024 + k] = w4.w;
        }
        __syncthreads();
    }
    float* lgb = (float*)(lds + LDS_CTL + 512);
    int myrow = 0, it = 0;
    float4 vn[4];
    {
        const int row0 = BID() * 4 + wave;
        const size_t xo = (size_t)(row0 < T_TOK ? row0 : 0) * DM;
#pragma unroll
        for (int i = 0; i < 4; ++i) vn[i] = ldx4<HIN>(xin, xo + (lane + 64 * i) * 4);
    }
    for (int row = BID() * 4 + wave; row < T_TOK; row += gridDim.x * 4) {
        const int b = row >> 11;
        float4 v[4]; float ss = 0.f;
#pragma unroll
        for (int i = 0; i < 4; ++i) v[i] = vn[i];
        {
            const int rown = row + gridDim.x * 4;
            const size_t xo = (size_t)(rown < T_TOK ? rown : row) * DM;
#pragma unroll
            for (int i = 0; i < 4; ++i) vn[i] = ldx4<HIN>(xin, xo + (lane + 64 * i) * 4);
        }
#pragma unroll
        for (int i = 0; i < 4; ++i) ss += v[i].x * v[i].x + v[i].y * v[i].y + v[i].z * v[i].z + v[i].w * v[i].w;
#pragma unroll
        for (int o = 32; o >= 1; o >>= 1) ss += __shfl_xor(ss, o);
        const float rstd = 1.0f / sqrtf(ss * (1.0f / 1024.0f) + 1e-6f);
        float acc[16], ya[16];
#pragma unroll
        for (int i = 0; i < 4; ++i) {
            const int k = (lane + 64 * i) * 4;
            const float4 gg = *(const float4*)(g + k);
            float y[4] = {v[i].x * rstd * gg.x, v[i].y * rstd * gg.y, v[i].z * rstd * gg.z, v[i].w * rstd * gg.w};
            if (MODE != 2) {
                const float4 s1 = *(const float4*)(sh + (size_t)b * 6144 + k), s2 = *(const float4*)(sc + (size_t)b * 6144 + k);
                y[0] = y[0] * (1.f + s2.x) + s1.x; y[1] = y[1] * (1.f + s2.y) + s1.y; y[2] = y[2] * (1.f + s2.z) + s1.z; y[3] = y[3] * (1.f + s2.w) + s1.w;
                if (MODE == 0) *(h4*)(p->hn + ((size_t)(k >> 5) * T_TOK + row) * 32 + (k & 31)) = pack4(y[0], y[1], y[2], y[3]);
                else *(h4*)(p->hn + (size_t)row * DM + k) = pack4(y[0], y[1], y[2], y[3]);
            } else {
                *(float4*)(p->out + (size_t)row * DM + k) = make_float4(y[0], y[1], y[2], y[3]);
            }
            ya[4 * i] = y[0]; ya[4 * i + 1] = y[1]; ya[4 * i + 2] = y[2]; ya[4 * i + 3] = y[3];
        }
        if (MODE == 1) {
#pragma unroll
            for (int e = 0; e < 16; ++e) acc[e] = 0.f;
            float4 wq[2][4];
            const float* wl = wt + lane * 4;
#pragma unroll
            for (int e = 0; e < 4; ++e) wq[0][e] = *(const float4*)(wl + e * 1024);
#pragma unroll
            for (int st = 0; st < 16; ++st) {
                const int i = st >> 2, eg = st & 3, cur = st & 1;
                if (st + 1 < 16) {
                    const int i2 = (st + 1) >> 2, eg2 = (st + 1) & 3;
#pragma unroll
                    for (int e = 0; e < 4; ++e) wq[cur ^ 1][e] = *(const float4*)(wl + (eg2 * 4 + e) * 1024 + i2 * 256);
                }
#pragma unroll
                for (int e = 0; e < 4; ++e) {
                    const float4 w4 = wq[cur][e];
                    acc[eg * 4 + e] = fmaf(ya[4 * i], w4.x, fmaf(ya[4 * i + 1], w4.y, fmaf(ya[4 * i + 2], w4.z, fmaf(ya[4 * i + 3], w4.w, acc[eg * 4 + e]))));
                }
                __builtin_amdgcn_sched_barrier(0);
            }
        }
        if (MODE == 1) {
            const bool b5 = lane & 32, b4 = lane & 16, b3 = lane & 8, b2 = lane & 4;
            float r8[8], r4[4], r2[2];
#pragma unroll
            for (int e = 0; e < 8; ++e) { const float snd = b5 ? acc[e] : acc[e + 8], kp = b5 ? acc[e + 8] : acc[e]; r8[e] = kp + __shfl_xor(snd, 32); }
#pragma unroll
            for (int e = 0; e < 4; ++e) { const float snd = b4 ? r8[e] : r8[e + 4], kp = b4 ? r8[e + 4] : r8[e]; r4[e] = kp + __shfl_xor(snd, 16); }
#pragma unroll
            for (int e = 0; e < 2; ++e) { const float snd = b3 ? r4[e] : r4[e + 2], kp = b3 ? r4[e + 2] : r4[e]; r2[e] = kp + __shfl_xor(snd, 8); }
            float rv; { const float snd = b2 ? r2[0] : r2[1], kp = b2 ? r2[1] : r2[0]; rv = kp + __shfl_xor(snd, 4); }
            rv += __shfl_xor(rv, 2); rv += __shfl_xor(rv, 1);
            if ((lane & 3) == 0) lgb[(wave * 16 + it) * 16 + (lane >> 2)] = rv;
            if (lane == it) myrow = row;
            ++it;
            if (it == 16) { route_flush(p, lds, lane, wave, it, myrow, layer); it = 0; }
        }
    }
    if (MODE == 1 && it > 0) route_flush(p, lds, lane, wave, it, myrow, layer);
}

typedef float f2_t __attribute__((ext_vector_type(2)));
#define NRR 2
__device__ __forceinline__ void phase_norm_router(KP p, char* lds, const half_t* xin, const float* g, const float* sh, const float* sc, int layer) {
    const int lane = TID() & 63, wave = TID() >> 6;
    float* wt = (float*)lds;
    __syncthreads();
    for (int i = TID(); i < 4096; i += 256) {
        const float4 w4 = ((const float4*)p->w_router)[i];
        const int k = i >> 2, e0 = (i & 3) * 4;
        wt[(e0 + 0) * 1024 + k] = w4.x; wt[(e0 + 1) * 1024 + k] = w4.y; wt[(e0 + 2) * 1024 + k] = w4.z; wt[(e0 + 3) * 1024 + k] = w4.w;
    }
    __syncthreads();
    float* lgb = (float*)(lds + LDS_CTL + 512);
    int myrow = 0, it = 0;
    const int rstride = gridDim.x * 4;
    for (int row0 = BID() * 4 + wave; row0 < T_TOK; row0 += rstride * NRR) {
        f2_t ya[NRR / 2][16];
        float ss[NRR];
        int nv = 0;
#pragma unroll
        for (int j = 0; j < NRR; ++j) nv += (row0 + j * rstride < T_TOK) ? 1 : 0;
        {
            float4 v[NRR][4];
#pragma unroll
            for (int j = 0; j < NRR; ++j) {
                const int r = row0 + j * rstride;
                const size_t xo = (size_t)(r < T_TOK ? r : row0) * DM;
#pragma unroll
                for (int i = 0; i < 4; ++i) v[j][i] = ldx4<true>(xin, xo + (lane + 64 * i) * 4);
            }
#pragma unroll
            for (int j = 0; j < NRR; ++j) {
                ss[j] = 0.f;
#pragma unroll
                for (int i = 0; i < 4; ++i) ss[j] += v[j][i].x * v[j][i].x + v[j][i].y * v[j][i].y + v[j][i].z * v[j][i].z + v[j][i].w * v[j][i].w;
            }
#pragma unroll
            for (int o = 32; o >= 1; o >>= 1) {
#pragma unroll
                for (int j = 0; j < NRR; ++j) ss[j] += __shfl_xor(ss[j], o);
            }
#pragma unroll
            for (int j = 0; j < NRR; ++j) ss[j] = 1.0f / sqrtf(ss[j] * (1.0f / 1024.0f) + 1e-6f);
#pragma unroll
            for (int j = 0; j < NRR; ++j) {
                const int r = row0 + j * rstride;
                const int rr = r < T_TOK ? r : row0;
                const int b = rr >> 11;
                const float rs = ss[j];
#pragma unroll
                for (int i = 0; i < 4; ++i) {
                    const int k = (lane + 64 * i) * 4;
                    const float4 gg = *(const float4*)(g + k);
                    const float4 s1 = *(const float4*)(sh + (size_t)b * 6144 + k), s2 = *(const float4*)(sc + (size_t)b * 6144 + k);
                    const float y0 = v[j][i].x * rs * gg.x * (1.f + s2.x) + s1.x, y1 = v[j][i].y * rs * gg.y * (1.f + s2.y) + s1.y;
                    const float y2 = v[j][i].z * rs * gg.z * (1.f + s2.z) + s1.z, y3 = v[j][i].w * rs * gg.w * (1.f + s2.w) + s1.w;
                    if (r < T_TOK) *(h4*)(p->hn + (size_t)r * DM + k) = pack4(y0, y1, y2, y3);
                    if (j & 1) { ya[j >> 1][4 * i].y = y0; ya[j >> 1][4 * i + 1].y = y1; ya[j >> 1][4 * i + 2].y = y2; ya[j >> 1][4 * i + 3].y = y3; }
                    else       { ya[j >> 1][4 * i].x = y0; ya[j >> 1][4 * i + 1].x = y1; ya[j >> 1][4 * i + 2].x = y2; ya[j >> 1][4 * i + 3].x = y3; }
                }
                __builtin_amdgcn_sched_barrier(0);
            }
        }
        f2_t acc[NRR / 2][16];
#pragma unroll
        for (int e = 0; e < 16; ++e) {
#pragma unroll
            for (int jp = 0; jp < NRR / 2; ++jp) acc[jp][e] = (f2_t){0.f, 0.f};
        }
        {
            float4 wq[2][4];
            const float* wl = wt + lane * 4;
#pragma unroll
            for (int e = 0; e < 4; ++e) wq[0][e] = *(const float4*)(wl + e * 1024);
#pragma unroll
            for (int st = 0; st < 16; ++st) {
                const int i = st >> 2, eg = st & 3, cur = st & 1;
                if (st + 1 < 16) {
                    const int i2 = (st + 1) >> 2, eg2 = (st + 1) & 3;
#pragma unroll
                    for (int e = 0; e < 4; ++e) wq[cur ^ 1][e] = *(const float4*)(wl + (eg2 * 4 + e) * 1024 + i2 * 256);
                }
#pragma unroll
                for (int e = 0; e < 4; ++e) {
                    const float4 w4 = wq[cur][e];
#pragma unroll
                    for (int jp = 0; jp < NRR / 2; ++jp) {
                        f2_t a = acc[jp][eg * 4 + e];
                        a = ya[jp][4 * i + 3] * (f2_t){w4.w, w4.w} + a;
                        a = ya[jp][4 * i + 2] * (f2_t){w4.z, w4.z} + a;
                        a = ya[jp][4 * i + 1] * (f2_t){w4.y, w4.y} + a;
                        a = ya[jp][4 * i] * (f2_t){w4.x, w4.x} + a;
                        acc[jp][eg * 4 + e] = a;
                    }
                }
                __builtin_amdgcn_sched_barrier(0);
            }
        }
        const bool b5 = lane & 32, b4 = lane & 16, b3 = lane & 8, b2 = lane & 4;
#pragma unroll
        for (int j = 0; j < NRR; ++j) {
            float r8[8], r4[4], r2[2];
#pragma unroll
            for (int e = 0; e < 8; ++e) {
                const float lo = (j & 1) ? acc[j >> 1][e].y : acc[j >> 1][e].x, hi = (j & 1) ? acc[j >> 1][e + 8].y : acc[j >> 1][e + 8].x;
                const float snd = b5 ? lo : hi, kp = b5 ? hi : lo; r8[e] = kp + __shfl_xor(snd, 32);
            }
#pragma unroll
            for (int e = 0; e < 4; ++e) { const float snd = b4 ? r8[e] : r8[e + 4], kp = b4 ? r8[e + 4] : r8[e]; r4[e] = kp + __shfl_xor(snd, 16); }
#pragma unroll
            for (int e = 0; e < 2; ++e) { const float snd = b3 ? r4[e] : r4[e + 2], kp = b3 ? r4[e + 2] : r4[e]; r2[e] = kp + __shfl_xor(snd, 8); }
            float rv; { const float snd = b2 ? r2[0] : r2[1], kp = b2 ? r2[1] : r2[0]; rv = kp + __shfl_xor(snd, 4); }
            rv += __shfl_xor(rv, 2); rv += __shfl_xor(rv, 1);
            if (j < nv) {
                if ((lane & 3) == 0) lgb[(wave * 16 + it) * 16 + (lane >> 2)] = rv;
                if (lane == it) myrow = row0 + j * rstride;
                ++it;
            }
        }
        if (it == 16) { route_flush(p, lds, lane, wave, it, myrow, layer); it = 0; }
    }
    if (it > 0) route_flush(p, lds, lane, wave, it, myrow, layer);
}

template <class WF, class XF, class EPI>
__device__ __forceinline__ void gemm_tile(char* lds, int nkt, WF wf, XF xf, EPI epi) {
    const int tid = TID(), lane = tid & 63, wave = tid >> 6;
    const int wn = wave & 1, wm = wave >> 1, hh = lane >> 5;
    const int lrow = tid >> 3;
    const int lchunk = (tid & 7) ^ ((tid >> 4) & 7);
    const half_t* xs[4];
#pragma unroll
    for (int i = 0; i < 4; ++i) xs[i] = xf(lrow + 32 * i) + lchunk * 8;
    char* ldst = lds + lrow * 128 + (tid & 7) * 16;
    f16v acc[2][2];
#pragma unroll
    for (int i = 0; i < 2; ++i)
#pragma unroll
        for (int j = 0; j < 2; ++j)
#pragma unroll
            for (int r = 0; r < 16; ++r) acc[i][j][r] = 0.f;
    auto issue = [&](int kt, int s) {
        char* d = ldst + s * 32768;
#pragma unroll
        for (int i = 0; i < 4; ++i) glds16(wf(kt, lrow + 32 * i) + lchunk * 8, d + i * 4096);
#pragma unroll
        for (int i = 0; i < 4; ++i) glds16(xs[i] + kt * 64, d + 16384 + i * 4096);
    };
    __syncthreads();
    issue(0, 0);
    const int rsw = (lane >> 1) & 7;
    const int roff_w = (wn * 64 + (lane & 31)) * 128, roff_x = 16384 + (wm * 64 + (lane & 31)) * 128;
    for (int kt = 0; kt < nkt; ++kt) {
        asm volatile("s_waitcnt vmcnt(0)" ::: "memory");
        __syncthreads();
        if (kt + 1 < nkt) issue(kt + 1, (kt + 1) & 1);
        const char* base = lds + (kt & 1) * 32768;
#pragma unroll
        for (int ks = 0; ks < 4; ++ks) {
            const int co = ((2 * ks + hh) ^ rsw) << 4;
            const h8 a0 = *(const h8*)(base + roff_w + co), a1 = *(const h8*)(base + roff_w + 4096 + co);
            const h8 b0 = *(const h8*)(base + roff_x + co), b1 = *(const h8*)(base + roff_x + 4096 + co);
            acc[0][0] = __builtin_amdgcn_mfma_f32_32x32x16_f16(a0, b0, acc[0][0], 0, 0, 0);
            acc[0][1] = __builtin_amdgcn_mfma_f32_32x32x16_f16(a0, b1, acc[0][1], 0, 0, 0);
            acc[1][0] = __builtin_amdgcn_mfma_f32_32x32x16_f16(a1, b0, acc[1][0], 0, 0, 0);
            acc[1][1] = __builtin_amdgcn_mfma_f32_32x32x16_f16(a1, b1, acc[1][1], 0, 0, 0);
        }
    }
    epi(acc, wn, wm, lane);
}

template <class WF, class XF, class EPI>
__device__ __forceinline__ void gemm_tile2(char* lds, int nkt, size_t xkstride, WF wf, XF xf, EPI epi) {
    const int tid = TID(), lane = tid & 63, wave = tid >> 6;
    const int wn = wave & 1, wm = wave >> 1, hh = lane >> 5;
    const int lrow = tid >> 2;
    const int lchunk = (tid & 3) ^ ((tid >> 4) & 3);
    const half_t* xs[2];
#pragma unroll
    for (int i = 0; i < 2; ++i) xs[i] = xf(lrow + 64 * i) + lchunk * 8;
    char* ldst = lds + lrow * 64 + (tid & 3) * 16;
    f16v acc[4][2];
#pragma unroll
    for (int i = 0; i < 4; ++i)
#pragma unroll
        for (int j = 0; j < 2; ++j)
#pragma unroll
            for (int r = 0; r < 16; ++r) acc[i][j][r] = 0.f;
    auto issue = [&](int kt, int s) {
        char* d = ldst + s * 24576;
#pragma unroll
        for (int i = 0; i < 4; ++i) glds16(wf(kt, lrow + 64 * i) + lchunk * 8, d + i * 4096);
#pragma unroll
        for (int i = 0; i < 2; ++i) glds16(xs[i] + (size_t)kt * xkstride, d + 16384 + i * 4096);
    };
    __syncthreads();
    issue(0, 0); issue(1, 1);
    const int rsw = (lane >> 2) & 3;
    const int roff_w = (wn * 128 + (lane & 31)) * 64, roff_x = 16384 + (wm * 64 + (lane & 31)) * 64;
    int st = 0;
    for (int kt = 0; kt < nkt; ++kt) {
        if (kt + 1 < nkt) asm volatile("s_waitcnt vmcnt(6)" ::: "memory");
        else asm volatile("s_waitcnt vmcnt(0)" ::: "memory");
        asm volatile("s_waitcnt lgkmcnt(0)" ::: "memory");
        __builtin_amdgcn_s_barrier();
        if (kt + 2 < nkt) issue(kt + 2, st >= 1 ? st - 1 : 2);
        const char* base = lds + st * 24576;
        st = st == 2 ? 0 : st + 1;
#pragma unroll
        for (int ks = 0; ks < 2; ++ks) {
            const int co = ((2 * ks + hh) ^ rsw) << 4;
            h8 a[4], b[2];
#pragma unroll
            for (int i = 0; i < 4; ++i) a[i] = *(const h8*)(base + roff_w + i * 2048 + co);
#pragma unroll
            for (int j = 0; j < 2; ++j) b[j] = *(const h8*)(base + roff_x + j * 2048 + co);
#pragma unroll
            for (int i = 0; i < 4; ++i)
#pragma unroll
                for (int j = 0; j < 2; ++j) acc[i][j] = __builtin_amdgcn_mfma_f32_32x32x16_f16(a[i], b[j], acc[i][j], 0, 0, 0);
        }
    }
    epi(acc, wn, wm, lane);
}

__device__ __forceinline__ void phase_inproj(KP p, char* lds, int l) {
    const half_t* W = p->Wt_in + (size_t)l * NP * DM;
    const float* rc16 = p->rope; const float* rs16 = p->rope + 16384; const float* rc8 = p->rope + 32768; const float* rs8 = p->rope + 32768 + 8192;
    for (int u = BID(); u < 256 * 10; u += gridDim.x) {
        const int xl = u & 7, Lx = u >> 3, mi = Lx & 15, rr_ = Lx >> 4;
        const int nt = rr_ % 10, mt = 32 * xl + 16 * (rr_ / 10) + mi;
        gemm_tile2(lds, 32, (size_t)T_TOK * 32,
            [&](int kt, int row) { int n = nt * 256 + row; n = n < NP ? n : NP - 1; return W + ((size_t)kt * NP + n) * 32; },
            [&](int row) { return p->hn + (size_t)(mt * 128 + row) * 32; },
            [&](f16v (&acc)[4][2], int wn, int wm, int lane) {
                const int hh = lane >> 5;
                half_t* stg = (half_t*)lds;
                __syncthreads();
#pragma unroll
                for (int i = 0; i < 4; ++i) {
                    const int nb = nt * 256 + wn * 128 + i * 32;
                    if (nb == 1216 || nb == 1248 || nb >= NP) continue;
                    if (nt < 2) {
                        if (i & 1) continue;
#pragma unroll
                        for (int j = 0; j < 2; ++j) {
                            half_t* dst = stg + (wm * 64 + j * 32 + (lane & 31)) * 260 + wn * 64 + (i >> 1) * 32 + 4 * hh;
#pragma unroll
                            for (int g = 0; g < 4; ++g) {
                                float a4[4];
#pragma unroll
                                for (int r = 0; r < 4; ++r) a4[r] = acc[i][j][4 * g + r] * sigmoidf_(acc[i + 1][j][4 * g + r]);
                                *(h4*)(dst + 8 * g) = pack4(a4[0], a4[1], a4[2], a4[3]);
                            }
                        }
                        continue;
                    }
                    const bool rope64 = ((nb >= PC_DQ && nb < PC_DV) || (nb >= PC_MQ && nb < PC_MV)) && ((nb & 63) == 0);
                    const bool rope32 = (nb >= PC_IQ && nb < PC_IW);
#pragma unroll
                    for (int j = 0; j < 2; ++j) {
                        const int tok = mt * 128 + wm * 64 + j * 32 + (lane & 31);
                        const int t = tok & 2047;
                        f16v v = acc[i][j];
                        if (nb == PC_IW) { if (hh == 0) *(float4*)(p->iwf + (size_t)tok * 4) = make_float4(v[0], v[1], v[2], v[3]); continue; }
                        if (rope64) {
                            const float4 c4 = *(const float4*)(rc16 + t * 8 + 4 * hh), s4 = *(const float4*)(rs16 + t * 8 + 4 * hh);
                            const float cc[4] = {c4.x, c4.y, c4.z, c4.w}, sn[4] = {s4.x, s4.y, s4.z, s4.w};
#pragma unroll
                            for (int r = 0; r < 4; ++r) { const float x1 = v[r], x2 = v[r + 4]; v[r] = x1 * cc[r] - x2 * sn[r]; v[r + 4] = x2 * cc[r] + x1 * sn[r]; }
                        } else if (rope32) {
                            const float4 c4 = *(const float4*)(rc8 + t * 4), s4 = *(const float4*)(rs8 + t * 4);
                            const float cc[4] = {c4.x, c4.y, c4.z, c4.w}, sn[4] = {s4.x, s4.y, s4.z, s4.w};
#pragma unroll
                            for (int r = 0; r < 4; ++r) { const float o = __shfl_xor(v[r], 32); v[r] = hh ? (v[r] * cc[r] + o * sn[r]) : (v[r] * cc[r] - o * sn[r]); }
                        }
                        if ((nb >= PC_DQ && nb < PC_DK) || (nb >= PC_MQ && nb < PC_MK)) {
#pragma unroll
                            for (int r = 0; r < 16; ++r) v[r] *= 0.18033688011112042f;
                        }
                        half_t* dst = stg + (wm * 64 + j * 32 + (lane & 31)) * 260 + wn * 128 + i * 32 + 4 * hh;
#pragma unroll
                        for (int g = 0; g < 4; ++g) *(h4*)(dst + 8 * g) = pack4(v[4 * g], v[4 * g + 1], v[4 * g + 2], v[4 * g + 3]);
                    }
                }
                __syncthreads();
                const int wv_ = TID() >> 6;
#pragma unroll 4
                for (int it = 0; it < 32; ++it) {
                    const int row = it * 4 + wv_;
                    const uint2 v2 = *(const uint2*)(stg + row * 260 + lane * 4);
                    if (nt < 2) { if (lane < 32) *(uint2*)(p->P + (size_t)(mt * 128 + row) * NP + nt * 128 + lane * 4) = v2; }
                    else { const int n = nt * 256 + lane * 4; if (n < NP) *(uint2*)(p->P + (size_t)(mt * 128 + row) * NP + n) = v2; }
                }
            });
    }
}

__device__ __forceinline__ void stage_acc_f32(char* lds, const f16v (&acc)[2][2], int wn, int wm, int lane) {
    float* stg = (float*)lds;
    const int hh = lane >> 5;
    __syncthreads();
#pragma unroll
    for (int j = 0; j < 2; ++j)
#pragma unroll
        for (int i = 0; i < 2; ++i)
#pragma unroll
            for (int g = 0; g < 4; ++g)
                *(float4*)(stg + (wm * 64 + j * 32 + (lane & 31)) * 132 + wn * 64 + i * 32 + 4 * hh + 8 * g) = make_float4(acc[i][j][4 * g], acc[i][j][4 * g + 1], acc[i][j][4 * g + 2], acc[i][j][4 * g + 3]);
    __syncthreads();
}
template <bool HIN>
__device__ __forceinline__ void phase_outproj(KP p, char* lds, int l, const void* xin) {
    const half_t* W = p->Wt_o + (size_t)l * DM * DM;
    const float* g1 = p->modf + (size_t)l * 16 * 6144 + 2 * 1024;
    for (int u = BID(); u < 256 * 4; u += gridDim.x) {
        const int xl = u & 7, Lx = u >> 3, mi = Lx & 7, rr_ = Lx >> 3;
        const int nt = rr_ & 3, mt = 32 * xl + 8 * (rr_ >> 2) + mi;
        gemm_tile2(lds, 32, (size_t)T_TOK * 32,
            [&](int kt, int row) { return W + ((size_t)kt * DM + nt * 256 + row) * 32; },
            [&](int row) { return p->ycat + (size_t)(mt * 128 + row) * 32; },
            [&](f16v (&acc)[4][2], int wn, int wm, int lane) {
                const int hh = lane >> 5, tid = TID();
                float* stg = (float*)lds;
#pragma unroll
                for (int rnd = 0; rnd < 2; ++rnd) {
                    __syncthreads();
                    if (wm == rnd) {
#pragma unroll
                        for (int j = 0; j < 2; ++j)
#pragma unroll
                            for (int i = 0; i < 4; ++i)
#pragma unroll
                                for (int g = 0; g < 4; ++g)
                                    *(float4*)(stg + (j * 32 + (lane & 31)) * 260 + wn * 128 + i * 32 + 4 * hh + 8 * g) = make_float4(acc[i][j][4 * g], acc[i][j][4 * g + 1], acc[i][j][4 * g + 2], acc[i][j][4 * g + 3]);
                    }
                    __syncthreads();
#pragma unroll 4
                    for (int it = 0; it < 16; ++it) {
                        const int idx = it * 256 + tid, row = idx >> 6, c = idx & 63;
                        const int tok = mt * 128 + rnd * 64 + row, n = nt * 256 + 4 * c;
                        const float4 a4 = *(const float4*)(stg + row * 260 + 4 * c);
                        const float4 xi = ldx4<HIN>(xin, (size_t)tok * DM + n);
                        const float4 gg = *(const float4*)(g1 + (size_t)(tok >> 11) * 6144 + n);
                        *(h4*)(p->xr + (size_t)tok * DM + n) = pack4(xi.x + gg.x * a4.x, xi.y + gg.y * a4.y, xi.z + gg.z * a4.z, xi.w + gg.w * a4.w);
                    }
                }
            });
    }
}

__device__ __forceinline__ bool moe_tile(const int* cnt, int tile, int& cls, int& pos0, int& n) {
    int tb = 0;
    for (int c = 0; c < NCLS; ++c) {
        const int nc = cnt[c * 64], nt = (nc + 127) >> 7;
        if (tile < tb + nt) { cls = c; pos0 = (tile - tb) * 128; n = nc; return true; }
        tb += nt;
    }
    return false;
}
__device__ __forceinline__ void cls_experts(int cls, int& e1, int& e2) {
    const int g = cls / 6, pi = cls % 6;
    const int a = pi < 3 ? 0 : (pi < 5 ? 1 : 2);
    const int b = pi < 3 ? pi + 1 : (pi < 5 ? pi - 1 : 3);
    e1 = g * 4 + a; e2 = g * 4 + b;
}
__device__ __forceinline__ void phase_moe_up(KP p, char* lds, int l) {
    const int* cnt = p->cnt + l * 32 * 64;
    for (int u = BID(); u < (256 + NCLS) * 8; u += gridDim.x) {
        const int xl = u & 7, Lx = u >> 3;
        const int nt = Lx & 7, tile = (Lx >> 3) * 8 + xl;
        int cls, pos0, nc;
        if (!moe_tile(cnt, tile, cls, pos0, nc)) continue;
        int e1, e2; cls_experts(cls, e1, e2);
        const int slot = nt >> 2;
        const half_t* W = p->Wt_gu + ((size_t)(l * 16 + (slot ? e2 : e1)) * 512 + (nt & 3) * 128) * 1024;
        const int* lst = p->lists + (size_t)cls * T_TOK + pos0;
        const int nvalid = nc - pos0;
        gemm_tile(lds, 16,
            [&](int kt, int row) { return W + (size_t)row * 1024 + kt * 64; },
            [&](int row) { const int tok = lst[row < nvalid ? row : 0]; return p->hn + (size_t)tok * DM; },
            [&](f16v (&acc)[2][2], int wn, int wm, int lane) {
                const int hh = lane >> 5;
#pragma unroll
                for (int j = 0; j < 2; ++j) {
                    const int row = wm * 64 + j * 32 + (lane & 31);
                    if (row < nvalid) {
                        const int tok = lst[row];
                        const float wgt = p->tokw[(size_t)tok * 2 + slot];
                        half_t* dst = p->act + (size_t)tok * 512 + slot * 256 + ((nt & 3) * 2 + wn) * 32 + 4 * hh;
#pragma unroll
                        for (int g = 0; g < 4; ++g) {
                            float a[4];
#pragma unroll
                            for (int r = 0; r < 4; ++r) { const float gv = acc[0][j][4 * g + r], uv = acc[1][j][4 * g + r]; a[r] = gv * sigmoidf_(gv) * uv * wgt; }
                            *(h4*)(dst + 8 * g) = pack4(a[0], a[1], a[2], a[3]);
                        }
                    }
                }
            });
    }
}
__device__ __forceinline__ void phase_moe_down(KP p, char* lds, int l, float gsc) {
    const int* cnt = p->cnt + l * 32 * 64;
    const float* g2 = p->modf + (size_t)l * 16 * 6144 + 5 * 1024;
    for (int u = BID(); u < (256 + NCLS) * 8; u += gridDim.x) {
        const int xl = u & 7, Lx = u >> 3;
        const int nt = Lx & 7, tile = (Lx >> 3) * 8 + xl;
        int cls, pos0, nc;
        if (!moe_tile(cnt, tile, cls, pos0, nc)) continue;
        int e1, e2; cls_experts(cls, e1, e2);
        const half_t* W1 = p->Wt_d + ((size_t)(l * 16 + e1) * 1024 + nt * 128) * 256;
        const half_t* W2 = p->Wt_d + ((size_t)(l * 16 + e2) * 1024 + nt * 128) * 256;
        const int* lst = p->lists + (size_t)cls * T_TOK + pos0;
        const int nvalid = nc - pos0;
        gemm_tile(lds, 8,
            [&](int kt, int row) { return (kt < 4 ? W1 : W2) + (size_t)row * 256 + (kt & 3) * 64; },
            [&](int row) { const int tok = lst[row < nvalid ? row : 0]; return p->act + (size_t)tok * 512; },
            [&](f16v (&acc)[2][2], int wn, int wm, int lane) {
                const int hh = lane >> 5;
#pragma unroll
                for (int j = 0; j < 2; ++j) {
                    const int row = wm * 64 + j * 32 + (lane & 31);
                    if (row < nvalid) {
                        const int tok = lst[row];
                        const int b = tok >> 11;
#pragma unroll
                        for (int i = 0; i < 2; ++i) {
                            const int nb = nt * 128 + wn * 64 + i * 32 + 4 * hh;
#pragma unroll
                            for (int g = 0; g < 4; ++g) {
                                const int n = nb + 8 * g;
                                h4* xp = (h4*)(p->xr + (size_t)tok * DM + n);
                                const h4 xi = *xp;
                                const float4 gg = *(const float4*)(g2 + (size_t)b * 6144 + n);
                                *xp = pack4((float)xi[0] + gsc * gg.x * acc[i][j][4 * g], (float)xi[1] + gsc * gg.y * acc[i][j][4 * g + 1],
                                            (float)xi[2] + gsc * gg.z * acc[i][j][4 * g + 2], (float)xi[3] + gsc * gg.w * acc[i][j][4 * g + 3]);
                            }
                        }
                    }
                }
            });
    }
}

__device__ __forceinline__ void dsa_select_unit(KP p, char* lds, int b, int qt) {
    unsigned* hist = (unsigned*)lds;
    unsigned* maskl = hist + 16 * 257 + 16;
    unsigned* stP = maskl + 1024;
    unsigned* stNeed = stP + 16;
    unsigned* stDone = stNeed + 16;
    unsigned* flag = stDone + 16;
    unsigned* dummyb = flag + 16;
    const int tid = TID(), lane = tid & 63, wave = tid >> 6;
    const int q0 = qt * 16, tokbase = b * SEQ;
    __syncthreads();
    if (q0 < 256) {
        for (int i = tid; i < 1024; i += 256) {
            const int q = i >> 6, wd = i & 63;
            const int n = q0 + q + 1 - 32 * wd;
            const unsigned w = n >= 32 ? 0xFFFFFFFFu : (n <= 0 ? 0u : ((1u << n) - 1u));
            p->dmask[(size_t)(tokbase + q0 + q) * 64 + wd] = w;
        }
        return;
    }
    for (int i = tid; i < 1024; i += 256) maskl[i] = 0u;
    if (tid < 16) { stP[tid] = 0u; stNeed[tid] = 256u; stDone[tid] = 0u; }
    for (int i = tid; i < 16 * 257; i += 256) hist[i] = 0u;
    __syncthreads();
    const int ql = lane & 15, fq = lane >> 4;
    const int tq = q0 + ql;
    const half_t* Pb = p->P + (size_t)tokbase * NP;
    h8 iqf[4];
#pragma unroll
    for (int hd = 0; hd < 4; ++hd) iqf[hd] = *(const h8*)(Pb + (size_t)tq * NP + PC_IQ + hd * 32 + 8 * fq);
    const float4 iw4 = *(const float4*)(p->iwf + (size_t)(tokbase + tq) * 4);
    const float wsc0 = iw4.x * 0.08838834764831845f, wsc1 = iw4.y * 0.08838834764831845f, wsc2 = iw4.z * 0.08838834764831845f, wsc3 = iw4.w * 0.08838834764831845f;
    const int ng = qt + 1;
    unsigned sc[32][4];
    const half_t* ikp = Pb + (size_t)ql * NP + PC_IK + 8 * fq;
#pragma unroll
    for (int gb = 0; gb < 4; ++gb) {
        h8 ik[8];
#pragma unroll
        for (int x = 0; x < 8; ++x) {
            int g = wave + 4 * (gb * 8 + x);
            g = g < ng ? g : ng - 1;
            ik[x] = *(const h8*)(ikp + (size_t)(16 * g) * NP);
        }
#pragma unroll
        for (int x = 0; x < 8; ++x) {
            const int gi = gb * 8 + x;
            const int g = wave + 4 * gi;
            const f4v z = {0.f, 0.f, 0.f, 0.f};
            const f4v c0 = __builtin_amdgcn_mfma_f32_16x16x32_f16(ik[x], iqf[0], z, 0, 0, 0);
            const f4v c1 = __builtin_amdgcn_mfma_f32_16x16x32_f16(ik[x], iqf[1], z, 0, 0, 0);
            const f4v c2 = __builtin_amdgcn_mfma_f32_16x16x32_f16(ik[x], iqf[2], z, 0, 0, 0);
            const f4v c3 = __builtin_amdgcn_mfma_f32_16x16x32_f16(ik[x], iqf[3], z, 0, 0, 0);
#pragma unroll
            for (int r = 0; r < 4; ++r) {
                const int j = 16 * g + 4 * fq + r;
                float sv = wsc0 * __builtin_amdgcn_fmed3f(c0[r], 0.f, INFINITY);
                sv = fmaf(wsc1, __builtin_amdgcn_fmed3f(c1[r], 0.f, INFINITY), sv);
                sv = fmaf(wsc2, __builtin_amdgcn_fmed3f(c2[r], 0.f, INFINITY), sv);
                sv = fmaf(wsc3, __builtin_amdgcn_fmed3f(c3[r], 0.f, INFINITY), sv);
                sv += 0.0f;
                const int sb = __float_as_int(sv);
                const unsigned su = (unsigned)sb ^ ((unsigned)(sb >> 31) | 0x80000000u);
                const unsigned ck = (su & 0xFFFFF800u) | (unsigned)(2047 - j);
                sc[gi][r] = (g < ng && j <= tq) ? ck : 0u;
            }
            if (g < ng) {
#pragma unroll
                for (int r = 0; r < 4; ++r) atomicAdd(hist + ql * 257 + (sc[gi][r] >> 24), 1u);
            }
        }
    }
    bool alldone = false;
    for (int pass = 0; pass < 5; ++pass) {
        const bool fin = alldone;
        if (!fin && pass > 0) { for (int i = tid; i < 16 * 257; i += 256) hist[i] = 0u; }
        if (tid == 0) *flag = 0u;
        __syncthreads();
        if (pass > 0) {
        const unsigned sP = stP[ql], sDone = stDone[ql];
        int wv = wave, fqv = fq;
        asm volatile("" : "+v"(wv), "+v"(fqv));
        if (fin) {
            const int sh = (int)(32u - 8u * (sDone ? sDone : 1u));
            unsigned* mrow = maskl + ql * 64;
#pragma unroll
            for (int gi = 0; gi < 32; ++gi) {
                const int g = wv + 4 * gi;
                unsigned nib = 0u;
#pragma unroll
                for (int r = 0; r < 4; ++r) {
                    const unsigned uu = sc[gi][r];
                    nib |= ((uu >> sh) >= sP) ? (1u << r) : 0u;
                }
                if (g < ng) atomicOr(&mrow[g >> 1], nib << ((g & 1) * 16 + 4 * fqv));
            }
        } else {
            const int shm = pass ? 32 - 8 * pass : 0, shd = 24 - 8 * pass;
            const unsigned orm = pass ? 0u : 0xFFFFFFFFu;
            const unsigned cmpv = pass ? (sDone == 0u ? sP : 0xFFFFFFFFu) : 0xFFFFFFFFu;
            unsigned* hrow = hist + ql * 257;
            unsigned* dummy = dummyb + lane;
#pragma unroll
            for (int gi = 0; gi < 32; ++gi) {
                const int g = wv + 4 * gi;
                if (g < ng) {
#pragma unroll
                    for (int r = 0; r < 4; ++r) {
                        const unsigned uu = sc[gi][r];
                        const bool match = (((uu >> shm) | orm) == cmpv);
                        const unsigned dig = (uu >> shd) & 255u;
                        unsigned* a = match ? hrow + dig : dummy;
                        atomicAdd(a, 1u);
                    }
                }
            }
        }
        }
        __syncthreads();
        if (fin) break;
        {
            const int qq = tid >> 4, seg = tid & 15;
            const bool active = (stDone[qq] == 0u);
            unsigned c16 = 0u;
            if (active) {
#pragma unroll
                for (int d = 0; d < 16; ++d) c16 += hist[qq * 257 + seg * 16 + d];
            }
            unsigned v = c16;
#pragma unroll
            for (int off = 1; off < 16; off <<= 1) { const unsigned t = __shfl_down(v, off, 16); if (seg + off < 16) v += t; }
            const unsigned suf = v - c16;
            const unsigned need = stNeed[qq];
            if (active && suf < need && need <= suf + c16) {
                unsigned run = suf, D = 0u, cD = 0u, nn = need;
                for (int d = 15; d >= 0; --d) {
                    const unsigned cc = hist[qq * 257 + seg * 16 + d];
                    if (run + cc >= need) { D = (unsigned)(seg * 16 + d); cD = cc; nn = need - run; break; }
                    run += cc;
                }
                const bool done = (cD == nn) || pass == 3;
                stP[qq] = (stP[qq] << 8) | D; stNeed[qq] = nn;
                if (done) stDone[qq] = (unsigned)(pass + 1); else atomicAdd(flag, 1u);
            }
        }
        __syncthreads();
        alldone = (*flag == 0u);
    }
    for (int i = tid; i < 1024; i += 256) p->dmask[(size_t)(tokbase + q0 + (i >> 6)) * 64 + (i & 63)] = maskl[i];
}

__device__ __forceinline__ void conv_unit(KP p, char* lds, int l, int b, int c) {
    float* red = (float*)lds;
    const int ch = TID(), lane = ch & 63, wave = ch >> 6;
    const int t0 = c * 32, tokbase = b * SEQ;
    float aw[62];
#pragma unroll
    for (int rr = 0; rr < 62; ++rr) {
        int tt = t0 - 30 + rr; const bool ok = tt >= 0; tt = ok ? tt : t0;
        const float v = (float)p->P[(size_t)(tokbase + tt) * NP + ch];
        aw[rr] = ok ? v : 0.f;
    }
    float w[31];
#pragma unroll
    for (int i = 0; i < 31; ++i) w[i] = p->w_dw[(l * 31 + i) * 256 + ch];
    const float bias = p->b_dw[l * 256 + ch];
    float y[32], s1[32], s2[32];
#pragma unroll
    for (int tk = 0; tk < 32; ++tk) {
        float sacc = bias;
#pragma unroll
        for (int i = 0; i < 31; ++i) sacc = fmaf(aw[tk + i], w[i], sacc);
        y[tk] = sacc; s1[tk] = sacc; s2[tk] = sacc * sacc;
    }
    {
        const bool b5 = lane & 32, b4 = lane & 16, b3 = lane & 8, b2 = lane & 4, b1 = lane & 2;
        float a16[16], c16[16], a8[8], c8[8], a4[4], c4[4], a2[2], c2[2];
#pragma unroll
        for (int e = 0; e < 16; ++e) { a16[e] = (b5 ? s1[e + 16] : s1[e]) + __shfl_xor(b5 ? s1[e] : s1[e + 16], 32); c16[e] = (b5 ? s2[e + 16] : s2[e]) + __shfl_xor(b5 ? s2[e] : s2[e + 16], 32); }
#pragma unroll
        for (int e = 0; e < 8; ++e) { a8[e] = (b4 ? a16[e + 8] : a16[e]) + __shfl_xor(b4 ? a16[e] : a16[e + 8], 16); c8[e] = (b4 ? c16[e + 8] : c16[e]) + __shfl_xor(b4 ? c16[e] : c16[e + 8], 16); }
#pragma unroll
        for (int e = 0; e < 4; ++e) { a4[e] = (b3 ? a8[e + 4] : a8[e]) + __shfl_xor(b3 ? a8[e] : a8[e + 4], 8); c4[e] = (b3 ? c8[e + 4] : c8[e]) + __shfl_xor(b3 ? c8[e] : c8[e + 4], 8); }
#pragma unroll
        for (int e = 0; e < 2; ++e) { a2[e] = (b2 ? a4[e + 2] : a4[e]) + __shfl_xor(b2 ? a4[e] : a4[e + 2], 4); c2[e] = (b2 ? c4[e + 2] : c4[e]) + __shfl_xor(b2 ? c4[e] : c4[e + 2], 4); }
        float av = (b1 ? a2[1] : a2[0]) + __shfl_xor(b1 ? a2[0] : a2[1], 2), cv = (b1 ? c2[1] : c2[0]) + __shfl_xor(b1 ? c2[0] : c2[1], 2);
        av += __shfl_xor(av, 1); cv += __shfl_xor(cv, 1);
        const int tokk = (b5 ? 16 : 0) + (b4 ? 8 : 0) + (b3 ? 4 : 0) + (b2 ? 2 : 0) + (b1 ? 1 : 0);
        __syncthreads();
        if ((lane & 1) == 0) { red[(tokk * 4 + wave) * 2] = av; red[(tokk * 4 + wave) * 2 + 1] = cv; }
        __syncthreads();
    }
    const float lg = p->ln_g[l * 256 + ch], lb = p->ln_b[l * 256 + ch];
#pragma unroll
    for (int tk = 0; tk < 32; ++tk) {
        const float4 ra = *(const float4*)(red + tk * 8), rb = *(const float4*)(red + tk * 8 + 4);
        const float t1 = (ra.x + ra.z) + (rb.x + rb.z);
        const float t2 = (ra.y + ra.w) + (rb.y + rb.w);
        const float mu = t1 * (1.0f / 256.0f);
        float var = t2 * (1.0f / 256.0f) - mu * mu; var = var < 0.f ? 0.f : var;
        float z = (y[tk] - mu) * (1.0f / sqrtf(var + 1e-6f)) * lg + lb;
        z = z * sigmoidf_(z);
        p->ycat[((size_t)(ch >> 5) * T_TOK + tokbase + t0 + tk) * 32 + (ch & 31)] = (half_t)z;
    }
}

__device__ __forceinline__ void kmean_unit(KP p, char* lds, int b, int h, int blk) {
    float* part = (float*)lds;
    const int tid = TID(), d = tid & 63, pt = tid >> 6;
    const half_t* r = p->P + (size_t)(b * SEQ + blk * 256 + pt * 64) * NP + PC_MK + h * 64 + d;
    float s = 0.f;
#pragma unroll 16
    for (int k = 0; k < 64; ++k) s += (float)r[(size_t)k * NP];
    __syncthreads();
    part[pt * 64 + d] = s;
    __syncthreads();
    if (tid < 64) p->kmean[(((size_t)b * 6 + h) * 8 + blk) * 64 + tid] = ((part[tid] + part[64 + tid]) + (part[128 + tid] + part[192 + tid])) * (1.0f / 256.0f);
}

#ifndef POST_MASK
#define POST_MASK 7
#endif
__device__ __forceinline__ void phase_post(KP p, char* lds, int l, int tm) {
    const int NA = 2048, NB = 1024, NC = 768;
    const int G_ = gridDim.x;
    for (int u0 = BID(), k_ = 0; u0 < NA + NB + NC; u0 += G_, ++k_) {
        int u = u0;
        if (u0 < NA && (k_ & 1) && (k_ + 1) * G_ <= NA) u = k_ * G_ + (G_ - 1 - (u0 - k_ * G_));
        if (u < NA) { if (tm & 1) dsa_select_unit(p, lds, u % 16, 127 - (u / 16)); }
        else if (u < NA + NB) { const int v = u - NA; if (tm & 2) conv_unit(p, lds, l, v % 16, v / 16); }
        else { const int v = u - NA - NB; if (tm & 4) kmean_unit(p, lds, v / 48, (v / 8) % 6, v % 8); }
    }
}

template <int MODE>
__device__ __forceinline__ void attn_unit(KP p, char* lds, int b, int h, int qt) {
    const int tid = TID(), lane = tid & 63, wave = tid >> 6, hh = lane >> 5, ql = lane & 31;
    const int q0 = qt * 128, tokbase = b * SEQ;
    const int tq = q0 + wave * 32 + ql;
    const half_t* Pb = p->P + (size_t)tokbase * NP;
    const int QOFF = MODE ? PC_MQ + h * 64 : PC_DQ + h * 64;
    const int KOFF = MODE ? PC_MK + h * 64 : PC_DK;
    const int VOFF = MODE ? PC_MV + h * 64 : PC_DV;
    const int own = qt >> 1;
    unsigned mysel = 0u, anysel = 0u;
    __syncthreads();
    if (MODE == 1) {
        float* km = (float*)(lds + 32768);
        float* gts = km + 512;
        unsigned* selq = (unsigned*)(gts + 1024);
        unsigned* anyb = selq + 128;
        for (int i = tid; i < 512; i += 256) km[i] = p->kmean[((size_t)b * 6 + h) * 512 + i];
        if (tid == 0) *anyb = 0u;
        __syncthreads();
        {
            const int q = tid & 127, hf = tid >> 7;
            if (hf * 4 < own) {
                const half_t* qr = Pb + (size_t)(q0 + q) * NP + QOFF;
                float g0 = 0.f, g1 = 0.f, g2 = 0.f, g3 = 0.f;
#pragma unroll
                for (int c8 = 0; c8 < 8; ++c8) {
                    const h8 qv = *(const h8*)(qr + c8 * 8);
#pragma unroll
                    for (int j4 = 0; j4 < 2; ++j4) {
                        const int d = c8 * 8 + j4 * 4;
                        const float q0f = (float)qv[j4 * 4], q1f = (float)qv[j4 * 4 + 1], q2f = (float)qv[j4 * 4 + 2], q3f = (float)qv[j4 * 4 + 3];
                        const float4 k0 = *(const float4*)(km + (hf * 4 + 0) * 64 + d), k1 = *(const float4*)(km + (hf * 4 + 1) * 64 + d);
                        const float4 k2 = *(const float4*)(km + (hf * 4 + 2) * 64 + d), k3 = *(const float4*)(km + (hf * 4 + 3) * 64 + d);
                        g0 = fmaf(q0f, k0.x, g0); g0 = fmaf(q1f, k0.y, g0); g0 = fmaf(q2f, k0.z, g0); g0 = fmaf(q3f, k0.w, g0);
                        g1 = fmaf(q0f, k1.x, g1); g1 = fmaf(q1f, k1.y, g1); g1 = fmaf(q2f, k1.z, g1); g1 = fmaf(q3f, k1.w, g1);
                        g2 = fmaf(q0f, k2.x, g2); g2 = fmaf(q1f, k2.y, g2); g2 = fmaf(q2f, k2.z, g2); g2 = fmaf(q3f, k2.w, g2);
                        g3 = fmaf(q0f, k3.x, g3); g3 = fmaf(q1f, k3.y, g3); g3 = fmaf(q2f, k3.z, g3); g3 = fmaf(q3f, k3.w, g3);
                    }
                }
                gts[q * 8 + hf * 4 + 0] = g0; gts[q * 8 + hf * 4 + 1] = g1; gts[q * 8 + hf * 4 + 2] = g2; gts[q * 8 + hf * 4 + 3] = g3;
            }
        }
        __syncthreads();
        if (tid < 128) {
            unsigned m = 0u;
            const int want = own < 3 ? own : 3;
            for (int r = 0; r < want; ++r) {
                int best = -1; float bv = -INFINITY;
                for (int j = 0; j < own; ++j) { const float gv = gts[tid * 8 + j]; if (!((m >> j) & 1u) && (best < 0 || gv > bv)) { best = j; bv = gv; } }
                m |= 1u << best;
            }
            selq[tid] = m;
            if (m) atomicOr(anyb, m);
        }
        __syncthreads();
        mysel = selq[wave * 32 + ql];
        anysel = *anyb;
        __syncthreads();
    }
    h8 qf[4];
#pragma unroll
    for (int ks = 0; ks < 4; ++ks) qf[ks] = *(const h8*)(Pb + (size_t)tq * NP + QOFF + 16 * ks + 8 * hh);
    f16v O0, O1;
#pragma unroll
    for (int r = 0; r < 16; ++r) { O0[r] = 0.f; O1[r] = 0.f; }
    float l_run = 0.f;
    bool unset = true;
    f16v negm;
#pragma unroll
    for (int r = 0; r < 16; ++r) negm[r] = 0.f;
    const float THR = 8.0f;
    const int ntile = 2 * qt + 2;
    auto skip = [&](int kt) -> bool { return MODE == 1 && kt < 4 * own && !((anysel >> (kt >> 2)) & 1u); };
    auto nexttile = [&](int kt) -> int { ++kt; while (kt < ntile && skip(kt)) ++kt; return kt; };
    const int lrow = tid >> 3;
    const int kchunk = (tid & 7) ^ ((tid >> 4) & 7);
    const int vchunk = (tid & 7) ^ (((tid >> 4) & 1) << 2);
    char* ldst = lds + lrow * 128 + (tid & 7) * 16;
    auto issue = [&](int kt, int s) {
        const half_t* src = Pb + (size_t)(kt * 64 + lrow) * NP;
        char* d = ldst + s * 16384;
        glds16(src + KOFF + kchunk * 8, d);
        glds16(src + (size_t)32 * NP + KOFF + kchunk * 8, d + 4096);
        glds16(src + VOFF + vchunk * 8, d + 8192);
        glds16(src + (size_t)32 * NP + VOFF + vchunk * 8, d + 8192 + 4096);
    };
    const int rsw = (lane >> 1) & 7;
    const int kro = ql * 128;
    const int li = lane & 15, qp = li >> 2, pp = li & 3, swv = (qp >> 1) & 1;
    const int vb0 = 8192 + (4 * hh + qp) * 128 + 32 * ((lane >> 4) & 1) + 8 * pp + 64 * (0 ^ swv);
    const int vb1 = 8192 + (4 * hh + qp) * 128 + 32 * ((lane >> 4) & 1) + 8 * pp + 64 * (1 ^ swv);
    int kt = -1; kt = nexttile(kt);
    int s = 0;
    if (kt < ntile) issue(kt, 0);
    while (kt < ntile) {
        const int ktn = nexttile(kt);
        asm volatile("s_waitcnt vmcnt(0)" ::: "memory");
        __syncthreads();
        if (ktn < ntile) issue(ktn, s ^ 1);
        const bool wave_active = (kt * 64 <= q0 + wave * 32 + 31);
        if (wave_active) {
            const char* base = lds + s * 16384;
            uint2 mw = make_uint2(0u, 0u);
            if (MODE == 0) mw = *(const uint2*)(p->dmask + (size_t)(tokbase + tq) * 64 + 2 * kt);
            h8 vf0[4], vf1[4];
#pragma unroll
            for (int kk = 0; kk < 4; ++kk) {
                const int roff = (32 * (kk >> 1) + 16 * (kk & 1)) * 128;
                const s4v lo0 = __builtin_amdgcn_ds_read_tr16_b64_v4i16((LAS s4v*)(base + vb0 + roff));
                const s4v hi0 = __builtin_amdgcn_ds_read_tr16_b64_v4i16((LAS s4v*)(base + vb0 + roff + 8 * 128));
                const s4v lo1 = __builtin_amdgcn_ds_read_tr16_b64_v4i16((LAS s4v*)(base + vb1 + roff));
                const s4v hi1 = __builtin_amdgcn_ds_read_tr16_b64_v4i16((LAS s4v*)(base + vb1 + roff + 8 * 128));
                vf0[kk] = __builtin_bit_cast(h8, __builtin_shufflevector(lo0, hi0, 0, 1, 2, 3, 4, 5, 6, 7));
                vf1[kk] = __builtin_bit_cast(h8, __builtin_shufflevector(lo1, hi1, 0, 1, 2, 3, 4, 5, 6, 7));
            }
            bool lane_on = true;
            if (MODE == 1 && kt < 4 * own) lane_on = (mysel >> (kt >> 2)) & 1u;
            f16v cin = negm;
            if (MODE == 1 && kt < 4 * own) {
#pragma unroll
                for (int r = 0; r < 16; ++r) cin[r] = lane_on ? negm[r] : -INFINITY;
            }
            f16v s0 = cin, s1 = cin;
#pragma unroll
            for (int ks = 0; ks < 4; ++ks) {
                const int co = ((2 * ks + hh) ^ rsw) << 4;
                const h8 k0 = *(const h8*)(base + kro + co), k1 = *(const h8*)(base + kro + 4096 + co);
                s0 = __builtin_amdgcn_mfma_f32_32x32x16_f16(k0, qf[ks], s0, 0, 0, 0);
                s1 = __builtin_amdgcn_mfma_f32_32x32x16_f16(k1, qf[ks], s1, 0, 0, 0);
            }
            if (MODE == 0) {
                const unsigned w0 = mw.x >> (4 * hh), w1 = mw.y >> (4 * hh);
#pragma unroll
                for (int r = 0; r < 16; ++r) {
                    const int pos = (r & 3) + 8 * (r >> 2);
                    const unsigned m0 = (unsigned)__builtin_amdgcn_sbfe((int)w0, pos, 1), m1 = (unsigned)__builtin_amdgcn_sbfe((int)w1, pos, 1);
                    s0[r] = __uint_as_float((__float_as_uint(s0[r]) & m0) | (0xFF800000u & ~m0));
                    s1[r] = __uint_as_float((__float_as_uint(s1[r]) & m1) | (0xFF800000u & ~m1));
                }
            } else if (kt >= 4 * own && kt * 64 + 63 > q0 + wave * 32) {
#pragma unroll
                for (int r = 0; r < 16; ++r) {
                    const int key = kt * 64 + (r & 3) + 8 * (r >> 2) + 4 * hh;
                    s0[r] = (key <= tq) ? s0[r] : -INFINITY;
                    s1[r] = (key + 32 <= tq) ? s1[r] : -INFINITY;
                }
            }
            float mx = s0[0];
#pragma unroll
            for (int r = 1; r < 16; ++r) mx = fmaxf(mx, s0[r]);
#pragma unroll
            for (int r = 0; r < 16; ++r) mx = fmaxf(mx, s1[r]);
            mx = fmaxf(mx, __shfl_xor(mx, 32));
            const bool need = unset ? (mx > -INFINITY) : (mx > THR);
            if (__any(need)) {
                const float delta = need ? mx : 0.f;
                const float alpha = (need && !unset) ? __builtin_amdgcn_exp2f(-delta) : 1.0f;
#pragma unroll
                for (int r = 0; r < 16; ++r) { s0[r] -= delta; s1[r] -= delta; negm[r] -= delta; O0[r] *= alpha; O1[r] *= alpha; }
                l_run *= alpha;
                unset = unset && !need;
            }
            float ls = 0.f;
#pragma unroll
            for (int r = 0; r < 16; ++r) { s0[r] = __builtin_amdgcn_exp2f(s0[r]); ls += s0[r]; }
#pragma unroll
            for (int r = 0; r < 16; ++r) { s1[r] = __builtin_amdgcn_exp2f(s1[r]); ls += s1[r]; }
            l_run += ls;
#pragma unroll
            for (int kk = 0; kk < 4; ++kk) {
                h8 pf;
#pragma unroll
                for (int j = 0; j < 8; ++j) pf[j] = (half_t)((kk >> 1) ? s1[8 * (kk & 1) + j] : s0[8 * (kk & 1) + j]);
                O0 = __builtin_amdgcn_mfma_f32_32x32x16_f16(vf0[kk], pf, O0, 0, 0, 0);
                O1 = __builtin_amdgcn_mfma_f32_32x32x16_f16(vf1[kk], pf, O1, 0, 0, 0);
            }
        }
        kt = ktn; s ^= 1;
    }
    const float lt = l_run + __shfl_xor(l_run, 32);
    const float inv = 1.0f / lt;
    const int ycol = (MODE ? 640 : 256) + h * 64;
    half_t* dst = p->ycat + ((size_t)(ycol >> 5) * T_TOK + tokbase + tq) * 32 + 4 * hh;
#pragma unroll
    for (int g = 0; g < 4; ++g) {
        *(h4*)(dst + 8 * g) = pack4(O0[4 * g] * inv, O0[4 * g + 1] * inv, O0[4 * g + 2] * inv, O0[4 * g + 3] * inv);
        *(h4*)(dst + (size_t)T_TOK * 32 + 8 * g) = pack4(O1[4 * g] * inv, O1[4 * g + 1] * inv, O1[4 * g + 2] * inv, O1[4 * g + 3] * inv);
    }
}

#ifndef ATT_MASK
#define ATT_MASK 3
#endif
__device__ __forceinline__ void phase_attn(KP p, char* lds, int tm) {
    const int G_ = gridDim.x, per_ = G_ >> 3;
    const bool snake_ = (G_ >= 8) && ((G_ & 7) == 0);
    for (int k_ = 0, b_ = BID(); snake_ ? (k_ * per_ < 384) : (b_ + k_ * G_ < 3072); ++k_) {
        int xl, Lx;
        if (snake_) { const int idx_ = b_ >> 3; xl = b_ & 7; Lx = k_ * per_ + ((k_ & 1) ? (per_ - 1 - idx_) : idx_); }
        else { const int u = b_ + k_ * G_; xl = u & 7; Lx = u >> 3; }
        if (Lx >= 384) continue;
        const int qt = 15 - (Lx / 24), rem = Lx % 24;
        const int type = rem & 1, bh = xl * 12 + (rem >> 1);
        if (type == 0) { if (tm & 1) attn_unit<0>(p, lds, bh / 6, bh % 6, qt); }
        else { if (tm & 2) attn_unit<1>(p, lds, bh / 6, bh % 6, qt); }
    }
}

__global__ void __launch_bounds__(256, 2) mk_fwd(Params p_unused) {
    extern __shared__ __attribute__((aligned(16))) char lds[];
    volatile LAS unsigned* stw = (volatile LAS unsigned*)(lds + LDS_CTL);
    if (threadIdx.x < 4) stw[threadIdx.x] = 0u;
    __syncthreads();
    KP p0 = (KP)__builtin_amdgcn_kernarg_segment_ptr();
    XcdBarrier bar; bar.bar = p0->bar; bar.x = 0; bar.st = stw;
#if !MK_SPLIT
    bar = xcd_barrier_post(p0->bar, stw);
#endif
    const int ph_lo = p0->ph_lo, ph_hi = p0->ph_hi;
    for (int ph = ph_lo; ph < ph_hi; ++ph) {
      KP p = p0; asm volatile("" : "+s"(p));
      const int nrep = (DUP_SUB >= 0 && ((DUP_SUB == 100 && ph == 0) || (ph >= 2 && ph < NPHASE - 1 && ((ph - 2) & 7) == DUP_SUB && (DUP_SUB != 4 || ph < 10)))) ? 2 : 1;
      for (int rep = 0; rep < nrep; ++rep) {
        if (ph == 0) phase_prologue(p, lds);
        else if (ph == 1) phase_modsum(p);
        else if (ph == NPHASE - 1) phase_norm<2, true>(p, lds, p->xr, p->g_final, nullptr, nullptr, 0);
        else {
            const int l = (ph - 2) >> 3, sub = (ph - 2) & 7;
            const float* mf = p->modf + (size_t)l * 16 * 6144;
            if (sub == 0) { if (l == 0) phase_norm<0, false>(p, lds, p->x, p->g_mix + l * DM, mf, mf + 1024, l); else phase_norm<0, true>(p, lds, p->xr, p->g_mix + l * DM, mf, mf + 1024, l); }
            else if (sub == 1) phase_inproj(p, lds, l);
            else if (sub == 2) phase_post(p, lds, l, rep ? POST_MASK : 7);
            else if (sub == 3) phase_attn(p, lds, rep ? ATT_MASK : 3);
            else if (sub == 4) { if (l == 0) phase_outproj<false>(p, lds, l, p->x); else phase_outproj<true>(p, lds, l, p->xr); }
            else if (sub == 5) phase_norm_router(p, lds, p->xr, p->g_ffn + l * DM, mf + 3 * 1024, mf + 4 * 1024, (nrep == 2 && rep == 0) ? l + 2 : l);
            else if (sub == 6) phase_moe_up(p, lds, l);
            else phase_moe_down(p, lds, l, nrep == 2 ? 0.5f : 1.0f);
        }
      }
#if !MK_SPLIT
        if (ph + 1 < ph_hi) xcd_barrier(bar);
#endif
    }
}

extern "C" void kernel_launch(void* const* d_in, const int* in_sizes, int n_in, void* d_out, int out_size, void* d_ws, size_t ws_size, hipStream_t stream) {
    static int grid = 0;
    if (grid == 0) {
        int dev = 0, cus = 0, per_cu = 0;
        (void)hipGetDevice(&dev);
        (void)hipDeviceGetAttribute(&cus, hipDeviceAttributeMultiprocessorCount, dev);
        (void)hipFuncSetAttribute((const void*)mk_fwd, hipFuncAttributeMaxDynamicSharedMemorySize, LDS_BYTES);
        if (hipOccupancyMaxActiveBlocksPerMultiprocessor(&per_cu, (const void*)mk_fwd, 256, LDS_BYTES) != hipSuccess || per_cu < 1) per_cu = 1;
        (void)hipGetLastError();
        if (per_cu > 2) per_cu = 2;
        grid = cus * per_cu;
        fprintf(stderr, "mk_fwd: cus %d per_cu %d grid %d\n", cus, per_cu, grid);
    }
    Params p{};
    const float** pin = (const float**)&p.x;
    for (int i = 0; i < 18; ++i) pin[i] = (const float*)d_in[i];
    p.out = (float*)d_out;
    char* ws = (char*)d_ws;
    size_t off = 0;
    auto carve = [&](size_t bytes) { void* q = ws + off; off += (bytes + 255) & ~(size_t)255; return q; };
    p.bar = (unsigned*)carve(XCD_BAR_WORDS * 4);
    p.cnt = (int*)carve(4 * 32 * 64 * 4);
    const size_t zero_bytes = off;
    p.Wt_in = (half_t*)carve((size_t)2 * NP * DM * 2);
    p.Wt_o = (half_t*)carve((size_t)2 * DM * DM * 2);
    p.Wt_gu = (half_t*)carve((size_t)2 * 16 * 512 * 1024 * 2);
    p.Wt_d = (half_t*)carve((size_t)2 * 16 * 1024 * 256 * 2);
    p.hn = (half_t*)carve((size_t)T_TOK * DM * 2);
    p.P = (half_t*)carve((size_t)T_TOK * NP * 2);
    p.ycat = (half_t*)carve((size_t)T_TOK * DM * 2);
    p.act = (half_t*)carve((size_t)T_TOK * 512 * 2);
    p.xr = (half_t*)carve((size_t)T_TOK * DM * 2);
    p.modpart = (float*)carve((size_t)8 * 2 * 16 * 6144 * 4);
    p.modf = (float*)carve((size_t)2 * 16 * 6144 * 4);
    p.kmean = (float*)carve((size_t)16 * 6 * 8 * 64 * 4);
    p.rope = (float*)carve((size_t)2048 * 24 * 4);
    p.iwf = (float*)carve((size_t)T_TOK * 4 * 4);
    p.tokw = (float*)carve((size_t)T_TOK * 2 * 4);
    p.dmask = (unsigned*)carve((size_t)T_TOK * 64 * 4);
    p.lists = (int*)carve((size_t)NCLS * T_TOK * 4);
    if (off > ws_size) { fprintf(stderr, "workspace too small: need %zu have %zu\n", off, ws_size); return; }
    (void)hipMemsetAsync(d_ws, 0, zero_bytes, stream);
#if MK_SPLIT
    for (int ph = 0; ph < NPHASE; ++ph) {
        p.ph_lo = ph; p.ph_hi = ph + 1;
        hipLaunchKernelGGL(mk_fwd, dim3(grid), dim3(256), LDS_BYTES, stream, p);
    }
#else
    p.ph_lo = 0; p.ph_hi = NPHASE;
    hipLaunchKernelGGL(mk_fwd, dim3(grid), dim3(256), LDS_BYTES, stream, p);
#endif
}
```

```cpp
#include <hip/hip_runtime.h>
#include <cstdio>
#include <cstdint>

#ifndef MK_SPLIT
#define MK_SPLIT 0
#endif

#define T_TOK 32768
#define DM 1024
#define SEQ 2048
#define INW 2340
#define NP 2432
#define PC_CU 0
#define PC_CG 256
#define PC_DQ 512
#define PC_DK 896
#define PC_DV 960
#define PC_IQ 1024
#define PC_IK 1152
#define PC_IW 1184
#define PC_MQ 1280
#define PC_MK 1664
#define PC_MV 2048
#define LOG_THETA 13.122363377404328f
#define NCLS 24
#define LDS_CTL 73728
#define LDS_BYTES 78336
#define NPHASE 19
#ifndef DUP_SUB
#define DUP_SUB -1
#endif

typedef _Float16 half_t;
typedef _Float16 h8 __attribute__((ext_vector_type(8)));
typedef _Float16 h4 __attribute__((ext_vector_type(4)));
typedef short s4v __attribute__((ext_vector_type(4)));
typedef short s8v __attribute__((ext_vector_type(8)));
typedef float f16v __attribute__((ext_vector_type(16)));
typedef float f4v __attribute__((ext_vector_type(4)));
#define LAS __attribute__((address_space(3)))

struct Params {
    const float *x, *c, *w_ada, *b_ada, *g_mix, *w_in, *w_dw, *b_dw, *ln_g, *ln_b, *w_o, *g_ffn, *w_router, *b_router, *w_gate, *w_up, *w_down, *g_final;
    float* out;
    half_t *Wt_in, *Wt_o, *Wt_gu, *Wt_d, *hn, *P, *ycat, *act, *xr;
    float *modpart, *modf, *kmean, *rope, *iwf, *tokw;
    unsigned* dmask; int* cnt; int* lists; unsigned* bar;
    int ph_lo, ph_hi;
};

#define XB_TMO      128
#define XB_XCNT(j)  (256  + 64 * (j))
#define XB_XSUB(j)  (1280 + 64 * (j))
#define XB_XGEN(j)  (2304 + 64 * (j))
#define XB_TOP      3328
#define XB_TOPGEN   3392
#define XCD_BAR_WORDS 3456
#define XB_SPIN_CAP (1u << 20)
__device__ __forceinline__ unsigned xb_ld(unsigned* p)              { return __hip_atomic_load(p, __ATOMIC_RELAXED, __HIP_MEMORY_SCOPE_AGENT); }
__device__ __forceinline__ unsigned xb_add(unsigned* p, unsigned v) { return __hip_atomic_fetch_add(p, v, __ATOMIC_RELAXED, __HIP_MEMORY_SCOPE_AGENT); }
__device__ __forceinline__ unsigned xb_xcc_id() { return (unsigned)__builtin_amdgcn_s_getreg((3 << 11) | 20) & 0xFu; }
#define XB_SPIN(cond, bar) do { unsigned _sp = 0; while (cond) { __builtin_amdgcn_s_sleep(1); \
    if ((++_sp & 255u) == 0u) { if (xb_ld(&(bar)[XB_TMO])) break; if (_sp > XB_SPIN_CAP) { atomicAdd(&(bar)[XB_TMO], 1u); break; } } } } while (0)
struct XcdBarrier { unsigned* bar; unsigned x; volatile LAS unsigned* st; };
__device__ __forceinline__ XcdBarrier xcd_barrier_post(unsigned* bar, volatile LAS unsigned* st) {
    XcdBarrier b; b.bar = bar; b.x = xb_xcc_id(); b.st = st;
    if (threadIdx.x == 0) (void)xb_add(&bar[XB_XCNT(b.x)], 1u);
    return b;
}
__device__ __forceinline__ void xcd_barrier_complete(unsigned* bar, unsigned x, unsigned& nloc, unsigned& nx) {
    const unsigned G = gridDim.x * gridDim.y * gridDim.z;
    unsigned sum, cnt, mine, sp = 0u;
    for (;;) {
        sum = 0u; cnt = 0u; mine = 0u;
#pragma unroll
        for (unsigned j = 0; j < 16; ++j) { const unsigned c = xb_ld(&bar[XB_XCNT(j)]); sum += c; cnt += (c > 0u) ? 1u : 0u; mine = (j == x) ? c : mine; }
        if (sum == G) break;
        __builtin_amdgcn_s_sleep(1);
        if ((++sp & 255u) == 0u) { if (xb_ld(&bar[XB_TMO])) break; if (sp > XB_SPIN_CAP) { atomicAdd(&bar[XB_TMO], 1u); break; } }
    }
    nloc = mine > 0u ? mine : 1u; nx = cnt > 0u ? cnt : 1u;
}
__device__ __forceinline__ void xcd_barrier(const XcdBarrier& b) {
    asm volatile("s_waitcnt vmcnt(0)" ::: "memory");
    __syncthreads();
    if (threadIdx.x == 0) {
        unsigned* bar = b.bar;
        __builtin_amdgcn_s_waitcnt(0);
        unsigned nloc = b.st[0], nx = b.st[1];
        if (nloc == 0u) { xcd_barrier_complete(bar, b.x, nloc, nx); b.st[0] = nloc; b.st[1] = nx; }
        const unsigned old = xb_add(&bar[XB_XSUB(b.x)], 1u);
        const unsigned gen = old / nloc;
        if (old + 1u == (gen + 1u) * nloc) {
            __builtin_amdgcn_fence(__ATOMIC_RELEASE, "agent");
            asm volatile("s_waitcnt vmcnt(0)" ::: "memory");
            const unsigned og = xb_add(&bar[XB_TOP], 1u);
            const unsigned tg = og / nx;
            if (og + 1u == (tg + 1u) * nx) xb_add(&bar[XB_TOPGEN], 1u);
            else XB_SPIN(xb_ld(&bar[XB_TOPGEN]) == tg, bar);
            __builtin_amdgcn_fence(__ATOMIC_ACQUIRE, "agent");
            xb_add(&bar[XB_XGEN(b.x)], 1u);
            asm volatile("s_waitcnt vmcnt(0)" ::: "memory");
        } else {
            XB_SPIN(xb_ld(&bar[XB_XGEN(b.x)]) == gen, bar);
            __builtin_amdgcn_fence(__ATOMIC_ACQUIRE, "agent");
            asm volatile("s_waitcnt vmcnt(0)" ::: "memory");
        }
    }
    __syncthreads();
}

typedef const __attribute__((address_space(4))) Params* KP;
__device__ __forceinline__ int TID() { int t = threadIdx.x; asm volatile("" : "+v"(t)); return t; }
__device__ __forceinline__ int BID() { int b = blockIdx.x; asm volatile("" : "+s"(b)); return b; }
__device__ __forceinline__ float sigmoidf_(float v) { return __builtin_amdgcn_rcpf(1.0f + __expf(-v)); }
__device__ __forceinline__ void glds16(const void* g, char* l) { __builtin_amdgcn_global_load_lds((const unsigned*)g, (unsigned*)l, 16, 0, 0); }
__device__ __forceinline__ unsigned f2sortable(float f) { unsigned u = __float_as_uint(f); return (u & 0x80000000u) ? ~u : (u | 0x80000000u); }
template <bool HIN> __device__ __forceinline__ float4 ldx4(const void* base, size_t idx) {
    if (HIN) { const h4 t = *(const h4*)((const half_t*)base + idx); return make_float4((float)t[0], (float)t[1], (float)t[2], (float)t[3]); }
    return *(const float4*)((const float*)base + idx);
}
__device__ __forceinline__ h4 pack4(float a, float b, float c, float d) { h4 r = {(half_t)a, (half_t)b, (half_t)c, (half_t)d}; return r; }

template <class CF>
__device__ __forceinline__ void conv_tile_panel(char* lds, CF colf, int src_ld, int k0, int n0, half_t* dst, int nrows) {
    float* tl = (float*)lds;
    const int tid = TID();
    __syncthreads();
    {
        const int nn = tid & 63;
        const float* cp = colf(nn);
        float tv[16];
#pragma unroll
        for (int i = 0; i < 16; ++i) { const int k = i * 4 + (tid >> 6); tv[i] = cp ? cp[(size_t)(k0 + k) * src_ld] : 0.f; }
#pragma unroll
        for (int i = 0; i < 16; ++i) { const int k = i * 4 + (tid >> 6); tl[k * 65 + nn] = tv[i]; }
    }
    __syncthreads();
    {
        const int n = tid >> 2, kq = (tid & 3) * 16;
        h8 a, b;
#pragma unroll
        for (int j = 0; j < 8; ++j) { a[j] = (half_t)tl[(kq + j) * 65 + n]; b[j] = (half_t)tl[(kq + 8 + j) * 65 + n]; }
        const int k = k0 + kq;
        h8* d = (h8*)(dst + ((size_t)(k >> 5) * nrows + n0 + n) * 32 + (k & 31));
        d[0] = a; d[1] = b;
    }
}
template <class CF>
__device__ __forceinline__ void conv_tile(char* lds, CF colf, int src_ld, int k0, half_t* dst_tile  , int dstK) {
    float* tl = (float*)lds;
    const int tid = TID();
    __syncthreads();
    {
        const int nn = tid & 63;
        const float* cp = colf(nn);
        float tv[16];
#pragma unroll
        for (int i = 0; i < 16; ++i) { const int k = i * 4 + (tid >> 6); tv[i] = cp ? cp[(size_t)(k0 + k) * src_ld] : 0.f; }
#pragma unroll
        for (int i = 0; i < 16; ++i) { const int k = i * 4 + (tid >> 6); tl[k * 65 + nn] = tv[i]; }
    }
    __syncthreads();
    {
        const int n = tid >> 2, kq = (tid & 3) * 16;
        h8 a, b;
#pragma unroll
        for (int j = 0; j < 8; ++j) { a[j] = (half_t)tl[(kq + j) * 65 + n]; b[j] = (half_t)tl[(kq + 8 + j) * 65 + n]; }
        h8* d = (h8*)(dst_tile + (size_t)n * dstK + kq);
        d[0] = a; d[1] = b;
    }
}

__device__ __forceinline__ void phase_prologue(KP p, char* lds) {
    const int tid = TID();
    const int NA = 2 * 16 * 38, NB = 2 * 16 * 16, NC = 2 * 16 * 16 * 8, ND = 2 * 16 * 4 * 16, NE = 384, NF = 8;
    const int total = NA + NB + NC + ND + NE + NF;
    for (int u0 = BID(); u0 < total; u0 += gridDim.x) {
        int u = u0;
        if (u < NA) {
            const int nt = u % 38, kt = (u / 38) % 16, l = u / (38 * 16);
            const float* src = p->w_in + (size_t)l * DM * INW;
            const int n0 = nt * 64;
            conv_tile_panel(lds, [&](int nn) -> const float* { const int np = n0 + nn; const int sc = np < 512 ? (((np & 63) < 32) ? 32 * (np >> 6) + (np & 31) : 256 + 32 * (np >> 6) + (np & 31)) : (np < 1188 ? np : (np < 1280 ? -1 : np - 92)); return sc >= 0 ? src + sc : (const float*)nullptr; },
                      INW, kt * 64, n0, p->Wt_in + (size_t)l * NP * DM, NP);
            continue;
        }
        u -= NA;
        if (u < NB) {
            const int nt = u % 16, kt = (u / 16) % 16, l = u / 256;
            const float* src = p->w_o + (size_t)l * DM * DM + nt * 64;
            conv_tile_panel(lds, [&](int nn) -> const float* { return src + nn; }, DM, kt * 64, nt * 64, p->Wt_o + (size_t)l * DM * DM, DM);
            continue;
        }
        u -= NB;
        if (u < NC) {
            const int nt = u % 8, kt = (u / 8) % 16, le = u / 128;
            const float* sg = p->w_gate + (size_t)le * 1024 * 256 + nt * 32;
            const float* su = p->w_up + (size_t)le * 1024 * 256 + nt * 32;
            conv_tile(lds, [&](int nn) -> const float* { return nn < 32 ? sg + nn : su + (nn - 32); }, 256, kt * 64, p->Wt_gu + ((size_t)le * 512 + nt * 64) * 1024 + kt * 64, 1024);
            continue;
        }
        u -= NC;
        if (u < ND) {
            const int nt = u % 16, kt = (u / 16) % 4, le = u / 64;
            const float* src = p->w_down + (size_t)le * 256 * 1024 + nt * 64;
            conv_tile(lds, [&](int nn) -> const float* { return src + nn; }, 1024, kt * 64, p->Wt_d + ((size_t)le * 1024 + nt * 64) * 256 + kt * 64, 256);
            continue;
        }
        u -= ND;
        if (u < NE) {
            const int kc = u % 8, cc = (u / 8) % 24, l = u / 192;
            float* ca = (float*)lds;
            __syncthreads();
            for (int i = tid; i < 2048; i += 256) { const int b = i >> 7, k = i & 127; const float v = p->c[b * 1024 + kc * 128 + k]; ca[i] = v / (1.0f + expf(-v)); }
            __syncthreads();
            const int n = cc * 256 + tid;
            float acc[16];
#pragma unroll
            for (int b = 0; b < 16; ++b) acc[b] = 0.f;
            const float* w = p->w_ada + ((size_t)l * 1024 + kc * 128) * 6144 + n;
#pragma unroll 16
            for (int k = 0; k < 128; ++k) {
                const float wv = w[(size_t)k * 6144];
#pragma unroll
                for (int b = 0; b < 16; ++b) acc[b] = fmaf(ca[b * 128 + k], wv, acc[b]);
            }
#pragma unroll
            for (int b = 0; b < 16; ++b) p->modpart[(((size_t)kc * 2 + l) * 16 + b) * 6144 + n] = acc[b];
            continue;
        }
        u -= NE;
        {
            for (int i = u * 256 + tid; i < 2048 * 12; i += NF * 256) {
                const int t = i / 12, r = i % 12;
                const int fi = r < 8 ? r : r - 8;
                const float rot = r < 8 ? 16.f : 8.f;
                const float inv = expf(-LOG_THETA * ((float)fi * 2.0f / rot));
                const float ang = (float)t * inv;
                float sn, cs; sincosf(ang, &sn, &cs);
                if (r < 8) { p->rope[t * 8 + fi] = cs; p->rope[16384 + t * 8 + fi] = sn; }
                else { p->rope[32768 + t * 4 + fi] = cs; p->rope[32768 + 8192 + t * 4 + fi] = sn; }
            }
        }
    }
}

__device__ __forceinline__ void phase_modsum(KP p) {
    for (int i = BID() * 256 + TID(); i < 2 * 16 * 6144; i += gridDim.x * 256) {
        const int n = i % 6144, l = i / (16 * 6144);
        float s = p->b_ada[l * 6144 + n];
#pragma unroll
        for (int kc = 0; kc < 8; ++kc) s += p->modpart[(size_t)kc * (2 * 16 * 6144) + i];
        p->modf[i] = s;
    }
}

__device__ __forceinline__ void route_flush(KP p, char* lds, int lane, int wave, int n, int myrow, int layer) {
    const float* lg = (const float*)(lds + LDS_CTL + 512) + wave * 256;
    int* lc = (int*)(lds + LDS_CTL + 64);
    int* lbase = lc + 32;
    const int tid = wave * 64 + lane;
    if (tid < 32) lc[tid] = 0;
    __syncthreads();
    int cls = 0, lpos = 0;
    if (lane < n) {
        float aff[16], bia[16];
#pragma unroll
        for (int e = 0; e < 16; ++e) { aff[e] = 1.0f / (1.0f + expf(-lg[lane * 16 + e])); bia[e] = aff[e] + p->b_router[e]; }
        int bestg = 0; float bests = -INFINITY;
#pragma unroll
        for (int gi = 0; gi < 4; ++gi) {
            float m1 = -INFINITY, m2 = -INFINITY;
#pragma unroll
            for (int j = 0; j < 4; ++j) { const float vv = bia[gi * 4 + j]; if (vv > m1) { m2 = m1; m1 = vv; } else if (vv > m2) m2 = vv; }
            const float s = m1 + m2;
            if (s > bests) { bests = s; bestg = gi; }
        }
        float bsel[4], asel[4];
#pragma unroll
        for (int j = 0; j < 4; ++j) { bsel[j] = 0.f; asel[j] = 0.f; }
#pragma unroll
        for (int gi = 0; gi < 4; ++gi) if (gi == bestg) {
#pragma unroll
            for (int j = 0; j < 4; ++j) { bsel[j] = bia[gi * 4 + j]; asel[j] = aff[gi * 4 + j]; }
        }
        int i1 = -1, i2 = -1; float v1 = -INFINITY, v2 = -INFINITY;
#pragma unroll
        for (int j = 0; j < 4; ++j) { const float vv = bsel[j]; if (vv > v1) { v2 = v1; i2 = i1; v1 = vv; i1 = j; } else if (vv > v2) { v2 = vv; i2 = j; } }
        const int a = i1 < i2 ? i1 : i2, bb = i1 < i2 ? i2 : i1;
        float wa = 0.f, wb = 0.f;
#pragma unroll
        for (int j = 0; j < 4; ++j) { if (j == a) wa = asel[j]; if (j == bb) wb = asel[j]; }
        const float sw = wa + wb;
        const int pi = (a == 0) ? (bb - 1) : (a == 1 ? (bb + 1) : 5);
        cls = bestg * 6 + pi;
        *(float2*)(p->tokw + (size_t)myrow * 2) = make_float2(wa / sw, wb / sw);
        lpos = atomicAdd(&lc[cls], 1);
    }
    __syncthreads();
    if (tid < NCLS) { const int c = lc[tid]; lbase[tid] = c ? atomicAdd(&p->cnt[(layer * 32 + tid) * 64], c) : 0; }
    __syncthreads();
    if (lane < n) p->lists[(size_t)cls * T_TOK + lbase[cls] + lpos] = myrow;
}

template <int MODE, bool HIN>
__device__ __forceinline__ void phase_norm(KP p, char* lds, const void* xin, const float* g, const float* sh, const float* sc, int layer) {
    const int lane = TID() & 63, wave = TID() >> 6;
    float* wt = (float*)lds;
    if (MODE == 1) {
        __syncthreads();
        for (int i = TID(); i < 4096; i += 256) {
            const float4 w4 = ((const float4*)p->w_router)[i];
            const int k = i >> 2, e0 = (i & 3) * 4;
            wt[(e0 + 0) * 1024 + k] = w4.x; wt[(e0 + 1) * 1024 + k] = w4.y; wt[(e0 + 2) * 1024 + k] = w4.z; wt[(e0 + 3) * 1024 + k] = w4.w;
        }
        __syncthreads();
    }
    float* lgb = (float*)(lds + LDS_CTL + 512);
    int myrow = 0, it = 0;
    float4 vn[4];
    {
        const int row0 = BID() * 4 + wave;
        const size_t xo = (size_t)(row0 < T_TOK ? row0 : 0) * DM;
#pragma unroll
        for (int i = 0; i < 4; ++i) vn[i] = ldx4<HIN>(xin, xo + (lane + 64 * i) * 4);
    }
    for (int row = BID() * 4 + wave; row < T_TOK; row += gridDim.x * 4) {
        const int b = row >> 11;
        float4 v[4]; float ss = 0.f;
#pragma unroll
        for (int i = 0; i < 4; ++i) v[i] = vn[i];
        {
            const int rown = row + gridDim.x * 4;
            const size_t xo = (size_t)(rown < T_TOK ? rown : row) * DM;
#pragma unroll
            for (int i = 0; i < 4; ++i) vn[i] = ldx4<HIN>(xin, xo + (lane + 64 * i) * 4);
        }
#pragma unroll
        for (int i = 0; i < 4; ++i) ss += v[i].x * v[i].x + v[i].y * v[i].y + v[i].z * v[i].z + v[i].w * v[i].w;
#pragma unroll
        for (int o = 32; o >= 1; o >>= 1) ss += __shfl_xor(ss, o);
        const float rstd = 1.0f / sqrtf(ss * (1.0f / 1024.0f) + 1e-6f);
        float acc[16], ya[16];
#pragma unroll
        for (int i = 0; i < 4; ++i) {
            const int k = (lane + 64 * i) * 4;
            const float4 gg = *(const float4*)(g + k);
            float y[4] = {v[i].x * rstd * gg.x, v[i].y * rstd * gg.y, v[i].z * rstd * gg.z, v[i].w * rstd * gg.w};
            if (MODE != 2) {
                const float4 s1 = *(const float4*)(sh + (size_t)b * 6144 + k), s2 = *(const float4*)(sc + (size_t)b * 6144 + k);
                y[0] = y[0] * (1.f + s2.x) + s1.x; y[1] = y[1] * (1.f + s2.y) + s1.y; y[2] = y[2] * (1.f + s2.z) + s1.z; y[3] = y[3] * (1.f + s2.w) + s1.w;
                if (MODE == 0) *(h4*)(p->hn + ((size_t)(k >> 5) * T_TOK + row) * 32 + (k & 31)) = pack4(y[0], y[1], y[2], y[3]);
                else *(h4*)(p->hn + (size_t)row * DM + k) = pack4(y[0], y[1], y[2], y[3]);
            } else {
                *(float4*)(p->out + (size_t)row * DM + k) = make_float4(y[0], y[1], y[2], y[3]);
            }
            ya[4 * i] = y[0]; ya[4 * i + 1] = y[1]; ya[4 * i + 2] = y[2]; ya[4 * i + 3] = y[3];
        }
        if (MODE == 1) {
#pragma unroll
            for (int e = 0; e < 16; ++e) acc[e] = 0.f;
            float4 wq[2][4];
            const float* wl = wt + lane * 4;
#pragma unroll
            for (int e = 0; e < 4; ++e) wq[0][e] = *(const float4*)(wl + e * 1024);
#pragma unroll
            for (int st = 0; st < 16; ++st) {
                const int i = st >> 2, eg = st & 3, cur = st & 1;
                if (st + 1 < 16) {
                    const int i2 = (st + 1) >> 2, eg2 = (st + 1) & 3;
#pragma unroll
                    for (int e = 0; e < 4; ++e) wq[cur ^ 1][e] = *(const float4*)(wl + (eg2 * 4 + e) * 1024 + i2 * 256);
                }
#pragma unroll
                for (int e = 0; e < 4; ++e) {
                    const float4 w4 = wq[cur][e];
                    acc[eg * 4 + e] = fmaf(ya[4 * i], w4.x, fmaf(ya[4 * i + 1], w4.y, fmaf(ya[4 * i + 2], w4.z, fmaf(ya[4 * i + 3], w4.w, acc[eg * 4 + e]))));
                }
                __builtin_amdgcn_sched_barrier(0);
            }
        }
        if (MODE == 1) {
            const bool b5 = lane & 32, b4 = lane & 16, b3 = lane & 8, b2 = lane & 4;
            float r8[8], r4[4], r2[2];
#pragma unroll
            for (int e = 0; e < 8; ++e) { const float snd = b5 ? acc[e] : acc[e + 8], kp = b5 ? acc[e + 8] : acc[e]; r8[e] = kp + __shfl_xor(snd, 32); }
#pragma unroll
            for (int e = 0; e < 4; ++e) { const float snd = b4 ? r8[e] : r8[e + 4], kp = b4 ? r8[e + 4] : r8[e]; r4[e] = kp + __shfl_xor(snd, 16); }
#pragma unroll
            for (int e = 0; e < 2; ++e) { const float snd = b3 ? r4[e] : r4[e + 2], kp = b3 ? r4[e + 2] : r4[e]; r2[e] = kp + __shfl_xor(snd, 8); }
            float rv; { const float snd = b2 ? r2[0] : r2[1], kp = b2 ? r2[1] : r2[0]; rv = kp + __shfl_xor(snd, 4); }
            rv += __shfl_xor(rv, 2); rv += __shfl_xor(rv, 1);
            if ((lane & 3) == 0) lgb[(wave * 16 + it) * 16 + (lane >> 2)] = rv;
            if (lane == it) myrow = row;
            ++it;
            if (it == 16) { route_flush(p, lds, lane, wave, it, myrow, layer); it = 0; }
        }
    }
    if (MODE == 1 && it > 0) route_flush(p, lds, lane, wave, it, myrow, layer);
}

typedef float f2_t __attribute__((ext_vector_type(2)));
#define NRR 2
__device__ __forceinline__ void phase_norm_router(KP p, char* lds, const half_t* xin, const float* g, const float* sh, const float* sc, int layer) {
    const int lane = TID() & 63, wave = TID() >> 6;
    float* wt = (float*)lds;
    __syncthreads();
    for (int i = TID(); i < 4096; i += 256) {
        const float4 w4 = ((const float4*)p->w_router)[i];
        const int k = i >> 2, e0 = (i & 3) * 4;
        wt[(e0 + 0) * 1024 + k] = w4.x; wt[(e0 + 1) * 1024 + k] = w4.y; wt[(e0 + 2) * 1024 + k] = w4.z; wt[(e0 + 3) * 1024 + k] = w4.w;
    }
    __syncthreads();
    float* lgb = (float*)(lds + LDS_CTL + 512);
    int myrow = 0, it = 0;
    const int rstride = gridDim.x * 4;
    for (int row0 = BID() * 4 + wave; row0 < T_TOK; row0 += rstride * NRR) {
        f2_t ya[NRR / 2][16];
        float ss[NRR];
        int nv = 0;
#pragma unroll
        for (int j = 0; j < NRR; ++j) nv += (row0 + j * rstride < T_TOK) ? 1 : 0;
        {
            float4 v[NRR][4];
#pragma unroll
            for (int j = 0; j < NRR; ++j) {
                const int r = row0 + j * rstride;
                const size_t xo = (size_t)(r < T_TOK ? r : row0) * DM;
#pragma unroll
                for (int i = 0; i < 4; ++i) v[j][i] = ldx4<true>(xin, xo + (lane + 64 * i) * 4);
            }
#pragma unroll
            for (int j = 0; j < NRR; ++j) {
                ss[j] = 0.f;
#pragma unroll
                for (int i = 0; i < 4; ++i) ss[j] += v[j][i].x * v[j][i].x + v[j][i].y * v[j][i].y + v[j][i].z * v[j][i].z + v[j][i].w * v[j][i].w;
            }
#pragma unroll
            for (int o = 32; o >= 1; o >>= 1) {
#pragma unroll
                for (int j = 0; j < NRR; ++j) ss[j] += __shfl_xor(ss[j], o);
            }
#pragma unroll
            for (int j = 0; j < NRR; ++j) ss[j] = 1.0f / sqrtf(ss[j] * (1.0f / 1024.0f) + 1e-6f);
#pragma unroll
            for (int j = 0; j < NRR; ++j) {
                const int r = row0 + j * rstride;
                const int rr = r < T_TOK ? r : row0;
                const int b = rr >> 11;
                const float rs = ss[j];
#pragma unroll
                for (int i = 0; i < 4; ++i) {
                    const int k = (lane + 64 * i) * 4;
                    const float4 gg = *(const float4*)(g + k);
                    const float4 s1 = *(const float4*)(sh + (size_t)b * 6144 + k), s2 = *(const float4*)(sc + (size_t)b * 6144 + k);
                    const float y0 = v[j][i].x * rs * gg.x * (1.f + s2.x) + s1.x, y1 = v[j][i].y * rs * gg.y * (1.f + s2.y) + s1.y;
                    const float y2 = v[j][i].z * rs * gg.z * (1.f + s2.z) + s1.z, y3 = v[j][i].w * rs * gg.w * (1.f + s2.w) + s1.w;
                    if (r < T_TOK) *(h4*)(p->hn + (size_t)r * DM + k) = pack4(y0, y1, y2, y3);
                    if (j & 1) { ya[j >> 1][4 * i].y = y0; ya[j >> 1][4 * i + 1].y = y1; ya[j >> 1][4 * i + 2].y = y2; ya[j >> 1][4 * i + 3].y = y3; }
                    else       { ya[j >> 1][4 * i].x = y0; ya[j >> 1][4 * i + 1].x = y1; ya[j >> 1][4 * i + 2].x = y2; ya[j >> 1][4 * i + 3].x = y3; }
                }
                __builtin_amdgcn_sched_barrier(0);
            }
        }
        f2_t acc[NRR / 2][16];
#pragma unroll
        for (int e = 0; e < 16; ++e) {
#pragma unroll
            for (int jp = 0; jp < NRR / 2; ++jp) acc[jp][e] = (f2_t){0.f, 0.f};
        }
        {
            float4 wq[2][4];
            const float* wl = wt + lane * 4;
#pragma unroll
            for (int e = 0; e < 4; ++e) wq[0][e] = *(const float4*)(wl + e * 1024);
#pragma unroll
            for (int st = 0; st < 16; ++st) {
                const int i = st >> 2, eg = st & 3, cur = st & 1;
                if (st + 1 < 16) {
                    const int i2 = (st + 1) >> 2, eg2 = (st + 1) & 3;
#pragma unroll
                    for (int e = 0; e < 4; ++e) wq[cur ^ 1][e] = *(const float4*)(wl + (eg2 * 4 + e) * 1024 + i2 * 256);
                }
#pragma unroll
                for (int e = 0; e < 4; ++e) {
                    const float4 w4 = wq[cur][e];
#pragma unroll
                    for (int jp = 0; jp < NRR / 2; ++jp) {
                        f2_t a = acc[jp][eg * 4 + e];
                        a = ya[jp][4 * i + 3] * (f2_t){w4.w, w4.w} + a;
                        a = ya[jp][4 * i + 2] * (f2_t){w4.z, w4.z} + a;
                        a = ya[jp][4 * i + 1] * (f2_t){w4.y, w4.y} + a;
                        a = ya[jp][4 * i] * (f2_t){w4.x, w4.x} + a;
                        acc[jp][eg * 4 + e] = a;
                    }
                }
                __builtin_amdgcn_sched_barrier(0);
            }
        }
        const bool b5 = lane & 32, b4 = lane & 16, b3 = lane & 8, b2 = lane & 4;
#pragma unroll
        for (int j = 0; j < NRR; ++j) {
            float r8[8], r4[4], r2[2];
#pragma unroll
            for (int e = 0; e < 8; ++e) {
                const float lo = (j & 1) ? acc[j >> 1][e].y : acc[j >> 1][e].x, hi = (j & 1) ? acc[j >> 1][e + 8].y : acc[j >> 1][e + 8].x;
                const float snd = b5 ? lo : hi, kp = b5 ? hi : lo; r8[e] = kp + __shfl_xor(snd, 32);
            }
#pragma unroll
            for (int e = 0; e < 4; ++e) { const float snd = b4 ? r8[e] : r8[e + 4], kp = b4 ? r8[e + 4] : r8[e]; r4[e] = kp + __shfl_xor(snd, 16); }
#pragma unroll
            for (int e = 0; e < 2; ++e) { const float snd = b3 ? r4[e] : r4[e + 2], kp = b3 ? r4[e + 2] : r4[e]; r2[e] = kp + __shfl_xor(snd, 8); }
            float rv; { const float snd = b2 ? r2[0] : r2[1], kp = b2 ? r2[1] : r2[0]; rv = kp + __shfl_xor(snd, 4); }
            rv += __shfl_xor(rv, 2); rv += __shfl_xor(rv, 1);
            if (j < nv) {
                if ((lane & 3) == 0) lgb[(wave * 16 + it) * 16 + (lane >> 2)] = rv;
                if (lane == it) myrow = row0 + j * rstride;
                ++it;
            }
        }
        if (it == 16) { route_flush(p, lds, lane, wave, it, myrow, layer); it = 0; }
    }
    if (it > 0) route_flush(p, lds, lane, wave, it, myrow, layer);
}

template <class WF, class XF, class EPI>
__device__ __forceinline__ void gemm_tile(char* lds, int nkt, WF wf, XF xf, EPI epi) {
    const int tid = TID(), lane = tid & 63, wave = tid >> 6;
    const int wn = wave & 1, wm = wave >> 1, hh = lane >> 5;
    const int lrow = tid >> 3;
    const int lchunk = (tid & 7) ^ ((tid >> 4) & 7);
    const half_t* xs[4];
#pragma unroll
    for (int i = 0; i < 4; ++i) xs[i] = xf(lrow + 32 * i) + lchunk * 8;
    char* ldst = lds + lrow * 128 + (tid & 7) * 16;
    f16v acc[2][2];
#pragma unroll
    for (int i = 0; i < 2; ++i)
#pragma unroll
        for (int j = 0; j < 2; ++j)
#pragma unroll
            for (int r = 0; r < 16; ++r) acc[i][j][r] = 0.f;
    auto issue = [&](int kt, int s) {
        char* d = ldst + s * 32768;
#pragma unroll
        for (int i = 0; i < 4; ++i) glds16(wf(kt, lrow + 32 * i) + lchunk * 8, d + i * 4096);
#pragma unroll
        for (int i = 0; i < 4; ++i) glds16(xs[i] + kt * 64, d + 16384 + i * 4096);
    };
    __syncthreads();
    issue(0, 0);
    const int rsw = (lane >> 1) & 7;
    const int roff_w = (wn * 64 + (lane & 31)) * 128, roff_x = 16384 + (wm * 64 + (lane & 31)) * 128;
    for (int kt = 0; kt < nkt; ++kt) {
        asm volatile("s_waitcnt vmcnt(0)" ::: "memory");
        __syncthreads();
        if (kt + 1 < nkt) issue(kt + 1, (kt + 1) & 1);
        const char* base = lds + (kt & 1) * 32768;
#pragma unroll
        for (int ks = 0; ks < 4; ++ks) {
            const int co = ((2 * ks + hh) ^ rsw) << 4;
            const h8 a0 = *(const h8*)(base + roff_w + co), a1 = *(const h8*)(base + roff_w + 4096 + co);
            const h8 b0 = *(const h8*)(base + roff_x + co), b1 = *(const h8*)(base + roff_x + 4096 + co);
            acc[0][0] = __builtin_amdgcn_mfma_f32_32x32x16_f16(a0, b0, acc[0][0], 0, 0, 0);
            acc[0][1] = __builtin_amdgcn_mfma_f32_32x32x16_f16(a0, b1, acc[0][1], 0, 0, 0);
            acc[1][0] = __builtin_amdgcn_mfma_f32_32x32x16_f16(a1, b0, acc[1][0], 0, 0, 0);
            acc[1][1] = __builtin_amdgcn_mfma_f32_32x32x16_f16(a1, b1, acc[1][1], 0, 0, 0);
        }
    }
    epi(acc, wn, wm, lane);
}

template <class WF, class XF, class EPI>
__device__ __forceinline__ void gemm_tile2(char* lds, int nkt, size_t xkstride, WF wf, XF xf, EPI epi) {
    const int tid = TID(), lane = tid & 63, wave = tid >> 6;
    const int wn = wave & 1, wm = wave >> 1, hh = lane >> 5;
    const int lrow = tid >> 2;
    const int lchunk = (tid & 3) ^ ((tid >> 4) & 3);
    const half_t* xs[2];
#pragma unroll
    for (int i = 0; i < 2; ++i) xs[i] = xf(lrow + 64 * i) + lchunk * 8;
    char* ldst = lds + lrow * 64 + (tid & 3) * 16;
    f16v acc[4][2];
#pragma unroll
    for (int i = 0; i < 4; ++i)
#pragma unroll
        for (int j = 0; j < 2; ++j)
#pragma unroll
            for (int r = 0; r < 16; ++r) acc[i][j][r] = 0.f;
    auto issue = [&](int kt, int s) {
        char* d = ldst + s * 24576;
#pragma unroll
        for (int i = 0; i < 4; ++i) glds16(wf(kt, lrow + 64 * i) + lchunk * 8, d + i * 4096);
#pragma unroll
        for (int i = 0; i < 2; ++i) glds16(xs[i] + (size_t)kt * xkstride, d + 16384 + i * 4096);
    };
    __syncthreads();
    issue(0, 0); issue(1, 1);
    const int rsw = (lane >> 2) & 3;
    const int roff_w = (wn * 128 + (lane & 31)) * 64, roff_x = 16384 + (wm * 64 + (lane & 31)) * 64;
    int st = 0;
    for (int kt = 0; kt < nkt; ++kt) {
        if (kt + 1 < nkt) asm volatile("s_waitcnt vmcnt(6)" ::: "memory");
        else asm volatile("s_waitcnt vmcnt(0)" ::: "memory");
        asm volatile("s_waitcnt lgkmcnt(0)" ::: "memory");
        __builtin_amdgcn_s_barrier();
        if (kt + 2 < nkt) issue(kt + 2, st >= 1 ? st - 1 : 2);
        const char* base = lds + st * 24576;
        st = st == 2 ? 0 : st + 1;
#pragma unroll
        for (int ks = 0; ks < 2; ++ks) {
            const int co = ((2 * ks + hh) ^ rsw) << 4;
            h8 a[4], b[2];
#pragma unroll
            for (int i = 0; i < 4; ++i) a[i] = *(const h8*)(base + roff_w + i * 2048 + co);
#pragma unroll
            for (int j = 0; j < 2; ++j) b[j] = *(const h8*)(base + roff_x + j * 2048 + co);
#pragma unroll
            for (int i = 0; i < 4; ++i)
#pragma unroll
                for (int j = 0; j < 2; ++j) acc[i][j] = __builtin_amdgcn_mfma_f32_32x32x16_f16(a[i], b[j], acc[i][j], 0, 0, 0);
        }
    }
    epi(acc, wn, wm, lane);
}

__device__ __forceinline__ void phase_inproj(KP p, char* lds, int l) {
    const half_t* W = p->Wt_in + (size_t)l * NP * DM;
    const float* rc16 = p->rope; const float* rs16 = p->rope + 16384; const float* rc8 = p->rope + 32768; const float* rs8 = p->rope + 32768 + 8192;
    for (int u = BID(); u < 256 * 10; u += gridDim.x) {
        const int xl = u & 7, Lx = u >> 3, mi = Lx & 15, rr_ = Lx >> 4;
        const int nt = rr_ % 10, mt = 32 * xl + 16 * (rr_ / 10) + mi;
        gemm_tile2(lds, 32, (size_t)T_TOK * 32,
            [&](int kt, int row) { int n = nt * 256 + row; n = n < NP ? n : NP - 1; return W + ((size_t)kt * NP + n) * 32; },
            [&](int row) { return p->hn + (size_t)(mt * 128 + row) * 32; },
            [&](f16v (&acc)[4][2], int wn, int wm, int lane) {
                const int hh = lane >> 5;
                half_t* stg = (half_t*)lds;
                __syncthreads();
#pragma unroll
                for (int i = 0; i < 4; ++i) {
                    const int nb = nt * 256 + wn * 128 + i * 32;
                    if (nb == 1216 || nb == 1248 || nb >= NP) continue;
                    if (nt < 2) {
                        if (i & 1) continue;
#pragma unroll
                        for (int j = 0; j < 2; ++j) {
                            half_t* dst = stg + (wm * 64 + j * 32 + (lane & 31)) * 260 + wn * 64 + (i >> 1) * 32 + 4 * hh;
#pragma unroll
                            for (int g = 0; g < 4; ++g) {
                                float a4[4];
#pragma unroll
                                for (int r = 0; r < 4; ++r) a4[r] = acc[i][j][4 * g + r] * sigmoidf_(acc[i + 1][j][4 * g + r]);
                                *(h4*)(dst + 8 * g) = pack4(a4[0], a4[1], a4[2], a4[3]);
                            }
                        }
                        continue;
                    }
                    const bool rope64 = ((nb >= PC_DQ && nb < PC_DV) || (nb >= PC_MQ && nb < PC_MV)) && ((nb & 63) == 0);
                    const bool rope32 = (nb >= PC_IQ && nb < PC_IW);
#pragma unroll
                    for (int j = 0; j < 2; ++j) {
                        const int tok = mt * 128 + wm * 64 + j * 32 + (lane & 31);
                        const int t = tok & 2047;
                        f16v v = acc[i][j];
                        if (nb == PC_IW) { if (hh == 0) *(float4*)(p->iwf + (size_t)tok * 4) = make_float4(v[0], v[1], v[2], v[3]); continue; }
                        if (rope64) {
                            const float4 c4 = *(const float4*)(rc16 + t * 8 + 4 * hh), s4 = *(const float4*)(rs16 + t * 8 + 4 * hh);
                            const float cc[4] = {c4.x, c4.y, c4.z, c4.w}, sn[4] = {s4.x, s4.y, s4.z, s4.w};
#pragma unroll
                            for (int r = 0; r < 4; ++r) { const float x1 = v[r], x2 = v[r + 4]; v[r] = x1 * cc[r] - x2 * sn[r]; v[r + 4] = x2 * cc[r] + x1 * sn[r]; }
                        } else if (rope32) {
                            const float4 c4 = *(const float4*)(rc8 + t * 4), s4 = *(const float4*)(rs8 + t * 4);
                            const float cc[4] = {c4.x, c4.y, c4.z, c4.w}, sn[4] = {s4.x, s4.y, s4.z, s4.w};
#pragma unroll
                            for (int r = 0; r < 4; ++r) { const float o = __shfl_xor(v[r], 32); v[r] = hh ? (v[r] * cc[r] + o * sn[r]) : (v[r] * cc[r] - o * sn[r]); }
                        }
                        if ((nb >= PC_DQ && nb < PC_DK) || (nb >= PC_MQ && nb < PC_MK)) {
#pragma unroll
                            for (int r = 0; r < 16; ++r) v[r] *= 0.18033688011112042f;
                        }
                        half_t* dst = stg + (wm * 64 + j * 32 + (lane & 31)) * 260 + wn * 128 + i * 32 + 4 * hh;
#pragma unroll
                        for (int g = 0; g < 4; ++g) *(h4*)(dst + 8 * g) = pack4(v[4 * g], v[4 * g + 1], v[4 * g + 2], v[4 * g + 3]);
                    }
                }
                __syncthreads();
                const int wv_ = TID() >> 6;
#pragma unroll 4
                for (int it = 0; it < 32; ++it) {
                    const int row = it * 4 + wv_;
                    const uint2 v2 = *(const uint2*)(stg + row * 260 + lane * 4);
                    if (nt < 2) { if (lane < 32) *(uint2*)(p->P + (size_t)(mt * 128 + row) * NP + nt * 128 + lane * 4) = v2; }
                    else { const int n = nt * 256 + lane * 4; if (n < NP) *(uint2*)(p->P + (size_t)(mt * 128 + row) * NP + n) = v2; }
                }
            });
    }
}

__device__ __forceinline__ void stage_acc_f32(char* lds, const f16v (&acc)[2][2], int wn, int wm, int lane) {
    float* stg = (float*)lds;
    const int hh = lane >> 5;
    __syncthreads();
#pragma unroll
    for (int j = 0; j < 2; ++j)
#pragma unroll
        for (int i = 0; i < 2; ++i)
#pragma unroll
            for (int g = 0; g < 4; ++g)
                *(float4*)(stg + (wm * 64 + j * 32 + (lane & 31)) * 132 + wn * 64 + i * 32 + 4 * hh + 8 * g) = make_float4(acc[i][j][4 * g], acc[i][j][4 * g + 1], acc[i][j][4 * g + 2], acc[i][j][4 * g + 3]);
    __syncthreads();
}
template <bool HIN>
__device__ __forceinline__ void phase_outproj(KP p, char* lds, int l, const void* xin) {
    const half_t* W = p->Wt_o + (size_t)l * DM * DM;
    const float* g1 = p->modf + (size_t)l * 16 * 6144 + 2 * 1024;
    for (int u = BID(); u < 256 * 4; u += gridDim.x) {
        const int xl = u & 7, Lx = u >> 3, mi = Lx & 7, rr_ = Lx >> 3;
        const int nt = rr_ & 3, mt = 32 * xl + 8 * (rr_ >> 2) + mi;
        gemm_tile2(lds, 32, (size_t)T_TOK * 32,
            [&](int kt, int row) { return W + ((size_t)kt * DM + nt * 256 + row) * 32; },
            [&](int row) { return p->ycat + (size_t)(mt * 128 + row) * 32; },
            [&](f16v (&acc)[4][2], int wn, int wm, int lane) {
                const int hh = lane >> 5, tid = TID();
                float* stg = (float*)lds;
#pragma unroll
                for (int rnd = 0; rnd < 2; ++rnd) {
                    __syncthreads();
                    if (wm == rnd) {
#pragma unroll
                        for (int j = 0; j < 2; ++j)
#pragma unroll
                            for (int i = 0; i < 4; ++i)
#pragma unroll
                                for (int g = 0; g < 4; ++g)
                                    *(float4*)(stg + (j * 32 + (lane & 31)) * 260 + wn * 128 + i * 32 + 4 * hh + 8 * g) = make_float4(acc[i][j][4 * g], acc[i][j][4 * g + 1], acc[i][j][4 * g + 2], acc[i][j][4 * g + 3]);
                    }
                    __syncthreads();
#pragma unroll 4
                    for (int it = 0; it < 16; ++it) {
                        const int idx = it * 256 + tid, row = idx >> 6, c = idx & 63;
                        const int tok = mt * 128 + rnd * 64 + row, n = nt * 256 + 4 * c;
                        const float4 a4 = *(const float4*)(stg + row * 260 + 4 * c);
                        const float4 xi = ldx4<HIN>(xin, (size_t)tok * DM + n);
                        const float4 gg = *(const float4*)(g1 + (size_t)(tok >> 11) * 6144 + n);
                        *(h4*)(p->xr + (size_t)tok * DM + n) = pack4(xi.x + gg.x * a4.x, xi.y + gg.y * a4.y, xi.z + gg.z * a4.z, xi.w + gg.w * a4.w);
                    }
                }
            });
    }
}

struct MoeTab { int tb, nt, nc; };
__device__ __forceinline__ MoeTab moe_table(const int* cnt) {
    const int c = TID() & 31;
    MoeTab t;
    t.nc = (c < NCLS) ? cnt[c * 64] : 0;
    t.nt = (t.nc + 127) >> 7;
    int incl = t.nt;
#pragma unroll
    for (int o = 1; o < 32; o <<= 1) { const int v = __shfl_up(incl, o, 32); if (c >= o) incl += v; }
    t.tb = incl - t.nt;
    return t;
}
__device__ __forceinline__ bool moe_tile(const MoeTab& t, int tile, int& cls, int& pos0, int& n) {
    const unsigned long long m = __ballot(tile >= t.tb && tile < t.tb + t.nt);
    if (m == 0ull) return false;
    cls = __ffsll((long long)m) - 1;
    pos0 = (tile - __builtin_amdgcn_readlane(t.tb, cls)) * 128;
    n = __builtin_amdgcn_readlane(t.nc, cls);
    return true;
}
__device__ __forceinline__ void cls_experts(int cls, int& e1, int& e2) {
    const int g = cls / 6, pi = cls % 6;
    const int a = pi < 3 ? 0 : (pi < 5 ? 1 : 2);
    const int b = pi < 3 ? pi + 1 : (pi < 5 ? pi - 1 : 3);
    e1 = g * 4 + a; e2 = g * 4 + b;
}
__device__ __forceinline__ void phase_moe_up(KP p, char* lds, int l) {
    const MoeTab tab = moe_table(p->cnt + l * 32 * 64);
    for (int u = BID(); u < (256 + NCLS) * 8; u += gridDim.x) {
        const int xl = u & 7, Lx = u >> 3;
        const int nt = Lx & 7, tile = (Lx >> 3) * 8 + xl;
        int cls, pos0, nc;
        if (!moe_tile(tab, tile, cls, pos0, nc)) continue;
        int e1, e2; cls_experts(cls, e1, e2);
        const int slot = nt >> 2;
        const half_t* W = p->Wt_gu + ((size_t)(l * 16 + (slot ? e2 : e1)) * 512 + (nt & 3) * 128) * 1024;
        const int* lst = p->lists + (size_t)cls * T_TOK + pos0;
        const int nvalid = nc - pos0;
        gemm_tile(lds, 16,
            [&](int kt, int row) { return W + (size_t)row * 1024 + kt * 64; },
            [&](int row) { const int tok = lst[row < nvalid ? row : 0]; return p->hn + (size_t)tok * DM; },
            [&](f16v (&acc)[2][2], int wn, int wm, int lane) {
                const int hh = lane >> 5;
#pragma unroll
                for (int j = 0; j < 2; ++j) {
                    const int row = wm * 64 + j * 32 + (lane & 31);
                    if (row < nvalid) {
                        const int tok = lst[row];
                        const float wgt = p->tokw[(size_t)tok * 2 + slot];
                        half_t* dst = p->act + (size_t)tok * 512 + slot * 256 + ((nt & 3) * 2 + wn) * 32 + 4 * hh;
#pragma unroll
                        for (int g = 0; g < 4; ++g) {
                            float a[4];
#pragma unroll
                            for (int r = 0; r < 4; ++r) { const float gv = acc[0][j][4 * g + r], uv = acc[1][j][4 * g + r]; a[r] = gv * sigmoidf_(gv) * uv * wgt; }
                            *(h4*)(dst + 8 * g) = pack4(a[0], a[1], a[2], a[3]);
                        }
                    }
                }
            });
    }
}
__device__ __forceinline__ void phase_moe_down(KP p, char* lds, int l, float gsc) {
    const MoeTab tab = moe_table(p->cnt + l * 32 * 64);
    const float* g2 = p->modf + (size_t)l * 16 * 6144 + 5 * 1024;
    for (int u = BID(); u < (256 + NCLS) * 8; u += gridDim.x) {
        const int xl = u & 7, Lx = u >> 3;
        const int nt = Lx & 7, tile = (Lx >> 3) * 8 + xl;
        int cls, pos0, nc;
        if (!moe_tile(tab, tile, cls, pos0, nc)) continue;
        int e1, e2; cls_experts(cls, e1, e2);
        const half_t* W1 = p->Wt_d + ((size_t)(l * 16 + e1) * 1024 + nt * 128) * 256;
        const half_t* W2 = p->Wt_d + ((size_t)(l * 16 + e2) * 1024 + nt * 128) * 256;
        const int* lst = p->lists + (size_t)cls * T_TOK + pos0;
        const int nvalid = nc - pos0;
        gemm_tile(lds, 8,
            [&](int kt, int row) { return (kt < 4 ? W1 : W2) + (size_t)row * 256 + (kt & 3) * 64; },
            [&](int row) { const int tok = lst[row < nvalid ? row : 0]; return p->act + (size_t)tok * 512; },
            [&](f16v (&acc)[2][2], int wn, int wm, int lane) {
                const int hh = lane >> 5;
#pragma unroll
                for (int j = 0; j < 2; ++j) {
                    const int row = wm * 64 + j * 32 + (lane & 31);
                    if (row < nvalid) {
                        const int tok = lst[row];
                        const int b = tok >> 11;
#pragma unroll
                        for (int i = 0; i < 2; ++i) {
                            const int nb = nt * 128 + wn * 64 + i * 32 + 4 * hh;
#pragma unroll
                            for (int g = 0; g < 4; ++g) {
                                const int n = nb + 8 * g;
                                h4* xp = (h4*)(p->xr + (size_t)tok * DM + n);
                                const h4 xi = *xp;
                                const float4 gg = *(const float4*)(g2 + (size_t)b * 6144 + n);
                                *xp = pack4((float)xi[0] + gsc * gg.x * acc[i][j][4 * g], (float)xi[1] + gsc * gg.y * acc[i][j][4 * g + 1],
                                            (float)xi[2] + gsc * gg.z * acc[i][j][4 * g + 2], (float)xi[3] + gsc * gg.w * acc[i][j][4 * g + 3]);
                            }
                        }
                    }
                }
            });
    }
}

__device__ __forceinline__ void dsa_select_unit(KP p, char* lds, int b, int qt) {
    unsigned* hist = (unsigned*)lds;
    unsigned* maskl = hist + 16 * 257 + 16;
    unsigned* stP = maskl + 1024;
    unsigned* stNeed = stP + 16;
    unsigned* stDone = stNeed + 16;
    unsigned* flag = stDone + 16;
    unsigned* dummyb = flag + 16;
    const int tid = TID(), lane = tid & 63, wave = tid >> 6;
    const int q0 = qt * 16, tokbase = b * SEQ;
    __syncthreads();
    if (q0 < 256) {
        for (int i = tid; i < 1024; i += 256) {
            const int q = i >> 6, wd = i & 63;
            const int n = q0 + q + 1 - 32 * wd;
            const unsigned w = n >= 32 ? 0xFFFFFFFFu : (n <= 0 ? 0u : ((1u << n) - 1u));
            p->dmask[(size_t)(tokbase + q0 + q) * 64 + wd] = w;
        }
        return;
    }
    for (int i = tid; i < 1024; i += 256) maskl[i] = 0u;
    if (tid < 16) { stP[tid] = 0u; stNeed[tid] = 256u; stDone[tid] = 0u; }
    for (int i = tid; i < 16 * 257; i += 256) hist[i] = 0u;
    __syncthreads();
    const int ql = lane & 15, fq = lane >> 4;
    const int tq = q0 + ql;
    const half_t* Pb = p->P + (size_t)tokbase * NP;
    h8 iqf[4];
#pragma unroll
    for (int hd = 0; hd < 4; ++hd) iqf[hd] = *(const h8*)(Pb + (size_t)tq * NP + PC_IQ + hd * 32 + 8 * fq);
    const float4 iw4 = *(const float4*)(p->iwf + (size_t)(tokbase + tq) * 4);
    const float wsc0 = iw4.x * 0.08838834764831845f, wsc1 = iw4.y * 0.08838834764831845f, wsc2 = iw4.z * 0.08838834764831845f, wsc3 = iw4.w * 0.08838834764831845f;
    const int ng = qt + 1;
    unsigned sc[32][4];
    const half_t* ikp = Pb + (size_t)ql * NP + PC_IK + 8 * fq;
#pragma unroll
    for (int gb = 0; gb < 4; ++gb) {
        h8 ik[8];
#pragma unroll
        for (int x = 0; x < 8; ++x) {
            int g = wave + 4 * (gb * 8 + x);
            g = g < ng ? g : ng - 1;
            ik[x] = *(const h8*)(ikp + (size_t)(16 * g) * NP);
        }
#pragma unroll
        for (int x = 0; x < 8; ++x) {
            const int gi = gb * 8 + x;
            const int g = wave + 4 * gi;
            const f4v z = {0.f, 0.f, 0.f, 0.f};
            const f4v c0 = __builtin_amdgcn_mfma_f32_16x16x32_f16(ik[x], iqf[0], z, 0, 0, 0);
            const f4v c1 = __builtin_amdgcn_mfma_f32_16x16x32_f16(ik[x], iqf[1], z, 0, 0, 0);
            const f4v c2 = __builtin_amdgcn_mfma_f32_16x16x32_f16(ik[x], iqf[2], z, 0, 0, 0);
            const f4v c3 = __builtin_amdgcn_mfma_f32_16x16x32_f16(ik[x], iqf[3], z, 0, 0, 0);
#pragma unroll
            for (int r = 0; r < 4; ++r) {
                const int j = 16 * g + 4 * fq + r;
                float sv = wsc0 * __builtin_amdgcn_fmed3f(c0[r], 0.f, INFINITY);
                sv = fmaf(wsc1, __builtin_amdgcn_fmed3f(c1[r], 0.f, INFINITY), sv);
                sv = fmaf(wsc2, __builtin_amdgcn_fmed3f(c2[r], 0.f, INFINITY), sv);
                sv = fmaf(wsc3, __builtin_amdgcn_fmed3f(c3[r], 0.f, INFINITY), sv);
                sv += 0.0f;
                const int sb = __float_as_int(sv);
                const unsigned su = (unsigned)sb ^ ((unsigned)(sb >> 31) | 0x80000000u);
                const unsigned ck = (su & 0xFFFFF800u) | (unsigned)(2047 - j);
                sc[gi][r] = (g < ng && j <= tq) ? ck : 0u;
            }
            if (g < ng) {
#pragma unroll
                for (int r = 0; r < 4; ++r) atomicAdd(hist + ql * 257 + (sc[gi][r] >> 24), 1u);
            }
        }
    }
    bool alldone = false;
    for (int pass = 0; pass < 5; ++pass) {
        const bool fin = alldone;
        if (!fin && pass > 0) { for (int i = tid; i < 16 * 257; i += 256) hist[i] = 0u; }
        if (tid == 0) *flag = 0u;
        __syncthreads();
        if (pass > 0) {
        const unsigned sP = stP[ql], sDone = stDone[ql];
        int wv = wave, fqv = fq;
        asm volatile("" : "+v"(wv), "+v"(fqv));
        if (fin) {
            const int sh = (int)(32u - 8u * (sDone ? sDone : 1u));
            unsigned* mrow = maskl + ql * 64;
#pragma unroll
            for (int gi = 0; gi < 32; ++gi) {
                const int g = wv + 4 * gi;
                unsigned nib = 0u;
#pragma unroll
                for (int r = 0; r < 4; ++r) {
                    const unsigned uu = sc[gi][r];
                    nib |= ((uu >> sh) >= sP) ? (1u << r) : 0u;
                }
                if (g < ng) atomicOr(&mrow[g >> 1], nib << ((g & 1) * 16 + 4 * fqv));
            }
        } else {
            const int shm = pass ? 32 - 8 * pass : 0, shd = 24 - 8 * pass;
            const unsigned orm = pass ? 0u : 0xFFFFFFFFu;
            const unsigned cmpv = pass ? (sDone == 0u ? sP : 0xFFFFFFFFu) : 0xFFFFFFFFu;
            unsigned* hrow = hist + ql * 257;
            unsigned* dummy = dummyb + lane;
#pragma unroll
            for (int gi = 0; gi < 32; ++gi) {
                const int g = wv + 4 * gi;
                if (g < ng) {
#pragma unroll
                    for (int r = 0; r < 4; ++r) {
                        const unsigned uu = sc[gi][r];
                        const bool match = (((uu >> shm) | orm) == cmpv);
                        const unsigned dig = (uu >> shd) & 255u;
                        unsigned* a = match ? hrow + dig : dummy;
                        atomicAdd(a, 1u);
                    }
                }
            }
        }
        }
        __syncthreads();
        if (fin) break;
        {
            const int qq = tid >> 4, seg = tid & 15;
            const bool active = (stDone[qq] == 0u);
            unsigned c16 = 0u;
            if (active) {
#pragma unroll
                for (int d = 0; d < 16; ++d) c16 += hist[qq * 257 + seg * 16 + d];
            }
            unsigned v = c16;
#pragma unroll
            for (int off = 1; off < 16; off <<= 1) { const unsigned t = __shfl_down(v, off, 16); if (seg + off < 16) v += t; }
            const unsigned suf = v - c16;
            const unsigned need = stNeed[qq];
            if (active && suf < need && need <= suf + c16) {
                unsigned run = suf, D = 0u, cD = 0u, nn = need;
                for (int d = 15; d >= 0; --d) {
                    const unsigned cc = hist[qq * 257 + seg * 16 + d];
                    if (run + cc >= need) { D = (unsigned)(seg * 16 + d); cD = cc; nn = need - run; break; }
                    run += cc;
                }
                const bool done = (cD == nn) || pass == 3;
                stP[qq] = (stP[qq] << 8) | D; stNeed[qq] = nn;
                if (done) stDone[qq] = (unsigned)(pass + 1); else atomicAdd(flag, 1u);
            }
        }
        __syncthreads();
        alldone = (*flag == 0u);
    }
    for (int i = tid; i < 1024; i += 256) p->dmask[(size_t)(tokbase + q0 + (i >> 6)) * 64 + (i & 63)] = maskl[i];
}

__device__ __forceinline__ void conv_unit(KP p, char* lds, int l, int b, int c) {
    float* red = (float*)lds;
    const int ch = TID(), lane = ch & 63, wave = ch >> 6;
    const int t0 = c * 32, tokbase = b * SEQ;
    float aw[62];
#pragma unroll
    for (int rr = 0; rr < 62; ++rr) {
        int tt = t0 - 30 + rr; const bool ok = tt >= 0; tt = ok ? tt : t0;
        const float v = (float)p->P[(size_t)(tokbase + tt) * NP + ch];
        aw[rr] = ok ? v : 0.f;
    }
    float w[31];
#pragma unroll
    for (int i = 0; i < 31; ++i) w[i] = p->w_dw[(l * 31 + i) * 256 + ch];
    const float bias = p->b_dw[l * 256 + ch];
    float y[32], s1[32], s2[32];
#pragma unroll
    for (int tk = 0; tk < 32; ++tk) {
        float sacc = bias;
#pragma unroll
        for (int i = 0; i < 31; ++i) sacc = fmaf(aw[tk + i], w[i], sacc);
        y[tk] = sacc; s1[tk] = sacc; s2[tk] = sacc * sacc;
    }
    {
        const bool b5 = lane & 32, b4 = lane & 16, b3 = lane & 8, b2 = lane & 4, b1 = lane & 2;
        float a16[16], c16[16], a8[8], c8[8], a4[4], c4[4], a2[2], c2[2];
#pragma unroll
        for (int e = 0; e < 16; ++e) { a16[e] = (b5 ? s1[e + 16] : s1[e]) + __shfl_xor(b5 ? s1[e] : s1[e + 16], 32); c16[e] = (b5 ? s2[e + 16] : s2[e]) + __shfl_xor(b5 ? s2[e] : s2[e + 16], 32); }
#pragma unroll
        for (int e = 0; e < 8; ++e) { a8[e] = (b4 ? a16[e + 8] : a16[e]) + __shfl_xor(b4 ? a16[e] : a16[e + 8], 16); c8[e] = (b4 ? c16[e + 8] : c16[e]) + __shfl_xor(b4 ? c16[e] : c16[e + 8], 16); }
#pragma unroll
        for (int e = 0; e < 4; ++e) { a4[e] = (b3 ? a8[e + 4] : a8[e]) + __shfl_xor(b3 ? a8[e] : a8[e + 4], 8); c4[e] = (b3 ? c8[e + 4] : c8[e]) + __shfl_xor(b3 ? c8[e] : c8[e + 4], 8); }
#pragma unroll
        for (int e = 0; e < 2; ++e) { a2[e] = (b2 ? a4[e + 2] : a4[e]) + __shfl_xor(b2 ? a4[e] : a4[e + 2], 4); c2[e] = (b2 ? c4[e + 2] : c4[e]) + __shfl_xor(b2 ? c4[e] : c4[e + 2], 4); }
        float av = (b1 ? a2[1] : a2[0]) + __shfl_xor(b1 ? a2[0] : a2[1], 2), cv = (b1 ? c2[1] : c2[0]) + __shfl_xor(b1 ? c2[0] : c2[1], 2);
        av += __shfl_xor(av, 1); cv += __shfl_xor(cv, 1);
        const int tokk = (b5 ? 16 : 0) + (b4 ? 8 : 0) + (b3 ? 4 : 0) + (b2 ? 2 : 0) + (b1 ? 1 : 0);
        __syncthreads();
        if ((lane & 1) == 0) { red[(tokk * 4 + wave) * 2] = av; red[(tokk * 4 + wave) * 2 + 1] = cv; }
        __syncthreads();
    }
    const float lg = p->ln_g[l * 256 + ch], lb = p->ln_b[l * 256 + ch];
#pragma unroll
    for (int tk = 0; tk < 32; ++tk) {
        const float4 ra = *(const float4*)(red + tk * 8), rb = *(const float4*)(red + tk * 8 + 4);
        const float t1 = (ra.x + ra.z) + (rb.x + rb.z);
        const float t2 = (ra.y + ra.w) + (rb.y + rb.w);
        const float mu = t1 * (1.0f / 256.0f);
        float var = t2 * (1.0f / 256.0f) - mu * mu; var = var < 0.f ? 0.f : var;
        float z = (y[tk] - mu) * (1.0f / sqrtf(var + 1e-6f)) * lg + lb;
        z = z * sigmoidf_(z);
        p->ycat[((size_t)(ch >> 5) * T_TOK + tokbase + t0 + tk) * 32 + (ch & 31)] = (half_t)z;
    }
}

__device__ __forceinline__ void kmean_unit(KP p, char* lds, int b, int h, int blk) {
    float* part = (float*)lds;
    const int tid = TID(), d = tid & 63, pt = tid >> 6;
    const half_t* r = p->P + (size_t)(b * SEQ + blk * 256 + pt * 64) * NP + PC_MK + h * 64 + d;
    float s = 0.f;
#pragma unroll 16
    for (int k = 0; k < 64; ++k) s += (float)r[(size_t)k * NP];
    __syncthreads();
    part[pt * 64 + d] = s;
    __syncthreads();
    if (tid < 64) p->kmean[(((size_t)b * 6 + h) * 8 + blk) * 64 + tid] = ((part[tid] + part[64 + tid]) + (part[128 + tid] + part[192 + tid])) * (1.0f / 256.0f);
}

#ifndef POST_MASK
#define POST_MASK 7
#endif
__device__ __forceinline__ void phase_post(KP p, char* lds, int l, int tm) {
    const int NA = 2048, NB = 1024, NC = 768;
    const int G_ = gridDim.x;
    for (int u0 = BID(), k_ = 0; u0 < NA + NB + NC; u0 += G_, ++k_) {
        int u = u0;
        if (u0 < NA && (k_ & 1) && (k_ + 1) * G_ <= NA) u = k_ * G_ + (G_ - 1 - (u0 - k_ * G_));
        if (u < NA) { if (tm & 1) dsa_select_unit(p, lds, u % 16, 127 - (u / 16)); }
        else if (u < NA + NB) { const int v = u - NA; if (tm & 2) conv_unit(p, lds, l, v % 16, v / 16); }
        else { const int v = u - NA - NB; if (tm & 4) kmean_unit(p, lds, v / 48, (v / 8) % 6, v % 8); }
    }
}

template <int MODE>
__device__ __forceinline__ void attn_unit(KP p, char* lds, int b, int h, int qt) {
    const int tid = TID(), lane = tid & 63, wave = tid >> 6, hh = lane >> 5, ql = lane & 31;
    const int q0 = qt * 128, tokbase = b * SEQ;
    const int tq = q0 + wave * 32 + ql;
    const half_t* Pb = p->P + (size_t)tokbase * NP;
    const int QOFF = MODE ? PC_MQ + h * 64 : PC_DQ + h * 64;
    const int KOFF = MODE ? PC_MK + h * 64 : PC_DK;
    const int VOFF = MODE ? PC_MV + h * 64 : PC_DV;
    const int own = qt >> 1;
    unsigned mysel = 0u, anysel = 0u;
    __syncthreads();
    if (MODE == 1) {
        float* km = (float*)(lds + 32768);
        float* gts = km + 512;
        unsigned* selq = (unsigned*)(gts + 1024);
        unsigned* anyb = selq + 128;
        for (int i = tid; i < 512; i += 256) km[i] = p->kmean[((size_t)b * 6 + h) * 512 + i];
        if (tid == 0) *anyb = 0u;
        __syncthreads();
        {
            const int q = tid & 127, hf = tid >> 7;
            if (hf * 4 < own) {
                const half_t* qr = Pb + (size_t)(q0 + q) * NP + QOFF;
                float g0 = 0.f, g1 = 0.f, g2 = 0.f, g3 = 0.f;
#pragma unroll
                for (int c8 = 0; c8 < 8; ++c8) {
                    const h8 qv = *(const h8*)(qr + c8 * 8);
#pragma unroll
                    for (int j4 = 0; j4 < 2; ++j4) {
                        const int d = c8 * 8 + j4 * 4;
                        const float q0f = (float)qv[j4 * 4], q1f = (float)qv[j4 * 4 + 1], q2f = (float)qv[j4 * 4 + 2], q3f = (float)qv[j4 * 4 + 3];
                        const float4 k0 = *(const float4*)(km + (hf * 4 + 0) * 64 + d), k1 = *(const float4*)(km + (hf * 4 + 1) * 64 + d);
                        const float4 k2 = *(const float4*)(km + (hf * 4 + 2) * 64 + d), k3 = *(const float4*)(km + (hf * 4 + 3) * 64 + d);
                        g0 = fmaf(q0f, k0.x, g0); g0 = fmaf(q1f, k0.y, g0); g0 = fmaf(q2f, k0.z, g0); g0 = fmaf(q3f, k0.w, g0);
                        g1 = fmaf(q0f, k1.x, g1); g1 = fmaf(q1f, k1.y, g1); g1 = fmaf(q2f, k1.z, g1); g1 = fmaf(q3f, k1.w, g1);
                        g2 = fmaf(q0f, k2.x, g2); g2 = fmaf(q1f, k2.y, g2); g2 = fmaf(q2f, k2.z, g2); g2 = fmaf(q3f, k2.w, g2);
                        g3 = fmaf(q0f, k3.x, g3); g3 = fmaf(q1f, k3.y, g3); g3 = fmaf(q2f, k3.z, g3); g3 = fmaf(q3f, k3.w, g3);
                    }
                }
                gts[q * 8 + hf * 4 + 0] = g0; gts[q * 8 + hf * 4 + 1] = g1; gts[q * 8 + hf * 4 + 2] = g2; gts[q * 8 + hf * 4 + 3] = g3;
            }
        }
        __syncthreads();
        if (tid < 128) {
            unsigned m = 0u;
            const int want = own < 3 ? own : 3;
            for (int r = 0; r < want; ++r) {
                int best = -1; float bv = -INFINITY;
                for (int j = 0; j < own; ++j) { const float gv = gts[tid * 8 + j]; if (!((m >> j) & 1u) && (best < 0 || gv > bv)) { best = j; bv = gv; } }
                m |= 1u << best;
            }
            selq[tid] = m;
            if (m) atomicOr(anyb, m);
        }
        __syncthreads();
        mysel = selq[wave * 32 + ql];
        anysel = *anyb;
        __syncthreads();
    }
    h8 qf[4];
#pragma unroll
    for (int ks = 0; ks < 4; ++ks) qf[ks] = *(const h8*)(Pb + (size_t)tq * NP + QOFF + 16 * ks + 8 * hh);
    f16v O0, O1;
#pragma unroll
    for (int r = 0; r < 16; ++r) { O0[r] = 0.f; O1[r] = 0.f; }
    float l_run = 0.f;
    bool unset = true;
    f16v negm;
#pragma unroll
    for (int r = 0; r < 16; ++r) negm[r] = 0.f;
    const float THR = 8.0f;
    const int ntile = 2 * qt + 2;
    auto skip = [&](int kt) -> bool { return MODE == 1 && kt < 4 * own && !((anysel >> (kt >> 2)) & 1u); };
    auto nexttile = [&](int kt) -> int { ++kt; while (kt < ntile && skip(kt)) ++kt; return kt; };
    const int lrow = tid >> 3;
    const int kchunk = (tid & 7) ^ ((tid >> 4) & 7);
    const int vchunk = (tid & 7) ^ (((tid >> 4) & 1) << 2);
    char* ldst = lds + lrow * 128 + (tid & 7) * 16;
    auto issue = [&](int kt, int s) {
        const half_t* src = Pb + (size_t)(kt * 64 + lrow) * NP;
        char* d = ldst + s * 16384;
        glds16(src + KOFF + kchunk * 8, d);
        glds16(src + (size_t)32 * NP + KOFF + kchunk * 8, d + 4096);
        glds16(src + VOFF + vchunk * 8, d + 8192);
        glds16(src + (size_t)32 * NP + VOFF + vchunk * 8, d + 8192 + 4096);
    };
    const int rsw = (lane >> 1) & 7;
    const int kro = ql * 128;
    const int li = lane & 15, qp = li >> 2, pp = li & 3, swv = (qp >> 1) & 1;
    const int vb0 = 8192 + (4 * hh + qp) * 128 + 32 * ((lane >> 4) & 1) + 8 * pp + 64 * (0 ^ swv);
    const int vb1 = 8192 + (4 * hh + qp) * 128 + 32 * ((lane >> 4) & 1) + 8 * pp + 64 * (1 ^ swv);
    int kt = -1; kt = nexttile(kt);
    int s = 0;
    if (kt < ntile) issue(kt, 0);
    while (kt < ntile) {
        const int ktn = nexttile(kt);
        asm volatile("s_waitcnt vmcnt(0)" ::: "memory");
        __syncthreads();
        if (ktn < ntile) issue(ktn, s ^ 1);
        const bool wave_active = (kt * 64 <= q0 + wave * 32 + 31);
        if (wave_active) {
            const char* base = lds + s * 16384;
            uint2 mw = make_uint2(0u, 0u);
            if (MODE == 0) mw = *(const uint2*)(p->dmask + (size_t)(tokbase + tq) * 64 + 2 * kt);
            h8 vf0[4], vf1[4];
#pragma unroll
            for (int kk = 0; kk < 4; ++kk) {
                const int roff = (32 * (kk >> 1) + 16 * (kk & 1)) * 128;
                const s4v lo0 = __builtin_amdgcn_ds_read_tr16_b64_v4i16((LAS s4v*)(base + vb0 + roff));
                const s4v hi0 = __builtin_amdgcn_ds_read_tr16_b64_v4i16((LAS s4v*)(base + vb0 + roff + 8 * 128));
                const s4v lo1 = __builtin_amdgcn_ds_read_tr16_b64_v4i16((LAS s4v*)(base + vb1 + roff));
                const s4v hi1 = __builtin_amdgcn_ds_read_tr16_b64_v4i16((LAS s4v*)(base + vb1 + roff + 8 * 128));
                vf0[kk] = __builtin_bit_cast(h8, __builtin_shufflevector(lo0, hi0, 0, 1, 2, 3, 4, 5, 6, 7));
                vf1[kk] = __builtin_bit_cast(h8, __builtin_shufflevector(lo1, hi1, 0, 1, 2, 3, 4, 5, 6, 7));
            }
            bool lane_on = true;
            if (MODE == 1 && kt < 4 * own) lane_on = (mysel >> (kt >> 2)) & 1u;
            f16v cin = negm;
            if (MODE == 1 && kt < 4 * own) {
#pragma unroll
                for (int r = 0; r < 16; ++r) cin[r] = lane_on ? negm[r] : -INFINITY;
            }
            f16v s0 = cin, s1 = cin;
#pragma unroll
            for (int ks = 0; ks < 4; ++ks) {
                const int co = ((2 * ks + hh) ^ rsw) << 4;
                const h8 k0 = *(const h8*)(base + kro + co), k1 = *(const h8*)(base + kro + 4096 + co);
                s0 = __builtin_amdgcn_mfma_f32_32x32x16_f16(k0, qf[ks], s0, 0, 0, 0);
                s1 = __builtin_amdgcn_mfma_f32_32x32x16_f16(k1, qf[ks], s1, 0, 0, 0);
            }
            if (MODE == 0) {
                const unsigned w0 = mw.x >> (4 * hh), w1 = mw.y >> (4 * hh);
#pragma unroll
                for (int r = 0; r < 16; ++r) {
                    const int pos = (r & 3) + 8 * (r >> 2);
                    const unsigned m0 = (unsigned)__builtin_amdgcn_sbfe((int)w0, pos, 1), m1 = (unsigned)__builtin_amdgcn_sbfe((int)w1, pos, 1);
                    s0[r] = __uint_as_float((__float_as_uint(s0[r]) & m0) | (0xFF800000u & ~m0));
                    s1[r] = __uint_as_float((__float_as_uint(s1[r]) & m1) | (0xFF800000u & ~m1));
                }
            } else if (kt >= 4 * own && kt * 64 + 63 > q0 + wave * 32) {
#pragma unroll
                for (int r = 0; r < 16; ++r) {
                    const int key = kt * 64 + (r & 3) + 8 * (r >> 2) + 4 * hh;
                    s0[r] = (key <= tq) ? s0[r] : -INFINITY;
                    s1[r] = (key + 32 <= tq) ? s1[r] : -INFINITY;
                }
            }
            float mx = s0[0];
#pragma unroll
            for (int r = 1; r < 16; ++r) mx = fmaxf(mx, s0[r]);
#pragma unroll
            for (int r = 0; r < 16; ++r) mx = fmaxf(mx, s1[r]);
            mx = fmaxf(mx, __shfl_xor(mx, 32));
            const bool need = unset ? (mx > -INFINITY) : (mx > THR);
            if (__any(need)) {
                const float delta = need ? mx : 0.f;
                const float alpha = (need && !unset) ? __builtin_amdgcn_exp2f(-delta) : 1.0f;
#pragma unroll
                for (int r = 0; r < 16; ++r) { s0[r] -= delta; s1[r] -= delta; negm[r] -= delta; O0[r] *= alpha; O1[r] *= alpha; }
                l_run *= alpha;
                unset = unset && !need;
            }
            float ls = 0.f;
#pragma unroll
            for (int r = 0; r < 16; ++r) { s0[r] = __builtin_amdgcn_exp2f(s0[r]); ls += s0[r]; }
#pragma unroll
            for (int r = 0; r < 16; ++r) { s1[r] = __builtin_amdgcn_exp2f(s1[r]); ls += s1[r]; }
            l_run += ls;
#pragma unroll
            for (int kk = 0; kk < 4; ++kk) {
                h8 pf;
#pragma unroll
                for (int j = 0; j < 8; ++j) pf[j] = (half_t)((kk >> 1) ? s1[8 * (kk & 1) + j] : s0[8 * (kk & 1) + j]);
                O0 = __builtin_amdgcn_mfma_f32_32x32x16_f16(vf0[kk], pf, O0, 0, 0, 0);
                O1 = __builtin_amdgcn_mfma_f32_32x32x16_f16(vf1[kk], pf, O1, 0, 0, 0);
            }
        }
        kt = ktn; s ^= 1;
    }
    const float lt = l_run + __shfl_xor(l_run, 32);
    const float inv = 1.0f / lt;
    const int ycol = (MODE ? 640 : 256) + h * 64;
    half_t* dst = p->ycat + ((size_t)(ycol >> 5) * T_TOK + tokbase + tq) * 32 + 4 * hh;
#pragma unroll
    for (int g = 0; g < 4; ++g) {
        *(h4*)(dst + 8 * g) = pack4(O0[4 * g] * inv, O0[4 * g + 1] * inv, O0[4 * g + 2] * inv, O0[4 * g + 3] * inv);
        *(h4*)(dst + (size_t)T_TOK * 32 + 8 * g) = pack4(O1[4 * g] * inv, O1[4 * g + 1] * inv, O1[4 * g + 2] * inv, O1[4 * g + 3] * inv);
    }
}

#ifndef ATT_MASK
#define ATT_MASK 3
#endif
__device__ __forceinline__ void phase_attn(KP p, char* lds, int tm) {
    const int G_ = gridDim.x, per_ = G_ >> 3;
    const bool snake_ = (G_ >= 8) && ((G_ & 7) == 0);
    for (int k_ = 0, b_ = BID(); snake_ ? (k_ * per_ < 384) : (b_ + k_ * G_ < 3072); ++k_) {
        int xl, Lx;
        if (snake_) { const int idx_ = b_ >> 3; xl = b_ & 7; Lx = k_ * per_ + ((k_ & 1) ? (per_ - 1 - idx_) : idx_); }
        else { const int u = b_ + k_ * G_; xl = u & 7; Lx = u >> 3; }
        if (Lx >= 384) continue;
        const int qt = 15 - (Lx / 24), rem = Lx % 24;
        const int type = rem & 1, bh = xl * 12 + (rem >> 1);
        if (type == 0) { if (tm & 1) attn_unit<0>(p, lds, bh / 6, bh % 6, qt); }
        else { if (tm & 2) attn_unit<1>(p, lds, bh / 6, bh % 6, qt); }
    }
}

__global__ void __launch_bounds__(256, 2) mk_fwd(Params p_unused) {
    extern __shared__ __attribute__((aligned(16))) char lds[];
    volatile LAS unsigned* stw = (volatile LAS unsigned*)(lds + LDS_CTL);
    if (threadIdx.x < 4) stw[threadIdx.x] = 0u;
    __syncthreads();
    KP p0 = (KP)__builtin_amdgcn_kernarg_segment_ptr();
    XcdBarrier bar; bar.bar = p0->bar; bar.x = 0; bar.st = stw;
#if !MK_SPLIT
    bar = xcd_barrier_post(p0->bar, stw);
#endif
    const int ph_lo = p0->ph_lo, ph_hi = p0->ph_hi;
    for (int ph = ph_lo; ph < ph_hi; ++ph) {
      KP p = p0; asm volatile("" : "+s"(p));
      const int nrep = (DUP_SUB >= 0 && ((DUP_SUB == 100 && ph == 0) || (ph >= 2 && ph < NPHASE - 1 && ((ph - 2) & 7) == DUP_SUB && (DUP_SUB != 4 || ph < 10)))) ? 2 : 1;
      for (int rep = 0; rep < nrep; ++rep) {
        if (ph == 0) phase_prologue(p, lds);
        else if (ph == 1) phase_modsum(p);
        else if (ph == NPHASE - 1) phase_norm<2, true>(p, lds, p->xr, p->g_final, nullptr, nullptr, 0);
        else {
            const int l = (ph - 2) >> 3, sub = (ph - 2) & 7;
            const float* mf = p->modf + (size_t)l * 16 * 6144;
            if (sub == 0) { if (l == 0) phase_norm<0, false>(p, lds, p->x, p->g_mix + l * DM, mf, mf + 1024, l); else phase_norm<0, true>(p, lds, p->xr, p->g_mix + l * DM, mf, mf + 1024, l); }
            else if (sub == 1) phase_inproj(p, lds, l);
            else if (sub == 2) phase_post(p, lds, l, rep ? POST_MASK : 7);
            else if (sub == 3) phase_attn(p, lds, rep ? ATT_MASK : 3);
            else if (sub == 4) { if (l == 0) phase_outproj<false>(p, lds, l, p->x); else phase_outproj<true>(p, lds, l, p->xr); }
            else if (sub == 5) phase_norm_router(p, lds, p->xr, p->g_ffn + l * DM, mf + 3 * 1024, mf + 4 * 1024, (nrep == 2 && rep == 0) ? l + 2 : l);
            else if (sub == 6) phase_moe_up(p, lds, l);
            else phase_moe_down(p, lds, l, nrep == 2 ? 0.5f : 1.0f);
        }
      }
#if !MK_SPLIT
        if (ph + 1 < ph_hi) xcd_barrier(bar);
#endif
    }
}

extern "C" void kernel_launch(void* const* d_in, const int* in_sizes, int n_in, void* d_out, int out_size, void* d_ws, size_t ws_size, hipStream_t stream) {
    static int grid = 0;
    if (grid == 0) {
        int dev = 0, cus = 0, per_cu = 0;
        (void)hipGetDevice(&dev);
        (void)hipDeviceGetAttribute(&cus, hipDeviceAttributeMultiprocessorCount, dev);
        (void)hipFuncSetAttribute((const void*)mk_fwd, hipFuncAttributeMaxDynamicSharedMemorySize, LDS_BYTES);
        if (hipOccupancyMaxActiveBlocksPerMultiprocessor(&per_cu, (const void*)mk_fwd, 256, LDS_BYTES) != hipSuccess || per_cu < 1) per_cu = 1;
        (void)hipGetLastError();
        if (per_cu > 2) per_cu = 2;
        grid = cus * per_cu;
        fprintf(stderr, "mk_fwd: cus %d per_cu %d grid %d\n", cus, per_cu, grid);
    }
    Params p{};
    const float** pin = (const float**)&p.x;
    for (int i = 0; i < 18; ++i) pin[i] = (const float*)d_in[i];
    p.out = (float*)d_out;
    char* ws = (char*)d_ws;
    size_t off = 0;
    auto carve = [&](size_t bytes) { void* q = ws + off; off += (bytes + 255) & ~(size_t)255; return q; };
    p.bar = (unsigned*)carve(XCD_BAR_WORDS * 4);
    p.cnt = (int*)carve(4 * 32 * 64 * 4);
    const size_t zero_bytes = off;
    p.Wt_in = (half_t*)carve((size_t)2 * NP * DM * 2);
    p.Wt_o = (half_t*)carve((size_t)2 * DM * DM * 2);
    p.Wt_gu = (half_t*)carve((size_t)2 * 16 * 512 * 1024 * 2);
    p.Wt_d = (half_t*)carve((size_t)2 * 16 * 1024 * 256 * 2);
    p.hn = (half_t*)carve((size_t)T_TOK * DM * 2);
    p.P = (half_t*)carve((size_t)T_TOK * NP * 2);
    p.ycat = (half_t*)carve((size_t)T_TOK * DM * 2);
    p.act = (half_t*)carve((size_t)T_TOK * 512 * 2);
    p.xr = (half_t*)carve((size_t)T_TOK * DM * 2);
    p.modpart = (float*)carve((size_t)8 * 2 * 16 * 6144 * 4);
    p.modf = (float*)carve((size_t)2 * 16 * 6144 * 4);
    p.kmean = (float*)carve((size_t)16 * 6 * 8 * 64 * 4);
    p.rope = (float*)carve((size_t)2048 * 24 * 4);
    p.iwf = (float*)carve((size_t)T_TOK * 4 * 4);
    p.tokw = (float*)carve((size_t)T_TOK * 2 * 4);
    p.dmask = (unsigned*)carve((size_t)T_TOK * 64 * 4);
    p.lists = (int*)carve((size_t)NCLS * T_TOK * 4);
    if (off > ws_size) { fprintf(stderr, "workspace too small: need %zu have %zu\n", off, ws_size); return; }
    (void)hipMemsetAsync(d_ws, 0, zero_bytes, stream);
#if MK_SPLIT
    for (int ph = 0; ph < NPHASE; ++ph) {
        p.ph_lo = ph; p.ph_hi = ph + 1;
        hipLaunchKernelGGL(mk_fwd, dim3(grid), dim3(256), LDS_BYTES, stream, p);
    }
#else
    p.ph_lo = 0; p.ph_hi = NPHASE;
    hipLaunchKernelGGL(mk_fwd, dim3(grid), dim3(256), LDS_BYTES, stream, p);
#endif
}
```

```cpp
#include <hip/hip_runtime.h>
#include <cstdio>
#include <cstdint>

#ifndef MK_SPLIT
#define MK_SPLIT 0
#endif

#define T_TOK 32768
#define DM 1024
#define SEQ 2048
#define INW 2340
#define NP 2432
#define PC_CU 0
#define PC_CG 256
#define PC_DQ 512
#define PC_DK 896
#define PC_DV 960
#define PC_IQ 1024
#define PC_IK 1152
#define PC_IW 1184
#define PC_MQ 1280
#define PC_MK 1664
#define PC_MV 2048
#define LOG_THETA 13.122363377404328f
#define NCLS 24
#define LDS_CTL 73728
#define LDS_BYTES 78336
#define NPHASE 19
#ifndef DUP_SUB
#define DUP_SUB -1
#endif

typedef _Float16 half_t;
typedef _Float16 h8 __attribute__((ext_vector_type(8)));
typedef _Float16 h4 __attribute__((ext_vector_type(4)));
typedef short s4v __attribute__((ext_vector_type(4)));
typedef short s8v __attribute__((ext_vector_type(8)));
typedef float f16v __attribute__((ext_vector_type(16)));
typedef float f4v __attribute__((ext_vector_type(4)));
#define LAS __attribute__((address_space(3)))

struct Params {
    const float *x, *c, *w_ada, *b_ada, *g_mix, *w_in, *w_dw, *b_dw, *ln_g, *ln_b, *w_o, *g_ffn, *w_router, *b_router, *w_gate, *w_up, *w_down, *g_final;
    float* out;
    half_t *Wt_in, *Wt_o, *Wt_gu, *Wt_d, *hn, *P, *ycat, *act, *xr;
    float *modpart, *modf, *kmean, *rope, *iwf, *tokw;
    unsigned* dmask; int* cnt; int* lists; unsigned* bar;
    int ph_lo, ph_hi;
};

#define XB_TMO      128
#define XB_XCNT(j)  (256  + 64 * (j))
#define XB_XSUB(j)  (1280 + 64 * (j))
#define XB_XGEN(j)  (2304 + 64 * (j))
#define XB_TOP      3328
#define XB_TOPGEN   3392
#define XCD_BAR_WORDS 3456
#define XB_SPIN_CAP (1u << 20)
__device__ __forceinline__ unsigned xb_ld(unsigned* p)              { return __hip_atomic_load(p, __ATOMIC_RELAXED, __HIP_MEMORY_SCOPE_AGENT); }
__device__ __forceinline__ unsigned xb_add(unsigned* p, unsigned v) { return __hip_atomic_fetch_add(p, v, __ATOMIC_RELAXED, __HIP_MEMORY_SCOPE_AGENT); }
__device__ __forceinline__ unsigned xb_xcc_id() { return (unsigned)__builtin_amdgcn_s_getreg((3 << 11) | 20) & 0xFu; }
#define XB_SPIN(cond, bar) do { unsigned _sp = 0; while (cond) { __builtin_amdgcn_s_sleep(1); \
    if ((++_sp & 255u) == 0u) { if (xb_ld(&(bar)[XB_TMO])) break; if (_sp > XB_SPIN_CAP) { atomicAdd(&(bar)[XB_TMO], 1u); break; } } } } while (0)
struct XcdBarrier { unsigned* bar; unsigned x; volatile LAS unsigned* st; };
__device__ __forceinline__ XcdBarrier xcd_barrier_post(unsigned* bar, volatile LAS unsigned* st) {
    XcdBarrier b; b.bar = bar; b.x = xb_xcc_id(); b.st = st;
    if (threadIdx.x == 0) (void)xb_add(&bar[XB_XCNT(b.x)], 1u);
    return b;
}
__device__ __forceinline__ void xcd_barrier_complete(unsigned* bar, unsigned x, unsigned& nloc, unsigned& nx) {
    const unsigned G = gridDim.x * gridDim.y * gridDim.z;
    unsigned sum, cnt, mine, sp = 0u;
    for (;;) {
        sum = 0u; cnt = 0u; mine = 0u;
#pragma unroll
        for (unsigned j = 0; j < 16; ++j) { const unsigned c = xb_ld(&bar[XB_XCNT(j)]); sum += c; cnt += (c > 0u) ? 1u : 0u; mine = (j == x) ? c : mine; }
        if (sum == G) break;
        __builtin_amdgcn_s_sleep(1);
        if ((++sp & 255u) == 0u) { if (xb_ld(&bar[XB_TMO])) break; if (sp > XB_SPIN_CAP) { atomicAdd(&bar[XB_TMO], 1u); break; } }
    }
    nloc = mine > 0u ? mine : 1u; nx = cnt > 0u ? cnt : 1u;
}
__device__ __forceinline__ void xcd_barrier(const XcdBarrier& b) {
    asm volatile("s_waitcnt vmcnt(0)" ::: "memory");
    __syncthreads();
    if (threadIdx.x == 0) {
        unsigned* bar = b.bar;
        __builtin_amdgcn_s_waitcnt(0);
        unsigned nloc = b.st[0], nx = b.st[1];
        if (nloc == 0u) { xcd_barrier_complete(bar, b.x, nloc, nx); b.st[0] = nloc; b.st[1] = nx; }
        const unsigned old = xb_add(&bar[XB_XSUB(b.x)], 1u);
        const unsigned gen = old / nloc;
        if (old + 1u == (gen + 1u) * nloc) {
            __builtin_amdgcn_fence(__ATOMIC_RELEASE, "agent");
            asm volatile("s_waitcnt vmcnt(0)" ::: "memory");
            const unsigned og = xb_add(&bar[XB_TOP], 1u);
            const unsigned tg = og / nx;
            if (og + 1u == (tg + 1u) * nx) xb_add(&bar[XB_TOPGEN], 1u);
            else XB_SPIN(xb_ld(&bar[XB_TOPGEN]) == tg, bar);
            __builtin_amdgcn_fence(__ATOMIC_ACQUIRE, "agent");
            xb_add(&bar[XB_XGEN(b.x)], 1u);
            asm volatile("s_waitcnt vmcnt(0)" ::: "memory");
        } else {
            XB_SPIN(xb_ld(&bar[XB_XGEN(b.x)]) == gen, bar);
            __builtin_amdgcn_fence(__ATOMIC_ACQUIRE, "agent");
            asm volatile("s_waitcnt vmcnt(0)" ::: "memory");
        }
    }
    __syncthreads();
}

typedef const __attribute__((address_space(4))) Params* KP;
__device__ __forceinline__ int TID() { int t = threadIdx.x; asm volatile("" : "+v"(t)); return t; }
__device__ __forceinline__ int BID() { int b = blockIdx.x; asm volatile("" : "+s"(b)); return b; }
__device__ __forceinline__ float sigmoidf_(float v) { return __builtin_amdgcn_rcpf(1.0f + __expf(-v)); }
__device__ __forceinline__ void glds16(const void* g, char* l) { __builtin_amdgcn_global_load_lds((const unsigned*)g, (unsigned*)l, 16, 0, 0); }
__device__ __forceinline__ unsigned f2sortable(float f) { unsigned u = __float_as_uint(f); return (u & 0x80000000u) ? ~u : (u | 0x80000000u); }
template <bool HIN> __device__ __forceinline__ float4 ldx4(const void* base, size_t idx) {
    if (HIN) { const h4 t = *(const h4*)((const half_t*)base + idx); return make_float4((float)t[0], (float)t[1], (float)t[2], (float)t[3]); }
    return *(const float4*)((const float*)base + idx);
}
__device__ __forceinline__ h4 pack4(float a, float b, float c, float d) { h4 r = {(half_t)a, (half_t)b, (half_t)c, (half_t)d}; return r; }

template <class CF>
__device__ __forceinline__ void conv_tile_panel(char* lds, CF colf, int src_ld, int k0, int n0, half_t* dst, int nrows) {
    float* tl = (float*)lds;
    const int tid = TID();
    __syncthreads();
    {
        const int nn = tid & 63;
        const float* cp = colf(nn);
        float tv[16];
#pragma unroll
        for (int i = 0; i < 16; ++i) { const int k = i * 4 + (tid >> 6); tv[i] = cp ? cp[(size_t)(k0 + k) * src_ld] : 0.f; }
#pragma unroll
        for (int i = 0; i < 16; ++i) { const int k = i * 4 + (tid >> 6); tl[k * 65 + nn] = tv[i]; }
    }
    __syncthreads();
    {
        const int n = tid >> 2, kq = (tid & 3) * 16;
        h8 a, b;
#pragma unroll
        for (int j = 0; j < 8; ++j) { a[j] = (half_t)tl[(kq + j) * 65 + n]; b[j] = (half_t)tl[(kq + 8 + j) * 65 + n]; }
        const int k = k0 + kq;
        h8* d = (h8*)(dst + ((size_t)(k >> 5) * nrows + n0 + n) * 32 + (k & 31));
        d[0] = a; d[1] = b;
    }
}
template <class CF>
__device__ __forceinline__ void conv_tile(char* lds, CF colf, int src_ld, int k0, half_t* dst_tile  , int dstK) {
    float* tl = (float*)lds;
    const int tid = TID();
    __syncthreads();
    {
        const int nn = tid & 63;
        const float* cp = colf(nn);
        float tv[16];
#pragma unroll
        for (int i = 0; i < 16; ++i) { const int k = i * 4 + (tid >> 6); tv[i] = cp ? cp[(size_t)(k0 + k) * src_ld] : 0.f; }
#pragma unroll
        for (int i = 0; i < 16; ++i) { const int k = i * 4 + (tid >> 6); tl[k * 65 + nn] = tv[i]; }
    }
    __syncthreads();
    {
        const int n = tid >> 2, kq = (tid & 3) * 16;
        h8 a, b;
#pragma unroll
        for (int j = 0; j < 8; ++j) { a[j] = (half_t)tl[(kq + j) * 65 + n]; b[j] = (half_t)tl[(kq + 8 + j) * 65 + n]; }
        h8* d = (h8*)(dst_tile + (size_t)n * dstK + kq);
        d[0] = a; d[1] = b;
    }
}

__device__ __forceinline__ void phase_prologue(KP p, char* lds) {
    const int tid = TID();
    const int NA = 2 * 16 * 38, NB = 2 * 16 * 16, NC = 2 * 16 * 16 * 8, ND = 2 * 16 * 4 * 16, NE = 384, NF = 8;
    const int total = NA + NB + NC + ND + NE + NF;
    for (int u0 = BID(); u0 < total; u0 += gridDim.x) {
        int u = u0;
        if (u < NA) {
            const int nt = u % 38, kt = (u / 38) % 16, l = u / (38 * 16);
            const float* src = p->w_in + (size_t)l * DM * INW;
            const int n0 = nt * 64;
            conv_tile_panel(lds, [&](int nn) -> const float* { const int np = n0 + nn; const int sc = np < 512 ? (((np & 63) < 32) ? 32 * (np >> 6) + (np & 31) : 256 + 32 * (np >> 6) + (np & 31)) : (np < 1188 ? np : (np < 1280 ? -1 : np - 92)); return sc >= 0 ? src + sc : (const float*)nullptr; },
                      INW, kt * 64, n0, p->Wt_in + (size_t)l * NP * DM, NP);
            continue;
        }
        u -= NA;
        if (u < NB) {
            const int nt = u % 16, kt = (u / 16) % 16, l = u / 256;
            const float* src = p->w_o + (size_t)l * DM * DM + nt * 64;
            conv_tile_panel(lds, [&](int nn) -> const float* { return src + nn; }, DM, kt * 64, nt * 64, p->Wt_o + (size_t)l * DM * DM, DM);
            continue;
        }
        u -= NB;
        if (u < NC) {
            const int nt = u % 8, kt = (u / 8) % 16, le = u / 128;
            const float* sg = p->w_gate + (size_t)le * 1024 * 256 + nt * 32;
            const float* su = p->w_up + (size_t)le * 1024 * 256 + nt * 32;
            conv_tile(lds, [&](int nn) -> const float* { return nn < 32 ? sg + nn : su + (nn - 32); }, 256, kt * 64, p->Wt_gu + ((size_t)le * 512 + nt * 64) * 1024 + kt * 64, 1024);
            continue;
        }
        u -= NC;
        if (u < ND) {
            const int nt = u % 16, kt = (u / 16) % 4, le = u / 64;
            const float* src = p->w_down + (size_t)le * 256 * 1024 + nt * 64;
            conv_tile(lds, [&](int nn) -> const float* { return src + nn; }, 1024, kt * 64, p->Wt_d + ((size_t)le * 1024 + nt * 64) * 256 + kt * 64, 256);
            continue;
        }
        u -= ND;
        if (u < NE) {
            const int kc = u % 8, cc = (u / 8) % 24, l = u / 192;
            float* ca = (float*)lds;
            __syncthreads();
            for (int i = tid; i < 2048; i += 256) { const int b = i >> 7, k = i & 127; const float v = p->c[b * 1024 + kc * 128 + k]; ca[i] = v / (1.0f + expf(-v)); }
            __syncthreads();
            const int n = cc * 256 + tid;
            float acc[16];
#pragma unroll
            for (int b = 0; b < 16; ++b) acc[b] = 0.f;
            const float* w = p->w_ada + ((size_t)l * 1024 + kc * 128) * 6144 + n;
#pragma unroll 16
            for (int k = 0; k < 128; ++k) {
                const float wv = w[(size_t)k * 6144];
#pragma unroll
                for (int b = 0; b < 16; ++b) acc[b] = fmaf(ca[b * 128 + k], wv, acc[b]);
            }
#pragma unroll
            for (int b = 0; b < 16; ++b) p->modpart[(((size_t)kc * 2 + l) * 16 + b) * 6144 + n] = acc[b];
            continue;
        }
        u -= NE;
        {
            for (int i = u * 256 + tid; i < 2048 * 12; i += NF * 256) {
                const int t = i / 12, r = i % 12;
                const int fi = r < 8 ? r : r - 8;
                const float rot = r < 8 ? 16.f : 8.f;
                const float inv = expf(-LOG_THETA * ((float)fi * 2.0f / rot));
                const float ang = (float)t * inv;
                float sn, cs; sincosf(ang, &sn, &cs);
                if (r < 8) { p->rope[t * 8 + fi] = cs; p->rope[16384 + t * 8 + fi] = sn; }
                else { p->rope[32768 + t * 4 + fi] = cs; p->rope[32768 + 8192 + t * 4 + fi] = sn; }
            }
        }
    }
}

__device__ __forceinline__ void phase_modsum(KP p) {
    for (int i = BID() * 256 + TID(); i < 2 * 16 * 6144; i += gridDim.x * 256) {
        const int n = i % 6144, l = i / (16 * 6144);
        float s = p->b_ada[l * 6144 + n];
#pragma unroll
        for (int kc = 0; kc < 8; ++kc) s += p->modpart[(size_t)kc * (2 * 16 * 6144) + i];
        p->modf[i] = s;
    }
}

__device__ __forceinline__ void route_flush(KP p, char* lds, int lane, int wave, int n, int myrow, int layer) {
    const float* lg = (const float*)(lds + LDS_CTL + 512) + wave * 256;
    int* lc = (int*)(lds + LDS_CTL + 64);
    int* lbase = lc + 32;
    const int tid = wave * 64 + lane;
    if (tid < 32) lc[tid] = 0;
    __syncthreads();
    int cls = 0, lpos = 0;
    if (lane < n) {
        float aff[16], bia[16];
#pragma unroll
        for (int e = 0; e < 16; ++e) { aff[e] = 1.0f / (1.0f + expf(-lg[lane * 16 + e])); bia[e] = aff[e] + p->b_router[e]; }
        int bestg = 0; float bests = -INFINITY;
#pragma unroll
        for (int gi = 0; gi < 4; ++gi) {
            float m1 = -INFINITY, m2 = -INFINITY;
#pragma unroll
            for (int j = 0; j < 4; ++j) { const float vv = bia[gi * 4 + j]; if (vv > m1) { m2 = m1; m1 = vv; } else if (vv > m2) m2 = vv; }
            const float s = m1 + m2;
            if (s > bests) { bests = s; bestg = gi; }
        }
        float bsel[4], asel[4];
#pragma unroll
        for (int j = 0; j < 4; ++j) { bsel[j] = 0.f; asel[j] = 0.f; }
#pragma unroll
        for (int gi = 0; gi < 4; ++gi) if (gi == bestg) {
#pragma unroll
            for (int j = 0; j < 4; ++j) { bsel[j] = bia[gi * 4 + j]; asel[j] = aff[gi * 4 + j]; }
        }
        int i1 = -1, i2 = -1; float v1 = -INFINITY, v2 = -INFINITY;
#pragma unroll
        for (int j = 0; j < 4; ++j) { const float vv = bsel[j]; if (vv > v1) { v2 = v1; i2 = i1; v1 = vv; i1 = j; } else if (vv > v2) { v2 = vv; i2 = j; } }
        const int a = i1 < i2 ? i1 : i2, bb = i1 < i2 ? i2 : i1;
        float wa = 0.f, wb = 0.f;
#pragma unroll
        for (int j = 0; j < 4; ++j) { if (j == a) wa = asel[j]; if (j == bb) wb = asel[j]; }
        const float sw = wa + wb;
        const int pi = (a == 0) ? (bb - 1) : (a == 1 ? (bb + 1) : 5);
        cls = bestg * 6 + pi;
        *(float2*)(p->tokw + (size_t)myrow * 2) = make_float2(wa / sw, wb / sw);
        lpos = atomicAdd(&lc[cls], 1);
    }
    __syncthreads();
    if (tid < NCLS) { const int c = lc[tid]; lbase[tid] = c ? atomicAdd(&p->cnt[(layer * 32 + tid) * 64], c) : 0; }
    __syncthreads();
    if (lane < n) p->lists[(size_t)cls * T_TOK + lbase[cls] + lpos] = myrow;
}

template <int MODE, bool HIN>
__device__ __forceinline__ void phase_norm(KP p, char* lds, const void* xin, const float* g, const float* sh, const float* sc, int layer) {
    const int lane = TID() & 63, wave = TID() >> 6;
    float* wt = (float*)lds;
    if (MODE == 1) {
        __syncthreads();
        for (int i = TID(); i < 4096; i += 256) {
            const float4 w4 = ((const float4*)p->w_router)[i];
            const int k = i >> 2, e0 = (i & 3) * 4;
            wt[(e0 + 0) * 1024 + k] = w4.x; wt[(e0 + 1) * 1024 + k] = w4.y; wt[(e0 + 2) * 1024 + k] = w4.z; wt[(e0 + 3) * 1024 + k] = w4.w;
        }
        __syncthreads();
    }
    float* lgb = (float*)(lds + LDS_CTL + 512);
    int myrow = 0, it = 0;
    float4 vn[4];
    {
        const int row0 = BID() * 4 + wave;
        const size_t xo = (size_t)(row0 < T_TOK ? row0 : 0) * DM;
#pragma unroll
        for (int i = 0; i < 4; ++i) vn[i] = ldx4<HIN>(xin, xo + (lane + 64 * i) * 4);
    }
    for (int row = BID() * 4 + wave; row < T_TOK; row += gridDim.x * 4) {
        const int b = row >> 11;
        float4 v[4]; float ss = 0.f;
#pragma unroll
        for (int i = 0; i < 4; ++i) v[i] = vn[i];
        {
            const int rown = row + gridDim.x * 4;
            const size_t xo = (size_t)(rown < T_TOK ? rown : row) * DM;
#pragma unroll
            for (int i = 0; i < 4; ++i) vn[i] = ldx4<HIN>(xin, xo + (lane + 64 * i) * 4);
        }
#pragma unroll
        for (int i = 0; i < 4; ++i) ss += v[i].x * v[i].x + v[i].y * v[i].y + v[i].z * v[i].z + v[i].w * v[i].w;
#pragma unroll
        for (int o = 32; o >= 1; o >>= 1) ss += __shfl_xor(ss, o);
        const float rstd = 1.0f / sqrtf(ss * (1.0f / 1024.0f) + 1e-6f);
        float acc[16], ya[16];
#pragma unroll
        for (int i = 0; i < 4; ++i) {
            const int k = (lane + 64 * i) * 4;
            const float4 gg = *(const float4*)(g + k);
            float y[4] = {v[i].x * rstd * gg.x, v[i].y * rstd * gg.y, v[i].z * rstd * gg.z, v[i].w * rstd * gg.w};
            if (MODE != 2) {
                const float4 s1 = *(const float4*)(sh + (size_t)b * 6144 + k), s2 = *(const float4*)(sc + (size_t)b * 6144 + k);
                y[0] = y[0] * (1.f + s2.x) + s1.x; y[1] = y[1] * (1.f + s2.y) + s1.y; y[2] = y[2] * (1.f + s2.z) + s1.z; y[3] = y[3] * (1.f + s2.w) + s1.w;
                if (MODE == 0) *(h4*)(p->hn + ((size_t)(k >> 5) * T_TOK + row) * 32 + (k & 31)) = pack4(y[0], y[1], y[2], y[3]);
                else *(h4*)(p->hn + (size_t)row * DM + k) = pack4(y[0], y[1], y[2], y[3]);
            } else {
                *(float4*)(p->out + (size_t)row * DM + k) = make_float4(y[0], y[1], y[2], y[3]);
            }
            ya[4 * i] = y[0]; ya[4 * i + 1] = y[1]; ya[4 * i + 2] = y[2]; ya[4 * i + 3] = y[3];
        }
        if (MODE == 1) {
#pragma unroll
            for (int e = 0; e < 16; ++e) acc[e] = 0.f;
            float4 wq[2][4];
            const float* wl = wt + lane * 4;
#pragma unroll
            for (int e = 0; e < 4; ++e) wq[0][e] = *(const float4*)(wl + e * 1024);
#pragma unroll
            for (int st = 0; st < 16; ++st) {
                const int i = st >> 2, eg = st & 3, cur = st & 1;
                if (st + 1 < 16) {
                    const int i2 = (st + 1) >> 2, eg2 = (st + 1) & 3;
#pragma unroll
                    for (int e = 0; e < 4; ++e) wq[cur ^ 1][e] = *(const float4*)(wl + (eg2 * 4 + e) * 1024 + i2 * 256);
                }
#pragma unroll
                for (int e = 0; e < 4; ++e) {
                    const float4 w4 = wq[cur][e];
                    acc[eg * 4 + e] = fmaf(ya[4 * i], w4.x, fmaf(ya[4 * i + 1], w4.y, fmaf(ya[4 * i + 2], w4.z, fmaf(ya[4 * i + 3], w4.w, acc[eg * 4 + e]))));
                }
                __builtin_amdgcn_sched_barrier(0);
            }
        }
        if (MODE == 1) {
            const bool b5 = lane & 32, b4 = lane & 16, b3 = lane & 8, b2 = lane & 4;
            float r8[8], r4[4], r2[2];
#pragma unroll
            for (int e = 0; e < 8; ++e) { const float snd = b5 ? acc[e] : acc[e + 8], kp = b5 ? acc[e + 8] : acc[e]; r8[e] = kp + __shfl_xor(snd, 32); }
#pragma unroll
            for (int e = 0; e < 4; ++e) { const float snd = b4 ? r8[e] : r8[e + 4], kp = b4 ? r8[e + 4] : r8[e]; r4[e] = kp + __shfl_xor(snd, 16); }
#pragma unroll
            for (int e = 0; e < 2; ++e) { const float snd = b3 ? r4[e] : r4[e + 2], kp = b3 ? r4[e + 2] : r4[e]; r2[e] = kp + __shfl_xor(snd, 8); }
            float rv; { const float snd = b2 ? r2[0] : r2[1], kp = b2 ? r2[1] : r2[0]; rv = kp + __shfl_xor(snd, 4); }
            rv += __shfl_xor(rv, 2); rv += __shfl_xor(rv, 1);
            if ((lane & 3) == 0) lgb[(wave * 16 + it) * 16 + (lane >> 2)] = rv;
            if (lane == it) myrow = row;
            ++it;
            if (it == 16) { route_flush(p, lds, lane, wave, it, myrow, layer); it = 0; }
        }
    }
    if (MODE == 1 && it > 0) route_flush(p, lds, lane, wave, it, myrow, layer);
}

typedef float f2_t __attribute__((ext_vector_type(2)));
#define NRR 2
__device__ __forceinline__ void phase_norm_router(KP p, char* lds, const half_t* xin, const float* g, const float* sh, const float* sc, int layer) {
    const int lane = TID() & 63, wave = TID() >> 6;
    float* wt = (float*)lds;
    __syncthreads();
    for (int i = TID(); i < 4096; i += 256) {
        const float4 w4 = ((const float4*)p->w_router)[i];
        const int k = i >> 2, e0 = (i & 3) * 4;
        wt[(e0 + 0) * 1024 + k] = w4.x; wt[(e0 + 1) * 1024 + k] = w4.y; wt[(e0 + 2) * 1024 + k] = w4.z; wt[(e0 + 3) * 1024 + k] = w4.w;
    }
    __syncthreads();
    float* lgb = (float*)(lds + LDS_CTL + 512);
    int myrow = 0, it = 0;
    const int rstride = gridDim.x * 4;
    for (int row0 = BID() * 4 + wave; row0 < T_TOK; row0 += rstride * NRR) {
        f2_t ya[NRR / 2][16];
        float ss[NRR];
        int nv = 0;
#pragma unroll
        for (int j = 0; j < NRR; ++j) nv += (row0 + j * rstride < T_TOK) ? 1 : 0;
        {
            float4 v[NRR][4];
#pragma unroll
            for (int j = 0; j < NRR; ++j) {
                const int r = row0 + j * rstride;
                const size_t xo = (size_t)(r < T_TOK ? r : row0) * DM;
#pragma unroll
                for (int i = 0; i < 4; ++i) v[j][i] = ldx4<true>(xin, xo + (lane + 64 * i) * 4);
            }
#pragma unroll
            for (int j = 0; j < NRR; ++j) {
                ss[j] = 0.f;
#pragma unroll
                for (int i = 0; i < 4; ++i) ss[j] += v[j][i].x * v[j][i].x + v[j][i].y * v[j][i].y + v[j][i].z * v[j][i].z + v[j][i].w * v[j][i].w;
            }
#pragma unroll
            for (int o = 32; o >= 1; o >>= 1) {
#pragma unroll
                for (int j = 0; j < NRR; ++j) ss[j] += __shfl_xor(ss[j], o);
            }
#pragma unroll
            for (int j = 0; j < NRR; ++j) ss[j] = 1.0f / sqrtf(ss[j] * (1.0f / 1024.0f) + 1e-6f);
#pragma unroll
            for (int j = 0; j < NRR; ++j) {
                const int r = row0 + j * rstride;
                const int rr = r < T_TOK ? r : row0;
                const int b = rr >> 11;
                const float rs = ss[j];
#pragma unroll
                for (int i = 0; i < 4; ++i) {
                    const int k = (lane + 64 * i) * 4;
                    const float4 gg = *(const float4*)(g + k);
                    const float4 s1 = *(const float4*)(sh + (size_t)b * 6144 + k), s2 = *(const float4*)(sc + (size_t)b * 6144 + k);
                    const float y0 = v[j][i].x * rs * gg.x * (1.f + s2.x) + s1.x, y1 = v[j][i].y * rs * gg.y * (1.f + s2.y) + s1.y;
                    const float y2 = v[j][i].z * rs * gg.z * (1.f + s2.z) + s1.z, y3 = v[j][i].w * rs * gg.w * (1.f + s2.w) + s1.w;
                    if (r < T_TOK) *(h4*)(p->hn + (size_t)r * DM + k) = pack4(y0, y1, y2, y3);
                    if (j & 1) { ya[j >> 1][4 * i].y = y0; ya[j >> 1][4 * i + 1].y = y1; ya[j >> 1][4 * i + 2].y = y2; ya[j >> 1][4 * i + 3].y = y3; }
                    else       { ya[j >> 1][4 * i].x = y0; ya[j >> 1][4 * i + 1].x = y1; ya[j >> 1][4 * i + 2].x = y2; ya[j >> 1][4 * i + 3].x = y3; }
                }
                __builtin_amdgcn_sched_barrier(0);
            }
        }
        f2_t acc[NRR / 2][16];
#pragma unroll
        for (int e = 0; e < 16; ++e) {
#pragma unroll
            for (int jp = 0; jp < NRR / 2; ++jp) acc[jp][e] = (f2_t){0.f, 0.f};
        }
        {
            float4 wq[2][4];
            const float* wl = wt + lane * 4;
#pragma unroll
            for (int e = 0; e < 4; ++e) wq[0][e] = *(const float4*)(wl + e * 1024);
#pragma unroll
            for (int st = 0; st < 16; ++st) {
                const int i = st >> 2, eg = st & 3, cur = st & 1;
                if (st + 1 < 16) {
                    const int i2 = (st + 1) >> 2, eg2 = (st + 1) & 3;
#pragma unroll
                    for (int e = 0; e < 4; ++e) wq[cur ^ 1][e] = *(const float4*)(wl + (eg2 * 4 + e) * 1024 + i2 * 256);
                }
#pragma unroll
                for (int e = 0; e < 4; ++e) {
                    const float4 w4 = wq[cur][e];
#pragma unroll
                    for (int jp = 0; jp < NRR / 2; ++jp) {
                        f2_t a = acc[jp][eg * 4 + e];
                        a = ya[jp][4 * i + 3] * (f2_t){w4.w, w4.w} + a;
                        a = ya[jp][4 * i + 2] * (f2_t){w4.z, w4.z} + a;
                        a = ya[jp][4 * i + 1] * (f2_t){w4.y, w4.y} + a;
                        a = ya[jp][4 * i] * (f2_t){w4.x, w4.x} + a;
                        acc[jp][eg * 4 + e] = a;
                    }
                }
                __builtin_amdgcn_sched_barrier(0);
            }
        }
        const bool b5 = lane & 32, b4 = lane & 16, b3 = lane & 8, b2 = lane & 4;
#pragma unroll
        for (int j = 0; j < NRR; ++j) {
            float r8[8], r4[4], r2[2];
#pragma unroll
            for (int e = 0; e < 8; ++e) {
                const float lo = (j & 1) ? acc[j >> 1][e].y : acc[j >> 1][e].x, hi = (j & 1) ? acc[j >> 1][e + 8].y : acc[j >> 1][e + 8].x;
                const float snd = b5 ? lo : hi, kp = b5 ? hi : lo; r8[e] = kp + __shfl_xor(snd, 32);
            }
#pragma unroll
            for (int e = 0; e < 4; ++e) { const float snd = b4 ? r8[e] : r8[e + 4], kp = b4 ? r8[e + 4] : r8[e]; r4[e] = kp + __shfl_xor(snd, 16); }
#pragma unroll
            for (int e = 0; e < 2; ++e) { const float snd = b3 ? r4[e] : r4[e + 2], kp = b3 ? r4[e + 2] : r4[e]; r2[e] = kp + __shfl_xor(snd, 8); }
            float rv; { const float snd = b2 ? r2[0] : r2[1], kp = b2 ? r2[1] : r2[0]; rv = kp + __shfl_xor(snd, 4); }
            rv += __shfl_xor(rv, 2); rv += __shfl_xor(rv, 1);
            if (j < nv) {
                if ((lane & 3) == 0) lgb[(wave * 16 + it) * 16 + (lane >> 2)] = rv;
                if (lane == it) myrow = row0 + j * rstride;
                ++it;
            }
        }
        if (it == 16) { route_flush(p, lds, lane, wave, it, myrow, layer); it = 0; }
    }
    if (it > 0) route_flush(p, lds, lane, wave, it, myrow, layer);
}

template <class WF, class XF, class EPI>
__device__ __forceinline__ void gemm_tile(char* lds, int nkt, WF wf, XF xf, EPI epi) {
    const int tid = TID(), lane = tid & 63, wave = tid >> 6;
    const int wn = wave & 1, wm = wave >> 1, hh = lane >> 5;
    const int lrow = tid >> 3;
    const int lchunk = (tid & 7) ^ ((tid >> 4) & 7);
    const half_t* xs[4];
#pragma unroll
    for (int i = 0; i < 4; ++i) xs[i] = xf(lrow + 32 * i) + lchunk * 8;
    char* ldst = lds + lrow * 128 + (tid & 7) * 16;
    f16v acc[2][2];
#pragma unroll
    for (int i = 0; i < 2; ++i)
#pragma unroll
        for (int j = 0; j < 2; ++j)
#pragma unroll
            for (int r = 0; r < 16; ++r) acc[i][j][r] = 0.f;
    auto issue = [&](int kt, int s) {
        char* d = ldst + s * 32768;
#pragma unroll
        for (int i = 0; i < 4; ++i) glds16(wf(kt, lrow + 32 * i) + lchunk * 8, d + i * 4096);
#pragma unroll
        for (int i = 0; i < 4; ++i) glds16(xs[i] + kt * 64, d + 16384 + i * 4096);
    };
    __syncthreads();
    issue(0, 0);
    const int rsw = (lane >> 1) & 7;
    const int roff_w = (wn * 64 + (lane & 31)) * 128, roff_x = 16384 + (wm * 64 + (lane & 31)) * 128;
    for (int kt = 0; kt < nkt; ++kt) {
        asm volatile("s_waitcnt vmcnt(0)" ::: "memory");
        __syncthreads();
        if (kt + 1 < nkt) issue(kt + 1, (kt + 1) & 1);
        const char* base = lds + (kt & 1) * 32768;
#pragma unroll
        for (int ks = 0; ks < 4; ++ks) {
            const int co = ((2 * ks + hh) ^ rsw) << 4;
            const h8 a0 = *(const h8*)(base + roff_w + co), a1 = *(const h8*)(base + roff_w + 4096 + co);
            const h8 b0 = *(const h8*)(base + roff_x + co), b1 = *(const h8*)(base + roff_x + 4096 + co);
            acc[0][0] = __builtin_amdgcn_mfma_f32_32x32x16_f16(a0, b0, acc[0][0], 0, 0, 0);
            acc[0][1] = __builtin_amdgcn_mfma_f32_32x32x16_f16(a0, b1, acc[0][1], 0, 0, 0);
            acc[1][0] = __builtin_amdgcn_mfma_f32_32x32x16_f16(a1, b0, acc[1][0], 0, 0, 0);
            acc[1][1] = __builtin_amdgcn_mfma_f32_32x32x16_f16(a1, b1, acc[1][1], 0, 0, 0);
        }
    }
    epi(acc, wn, wm, lane);
}

template <class WF, class XF, class EPI>
__device__ __forceinline__ void gemm_tile2(char* lds, int nkt, size_t xkstride, WF wf, XF xf, EPI epi) {
    const int tid = TID(), lane = tid & 63, wave = tid >> 6;
    const int wn = wave & 1, wm = wave >> 1, hh = lane >> 5;
    const int lrow = tid >> 2;
    const int lchunk = (tid & 3) ^ ((tid >> 4) & 3);
    const half_t* xs[2];
#pragma unroll
    for (int i = 0; i < 2; ++i) xs[i] = xf(lrow + 64 * i) + lchunk * 8;
    char* ldst = lds + lrow * 64 + (tid & 3) * 16;
    f16v acc[4][2];
#pragma unroll
    for (int i = 0; i < 4; ++i)
#pragma unroll
        for (int j = 0; j < 2; ++j)
#pragma unroll
            for (int r = 0; r < 16; ++r) acc[i][j][r] = 0.f;
    auto issue = [&](int kt, int s) {
        char* d = ldst + s * 24576;
#pragma unroll
        for (int i = 0; i < 4; ++i) glds16(wf(kt, lrow + 64 * i) + lchunk * 8, d + i * 4096);
#pragma unroll
        for (int i = 0; i < 2; ++i) glds16(xs[i] + (size_t)kt * xkstride, d + 16384 + i * 4096);
    };
    __syncthreads();
    issue(0, 0); issue(1, 1);
    const int rsw = (lane >> 2) & 3;
    const int roff_w = (wn * 128 + (lane & 31)) * 64, roff_x = 16384 + (wm * 64 + (lane & 31)) * 64;
    int st = 0;
    for (int kt = 0; kt < nkt; ++kt) {
        if (kt + 1 < nkt) asm volatile("s_waitcnt vmcnt(6)" ::: "memory");
        else asm volatile("s_waitcnt vmcnt(0)" ::: "memory");
        asm volatile("s_waitcnt lgkmcnt(0)" ::: "memory");
        __builtin_amdgcn_s_barrier();
        if (kt + 2 < nkt) issue(kt + 2, st >= 1 ? st - 1 : 2);
        const char* base = lds + st * 24576;
        st = st == 2 ? 0 : st + 1;
#pragma unroll
        for (int ks = 0; ks < 2; ++ks) {
            const int co = ((2 * ks + hh) ^ rsw) << 4;
            h8 a[4], b[2];
#pragma unroll
            for (int i = 0; i < 4; ++i) a[i] = *(const h8*)(base + roff_w + i * 2048 + co);
#pragma unroll
            for (int j = 0; j < 2; ++j) b[j] = *(const h8*)(base + roff_x + j * 2048 + co);
#pragma unroll
            for (int i = 0; i < 4; ++i)
#pragma unroll
                for (int j = 0; j < 2; ++j) acc[i][j] = __builtin_amdgcn_mfma_f32_32x32x16_f16(a[i], b[j], acc[i][j], 0, 0, 0);
        }
    }
    epi(acc, wn, wm, lane);
}

__device__ __forceinline__ void phase_inproj(KP p, char* lds, int l) {
    const half_t* W = p->Wt_in + (size_t)l * NP * DM;
    const float* rc16 = p->rope; const float* rs16 = p->rope + 16384; const float* rc8 = p->rope + 32768; const float* rs8 = p->rope + 32768 + 8192;
    for (int u = BID(); u < 256 * 10; u += gridDim.x) {
        const int xl = u & 7, Lx = u >> 3, mi = Lx & 15, rr_ = Lx >> 4;
        const int nt = rr_ % 10, mt = 32 * xl + 16 * (rr_ / 10) + mi;
        gemm_tile2(lds, 32, (size_t)T_TOK * 32,
            [&](int kt, int row) { int n = nt * 256 + row; n = n < NP ? n : NP - 1; return W + ((size_t)kt * NP + n) * 32; },
            [&](int row) { return p->hn + (size_t)(mt * 128 + row) * 32; },
            [&](f16v (&acc)[4][2], int wn, int wm, int lane) {
                const int hh = lane >> 5;
                half_t* stg = (half_t*)lds;
                __syncthreads();
#pragma unroll
                for (int i = 0; i < 4; ++i) {
                    const int nb = nt * 256 + wn * 128 + i * 32;
                    if (nb == 1216 || nb == 1248 || nb >= NP) continue;
                    if (nt < 2) {
                        if (i & 1) continue;
#pragma unroll
                        for (int j = 0; j < 2; ++j) {
                            half_t* dst = stg + (wm * 64 + j * 32 + (lane & 31)) * 260 + wn * 64 + (i >> 1) * 32 + 4 * hh;
#pragma unroll
                            for (int g = 0; g < 4; ++g) {
                                float a4[4];
#pragma unroll
                                for (int r = 0; r < 4; ++r) a4[r] = acc[i][j][4 * g + r] * sigmoidf_(acc[i + 1][j][4 * g + r]);
                                *(h4*)(dst + 8 * g) = pack4(a4[0], a4[1], a4[2], a4[3]);
                            }
                        }
                        continue;
                    }
                    const bool rope64 = ((nb >= PC_DQ && nb < PC_DV) || (nb >= PC_MQ && nb < PC_MV)) && ((nb & 63) == 0);
                    const bool rope32 = (nb >= PC_IQ && nb < PC_IW);
#pragma unroll
                    for (int j = 0; j < 2; ++j) {
                        const int tok = mt * 128 + wm * 64 + j * 32 + (lane & 31);
                        const int t = tok & 2047;
                        f16v v = acc[i][j];
                        if (nb == PC_IW) { if (hh == 0) *(float4*)(p->iwf + (size_t)tok * 4) = make_float4(v[0], v[1], v[2], v[3]); continue; }
                        if (rope64) {
                            const float4 c4 = *(const float4*)(rc16 + t * 8 + 4 * hh), s4 = *(const float4*)(rs16 + t * 8 + 4 * hh);
                            const float cc[4] = {c4.x, c4.y, c4.z, c4.w}, sn[4] = {s4.x, s4.y, s4.z, s4.w};
#pragma unroll
                            for (int r = 0; r < 4; ++r) { const float x1 = v[r], x2 = v[r + 4]; v[r] = x1 * cc[r] - x2 * sn[r]; v[r + 4] = x2 * cc[r] + x1 * sn[r]; }
                        } else if (rope32) {
                            const float4 c4 = *(const float4*)(rc8 + t * 4), s4 = *(const float4*)(rs8 + t * 4);
                            const float cc[4] = {c4.x, c4.y, c4.z, c4.w}, sn[4] = {s4.x, s4.y, s4.z, s4.w};
#pragma unroll
                            for (int r = 0; r < 4; ++r) { const float o = __shfl_xor(v[r], 32); v[r] = hh ? (v[r] * cc[r] + o * sn[r]) : (v[r] * cc[r] - o * sn[r]); }
                        }
                        if ((nb >= PC_DQ && nb < PC_DK) || (nb >= PC_MQ && nb < PC_MK)) {
#pragma unroll
                            for (int r = 0; r < 16; ++r) v[r] *= 0.18033688011112042f;
                        }
                        half_t* dst = stg + (wm * 64 + j * 32 + (lane & 31)) * 260 + wn * 128 + i * 32 + 4 * hh;
#pragma unroll
                        for (int g = 0; g < 4; ++g) *(h4*)(dst + 8 * g) = pack4(v[4 * g], v[4 * g + 1], v[4 * g + 2], v[4 * g + 3]);
                    }
                }
                __syncthreads();
                const int wv_ = TID() >> 6;
#pragma unroll 4
                for (int it = 0; it < 32; ++it) {
                    const int row = it * 4 + wv_;
                    const uint2 v2 = *(const uint2*)(stg + row * 260 + lane * 4);
                    if (nt < 2) { if (lane < 32) *(uint2*)(p->P + (size_t)(mt * 128 + row) * NP + nt * 128 + lane * 4) = v2; }
                    else { const int n = nt * 256 + lane * 4; if (n < NP) *(uint2*)(p->P + (size_t)(mt * 128 + row) * NP + n) = v2; }
                }
            });
    }
}

__device__ __forceinline__ void stage_acc_f32(char* lds, const f16v (&acc)[2][2], int wn, int wm, int lane) {
    float* stg = (float*)lds;
    const int hh = lane >> 5;
    __syncthreads();
#pragma unroll
    for (int j = 0; j < 2; ++j)
#pragma unroll
        for (int i = 0; i < 2; ++i)
#pragma unroll
            for (int g = 0; g < 4; ++g)
                *(float4*)(stg + (wm * 64 + j * 32 + (lane & 31)) * 132 + wn * 64 + i * 32 + 4 * hh + 8 * g) = make_float4(acc[i][j][4 * g], acc[i][j][4 * g + 1], acc[i][j][4 * g + 2], acc[i][j][4 * g + 3]);
    __syncthreads();
}
template <bool HIN>
__device__ __forceinline__ void phase_outproj(KP p, char* lds, int l, const void* xin) {
    const half_t* W = p->Wt_o + (size_t)l * DM * DM;
    const float* g1 = p->modf + (size_t)l * 16 * 6144 + 2 * 1024;
    for (int u = BID(); u < 256 * 4; u += gridDim.x) {
        const int xl = u & 7, Lx = u >> 3, mi = Lx & 7, rr_ = Lx >> 3;
        const int nt = rr_ & 3, mt = 32 * xl + 8 * (rr_ >> 2) + mi;
        gemm_tile2(lds, 32, (size_t)T_TOK * 32,
            [&](int kt, int row) { return W + ((size_t)kt * DM + nt * 256 + row) * 32; },
            [&](int row) { return p->ycat + (size_t)(mt * 128 + row) * 32; },
            [&](f16v (&acc)[4][2], int wn, int wm, int lane) {
                const int hh = lane >> 5, tid = TID();
                float* stg = (float*)lds;
#pragma unroll
                for (int rnd = 0; rnd < 2; ++rnd) {
                    __syncthreads();
                    if (wm == rnd) {
#pragma unroll
                        for (int j = 0; j < 2; ++j)
#pragma unroll
                            for (int i = 0; i < 4; ++i)
#pragma unroll
                                for (int g = 0; g < 4; ++g)
                                    *(float4*)(stg + (j * 32 + (lane & 31)) * 260 + wn * 128 + i * 32 + 4 * hh + 8 * g) = make_float4(acc[i][j][4 * g], acc[i][j][4 * g + 1], acc[i][j][4 * g + 2], acc[i][j][4 * g + 3]);
                    }
                    __syncthreads();
#pragma unroll 4
                    for (int it = 0; it < 16; ++it) {
                        const int idx = it * 256 + tid, row = idx >> 6, c = idx & 63;
                        const int tok = mt * 128 + rnd * 64 + row, n = nt * 256 + 4 * c;
                        const float4 a4 = *(const float4*)(stg + row * 260 + 4 * c);
                        const float4 xi = ldx4<HIN>(xin, (size_t)tok * DM + n);
                        const float4 gg = *(const float4*)(g1 + (size_t)(tok >> 11) * 6144 + n);
                        *(h4*)(p->xr + (size_t)tok * DM + n) = pack4(xi.x + gg.x * a4.x, xi.y + gg.y * a4.y, xi.z + gg.z * a4.z, xi.w + gg.w * a4.w);
                    }
                }
            });
    }
}

struct MoeTab { int tb, nt, nc; };
__device__ __forceinline__ MoeTab moe_table(const int* cnt) {
    const int c = TID() & 31;
    MoeTab t;
    t.nc = (c < NCLS) ? cnt[c * 64] : 0;
    t.nt = (t.nc + 127) >> 7;
    int incl = t.nt;
#pragma unroll
    for (int o = 1; o < 32; o <<= 1) { const int v = __shfl_up(incl, o, 32); if (c >= o) incl += v; }
    t.tb = incl - t.nt;
    return t;
}
__device__ __forceinline__ bool moe_tile(const MoeTab& t, int tile, int& cls, int& pos0, int& n) {
    const unsigned long long m = __ballot(tile >= t.tb && tile < t.tb + t.nt);
    if (m == 0ull) return false;
    cls = __ffsll((long long)m) - 1;
    pos0 = (tile - __builtin_amdgcn_readlane(t.tb, cls)) * 128;
    n = __builtin_amdgcn_readlane(t.nc, cls);
    return true;
}
__device__ __forceinline__ void cls_experts(int cls, int& e1, int& e2) {
    const int g = cls / 6, pi = cls % 6;
    const int a = pi < 3 ? 0 : (pi < 5 ? 1 : 2);
    const int b = pi < 3 ? pi + 1 : (pi < 5 ? pi - 1 : 3);
    e1 = g * 4 + a; e2 = g * 4 + b;
}
__device__ __forceinline__ void phase_moe_up(KP p, char* lds, int l) {
    const MoeTab tab = moe_table(p->cnt + l * 32 * 64);
    for (int u = BID(); u < (256 + NCLS) * 8; u += gridDim.x) {
        const int xl = u & 7, Lx = u >> 3;
        const int nt = Lx & 7, tile = (Lx >> 3) * 8 + xl;
        int cls, pos0, nc;
        if (!moe_tile(tab, tile, cls, pos0, nc)) continue;
        int e1, e2; cls_experts(cls, e1, e2);
        const int slot = nt >> 2;
        const half_t* W = p->Wt_gu + ((size_t)(l * 16 + (slot ? e2 : e1)) * 512 + (nt & 3) * 128) * 1024;
        const int* lst = p->lists + (size_t)cls * T_TOK + pos0;
        const int nvalid = nc - pos0;
        int tokE[2]; float wgtE[2];
        {
            const int lane_ = TID() & 63, wm_ = TID() >> 7;
#pragma unroll
            for (int j = 0; j < 2; ++j) {
                const int row = wm_ * 64 + j * 32 + (lane_ & 31);
                tokE[j] = lst[row < nvalid ? row : 0];
                wgtE[j] = p->tokw[(size_t)tokE[j] * 2 + slot];
            }
        }
        gemm_tile(lds, 16,
            [&](int kt, int row) { return W + (size_t)row * 1024 + kt * 64; },
            [&](int row) { const int tok = lst[row < nvalid ? row : 0]; return p->hn + (size_t)tok * DM; },
            [&](f16v (&acc)[2][2], int wn, int wm, int lane) {
                const int hh = lane >> 5;
#pragma unroll
                for (int j = 0; j < 2; ++j) {
                    const int row = wm * 64 + j * 32 + (lane & 31);
                    if (row < nvalid) {
                        const int tok = tokE[j];
                        const float wgt = wgtE[j];
                        half_t* dst = p->act + (size_t)tok * 512 + slot * 256 + ((nt & 3) * 2 + wn) * 32 + 4 * hh;
#pragma unroll
                        for (int g = 0; g < 4; ++g) {
                            float a[4];
#pragma unroll
                            for (int r = 0; r < 4; ++r) { const float gv = acc[0][j][4 * g + r], uv = acc[1][j][4 * g + r]; a[r] = gv * sigmoidf_(gv) * uv * wgt; }
                            *(h4*)(dst + 8 * g) = pack4(a[0], a[1], a[2], a[3]);
                        }
                    }
                }
            });
    }
}
__device__ __forceinline__ void phase_moe_down(KP p, char* lds, int l, float gsc) {
    const MoeTab tab = moe_table(p->cnt + l * 32 * 64);
    const float* g2 = p->modf + (size_t)l * 16 * 6144 + 5 * 1024;
    for (int u = BID(); u < (256 + NCLS) * 8; u += gridDim.x) {
        const int xl = u & 7, Lx = u >> 3;
        const int nt = Lx & 7, tile = (Lx >> 3) * 8 + xl;
        int cls, pos0, nc;
        if (!moe_tile(tab, tile, cls, pos0, nc)) continue;
        int e1, e2; cls_experts(cls, e1, e2);
        const half_t* W1 = p->Wt_d + ((size_t)(l * 16 + e1) * 1024 + nt * 128) * 256;
        const half_t* W2 = p->Wt_d + ((size_t)(l * 16 + e2) * 1024 + nt * 128) * 256;
        const int* lst = p->lists + (size_t)cls * T_TOK + pos0;
        const int nvalid = nc - pos0;
        int tokS[8];
        {
            const int r0 = TID() >> 4;
#pragma unroll
            for (int it = 0; it < 8; ++it) { const int row = it * 16 + r0; tokS[it] = lst[row < nvalid ? row : 0]; }
        }
        gemm_tile(lds, 8,
            [&](int kt, int row) { return (kt < 4 ? W1 : W2) + (size_t)row * 256 + (kt & 3) * 64; },
            [&](int row) { const int tok = lst[row < nvalid ? row : 0]; return p->act + (size_t)tok * 512; },
            [&](f16v (&acc)[2][2], int wn, int wm, int lane) {
                const int hh = lane >> 5, tid = TID();
                float* stg = (float*)lds;
                __syncthreads();
#pragma unroll
                for (int j = 0; j < 2; ++j)
#pragma unroll
                    for (int i = 0; i < 2; ++i)
#pragma unroll
                        for (int g = 0; g < 4; ++g)
                            *(float4*)(stg + (wm * 64 + j * 32 + (lane & 31)) * 132 + wn * 64 + i * 32 + 8 * g + 4 * hh) =
                                make_float4(acc[i][j][4 * g], acc[i][j][4 * g + 1], acc[i][j][4 * g + 2], acc[i][j][4 * g + 3]);
                __syncthreads();
                const int r0 = tid >> 4, c8 = (tid & 15) * 8;
#pragma unroll
                for (int it = 0; it < 8; ++it) {
                    const int row = it * 16 + r0;
                    if (row < nvalid) {
                        const int tok = tokS[it];
                        const int n = nt * 128 + c8;
                        const float* gp = g2 + (size_t)(tok >> 11) * 6144 + n;
                        const float4 a0 = *(const float4*)(stg + row * 132 + c8), a1 = *(const float4*)(stg + row * 132 + c8 + 4);
                        const float4 g0 = *(const float4*)gp, g1 = *(const float4*)(gp + 4);
                        h8* xp = (h8*)(p->xr + (size_t)tok * DM + n);
                        const h8 xi = *xp;
                        h8 o;
                        o[0] = (half_t)((float)xi[0] + gsc * g0.x * a0.x); o[1] = (half_t)((float)xi[1] + gsc * g0.y * a0.y);
                        o[2] = (half_t)((float)xi[2] + gsc * g0.z * a0.z); o[3] = (half_t)((float)xi[3] + gsc * g0.w * a0.w);
                        o[4] = (half_t)((float)xi[4] + gsc * g1.x * a1.x); o[5] = (half_t)((float)xi[5] + gsc * g1.y * a1.y);
                        o[6] = (half_t)((float)xi[6] + gsc * g1.z * a1.z); o[7] = (half_t)((float)xi[7] + gsc * g1.w * a1.w);
                        *xp = o;
                    }
                }
            });
    }
}

__device__ __forceinline__ void dsa_select_unit(KP p, char* lds, int b, int qt) {
    unsigned* hist = (unsigned*)lds;
    unsigned* maskl = hist + 16 * 257 + 16;
    unsigned* stP = maskl + 1024;
    unsigned* stNeed = stP + 16;
    unsigned* stDone = stNeed + 16;
    unsigned* flag = stDone + 16;
    unsigned* dummyb = flag + 16;
    const int tid = TID(), lane = tid & 63, wave = tid >> 6;
    const int q0 = qt * 16, tokbase = b * SEQ;
    __syncthreads();
    if (q0 < 256) {
        for (int i = tid; i < 1024; i += 256) {
            const int q = i >> 6, wd = i & 63;
            const int n = q0 + q + 1 - 32 * wd;
            const unsigned w = n >= 32 ? 0xFFFFFFFFu : (n <= 0 ? 0u : ((1u << n) - 1u));
            p->dmask[(size_t)(tokbase + q0 + q) * 64 + wd] = w;
        }
        return;
    }
    for (int i = tid; i < 1024; i += 256) maskl[i] = 0u;
    if (tid < 16) { stP[tid] = 0u; stNeed[tid] = 256u; stDone[tid] = 0u; }
    for (int i = tid; i < 16 * 257; i += 256) hist[i] = 0u;
    __syncthreads();
    const int ql = lane & 15, fq = lane >> 4;
    const int tq = q0 + ql;
    const half_t* Pb = p->P + (size_t)tokbase * NP;
    h8 iqf[4];
#pragma unroll
    for (int hd = 0; hd < 4; ++hd) iqf[hd] = *(const h8*)(Pb + (size_t)tq * NP + PC_IQ + hd * 32 + 8 * fq);
    const float4 iw4 = *(const float4*)(p->iwf + (size_t)(tokbase + tq) * 4);
    const float wsc0 = iw4.x * 0.08838834764831845f, wsc1 = iw4.y * 0.08838834764831845f, wsc2 = iw4.z * 0.08838834764831845f, wsc3 = iw4.w * 0.08838834764831845f;
    const int ng = qt + 1;
    unsigned sc[32][4];
    const half_t* ikp = Pb + (size_t)ql * NP + PC_IK + 8 * fq;
#pragma unroll
    for (int gb = 0; gb < 4; ++gb) {
        h8 ik[8];
#pragma unroll
        for (int x = 0; x < 8; ++x) {
            int g = wave + 4 * (gb * 8 + x);
            g = g < ng ? g : ng - 1;
            ik[x] = *(const h8*)(ikp + (size_t)(16 * g) * NP);
        }
#pragma unroll
        for (int x = 0; x < 8; ++x) {
            const int gi = gb * 8 + x;
            const int g = wave + 4 * gi;
            const f4v z = {0.f, 0.f, 0.f, 0.f};
            const f4v c0 = __builtin_amdgcn_mfma_f32_16x16x32_f16(ik[x], iqf[0], z, 0, 0, 0);
            const f4v c1 = __builtin_amdgcn_mfma_f32_16x16x32_f16(ik[x], iqf[1], z, 0, 0, 0);
            const f4v c2 = __builtin_amdgcn_mfma_f32_16x16x32_f16(ik[x], iqf[2], z, 0, 0, 0);
            const f4v c3 = __builtin_amdgcn_mfma_f32_16x16x32_f16(ik[x], iqf[3], z, 0, 0, 0);
#pragma unroll
            for (int r = 0; r < 4; ++r) {
                const int j = 16 * g + 4 * fq + r;
                float sv = wsc0 * __builtin_amdgcn_fmed3f(c0[r], 0.f, INFINITY);
                sv = fmaf(wsc1, __builtin_amdgcn_fmed3f(c1[r], 0.f, INFINITY), sv);
                sv = fmaf(wsc2, __builtin_amdgcn_fmed3f(c2[r], 0.f, INFINITY), sv);
                sv = fmaf(wsc3, __builtin_amdgcn_fmed3f(c3[r], 0.f, INFINITY), sv);
                sv += 0.0f;
                const int sb = __float_as_int(sv);
                const unsigned su = (unsigned)sb ^ ((unsigned)(sb >> 31) | 0x80000000u);
                const unsigned ck = (su & 0xFFFFF800u) | (unsigned)(2047 - j);
                sc[gi][r] = (g < ng && j <= tq) ? ck : 0u;
            }
            if (g < ng) {
#pragma unroll
                for (int r = 0; r < 4; ++r) atomicAdd(hist + ql * 257 + (sc[gi][r] >> 24), 1u);
            }
        }
    }
    bool alldone = false;
    for (int pass = 0; pass < 5; ++pass) {
        const bool fin = alldone;
        if (!fin && pass > 0) { for (int i = tid; i < 16 * 257; i += 256) hist[i] = 0u; }
        if (tid == 0) *flag = 0u;
        __syncthreads();
        if (pass > 0) {
        const unsigned sP = stP[ql], sDone = stDone[ql];
        int wv = wave, fqv = fq;
        asm volatile("" : "+v"(wv), "+v"(fqv));
        if (fin) {
            const int sh = (int)(32u - 8u * (sDone ? sDone : 1u));
            unsigned* mrow = maskl + ql * 64;
#pragma unroll
            for (int gi = 0; gi < 32; ++gi) {
                const int g = wv + 4 * gi;
                unsigned nib = 0u;
#pragma unroll
                for (int r = 0; r < 4; ++r) {
                    const unsigned uu = sc[gi][r];
                    nib |= ((uu >> sh) >= sP) ? (1u << r) : 0u;
                }
                if (g < ng) atomicOr(&mrow[g >> 1], nib << ((g & 1) * 16 + 4 * fqv));
            }
        } else {
            const int shm = pass ? 32 - 8 * pass : 0, shd = 24 - 8 * pass;
            const unsigned orm = pass ? 0u : 0xFFFFFFFFu;
            const unsigned cmpv = pass ? (sDone == 0u ? sP : 0xFFFFFFFFu) : 0xFFFFFFFFu;
            unsigned* hrow = hist + ql * 257;
            unsigned* dummy = dummyb + lane;
#pragma unroll
            for (int gi = 0; gi < 32; ++gi) {
                const int g = wv + 4 * gi;
                if (g < ng) {
#pragma unroll
                    for (int r = 0; r < 4; ++r) {
                        const unsigned uu = sc[gi][r];
                        const bool match = (((uu >> shm) | orm) == cmpv);
                        const unsigned dig = (uu >> shd) & 255u;
                        unsigned* a = match ? hrow + dig : dummy;
                        atomicAdd(a, 1u);
                    }
                }
            }
        }
        }
        __syncthreads();
        if (fin) break;
        {
            const int qq = tid >> 4, seg = tid & 15;
            const bool active = (stDone[qq] == 0u);
            unsigned c16 = 0u;
            if (active) {
#pragma unroll
                for (int d = 0; d < 16; ++d) c16 += hist[qq * 257 + seg * 16 + d];
            }
            unsigned v = c16;
#pragma unroll
            for (int off = 1; off < 16; off <<= 1) { const unsigned t = __shfl_down(v, off, 16); if (seg + off < 16) v += t; }
            const unsigned suf = v - c16;
            const unsigned need = stNeed[qq];
            if (active && suf < need && need <= suf + c16) {
                unsigned run = suf, D = 0u, cD = 0u, nn = need;
                for (int d = 15; d >= 0; --d) {
                    const unsigned cc = hist[qq * 257 + seg * 16 + d];
                    if (run + cc >= need) { D = (unsigned)(seg * 16 + d); cD = cc; nn = need - run; break; }
                    run += cc;
                }
                const bool done = (cD == nn) || pass == 3;
                stP[qq] = (stP[qq] << 8) | D; stNeed[qq] = nn;
                if (done) stDone[qq] = (unsigned)(pass + 1); else atomicAdd(flag, 1u);
            }
        }
        __syncthreads();
        alldone = (*flag == 0u);
    }
    for (int i = tid; i < 1024; i += 256) p->dmask[(size_t)(tokbase + q0 + (i >> 6)) * 64 + (i & 63)] = maskl[i];
}

__device__ __forceinline__ void conv_unit(KP p, char* lds, int l, int b, int c) {
    float* red = (float*)lds;
    const int ch = TID(), lane = ch & 63, wave = ch >> 6;
    const int t0 = c * 32, tokbase = b * SEQ;
    float aw[62];
#pragma unroll
    for (int rr = 0; rr < 62; ++rr) {
        int tt = t0 - 30 + rr; const bool ok = tt >= 0; tt = ok ? tt : t0;
        const float v = (float)p->P[(size_t)(tokbase + tt) * NP + ch];
        aw[rr] = ok ? v : 0.f;
    }
    float w[31];
#pragma unroll
    for (int i = 0; i < 31; ++i) w[i] = p->w_dw[(l * 31 + i) * 256 + ch];
    const float bias = p->b_dw[l * 256 + ch];
    float y[32], s1[32], s2[32];
#pragma unroll
    for (int tk = 0; tk < 32; ++tk) {
        float sacc = bias;
#pragma unroll
        for (int i = 0; i < 31; ++i) sacc = fmaf(aw[tk + i], w[i], sacc);
        y[tk] = sacc; s1[tk] = sacc; s2[tk] = sacc * sacc;
    }
    {
        const bool b5 = lane & 32, b4 = lane & 16, b3 = lane & 8, b2 = lane & 4, b1 = lane & 2;
        float a16[16], c16[16], a8[8], c8[8], a4[4], c4[4], a2[2], c2[2];
#pragma unroll
        for (int e = 0; e < 16; ++e) { a16[e] = (b5 ? s1[e + 16] : s1[e]) + __shfl_xor(b5 ? s1[e] : s1[e + 16], 32); c16[e] = (b5 ? s2[e + 16] : s2[e]) + __shfl_xor(b5 ? s2[e] : s2[e + 16], 32); }
#pragma unroll
        for (int e = 0; e < 8; ++e) { a8[e] = (b4 ? a16[e + 8] : a16[e]) + __shfl_xor(b4 ? a16[e] : a16[e + 8], 16); c8[e] = (b4 ? c16[e + 8] : c16[e]) + __shfl_xor(b4 ? c16[e] : c16[e + 8], 16); }
#pragma unroll
        for (int e = 0; e < 4; ++e) { a4[e] = (b3 ? a8[e + 4] : a8[e]) + __shfl_xor(b3 ? a8[e] : a8[e + 4], 8); c4[e] = (b3 ? c8[e + 4] : c8[e]) + __shfl_xor(b3 ? c8[e] : c8[e + 4], 8); }
#pragma unroll
        for (int e = 0; e < 2; ++e) { a2[e] = (b2 ? a4[e + 2] : a4[e]) + __shfl_xor(b2 ? a4[e] : a4[e + 2], 4); c2[e] = (b2 ? c4[e + 2] : c4[e]) + __shfl_xor(b2 ? c4[e] : c4[e + 2], 4); }
        float av = (b1 ? a2[1] : a2[0]) + __shfl_xor(b1 ? a2[0] : a2[1], 2), cv = (b1 ? c2[1] : c2[0]) + __shfl_xor(b1 ? c2[0] : c2[1], 2);
        av += __shfl_xor(av, 1); cv += __shfl_xor(cv, 1);
        const int tokk = (b5 ? 16 : 0) + (b4 ? 8 : 0) + (b3 ? 4 : 0) + (b2 ? 2 : 0) + (b1 ? 1 : 0);
        __syncthreads();
        if ((lane & 1) == 0) { red[(tokk * 4 + wave) * 2] = av; red[(tokk * 4 + wave) * 2 + 1] = cv; }
        __syncthreads();
    }
    const float lg = p->ln_g[l * 256 + ch], lb = p->ln_b[l * 256 + ch];
#pragma unroll
    for (int tk = 0; tk < 32; ++tk) {
        const float4 ra = *(const float4*)(red + tk * 8), rb = *(const float4*)(red + tk * 8 + 4);
        const float t1 = (ra.x + ra.z) + (rb.x + rb.z);
        const float t2 = (ra.y + ra.w) + (rb.y + rb.w);
        const float mu = t1 * (1.0f / 256.0f);
        float var = t2 * (1.0f / 256.0f) - mu * mu; var = var < 0.f ? 0.f : var;
        float z = (y[tk] - mu) * (1.0f / sqrtf(var + 1e-6f)) * lg + lb;
        z = z * sigmoidf_(z);
        p->ycat[((size_t)(ch >> 5) * T_TOK + tokbase + t0 + tk) * 32 + (ch & 31)] = (half_t)z;
    }
}

__device__ __forceinline__ void kmean_unit(KP p, char* lds, int b, int h, int blk) {
    float* part = (float*)lds;
    const int tid = TID(), d = tid & 63, pt = tid >> 6;
    const half_t* r = p->P + (size_t)(b * SEQ + blk * 256 + pt * 64) * NP + PC_MK + h * 64 + d;
    float s = 0.f;
#pragma unroll 16
    for (int k = 0; k < 64; ++k) s += (float)r[(size_t)k * NP];
    __syncthreads();
    part[pt * 64 + d] = s;
    __syncthreads();
    if (tid < 64) p->kmean[(((size_t)b * 6 + h) * 8 + blk) * 64 + tid] = ((part[tid] + part[64 + tid]) + (part[128 + tid] + part[192 + tid])) * (1.0f / 256.0f);
}

#ifndef POST_MASK
#define POST_MASK 7
#endif
__device__ __forceinline__ void phase_post(KP p, char* lds, int l, int tm) {
    const int NA = 2048, NB = 1024, NC = 768;
    const int G_ = gridDim.x;
    for (int u0 = BID(), k_ = 0; u0 < NA + NB + NC; u0 += G_, ++k_) {
        int u = u0;
        if (u0 < NA && (k_ & 1) && (k_ + 1) * G_ <= NA) u = k_ * G_ + (G_ - 1 - (u0 - k_ * G_));
        if (u < NA) { if (tm & 1) dsa_select_unit(p, lds, u % 16, 127 - (u / 16)); }
        else if (u < NA + NB) { const int v = u - NA; if (tm & 2) conv_unit(p, lds, l, v % 16, v / 16); }
        else { const int v = u - NA - NB; if (tm & 4) kmean_unit(p, lds, v / 48, (v / 8) % 6, v % 8); }
    }
}

template <int MODE>
__device__ __forceinline__ void attn_unit(KP p, char* lds, int b, int h, int qt) {
    const int tid = TID(), lane = tid & 63, wave = tid >> 6, hh = lane >> 5, ql = lane & 31;
    const int q0 = qt * 128, tokbase = b * SEQ;
    const int tq = q0 + wave * 32 + ql;
    const half_t* Pb = p->P + (size_t)tokbase * NP;
    const int QOFF = MODE ? PC_MQ + h * 64 : PC_DQ + h * 64;
    const int KOFF = MODE ? PC_MK + h * 64 : PC_DK;
    const int VOFF = MODE ? PC_MV + h * 64 : PC_DV;
    const int own = qt >> 1;
    unsigned mysel = 0u, anysel = 0u;
    __syncthreads();
    if (MODE == 1) {
        float* km = (float*)(lds + 32768);
        float* gts = km + 512;
        unsigned* selq = (unsigned*)(gts + 1024);
        unsigned* anyb = selq + 128;
        for (int i = tid; i < 512; i += 256) km[i] = p->kmean[((size_t)b * 6 + h) * 512 + i];
        if (tid == 0) *anyb = 0u;
        __syncthreads();
        {
            const int q = tid & 127, hf = tid >> 7;
            if (hf * 4 < own) {
                const half_t* qr = Pb + (size_t)(q0 + q) * NP + QOFF;
                float g0 = 0.f, g1 = 0.f, g2 = 0.f, g3 = 0.f;
#pragma unroll
                for (int c8 = 0; c8 < 8; ++c8) {
                    const h8 qv = *(const h8*)(qr + c8 * 8);
#pragma unroll
                    for (int j4 = 0; j4 < 2; ++j4) {
                        const int d = c8 * 8 + j4 * 4;
                        const float q0f = (float)qv[j4 * 4], q1f = (float)qv[j4 * 4 + 1], q2f = (float)qv[j4 * 4 + 2], q3f = (float)qv[j4 * 4 + 3];
                        const float4 k0 = *(const float4*)(km + (hf * 4 + 0) * 64 + d), k1 = *(const float4*)(km + (hf * 4 + 1) * 64 + d);
                        const float4 k2 = *(const float4*)(km + (hf * 4 + 2) * 64 + d), k3 = *(const float4*)(km + (hf * 4 + 3) * 64 + d);
                        g0 = fmaf(q0f, k0.x, g0); g0 = fmaf(q1f, k0.y, g0); g0 = fmaf(q2f, k0.z, g0); g0 = fmaf(q3f, k0.w, g0);
                        g1 = fmaf(q0f, k1.x, g1); g1 = fmaf(q1f, k1.y, g1); g1 = fmaf(q2f, k1.z, g1); g1 = fmaf(q3f, k1.w, g1);
                        g2 = fmaf(q0f, k2.x, g2); g2 = fmaf(q1f, k2.y, g2); g2 = fmaf(q2f, k2.z, g2); g2 = fmaf(q3f, k2.w, g2);
                        g3 = fmaf(q0f, k3.x, g3); g3 = fmaf(q1f, k3.y, g3); g3 = fmaf(q2f, k3.z, g3); g3 = fmaf(q3f, k3.w, g3);
                    }
                }
                gts[q * 8 + hf * 4 + 0] = g0; gts[q * 8 + hf * 4 + 1] = g1; gts[q * 8 + hf * 4 + 2] = g2; gts[q * 8 + hf * 4 + 3] = g3;
            }
        }
        __syncthreads();
        if (tid < 128) {
            unsigned m = 0u;
            const int want = own < 3 ? own : 3;
            for (int r = 0; r < want; ++r) {
                int best = -1; float bv = -INFINITY;
                for (int j = 0; j < own; ++j) { const float gv = gts[tid * 8 + j]; if (!((m >> j) & 1u) && (best < 0 || gv > bv)) { best = j; bv = gv; } }
                m |= 1u << best;
            }
            selq[tid] = m;
            if (m) atomicOr(anyb, m);
        }
        __syncthreads();
        mysel = selq[wave * 32 + ql];
        anysel = *anyb;
        __syncthreads();
    }
    h8 qf[4];
#pragma unroll
    for (int ks = 0; ks < 4; ++ks) qf[ks] = *(const h8*)(Pb + (size_t)tq * NP + QOFF + 16 * ks + 8 * hh);
    f16v O0, O1;
#pragma unroll
    for (int r = 0; r < 16; ++r) { O0[r] = 0.f; O1[r] = 0.f; }
    float l_run = 0.f;
    bool unset = true;
    f16v negm;
#pragma unroll
    for (int r = 0; r < 16; ++r) negm[r] = 0.f;
    const float THR = 8.0f;
    const int ntile = 2 * qt + 2;
    auto skip = [&](int kt) -> bool { return MODE == 1 && kt < 4 * own && !((anysel >> (kt >> 2)) & 1u); };
    auto nexttile = [&](int kt) -> int { ++kt; while (kt < ntile && skip(kt)) ++kt; return kt; };
    const int lrow = tid >> 3;
    const int kchunk = (tid & 7) ^ ((tid >> 4) & 7);
    const int vchunk = (tid & 7) ^ (((tid >> 4) & 1) << 2);
    char* ldst = lds + lrow * 128 + (tid & 7) * 16;
    auto issue = [&](int kt, int s) {
        const half_t* src = Pb + (size_t)(kt * 64 + lrow) * NP;
        char* d = ldst + s * 16384;
        glds16(src + KOFF + kchunk * 8, d);
        glds16(src + (size_t)32 * NP + KOFF + kchunk * 8, d + 4096);
        glds16(src + VOFF + vchunk * 8, d + 8192);
        glds16(src + (size_t)32 * NP + VOFF + vchunk * 8, d + 8192 + 4096);
    };
    const int rsw = (lane >> 1) & 7;
    const int kro = ql * 128;
    const int li = lane & 15, qp = li >> 2, pp = li & 3, swv = (qp >> 1) & 1;
    const int vb0 = 8192 + (4 * hh + qp) * 128 + 32 * ((lane >> 4) & 1) + 8 * pp + 64 * (0 ^ swv);
    const int vb1 = 8192 + (4 * hh + qp) * 128 + 32 * ((lane >> 4) & 1) + 8 * pp + 64 * (1 ^ swv);
    int kt = -1; kt = nexttile(kt);
    int s = 0;
    if (kt < ntile) issue(kt, 0);
    while (kt < ntile) {
        const int ktn = nexttile(kt);
        asm volatile("s_waitcnt vmcnt(0)" ::: "memory");
        __syncthreads();
        if (ktn < ntile) issue(ktn, s ^ 1);
        const bool wave_active = (kt * 64 <= q0 + wave * 32 + 31);
        if (wave_active) {
            const char* base = lds + s * 16384;
            uint2 mw = make_uint2(0u, 0u);
            if (MODE == 0) mw = *(const uint2*)(p->dmask + (size_t)(tokbase + tq) * 64 + 2 * kt);
            h8 vf0[4], vf1[4];
#pragma unroll
            for (int kk = 0; kk < 4; ++kk) {
                const int roff = (32 * (kk >> 1) + 16 * (kk & 1)) * 128;
                const s4v lo0 = __builtin_amdgcn_ds_read_tr16_b64_v4i16((LAS s4v*)(base + vb0 + roff));
                const s4v hi0 = __builtin_amdgcn_ds_read_tr16_b64_v4i16((LAS s4v*)(base + vb0 + roff + 8 * 128));
                const s4v lo1 = __builtin_amdgcn_ds_read_tr16_b64_v4i16((LAS s4v*)(base + vb1 + roff));
                const s4v hi1 = __builtin_amdgcn_ds_read_tr16_b64_v4i16((LAS s4v*)(base + vb1 + roff + 8 * 128));
                vf0[kk] = __builtin_bit_cast(h8, __builtin_shufflevector(lo0, hi0, 0, 1, 2, 3, 4, 5, 6, 7));
                vf1[kk] = __builtin_bit_cast(h8, __builtin_shufflevector(lo1, hi1, 0, 1, 2, 3, 4, 5, 6, 7));
            }
            bool lane_on = true;
            if (MODE == 1 && kt < 4 * own) lane_on = (mysel >> (kt >> 2)) & 1u;
            f16v cin = negm;
            if (MODE == 1 && kt < 4 * own) {
#pragma unroll
                for (int r = 0; r < 16; ++r) cin[r] = lane_on ? negm[r] : -INFINITY;
            }
            f16v s0 = cin, s1 = cin;
#pragma unroll
            for (int ks = 0; ks < 4; ++ks) {
                const int co = ((2 * ks + hh) ^ rsw) << 4;
                const h8 k0 = *(const h8*)(base + kro + co), k1 = *(const h8*)(base + kro + 4096 + co);
                s0 = __builtin_amdgcn_mfma_f32_32x32x16_f16(k0, qf[ks], s0, 0, 0, 0);
                s1 = __builtin_amdgcn_mfma_f32_32x32x16_f16(k1, qf[ks], s1, 0, 0, 0);
            }
            if (MODE == 0) {
                const unsigned w0 = mw.x >> (4 * hh), w1 = mw.y >> (4 * hh);
#pragma unroll
                for (int r = 0; r < 16; ++r) {
                    const int pos = (r & 3) + 8 * (r >> 2);
                    const unsigned m0 = (unsigned)__builtin_amdgcn_sbfe((int)w0, pos, 1), m1 = (unsigned)__builtin_amdgcn_sbfe((int)w1, pos, 1);
                    s0[r] = __uint_as_float((__float_as_uint(s0[r]) & m0) | (0xFF800000u & ~m0));
                    s1[r] = __uint_as_float((__float_as_uint(s1[r]) & m1) | (0xFF800000u & ~m1));
                }
            } else if (kt >= 4 * own && kt * 64 + 63 > q0 + wave * 32) {
#pragma unroll
                for (int r = 0; r < 16; ++r) {
                    const int key = kt * 64 + (r & 3) + 8 * (r >> 2) + 4 * hh;
                    s0[r] = (key <= tq) ? s0[r] : -INFINITY;
                    s1[r] = (key + 32 <= tq) ? s1[r] : -INFINITY;
                }
            }
            float mx = s0[0];
#pragma unroll
            for (int r = 1; r < 16; ++r) mx = fmaxf(mx, s0[r]);
#pragma unroll
            for (int r = 0; r < 16; ++r) mx = fmaxf(mx, s1[r]);
            mx = fmaxf(mx, __shfl_xor(mx, 32));
            const bool need = unset ? (mx > -INFINITY) : (mx > THR);
            if (__any(need)) {
                const float delta = need ? mx : 0.f;
                const float alpha = (need && !unset) ? __builtin_amdgcn_exp2f(-delta) : 1.0f;
#pragma unroll
                for (int r = 0; r < 16; ++r) { s0[r] -= delta; s1[r] -= delta; negm[r] -= delta; O0[r] *= alpha; O1[r] *= alpha; }
                l_run *= alpha;
                unset = unset && !need;
            }
            float ls = 0.f;
#pragma unroll
            for (int r = 0; r < 16; ++r) { s0[r] = __builtin_amdgcn_exp2f(s0[r]); ls += s0[r]; }
#pragma unroll
            for (int r = 0; r < 16; ++r) { s1[r] = __builtin_amdgcn_exp2f(s1[r]); ls += s1[r]; }
            l_run += ls;
#pragma unroll
            for (int kk = 0; kk < 4; ++kk) {
                h8 pf;
#pragma unroll
                for (int j = 0; j < 8; ++j) pf[j] = (half_t)((kk >> 1) ? s1[8 * (kk & 1) + j] : s0[8 * (kk & 1) + j]);
                O0 = __builtin_amdgcn_mfma_f32_32x32x16_f16(vf0[kk], pf, O0, 0, 0, 0);
                O1 = __builtin_amdgcn_mfma_f32_32x32x16_f16(vf1[kk], pf, O1, 0, 0, 0);
            }
        }
        kt = ktn; s ^= 1;
    }
    const float lt = l_run + __shfl_xor(l_run, 32);
    const float inv = 1.0f / lt;
    const int ycol = (MODE ? 640 : 256) + h * 64;
    half_t* dst = p->ycat + ((size_t)(ycol >> 5) * T_TOK + tokbase + tq) * 32 + 4 * hh;
#pragma unroll
    for (int g = 0; g < 4; ++g) {
        *(h4*)(dst + 8 * g) = pack4(O0[4 * g] * inv, O0[4 * g + 1] * inv, O0[4 * g + 2] * inv, O0[4 * g + 3] * inv);
        *(h4*)(dst + (size_t)T_TOK * 32 + 8 * g) = pack4(O1[4 * g] * inv, O1[4 * g + 1] * inv, O1[4 * g + 2] * inv, O1[4 * g + 3] * inv);
    }
}

#ifndef ATT_MASK
#define ATT_MASK 3
#endif
__device__ __forceinline__ void phase_attn(KP p, char* lds, int tm) {
    const int G_ = gridDim.x, per_ = G_ >> 3;
    const bool snake_ = (G_ >= 8) && ((G_ & 7) == 0);
    for (int k_ = 0, b_ = BID(); snake_ ? (k_ * per_ < 384) : (b_ + k_ * G_ < 3072); ++k_) {
        int xl, Lx;
        if (snake_) { const int idx_ = b_ >> 3; xl = b_ & 7; Lx = k_ * per_ + ((k_ & 1) ? (per_ - 1 - idx_) : idx_); }
        else { const int u = b_ + k_ * G_; xl = u & 7; Lx = u >> 3; }
        if (Lx >= 384) continue;
        const int qt = 15 - (Lx / 24), rem = Lx % 24;
        const int type = rem & 1, bh = xl * 12 + (rem >> 1);
        if (type == 0) { if (tm & 1) attn_unit<0>(p, lds, bh / 6, bh % 6, qt); }
        else { if (tm & 2) attn_unit<1>(p, lds, bh / 6, bh % 6, qt); }
    }
}

__global__ void __launch_bounds__(256, 2) mk_fwd(Params p_unused) {
    extern __shared__ __attribute__((aligned(16))) char lds[];
    volatile LAS unsigned* stw = (volatile LAS unsigned*)(lds + LDS_CTL);
    if (threadIdx.x < 4) stw[threadIdx.x] = 0u;
    __syncthreads();
    KP p0 = (KP)__builtin_amdgcn_kernarg_segment_ptr();
    XcdBarrier bar; bar.bar = p0->bar; bar.x = 0; bar.st = stw;
#if !MK_SPLIT
    bar = xcd_barrier_post(p0->bar, stw);
#endif
    const int ph_lo = p0->ph_lo, ph_hi = p0->ph_hi;
    for (int ph = ph_lo; ph < ph_hi; ++ph) {
      KP p = p0; asm volatile("" : "+s"(p));
      const int nrep = (DUP_SUB >= 0 && ((DUP_SUB == 100 && ph == 0) || (ph >= 2 && ph < NPHASE - 1 && ((ph - 2) & 7) == DUP_SUB && (DUP_SUB != 4 || ph < 10)))) ? 2 : 1;
      for (int rep = 0; rep < nrep; ++rep) {
        if (ph == 0) phase_prologue(p, lds);
        else if (ph == 1) phase_modsum(p);
        else if (ph == NPHASE - 1) phase_norm<2, true>(p, lds, p->xr, p->g_final, nullptr, nullptr, 0);
        else {
            const int l = (ph - 2) >> 3, sub = (ph - 2) & 7;
            const float* mf = p->modf + (size_t)l * 16 * 6144;
            if (sub == 0) { if (l == 0) phase_norm<0, false>(p, lds, p->x, p->g_mix + l * DM, mf, mf + 1024, l); else phase_norm<0, true>(p, lds, p->xr, p->g_mix + l * DM, mf, mf + 1024, l); }
            else if (sub == 1) phase_inproj(p, lds, l);
            else if (sub == 2) phase_post(p, lds, l, rep ? POST_MASK : 7);
            else if (sub == 3) phase_attn(p, lds, rep ? ATT_MASK : 3);
            else if (sub == 4) { if (l == 0) phase_outproj<false>(p, lds, l, p->x); else phase_outproj<true>(p, lds, l, p->xr); }
            else if (sub == 5) phase_norm_router(p, lds, p->xr, p->g_ffn + l * DM, mf + 3 * 1024, mf + 4 * 1024, (nrep == 2 && rep == 0) ? l + 2 : l);
            else if (sub == 6) phase_moe_up(p, lds, l);
            else phase_moe_down(p, lds, l, nrep == 2 ? 0.5f : 1.0f);
        }
      }
#if !MK_SPLIT
        if (ph + 1 < ph_hi) xcd_barrier(bar);
#endif
    }
}

extern "C" void kernel_launch(void* const* d_in, const int* in_sizes, int n_in, void* d_out, int out_size, void* d_ws, size_t ws_size, hipStream_t stream) {
    static int grid = 0;
    if (grid == 0) {
        int dev = 0, cus = 0, per_cu = 0;
        (void)hipGetDevice(&dev);
        (void)hipDeviceGetAttribute(&cus, hipDeviceAttributeMultiprocessorCount, dev);
        (void)hipFuncSetAttribute((const void*)mk_fwd, hipFuncAttributeMaxDynamicSharedMemorySize, LDS_BYTES);
        if (hipOccupancyMaxActiveBlocksPerMultiprocessor(&per_cu, (const void*)mk_fwd, 256, LDS_BYTES) != hipSuccess || per_cu < 1) per_cu = 1;
        (void)hipGetLastError();
        if (per_cu > 2) per_cu = 2;
        grid = cus * per_cu;
        fprintf(stderr, "mk_fwd: cus %d per_cu %d grid %d\n", cus, per_cu, grid);
    }
    Params p{};
    const float** pin = (const float**)&p.x;
    for (int i = 0; i < 18; ++i) pin[i] = (const float*)d_in[i];
    p.out = (float*)d_out;
    char* ws = (char*)d_ws;
    size_t off = 0;
    auto carve = [&](size_t bytes) { void* q = ws + off; off += (bytes + 255) & ~(size_t)255; return q; };
    p.bar = (unsigned*)carve(XCD_BAR_WORDS * 4);
    p.cnt = (int*)carve(4 * 32 * 64 * 4);
    const size_t zero_bytes = off;
    p.Wt_in = (half_t*)carve((size_t)2 * NP * DM * 2);
    p.Wt_o = (half_t*)carve((size_t)2 * DM * DM * 2);
    p.Wt_gu = (half_t*)carve((size_t)2 * 16 * 512 * 1024 * 2);
    p.Wt_d = (half_t*)carve((size_t)2 * 16 * 1024 * 256 * 2);
    p.hn = (half_t*)carve((size_t)T_TOK * DM * 2);
    p.P = (half_t*)carve((size_t)T_TOK * NP * 2);
    p.ycat = (half_t*)carve((size_t)T_TOK * DM * 2);
    p.act = (half_t*)carve((size_t)T_TOK * 512 * 2);
    p.xr = (half_t*)carve((size_t)T_TOK * DM * 2);
    p.modpart = (float*)carve((size_t)8 * 2 * 16 * 6144 * 4);
    p.modf = (float*)carve((size_t)2 * 16 * 6144 * 4);
    p.kmean = (float*)carve((size_t)16 * 6 * 8 * 64 * 4);
    p.rope = (float*)carve((size_t)2048 * 24 * 4);
    p.iwf = (float*)carve((size_t)T_TOK * 4 * 4);
    p.tokw = (float*)carve((size_t)T_TOK * 2 * 4);
    p.dmask = (unsigned*)carve((size_t)T_TOK * 64 * 4);
    p.lists = (int*)carve((size_t)NCLS * T_TOK * 4);
    if (off > ws_size) { fprintf(stderr, "workspace too small: need %zu have %zu\n", off, ws_size); return; }
    (void)hipMemsetAsync(d_ws, 0, zero_bytes, stream);
#if MK_SPLIT
    for (int ph = 0; ph < NPHASE; ++ph) {
        p.ph_lo = ph; p.ph_hi = ph + 1;
        hipLaunchKernelGGL(mk_fwd, dim3(grid), dim3(256), LDS_BYTES, stream, p);
    }
#else
    p.ph_lo = 0; p.ph_hi = NPHASE;
    hipLaunchKernelGGL(mk_fwd, dim3(grid), dim3(256), LDS_BYTES, stream, p);
#endif
}
```

```cpp
#include <hip/hip_runtime.h>
#include <cstdio>
#include <cstdint>

#ifndef MK_SPLIT
#define MK_SPLIT 0
#endif

#define T_TOK 32768
#define DM 1024
#define SEQ 2048
#define INW 2340
#define NP 2432
#define PC_CU 0
#define PC_CG 256
#define PC_DQ 512
#define PC_DK 896
#define PC_DV 960
#define PC_IQ 1024
#define PC_IK 1152
#define PC_IW 1184
#define PC_MQ 1280
#define PC_MK 1664
#define PC_MV 2048
#define LOG_THETA 13.122363377404328f
#define NCLS 24
#define LDS_CTL 73728
#define LDS_BYTES 78336
#define NPHASE 19
#ifndef DUP_SUB
#define DUP_SUB -1
#endif

typedef _Float16 half_t;
typedef _Float16 h8 __attribute__((ext_vector_type(8)));
typedef _Float16 h4 __attribute__((ext_vector_type(4)));
typedef short s4v __attribute__((ext_vector_type(4)));
typedef short s8v __attribute__((ext_vector_type(8)));
typedef float f16v __attribute__((ext_vector_type(16)));
typedef float f4v __attribute__((ext_vector_type(4)));
#define LAS __attribute__((address_space(3)))

struct Params {
    const float *x, *c, *w_ada, *b_ada, *g_mix, *w_in, *w_dw, *b_dw, *ln_g, *ln_b, *w_o, *g_ffn, *w_router, *b_router, *w_gate, *w_up, *w_down, *g_final;
    float* out;
    half_t *Wt_in, *Wt_o, *Wt_gu, *Wt_d, *hn, *P, *ycat, *act, *xr;
    float *modpart, *modf, *kmean, *rope, *iwf, *tokw;
    unsigned* dmask; int* cnt; int* lists; unsigned* bar;
    int ph_lo, ph_hi;
};

#define XB_TMO      128
#define XB_XCNT(j)  (256  + 64 * (j))
#define XB_XSUB(j)  (1280 + 64 * (j))
#define XB_XGEN(j)  (2304 + 64 * (j))
#define XB_TOP      3328
#define XB_TOPGEN   3392
#define XCD_BAR_WORDS 3456
#define XB_SPIN_CAP (1u << 20)
__device__ __forceinline__ unsigned xb_ld(unsigned* p)              { return __hip_atomic_load(p, __ATOMIC_RELAXED, __HIP_MEMORY_SCOPE_AGENT); }
__device__ __forceinline__ unsigned xb_add(unsigned* p, unsigned v) { return __hip_atomic_fetch_add(p, v, __ATOMIC_RELAXED, __HIP_MEMORY_SCOPE_AGENT); }
__device__ __forceinline__ unsigned xb_xcc_id() { return (unsigned)__builtin_amdgcn_s_getreg((3 << 11) | 20) & 0xFu; }
#define XB_SPIN(cond, bar) do { unsigned _sp = 0; while (cond) { __builtin_amdgcn_s_sleep(1); \
    if ((++_sp & 255u) == 0u) { if (xb_ld(&(bar)[XB_TMO])) break; if (_sp > XB_SPIN_CAP) { atomicAdd(&(bar)[XB_TMO], 1u); break; } } } } while (0)
struct XcdBarrier { unsigned* bar; unsigned x; volatile LAS unsigned* st; };
__device__ __forceinline__ XcdBarrier xcd_barrier_post(unsigned* bar, volatile LAS unsigned* st) {
    XcdBarrier b; b.bar = bar; b.x = xb_xcc_id(); b.st = st;
    if (threadIdx.x == 0) (void)xb_add(&bar[XB_XCNT(b.x)], 1u);
    return b;
}
__device__ __forceinline__ void xcd_barrier_complete(unsigned* bar, unsigned x, unsigned& nloc, unsigned& nx) {
    const unsigned G = gridDim.x * gridDim.y * gridDim.z;
    unsigned sum, cnt, mine, sp = 0u;
    for (;;) {
        sum = 0u; cnt = 0u; mine = 0u;
#pragma unroll
        for (unsigned j = 0; j < 16; ++j) { const unsigned c = xb_ld(&bar[XB_XCNT(j)]); sum += c; cnt += (c > 0u) ? 1u : 0u; mine = (j == x) ? c : mine; }
        if (sum == G) break;
        __builtin_amdgcn_s_sleep(1);
        if ((++sp & 255u) == 0u) { if (xb_ld(&bar[XB_TMO])) break; if (sp > XB_SPIN_CAP) { atomicAdd(&bar[XB_TMO], 1u); break; } }
    }
    nloc = mine > 0u ? mine : 1u; nx = cnt > 0u ? cnt : 1u;
}
__device__ __forceinline__ void xcd_barrier(const XcdBarrier& b) {
    asm volatile("s_waitcnt vmcnt(0)" ::: "memory");
    __syncthreads();
    if (threadIdx.x == 0) {
        unsigned* bar = b.bar;
        __builtin_amdgcn_s_waitcnt(0);
        unsigned nloc = b.st[0], nx = b.st[1];
        if (nloc == 0u) { xcd_barrier_complete(bar, b.x, nloc, nx); b.st[0] = nloc; b.st[1] = nx; }
        const unsigned old = xb_add(&bar[XB_XSUB(b.x)], 1u);
        const unsigned gen = old / nloc;
        if (old + 1u == (gen + 1u) * nloc) {
            __builtin_amdgcn_fence(__ATOMIC_RELEASE, "agent");
            asm volatile("s_waitcnt vmcnt(0)" ::: "memory");
            const unsigned og = xb_add(&bar[XB_TOP], 1u);
            const unsigned tg = og / nx;
            if (og + 1u == (tg + 1u) * nx) xb_add(&bar[XB_TOPGEN], 1u);
            else XB_SPIN(xb_ld(&bar[XB_TOPGEN]) == tg, bar);
            __builtin_amdgcn_fence(__ATOMIC_ACQUIRE, "agent");
            xb_add(&bar[XB_XGEN(b.x)], 1u);
            asm volatile("s_waitcnt vmcnt(0)" ::: "memory");
        } else {
            XB_SPIN(xb_ld(&bar[XB_XGEN(b.x)]) == gen, bar);
            __builtin_amdgcn_fence(__ATOMIC_ACQUIRE, "agent");
            asm volatile("s_waitcnt vmcnt(0)" ::: "memory");
        }
    }
    __syncthreads();
}

typedef const __attribute__((address_space(4))) Params* KP;
__device__ __forceinline__ int TID() { int t = threadIdx.x; asm volatile("" : "+v"(t)); return t; }
__device__ __forceinline__ int BID() { int b = blockIdx.x; asm volatile("" : "+s"(b)); return b; }
__device__ __forceinline__ float sigmoidf_(float v) { return __builtin_amdgcn_rcpf(1.0f + __expf(-v)); }
__device__ __forceinline__ void glds16(const void* g, char* l) { __builtin_amdgcn_global_load_lds((const unsigned*)g, (unsigned*)l, 16, 0, 0); }
__device__ __forceinline__ unsigned f2sortable(float f) { unsigned u = __float_as_uint(f); return (u & 0x80000000u) ? ~u : (u | 0x80000000u); }
template <bool HIN> __device__ __forceinline__ float4 ldx4(const void* base, size_t idx) {
    if (HIN) { const h4 t = *(const h4*)((const half_t*)base + idx); return make_float4((float)t[0], (float)t[1], (float)t[2], (float)t[3]); }
    return *(const float4*)((const float*)base + idx);
}
__device__ __forceinline__ h4 pack4(float a, float b, float c, float d) { h4 r = {(half_t)a, (half_t)b, (half_t)c, (half_t)d}; return r; }

template <class CF>
__device__ __forceinline__ void conv_tile_panel(char* lds, CF colf, int src_ld, int k0, int n0, half_t* dst, int nrows) {
    float* tl = (float*)lds;
    const int tid = TID();
    __syncthreads();
    {
        const int nn = tid & 63;
        const float* cp = colf(nn);
        float tv[16];
#pragma unroll
        for (int i = 0; i < 16; ++i) { const int k = i * 4 + (tid >> 6); tv[i] = cp ? cp[(size_t)(k0 + k) * src_ld] : 0.f; }
#pragma unroll
        for (int i = 0; i < 16; ++i) { const int k = i * 4 + (tid >> 6); tl[k * 65 + nn] = tv[i]; }
    }
    __syncthreads();
    {
        const int n = tid >> 2, kq = (tid & 3) * 16;
        h8 a, b;
#pragma unroll
        for (int j = 0; j < 8; ++j) { a[j] = (half_t)tl[(kq + j) * 65 + n]; b[j] = (half_t)tl[(kq + 8 + j) * 65 + n]; }
        const int k = k0 + kq;
        h8* d = (h8*)(dst + ((size_t)(k >> 5) * nrows + n0 + n) * 32 + (k & 31));
        d[0] = a; d[1] = b;
    }
}
template <class CF>
__device__ __forceinline__ void conv_tile(char* lds, CF colf, int src_ld, int k0, half_t* dst_tile  , int dstK) {
    float* tl = (float*)lds;
    const int tid = TID();
    __syncthreads();
    {
        const int nn = tid & 63;
        const float* cp = colf(nn);
        float tv[16];
#pragma unroll
        for (int i = 0; i < 16; ++i) { const int k = i * 4 + (tid >> 6); tv[i] = cp ? cp[(size_t)(k0 + k) * src_ld] : 0.f; }
#pragma unroll
        for (int i = 0; i < 16; ++i) { const int k = i * 4 + (tid >> 6); tl[k * 65 + nn] = tv[i]; }
    }
    __syncthreads();
    {
        const int n = tid >> 2, kq = (tid & 3) * 16;
        h8 a, b;
#pragma unroll
        for (int j = 0; j < 8; ++j) { a[j] = (half_t)tl[(kq + j) * 65 + n]; b[j] = (half_t)tl[(kq + 8 + j) * 65 + n]; }
        h8* d = (h8*)(dst_tile + (size_t)n * dstK + kq);
        d[0] = a; d[1] = b;
    }
}

__device__ __forceinline__ void phase_prologue(KP p, char* lds) {
    const int tid = TID();
    const int NA = 2 * 16 * 38, NB = 2 * 16 * 16, NC = 2 * 16 * 16 * 8, ND = 2 * 16 * 4 * 16, NE = 384, NF = 8;
    const int total = NA + NB + NC + ND + NE + NF;
    for (int u0 = BID(); u0 < total; u0 += gridDim.x) {
        int u = u0;
        if (u < NA) {
            const int nt = u % 38, kt = (u / 38) % 16, l = u / (38 * 16);
            const float* src = p->w_in + (size_t)l * DM * INW;
            const int n0 = nt * 64;
            conv_tile_panel(lds, [&](int nn) -> const float* { const int np = n0 + nn; const int sc = np < 512 ? (((np & 63) < 32) ? 32 * (np >> 6) + (np & 31) : 256 + 32 * (np >> 6) + (np & 31)) : (np < 1188 ? np : (np < 1280 ? -1 : np - 92)); return sc >= 0 ? src + sc : (const float*)nullptr; },
                      INW, kt * 64, n0, p->Wt_in + (size_t)l * NP * DM, NP);
            continue;
        }
        u -= NA;
        if (u < NB) {
            const int nt = u % 16, kt = (u / 16) % 16, l = u / 256;
            const float* src = p->w_o + (size_t)l * DM * DM + nt * 64;
            conv_tile_panel(lds, [&](int nn) -> const float* { return src + nn; }, DM, kt * 64, nt * 64, p->Wt_o + (size_t)l * DM * DM, DM);
            continue;
        }
        u -= NB;
        if (u < NC) {
            const int nt = u % 8, kt = (u / 8) % 16, le = u / 128;
            const float* sg = p->w_gate + (size_t)le * 1024 * 256 + nt * 32;
            const float* su = p->w_up + (size_t)le * 1024 * 256 + nt * 32;
            conv_tile(lds, [&](int nn) -> const float* { return nn < 32 ? sg + nn : su + (nn - 32); }, 256, kt * 64, p->Wt_gu + ((size_t)le * 512 + nt * 64) * 1024 + kt * 64, 1024);
            continue;
        }
        u -= NC;
        if (u < ND) {
            const int nt = u % 16, kt = (u / 16) % 4, le = u / 64;
            const float* src = p->w_down + (size_t)le * 256 * 1024 + nt * 64;
            conv_tile(lds, [&](int nn) -> const float* { return src + nn; }, 1024, kt * 64, p->Wt_d + ((size_t)le * 1024 + nt * 64) * 256 + kt * 64, 256);
            continue;
        }
        u -= ND;
        if (u < NE) {
            const int kc = u % 8, cc = (u / 8) % 24, l = u / 192;
            float* ca = (float*)lds;
            __syncthreads();
            for (int i = tid; i < 2048; i += 256) { const int b = i >> 7, k = i & 127; const float v = p->c[b * 1024 + kc * 128 + k]; ca[i] = v / (1.0f + expf(-v)); }
            __syncthreads();
            const int n = cc * 256 + tid;
            float acc[16];
#pragma unroll
            for (int b = 0; b < 16; ++b) acc[b] = 0.f;
            const float* w = p->w_ada + ((size_t)l * 1024 + kc * 128) * 6144 + n;
#pragma unroll 16
            for (int k = 0; k < 128; ++k) {
                const float wv = w[(size_t)k * 6144];
#pragma unroll
                for (int b = 0; b < 16; ++b) acc[b] = fmaf(ca[b * 128 + k], wv, acc[b]);
            }
#pragma unroll
            for (int b = 0; b < 16; ++b) p->modpart[(((size_t)kc * 2 + l) * 16 + b) * 6144 + n] = acc[b];
            continue;
        }
        u -= NE;
        {
            for (int i = u * 256 + tid; i < 2048 * 12; i += NF * 256) {
                const int t = i / 12, r = i % 12;
                const int fi = r < 8 ? r : r - 8;
                const float rot = r < 8 ? 16.f : 8.f;
                const float inv = expf(-LOG_THETA * ((float)fi * 2.0f / rot));
                const float ang = (float)t * inv;
                float sn, cs; sincosf(ang, &sn, &cs);
                if (r < 8) { p->rope[t * 8 + fi] = cs; p->rope[16384 + t * 8 + fi] = sn; }
                else { p->rope[32768 + t * 4 + fi] = cs; p->rope[32768 + 8192 + t * 4 + fi] = sn; }
            }
        }
    }
}

__device__ __forceinline__ void phase_modsum(KP p) {
    for (int i = BID() * 256 + TID(); i < 2 * 16 * 6144; i += gridDim.x * 256) {
        const int n = i % 6144, l = i / (16 * 6144);
        float s = p->b_ada[l * 6144 + n];
#pragma unroll
        for (int kc = 0; kc < 8; ++kc) s += p->modpart[(size_t)kc * (2 * 16 * 6144) + i];
        p->modf[i] = s;
    }
}

__device__ __forceinline__ void route_flush(KP p, char* lds, int lane, int wave, int n, int myrow, int layer) {
    const float* lg = (const float*)(lds + LDS_CTL + 512) + wave * 256;
    int* lc = (int*)(lds + LDS_CTL + 64);
    int* lbase = lc + 32;
    const int tid = wave * 64 + lane;
    if (tid < 32) lc[tid] = 0;
    __syncthreads();
    int cls = 0, lpos = 0;
    if (lane < n) {
        float aff[16], bia[16];
#pragma unroll
        for (int e = 0; e < 16; ++e) { aff[e] = 1.0f / (1.0f + expf(-lg[lane * 16 + e])); bia[e] = aff[e] + p->b_router[e]; }
        int bestg = 0; float bests = -INFINITY;
#pragma unroll
        for (int gi = 0; gi < 4; ++gi) {
            float m1 = -INFINITY, m2 = -INFINITY;
#pragma unroll
            for (int j = 0; j < 4; ++j) { const float vv = bia[gi * 4 + j]; if (vv > m1) { m2 = m1; m1 = vv; } else if (vv > m2) m2 = vv; }
            const float s = m1 + m2;
            if (s > bests) { bests = s; bestg = gi; }
        }
        float bsel[4], asel[4];
#pragma unroll
        for (int j = 0; j < 4; ++j) { bsel[j] = 0.f; asel[j] = 0.f; }
#pragma unroll
        for (int gi = 0; gi < 4; ++gi) if (gi == bestg) {
#pragma unroll
            for (int j = 0; j < 4; ++j) { bsel[j] = bia[gi * 4 + j]; asel[j] = aff[gi * 4 + j]; }
        }
        int i1 = -1, i2 = -1; float v1 = -INFINITY, v2 = -INFINITY;
#pragma unroll
        for (int j = 0; j < 4; ++j) { const float vv = bsel[j]; if (vv > v1) { v2 = v1; i2 = i1; v1 = vv; i1 = j; } else if (vv > v2) { v2 = vv; i2 = j; } }
        const int a = i1 < i2 ? i1 : i2, bb = i1 < i2 ? i2 : i1;
        float wa = 0.f, wb = 0.f;
#pragma unroll
        for (int j = 0; j < 4; ++j) { if (j == a) wa = asel[j]; if (j == bb) wb = asel[j]; }
        const float sw = wa + wb;
        const int pi = (a == 0) ? (bb - 1) : (a == 1 ? (bb + 1) : 5);
        cls = bestg * 6 + pi;
        *(float2*)(p->tokw + (size_t)myrow * 2) = make_float2(wa / sw, wb / sw);
        lpos = atomicAdd(&lc[cls], 1);
    }
    __syncthreads();
    if (tid < NCLS) { const int c = lc[tid]; lbase[tid] = c ? atomicAdd(&p->cnt[(layer * 32 + tid) * 64], c) : 0; }
    __syncthreads();
    if (lane < n) p->lists[(size_t)cls * T_TOK + lbase[cls] + lpos] = myrow;
}

template <int MODE, bool HIN>
__device__ __forceinline__ void phase_norm(KP p, char* lds, const void* xin, const float* g, const float* sh, const float* sc, int layer) {
    const int lane = TID() & 63, wave = TID() >> 6;
    float* wt = (float*)lds;
    if (MODE == 1) {
        __syncthreads();
        for (int i = TID(); i < 4096; i += 256) {
            const float4 w4 = ((const float4*)p->w_router)[i];
            const int k = i >> 2, e0 = (i & 3) * 4;
            wt[(e0 + 0) * 1024 + k] = w4.x; wt[(e0 + 1) * 1024 + k] = w4.y; wt[(e0 + 2) * 1024 + k] = w4.z; wt[(e0 + 3) * 1024 + k] = w4.w;
        }
        __syncthreads();
    }
    float* lgb = (float*)(lds + LDS_CTL + 512);
    int myrow = 0, it = 0;
    float4 vn[4];
    {
        const int row0 = BID() * 4 + wave;
        const size_t xo = (size_t)(row0 < T_TOK ? row0 : 0) * DM;
#pragma unroll
        for (int i = 0; i < 4; ++i) vn[i] = ldx4<HIN>(xin, xo + (lane + 64 * i) * 4);
    }
    for (int row = BID() * 4 + wave; row < T_TOK; row += gridDim.x * 4) {
        const int b = row >> 11;
        float4 v[4]; float ss = 0.f;
#pragma unroll
        for (int i = 0; i < 4; ++i) v[i] = vn[i];
        {
            const int rown = row + gridDim.x * 4;
            const size_t xo = (size_t)(rown < T_TOK ? rown : row) * DM;
#pragma unroll
            for (int i = 0; i < 4; ++i) vn[i] = ldx4<HIN>(xin, xo + (lane + 64 * i) * 4);
        }
#pragma unroll
        for (int i = 0; i < 4; ++i) ss += v[i].x * v[i].x + v[i].y * v[i].y + v[i].z * v[i].z + v[i].w * v[i].w;
#pragma unroll
        for (int o = 32; o >= 1; o >>= 1) ss += __shfl_xor(ss, o);
        const float rstd = 1.0f / sqrtf(ss * (1.0f / 1024.0f) + 1e-6f);
        float acc[16], ya[16];
#pragma unroll
        for (int i = 0; i < 4; ++i) {
            const int k = (lane + 64 * i) * 4;
            const float4 gg = *(const float4*)(g + k);
            float y[4] = {v[i].x * rstd * gg.x, v[i].y * rstd * gg.y, v[i].z * rstd * gg.z, v[i].w * rstd * gg.w};
            if (MODE != 2) {
                const float4 s1 = *(const float4*)(sh + (size_t)b * 6144 + k), s2 = *(const float4*)(sc + (size_t)b * 6144 + k);
                y[0] = y[0] * (1.f + s2.x) + s1.x; y[1] = y[1] * (1.f + s2.y) + s1.y; y[2] = y[2] * (1.f + s2.z) + s1.z; y[3] = y[3] * (1.f + s2.w) + s1.w;
                if (MODE == 0) *(h4*)(p->hn + ((size_t)(k >> 5) * T_TOK + row) * 32 + (k & 31)) = pack4(y[0], y[1], y[2], y[3]);
                else *(h4*)(p->hn + (size_t)row * DM + k) = pack4(y[0], y[1], y[2], y[3]);
            } else {
                *(float4*)(p->out + (size_t)row * DM + k) = make_float4(y[0], y[1], y[2], y[3]);
            }
            ya[4 * i] = y[0]; ya[4 * i + 1] = y[1]; ya[4 * i + 2] = y[2]; ya[4 * i + 3] = y[3];
        }
        if (MODE == 1) {
#pragma unroll
            for (int e = 0; e < 16; ++e) acc[e] = 0.f;
            float4 wq[2][4];
            const float* wl = wt + lane * 4;
#pragma unroll
            for (int e = 0; e < 4; ++e) wq[0][e] = *(const float4*)(wl + e * 1024);
#pragma unroll
            for (int st = 0; st < 16; ++st) {
                const int i = st >> 2, eg = st & 3, cur = st & 1;
                if (st + 1 < 16) {
                    const int i2 = (st + 1) >> 2, eg2 = (st + 1) & 3;
#pragma unroll
                    for (int e = 0; e < 4; ++e) wq[cur ^ 1][e] = *(const float4*)(wl + (eg2 * 4 + e) * 1024 + i2 * 256);
                }
#pragma unroll
                for (int e = 0; e < 4; ++e) {
                    const float4 w4 = wq[cur][e];
                    acc[eg * 4 + e] = fmaf(ya[4 * i], w4.x, fmaf(ya[4 * i + 1], w4.y, fmaf(ya[4 * i + 2], w4.z, fmaf(ya[4 * i + 3], w4.w, acc[eg * 4 + e]))));
                }
                __builtin_amdgcn_sched_barrier(0);
            }
        }
        if (MODE == 1) {
            const bool b5 = lane & 32, b4 = lane & 16, b3 = lane & 8, b2 = lane & 4;
            float r8[8], r4[4], r2[2];
#pragma unroll
            for (int e = 0; e < 8; ++e) { const float snd = b5 ? acc[e] : acc[e + 8], kp = b5 ? acc[e + 8] : acc[e]; r8[e] = kp + __shfl_xor(snd, 32); }
#pragma unroll
            for (int e = 0; e < 4; ++e) { const float snd = b4 ? r8[e] : r8[e + 4], kp = b4 ? r8[e + 4] : r8[e]; r4[e] = kp + __shfl_xor(snd, 16); }
#pragma unroll
            for (int e = 0; e < 2; ++e) { const float snd = b3 ? r4[e] : r4[e + 2], kp = b3 ? r4[e + 2] : r4[e]; r2[e] = kp + __shfl_xor(snd, 8); }
            float rv; { const float snd = b2 ? r2[0] : r2[1], kp = b2 ? r2[1] : r2[0]; rv = kp + __shfl_xor(snd, 4); }
            rv += __shfl_xor(rv, 2); rv += __shfl_xor(rv, 1);
            if ((lane & 3) == 0) lgb[(wave * 16 + it) * 16 + (lane >> 2)] = rv;
            if (lane == it) myrow = row;
            ++it;
            if (it == 16) { route_flush(p, lds, lane, wave, it, myrow, layer); it = 0; }
        }
    }
    if (MODE == 1 && it > 0) route_flush(p, lds, lane, wave, it, myrow, layer);
}

typedef float f2_t __attribute__((ext_vector_type(2)));
#define NRR 2
__device__ __forceinline__ void phase_norm_router(KP p, char* lds, const half_t* xin, const float* g, const float* sh, const float* sc, int layer) {
    const int lane = TID() & 63, wave = TID() >> 6;
    float* wt = (float*)lds;
    __syncthreads();
    for (int i = TID(); i < 4096; i += 256) {
        const float4 w4 = ((const float4*)p->w_router)[i];
        const int k = i >> 2, e0 = (i & 3) * 4;
        wt[(e0 + 0) * 1024 + k] = w4.x; wt[(e0 + 1) * 1024 + k] = w4.y; wt[(e0 + 2) * 1024 + k] = w4.z; wt[(e0 + 3) * 1024 + k] = w4.w;
    }
    __syncthreads();
    float* lgb = (float*)(lds + LDS_CTL + 512);
    int myrow = 0, it = 0;
    const int rstride = gridDim.x * 4;
    for (int row0 = BID() * 4 + wave; row0 < T_TOK; row0 += rstride * NRR) {
        f2_t ya[NRR / 2][16];
        float ss[NRR];
        int nv = 0;
#pragma unroll
        for (int j = 0; j < NRR; ++j) nv += (row0 + j * rstride < T_TOK) ? 1 : 0;
        {
            float4 v[NRR][4];
#pragma unroll
            for (int j = 0; j < NRR; ++j) {
                const int r = row0 + j * rstride;
                const size_t xo = (size_t)(r < T_TOK ? r : row0) * DM;
#pragma unroll
                for (int i = 0; i < 4; ++i) v[j][i] = ldx4<true>(xin, xo + (lane + 64 * i) * 4);
            }
#pragma unroll
            for (int j = 0; j < NRR; ++j) {
                ss[j] = 0.f;
#pragma unroll
                for (int i = 0; i < 4; ++i) ss[j] += v[j][i].x * v[j][i].x + v[j][i].y * v[j][i].y + v[j][i].z * v[j][i].z + v[j][i].w * v[j][i].w;
            }
#pragma unroll
            for (int o = 32; o >= 1; o >>= 1) {
#pragma unroll
                for (int j = 0; j < NRR; ++j) ss[j] += __shfl_xor(ss[j], o);
            }
#pragma unroll
            for (int j = 0; j < NRR; ++j) ss[j] = 1.0f / sqrtf(ss[j] * (1.0f / 1024.0f) + 1e-6f);
#pragma unroll
            for (int j = 0; j < NRR; ++j) {
                const int r = row0 + j * rstride;
                const int rr = r < T_TOK ? r : row0;
                const int b = rr >> 11;
                const float rs = ss[j];
#pragma unroll
                for (int i = 0; i < 4; ++i) {
                    const int k = (lane + 64 * i) * 4;
                    const float4 gg = *(const float4*)(g + k);
                    const float4 s1 = *(const float4*)(sh + (size_t)b * 6144 + k), s2 = *(const float4*)(sc + (size_t)b * 6144 + k);
                    const float y0 = v[j][i].x * rs * gg.x * (1.f + s2.x) + s1.x, y1 = v[j][i].y * rs * gg.y * (1.f + s2.y) + s1.y;
                    const float y2 = v[j][i].z * rs * gg.z * (1.f + s2.z) + s1.z, y3 = v[j][i].w * rs * gg.w * (1.f + s2.w) + s1.w;
                    if (r < T_TOK) *(h4*)(p->hn + (size_t)r * DM + k) = pack4(y0, y1, y2, y3);
                    if (j & 1) { ya[j >> 1][4 * i].y = y0; ya[j >> 1][4 * i + 1].y = y1; ya[j >> 1][4 * i + 2].y = y2; ya[j >> 1][4 * i + 3].y = y3; }
                    else       { ya[j >> 1][4 * i].x = y0; ya[j >> 1][4 * i + 1].x = y1; ya[j >> 1][4 * i + 2].x = y2; ya[j >> 1][4 * i + 3].x = y3; }
                }
                __builtin_amdgcn_sched_barrier(0);
            }
        }
        f2_t acc[NRR / 2][16];
#pragma unroll
        for (int e = 0; e < 16; ++e) {
#pragma unroll
            for (int jp = 0; jp < NRR / 2; ++jp) acc[jp][e] = (f2_t){0.f, 0.f};
        }
        {
            float4 wq[2][4];
            const float* wl = wt + lane * 4;
#pragma unroll
            for (int e = 0; e < 4; ++e) wq[0][e] = *(const float4*)(wl + e * 1024);
#pragma unroll
            for (int st = 0; st < 16; ++st) {
                const int i = st >> 2, eg = st & 3, cur = st & 1;
                if (st + 1 < 16) {
                    const int i2 = (st + 1) >> 2, eg2 = (st + 1) & 3;
#pragma unroll
                    for (int e = 0; e < 4; ++e) wq[cur ^ 1][e] = *(const float4*)(wl + (eg2 * 4 + e) * 1024 + i2 * 256);
                }
#pragma unroll
                for (int e = 0; e < 4; ++e) {
                    const float4 w4 = wq[cur][e];
#pragma unroll
                    for (int jp = 0; jp < NRR / 2; ++jp) {
                        f2_t a = acc[jp][eg * 4 + e];
                        a = ya[jp][4 * i + 3] * (f2_t){w4.w, w4.w} + a;
                        a = ya[jp][4 * i + 2] * (f2_t){w4.z, w4.z} + a;
                        a = ya[jp][4 * i + 1] * (f2_t){w4.y, w4.y} + a;
                        a = ya[jp][4 * i] * (f2_t){w4.x, w4.x} + a;
                        acc[jp][eg * 4 + e] = a;
                    }
                }
                __builtin_amdgcn_sched_barrier(0);
            }
        }
        const bool b5 = lane & 32, b4 = lane & 16, b3 = lane & 8, b2 = lane & 4;
#pragma unroll
        for (int j = 0; j < NRR; ++j) {
            float r8[8], r4[4], r2[2];
#pragma unroll
            for (int e = 0; e < 8; ++e) {
                const float lo = (j & 1) ? acc[j >> 1][e].y : acc[j >> 1][e].x, hi = (j & 1) ? acc[j >> 1][e + 8].y : acc[j >> 1][e + 8].x;
                const float snd = b5 ? lo : hi, kp = b5 ? hi : lo; r8[e] = kp + __shfl_xor(snd, 32);
            }
#pragma unroll
            for (int e = 0; e < 4; ++e) { const float snd = b4 ? r8[e] : r8[e + 4], kp = b4 ? r8[e + 4] : r8[e]; r4[e] = kp + __shfl_xor(snd, 16); }
#pragma unroll
            for (int e = 0; e < 2; ++e) { const float snd = b3 ? r4[e] : r4[e + 2], kp = b3 ? r4[e + 2] : r4[e]; r2[e] = kp + __shfl_xor(snd, 8); }
            float rv; { const float snd = b2 ? r2[0] : r2[1], kp = b2 ? r2[1] : r2[0]; rv = kp + __shfl_xor(snd, 4); }
            rv += __shfl_xor(rv, 2); rv += __shfl_xor(rv, 1);
            if (j < nv) {
                if ((lane & 3) == 0) lgb[(wave * 16 + it) * 16 + (lane >> 2)] = rv;
                if (lane == it) myrow = row0 + j * rstride;
                ++it;
            }
        }
        if (it == 16) { route_flush(p, lds, lane, wave, it, myrow, layer); it = 0; }
    }
    if (it > 0) route_flush(p, lds, lane, wave, it, myrow, layer);
}

template <class WF, class XF, class EPI>
__device__ __forceinline__ void gemm_tile(char* lds, int nkt, WF wf, XF xf, EPI epi) {
    const int tid = TID(), lane = tid & 63, wave = tid >> 6;
    const int wn = wave & 1, wm = wave >> 1, hh = lane >> 5;
    const int lrow = tid >> 3;
    const int lchunk = (tid & 7) ^ ((tid >> 4) & 7);
    const half_t* xs[4];
#pragma unroll
    for (int i = 0; i < 4; ++i) xs[i] = xf(lrow + 32 * i) + lchunk * 8;
    char* ldst = lds + lrow * 128 + (tid & 7) * 16;
    f16v acc[2][2];
#pragma unroll
    for (int i = 0; i < 2; ++i)
#pragma unroll
        for (int j = 0; j < 2; ++j)
#pragma unroll
            for (int r = 0; r < 16; ++r) acc[i][j][r] = 0.f;
    auto issue = [&](int kt, int s) {
        char* d = ldst + s * 32768;
#pragma unroll
        for (int i = 0; i < 4; ++i) glds16(wf(kt, lrow + 32 * i) + lchunk * 8, d + i * 4096);
#pragma unroll
        for (int i = 0; i < 4; ++i) glds16(xs[i] + kt * 64, d + 16384 + i * 4096);
    };
    __syncthreads();
    issue(0, 0);
    const int rsw = (lane >> 1) & 7;
    const int roff_w = (wn * 64 + (lane & 31)) * 128, roff_x = 16384 + (wm * 64 + (lane & 31)) * 128;
    for (int kt = 0; kt < nkt; ++kt) {
        asm volatile("s_waitcnt vmcnt(0)" ::: "memory");
        __syncthreads();
        if (kt + 1 < nkt) issue(kt + 1, (kt + 1) & 1);
        const char* base = lds + (kt & 1) * 32768;
#pragma unroll
        for (int ks = 0; ks < 4; ++ks) {
            const int co = ((2 * ks + hh) ^ rsw) << 4;
            const h8 a0 = *(const h8*)(base + roff_w + co), a1 = *(const h8*)(base + roff_w + 4096 + co);
            const h8 b0 = *(const h8*)(base + roff_x + co), b1 = *(const h8*)(base + roff_x + 4096 + co);
            acc[0][0] = __builtin_amdgcn_mfma_f32_32x32x16_f16(a0, b0, acc[0][0], 0, 0, 0);
            acc[0][1] = __builtin_amdgcn_mfma_f32_32x32x16_f16(a0, b1, acc[0][1], 0, 0, 0);
            acc[1][0] = __builtin_amdgcn_mfma_f32_32x32x16_f16(a1, b0, acc[1][0], 0, 0, 0);
            acc[1][1] = __builtin_amdgcn_mfma_f32_32x32x16_f16(a1, b1, acc[1][1], 0, 0, 0);
        }
    }
    epi(acc, wn, wm, lane);
}

template <class WF, class XF, class EPI>
__device__ __forceinline__ void gemm_tile2(char* lds, int nkt, size_t xkstride, WF wf, XF xf, EPI epi) {
    const int tid = TID(), lane = tid & 63, wave = tid >> 6;
    const int wn = wave & 1, wm = wave >> 1, hh = lane >> 5;
    const int lrow = tid >> 2;
    const int lchunk = (tid & 3) ^ ((tid >> 4) & 3);
    const half_t* xs[2];
#pragma unroll
    for (int i = 0; i < 2; ++i) xs[i] = xf(lrow + 64 * i) + lchunk * 8;
    char* ldst = lds + lrow * 64 + (tid & 3) * 16;
    f16v acc[4][2];
#pragma unroll
    for (int i = 0; i < 4; ++i)
#pragma unroll
        for (int j = 0; j < 2; ++j)
#pragma unroll
            for (int r = 0; r < 16; ++r) acc[i][j][r] = 0.f;
    auto issue = [&](int kt, int s) {
        char* d = ldst + s * 24576;
#pragma unroll
        for (int i = 0; i < 4; ++i) glds16(wf(kt, lrow + 64 * i) + lchunk * 8, d + i * 4096);
#pragma unroll
        for (int i = 0; i < 2; ++i) glds16(xs[i] + (size_t)kt * xkstride, d + 16384 + i * 4096);
    };
    __syncthreads();
    issue(0, 0); issue(1, 1);
    const int rsw = (lane >> 2) & 3;
    const int roff_w = (wn * 128 + (lane & 31)) * 64, roff_x = 16384 + (wm * 64 + (lane & 31)) * 64;
    int st = 0;
    for (int kt = 0; kt < nkt; ++kt) {
        if (kt + 1 < nkt) asm volatile("s_waitcnt vmcnt(6)" ::: "memory");
        else asm volatile("s_waitcnt vmcnt(0)" ::: "memory");
        asm volatile("s_waitcnt lgkmcnt(0)" ::: "memory");
        __builtin_amdgcn_s_barrier();
        if (kt + 2 < nkt) issue(kt + 2, st >= 1 ? st - 1 : 2);
        const char* base = lds + st * 24576;
        st = st == 2 ? 0 : st + 1;
#pragma unroll
        for (int ks = 0; ks < 2; ++ks) {
            const int co = ((2 * ks + hh) ^ rsw) << 4;
            h8 a[4], b[2];
#pragma unroll
            for (int i = 0; i < 4; ++i) a[i] = *(const h8*)(base + roff_w + i * 2048 + co);
#pragma unroll
            for (int j = 0; j < 2; ++j) b[j] = *(const h8*)(base + roff_x + j * 2048 + co);
#pragma unroll
            for (int i = 0; i < 4; ++i)
#pragma unroll
                for (int j = 0; j < 2; ++j) acc[i][j] = __builtin_amdgcn_mfma_f32_32x32x16_f16(a[i], b[j], acc[i][j], 0, 0, 0);
        }
    }
    epi(acc, wn, wm, lane);
}

__device__ __forceinline__ void phase_inproj(KP p, char* lds, int l) {
    const half_t* W = p->Wt_in + (size_t)l * NP * DM;
    const float* rc16 = p->rope; const float* rs16 = p->rope + 16384; const float* rc8 = p->rope + 32768; const float* rs8 = p->rope + 32768 + 8192;
    for (int u = BID(); u < 256 * 10; u += gridDim.x) {
        const int xl = u & 7, Lx = u >> 3, mi = Lx & 15, rr_ = Lx >> 4;
        const int nt = rr_ % 10, mt = 32 * xl + 16 * (rr_ / 10) + mi;
        gemm_tile2(lds, 32, (size_t)T_TOK * 32,
            [&](int kt, int row) { int n = nt * 256 + row; n = n < NP ? n : NP - 1; return W + ((size_t)kt * NP + n) * 32; },
            [&](int row) { return p->hn + (size_t)(mt * 128 + row) * 32; },
            [&](f16v (&acc)[4][2], int wn, int wm, int lane) {
                const int hh = lane >> 5;
                half_t* stg = (half_t*)lds;
                __syncthreads();
#pragma unroll
                for (int i = 0; i < 4; ++i) {
                    const int nb = nt * 256 + wn * 128 + i * 32;
                    if (nb == 1216 || nb == 1248 || nb >= NP) continue;
                    if (nt < 2) {
                        if (i & 1) continue;
#pragma unroll
                        for (int j = 0; j < 2; ++j) {
                            half_t* dst = stg + (wm * 64 + j * 32 + (lane & 31)) * 260 + wn * 64 + (i >> 1) * 32 + 4 * hh;
#pragma unroll
                            for (int g = 0; g < 4; ++g) {
                                float a4[4];
#pragma unroll
                                for (int r = 0; r < 4; ++r) a4[r] = acc[i][j][4 * g + r] * sigmoidf_(acc[i + 1][j][4 * g + r]);
                                *(h4*)(dst + 8 * g) = pack4(a4[0], a4[1], a4[2], a4[3]);
                            }
                        }
                        continue;
                    }
                    const bool rope64 = ((nb >= PC_DQ && nb < PC_DV) || (nb >= PC_MQ && nb < PC_MV)) && ((nb & 63) == 0);
                    const bool rope32 = (nb >= PC_IQ && nb < PC_IW);
#pragma unroll
                    for (int j = 0; j < 2; ++j) {
                        const int tok = mt * 128 + wm * 64 + j * 32 + (lane & 31);
                        const int t = tok & 2047;
                        f16v v = acc[i][j];
                        if (nb == PC_IW) { if (hh == 0) *(float4*)(p->iwf + (size_t)tok * 4) = make_float4(v[0], v[1], v[2], v[3]); continue; }
                        if (rope64) {
                            const float4 c4 = *(const float4*)(rc16 + t * 8 + 4 * hh), s4 = *(const float4*)(rs16 + t * 8 + 4 * hh);
                            const float cc[4] = {c4.x, c4.y, c4.z, c4.w}, sn[4] = {s4.x, s4.y, s4.z, s4.w};
#pragma unroll
                            for (int r = 0; r < 4; ++r) { const float x1 = v[r], x2 = v[r + 4]; v[r] = x1 * cc[r] - x2 * sn[r]; v[r + 4] = x2 * cc[r] + x1 * sn[r]; }
                        } else if (rope32) {
                            const float4 c4 = *(const float4*)(rc8 + t * 4), s4 = *(const float4*)(rs8 + t * 4);
                            const float cc[4] = {c4.x, c4.y, c4.z, c4.w}, sn[4] = {s4.x, s4.y, s4.z, s4.w};
#pragma unroll
                            for (int r = 0; r < 4; ++r) { const float o = __shfl_xor(v[r], 32); v[r] = hh ? (v[r] * cc[r] + o * sn[r]) : (v[r] * cc[r] - o * sn[r]); }
                        }
                        if ((nb >= PC_DQ && nb < PC_DK) || (nb >= PC_MQ && nb < PC_MK)) {
#pragma unroll
                            for (int r = 0; r < 16; ++r) v[r] *= 0.18033688011112042f;
                        }
                        half_t* dst = stg + (wm * 64 + j * 32 + (lane & 31)) * 260 + wn * 128 + i * 32 + 4 * hh;
#pragma unroll
                        for (int g = 0; g < 4; ++g) *(h4*)(dst + 8 * g) = pack4(v[4 * g], v[4 * g + 1], v[4 * g + 2], v[4 * g + 3]);
                    }
                }
                __syncthreads();
                const int wv_ = TID() >> 6;
#pragma unroll 4
                for (int it = 0; it < 32; ++it) {
                    const int row = it * 4 + wv_;
                    const uint2 v2 = *(const uint2*)(stg + row * 260 + lane * 4);
                    if (nt < 2) { if (lane < 32) *(uint2*)(p->P + (size_t)(mt * 128 + row) * NP + nt * 128 + lane * 4) = v2; }
                    else { const int n = nt * 256 + lane * 4; if (n < NP) *(uint2*)(p->P + (size_t)(mt * 128 + row) * NP + n) = v2; }
                }
            });
    }
}

__device__ __forceinline__ void stage_acc_f32(char* lds, const f16v (&acc)[2][2], int wn, int wm, int lane) {
    float* stg = (float*)lds;
    const int hh = lane >> 5;
    __syncthreads();
#pragma unroll
    for (int j = 0; j < 2; ++j)
#pragma unroll
        for (int i = 0; i < 2; ++i)
#pragma unroll
            for (int g = 0; g < 4; ++g)
                *(float4*)(stg + (wm * 64 + j * 32 + (lane & 31)) * 132 + wn * 64 + i * 32 + 4 * hh + 8 * g) = make_float4(acc[i][j][4 * g], acc[i][j][4 * g + 1], acc[i][j][4 * g + 2], acc[i][j][4 * g + 3]);
    __syncthreads();
}
template <bool HIN>
__device__ __forceinline__ void phase_outproj(KP p, char* lds, int l, const void* xin) {
    const half_t* W = p->Wt_o + (size_t)l * DM * DM;
    const float* g1 = p->modf + (size_t)l * 16 * 6144 + 2 * 1024;
    for (int u = BID(); u < 256 * 4; u += gridDim.x) {
        const int xl = u & 7, Lx = u >> 3, mi = Lx & 7, rr_ = Lx >> 3;
        const int nt = rr_ & 3, mt = 32 * xl + 8 * (rr_ >> 2) + mi;
        gemm_tile2(lds, 32, (size_t)T_TOK * 32,
            [&](int kt, int row) { return W + ((size_t)kt * DM + nt * 256 + row) * 32; },
            [&](int row) { return p->ycat + (size_t)(mt * 128 + row) * 32; },
            [&](f16v (&acc)[4][2], int wn, int wm, int lane) {
                const int hh = lane >> 5, tid = TID();
                float* stg = (float*)lds;
#pragma unroll
                for (int rnd = 0; rnd < 2; ++rnd) {
                    __syncthreads();
                    if (wm == rnd) {
#pragma unroll
                        for (int j = 0; j < 2; ++j)
#pragma unroll
                            for (int i = 0; i < 4; ++i)
#pragma unroll
                                for (int g = 0; g < 4; ++g)
                                    *(float4*)(stg + (j * 32 + (lane & 31)) * 260 + wn * 128 + i * 32 + 4 * hh + 8 * g) = make_float4(acc[i][j][4 * g], acc[i][j][4 * g + 1], acc[i][j][4 * g + 2], acc[i][j][4 * g + 3]);
                    }
                    __syncthreads();
#pragma unroll 4
                    for (int it = 0; it < 16; ++it) {
                        const int idx = it * 256 + tid, row = idx >> 6, c = idx & 63;
                        const int tok = mt * 128 + rnd * 64 + row, n = nt * 256 + 4 * c;
                        const float4 a4 = *(const float4*)(stg + row * 260 + 4 * c);
                        const float4 xi = ldx4<HIN>(xin, (size_t)tok * DM + n);
                        const float4 gg = *(const float4*)(g1 + (size_t)(tok >> 11) * 6144 + n);
                        *(h4*)(p->xr + (size_t)tok * DM + n) = pack4(xi.x + gg.x * a4.x, xi.y + gg.y * a4.y, xi.z + gg.z * a4.z, xi.w + gg.w * a4.w);
                    }
                }
            });
    }
}

struct MoeTab { int tb, nt, nc; };
__device__ __forceinline__ MoeTab moe_table(const int* cnt) {
    const int c = TID() & 31;
    MoeTab t;
    t.nc = (c < NCLS) ? cnt[c * 64] : 0;
    t.nt = (t.nc + 127) >> 7;
    int incl = t.nt;
#pragma unroll
    for (int o = 1; o < 32; o <<= 1) { const int v = __shfl_up(incl, o, 32); if (c >= o) incl += v; }
    t.tb = incl - t.nt;
    return t;
}
__device__ __forceinline__ bool moe_tile(const MoeTab& t, int tile, int& cls, int& pos0, int& n) {
    const unsigned long long m = __ballot(tile >= t.tb && tile < t.tb + t.nt);
    if (m == 0ull) return false;
    cls = __ffsll((long long)m) - 1;
    pos0 = (tile - __builtin_amdgcn_readlane(t.tb, cls)) * 128;
    n = __builtin_amdgcn_readlane(t.nc, cls);
    return true;
}
__device__ __forceinline__ void cls_experts(int cls, int& e1, int& e2) {
    const int g = cls / 6, pi = cls % 6;
    const int a = pi < 3 ? 0 : (pi < 5 ? 1 : 2);
    const int b = pi < 3 ? pi + 1 : (pi < 5 ? pi - 1 : 3);
    e1 = g * 4 + a; e2 = g * 4 + b;
}
__device__ __forceinline__ void phase_moe_up(KP p, char* lds, int l) {
    const MoeTab tab = moe_table(p->cnt + l * 32 * 64);
    for (int u = BID(); u < (256 + NCLS) * 8; u += gridDim.x) {
        const int xl = u & 7, Lx = u >> 3;
        const int nt = Lx & 7, tile = (Lx >> 3) * 8 + xl;
        int cls, pos0, nc;
        if (!moe_tile(tab, tile, cls, pos0, nc)) continue;
        int e1, e2; cls_experts(cls, e1, e2);
        const int slot = nt >> 2;
        const half_t* W = p->Wt_gu + ((size_t)(l * 16 + (slot ? e2 : e1)) * 512 + (nt & 3) * 128) * 1024;
        const int* lst = p->lists + (size_t)cls * T_TOK + pos0;
        const int nvalid = nc - pos0;
        int tokE[2]; float wgtE[2];
        {
            const int lane_ = TID() & 63, wm_ = TID() >> 7;
#pragma unroll
            for (int j = 0; j < 2; ++j) {
                const int row = wm_ * 64 + j * 32 + (lane_ & 31);
                tokE[j] = lst[row < nvalid ? row : 0];
                wgtE[j] = p->tokw[(size_t)tokE[j] * 2 + slot];
            }
        }
        gemm_tile(lds, 16,
            [&](int kt, int row) { return W + (size_t)row * 1024 + kt * 64; },
            [&](int row) { const int tok = lst[row < nvalid ? row : 0]; return p->hn + (size_t)tok * DM; },
            [&](f16v (&acc)[2][2], int wn, int wm, int lane) {
                const int hh = lane >> 5;
#pragma unroll
                for (int j = 0; j < 2; ++j) {
                    const int row = wm * 64 + j * 32 + (lane & 31);
                    if (row < nvalid) {
                        const int tok = tokE[j];
                        const float wgt = wgtE[j];
                        half_t* dst = p->act + (size_t)tok * 512 + slot * 256 + ((nt & 3) * 2 + wn) * 32 + 4 * hh;
#pragma unroll
                        for (int g = 0; g < 4; ++g) {
                            float a[4];
#pragma unroll
                            for (int r = 0; r < 4; ++r) { const float gv = acc[0][j][4 * g + r], uv = acc[1][j][4 * g + r]; a[r] = gv * sigmoidf_(gv) * uv * wgt; }
                            *(h4*)(dst + 8 * g) = pack4(a[0], a[1], a[2], a[3]);
                        }
                    }
                }
            });
    }
}
__device__ __forceinline__ void phase_moe_down(KP p, char* lds, int l, float gsc) {
    const MoeTab tab = moe_table(p->cnt + l * 32 * 64);
    const float* g2 = p->modf + (size_t)l * 16 * 6144 + 5 * 1024;
    for (int u = BID(); u < (256 + NCLS) * 8; u += gridDim.x) {
        const int xl = u & 7, Lx = u >> 3;
        const int nt = Lx & 7, tile = (Lx >> 3) * 8 + xl;
        int cls, pos0, nc;
        if (!moe_tile(tab, tile, cls, pos0, nc)) continue;
        int e1, e2; cls_experts(cls, e1, e2);
        const half_t* W1 = p->Wt_d + ((size_t)(l * 16 + e1) * 1024 + nt * 128) * 256;
        const half_t* W2 = p->Wt_d + ((size_t)(l * 16 + e2) * 1024 + nt * 128) * 256;
        const int* lst = p->lists + (size_t)cls * T_TOK + pos0;
        const int nvalid = nc - pos0;
        int tokS[8];
        {
            const int r0 = TID() >> 4;
#pragma unroll
            for (int it = 0; it < 8; ++it) { const int row = it * 16 + r0; tokS[it] = lst[row < nvalid ? row : 0]; }
        }
        gemm_tile(lds, 8,
            [&](int kt, int row) { return (kt < 4 ? W1 : W2) + (size_t)row * 256 + (kt & 3) * 64; },
            [&](int row) { const int tok = lst[row < nvalid ? row : 0]; return p->act + (size_t)tok * 512; },
            [&](f16v (&acc)[2][2], int wn, int wm, int lane) {
                const int hh = lane >> 5, tid = TID();
                float* stg = (float*)lds;
                __syncthreads();
#pragma unroll
                for (int j = 0; j < 2; ++j)
#pragma unroll
                    for (int i = 0; i < 2; ++i)
#pragma unroll
                        for (int g = 0; g < 4; ++g)
                            *(float4*)(stg + (wm * 64 + j * 32 + (lane & 31)) * 132 + wn * 64 + i * 32 + 8 * g + 4 * hh) =
                                make_float4(acc[i][j][4 * g], acc[i][j][4 * g + 1], acc[i][j][4 * g + 2], acc[i][j][4 * g + 3]);
                __syncthreads();
                const int r0 = tid >> 4, c8 = (tid & 15) * 8;
#pragma unroll
                for (int it = 0; it < 8; ++it) {
                    const int row = it * 16 + r0;
                    if (row < nvalid) {
                        const int tok = tokS[it];
                        const int n = nt * 128 + c8;
                        const float* gp = g2 + (size_t)(tok >> 11) * 6144 + n;
                        const float4 a0 = *(const float4*)(stg + row * 132 + c8), a1 = *(const float4*)(stg + row * 132 + c8 + 4);
                        const float4 g0 = *(const float4*)gp, g1 = *(const float4*)(gp + 4);
                        h8* xp = (h8*)(p->xr + (size_t)tok * DM + n);
                        const h8 xi = *xp;
                        h8 o;
                        o[0] = (half_t)((float)xi[0] + gsc * g0.x * a0.x); o[1] = (half_t)((float)xi[1] + gsc * g0.y * a0.y);
                        o[2] = (half_t)((float)xi[2] + gsc * g0.z * a0.z); o[3] = (half_t)((float)xi[3] + gsc * g0.w * a0.w);
                        o[4] = (half_t)((float)xi[4] + gsc * g1.x * a1.x); o[5] = (half_t)((float)xi[5] + gsc * g1.y * a1.y);
                        o[6] = (half_t)((float)xi[6] + gsc * g1.z * a1.z); o[7] = (half_t)((float)xi[7] + gsc * g1.w * a1.w);
                        *xp = o;
                    }
                }
            });
    }
}

__device__ __forceinline__ void dsa_select_unit(KP p, char* lds, int b, int qt) {
    unsigned* hist = (unsigned*)lds;
    unsigned* maskl = hist + 16 * 257 + 16;
    unsigned* stP = maskl + 1024;
    unsigned* stNeed = stP + 16;
    unsigned* stDone = stNeed + 16;
    unsigned* flag = stDone + 16;
    unsigned* dummyb = flag + 16;
    const int tid = TID(), lane = tid & 63, wave = tid >> 6;
    const int q0 = qt * 16, tokbase = b * SEQ;
    __syncthreads();
    if (q0 < 256) {
        for (int i = tid; i < 1024; i += 256) {
            const int q = i >> 6, wd = i & 63;
            const int n = q0 + q + 1 - 32 * wd;
            const unsigned w = n >= 32 ? 0xFFFFFFFFu : (n <= 0 ? 0u : ((1u << n) - 1u));
            p->dmask[(size_t)(tokbase + q0 + q) * 64 + wd] = w;
        }
        return;
    }
    for (int i = tid; i < 1024; i += 256) maskl[i] = 0u;
    if (tid < 16) { stP[tid] = 0u; stNeed[tid] = 256u; stDone[tid] = 0u; }
    for (int i = tid; i < 16 * 257; i += 256) hist[i] = 0u;
    __syncthreads();
    const int ql = lane & 15, fq = lane >> 4;
    const int tq = q0 + ql;
    const half_t* Pb = p->P + (size_t)tokbase * NP;
    h8 iqf[4];
#pragma unroll
    for (int hd = 0; hd < 4; ++hd) iqf[hd] = *(const h8*)(Pb + (size_t)tq * NP + PC_IQ + hd * 32 + 8 * fq);
    const float4 iw4 = *(const float4*)(p->iwf + (size_t)(tokbase + tq) * 4);
    const float wsc0 = iw4.x * 0.08838834764831845f, wsc1 = iw4.y * 0.08838834764831845f, wsc2 = iw4.z * 0.08838834764831845f, wsc3 = iw4.w * 0.08838834764831845f;
    const int ng = qt + 1;
    unsigned sc[32][4];
    const half_t* ikp = Pb + (size_t)ql * NP + PC_IK + 8 * fq;
#pragma unroll
    for (int gb = 0; gb < 4; ++gb) {
        h8 ik[8];
#pragma unroll
        for (int x = 0; x < 8; ++x) {
            int g = wave + 4 * (gb * 8 + x);
            g = g < ng ? g : ng - 1;
            ik[x] = *(const h8*)(ikp + (size_t)(16 * g) * NP);
        }
#pragma unroll
        for (int x = 0; x < 8; ++x) {
            const int gi = gb * 8 + x;
            const int g = wave + 4 * gi;
            const f4v z = {0.f, 0.f, 0.f, 0.f};
            const f4v c0 = __builtin_amdgcn_mfma_f32_16x16x32_f16(ik[x], iqf[0], z, 0, 0, 0);
            const f4v c1 = __builtin_amdgcn_mfma_f32_16x16x32_f16(ik[x], iqf[1], z, 0, 0, 0);
            const f4v c2 = __builtin_amdgcn_mfma_f32_16x16x32_f16(ik[x], iqf[2], z, 0, 0, 0);
            const f4v c3 = __builtin_amdgcn_mfma_f32_16x16x32_f16(ik[x], iqf[3], z, 0, 0, 0);
#pragma unroll
            for (int r = 0; r < 4; ++r) {
                const int j = 16 * g + 4 * fq + r;
                float sv = wsc0 * __builtin_amdgcn_fmed3f(c0[r], 0.f, INFINITY);
                sv = fmaf(wsc1, __builtin_amdgcn_fmed3f(c1[r], 0.f, INFINITY), sv);
                sv = fmaf(wsc2, __builtin_amdgcn_fmed3f(c2[r], 0.f, INFINITY), sv);
                sv = fmaf(wsc3, __builtin_amdgcn_fmed3f(c3[r], 0.f, INFINITY), sv);
                sv += 0.0f;
                const int sb = __float_as_int(sv);
                const unsigned su = (unsigned)sb ^ ((unsigned)(sb >> 31) | 0x80000000u);
                const unsigned ck = (su & 0xFFFFF800u) | (unsigned)(2047 - j);
                sc[gi][r] = (g < ng && j <= tq) ? ck : 0u;
            }
            if (g < ng) {
#pragma unroll
                for (int r = 0; r < 4; ++r) atomicAdd(hist + ql * 257 + (sc[gi][r] >> 24), 1u);
            }
        }
    }
    bool alldone = false;
    for (int pass = 0; pass < 5; ++pass) {
        const bool fin = alldone;
        if (!fin && pass > 0) { for (int i = tid; i < 16 * 257; i += 256) hist[i] = 0u; }
        if (tid == 0) *flag = 0u;
        __syncthreads();
        if (pass > 0) {
        const unsigned sP = stP[ql], sDone = stDone[ql];
        int wv = wave, fqv = fq;
        asm volatile("" : "+v"(wv), "+v"(fqv));
        if (fin) {
            const int sh = (int)(32u - 8u * (sDone ? sDone : 1u));
            unsigned* mrow = maskl + ql * 64;
#pragma unroll
            for (int gi = 0; gi < 32; ++gi) {
                const int g = wv + 4 * gi;
                unsigned nib = 0u;
#pragma unroll
                for (int r = 0; r < 4; ++r) {
                    const unsigned uu = sc[gi][r];
                    nib |= ((uu >> sh) >= sP) ? (1u << r) : 0u;
                }
                if (g < ng) atomicOr(&mrow[g >> 1], nib << ((g & 1) * 16 + 4 * fqv));
            }
        } else {
            const int shm = pass ? 32 - 8 * pass : 0, shd = 24 - 8 * pass;
            const unsigned orm = pass ? 0u : 0xFFFFFFFFu;
            const unsigned cmpv = pass ? (sDone == 0u ? sP : 0xFFFFFFFFu) : 0xFFFFFFFFu;
            unsigned* hrow = hist + ql * 257;
            unsigned* dummy = dummyb + lane;
#pragma unroll
            for (int gi = 0; gi < 32; ++gi) {
                const int g = wv + 4 * gi;
                if (g < ng) {
#pragma unroll
                    for (int r = 0; r < 4; ++r) {
                        const unsigned uu = sc[gi][r];
                        const bool match = (((uu >> shm) | orm) == cmpv);
                        const unsigned dig = (uu >> shd) & 255u;
                        unsigned* a = match ? hrow + dig : dummy;
                        atomicAdd(a, 1u);
                    }
                }
            }
        }
        }
        __syncthreads();
        if (fin) break;
        {
            const int qq = tid >> 4, seg = tid & 15;
            const bool active = (stDone[qq] == 0u);
            unsigned c16 = 0u;
            if (active) {
#pragma unroll
                for (int d = 0; d < 16; ++d) c16 += hist[qq * 257 + seg * 16 + d];
            }
            unsigned v = c16;
#pragma unroll
            for (int off = 1; off < 16; off <<= 1) { const unsigned t = __shfl_down(v, off, 16); if (seg + off < 16) v += t; }
            const unsigned suf = v - c16;
            const unsigned need = stNeed[qq];
            if (active && suf < need && need <= suf + c16) {
                unsigned run = suf, D = 0u, cD = 0u, nn = need;
                for (int d = 15; d >= 0; --d) {
                    const unsigned cc = hist[qq * 257 + seg * 16 + d];
                    if (run + cc >= need) { D = (unsigned)(seg * 16 + d); cD = cc; nn = need - run; break; }
                    run += cc;
                }
                const bool done = (cD == nn) || pass == 3;
                stP[qq] = (stP[qq] << 8) | D; stNeed[qq] = nn;
                if (done) stDone[qq] = (unsigned)(pass + 1); else atomicAdd(flag, 1u);
            }
        }
        __syncthreads();
        alldone = (*flag == 0u);
    }
    for (int i = tid; i < 1024; i += 256) p->dmask[(size_t)(tokbase + q0 + (i >> 6)) * 64 + (i & 63)] = maskl[i];
}

__device__ __forceinline__ void conv_unit(KP p, char* lds, int l, int b, int c) {
    float* red = (float*)lds;
    const int ch = TID(), lane = ch & 63, wave = ch >> 6;
    const int t0 = c * 32, tokbase = b * SEQ;
    float aw[62];
#pragma unroll
    for (int rr = 0; rr < 62; ++rr) {
        int tt = t0 - 30 + rr; const bool ok = tt >= 0; tt = ok ? tt : t0;
        const float v = (float)p->P[(size_t)(tokbase + tt) * NP + ch];
        aw[rr] = ok ? v : 0.f;
    }
    float w[31];
#pragma unroll
    for (int i = 0; i < 31; ++i) w[i] = p->w_dw[(l * 31 + i) * 256 + ch];
    const float bias = p->b_dw[l * 256 + ch];
    float y[32], s1[32], s2[32];
#pragma unroll
    for (int tk = 0; tk < 32; ++tk) {
        float sacc = bias;
#pragma unroll
        for (int i = 0; i < 31; ++i) sacc = fmaf(aw[tk + i], w[i], sacc);
        y[tk] = sacc; s1[tk] = sacc; s2[tk] = sacc * sacc;
    }
    {
        const bool b5 = lane & 32, b4 = lane & 16, b3 = lane & 8, b2 = lane & 4, b1 = lane & 2;
        float a16[16], c16[16], a8[8], c8[8], a4[4], c4[4], a2[2], c2[2];
#pragma unroll
        for (int e = 0; e < 16; ++e) { a16[e] = (b5 ? s1[e + 16] : s1[e]) + __shfl_xor(b5 ? s1[e] : s1[e + 16], 32); c16[e] = (b5 ? s2[e + 16] : s2[e]) + __shfl_xor(b5 ? s2[e] : s2[e + 16], 32); }
#pragma unroll
        for (int e = 0; e < 8; ++e) { a8[e] = (b4 ? a16[e + 8] : a16[e]) + __shfl_xor(b4 ? a16[e] : a16[e + 8], 16); c8[e] = (b4 ? c16[e + 8] : c16[e]) + __shfl_xor(b4 ? c16[e] : c16[e + 8], 16); }
#pragma unroll
        for (int e = 0; e < 4; ++e) { a4[e] = (b3 ? a8[e + 4] : a8[e]) + __shfl_xor(b3 ? a8[e] : a8[e + 4], 8); c4[e] = (b3 ? c8[e + 4] : c8[e]) + __shfl_xor(b3 ? c8[e] : c8[e + 4], 8); }
#pragma unroll
        for (int e = 0; e < 2; ++e) { a2[e] = (b2 ? a4[e + 2] : a4[e]) + __shfl_xor(b2 ? a4[e] : a4[e + 2], 4); c2[e] = (b2 ? c4[e + 2] : c4[e]) + __shfl_xor(b2 ? c4[e] : c4[e + 2], 4); }
        float av = (b1 ? a2[1] : a2[0]) + __shfl_xor(b1 ? a2[0] : a2[1], 2), cv = (b1 ? c2[1] : c2[0]) + __shfl_xor(b1 ? c2[0] : c2[1], 2);
        av += __shfl_xor(av, 1); cv += __shfl_xor(cv, 1);
        const int tokk = (b5 ? 16 : 0) + (b4 ? 8 : 0) + (b3 ? 4 : 0) + (b2 ? 2 : 0) + (b1 ? 1 : 0);
        __syncthreads();
        if ((lane & 1) == 0) { red[(tokk * 4 + wave) * 2] = av; red[(tokk * 4 + wave) * 2 + 1] = cv; }
        __syncthreads();
    }
    const float lg = p->ln_g[l * 256 + ch], lb = p->ln_b[l * 256 + ch];
#pragma unroll
    for (int tk = 0; tk < 32; ++tk) {
        const float4 ra = *(const float4*)(red + tk * 8), rb = *(const float4*)(red + tk * 8 + 4);
        const float t1 = (ra.x + ra.z) + (rb.x + rb.z);
        const float t2 = (ra.y + ra.w) + (rb.y + rb.w);
        const float mu = t1 * (1.0f / 256.0f);
        float var = t2 * (1.0f / 256.0f) - mu * mu; var = var < 0.f ? 0.f : var;
        float z = (y[tk] - mu) * (1.0f / sqrtf(var + 1e-6f)) * lg + lb;
        z = z * sigmoidf_(z);
        p->ycat[((size_t)(ch >> 5) * T_TOK + tokbase + t0 + tk) * 32 + (ch & 31)] = (half_t)z;
    }
}

__device__ __forceinline__ void kmean_unit(KP p, char* lds, int b, int h, int blk) {
    float* part = (float*)lds;
    const int tid = TID(), d = tid & 63, pt = tid >> 6;
    const half_t* r = p->P + (size_t)(b * SEQ + blk * 256 + pt * 64) * NP + PC_MK + h * 64 + d;
    float s = 0.f;
#pragma unroll 16
    for (int k = 0; k < 64; ++k) s += (float)r[(size_t)k * NP];
    __syncthreads();
    part[pt * 64 + d] = s;
    __syncthreads();
    if (tid < 64) p->kmean[(((size_t)b * 6 + h) * 8 + blk) * 64 + tid] = ((part[tid] + part[64 + tid]) + (part[128 + tid] + part[192 + tid])) * (1.0f / 256.0f);
}

#ifndef POST_MASK
#define POST_MASK 7
#endif
__device__ __forceinline__ void phase_post(KP p, char* lds, int l, int tm) {
    const int NA = 2048, NB = 1024, NC = 768;
    const int G_ = gridDim.x;
    for (int u0 = BID(), k_ = 0; u0 < NA + NB + NC; u0 += G_, ++k_) {
        int u = u0;
        if (u0 < NA && (k_ & 1) && (k_ + 1) * G_ <= NA) u = k_ * G_ + (G_ - 1 - (u0 - k_ * G_));
        if (u < NA) { if (tm & 1) dsa_select_unit(p, lds, u % 16, 127 - (u / 16)); }
        else if (u < NA + NB) { const int v = u - NA; if (tm & 2) conv_unit(p, lds, l, v % 16, v / 16); }
        else { const int v = u - NA - NB; if (tm & 4) kmean_unit(p, lds, v / 48, (v / 8) % 6, v % 8); }
    }
}

template <int MODE>
__device__ __forceinline__ void attn_unit(KP p, char* lds, int b, int h, int qt) {
    const int tid = TID(), lane = tid & 63, wave = tid >> 6, hh = lane >> 5, ql = lane & 31;
    const int q0 = qt * 128, tokbase = b * SEQ;
    const int tq = q0 + wave * 32 + ql;
    const half_t* Pb = p->P + (size_t)tokbase * NP;
    const int QOFF = MODE ? PC_MQ + h * 64 : PC_DQ + h * 64;
    const int KOFF = MODE ? PC_MK + h * 64 : PC_DK;
    const int VOFF = MODE ? PC_MV + h * 64 : PC_DV;
    const int own = qt >> 1;
    unsigned mysel = 0u, anysel = 0u;
    __syncthreads();
    h8 qf[4];
#pragma unroll
    for (int ks = 0; ks < 4; ++ks) qf[ks] = *(const h8*)(Pb + (size_t)tq * NP + QOFF + 16 * ks + 8 * hh);
    if (MODE == 1) {
        float* km = (float*)(lds + 32768);
        unsigned* anyb = (unsigned*)(km + 512);
        for (int i = tid; i < 512; i += 256) km[i] = p->kmean[((size_t)b * 6 + h) * 512 + i];
        if (tid == 0) *anyb = 0u;
        __syncthreads();
        float gt[8];
#pragma unroll
        for (int j = 0; j < 8; ++j) {
            float sacc = 0.f;
            if (j < own) {
#pragma unroll
                for (int ks = 0; ks < 4; ++ks) {
                    const float4 k0 = *(const float4*)(km + j * 64 + 16 * ks + 8 * hh), k1 = *(const float4*)(km + j * 64 + 16 * ks + 8 * hh + 4);
                    sacc = fmaf((float)qf[ks][0], k0.x, sacc); sacc = fmaf((float)qf[ks][1], k0.y, sacc); sacc = fmaf((float)qf[ks][2], k0.z, sacc); sacc = fmaf((float)qf[ks][3], k0.w, sacc);
                    sacc = fmaf((float)qf[ks][4], k1.x, sacc); sacc = fmaf((float)qf[ks][5], k1.y, sacc); sacc = fmaf((float)qf[ks][6], k1.z, sacc); sacc = fmaf((float)qf[ks][7], k1.w, sacc);
                }
            }
            gt[j] = sacc + __shfl_xor(sacc, 32);
        }
        unsigned m = 0u;
        const int want = own < 3 ? own : 3;
#pragma unroll
        for (int r = 0; r < 3; ++r) {
            if (r < want) {
                int best = -1; float bv = -INFINITY;
#pragma unroll
                for (int j = 0; j < 8; ++j) { if (j < own && !((m >> j) & 1u) && (best < 0 || gt[j] > bv)) { best = j; bv = gt[j]; } }
                m |= 1u << best;
            }
        }
        mysel = m;
        unsigned wmk = m;
#pragma unroll
        for (int o = 16; o >= 1; o >>= 1) wmk |= (unsigned)__shfl_xor((int)wmk, o);
        if (lane == 0 && wmk) atomicOr(anyb, wmk);
        __syncthreads();
        anysel = *anyb;
    }
    f16v O0, O1;
#pragma unroll
    for (int r = 0; r < 16; ++r) { O0[r] = 0.f; O1[r] = 0.f; }
    float l_run = 0.f;
    bool unset = true;
    f16v negm;
#pragma unroll
    for (int r = 0; r < 16; ++r) negm[r] = 0.f;
    const float THR = 8.0f;
    const int ntile = 2 * qt + 2;
    auto skip = [&](int kt) -> bool { return MODE == 1 && kt < 4 * own && !((anysel >> (kt >> 2)) & 1u); };
    auto nexttile = [&](int kt) -> int { ++kt; while (kt < ntile && skip(kt)) ++kt; return kt; };
    const int lrow = tid >> 3;
    const int kchunk = (tid & 7) ^ ((tid >> 4) & 7);
    const int vchunk = (tid & 7) ^ (((tid >> 4) & 1) << 2);
    char* ldst = lds + lrow * 128 + (tid & 7) * 16;
    auto issue = [&](int kt, int s) {
        const half_t* src = Pb + (size_t)(kt * 64 + lrow) * NP;
        char* d = ldst + s * 16384;
        glds16(src + KOFF + kchunk * 8, d);
        glds16(src + (size_t)32 * NP + KOFF + kchunk * 8, d + 4096);
        glds16(src + VOFF + vchunk * 8, d + 8192);
        glds16(src + (size_t)32 * NP + VOFF + vchunk * 8, d + 8192 + 4096);
    };
    const int rsw = (lane >> 1) & 7;
    const int kro = ql * 128;
    const int li = lane & 15, qp = li >> 2, pp = li & 3, swv = (qp >> 1) & 1;
    const int vb0 = 8192 + (4 * hh + qp) * 128 + 32 * ((lane >> 4) & 1) + 8 * pp + 64 * (0 ^ swv);
    const int vb1 = 8192 + (4 * hh + qp) * 128 + 32 * ((lane >> 4) & 1) + 8 * pp + 64 * (1 ^ swv);
    int kt = -1; kt = nexttile(kt);
    int s = 0;
    if (kt < ntile) issue(kt, 0);
    while (kt < ntile) {
        const int ktn = nexttile(kt);
        asm volatile("s_waitcnt vmcnt(0)" ::: "memory");
        __syncthreads();
        if (ktn < ntile) issue(ktn, s ^ 1);
        const bool wave_active = (kt * 64 <= q0 + wave * 32 + 31);
        if (wave_active) {
            const char* base = lds + s * 16384;
            uint2 mw = make_uint2(0u, 0u);
            if (MODE == 0) mw = *(const uint2*)(p->dmask + (size_t)(tokbase + tq) * 64 + 2 * kt);
            h8 vf0[4], vf1[4];
#pragma unroll
            for (int kk = 0; kk < 4; ++kk) {
                const int roff = (32 * (kk >> 1) + 16 * (kk & 1)) * 128;
                const s4v lo0 = __builtin_amdgcn_ds_read_tr16_b64_v4i16((LAS s4v*)(base + vb0 + roff));
                const s4v hi0 = __builtin_amdgcn_ds_read_tr16_b64_v4i16((LAS s4v*)(base + vb0 + roff + 8 * 128));
                const s4v lo1 = __builtin_amdgcn_ds_read_tr16_b64_v4i16((LAS s4v*)(base + vb1 + roff));
                const s4v hi1 = __builtin_amdgcn_ds_read_tr16_b64_v4i16((LAS s4v*)(base + vb1 + roff + 8 * 128));
                vf0[kk] = __builtin_bit_cast(h8, __builtin_shufflevector(lo0, hi0, 0, 1, 2, 3, 4, 5, 6, 7));
                vf1[kk] = __builtin_bit_cast(h8, __builtin_shufflevector(lo1, hi1, 0, 1, 2, 3, 4, 5, 6, 7));
            }
            bool lane_on = true;
            if (MODE == 1 && kt < 4 * own) lane_on = (mysel >> (kt >> 2)) & 1u;
            f16v cin = negm;
            if (MODE == 1 && kt < 4 * own) {
#pragma unroll
                for (int r = 0; r < 16; ++r) cin[r] = lane_on ? negm[r] : -INFINITY;
            }
            f16v s0 = cin, s1 = cin;
#pragma unroll
            for (int ks = 0; ks < 4; ++ks) {
                const int co = ((2 * ks + hh) ^ rsw) << 4;
                const h8 k0 = *(const h8*)(base + kro + co), k1 = *(const h8*)(base + kro + 4096 + co);
                s0 = __builtin_amdgcn_mfma_f32_32x32x16_f16(k0, qf[ks], s0, 0, 0, 0);
                s1 = __builtin_amdgcn_mfma_f32_32x32x16_f16(k1, qf[ks], s1, 0, 0, 0);
            }
            if (MODE == 0) {
                const unsigned w0 = mw.x >> (4 * hh), w1 = mw.y >> (4 * hh);
#pragma unroll
                for (int r = 0; r < 16; ++r) {
                    const int pos = (r & 3) + 8 * (r >> 2);
                    const unsigned m0 = (unsigned)__builtin_amdgcn_sbfe((int)w0, pos, 1), m1 = (unsigned)__builtin_amdgcn_sbfe((int)w1, pos, 1);
                    s0[r] = __uint_as_float((__float_as_uint(s0[r]) & m0) | (0xFF800000u & ~m0));
                    s1[r] = __uint_as_float((__float_as_uint(s1[r]) & m1) | (0xFF800000u & ~m1));
                }
            } else if (kt >= 4 * own && kt * 64 + 63 > q0 + wave * 32) {
#pragma unroll
                for (int r = 0; r < 16; ++r) {
                    const int key = kt * 64 + (r & 3) + 8 * (r >> 2) + 4 * hh;
                    s0[r] = (key <= tq) ? s0[r] : -INFINITY;
                    s1[r] = (key + 32 <= tq) ? s1[r] : -INFINITY;
                }
            }
            float mx = s0[0];
#pragma unroll
            for (int r = 1; r < 16; ++r) mx = fmaxf(mx, s0[r]);
#pragma unroll
            for (int r = 0; r < 16; ++r) mx = fmaxf(mx, s1[r]);
            mx = fmaxf(mx, __shfl_xor(mx, 32));
            const bool need = unset ? (mx > -INFINITY) : (mx > THR);
            if (__any(need)) {
                const float delta = need ? mx : 0.f;
                const float alpha = (need && !unset) ? __builtin_amdgcn_exp2f(-delta) : 1.0f;
#pragma unroll
                for (int r = 0; r < 16; ++r) { s0[r] -= delta; s1[r] -= delta; negm[r] -= delta; O0[r] *= alpha; O1[r] *= alpha; }
                l_run *= alpha;
                unset = unset && !need;
            }
            float ls = 0.f;
#pragma unroll
            for (int r = 0; r < 16; ++r) { s0[r] = __builtin_amdgcn_exp2f(s0[r]); ls += s0[r]; }
#pragma unroll
            for (int r = 0; r < 16; ++r) { s1[r] = __builtin_amdgcn_exp2f(s1[r]); ls += s1[r]; }
            l_run += ls;
#pragma unroll
            for (int kk = 0; kk < 4; ++kk) {
                h8 pf;
#pragma unroll
                for (int j = 0; j < 8; ++j) pf[j] = (half_t)((kk >> 1) ? s1[8 * (kk & 1) + j] : s0[8 * (kk & 1) + j]);
                O0 = __builtin_amdgcn_mfma_f32_32x32x16_f16(vf0[kk], pf, O0, 0, 0, 0);
                O1 = __builtin_amdgcn_mfma_f32_32x32x16_f16(vf1[kk], pf, O1, 0, 0, 0);
            }
        }
        kt = ktn; s ^= 1;
    }
    const float lt = l_run + __shfl_xor(l_run, 32);
    const float inv = 1.0f / lt;
    const int ycol = (MODE ? 640 : 256) + h * 64;
    half_t* dst = p->ycat + ((size_t)(ycol >> 5) * T_TOK + tokbase + tq) * 32 + 4 * hh;
#pragma unroll
    for (int g = 0; g < 4; ++g) {
        *(h4*)(dst + 8 * g) = pack4(O0[4 * g] * inv, O0[4 * g + 1] * inv, O0[4 * g + 2] * inv, O0[4 * g + 3] * inv);
        *(h4*)(dst + (size_t)T_TOK * 32 + 8 * g) = pack4(O1[4 * g] * inv, O1[4 * g + 1] * inv, O1[4 * g + 2] * inv, O1[4 * g + 3] * inv);
    }
}

#ifndef ATT_MASK
#define ATT_MASK 3
#endif
__device__ __forceinline__ void phase_attn(KP p, char* lds, int tm) {
    const int G_ = gridDim.x, per_ = G_ >> 3;
    const bool snake_ = (G_ >= 8) && ((G_ & 7) == 0);
    for (int k_ = 0, b_ = BID(); snake_ ? (k_ * per_ < 384) : (b_ + k_ * G_ < 3072); ++k_) {
        int xl, Lx;
        if (snake_) { const int idx_ = b_ >> 3; xl = b_ & 7; Lx = k_ * per_ + ((k_ & 1) ? (per_ - 1 - idx_) : idx_); }
        else { const int u = b_ + k_ * G_; xl = u & 7; Lx = u >> 3; }
        if (Lx >= 384) continue;
        const int qt = 15 - (Lx / 24), rem = Lx % 24;
        const int type = rem & 1, bh = xl * 12 + (rem >> 1);
        if (type == 0) { if (tm & 1) attn_unit<0>(p, lds, bh / 6, bh % 6, qt); }
        else { if (tm & 2) attn_unit<1>(p, lds, bh / 6, bh % 6, qt); }
    }
}

__global__ void __launch_bounds__(256, 2) mk_fwd(Params p_unused) {
    extern __shared__ __attribute__((aligned(16))) char lds[];
    volatile LAS unsigned* stw = (volatile LAS unsigned*)(lds + LDS_CTL);
    if (threadIdx.x < 4) stw[threadIdx.x] = 0u;
    __syncthreads();
    KP p0 = (KP)__builtin_amdgcn_kernarg_segment_ptr();
    XcdBarrier bar; bar.bar = p0->bar; bar.x = 0; bar.st = stw;
#if !MK_SPLIT
    bar = xcd_barrier_post(p0->bar, stw);
#endif
    const int ph_lo = p0->ph_lo, ph_hi = p0->ph_hi;
    for (int ph = ph_lo; ph < ph_hi; ++ph) {
      KP p = p0; asm volatile("" : "+s"(p));
      const int nrep = (DUP_SUB >= 0 && ((DUP_SUB == 100 && ph == 0) || (ph >= 2 && ph < NPHASE - 1 && ((ph - 2) & 7) == DUP_SUB && (DUP_SUB != 4 || ph < 10)))) ? 2 : 1;
      for (int rep = 0; rep < nrep; ++rep) {
        if (ph == 0) phase_prologue(p, lds);
        else if (ph == 1) phase_modsum(p);
        else if (ph == NPHASE - 1) phase_norm<2, true>(p, lds, p->xr, p->g_final, nullptr, nullptr, 0);
        else {
            const int l = (ph - 2) >> 3, sub = (ph - 2) & 7;
            const float* mf = p->modf + (size_t)l * 16 * 6144;
            if (sub == 0) { if (l == 0) phase_norm<0, false>(p, lds, p->x, p->g_mix + l * DM, mf, mf + 1024, l); else phase_norm<0, true>(p, lds, p->xr, p->g_mix + l * DM, mf, mf + 1024, l); }
            else if (sub == 1) phase_inproj(p, lds, l);
            else if (sub == 2) phase_post(p, lds, l, rep ? POST_MASK : 7);
            else if (sub == 3) phase_attn(p, lds, rep ? ATT_MASK : 3);
            else if (sub == 4) { if (l == 0) phase_outproj<false>(p, lds, l, p->x); else phase_outproj<true>(p, lds, l, p->xr); }
            else if (sub == 5) phase_norm_router(p, lds, p->xr, p->g_ffn + l * DM, mf + 3 * 1024, mf + 4 * 1024, (nrep == 2 && rep == 0) ? l + 2 : l);
            else if (sub == 6) phase_moe_up(p, lds, l);
            else phase_moe_down(p, lds, l, nrep == 2 ? 0.5f : 1.0f);
        }
      }
#if !MK_SPLIT
        if (ph + 1 < ph_hi) xcd_barrier(bar);
#endif
    }
}

extern "C" void kernel_launch(void* const* d_in, const int* in_sizes, int n_in, void* d_out, int out_size, void* d_ws, size_t ws_size, hipStream_t stream) {
    static int grid = 0;
    if (grid == 0) {
        int dev = 0, cus = 0, per_cu = 0;
        (void)hipGetDevice(&dev);
        (void)hipDeviceGetAttribute(&cus, hipDeviceAttributeMultiprocessorCount, dev);
        (void)hipFuncSetAttribute((const void*)mk_fwd, hipFuncAttributeMaxDynamicSharedMemorySize, LDS_BYTES);
        if (hipOccupancyMaxActiveBlocksPerMultiprocessor(&per_cu, (const void*)mk_fwd, 256, LDS_BYTES) != hipSuccess || per_cu < 1) per_cu = 1;
        (void)hipGetLastError();
        if (per_cu > 2) per_cu = 2;
        grid = cus * per_cu;
        fprintf(stderr, "mk_fwd: cus %d per_cu %d grid %d\n", cus, per_cu, grid);
    }
    Params p{};
    const float** pin = (const float**)&p.x;
    for (int i = 0; i < 18; ++i) pin[i] = (const float*)d_in[i];
    p.out = (float*)d_out;
    char* ws = (char*)d_ws;
    size_t off = 0;
    auto carve = [&](size_t bytes) { void* q = ws + off; off += (bytes + 255) & ~(size_t)255; return q; };
    p.bar = (unsigned*)carve(XCD_BAR_WORDS * 4);
    p.cnt = (int*)carve(4 * 32 * 64 * 4);
    const size_t zero_bytes = off;
    p.Wt_in = (half_t*)carve((size_t)2 * NP * DM * 2);
    p.Wt_o = (half_t*)carve((size_t)2 * DM * DM * 2);
    p.Wt_gu = (half_t*)carve((size_t)2 * 16 * 512 * 1024 * 2);
    p.Wt_d = (half_t*)carve((size_t)2 * 16 * 1024 * 256 * 2);
    p.hn = (half_t*)carve((size_t)T_TOK * DM * 2);
    p.P = (half_t*)carve((size_t)T_TOK * NP * 2);
    p.ycat = (half_t*)carve((size_t)T_TOK * DM * 2);
    p.act = (half_t*)carve((size_t)T_TOK * 512 * 2);
    p.xr = (half_t*)carve((size_t)T_TOK * DM * 2);
    p.modpart = (float*)carve((size_t)8 * 2 * 16 * 6144 * 4);
    p.modf = (float*)carve((size_t)2 * 16 * 6144 * 4);
    p.kmean = (float*)carve((size_t)16 * 6 * 8 * 64 * 4);
    p.rope = (float*)carve((size_t)2048 * 24 * 4);
    p.iwf = (float*)carve((size_t)T_TOK * 4 * 4);
    p.tokw = (float*)carve((size_t)T_TOK * 2 * 4);
    p.dmask = (unsigned*)carve((size_t)T_TOK * 64 * 4);
    p.lists = (int*)carve((size_t)NCLS * T_TOK * 4);
    if (off > ws_size) { fprintf(stderr, "workspace too small: need %zu have %zu\n", off, ws_size); return; }
    (void)hipMemsetAsync(d_ws, 0, zero_bytes, stream);
#if MK_SPLIT
    for (int ph = 0; ph < NPHASE; ++ph) {
        p.ph_lo = ph; p.ph_hi = ph + 1;
        hipLaunchKernelGGL(mk_fwd, dim3(grid), dim3(256), LDS_BYTES, stream, p);
    }
#else
    p.ph_lo = 0; p.ph_hi = NPHASE;
    hipLaunchKernelGGL(mk_fwd, dim3(grid), dim3(256), LDS_BYTES, stream, p);
#endif
}
```

```cpp
#include <hip/hip_runtime.h>
#include <cstdio>
#include <cstdint>

#ifndef MK_SPLIT
#define MK_SPLIT 0
#endif

#define T_TOK 32768
#define DM 1024
#define SEQ 2048
#define INW 2340
#define NP 2432
#define PC_CU 0
#define PC_CG 256
#define PC_DQ 512
#define PC_DK 896
#define PC_DV 960
#define PC_IQ 1024
#define PC_IK 1152
#define PC_IW 1184
#define PC_MQ 1280
#define PC_MK 1664
#define PC_MV 2048
#define LOG_THETA 13.122363377404328f
#define NCLS 24
#define LDS_CTL 73728
#define LDS_BYTES 78336
#define NPHASE 19
#ifndef DUP_SUB
#define DUP_SUB -1
#endif

typedef _Float16 half_t;
typedef _Float16 h8 __attribute__((ext_vector_type(8)));
typedef _Float16 h4 __attribute__((ext_vector_type(4)));
typedef short s4v __attribute__((ext_vector_type(4)));
typedef short s8v __attribute__((ext_vector_type(8)));
typedef float f16v __attribute__((ext_vector_type(16)));
typedef float f4v __attribute__((ext_vector_type(4)));
#define LAS __attribute__((address_space(3)))

struct Params {
    const float *x, *c, *w_ada, *b_ada, *g_mix, *w_in, *w_dw, *b_dw, *ln_g, *ln_b, *w_o, *g_ffn, *w_router, *b_router, *w_gate, *w_up, *w_down, *g_final;
    float* out;
    half_t *Wt_in, *Wt_o, *Wt_gu, *Wt_d, *hn, *P, *ycat, *act, *xr;
    float *modpart, *modf, *kmean, *rope, *iwf, *tokw;
    unsigned* dmask; int* cnt; int* lists; unsigned* bar;
    int ph_lo, ph_hi;
};

#define XB_TMO      128
#define XB_XCNT(j)  (256  + 64 * (j))
#define XB_XSUB(j)  (1280 + 64 * (j))
#define XB_XGEN(j)  (2304 + 64 * (j))
#define XB_TOP      3328
#define XB_TOPGEN   3392
#define XCD_BAR_WORDS 3456
#define XB_SPIN_CAP (1u << 20)
__device__ __forceinline__ unsigned xb_ld(unsigned* p)              { return __hip_atomic_load(p, __ATOMIC_RELAXED, __HIP_MEMORY_SCOPE_AGENT); }
__device__ __forceinline__ unsigned xb_add(unsigned* p, unsigned v) { return __hip_atomic_fetch_add(p, v, __ATOMIC_RELAXED, __HIP_MEMORY_SCOPE_AGENT); }
__device__ __forceinline__ unsigned xb_xcc_id() { return (unsigned)__builtin_amdgcn_s_getreg((3 << 11) | 20) & 0xFu; }
#define XB_SPIN(cond, bar) do { unsigned _sp = 0; while (cond) { __builtin_amdgcn_s_sleep(1); \
    if ((++_sp & 255u) == 0u) { if (xb_ld(&(bar)[XB_TMO])) break; if (_sp > XB_SPIN_CAP) { atomicAdd(&(bar)[XB_TMO], 1u); break; } } } } while (0)
struct XcdBarrier { unsigned* bar; unsigned x; volatile LAS unsigned* st; };
__device__ __forceinline__ XcdBarrier xcd_barrier_post(unsigned* bar, volatile LAS unsigned* st) {
    XcdBarrier b; b.bar = bar; b.x = xb_xcc_id(); b.st = st;
    if (threadIdx.x == 0) (void)xb_add(&bar[XB_XCNT(b.x)], 1u);
    return b;
}
__device__ __forceinline__ void xcd_barrier_complete(unsigned* bar, unsigned x, unsigned& nloc, unsigned& nx) {
    const unsigned G = gridDim.x * gridDim.y * gridDim.z;
    unsigned sum, cnt, mine, sp = 0u;
    for (;;) {
        sum = 0u; cnt = 0u; mine = 0u;
#pragma unroll
        for (unsigned j = 0; j < 16; ++j) { const unsigned c = xb_ld(&bar[XB_XCNT(j)]); sum += c; cnt += (c > 0u) ? 1u : 0u; mine = (j == x) ? c : mine; }
        if (sum == G) break;
        __builtin_amdgcn_s_sleep(1);
        if ((++sp & 255u) == 0u) { if (xb_ld(&bar[XB_TMO])) break; if (sp > XB_SPIN_CAP) { atomicAdd(&bar[XB_TMO], 1u); break; } }
    }
    nloc = mine > 0u ? mine : 1u; nx = cnt > 0u ? cnt : 1u;
}
__device__ __forceinline__ void xcd_barrier(const XcdBarrier& b) {
    asm volatile("s_waitcnt vmcnt(0)" ::: "memory");
    __syncthreads();
    if (threadIdx.x == 0) {
        unsigned* bar = b.bar;
        __builtin_amdgcn_s_waitcnt(0);
        unsigned nloc = b.st[0], nx = b.st[1];
        if (nloc == 0u) { xcd_barrier_complete(bar, b.x, nloc, nx); b.st[0] = nloc; b.st[1] = nx; }
        const unsigned old = xb_add(&bar[XB_XSUB(b.x)], 1u);
        const unsigned gen = old / nloc;
        if (old + 1u == (gen + 1u) * nloc) {
            __builtin_amdgcn_fence(__ATOMIC_RELEASE, "agent");
            asm volatile("s_waitcnt vmcnt(0)" ::: "memory");
            const unsigned og = xb_add(&bar[XB_TOP], 1u);
            const unsigned tg = og / nx;
            if (og + 1u == (tg + 1u) * nx) xb_add(&bar[XB_TOPGEN], 1u);
            else XB_SPIN(xb_ld(&bar[XB_TOPGEN]) == tg, bar);
            __builtin_amdgcn_fence(__ATOMIC_ACQUIRE, "agent");
            xb_add(&bar[XB_XGEN(b.x)], 1u);
            asm volatile("s_waitcnt vmcnt(0)" ::: "memory");
        } else {
            XB_SPIN(xb_ld(&bar[XB_XGEN(b.x)]) == gen, bar);
            __builtin_amdgcn_fence(__ATOMIC_ACQUIRE, "agent");
            asm volatile("s_waitcnt vmcnt(0)" ::: "memory");
        }
    }
    __syncthreads();
}

typedef const __attribute__((address_space(4))) Params* KP;
__device__ __forceinline__ int TID() { int t = threadIdx.x; asm volatile("" : "+v"(t)); return t; }
__device__ __forceinline__ int BID() { int b = blockIdx.x; asm volatile("" : "+s"(b)); return b; }
__device__ __forceinline__ float sigmoidf_(float v) { return __builtin_amdgcn_rcpf(1.0f + __expf(-v)); }
__device__ __forceinline__ void glds16(const void* g, char* l) { __builtin_amdgcn_global_load_lds((const unsigned*)g, (unsigned*)l, 16, 0, 0); }
__device__ __forceinline__ unsigned f2sortable(float f) { unsigned u = __float_as_uint(f); return (u & 0x80000000u) ? ~u : (u | 0x80000000u); }
template <bool HIN> __device__ __forceinline__ float4 ldx4(const void* base, size_t idx) {
    if (HIN) { const h4 t = *(const h4*)((const half_t*)base + idx); return make_float4((float)t[0], (float)t[1], (float)t[2], (float)t[3]); }
    return *(const float4*)((const float*)base + idx);
}
__device__ __forceinline__ h4 pack4(float a, float b, float c, float d) { h4 r = {(half_t)a, (half_t)b, (half_t)c, (half_t)d}; return r; }

template <class CF>
__device__ __forceinline__ void conv_tile_panel(char* lds, CF colf, int src_ld, int k0, int n0, half_t* dst, int nrows) {
    float* tl = (float*)lds;
    const int tid = TID();
    __syncthreads();
    {
        const int nn = tid & 63;
        const float* cp = colf(nn);
        float tv[16];
#pragma unroll
        for (int i = 0; i < 16; ++i) { const int k = i * 4 + (tid >> 6); tv[i] = cp ? cp[(size_t)(k0 + k) * src_ld] : 0.f; }
#pragma unroll
        for (int i = 0; i < 16; ++i) { const int k = i * 4 + (tid >> 6); tl[k * 65 + nn] = tv[i]; }
    }
    __syncthreads();
    {
        const int n = tid >> 2, kq = (tid & 3) * 16;
        h8 a, b;
#pragma unroll
        for (int j = 0; j < 8; ++j) { a[j] = (half_t)tl[(kq + j) * 65 + n]; b[j] = (half_t)tl[(kq + 8 + j) * 65 + n]; }
        const int k = k0 + kq;
        h8* d = (h8*)(dst + ((size_t)(k >> 5) * nrows + n0 + n) * 32 + (k & 31));
        d[0] = a; d[1] = b;
    }
}
template <class CF>
__device__ __forceinline__ void conv_tile(char* lds, CF colf, int src_ld, int k0, half_t* dst_tile  , int dstK) {
    float* tl = (float*)lds;
    const int tid = TID();
    __syncthreads();
    {
        const int nn = tid & 63;
        const float* cp = colf(nn);
        float tv[16];
#pragma unroll
        for (int i = 0; i < 16; ++i) { const int k = i * 4 + (tid >> 6); tv[i] = cp ? cp[(size_t)(k0 + k) * src_ld] : 0.f; }
#pragma unroll
        for (int i = 0; i < 16; ++i) { const int k = i * 4 + (tid >> 6); tl[k * 65 + nn] = tv[i]; }
    }
    __syncthreads();
    {
        const int n = tid >> 2, kq = (tid & 3) * 16;
        h8 a, b;
#pragma unroll
        for (int j = 0; j < 8; ++j) { a[j] = (half_t)tl[(kq + j) * 65 + n]; b[j] = (half_t)tl[(kq + 8 + j) * 65 + n]; }
        h8* d = (h8*)(dst_tile + (size_t)n * dstK + kq);
        d[0] = a; d[1] = b;
    }
}

__device__ __forceinline__ void phase_prologue(KP p, char* lds) {
    const int tid = TID();
    const int NA = 2 * 16 * 38, NB = 2 * 16 * 16, NC = 2 * 16 * 16 * 8, ND = 2 * 16 * 4 * 16, NE = 384, NF = 8;
    const int total = NA + NB + NC + ND + NE + NF;
    for (int u0 = BID(); u0 < total; u0 += gridDim.x) {
        int u = u0;
        if (u < NA) {
            const int nt = u % 38, kt = (u / 38) % 16, l = u / (38 * 16);
            const float* src = p->w_in + (size_t)l * DM * INW;
            const int n0 = nt * 64;
            conv_tile_panel(lds, [&](int nn) -> const float* { const int np = n0 + nn; const int sc = np < 512 ? (((np & 63) < 32) ? 32 * (np >> 6) + (np & 31) : 256 + 32 * (np >> 6) + (np & 31)) : (np < 1188 ? np : (np < 1280 ? -1 : np - 92)); return sc >= 0 ? src + sc : (const float*)nullptr; },
                      INW, kt * 64, n0, p->Wt_in + (size_t)l * NP * DM, NP);
            continue;
        }
        u -= NA;
        if (u < NB) {
            const int nt = u % 16, kt = (u / 16) % 16, l = u / 256;
            const float* src = p->w_o + (size_t)l * DM * DM + nt * 64;
            conv_tile_panel(lds, [&](int nn) -> const float* { return src + nn; }, DM, kt * 64, nt * 64, p->Wt_o + (size_t)l * DM * DM, DM);
            continue;
        }
        u -= NB;
        if (u < NC) {
            const int nt = u % 8, kt = (u / 8) % 16, le = u / 128;
            const float* sg = p->w_gate + (size_t)le * 1024 * 256 + nt * 32;
            const float* su = p->w_up + (size_t)le * 1024 * 256 + nt * 32;
            conv_tile(lds, [&](int nn) -> const float* { return nn < 32 ? sg + nn : su + (nn - 32); }, 256, kt * 64, p->Wt_gu + ((size_t)le * 512 + nt * 64) * 1024 + kt * 64, 1024);
            continue;
        }
        u -= NC;
        if (u < ND) {
            const int nt = u % 16, kt = (u / 16) % 4, le = u / 64;
            const float* src = p->w_down + (size_t)le * 256 * 1024 + nt * 64;
            conv_tile(lds, [&](int nn) -> const float* { return src + nn; }, 1024, kt * 64, p->Wt_d + ((size_t)le * 1024 + nt * 64) * 256 + kt * 64, 256);
            continue;
        }
        u -= ND;
        if (u < NE) {
            const int kc = u % 8, cc = (u / 8) % 24, l = u / 192;
            float* ca = (float*)lds;
            __syncthreads();
            for (int i = tid; i < 2048; i += 256) { const int b = i >> 7, k = i & 127; const float v = p->c[b * 1024 + kc * 128 + k]; ca[i] = v / (1.0f + expf(-v)); }
            __syncthreads();
            const int n = cc * 256 + tid;
            float acc[16];
#pragma unroll
            for (int b = 0; b < 16; ++b) acc[b] = 0.f;
            const float* w = p->w_ada + ((size_t)l * 1024 + kc * 128) * 6144 + n;
#pragma unroll 16
            for (int k = 0; k < 128; ++k) {
                const float wv = w[(size_t)k * 6144];
#pragma unroll
                for (int b = 0; b < 16; ++b) acc[b] = fmaf(ca[b * 128 + k], wv, acc[b]);
            }
#pragma unroll
            for (int b = 0; b < 16; ++b) p->modpart[(((size_t)kc * 2 + l) * 16 + b) * 6144 + n] = acc[b];
            continue;
        }
        u -= NE;
        {
            for (int i = u * 256 + tid; i < 2048 * 12; i += NF * 256) {
                const int t = i / 12, r = i % 12;
                const int fi = r < 8 ? r : r - 8;
                const float rot = r < 8 ? 16.f : 8.f;
                const float inv = expf(-LOG_THETA * ((float)fi * 2.0f / rot));
                const float ang = (float)t * inv;
                float sn, cs; sincosf(ang, &sn, &cs);
                if (r < 8) { p->rope[t * 8 + fi] = cs; p->rope[16384 + t * 8 + fi] = sn; }
                else { p->rope[32768 + t * 4 + fi] = cs; p->rope[32768 + 8192 + t * 4 + fi] = sn; }
            }
        }
    }
}

__device__ __forceinline__ void phase_modsum(KP p) {
    for (int i = BID() * 256 + TID(); i < 2 * 16 * 6144; i += gridDim.x * 256) {
        const int n = i % 6144, l = i / (16 * 6144);
        float s = p->b_ada[l * 6144 + n];
#pragma unroll
        for (int kc = 0; kc < 8; ++kc) s += p->modpart[(size_t)kc * (2 * 16 * 6144) + i];
        p->modf[i] = s;
    }
}

__device__ __forceinline__ void route_flush(KP p, char* lds, int lane, int wave, int n, int myrow, int layer) {
    const float* lg = (const float*)(lds + LDS_CTL + 512) + wave * 256;
    int* lc = (int*)(lds + LDS_CTL + 64);
    int* lbase = lc + 32;
    const int tid = wave * 64 + lane;
    if (tid < 32) lc[tid] = 0;
    __syncthreads();
    int cls = 0, lpos = 0;
    if (lane < n) {
        float aff[16], bia[16];
#pragma unroll
        for (int e = 0; e < 16; ++e) { aff[e] = 1.0f / (1.0f + expf(-lg[lane * 16 + e])); bia[e] = aff[e] + p->b_router[e]; }
        int bestg = 0; float bests = -INFINITY;
#pragma unroll
        for (int gi = 0; gi < 4; ++gi) {
            float m1 = -INFINITY, m2 = -INFINITY;
#pragma unroll
            for (int j = 0; j < 4; ++j) { const float vv = bia[gi * 4 + j]; if (vv > m1) { m2 = m1; m1 = vv; } else if (vv > m2) m2 = vv; }
            const float s = m1 + m2;
            if (s > bests) { bests = s; bestg = gi; }
        }
        float bsel[4], asel[4];
#pragma unroll
        for (int j = 0; j < 4; ++j) { bsel[j] = 0.f; asel[j] = 0.f; }
#pragma unroll
        for (int gi = 0; gi < 4; ++gi) if (gi == bestg) {
#pragma unroll
            for (int j = 0; j < 4; ++j) { bsel[j] = bia[gi * 4 + j]; asel[j] = aff[gi * 4 + j]; }
        }
        int i1 = -1, i2 = -1; float v1 = -INFINITY, v2 = -INFINITY;
#pragma unroll
        for (int j = 0; j < 4; ++j) { const float vv = bsel[j]; if (vv > v1) { v2 = v1; i2 = i1; v1 = vv; i1 = j; } else if (vv > v2) { v2 = vv; i2 = j; } }
        const int a = i1 < i2 ? i1 : i2, bb = i1 < i2 ? i2 : i1;
        float wa = 0.f, wb = 0.f;
#pragma unroll
        for (int j = 0; j < 4; ++j) { if (j == a) wa = asel[j]; if (j == bb) wb = asel[j]; }
        const float sw = wa + wb;
        const int pi = (a == 0) ? (bb - 1) : (a == 1 ? (bb + 1) : 5);
        cls = bestg * 6 + pi;
        *(float2*)(p->tokw + (size_t)myrow * 2) = make_float2(wa / sw, wb / sw);
        lpos = atomicAdd(&lc[cls], 1);
    }
    __syncthreads();
    if (tid < NCLS) { const int c = lc[tid]; lbase[tid] = c ? atomicAdd(&p->cnt[(layer * 32 + tid) * 64], c) : 0; }
    __syncthreads();
    if (lane < n) p->lists[(size_t)cls * T_TOK + lbase[cls] + lpos] = myrow;
}

template <int MODE, bool HIN>
__device__ __forceinline__ void phase_norm(KP p, char* lds, const void* xin, const float* g, const float* sh, const float* sc, int layer) {
    const int lane = TID() & 63, wave = TID() >> 6;
    float* wt = (float*)lds;
    if (MODE == 1) {
        __syncthreads();
        for (int i = TID(); i < 4096; i += 256) {
            const float4 w4 = ((const float4*)p->w_router)[i];
            const int k = i >> 2, e0 = (i & 3) * 4;
            wt[(e0 + 0) * 1024 + k] = w4.x; wt[(e0 + 1) * 1024 + k] = w4.y; wt[(e0 + 2) * 1024 + k] = w4.z; wt[(e0 + 3) * 1024 + k] = w4.w;
        }
        __syncthreads();
    }
    float* lgb = (float*)(lds + LDS_CTL + 512);
    int myrow = 0, it = 0;
    float4 vn[4];
    {
        const int row0 = BID() * 4 + wave;
        const size_t xo = (size_t)(row0 < T_TOK ? row0 : 0) * DM;
#pragma unroll
        for (int i = 0; i < 4; ++i) vn[i] = ldx4<HIN>(xin, xo + (lane + 64 * i) * 4);
    }
    for (int row = BID() * 4 + wave; row < T_TOK; row += gridDim.x * 4) {
        const int b = row >> 11;
        float4 v[4]; float ss = 0.f;
#pragma unroll
        for (int i = 0; i < 4; ++i) v[i] = vn[i];
        {
            const int rown = row + gridDim.x * 4;
            const size_t xo = (size_t)(rown < T_TOK ? rown : row) * DM;
#pragma unroll
            for (int i = 0; i < 4; ++i) vn[i] = ldx4<HIN>(xin, xo + (lane + 64 * i) * 4);
        }
#pragma unroll
        for (int i = 0; i < 4; ++i) ss += v[i].x * v[i].x + v[i].y * v[i].y + v[i].z * v[i].z + v[i].w * v[i].w;
#pragma unroll
        for (int o = 32; o >= 1; o >>= 1) ss += __shfl_xor(ss, o);
        const float rstd = 1.0f / sqrtf(ss * (1.0f / 1024.0f) + 1e-6f);
        float acc[16], ya[16];
#pragma unroll
        for (int i = 0; i < 4; ++i) {
            const int k = (lane + 64 * i) * 4;
            const float4 gg = *(const float4*)(g + k);
            float y[4] = {v[i].x * rstd * gg.x, v[i].y * rstd * gg.y, v[i].z * rstd * gg.z, v[i].w * rstd * gg.w};
            if (MODE != 2) {
                const float4 s1 = *(const float4*)(sh + (size_t)b * 6144 + k), s2 = *(const float4*)(sc + (size_t)b * 6144 + k);
                y[0] = y[0] * (1.f + s2.x) + s1.x; y[1] = y[1] * (1.f + s2.y) + s1.y; y[2] = y[2] * (1.f + s2.z) + s1.z; y[3] = y[3] * (1.f + s2.w) + s1.w;
                if (MODE == 0) *(h4*)(p->hn + ((size_t)(k >> 5) * T_TOK + row) * 32 + (k & 31)) = pack4(y[0], y[1], y[2], y[3]);
                else *(h4*)(p->hn + (size_t)row * DM + k) = pack4(y[0], y[1], y[2], y[3]);
            } else {
                *(float4*)(p->out + (size_t)row * DM + k) = make_float4(y[0], y[1], y[2], y[3]);
            }
            ya[4 * i] = y[0]; ya[4 * i + 1] = y[1]; ya[4 * i + 2] = y[2]; ya[4 * i + 3] = y[3];
        }
        if (MODE == 1) {
#pragma unroll
            for (int e = 0; e < 16; ++e) acc[e] = 0.f;
            float4 wq[2][4];
            const float* wl = wt + lane * 4;
#pragma unroll
            for (int e = 0; e < 4; ++e) wq[0][e] = *(const float4*)(wl + e * 1024);
#pragma unroll
            for (int st = 0; st < 16; ++st) {
                const int i = st >> 2, eg = st & 3, cur = st & 1;
                if (st + 1 < 16) {
                    const int i2 = (st + 1) >> 2, eg2 = (st + 1) & 3;
#pragma unroll
                    for (int e = 0; e < 4; ++e) wq[cur ^ 1][e] = *(const float4*)(wl + (eg2 * 4 + e) * 1024 + i2 * 256);
                }
#pragma unroll
                for (int e = 0; e < 4; ++e) {
                    const float4 w4 = wq[cur][e];
                    acc[eg * 4 + e] = fmaf(ya[4 * i], w4.x, fmaf(ya[4 * i + 1], w4.y, fmaf(ya[4 * i + 2], w4.z, fmaf(ya[4 * i + 3], w4.w, acc[eg * 4 + e]))));
                }
                __builtin_amdgcn_sched_barrier(0);
            }
        }
        if (MODE == 1) {
            const bool b5 = lane & 32, b4 = lane & 16, b3 = lane & 8, b2 = lane & 4;
            float r8[8], r4[4], r2[2];
#pragma unroll
            for (int e = 0; e < 8; ++e) { const float snd = b5 ? acc[e] : acc[e + 8], kp = b5 ? acc[e + 8] : acc[e]; r8[e] = kp + __shfl_xor(snd, 32); }
#pragma unroll
            for (int e = 0; e < 4; ++e) { const float snd = b4 ? r8[e] : r8[e + 4], kp = b4 ? r8[e + 4] : r8[e]; r4[e] = kp + __shfl_xor(snd, 16); }
#pragma unroll
            for (int e = 0; e < 2; ++e) { const float snd = b3 ? r4[e] : r4[e + 2], kp = b3 ? r4[e + 2] : r4[e]; r2[e] = kp + __shfl_xor(snd, 8); }
            float rv; { const float snd = b2 ? r2[0] : r2[1], kp = b2 ? r2[1] : r2[0]; rv = kp + __shfl_xor(snd, 4); }
            rv += __shfl_xor(rv, 2); rv += __shfl_xor(rv, 1);
            if ((lane & 3) == 0) lgb[(wave * 16 + it) * 16 + (lane >> 2)] = rv;
            if (lane == it) myrow = row;
            ++it;
            if (it == 16) { route_flush(p, lds, lane, wave, it, myrow, layer); it = 0; }
        }
    }
    if (MODE == 1 && it > 0) route_flush(p, lds, lane, wave, it, myrow, layer);
}

typedef float f2_t __attribute__((ext_vector_type(2)));
#define NRR 2
__device__ __forceinline__ void phase_norm_router(KP p, char* lds, const half_t* xin, const float* g, const float* sh, const float* sc, int layer) {
    const int lane = TID() & 63, wave = TID() >> 6;
    float* wt = (float*)lds;
    __syncthreads();
    for (int i = TID(); i < 4096; i += 256) {
        const float4 w4 = ((const float4*)p->w_router)[i];
        const int k = i >> 2, e0 = (i & 3) * 4;
        wt[(e0 + 0) * 1024 + k] = w4.x; wt[(e0 + 1) * 1024 + k] = w4.y; wt[(e0 + 2) * 1024 + k] = w4.z; wt[(e0 + 3) * 1024 + k] = w4.w;
    }
    __syncthreads();
    float* lgb = (float*)(lds + LDS_CTL + 512);
    int myrow = 0, it = 0;
    const int rstride = gridDim.x * 4;
    for (int row0 = BID() * 4 + wave; row0 < T_TOK; row0 += rstride * NRR) {
        f2_t ya[NRR / 2][16];
        float ss[NRR];
        int nv = 0;
#pragma unroll
        for (int j = 0; j < NRR; ++j) nv += (row0 + j * rstride < T_TOK) ? 1 : 0;
        {
            float4 v[NRR][4];
#pragma unroll
            for (int j = 0; j < NRR; ++j) {
                const int r = row0 + j * rstride;
                const size_t xo = (size_t)(r < T_TOK ? r : row0) * DM;
#pragma unroll
                for (int i = 0; i < 4; ++i) v[j][i] = ldx4<true>(xin, xo + (lane + 64 * i) * 4);
            }
#pragma unroll
            for (int j = 0; j < NRR; ++j) {
                ss[j] = 0.f;
#pragma unroll
                for (int i = 0; i < 4; ++i) ss[j] += v[j][i].x * v[j][i].x + v[j][i].y * v[j][i].y + v[j][i].z * v[j][i].z + v[j][i].w * v[j][i].w;
            }
#pragma unroll
            for (int o = 32; o >= 1; o >>= 1) {
#pragma unroll
                for (int j = 0; j < NRR; ++j) ss[j] += __shfl_xor(ss[j], o);
            }
#pragma unroll
            for (int j = 0; j < NRR; ++j) ss[j] = 1.0f / sqrtf(ss[j] * (1.0f / 1024.0f) + 1e-6f);
#pragma unroll
            for (int j = 0; j < NRR; ++j) {
                const int r = row0 + j * rstride;
                const int rr = r < T_TOK ? r : row0;
                const int b = rr >> 11;
                const float rs = ss[j];
#pragma unroll
                for (int i = 0; i < 4; ++i) {
                    const int k = (lane + 64 * i) * 4;
                    const float4 gg = *(const float4*)(g + k);
                    const float4 s1 = *(const float4*)(sh + (size_t)b * 6144 + k), s2 = *(const float4*)(sc + (size_t)b * 6144 + k);
                    const float y0 = v[j][i].x * rs * gg.x * (1.f + s2.x) + s1.x, y1 = v[j][i].y * rs * gg.y * (1.f + s2.y) + s1.y;
                    const float y2 = v[j][i].z * rs * gg.z * (1.f + s2.z) + s1.z, y3 = v[j][i].w * rs * gg.w * (1.f + s2.w) + s1.w;
                    if (r < T_TOK) *(h4*)(p->hn + (size_t)r * DM + k) = pack4(y0, y1, y2, y3);
                    if (j & 1) { ya[j >> 1][4 * i].y = y0; ya[j >> 1][4 * i + 1].y = y1; ya[j >> 1][4 * i + 2].y = y2; ya[j >> 1][4 * i + 3].y = y3; }
                    else       { ya[j >> 1][4 * i].x = y0; ya[j >> 1][4 * i + 1].x = y1; ya[j >> 1][4 * i + 2].x = y2; ya[j >> 1][4 * i + 3].x = y3; }
                }
                __builtin_amdgcn_sched_barrier(0);
            }
        }
        f2_t acc[NRR / 2][16];
#pragma unroll
        for (int e = 0; e < 16; ++e) {
#pragma unroll
            for (int jp = 0; jp < NRR / 2; ++jp) acc[jp][e] = (f2_t){0.f, 0.f};
        }
        {
            float4 wq[2][4];
            const float* wl = wt + lane * 4;
#pragma unroll
            for (int e = 0; e < 4; ++e) wq[0][e] = *(const float4*)(wl + e * 1024);
#pragma unroll
            for (int st = 0; st < 16; ++st) {
                const int i = st >> 2, eg = st & 3, cur = st & 1;
                if (st + 1 < 16) {
                    const int i2 = (st + 1) >> 2, eg2 = (st + 1) & 3;
#pragma unroll
                    for (int e = 0; e < 4; ++e) wq[cur ^ 1][e] = *(const float4*)(wl + (eg2 * 4 + e) * 1024 + i2 * 256);
                }
#pragma unroll
                for (int e = 0; e < 4; ++e) {
                    const float4 w4 = wq[cur][e];
#pragma unroll
                    for (int jp = 0; jp < NRR / 2; ++jp) {
                        f2_t a = acc[jp][eg * 4 + e];
                        a = ya[jp][4 * i + 3] * (f2_t){w4.w, w4.w} + a;
                        a = ya[jp][4 * i + 2] * (f2_t){w4.z, w4.z} + a;
                        a = ya[jp][4 * i + 1] * (f2_t){w4.y, w4.y} + a;
                        a = ya[jp][4 * i] * (f2_t){w4.x, w4.x} + a;
                        acc[jp][eg * 4 + e] = a;
                    }
                }
                __builtin_amdgcn_sched_barrier(0);
            }
        }
        const bool b5 = lane & 32, b4 = lane & 16, b3 = lane & 8, b2 = lane & 4;
#pragma unroll
        for (int j = 0; j < NRR; ++j) {
            float r8[8], r4[4], r2[2];
#pragma unroll
            for (int e = 0; e < 8; ++e) {
                const float lo = (j & 1) ? acc[j >> 1][e].y : acc[j >> 1][e].x, hi = (j & 1) ? acc[j >> 1][e + 8].y : acc[j >> 1][e + 8].x;
                const float snd = b5 ? lo : hi, kp = b5 ? hi : lo; r8[e] = kp + __shfl_xor(snd, 32);
            }
#pragma unroll
            for (int e = 0; e < 4; ++e) { const float snd = b4 ? r8[e] : r8[e + 4], kp = b4 ? r8[e + 4] : r8[e]; r4[e] = kp + __shfl_xor(snd, 16); }
#pragma unroll
            for (int e = 0; e < 2; ++e) { const float snd = b3 ? r4[e] : r4[e + 2], kp = b3 ? r4[e + 2] : r4[e]; r2[e] = kp + __shfl_xor(snd, 8); }
            float rv; { const float snd = b2 ? r2[0] : r2[1], kp = b2 ? r2[1] : r2[0]; rv = kp + __shfl_xor(snd, 4); }
            rv += __shfl_xor(rv, 2); rv += __shfl_xor(rv, 1);
            if (j < nv) {
                if ((lane & 3) == 0) lgb[(wave * 16 + it) * 16 + (lane >> 2)] = rv;
                if (lane == it) myrow = row0 + j * rstride;
                ++it;
            }
        }
        if (it == 16) { route_flush(p, lds, lane, wave, it, myrow, layer); it = 0; }
    }
    if (it > 0) route_flush(p, lds, lane, wave, it, myrow, layer);
}

template <class WF, class XF, class EPI>
__device__ __forceinline__ void gemm_tile(char* lds, int nkt, WF wf, XF xf, EPI epi) {
    const int tid = TID(), lane = tid & 63, wave = tid >> 6;
    const int wn = wave & 1, wm = wave >> 1, hh = lane >> 5;
    const int lrow = tid >> 3;
    const int lchunk = (tid & 7) ^ ((tid >> 4) & 7);
    const half_t* xs[4];
#pragma unroll
    for (int i = 0; i < 4; ++i) xs[i] = xf(lrow + 32 * i) + lchunk * 8;
    char* ldst = lds + lrow * 128 + (tid & 7) * 16;
    f16v acc[2][2];
#pragma unroll
    for (int i = 0; i < 2; ++i)
#pragma unroll
        for (int j = 0; j < 2; ++j)
#pragma unroll
            for (int r = 0; r < 16; ++r) acc[i][j][r] = 0.f;
    auto issue = [&](int kt, int s) {
        char* d = ldst + s * 32768;
#pragma unroll
        for (int i = 0; i < 4; ++i) glds16(wf(kt, lrow + 32 * i) + lchunk * 8, d + i * 4096);
#pragma unroll
        for (int i = 0; i < 4; ++i) glds16(xs[i] + kt * 64, d + 16384 + i * 4096);
    };
    __syncthreads();
    issue(0, 0);
    const int rsw = (lane >> 1) & 7;
    const int roff_w = (wn * 64 + (lane & 31)) * 128, roff_x = 16384 + (wm * 64 + (lane & 31)) * 128;
    for (int kt = 0; kt < nkt; ++kt) {
        asm volatile("s_waitcnt vmcnt(0)" ::: "memory");
        __syncthreads();
        if (kt + 1 < nkt) issue(kt + 1, (kt + 1) & 1);
        const char* base = lds + (kt & 1) * 32768;
#pragma unroll
        for (int ks = 0; ks < 4; ++ks) {
            const int co = ((2 * ks + hh) ^ rsw) << 4;
            const h8 a0 = *(const h8*)(base + roff_w + co), a1 = *(const h8*)(base + roff_w + 4096 + co);
            const h8 b0 = *(const h8*)(base + roff_x + co), b1 = *(const h8*)(base + roff_x + 4096 + co);
            acc[0][0] = __builtin_amdgcn_mfma_f32_32x32x16_f16(a0, b0, acc[0][0], 0, 0, 0);
            acc[0][1] = __builtin_amdgcn_mfma_f32_32x32x16_f16(a0, b1, acc[0][1], 0, 0, 0);
            acc[1][0] = __builtin_amdgcn_mfma_f32_32x32x16_f16(a1, b0, acc[1][0], 0, 0, 0);
            acc[1][1] = __builtin_amdgcn_mfma_f32_32x32x16_f16(a1, b1, acc[1][1], 0, 0, 0);
        }
    }
    epi(acc, wn, wm, lane);
}

template <class WF, class XF, class EPI>
__device__ __forceinline__ void gemm_tile2(char* lds, int nkt, size_t xkstride, WF wf, XF xf, EPI epi) {
    const int tid = TID(), lane = tid & 63, wave = tid >> 6;
    const int wn = wave & 1, wm = wave >> 1, hh = lane >> 5;
    const int lrow = tid >> 2;
    const int lchunk = (tid & 3) ^ ((tid >> 4) & 3);
    const half_t* xs[2];
#pragma unroll
    for (int i = 0; i < 2; ++i) xs[i] = xf(lrow + 64 * i) + lchunk * 8;
    char* ldst = lds + lrow * 64 + (tid & 3) * 16;
    f16v acc[4][2];
#pragma unroll
    for (int i = 0; i < 4; ++i)
#pragma unroll
        for (int j = 0; j < 2; ++j)
#pragma unroll
            for (int r = 0; r < 16; ++r) acc[i][j][r] = 0.f;
    auto issue = [&](int kt, int s) {
        char* d = ldst + s * 24576;
#pragma unroll
        for (int i = 0; i < 4; ++i) glds16(wf(kt, lrow + 64 * i) + lchunk * 8, d + i * 4096);
#pragma unroll
        for (int i = 0; i < 2; ++i) glds16(xs[i] + (size_t)kt * xkstride, d + 16384 + i * 4096);
    };
    __syncthreads();
    issue(0, 0); issue(1, 1);
    const int rsw = (lane >> 2) & 3;
    const int roff_w = (wn * 128 + (lane & 31)) * 64, roff_x = 16384 + (wm * 64 + (lane & 31)) * 64;
    int st = 0;
    for (int kt = 0; kt < nkt; ++kt) {
        if (kt + 1 < nkt) asm volatile("s_waitcnt vmcnt(6)" ::: "memory");
        else asm volatile("s_waitcnt vmcnt(0)" ::: "memory");
        asm volatile("s_waitcnt lgkmcnt(0)" ::: "memory");
        __builtin_amdgcn_s_barrier();
        if (kt + 2 < nkt) issue(kt + 2, st >= 1 ? st - 1 : 2);
        const char* base = lds + st * 24576;
        st = st == 2 ? 0 : st + 1;
#pragma unroll
        for (int ks = 0; ks < 2; ++ks) {
            const int co = ((2 * ks + hh) ^ rsw) << 4;
            h8 a[4], b[2];
#pragma unroll
            for (int i = 0; i < 4; ++i) a[i] = *(const h8*)(base + roff_w + i * 2048 + co);
#pragma unroll
            for (int j = 0; j < 2; ++j) b[j] = *(const h8*)(base + roff_x + j * 2048 + co);
#pragma unroll
            for (int i = 0; i < 4; ++i)
#pragma unroll
                for (int j = 0; j < 2; ++j) acc[i][j] = __builtin_amdgcn_mfma_f32_32x32x16_f16(a[i], b[j], acc[i][j], 0, 0, 0);
        }
    }
    epi(acc, wn, wm, lane);
}

__device__ __forceinline__ void phase_inproj(KP p, char* lds, int l) {
    const half_t* W = p->Wt_in + (size_t)l * NP * DM;
    const float* rc16 = p->rope; const float* rs16 = p->rope + 16384; const float* rc8 = p->rope + 32768; const float* rs8 = p->rope + 32768 + 8192;
    for (int u = BID(); u < 256 * 10; u += gridDim.x) {
        const int xl = u & 7, Lx = u >> 3, mi = Lx & 15, rr_ = Lx >> 4;
        const int nt = rr_ % 10, mt = 32 * xl + 16 * (rr_ / 10) + mi;
        gemm_tile2(lds, 32, (size_t)T_TOK * 32,
            [&](int kt, int row) { int n = nt * 256 + row; n = n < NP ? n : NP - 1; return W + ((size_t)kt * NP + n) * 32; },
            [&](int row) { return p->hn + (size_t)(mt * 128 + row) * 32; },
            [&](f16v (&acc)[4][2], int wn, int wm, int lane) {
                const int hh = lane >> 5;
                half_t* stg = (half_t*)lds;
                __syncthreads();
#pragma unroll
                for (int i = 0; i < 4; ++i) {
                    const int nb = nt * 256 + wn * 128 + i * 32;
                    if (nb == 1216 || nb == 1248 || nb >= NP) continue;
                    if (nt < 2) {
                        if (i & 1) continue;
#pragma unroll
                        for (int j = 0; j < 2; ++j) {
                            half_t* dst = stg + (wm * 64 + j * 32 + (lane & 31)) * 260 + wn * 64 + (i >> 1) * 32 + 4 * hh;
#pragma unroll
                            for (int g = 0; g < 4; ++g) {
                                float a4[4];
#pragma unroll
                                for (int r = 0; r < 4; ++r) a4[r] = acc[i][j][4 * g + r] * sigmoidf_(acc[i + 1][j][4 * g + r]);
                                *(h4*)(dst + 8 * g) = pack4(a4[0], a4[1], a4[2], a4[3]);
                            }
                        }
                        continue;
                    }
                    const bool rope64 = ((nb >= PC_DQ && nb < PC_DV) || (nb >= PC_MQ && nb < PC_MV)) && ((nb & 63) == 0);
                    const bool rope32 = (nb >= PC_IQ && nb < PC_IW);
#pragma unroll
                    for (int j = 0; j < 2; ++j) {
                        const int tok = mt * 128 + wm * 64 + j * 32 + (lane & 31);
                        const int t = tok & 2047;
                        f16v v = acc[i][j];
                        if (nb == PC_IW) { if (hh == 0) *(float4*)(p->iwf + (size_t)tok * 4) = make_float4(v[0], v[1], v[2], v[3]); continue; }
                        if (rope64) {
                            const float4 c4 = *(const float4*)(rc16 + t * 8 + 4 * hh), s4 = *(const float4*)(rs16 + t * 8 + 4 * hh);
                            const float cc[4] = {c4.x, c4.y, c4.z, c4.w}, sn[4] = {s4.x, s4.y, s4.z, s4.w};
#pragma unroll
                            for (int r = 0; r < 4; ++r) { const float x1 = v[r], x2 = v[r + 4]; v[r] = x1 * cc[r] - x2 * sn[r]; v[r + 4] = x2 * cc[r] + x1 * sn[r]; }
                        } else if (rope32) {
                            const float4 c4 = *(const float4*)(rc8 + t * 4), s4 = *(const float4*)(rs8 + t * 4);
                            const float cc[4] = {c4.x, c4.y, c4.z, c4.w}, sn[4] = {s4.x, s4.y, s4.z, s4.w};
#pragma unroll
                            for (int r = 0; r < 4; ++r) { const float o = __shfl_xor(v[r], 32); v[r] = hh ? (v[r] * cc[r] + o * sn[r]) : (v[r] * cc[r] - o * sn[r]); }
                        }
                        if ((nb >= PC_DQ && nb < PC_DK) || (nb >= PC_MQ && nb < PC_MK)) {
#pragma unroll
                            for (int r = 0; r < 16; ++r) v[r] *= 0.18033688011112042f;
                        }
                        half_t* dst = stg + (wm * 64 + j * 32 + (lane & 31)) * 260 + wn * 128 + i * 32 + 4 * hh;
#pragma unroll
                        for (int g = 0; g < 4; ++g) *(h4*)(dst + 8 * g) = pack4(v[4 * g], v[4 * g + 1], v[4 * g + 2], v[4 * g + 3]);
                    }
                }
                __syncthreads();
                const int wv_ = TID() >> 6;
#pragma unroll 4
                for (int it = 0; it < 32; ++it) {
                    const int row = it * 4 + wv_;
                    const uint2 v2 = *(const uint2*)(stg + row * 260 + lane * 4);
                    if (nt < 2) { if (lane < 32) *(uint2*)(p->P + (size_t)(mt * 128 + row) * NP + nt * 128 + lane * 4) = v2; }
                    else { const int n = nt * 256 + lane * 4; if (n < NP) *(uint2*)(p->P + (size_t)(mt * 128 + row) * NP + n) = v2; }
                }
            });
    }
}

__device__ __forceinline__ void stage_acc_f32(char* lds, const f16v (&acc)[2][2], int wn, int wm, int lane) {
    float* stg = (float*)lds;
    const int hh = lane >> 5;
    __syncthreads();
#pragma unroll
    for (int j = 0; j < 2; ++j)
#pragma unroll
        for (int i = 0; i < 2; ++i)
#pragma unroll
            for (int g = 0; g < 4; ++g)
                *(float4*)(stg + (wm * 64 + j * 32 + (lane & 31)) * 132 + wn * 64 + i * 32 + 4 * hh + 8 * g) = make_float4(acc[i][j][4 * g], acc[i][j][4 * g + 1], acc[i][j][4 * g + 2], acc[i][j][4 * g + 3]);
    __syncthreads();
}
template <bool HIN>
__device__ __forceinline__ void phase_outproj(KP p, char* lds, int l, const void* xin) {
    const half_t* W = p->Wt_o + (size_t)l * DM * DM;
    const float* g1 = p->modf + (size_t)l * 16 * 6144 + 2 * 1024;
    for (int u = BID(); u < 256 * 4; u += gridDim.x) {
        const int xl = u & 7, Lx = u >> 3, mi = Lx & 7, rr_ = Lx >> 3;
        const int nt = rr_ & 3, mt = 32 * xl + 8 * (rr_ >> 2) + mi;
        gemm_tile2(lds, 32, (size_t)T_TOK * 32,
            [&](int kt, int row) { return W + ((size_t)kt * DM + nt * 256 + row) * 32; },
            [&](int row) { return p->ycat + (size_t)(mt * 128 + row) * 32; },
            [&](f16v (&acc)[4][2], int wn, int wm, int lane) {
                const int hh = lane >> 5, tid = TID();
                float* stg = (float*)lds;
#pragma unroll
                for (int rnd = 0; rnd < 2; ++rnd) {
                    __syncthreads();
                    if (wm == rnd) {
#pragma unroll
                        for (int j = 0; j < 2; ++j)
#pragma unroll
                            for (int i = 0; i < 4; ++i)
#pragma unroll
                                for (int g = 0; g < 4; ++g)
                                    *(float4*)(stg + (j * 32 + (lane & 31)) * 260 + wn * 128 + i * 32 + 4 * hh + 8 * g) = make_float4(acc[i][j][4 * g], acc[i][j][4 * g + 1], acc[i][j][4 * g + 2], acc[i][j][4 * g + 3]);
                    }
                    __syncthreads();
#pragma unroll 4
                    for (int it = 0; it < 16; ++it) {
                        const int idx = it * 256 + tid, row = idx >> 6, c = idx & 63;
                        const int tok = mt * 128 + rnd * 64 + row, n = nt * 256 + 4 * c;
                        const float4 a4 = *(const float4*)(stg + row * 260 + 4 * c);
                        const float4 xi = ldx4<HIN>(xin, (size_t)tok * DM + n);
                        const float4 gg = *(const float4*)(g1 + (size_t)(tok >> 11) * 6144 + n);
                        *(h4*)(p->xr + (size_t)tok * DM + n) = pack4(xi.x + gg.x * a4.x, xi.y + gg.y * a4.y, xi.z + gg.z * a4.z, xi.w + gg.w * a4.w);
                    }
                }
            });
    }
}

struct MoeTab { int tb, nt, nc; };
__device__ __forceinline__ MoeTab moe_table(const int* cnt) {
    const int c = TID() & 31;
    MoeTab t;
    t.nc = (c < NCLS) ? cnt[c * 64] : 0;
    t.nt = (t.nc + 127) >> 7;
    int incl = t.nt;
#pragma unroll
    for (int o = 1; o < 32; o <<= 1) { const int v = __shfl_up(incl, o, 32); if (c >= o) incl += v; }
    t.tb = incl - t.nt;
    return t;
}
__device__ __forceinline__ bool moe_tile(const MoeTab& t, int tile, int& cls, int& pos0, int& n) {
    const unsigned long long m = __ballot(tile >= t.tb && tile < t.tb + t.nt);
    if (m == 0ull) return false;
    cls = __ffsll((long long)m) - 1;
    pos0 = (tile - __builtin_amdgcn_readlane(t.tb, cls)) * 128;
    n = __builtin_amdgcn_readlane(t.nc, cls);
    return true;
}
__device__ __forceinline__ void cls_experts(int cls, int& e1, int& e2) {
    const int g = cls / 6, pi = cls % 6;
    const int a = pi < 3 ? 0 : (pi < 5 ? 1 : 2);
    const int b = pi < 3 ? pi + 1 : (pi < 5 ? pi - 1 : 3);
    e1 = g * 4 + a; e2 = g * 4 + b;
}
__device__ __forceinline__ void phase_moe_up(KP p, char* lds, int l) {
    const MoeTab tab = moe_table(p->cnt + l * 32 * 64);
    for (int u = BID(); u < (256 + NCLS) * 8; u += gridDim.x) {
        const int xl = u & 7, Lx = u >> 3;
        const int nt = Lx & 7, tile = (Lx >> 3) * 8 + xl;
        int cls, pos0, nc;
        if (!moe_tile(tab, tile, cls, pos0, nc)) continue;
        int e1, e2; cls_experts(cls, e1, e2);
        const int slot = nt >> 2;
        const half_t* W = p->Wt_gu + ((size_t)(l * 16 + (slot ? e2 : e1)) * 512 + (nt & 3) * 128) * 1024;
        const int* lst = p->lists + (size_t)cls * T_TOK + pos0;
        const int nvalid = nc - pos0;
        int tokE[2]; float wgtE[2];
        {
            const int lane_ = TID() & 63, wm_ = TID() >> 7;
#pragma unroll
            for (int j = 0; j < 2; ++j) {
                const int row = wm_ * 64 + j * 32 + (lane_ & 31);
                tokE[j] = lst[row < nvalid ? row : 0];
                wgtE[j] = p->tokw[(size_t)tokE[j] * 2 + slot];
            }
        }
        gemm_tile(lds, 16,
            [&](int kt, int row) { return W + (size_t)row * 1024 + kt * 64; },
            [&](int row) { const int tok = lst[row < nvalid ? row : 0]; return p->hn + (size_t)tok * DM; },
            [&](f16v (&acc)[2][2], int wn, int wm, int lane) {
                const int hh = lane >> 5;
#pragma unroll
                for (int j = 0; j < 2; ++j) {
                    const int row = wm * 64 + j * 32 + (lane & 31);
                    if (row < nvalid) {
                        const int tok = tokE[j];
                        const float wgt = wgtE[j];
                        half_t* dst = p->act + (size_t)tok * 512 + slot * 256 + ((nt & 3) * 2 + wn) * 32 + 4 * hh;
#pragma unroll
                        for (int g = 0; g < 4; ++g) {
                            float a[4];
#pragma unroll
                            for (int r = 0; r < 4; ++r) { const float gv = acc[0][j][4 * g + r], uv = acc[1][j][4 * g + r]; a[r] = gv * sigmoidf_(gv) * uv * wgt; }
                            *(h4*)(dst + 8 * g) = pack4(a[0], a[1], a[2], a[3]);
                        }
                    }
                }
            });
    }
}
__device__ __forceinline__ void phase_moe_down(KP p, char* lds, int l, float gsc) {
    const MoeTab tab = moe_table(p->cnt + l * 32 * 64);
    const float* g2 = p->modf + (size_t)l * 16 * 6144 + 5 * 1024;
    for (int u = BID(); u < (256 + NCLS) * 8; u += gridDim.x) {
        const int xl = u & 7, Lx = u >> 3;
        const int nt = Lx & 7, tile = (Lx >> 3) * 8 + xl;
        int cls, pos0, nc;
        if (!moe_tile(tab, tile, cls, pos0, nc)) continue;
        int e1, e2; cls_experts(cls, e1, e2);
        const half_t* W1 = p->Wt_d + ((size_t)(l * 16 + e1) * 1024 + nt * 128) * 256;
        const half_t* W2 = p->Wt_d + ((size_t)(l * 16 + e2) * 1024 + nt * 128) * 256;
        const int* lst = p->lists + (size_t)cls * T_TOK + pos0;
        const int nvalid = nc - pos0;
        int tokS[8];
        {
            const int r0 = TID() >> 4;
#pragma unroll
            for (int it = 0; it < 8; ++it) { const int row = it * 16 + r0; tokS[it] = lst[row < nvalid ? row : 0]; }
        }
        gemm_tile(lds, 8,
            [&](int kt, int row) { return (kt < 4 ? W1 : W2) + (size_t)row * 256 + (kt & 3) * 64; },
            [&](int row) { const int tok = lst[row < nvalid ? row : 0]; return p->act + (size_t)tok * 512; },
            [&](f16v (&acc)[2][2], int wn, int wm, int lane) {
                const int hh = lane >> 5, tid = TID();
                float* stg = (float*)lds;
                __syncthreads();
#pragma unroll
                for (int j = 0; j < 2; ++j)
#pragma unroll
                    for (int i = 0; i < 2; ++i)
#pragma unroll
                        for (int g = 0; g < 4; ++g)
                            *(float4*)(stg + (wm * 64 + j * 32 + (lane & 31)) * 132 + wn * 64 + i * 32 + 8 * g + 4 * hh) =
                                make_float4(acc[i][j][4 * g], acc[i][j][4 * g + 1], acc[i][j][4 * g + 2], acc[i][j][4 * g + 3]);
                __syncthreads();
                const int r0 = tid >> 4, c8 = (tid & 15) * 8;
#pragma unroll
                for (int it = 0; it < 8; ++it) {
                    const int row = it * 16 + r0;
                    if (row < nvalid) {
                        const int tok = tokS[it];
                        const int n = nt * 128 + c8;
                        const float* gp = g2 + (size_t)(tok >> 11) * 6144 + n;
                        const float4 a0 = *(const float4*)(stg + row * 132 + c8), a1 = *(const float4*)(stg + row * 132 + c8 + 4);
                        const float4 g0 = *(const float4*)gp, g1 = *(const float4*)(gp + 4);
                        h8* xp = (h8*)(p->xr + (size_t)tok * DM + n);
                        const h8 xi = *xp;
                        h8 o;
                        o[0] = (half_t)((float)xi[0] + gsc * g0.x * a0.x); o[1] = (half_t)((float)xi[1] + gsc * g0.y * a0.y);
                        o[2] = (half_t)((float)xi[2] + gsc * g0.z * a0.z); o[3] = (half_t)((float)xi[3] + gsc * g0.w * a0.w);
                        o[4] = (half_t)((float)xi[4] + gsc * g1.x * a1.x); o[5] = (half_t)((float)xi[5] + gsc * g1.y * a1.y);
                        o[6] = (half_t)((float)xi[6] + gsc * g1.z * a1.z); o[7] = (half_t)((float)xi[7] + gsc * g1.w * a1.w);
                        *xp = o;
                    }
                }
            });
    }
}

__device__ __forceinline__ void dsa_select_unit(KP p, char* lds, int b, int qt) {
    unsigned* hist = (unsigned*)lds;
    unsigned* maskl = hist + 16 * 257 + 16;
    unsigned* stP = maskl + 1024;
    unsigned* stNeed = stP + 16;
    unsigned* stDone = stNeed + 16;
    unsigned* flag = stDone + 16;
    unsigned* dummyb = flag + 16;
    const int tid = TID(), lane = tid & 63, wave = tid >> 6;
    const int q0 = qt * 16, tokbase = b * SEQ;
    __syncthreads();
    if (q0 < 256) {
        for (int i = tid; i < 1024; i += 256) {
            const int q = i >> 6, wd = i & 63;
            const int n = q0 + q + 1 - 32 * wd;
            const unsigned w = n >= 32 ? 0xFFFFFFFFu : (n <= 0 ? 0u : ((1u << n) - 1u));
            p->dmask[(size_t)(tokbase + q0 + q) * 64 + wd] = w;
        }
        return;
    }
    for (int i = tid; i < 1024; i += 256) maskl[i] = 0u;
    if (tid < 16) { stP[tid] = 0u; stNeed[tid] = 256u; stDone[tid] = 0u; }
    for (int i = tid; i < 16 * 257; i += 256) hist[i] = 0u;
    __syncthreads();
    const int ql = lane & 15, fq = lane >> 4;
    const int tq = q0 + ql;
    const half_t* Pb = p->P + (size_t)tokbase * NP;
    h8 iqf[4];
#pragma unroll
    for (int hd = 0; hd < 4; ++hd) iqf[hd] = *(const h8*)(Pb + (size_t)tq * NP + PC_IQ + hd * 32 + 8 * fq);
    const float4 iw4 = *(const float4*)(p->iwf + (size_t)(tokbase + tq) * 4);
    const float wsc0 = iw4.x * 0.08838834764831845f, wsc1 = iw4.y * 0.08838834764831845f, wsc2 = iw4.z * 0.08838834764831845f, wsc3 = iw4.w * 0.08838834764831845f;
    const int ng = qt + 1;
    unsigned sc[32][4];
    const half_t* ikp = Pb + (size_t)ql * NP + PC_IK + 8 * fq;
#pragma unroll
    for (int gb = 0; gb < 4; ++gb) {
        h8 ik[8];
#pragma unroll
        for (int x = 0; x < 8; ++x) {
            int g = wave + 4 * (gb * 8 + x);
            g = g < ng ? g : ng - 1;
            ik[x] = *(const h8*)(ikp + (size_t)(16 * g) * NP);
        }
#pragma unroll
        for (int x = 0; x < 8; ++x) {
            const int gi = gb * 8 + x;
            const int g = wave + 4 * gi;
            const f4v z = {0.f, 0.f, 0.f, 0.f};
            const f4v c0 = __builtin_amdgcn_mfma_f32_16x16x32_f16(ik[x], iqf[0], z, 0, 0, 0);
            const f4v c1 = __builtin_amdgcn_mfma_f32_16x16x32_f16(ik[x], iqf[1], z, 0, 0, 0);
            const f4v c2 = __builtin_amdgcn_mfma_f32_16x16x32_f16(ik[x], iqf[2], z, 0, 0, 0);
            const f4v c3 = __builtin_amdgcn_mfma_f32_16x16x32_f16(ik[x], iqf[3], z, 0, 0, 0);
#pragma unroll
            for (int r = 0; r < 4; ++r) {
                const int j = 16 * g + 4 * fq + r;
                float sv = wsc0 * __builtin_amdgcn_fmed3f(c0[r], 0.f, INFINITY);
                sv = fmaf(wsc1, __builtin_amdgcn_fmed3f(c1[r], 0.f, INFINITY), sv);
                sv = fmaf(wsc2, __builtin_amdgcn_fmed3f(c2[r], 0.f, INFINITY), sv);
                sv = fmaf(wsc3, __builtin_amdgcn_fmed3f(c3[r], 0.f, INFINITY), sv);
                sv += 0.0f;
                const int sb = __float_as_int(sv);
                const unsigned su = (unsigned)sb ^ ((unsigned)(sb >> 31) | 0x80000000u);
                const unsigned ck = (su & 0xFFFFF800u) | (unsigned)(2047 - j);
                sc[gi][r] = (g < ng && j <= tq) ? ck : 0u;
            }
            if (g < ng) {
#pragma unroll
                for (int r = 0; r < 4; ++r) atomicAdd(hist + ql * 257 + (sc[gi][r] >> 24), 1u);
            }
        }
    }
    bool alldone = false;
    for (int pass = 0; pass < 5; ++pass) {
        const bool fin = alldone;
        if (!fin && pass > 0) { for (int i = tid; i < 16 * 257; i += 256) hist[i] = 0u; }
        if (tid == 0) *flag = 0u;
        __syncthreads();
        if (pass > 0) {
        const unsigned sP = stP[ql], sDone = stDone[ql];
        int wv = wave, fqv = fq;
        asm volatile("" : "+v"(wv), "+v"(fqv));
        if (fin) {
            const int sh = (int)(32u - 8u * (sDone ? sDone : 1u));
            unsigned* mrow = maskl + ql * 64;
#pragma unroll
            for (int gi = 0; gi < 32; ++gi) {
                const int g = wv + 4 * gi;
                unsigned nib = 0u;
#pragma unroll
                for (int r = 0; r < 4; ++r) {
                    const unsigned uu = sc[gi][r];
                    nib |= ((uu >> sh) >= sP) ? (1u << r) : 0u;
                }
                if (g < ng) atomicOr(&mrow[g >> 1], nib << ((g & 1) * 16 + 4 * fqv));
            }
        } else {
            const int shm = pass ? 32 - 8 * pass : 0, shd = 24 - 8 * pass;
            const unsigned orm = pass ? 0u : 0xFFFFFFFFu;
            const unsigned cmpv = pass ? (sDone == 0u ? sP : 0xFFFFFFFFu) : 0xFFFFFFFFu;
            unsigned* hrow = hist + ql * 257;
            unsigned* dummy = dummyb + lane;
#pragma unroll
            for (int gi = 0; gi < 32; ++gi) {
                const int g = wv + 4 * gi;
                if (g < ng) {
#pragma unroll
                    for (int r = 0; r < 4; ++r) {
                        const unsigned uu = sc[gi][r];
                        const bool match = (((uu >> shm) | orm) == cmpv);
                        const unsigned dig = (uu >> shd) & 255u;
                        unsigned* a = match ? hrow + dig : dummy;
                        atomicAdd(a, 1u);
                    }
                }
            }
        }
        }
        __syncthreads();
        if (fin) break;
        {
            const int qq = tid >> 4, seg = tid & 15;
            const bool active = (stDone[qq] == 0u);
            unsigned c16 = 0u;
            if (active) {
#pragma unroll
                for (int d = 0; d < 16; ++d) c16 += hist[qq * 257 + seg * 16 + d];
            }
            unsigned v = c16;
#pragma unroll
            for (int off = 1; off < 16; off <<= 1) { const unsigned t = __shfl_down(v, off, 16); if (seg + off < 16) v += t; }
            const unsigned suf = v - c16;
            const unsigned need = stNeed[qq];
            if (active && suf < need && need <= suf + c16) {
                unsigned run = suf, D = 0u, cD = 0u, nn = need;
                for (int d = 15; d >= 0; --d) {
                    const unsigned cc = hist[qq * 257 + seg * 16 + d];
                    if (run + cc >= need) { D = (unsigned)(seg * 16 + d); cD = cc; nn = need - run; break; }
                    run += cc;
                }
                const bool done = (cD == nn) || pass == 3;
                stP[qq] = (stP[qq] << 8) | D; stNeed[qq] = nn;
                if (done) stDone[qq] = (unsigned)(pass + 1); else atomicAdd(flag, 1u);
            }
        }
        __syncthreads();
        alldone = (*flag == 0u);
    }
    for (int i = tid; i < 1024; i += 256) p->dmask[(size_t)(tokbase + q0 + (i >> 6)) * 64 + (i & 63)] = maskl[i];
}

__device__ __forceinline__ void conv_unit(KP p, char* lds, int l, int b, int c) {
    float* red = (float*)lds;
    const int ch = TID(), lane = ch & 63, wave = ch >> 6;
    const int t0 = c * 32, tokbase = b * SEQ;
    half_t* tile = (half_t*)(lds + 4096);
    __syncthreads();
#pragma unroll
    for (int it = 0; it < 8; ++it) {
        const int i = it * 256 + ch;
        if (i < 62 * 32) {
            const int rr = i >> 5, c16 = i & 31;
            const int tt = t0 - 30 + rr;
            h8 v;
#pragma unroll
            for (int j = 0; j < 8; ++j) v[j] = (half_t)0.f;
            if (tt >= 0) v = *(const h8*)(p->P + (size_t)(tokbase + tt) * NP + c16 * 8);
            *(h8*)(tile + rr * 256 + c16 * 8) = v;
        }
    }
    __syncthreads();
    float aw[62];
#pragma unroll
    for (int rr = 0; rr < 62; ++rr) aw[rr] = (float)tile[rr * 256 + ch];
    float w[31];
#pragma unroll
    for (int i = 0; i < 31; ++i) w[i] = p->w_dw[(l * 31 + i) * 256 + ch];
    const float bias = p->b_dw[l * 256 + ch];
    float y[32], s1[32], s2[32];
#pragma unroll
    for (int tk = 0; tk < 32; ++tk) {
        float sacc = bias;
#pragma unroll
        for (int i = 0; i < 31; ++i) sacc = fmaf(aw[tk + i], w[i], sacc);
        y[tk] = sacc; s1[tk] = sacc; s2[tk] = sacc * sacc;
    }
    {
        const bool b5 = lane & 32, b4 = lane & 16, b3 = lane & 8, b2 = lane & 4, b1 = lane & 2;
        float a16[16], c16[16], a8[8], c8[8], a4[4], c4[4], a2[2], c2[2];
#pragma unroll
        for (int e = 0; e < 16; ++e) { a16[e] = (b5 ? s1[e + 16] : s1[e]) + __shfl_xor(b5 ? s1[e] : s1[e + 16], 32); c16[e] = (b5 ? s2[e + 16] : s2[e]) + __shfl_xor(b5 ? s2[e] : s2[e + 16], 32); }
#pragma unroll
        for (int e = 0; e < 8; ++e) { a8[e] = (b4 ? a16[e + 8] : a16[e]) + __shfl_xor(b4 ? a16[e] : a16[e + 8], 16); c8[e] = (b4 ? c16[e + 8] : c16[e]) + __shfl_xor(b4 ? c16[e] : c16[e + 8], 16); }
#pragma unroll
        for (int e = 0; e < 4; ++e) { a4[e] = (b3 ? a8[e + 4] : a8[e]) + __shfl_xor(b3 ? a8[e] : a8[e + 4], 8); c4[e] = (b3 ? c8[e + 4] : c8[e]) + __shfl_xor(b3 ? c8[e] : c8[e + 4], 8); }
#pragma unroll
        for (int e = 0; e < 2; ++e) { a2[e] = (b2 ? a4[e + 2] : a4[e]) + __shfl_xor(b2 ? a4[e] : a4[e + 2], 4); c2[e] = (b2 ? c4[e + 2] : c4[e]) + __shfl_xor(b2 ? c4[e] : c4[e + 2], 4); }
        float av = (b1 ? a2[1] : a2[0]) + __shfl_xor(b1 ? a2[0] : a2[1], 2), cv = (b1 ? c2[1] : c2[0]) + __shfl_xor(b1 ? c2[0] : c2[1], 2);
        av += __shfl_xor(av, 1); cv += __shfl_xor(cv, 1);
        const int tokk = (b5 ? 16 : 0) + (b4 ? 8 : 0) + (b3 ? 4 : 0) + (b2 ? 2 : 0) + (b1 ? 1 : 0);
        __syncthreads();
        if ((lane & 1) == 0) { red[(tokk * 4 + wave) * 2] = av; red[(tokk * 4 + wave) * 2 + 1] = cv; }
        __syncthreads();
    }
    const float lg = p->ln_g[l * 256 + ch], lb = p->ln_b[l * 256 + ch];
#pragma unroll
    for (int tk = 0; tk < 32; ++tk) {
        const float4 ra = *(const float4*)(red + tk * 8), rb = *(const float4*)(red + tk * 8 + 4);
        const float t1 = (ra.x + ra.z) + (rb.x + rb.z);
        const float t2 = (ra.y + ra.w) + (rb.y + rb.w);
        const float mu = t1 * (1.0f / 256.0f);
        float var = t2 * (1.0f / 256.0f) - mu * mu; var = var < 0.f ? 0.f : var;
        float z = (y[tk] - mu) * (1.0f / sqrtf(var + 1e-6f)) * lg + lb;
        z = z * sigmoidf_(z);
        p->ycat[((size_t)(ch >> 5) * T_TOK + tokbase + t0 + tk) * 32 + (ch & 31)] = (half_t)z;
    }
}

__device__ __forceinline__ void kmean_unit(KP p, char* lds, int b, int h, int blk) {
    float* part = (float*)lds;
    const int tid = TID(), c = tid & 7, rg = tid >> 3;
    const half_t* r = p->P + (size_t)(b * SEQ + blk * 256 + rg * 8) * NP + PC_MK + h * 64 + c * 8;
    h8 v[8];
#pragma unroll
    for (int k = 0; k < 8; ++k) v[k] = *(const h8*)(r + (size_t)k * NP);
    float sacc[8];
#pragma unroll
    for (int j = 0; j < 8; ++j) {
        float t = 0.f;
#pragma unroll
        for (int k = 0; k < 8; ++k) t += (float)v[k][j];
        sacc[j] = t;
    }
    __syncthreads();
    *(float4*)(part + rg * 64 + c * 8) = make_float4(sacc[0], sacc[1], sacc[2], sacc[3]);
    *(float4*)(part + rg * 64 + c * 8 + 4) = make_float4(sacc[4], sacc[5], sacc[6], sacc[7]);
    __syncthreads();
    if (tid < 64) {
        float t = 0.f;
#pragma unroll
        for (int g = 0; g < 32; ++g) t += part[g * 64 + tid];
        p->kmean[(((size_t)b * 6 + h) * 8 + blk) * 64 + tid] = t * (1.0f / 256.0f);
    }
}

#ifndef POST_MASK
#define POST_MASK 7
#endif
__device__ __forceinline__ void phase_post(KP p, char* lds, int l, int tm) {
    const int NA = 2048, NB = 1024, NC = 768;
    const int G_ = gridDim.x;
    for (int u0 = BID(), k_ = 0; u0 < NA + NB + NC; u0 += G_, ++k_) {
        int u = u0;
        if (u0 < NA && (k_ & 1) && (k_ + 1) * G_ <= NA) u = k_ * G_ + (G_ - 1 - (u0 - k_ * G_));
        if (u < NA) { if (tm & 1) dsa_select_unit(p, lds, u % 16, 127 - (u / 16)); }
        else if (u < NA + NB) { const int v = u - NA; if (tm & 2) conv_unit(p, lds, l, v % 16, v / 16); }
        else { const int v = u - NA - NB; if (tm & 4) kmean_unit(p, lds, v / 48, (v / 8) % 6, v % 8); }
    }
}

template <int MODE>
__device__ __forceinline__ void attn_unit(KP p, char* lds, int b, int h, int qt) {
    const int tid = TID(), lane = tid & 63, wave = tid >> 6, hh = lane >> 5, ql = lane & 31;
    const int q0 = qt * 128, tokbase = b * SEQ;
    const int tq = q0 + wave * 32 + ql;
    const half_t* Pb = p->P + (size_t)tokbase * NP;
    const int QOFF = MODE ? PC_MQ + h * 64 : PC_DQ + h * 64;
    const int KOFF = MODE ? PC_MK + h * 64 : PC_DK;
    const int VOFF = MODE ? PC_MV + h * 64 : PC_DV;
    const int own = qt >> 1;
    unsigned mysel = 0u, anysel = 0u;
    __syncthreads();
    h8 qf[4];
#pragma unroll
    for (int ks = 0; ks < 4; ++ks) qf[ks] = *(const h8*)(Pb + (size_t)tq * NP + QOFF + 16 * ks + 8 * hh);
    if (MODE == 1) {
        float* km = (float*)(lds + 32768);
        unsigned* anyb = (unsigned*)(km + 512);
        for (int i = tid; i < 512; i += 256) km[i] = p->kmean[((size_t)b * 6 + h) * 512 + i];
        if (tid == 0) *anyb = 0u;
        __syncthreads();
        float gt[8];
#pragma unroll
        for (int j = 0; j < 8; ++j) {
            float sacc = 0.f;
            if (j < own) {
#pragma unroll
                for (int ks = 0; ks < 4; ++ks) {
                    const float4 k0 = *(const float4*)(km + j * 64 + 16 * ks + 8 * hh), k1 = *(const float4*)(km + j * 64 + 16 * ks + 8 * hh + 4);
                    sacc = fmaf((float)qf[ks][0], k0.x, sacc); sacc = fmaf((float)qf[ks][1], k0.y, sacc); sacc = fmaf((float)qf[ks][2], k0.z, sacc); sacc = fmaf((float)qf[ks][3], k0.w, sacc);
                    sacc = fmaf((float)qf[ks][4], k1.x, sacc); sacc = fmaf((float)qf[ks][5], k1.y, sacc); sacc = fmaf((float)qf[ks][6], k1.z, sacc); sacc = fmaf((float)qf[ks][7], k1.w, sacc);
                }
            }
            gt[j] = sacc + __shfl_xor(sacc, 32);
        }
        unsigned m = 0u;
        const int want = own < 3 ? own : 3;
#pragma unroll
        for (int r = 0; r < 3; ++r) {
            if (r < want) {
                int best = -1; float bv = -INFINITY;
#pragma unroll
                for (int j = 0; j < 8; ++j) { if (j < own && !((m >> j) & 1u) && (best < 0 || gt[j] > bv)) { best = j; bv = gt[j]; } }
                m |= 1u << best;
            }
        }
        mysel = m;
        unsigned wmk = m;
#pragma unroll
        for (int o = 16; o >= 1; o >>= 1) wmk |= (unsigned)__shfl_xor((int)wmk, o);
        if (lane == 0 && wmk) atomicOr(anyb, wmk);
        __syncthreads();
        anysel = *anyb;
    }
    f16v O0, O1;
#pragma unroll
    for (int r = 0; r < 16; ++r) { O0[r] = 0.f; O1[r] = 0.f; }
    float l_run = 0.f;
    bool unset = true;
    f16v negm;
#pragma unroll
    for (int r = 0; r < 16; ++r) negm[r] = 0.f;
    const float THR = 8.0f;
    const int ntile = 2 * qt + 2;
    auto skip = [&](int kt) -> bool { return MODE == 1 && kt < 4 * own && !((anysel >> (kt >> 2)) & 1u); };
    auto nexttile = [&](int kt) -> int { ++kt; while (kt < ntile && skip(kt)) ++kt; return kt; };
    const int lrow = tid >> 3;
    const int kchunk = (tid & 7) ^ ((tid >> 4) & 7);
    const int vchunk = (tid & 7) ^ (((tid >> 4) & 1) << 2);
    char* ldst = lds + lrow * 128 + (tid & 7) * 16;
    auto issue = [&](int kt, int s) {
        const half_t* src = Pb + (size_t)(kt * 64 + lrow) * NP;
        char* d = ldst + s * 16384;
        glds16(src + KOFF + kchunk * 8, d);
        glds16(src + (size_t)32 * NP + KOFF + kchunk * 8, d + 4096);
        glds16(src + VOFF + vchunk * 8, d + 8192);
        glds16(src + (size_t)32 * NP + VOFF + vchunk * 8, d + 8192 + 4096);
    };
    const int rsw = (lane >> 1) & 7;
    const int kro = ql * 128;
    const int li = lane & 15, qp = li >> 2, pp = li & 3, swv = (qp >> 1) & 1;
    const int vb0 = 8192 + (4 * hh + qp) * 128 + 32 * ((lane >> 4) & 1) + 8 * pp + 64 * (0 ^ swv);
    const int vb1 = 8192 + (4 * hh + qp) * 128 + 32 * ((lane >> 4) & 1) + 8 * pp + 64 * (1 ^ swv);
    int kt = -1; kt = nexttile(kt);
    int s = 0;
    if (kt < ntile) issue(kt, 0);
    while (kt < ntile) {
        const int ktn = nexttile(kt);
        asm volatile("s_waitcnt vmcnt(0)" ::: "memory");
        __syncthreads();
        if (ktn < ntile) issue(ktn, s ^ 1);
        const bool wave_active = (kt * 64 <= q0 + wave * 32 + 31);
        if (wave_active) {
            const char* base = lds + s * 16384;
            uint2 mw = make_uint2(0u, 0u);
            if (MODE == 0) mw = *(const uint2*)(p->dmask + (size_t)(tokbase + tq) * 64 + 2 * kt);
            h8 vf0[4], vf1[4];
#pragma unroll
            for (int kk = 0; kk < 4; ++kk) {
                const int roff = (32 * (kk >> 1) + 16 * (kk & 1)) * 128;
                const s4v lo0 = __builtin_amdgcn_ds_read_tr16_b64_v4i16((LAS s4v*)(base + vb0 + roff));
                const s4v hi0 = __builtin_amdgcn_ds_read_tr16_b64_v4i16((LAS s4v*)(base + vb0 + roff + 8 * 128));
                const s4v lo1 = __builtin_amdgcn_ds_read_tr16_b64_v4i16((LAS s4v*)(base + vb1 + roff));
                const s4v hi1 = __builtin_amdgcn_ds_read_tr16_b64_v4i16((LAS s4v*)(base + vb1 + roff + 8 * 128));
                vf0[kk] = __builtin_bit_cast(h8, __builtin_shufflevector(lo0, hi0, 0, 1, 2, 3, 4, 5, 6, 7));
                vf1[kk] = __builtin_bit_cast(h8, __builtin_shufflevector(lo1, hi1, 0, 1, 2, 3, 4, 5, 6, 7));
            }
            bool lane_on = true;
            if (MODE == 1 && kt < 4 * own) lane_on = (mysel >> (kt >> 2)) & 1u;
            f16v cin = negm;
            if (MODE == 1 && kt < 4 * own) {
#pragma unroll
                for (int r = 0; r < 16; ++r) cin[r] = lane_on ? negm[r] : -INFINITY;
            }
            f16v s0 = cin, s1 = cin;
#pragma unroll
            for (int ks = 0; ks < 4; ++ks) {
                const int co = ((2 * ks + hh) ^ rsw) << 4;
                const h8 k0 = *(const h8*)(base + kro + co), k1 = *(const h8*)(base + kro + 4096 + co);
                s0 = __builtin_amdgcn_mfma_f32_32x32x16_f16(k0, qf[ks], s0, 0, 0, 0);
                s1 = __builtin_amdgcn_mfma_f32_32x32x16_f16(k1, qf[ks], s1, 0, 0, 0);
            }
            if (MODE == 0) {
                const unsigned w0 = mw.x >> (4 * hh), w1 = mw.y >> (4 * hh);
#pragma unroll
                for (int r = 0; r < 16; ++r) {
                    const int pos = (r & 3) + 8 * (r >> 2);
                    const unsigned m0 = (unsigned)__builtin_amdgcn_sbfe((int)w0, pos, 1), m1 = (unsigned)__builtin_amdgcn_sbfe((int)w1, pos, 1);
                    s0[r] = __uint_as_float((__float_as_uint(s0[r]) & m0) | (0xFF800000u & ~m0));
                    s1[r] = __uint_as_float((__float_as_uint(s1[r]) & m1) | (0xFF800000u & ~m1));
                }
            } else if (kt >= 4 * own && kt * 64 + 63 > q0 + wave * 32) {
#pragma unroll
                for (int r = 0; r < 16; ++r) {
                    const int key = kt * 64 + (r & 3) + 8 * (r >> 2) + 4 * hh;
                    s0[r] = (key <= tq) ? s0[r] : -INFINITY;
                    s1[r] = (key + 32 <= tq) ? s1[r] : -INFINITY;
                }
            }
            float mx = s0[0];
#pragma unroll
            for (int r = 1; r < 16; ++r) mx = fmaxf(mx, s0[r]);
#pragma unroll
            for (int r = 0; r < 16; ++r) mx = fmaxf(mx, s1[r]);
            mx = fmaxf(mx, __shfl_xor(mx, 32));
            const bool need = unset ? (mx > -INFINITY) : (mx > THR);
            if (__any(need)) {
                const float delta = need ? mx : 0.f;
                const float alpha = (need && !unset) ? __builtin_amdgcn_exp2f(-delta) : 1.0f;
#pragma unroll
                for (int r = 0; r < 16; ++r) { s0[r] -= delta; s1[r] -= delta; negm[r] -= delta; O0[r] *= alpha; O1[r] *= alpha; }
                l_run *= alpha;
                unset = unset && !need;
            }
            float ls = 0.f;
#pragma unroll
            for (int r = 0; r < 16; ++r) { s0[r] = __builtin_amdgcn_exp2f(s0[r]); ls += s0[r]; }
#pragma unroll
            for (int r = 0; r < 16; ++r) { s1[r] = __builtin_amdgcn_exp2f(s1[r]); ls += s1[r]; }
            l_run += ls;
#pragma unroll
            for (int kk = 0; kk < 4; ++kk) {
                h8 pf;
#pragma unroll
                for (int j = 0; j < 8; ++j) pf[j] = (half_t)((kk >> 1) ? s1[8 * (kk & 1) + j] : s0[8 * (kk & 1) + j]);
                O0 = __builtin_amdgcn_mfma_f32_32x32x16_f16(vf0[kk], pf, O0, 0, 0, 0);
                O1 = __builtin_amdgcn_mfma_f32_32x32x16_f16(vf1[kk], pf, O1, 0, 0, 0);
            }
        }
        kt = ktn; s ^= 1;
    }
    const float lt = l_run + __shfl_xor(l_run, 32);
    const float inv = 1.0f / lt;
    const int ycol = (MODE ? 640 : 256) + h * 64;
    half_t* dst = p->ycat + ((size_t)(ycol >> 5) * T_TOK + tokbase + tq) * 32 + 4 * hh;
#pragma unroll
    for (int g = 0; g < 4; ++g) {
        *(h4*)(dst + 8 * g) = pack4(O0[4 * g] * inv, O0[4 * g + 1] * inv, O0[4 * g + 2] * inv, O0[4 * g + 3] * inv);
        *(h4*)(dst + (size_t)T_TOK * 32 + 8 * g) = pack4(O1[4 * g] * inv, O1[4 * g + 1] * inv, O1[4 * g + 2] * inv, O1[4 * g + 3] * inv);
    }
}

#ifndef ATT_MASK
#define ATT_MASK 3
#endif
__device__ __forceinline__ void phase_attn(KP p, char* lds, int tm) {
    const int G_ = gridDim.x, per_ = G_ >> 3;
    const bool snake_ = (G_ >= 8) && ((G_ & 7) == 0);
    for (int k_ = 0, b_ = BID(); snake_ ? (k_ * per_ < 384) : (b_ + k_ * G_ < 3072); ++k_) {
        int xl, Lx;
        if (snake_) { const int idx_ = b_ >> 3; xl = b_ & 7; Lx = k_ * per_ + ((k_ & 1) ? (per_ - 1 - idx_) : idx_); }
        else { const int u = b_ + k_ * G_; xl = u & 7; Lx = u >> 3; }
        if (Lx >= 384) continue;
        const int qt = 15 - (Lx / 24), rem = Lx % 24;
        const int type = rem & 1, bh = xl * 12 + (rem >> 1);
        if (type == 0) { if (tm & 1) attn_unit<0>(p, lds, bh / 6, bh % 6, qt); }
        else { if (tm & 2) attn_unit<1>(p, lds, bh / 6, bh % 6, qt); }
    }
}

__global__ void __launch_bounds__(256, 2) mk_fwd(Params p_unused) {
    extern __shared__ __attribute__((aligned(16))) char lds[];
    volatile LAS unsigned* stw = (volatile LAS unsigned*)(lds + LDS_CTL);
    if (threadIdx.x < 4) stw[threadIdx.x] = 0u;
    __syncthreads();
    KP p0 = (KP)__builtin_amdgcn_kernarg_segment_ptr();
    XcdBarrier bar; bar.bar = p0->bar; bar.x = 0; bar.st = stw;
#if !MK_SPLIT
    bar = xcd_barrier_post(p0->bar, stw);
#endif
    const int ph_lo = p0->ph_lo, ph_hi = p0->ph_hi;
    for (int ph = ph_lo; ph < ph_hi; ++ph) {
      KP p = p0; asm volatile("" : "+s"(p));
      const int nrep = (DUP_SUB >= 0 && ((DUP_SUB == 100 && ph == 0) || (ph >= 2 && ph < NPHASE - 1 && ((ph - 2) & 7) == DUP_SUB && (DUP_SUB != 4 || ph < 10)))) ? 2 : 1;
      for (int rep = 0; rep < nrep; ++rep) {
        if (ph == 0) phase_prologue(p, lds);
        else if (ph == 1) phase_modsum(p);
        else if (ph == NPHASE - 1) phase_norm<2, true>(p, lds, p->xr, p->g_final, nullptr, nullptr, 0);
        else {
            const int l = (ph - 2) >> 3, sub = (ph - 2) & 7;
            const float* mf = p->modf + (size_t)l * 16 * 6144;
            if (sub == 0) { if (l == 0) phase_norm<0, false>(p, lds, p->x, p->g_mix + l * DM, mf, mf + 1024, l); else phase_norm<0, true>(p, lds, p->xr, p->g_mix + l * DM, mf, mf + 1024, l); }
            else if (sub == 1) phase_inproj(p, lds, l);
            else if (sub == 2) phase_post(p, lds, l, rep ? POST_MASK : 7);
            else if (sub == 3) phase_attn(p, lds, rep ? ATT_MASK : 3);
            else if (sub == 4) { if (l == 0) phase_outproj<false>(p, lds, l, p->x); else phase_outproj<true>(p, lds, l, p->xr); }
            else if (sub == 5) phase_norm_router(p, lds, p->xr, p->g_ffn + l * DM, mf + 3 * 1024, mf + 4 * 1024, (nrep == 2 && rep == 0) ? l + 2 : l);
            else if (sub == 6) phase_moe_up(p, lds, l);
            else phase_moe_down(p, lds, l, nrep == 2 ? 0.5f : 1.0f);
        }
      }
#if !MK_SPLIT
        if (ph + 1 < ph_hi) xcd_barrier(bar);
#endif
    }
}

extern "C" void kernel_launch(void* const* d_in, const int* in_sizes, int n_in, void* d_out, int out_size, void* d_ws, size_t ws_size, hipStream_t stream) {
    static int grid = 0;
    if (grid == 0) {
        int dev = 0, cus = 0, per_cu = 0;
        (void)hipGetDevice(&dev);
        (void)hipDeviceGetAttribute(&cus, hipDeviceAttributeMultiprocessorCount, dev);
        (void)hipFuncSetAttribute((const void*)mk_fwd, hipFuncAttributeMaxDynamicSharedMemorySize, LDS_BYTES);
        if (hipOccupancyMaxActiveBlocksPerMultiprocessor(&per_cu, (const void*)mk_fwd, 256, LDS_BYTES) != hipSuccess || per_cu < 1) per_cu = 1;
        (void)hipGetLastError();
        if (per_cu > 2) per_cu = 2;
        grid = cus * per_cu;
        fprintf(stderr, "mk_fwd: cus %d per_cu %d grid %d\n", cus, per_cu, grid);
    }
    Params p{};
    const float** pin = (const float**)&p.x;
    for (int i = 0; i < 18; ++i) pin[i] = (const float*)d_in[i];
    p.out = (float*)d_out;
    char* ws = (char*)d_ws;
    size_t off = 0;
    auto carve = [&](size_t bytes) { void* q = ws + off; off += (bytes + 255) & ~(size_t)255; return q; };
    p.bar = (unsigned*)carve(XCD_BAR_WORDS * 4);
    p.cnt = (int*)carve(4 * 32 * 64 * 4);
    const size_t zero_bytes = off;
    p.Wt_in = (half_t*)carve((size_t)2 * NP * DM * 2);
    p.Wt_o = (half_t*)carve((size_t)2 * DM * DM * 2);
    p.Wt_gu = (half_t*)carve((size_t)2 * 16 * 512 * 1024 * 2);
    p.Wt_d = (half_t*)carve((size_t)2 * 16 * 1024 * 256 * 2);
    p.hn = (half_t*)carve((size_t)T_TOK * DM * 2);
    p.P = (half_t*)carve((size_t)T_TOK * NP * 2);
    p.ycat = (half_t*)carve((size_t)T_TOK * DM * 2);
    p.act = (half_t*)carve((size_t)T_TOK * 512 * 2);
    p.xr = (half_t*)carve((size_t)T_TOK * DM * 2);
    p.modpart = (float*)carve((size_t)8 * 2 * 16 * 6144 * 4);
    p.modf = (float*)carve((size_t)2 * 16 * 6144 * 4);
    p.kmean = (float*)carve((size_t)16 * 6 * 8 * 64 * 4);
    p.rope = (float*)carve((size_t)2048 * 24 * 4);
    p.iwf = (float*)carve((size_t)T_TOK * 4 * 4);
    p.tokw = (float*)carve((size_t)T_TOK * 2 * 4);
    p.dmask = (unsigned*)carve((size_t)T_TOK * 64 * 4);
    p.lists = (int*)carve((size_t)NCLS * T_TOK * 4);
    if (off > ws_size) { fprintf(stderr, "workspace too small: need %zu have %zu\n", off, ws_size); return; }
    (void)hipMemsetAsync(d_ws, 0, zero_bytes, stream);
#if MK_SPLIT
    for (int ph = 0; ph < NPHASE; ++ph) {
        p.ph_lo = ph; p.ph_hi = ph + 1;
        hipLaunchKernelGGL(mk_fwd, dim3(grid), dim3(256), LDS_BYTES, stream, p);
    }
#else
    p.ph_lo = 0; p.ph_hi = NPHASE;
    hipLaunchKernelGGL(mk_fwd, dim3(grid), dim3(256), LDS_BYTES, stream, p);
#endif
}
```

```cpp
#include <hip/hip_runtime.h>
#include <cstdio>
#include <cstdint>

#ifndef MK_SPLIT
#define MK_SPLIT 0
#endif

#define T_TOK 32768
#define DM 1024
#define SEQ 2048
#define INW 2340
#define NP 2432
#define PC_CU 0
#define PC_CG 256
#define PC_DQ 512
#define PC_DK 896
#define PC_DV 960
#define PC_IQ 1024
#define PC_IK 1152
#define PC_IW 1184
#define PC_MQ 1280
#define PC_MK 1664
#define PC_MV 2048
#define LOG_THETA 13.122363377404328f
#define NCLS 24
#define LDS_CTL 73728
#define LDS_BYTES 78336
#define NPHASE 19
#ifndef DUP_SUB
#define DUP_SUB -1
#endif

typedef _Float16 half_t;
typedef _Float16 h8 __attribute__((ext_vector_type(8)));
typedef _Float16 h4 __attribute__((ext_vector_type(4)));
typedef short s4v __attribute__((ext_vector_type(4)));
typedef short s8v __attribute__((ext_vector_type(8)));
typedef float f16v __attribute__((ext_vector_type(16)));
typedef float f4v __attribute__((ext_vector_type(4)));
#define LAS __attribute__((address_space(3)))

struct Params {
    const float *x, *c, *w_ada, *b_ada, *g_mix, *w_in, *w_dw, *b_dw, *ln_g, *ln_b, *w_o, *g_ffn, *w_router, *b_router, *w_gate, *w_up, *w_down, *g_final;
    float* out;
    half_t *Wt_in, *Wt_o, *Wt_gu, *Wt_d, *hn, *P, *ycat, *act, *xr;
    float *modpart, *modf, *kmean, *rope, *iwf, *tokw;
    unsigned* dmask; int* cnt; int* lists; unsigned* bar;
    int ph_lo, ph_hi;
};

#define XB_TMO      128
#define XB_XCNT(j)  (256  + 64 * (j))
#define XB_XSUB(j)  (1280 + 64 * (j))
#define XB_XGEN(j)  (2304 + 64 * (j))
#define XB_TOP      3328
#define XB_TOPGEN   3392
#define XCD_BAR_WORDS 3456
#define XB_SPIN_CAP (1u << 20)
__device__ __forceinline__ unsigned xb_ld(unsigned* p)              { return __hip_atomic_load(p, __ATOMIC_RELAXED, __HIP_MEMORY_SCOPE_AGENT); }
__device__ __forceinline__ unsigned xb_add(unsigned* p, unsigned v) { return __hip_atomic_fetch_add(p, v, __ATOMIC_RELAXED, __HIP_MEMORY_SCOPE_AGENT); }
__device__ __forceinline__ unsigned xb_xcc_id() { return (unsigned)__builtin_amdgcn_s_getreg((3 << 11) | 20) & 0xFu; }
#define XB_SPIN(cond, bar) do { unsigned _sp = 0; while (cond) { __builtin_amdgcn_s_sleep(1); \
    if ((++_sp & 255u) == 0u) { if (xb_ld(&(bar)[XB_TMO])) break; if (_sp > XB_SPIN_CAP) { atomicAdd(&(bar)[XB_TMO], 1u); break; } } } } while (0)
struct XcdBarrier { unsigned* bar; unsigned x; volatile LAS unsigned* st; };
__device__ __forceinline__ XcdBarrier xcd_barrier_post(unsigned* bar, volatile LAS unsigned* st) {
    XcdBarrier b; b.bar = bar; b.x = xb_xcc_id(); b.st = st;
    if (threadIdx.x == 0) (void)xb_add(&bar[XB_XCNT(b.x)], 1u);
    return b;
}
__device__ __forceinline__ void xcd_barrier_complete(unsigned* bar, unsigned x, unsigned& nloc, unsigned& nx) {
    const unsigned G = gridDim.x * gridDim.y * gridDim.z;
    unsigned sum, cnt, mine, sp = 0u;
    for (;;) {
        sum = 0u; cnt = 0u; mine = 0u;
#pragma unroll
        for (unsigned j = 0; j < 16; ++j) { const unsigned c = xb_ld(&bar[XB_XCNT(j)]); sum += c; cnt += (c > 0u) ? 1u : 0u; mine = (j == x) ? c : mine; }
        if (sum == G) break;
        __builtin_amdgcn_s_sleep(1);
        if ((++sp & 255u) == 0u) { if (xb_ld(&bar[XB_TMO])) break; if (sp > XB_SPIN_CAP) { atomicAdd(&bar[XB_TMO], 1u); break; } }
    }
    nloc = mine > 0u ? mine : 1u; nx = cnt > 0u ? cnt : 1u;
}
__device__ __forceinline__ void xcd_barrier(const XcdBarrier& b) {
    asm volatile("s_waitcnt vmcnt(0)" ::: "memory");
    __syncthreads();
    if (threadIdx.x == 0) {
        unsigned* bar = b.bar;
        __builtin_amdgcn_s_waitcnt(0);
        unsigned nloc = b.st[0], nx = b.st[1];
        if (nloc == 0u) { xcd_barrier_complete(bar, b.x, nloc, nx); b.st[0] = nloc; b.st[1] = nx; }
        const unsigned old = xb_add(&bar[XB_XSUB(b.x)], 1u);
        const unsigned gen = old / nloc;
        if (old + 1u == (gen + 1u) * nloc) {
            __builtin_amdgcn_fence(__ATOMIC_RELEASE, "agent");
            asm volatile("s_waitcnt vmcnt(0)" ::: "memory");
            const unsigned og = xb_add(&bar[XB_TOP], 1u);
            const unsigned tg = og / nx;
            if (og + 1u == (tg + 1u) * nx) xb_add(&bar[XB_TOPGEN], 1u);
            else XB_SPIN(xb_ld(&bar[XB_TOPGEN]) == tg, bar);
            __builtin_amdgcn_fence(__ATOMIC_ACQUIRE, "agent");
            xb_add(&bar[XB_XGEN(b.x)], 1u);
            asm volatile("s_waitcnt vmcnt(0)" ::: "memory");
        } else {
            XB_SPIN(xb_ld(&bar[XB_XGEN(b.x)]) == gen, bar);
            __builtin_amdgcn_fence(__ATOMIC_ACQUIRE, "agent");
            asm volatile("s_waitcnt vmcnt(0)" ::: "memory");
        }
    }
    __syncthreads();
}

typedef const __attribute__((address_space(4))) Params* KP;
__device__ __forceinline__ int TID() { int t = threadIdx.x; asm volatile("" : "+v"(t)); return t; }
__device__ __forceinline__ int BID() { int b = blockIdx.x; asm volatile("" : "+s"(b)); return b; }
__device__ __forceinline__ float sigmoidf_(float v) { return __builtin_amdgcn_rcpf(1.0f + __expf(-v)); }
__device__ __forceinline__ void glds16(const void* g, char* l) { __builtin_amdgcn_global_load_lds((const unsigned*)g, (unsigned*)l, 16, 0, 0); }
__device__ __forceinline__ unsigned f2sortable(float f) { unsigned u = __float_as_uint(f); return (u & 0x80000000u) ? ~u : (u | 0x80000000u); }
template <bool HIN> __device__ __forceinline__ float4 ldx4(const void* base, size_t idx) {
    if (HIN) { const h4 t = *(const h4*)((const half_t*)base + idx); return make_float4((float)t[0], (float)t[1], (float)t[2], (float)t[3]); }
    return *(const float4*)((const float*)base + idx);
}
__device__ __forceinline__ h4 pack4(float a, float b, float c, float d) { h4 r = {(half_t)a, (half_t)b, (half_t)c, (half_t)d}; return r; }

template <class CF>
__device__ __forceinline__ void conv_tile_panel(char* lds, CF colf, int src_ld, int k0, int n0, half_t* dst, int nrows) {
    float* tl = (float*)lds;
    const int tid = TID();
    __syncthreads();
    {
        const int nn = tid & 63;
        const float* cp = colf(nn);
        float tv[16];
#pragma unroll
        for (int i = 0; i < 16; ++i) { const int k = i * 4 + (tid >> 6); tv[i] = cp ? cp[(size_t)(k0 + k) * src_ld] : 0.f; }
#pragma unroll
        for (int i = 0; i < 16; ++i) { const int k = i * 4 + (tid >> 6); tl[k * 65 + nn] = tv[i]; }
    }
    __syncthreads();
    {
        const int n = tid >> 2, kq = (tid & 3) * 16;
        h8 a, b;
#pragma unroll
        for (int j = 0; j < 8; ++j) { a[j] = (half_t)tl[(kq + j) * 65 + n]; b[j] = (half_t)tl[(kq + 8 + j) * 65 + n]; }
        const int k = k0 + kq;
        h8* d = (h8*)(dst + ((size_t)(k >> 5) * nrows + n0 + n) * 32 + (k & 31));
        d[0] = a; d[1] = b;
    }
}
template <class CF>
__device__ __forceinline__ void conv_tile(char* lds, CF colf, int src_ld, int k0, half_t* dst_tile  , int dstK) {
    float* tl = (float*)lds;
    const int tid = TID();
    __syncthreads();
    {
        const int nn = tid & 63;
        const float* cp = colf(nn);
        float tv[16];
#pragma unroll
        for (int i = 0; i < 16; ++i) { const int k = i * 4 + (tid >> 6); tv[i] = cp ? cp[(size_t)(k0 + k) * src_ld] : 0.f; }
#pragma unroll
        for (int i = 0; i < 16; ++i) { const int k = i * 4 + (tid >> 6); tl[k * 65 + nn] = tv[i]; }
    }
    __syncthreads();
    {
        const int n = tid >> 2, kq = (tid & 3) * 16;
        h8 a, b;
#pragma unroll
        for (int j = 0; j < 8; ++j) { a[j] = (half_t)tl[(kq + j) * 65 + n]; b[j] = (half_t)tl[(kq + 8 + j) * 65 + n]; }
        h8* d = (h8*)(dst_tile + (size_t)n * dstK + kq);
        d[0] = a; d[1] = b;
    }
}

__device__ __forceinline__ void phase_prologue(KP p, char* lds) {
    const int tid = TID();
    const int NA = 2 * 16 * 38, NB = 2 * 16 * 16, NC = 2 * 16 * 16 * 8, ND = 2 * 16 * 4 * 16, NE = 384, NF = 8;
    const int total = NA + NB + NC + ND + NE + NF;
    for (int u0 = BID(); u0 < total; u0 += gridDim.x) {
        int u = u0;
        if (u < NA) {
            const int nt = u % 38, kt = (u / 38) % 16, l = u / (38 * 16);
            const float* src = p->w_in + (size_t)l * DM * INW;
            const int n0 = nt * 64;
            conv_tile_panel(lds, [&](int nn) -> const float* { const int np = n0 + nn; const int sc = np < 512 ? (((np & 63) < 32) ? 32 * (np >> 6) + (np & 31) : 256 + 32 * (np >> 6) + (np & 31)) : (np < 1188 ? np : (np < 1280 ? -1 : np - 92)); return sc >= 0 ? src + sc : (const float*)nullptr; },
                      INW, kt * 64, n0, p->Wt_in + (size_t)l * NP * DM, NP);
            continue;
        }
        u -= NA;
        if (u < NB) {
            const int nt = u % 16, kt = (u / 16) % 16, l = u / 256;
            const float* src = p->w_o + (size_t)l * DM * DM + nt * 64;
            conv_tile_panel(lds, [&](int nn) -> const float* { return src + nn; }, DM, kt * 64, nt * 64, p->Wt_o + (size_t)l * DM * DM, DM);
            continue;
        }
        u -= NB;
        if (u < NC) {
            const int nt = u % 8, kt = (u / 8) % 16, le = u / 128;
            const float* sg = p->w_gate + (size_t)le * 1024 * 256 + nt * 32;
            const float* su = p->w_up + (size_t)le * 1024 * 256 + nt * 32;
            conv_tile(lds, [&](int nn) -> const float* { return nn < 32 ? sg + nn : su + (nn - 32); }, 256, kt * 64, p->Wt_gu + ((size_t)le * 512 + nt * 64) * 1024 + kt * 64, 1024);
            continue;
        }
        u -= NC;
        if (u < ND) {
            const int nt = u % 16, kt = (u / 16) % 4, le = u / 64;
            const float* src = p->w_down + (size_t)le * 256 * 1024 + nt * 64;
            conv_tile(lds, [&](int nn) -> const float* { return src + nn; }, 1024, kt * 64, p->Wt_d + ((size_t)le * 1024 + nt * 64) * 256 + kt * 64, 256);
            continue;
        }
        u -= ND;
        if (u < NE) {
            const int kc = u % 8, cc = (u / 8) % 24, l = u / 192;
            float* ca = (float*)lds;
            __syncthreads();
            for (int i = tid; i < 2048; i += 256) { const int b = i >> 7, k = i & 127; const float v = p->c[b * 1024 + kc * 128 + k]; ca[i] = v / (1.0f + expf(-v)); }
            __syncthreads();
            const int n = cc * 256 + tid;
            float acc[16];
#pragma unroll
            for (int b = 0; b < 16; ++b) acc[b] = 0.f;
            const float* w = p->w_ada + ((size_t)l * 1024 + kc * 128) * 6144 + n;
            for (int k0 = 0; k0 < 128; k0 += 32) {
                float wv[32];
#pragma unroll
                for (int j = 0; j < 32; ++j) wv[j] = w[(size_t)(k0 + j) * 6144];
                __builtin_amdgcn_sched_barrier(0);
#pragma unroll
                for (int j4 = 0; j4 < 8; ++j4) {
#pragma unroll
                    for (int b = 0; b < 16; ++b) {
                        const float4 c4 = *(const float4*)(ca + b * 128 + k0 + 4 * j4);
                        acc[b] = fmaf(c4.x, wv[4 * j4], fmaf(c4.y, wv[4 * j4 + 1], fmaf(c4.z, wv[4 * j4 + 2], fmaf(c4.w, wv[4 * j4 + 3], acc[b]))));
                    }
                }
                __builtin_amdgcn_sched_barrier(0);
            }
#pragma unroll
            for (int b = 0; b < 16; ++b) p->modpart[(((size_t)kc * 2 + l) * 16 + b) * 6144 + n] = acc[b];
            continue;
        }
        u -= NE;
        {
            for (int i = u * 256 + tid; i < 2048 * 12; i += NF * 256) {
                const int t = i / 12, r = i % 12;
                const int fi = r < 8 ? r : r - 8;
                const float rot = r < 8 ? 16.f : 8.f;
                const float inv = expf(-LOG_THETA * ((float)fi * 2.0f / rot));
                const float ang = (float)t * inv;
                float sn, cs; sincosf(ang, &sn, &cs);
                if (r < 8) { p->rope[t * 8 + fi] = cs; p->rope[16384 + t * 8 + fi] = sn; }
                else { p->rope[32768 + t * 4 + fi] = cs; p->rope[32768 + 8192 + t * 4 + fi] = sn; }
            }
        }
    }
}

__device__ __forceinline__ void phase_modsum(KP p) {
    for (int i = BID() * 256 + TID(); i < 2 * 16 * 6144; i += gridDim.x * 256) {
        const int n = i % 6144, l = i / (16 * 6144);
        float s = p->b_ada[l * 6144 + n];
#pragma unroll
        for (int kc = 0; kc < 8; ++kc) s += p->modpart[(size_t)kc * (2 * 16 * 6144) + i];
        p->modf[i] = s;
    }
}

__device__ __forceinline__ void route_flush(KP p, char* lds, int lane, int wave, int n, int myrow, int layer) {
    const float* lg = (const float*)(lds + LDS_CTL + 512) + wave * 256;
    int* lc = (int*)(lds + LDS_CTL + 64);
    int* lbase = lc + 32;
    const int tid = wave * 64 + lane;
    if (tid < 32) lc[tid] = 0;
    __syncthreads();
    int cls = 0, lpos = 0;
    if (lane < n) {
        float aff[16], bia[16];
#pragma unroll
        for (int e = 0; e < 16; ++e) { aff[e] = 1.0f / (1.0f + expf(-lg[lane * 16 + e])); bia[e] = aff[e] + p->b_router[e]; }
        int bestg = 0; float bests = -INFINITY;
#pragma unroll
        for (int gi = 0; gi < 4; ++gi) {
            float m1 = -INFINITY, m2 = -INFINITY;
#pragma unroll
            for (int j = 0; j < 4; ++j) { const float vv = bia[gi * 4 + j]; if (vv > m1) { m2 = m1; m1 = vv; } else if (vv > m2) m2 = vv; }
            const float s = m1 + m2;
            if (s > bests) { bests = s; bestg = gi; }
        }
        float bsel[4], asel[4];
#pragma unroll
        for (int j = 0; j < 4; ++j) { bsel[j] = 0.f; asel[j] = 0.f; }
#pragma unroll
        for (int gi = 0; gi < 4; ++gi) if (gi == bestg) {
#pragma unroll
            for (int j = 0; j < 4; ++j) { bsel[j] = bia[gi * 4 + j]; asel[j] = aff[gi * 4 + j]; }
        }
        int i1 = -1, i2 = -1; float v1 = -INFINITY, v2 = -INFINITY;
#pragma unroll
        for (int j = 0; j < 4; ++j) { const float vv = bsel[j]; if (vv > v1) { v2 = v1; i2 = i1; v1 = vv; i1 = j; } else if (vv > v2) { v2 = vv; i2 = j; } }
        const int a = i1 < i2 ? i1 : i2, bb = i1 < i2 ? i2 : i1;
        float wa = 0.f, wb = 0.f;
#pragma unroll
        for (int j = 0; j < 4; ++j) { if (j == a) wa = asel[j]; if (j == bb) wb = asel[j]; }
        const float sw = wa + wb;
        const int pi = (a == 0) ? (bb - 1) : (a == 1 ? (bb + 1) : 5);
        cls = bestg * 6 + pi;
        *(float2*)(p->tokw + (size_t)myrow * 2) = make_float2(wa / sw, wb / sw);
        lpos = atomicAdd(&lc[cls], 1);
    }
    __syncthreads();
    if (tid < NCLS) { const int c = lc[tid]; lbase[tid] = c ? atomicAdd(&p->cnt[(layer * 32 + tid) * 64], c) : 0; }
    __syncthreads();
    if (lane < n) p->lists[(size_t)cls * T_TOK + lbase[cls] + lpos] = myrow;
}

template <int MODE, bool HIN>
__device__ __forceinline__ void phase_norm(KP p, char* lds, const void* xin, const float* g, const float* sh, const float* sc, int layer) {
    const int lane = TID() & 63, wave = TID() >> 6;
    float* wt = (float*)lds;
    if (MODE == 1) {
        __syncthreads();
        for (int i = TID(); i < 4096; i += 256) {
            const float4 w4 = ((const float4*)p->w_router)[i];
            const int k = i >> 2, e0 = (i & 3) * 4;
            wt[(e0 + 0) * 1024 + k] = w4.x; wt[(e0 + 1) * 1024 + k] = w4.y; wt[(e0 + 2) * 1024 + k] = w4.z; wt[(e0 + 3) * 1024 + k] = w4.w;
        }
        __syncthreads();
    }
    float* lgb = (float*)(lds + LDS_CTL + 512);
    int myrow = 0, it = 0;
    float4 vn[4];
    {
        const int row0 = BID() * 4 + wave;
        const size_t xo = (size_t)(row0 < T_TOK ? row0 : 0) * DM;
#pragma unroll
        for (int i = 0; i < 4; ++i) vn[i] = ldx4<HIN>(xin, xo + (lane + 64 * i) * 4);
    }
    for (int row = BID() * 4 + wave; row < T_TOK; row += gridDim.x * 4) {
        const int b = row >> 11;
        float4 v[4]; float ss = 0.f;
#pragma unroll
        for (int i = 0; i < 4; ++i) v[i] = vn[i];
        {
            const int rown = row + gridDim.x * 4;
            const size_t xo = (size_t)(rown < T_TOK ? rown : row) * DM;
#pragma unroll
            for (int i = 0; i < 4; ++i) vn[i] = ldx4<HIN>(xin, xo + (lane + 64 * i) * 4);
        }
#pragma unroll
        for (int i = 0; i < 4; ++i) ss += v[i].x * v[i].x + v[i].y * v[i].y + v[i].z * v[i].z + v[i].w * v[i].w;
#pragma unroll
        for (int o = 32; o >= 1; o >>= 1) ss += __shfl_xor(ss, o);
        const float rstd = 1.0f / sqrtf(ss * (1.0f / 1024.0f) + 1e-6f);
        float acc[16], ya[16];
#pragma unroll
        for (int i = 0; i < 4; ++i) {
            const int k = (lane + 64 * i) * 4;
            const float4 gg = *(const float4*)(g + k);
            float y[4] = {v[i].x * rstd * gg.x, v[i].y * rstd * gg.y, v[i].z * rstd * gg.z, v[i].w * rstd * gg.w};
            if (MODE != 2) {
                const float4 s1 = *(const float4*)(sh + (size_t)b * 6144 + k), s2 = *(const float4*)(sc + (size_t)b * 6144 + k);
                y[0] = y[0] * (1.f + s2.x) + s1.x; y[1] = y[1] * (1.f + s2.y) + s1.y; y[2] = y[2] * (1.f + s2.z) + s1.z; y[3] = y[3] * (1.f + s2.w) + s1.w;
                if (MODE == 0) *(h4*)(p->hn + ((size_t)(k >> 5) * T_TOK + row) * 32 + (k & 31)) = pack4(y[0], y[1], y[2], y[3]);
                else *(h4*)(p->hn + (size_t)row * DM + k) = pack4(y[0], y[1], y[2], y[3]);
            } else {
                *(float4*)(p->out + (size_t)row * DM + k) = make_float4(y[0], y[1], y[2], y[3]);
            }
            ya[4 * i] = y[0]; ya[4 * i + 1] = y[1]; ya[4 * i + 2] = y[2]; ya[4 * i + 3] = y[3];
        }
        if (MODE == 1) {
#pragma unroll
            for (int e = 0; e < 16; ++e) acc[e] = 0.f;
            float4 wq[2][4];
            const float* wl = wt + lane * 4;
#pragma unroll
            for (int e = 0; e < 4; ++e) wq[0][e] = *(const float4*)(wl + e * 1024);
#pragma unroll
            for (int st = 0; st < 16; ++st) {
                const int i = st >> 2, eg = st & 3, cur = st & 1;
                if (st + 1 < 16) {
                    const int i2 = (st + 1) >> 2, eg2 = (st + 1) & 3;
#pragma unroll
                    for (int e = 0; e < 4; ++e) wq[cur ^ 1][e] = *(const float4*)(wl + (eg2 * 4 + e) * 1024 + i2 * 256);
                }
#pragma unroll
                for (int e = 0; e < 4; ++e) {
                    const float4 w4 = wq[cur][e];
                    acc[eg * 4 + e] = fmaf(ya[4 * i], w4.x, fmaf(ya[4 * i + 1], w4.y, fmaf(ya[4 * i + 2], w4.z, fmaf(ya[4 * i + 3], w4.w, acc[eg * 4 + e]))));
                }
                __builtin_amdgcn_sched_barrier(0);
            }
        }
        if (MODE == 1) {
            const bool b5 = lane & 32, b4 = lane & 16, b3 = lane & 8, b2 = lane & 4;
            float r8[8], r4[4], r2[2];
#pragma unroll
            for (int e = 0; e < 8; ++e) { const float snd = b5 ? acc[e] : acc[e + 8], kp = b5 ? acc[e + 8] : acc[e]; r8[e] = kp + __shfl_xor(snd, 32); }
#pragma unroll
            for (int e = 0; e < 4; ++e) { const float snd = b4 ? r8[e] : r8[e + 4], kp = b4 ? r8[e + 4] : r8[e]; r4[e] = kp + __shfl_xor(snd, 16); }
#pragma unroll
            for (int e = 0; e < 2; ++e) { const float snd = b3 ? r4[e] : r4[e + 2], kp = b3 ? r4[e + 2] : r4[e]; r2[e] = kp + __shfl_xor(snd, 8); }
            float rv; { const float snd = b2 ? r2[0] : r2[1], kp = b2 ? r2[1] : r2[0]; rv = kp + __shfl_xor(snd, 4); }
            rv += __shfl_xor(rv, 2); rv += __shfl_xor(rv, 1);
            if ((lane & 3) == 0) lgb[(wave * 16 + it) * 16 + (lane >> 2)] = rv;
            if (lane == it) myrow = row;
            ++it;
            if (it == 16) { route_flush(p, lds, lane, wave, it, myrow, layer); it = 0; }
        }
    }
    if (MODE == 1 && it > 0) route_flush(p, lds, lane, wave, it, myrow, layer);
}

typedef float f2_t __attribute__((ext_vector_type(2)));
#define NRR 2
__device__ __forceinline__ void phase_norm_router(KP p, char* lds, const half_t* xin, const float* g, const float* sh, const float* sc, int layer) {
    const int lane = TID() & 63, wave = TID() >> 6;
    float* wt = (float*)lds;
    __syncthreads();
    for (int i = TID(); i < 4096; i += 256) {
        const float4 w4 = ((const float4*)p->w_router)[i];
        const int k = i >> 2, e0 = (i & 3) * 4;
        wt[(e0 + 0) * 1024 + k] = w4.x; wt[(e0 + 1) * 1024 + k] = w4.y; wt[(e0 + 2) * 1024 + k] = w4.z; wt[(e0 + 3) * 1024 + k] = w4.w;
    }
    __syncthreads();
    float* lgb = (float*)(lds + LDS_CTL + 512);
    int myrow = 0, it = 0;
    const int rstride = gridDim.x * 4;
    for (int row0 = BID() * 4 + wave; row0 < T_TOK; row0 += rstride * NRR) {
        f2_t ya[NRR / 2][16];
        float ss[NRR];
        int nv = 0;
#pragma unroll
        for (int j = 0; j < NRR; ++j) nv += (row0 + j * rstride < T_TOK) ? 1 : 0;
        {
            float4 v[NRR][4];
#pragma unroll
            for (int j = 0; j < NRR; ++j) {
                const int r = row0 + j * rstride;
                const size_t xo = (size_t)(r < T_TOK ? r : row0) * DM;
#pragma unroll
                for (int i = 0; i < 4; ++i) v[j][i] = ldx4<true>(xin, xo + (lane + 64 * i) * 4);
            }
#pragma unroll
            for (int j = 0; j < NRR; ++j) {
                ss[j] = 0.f;
#pragma unroll
                for (int i = 0; i < 4; ++i) ss[j] += v[j][i].x * v[j][i].x + v[j][i].y * v[j][i].y + v[j][i].z * v[j][i].z + v[j][i].w * v[j][i].w;
            }
#pragma unroll
            for (int o = 32; o >= 1; o >>= 1) {
#pragma unroll
                for (int j = 0; j < NRR; ++j) ss[j] += __shfl_xor(ss[j], o);
            }
#pragma unroll
            for (int j = 0; j < NRR; ++j) ss[j] = 1.0f / sqrtf(ss[j] * (1.0f / 1024.0f) + 1e-6f);
#pragma unroll
            for (int j = 0; j < NRR; ++j) {
                const int r = row0 + j * rstride;
                const int rr = r < T_TOK ? r : row0;
                const int b = rr >> 11;
                const float rs = ss[j];
#pragma unroll
                for (int i = 0; i < 4; ++i) {
                    const int k = (lane + 64 * i) * 4;
                    const float4 gg = *(const float4*)(g + k);
                    const float4 s1 = *(const float4*)(sh + (size_t)b * 6144 + k), s2 = *(const float4*)(sc + (size_t)b * 6144 + k);
                    const float y0 = v[j][i].x * rs * gg.x * (1.f + s2.x) + s1.x, y1 = v[j][i].y * rs * gg.y * (1.f + s2.y) + s1.y;
                    const float y2 = v[j][i].z * rs * gg.z * (1.f + s2.z) + s1.z, y3 = v[j][i].w * rs * gg.w * (1.f + s2.w) + s1.w;
                    if (r < T_TOK) *(h4*)(p->hn + (size_t)r * DM + k) = pack4(y0, y1, y2, y3);
                    if (j & 1) { ya[j >> 1][4 * i].y = y0; ya[j >> 1][4 * i + 1].y = y1; ya[j >> 1][4 * i + 2].y = y2; ya[j >> 1][4 * i + 3].y = y3; }
                    else       { ya[j >> 1][4 * i].x = y0; ya[j >> 1][4 * i + 1].x = y1; ya[j >> 1][4 * i + 2].x = y2; ya[j >> 1][4 * i + 3].x = y3; }
                }
                __builtin_amdgcn_sched_barrier(0);
            }
        }
        f2_t acc[NRR / 2][16];
#pragma unroll
        for (int e = 0; e < 16; ++e) {
#pragma unroll
            for (int jp = 0; jp < NRR / 2; ++jp) acc[jp][e] = (f2_t){0.f, 0.f};
        }
        {
            float4 wq[2][4];
            const float* wl = wt + lane * 4;
#pragma unroll
            for (int e = 0; e < 4; ++e) wq[0][e] = *(const float4*)(wl + e * 1024);
#pragma unroll
            for (int st = 0; st < 16; ++st) {
                const int i = st >> 2, eg = st & 3, cur = st & 1;
                if (st + 1 < 16) {
                    const int i2 = (st + 1) >> 2, eg2 = (st + 1) & 3;
#pragma unroll
                    for (int e = 0; e < 4; ++e) wq[cur ^ 1][e] = *(const float4*)(wl + (eg2 * 4 + e) * 1024 + i2 * 256);
                }
#pragma unroll
                for (int e = 0; e < 4; ++e) {
                    const float4 w4 = wq[cur][e];
#pragma unroll
                    for (int jp = 0; jp < NRR / 2; ++jp) {
                        f2_t a = acc[jp][eg * 4 + e];
                        a = ya[jp][4 * i + 3] * (f2_t){w4.w, w4.w} + a;
                        a = ya[jp][4 * i + 2] * (f2_t){w4.z, w4.z} + a;
                        a = ya[jp][4 * i + 1] * (f2_t){w4.y, w4.y} + a;
                        a = ya[jp][4 * i] * (f2_t){w4.x, w4.x} + a;
                        acc[jp][eg * 4 + e] = a;
                    }
                }
                __builtin_amdgcn_sched_barrier(0);
            }
        }
        const bool b5 = lane & 32, b4 = lane & 16, b3 = lane & 8, b2 = lane & 4;
#pragma unroll
        for (int j = 0; j < NRR; ++j) {
            float r8[8], r4[4], r2[2];
#pragma unroll
            for (int e = 0; e < 8; ++e) {
                const float lo = (j & 1) ? acc[j >> 1][e].y : acc[j >> 1][e].x, hi = (j & 1) ? acc[j >> 1][e + 8].y : acc[j >> 1][e + 8].x;
                const float snd = b5 ? lo : hi, kp = b5 ? hi : lo; r8[e] = kp + __shfl_xor(snd, 32);
            }
#pragma unroll
            for (int e = 0; e < 4; ++e) { const float snd = b4 ? r8[e] : r8[e + 4], kp = b4 ? r8[e + 4] : r8[e]; r4[e] = kp + __shfl_xor(snd, 16); }
#pragma unroll
            for (int e = 0; e < 2; ++e) { const float snd = b3 ? r4[e] : r4[e + 2], kp = b3 ? r4[e + 2] : r4[e]; r2[e] = kp + __shfl_xor(snd, 8); }
            float rv; { const float snd = b2 ? r2[0] : r2[1], kp = b2 ? r2[1] : r2[0]; rv = kp + __shfl_xor(snd, 4); }
            rv += __shfl_xor(rv, 2); rv += __shfl_xor(rv, 1);
            if (j < nv) {
                if ((lane & 3) == 0) lgb[(wave * 16 + it) * 16 + (lane >> 2)] = rv;
                if (lane == it) myrow = row0 + j * rstride;
                ++it;
            }
        }
        if (it == 16) { route_flush(p, lds, lane, wave, it, myrow, layer); it = 0; }
    }
    if (it > 0) route_flush(p, lds, lane, wave, it, myrow, layer);
}

template <class WF, class XF, class EPI>
__device__ __forceinline__ void gemm_tile(char* lds, int nkt, WF wf, XF xf, EPI epi) {
    const int tid = TID(), lane = tid & 63, wave = tid >> 6;
    const int wn = wave & 1, wm = wave >> 1, hh = lane >> 5;
    const int lrow = tid >> 3;
    const int lchunk = (tid & 7) ^ ((tid >> 4) & 7);
    const half_t* xs[4];
#pragma unroll
    for (int i = 0; i < 4; ++i) xs[i] = xf(lrow + 32 * i) + lchunk * 8;
    char* ldst = lds + lrow * 128 + (tid & 7) * 16;
    f16v acc[2][2];
#pragma unroll
    for (int i = 0; i < 2; ++i)
#pragma unroll
        for (int j = 0; j < 2; ++j)
#pragma unroll
            for (int r = 0; r < 16; ++r) acc[i][j][r] = 0.f;
    auto issue = [&](int kt, int s) {
        char* d = ldst + s * 32768;
#pragma unroll
        for (int i = 0; i < 4; ++i) glds16(wf(kt, lrow + 32 * i) + lchunk * 8, d + i * 4096);
#pragma unroll
        for (int i = 0; i < 4; ++i) glds16(xs[i] + kt * 64, d + 16384 + i * 4096);
    };
    __syncthreads();
    issue(0, 0);
    const int rsw = (lane >> 1) & 7;
    const int roff_w = (wn * 64 + (lane & 31)) * 128, roff_x = 16384 + (wm * 64 + (lane & 31)) * 128;
    for (int kt = 0; kt < nkt; ++kt) {
        asm volatile("s_waitcnt vmcnt(0)" ::: "memory");
        __syncthreads();
        if (kt + 1 < nkt) issue(kt + 1, (kt + 1) & 1);
        const char* base = lds + (kt & 1) * 32768;
#pragma unroll
        for (int ks = 0; ks < 4; ++ks) {
            const int co = ((2 * ks + hh) ^ rsw) << 4;
            const h8 a0 = *(const h8*)(base + roff_w + co), a1 = *(const h8*)(base + roff_w + 4096 + co);
            const h8 b0 = *(const h8*)(base + roff_x + co), b1 = *(const h8*)(base + roff_x + 4096 + co);
            acc[0][0] = __builtin_amdgcn_mfma_f32_32x32x16_f16(a0, b0, acc[0][0], 0, 0, 0);
            acc[0][1] = __builtin_amdgcn_mfma_f32_32x32x16_f16(a0, b1, acc[0][1], 0, 0, 0);
            acc[1][0] = __builtin_amdgcn_mfma_f32_32x32x16_f16(a1, b0, acc[1][0], 0, 0, 0);
            acc[1][1] = __builtin_amdgcn_mfma_f32_32x32x16_f16(a1, b1, acc[1][1], 0, 0, 0);
        }
    }
    epi(acc, wn, wm, lane);
}

template <class WF, class XF, class EPI>
__device__ __forceinline__ void gemm_tile2(char* lds, int nkt, size_t xkstride, WF wf, XF xf, EPI epi) {
    const int tid = TID(), lane = tid & 63, wave = tid >> 6;
    const int wn = wave & 1, wm = wave >> 1, hh = lane >> 5;
    const int lrow = tid >> 2;
    const int lchunk = (tid & 3) ^ ((tid >> 4) & 3);
    const half_t* xs[2];
#pragma unroll
    for (int i = 0; i < 2; ++i) xs[i] = xf(lrow + 64 * i) + lchunk * 8;
    char* ldst = lds + lrow * 64 + (tid & 3) * 16;
    f16v acc[4][2];
#pragma unroll
    for (int i = 0; i < 4; ++i)
#pragma unroll
        for (int j = 0; j < 2; ++j)
#pragma unroll
            for (int r = 0; r < 16; ++r) acc[i][j][r] = 0.f;
    auto issue = [&](int kt, int s) {
        char* d = ldst + s * 24576;
#pragma unroll
        for (int i = 0; i < 4; ++i) glds16(wf(kt, lrow + 64 * i) + lchunk * 8, d + i * 4096);
#pragma unroll
        for (int i = 0; i < 2; ++i) glds16(xs[i] + (size_t)kt * xkstride, d + 16384 + i * 4096);
    };
    __syncthreads();
    issue(0, 0); issue(1, 1);
    const int rsw = (lane >> 2) & 3;
    const int roff_w = (wn * 128 + (lane & 31)) * 64, roff_x = 16384 + (wm * 64 + (lane & 31)) * 64;
    int st = 0;
    for (int kt = 0; kt < nkt; ++kt) {
        if (kt + 1 < nkt) asm volatile("s_waitcnt vmcnt(6)" ::: "memory");
        else asm volatile("s_waitcnt vmcnt(0)" ::: "memory");
        asm volatile("s_waitcnt lgkmcnt(0)" ::: "memory");
        __builtin_amdgcn_s_barrier();
        if (kt + 2 < nkt) issue(kt + 2, st >= 1 ? st - 1 : 2);
        const char* base = lds + st * 24576;
        st = st == 2 ? 0 : st + 1;
#pragma unroll
        for (int ks = 0; ks < 2; ++ks) {
            const int co = ((2 * ks + hh) ^ rsw) << 4;
            h8 a[4], b[2];
#pragma unroll
            for (int i = 0; i < 4; ++i) a[i] = *(const h8*)(base + roff_w + i * 2048 + co);
#pragma unroll
            for (int j = 0; j < 2; ++j) b[j] = *(const h8*)(base + roff_x + j * 2048 + co);
#pragma unroll
            for (int i = 0; i < 4; ++i)
#pragma unroll
                for (int j = 0; j < 2; ++j) acc[i][j] = __builtin_amdgcn_mfma_f32_32x32x16_f16(a[i], b[j], acc[i][j], 0, 0, 0);
        }
    }
    epi(acc, wn, wm, lane);
}

__device__ __forceinline__ void phase_inproj(KP p, char* lds, int l) {
    const half_t* W = p->Wt_in + (size_t)l * NP * DM;
    const float* rc16 = p->rope; const float* rs16 = p->rope + 16384; const float* rc8 = p->rope + 32768; const float* rs8 = p->rope + 32768 + 8192;
    for (int u = BID(); u < 256 * 10; u += gridDim.x) {
        const int xl = u & 7, Lx = u >> 3, mi = Lx & 15, rr_ = Lx >> 4;
        const int nt = rr_ % 10, mt = 32 * xl + 16 * (rr_ / 10) + mi;
        gemm_tile2(lds, 32, (size_t)T_TOK * 32,
            [&](int kt, int row) { int n = nt * 256 + row; n = n < NP ? n : NP - 1; return W + ((size_t)kt * NP + n) * 32; },
            [&](int row) { return p->hn + (size_t)(mt * 128 + row) * 32; },
            [&](f16v (&acc)[4][2], int wn, int wm, int lane) {
                const int hh = lane >> 5;
                half_t* stg = (half_t*)lds;
                __syncthreads();
#pragma unroll
                for (int i = 0; i < 4; ++i) {
                    const int nb = nt * 256 + wn * 128 + i * 32;
                    if (nb == 1216 || nb == 1248 || nb >= NP) continue;
                    if (nt < 2) {
                        if (i & 1) continue;
#pragma unroll
                        for (int j = 0; j < 2; ++j) {
                            half_t* dst = stg + (wm * 64 + j * 32 + (lane & 31)) * 260 + wn * 64 + (i >> 1) * 32 + 4 * hh;
#pragma unroll
                            for (int g = 0; g < 4; ++g) {
                                float a4[4];
#pragma unroll
                                for (int r = 0; r < 4; ++r) a4[r] = acc[i][j][4 * g + r] * sigmoidf_(acc[i + 1][j][4 * g + r]);
                                *(h4*)(dst + 8 * g) = pack4(a4[0], a4[1], a4[2], a4[3]);
                            }
                        }
                        continue;
                    }
                    const bool rope64 = ((nb >= PC_DQ && nb < PC_DV) || (nb >= PC_MQ && nb < PC_MV)) && ((nb & 63) == 0);
                    const bool rope32 = (nb >= PC_IQ && nb < PC_IW);
#pragma unroll
                    for (int j = 0; j < 2; ++j) {
                        const int tok = mt * 128 + wm * 64 + j * 32 + (lane & 31);
                        const int t = tok & 2047;
                        f16v v = acc[i][j];
                        if (nb == PC_IW) { if (hh == 0) *(float4*)(p->iwf + (size_t)tok * 4) = make_float4(v[0], v[1], v[2], v[3]); continue; }
                        if (rope64) {
                            const float4 c4 = *(const float4*)(rc16 + t * 8 + 4 * hh), s4 = *(const float4*)(rs16 + t * 8 + 4 * hh);
                            const float cc[4] = {c4.x, c4.y, c4.z, c4.w}, sn[4] = {s4.x, s4.y, s4.z, s4.w};
#pragma unroll
                            for (int r = 0; r < 4; ++r) { const float x1 = v[r], x2 = v[r + 4]; v[r] = x1 * cc[r] - x2 * sn[r]; v[r + 4] = x2 * cc[r] + x1 * sn[r]; }
                        } else if (rope32) {
                            const float4 c4 = *(const float4*)(rc8 + t * 4), s4 = *(const float4*)(rs8 + t * 4);
                            const float cc[4] = {c4.x, c4.y, c4.z, c4.w}, sn[4] = {s4.x, s4.y, s4.z, s4.w};
#pragma unroll
                            for (int r = 0; r < 4; ++r) { const float o = __shfl_xor(v[r], 32); v[r] = hh ? (v[r] * cc[r] + o * sn[r]) : (v[r] * cc[r] - o * sn[r]); }
                        }
                        if ((nb >= PC_DQ && nb < PC_DK) || (nb >= PC_MQ && nb < PC_MK)) {
#pragma unroll
                            for (int r = 0; r < 16; ++r) v[r] *= 0.18033688011112042f;
                        }
                        half_t* dst = stg + (wm * 64 + j * 32 + (lane & 31)) * 260 + wn * 128 + i * 32 + 4 * hh;
#pragma unroll
                        for (int g = 0; g < 4; ++g) *(h4*)(dst + 8 * g) = pack4(v[4 * g], v[4 * g + 1], v[4 * g + 2], v[4 * g + 3]);
                    }
                }
                __syncthreads();
                const int wv_ = TID() >> 6;
#pragma unroll 4
                for (int it = 0; it < 32; ++it) {
                    const int row = it * 4 + wv_;
                    const uint2 v2 = *(const uint2*)(stg + row * 260 + lane * 4);
                    if (nt < 2) { if (lane < 32) *(uint2*)(p->P + (size_t)(mt * 128 + row) * NP + nt * 128 + lane * 4) = v2; }
                    else { const int n = nt * 256 + lane * 4; if (n < NP) *(uint2*)(p->P + (size_t)(mt * 128 + row) * NP + n) = v2; }
                }
            });
    }
}

__device__ __forceinline__ void stage_acc_f32(char* lds, const f16v (&acc)[2][2], int wn, int wm, int lane) {
    float* stg = (float*)lds;
    const int hh = lane >> 5;
    __syncthreads();
#pragma unroll
    for (int j = 0; j < 2; ++j)
#pragma unroll
        for (int i = 0; i < 2; ++i)
#pragma unroll
            for (int g = 0; g < 4; ++g)
                *(float4*)(stg + (wm * 64 + j * 32 + (lane & 31)) * 132 + wn * 64 + i * 32 + 4 * hh + 8 * g) = make_float4(acc[i][j][4 * g], acc[i][j][4 * g + 1], acc[i][j][4 * g + 2], acc[i][j][4 * g + 3]);
    __syncthreads();
}
template <bool HIN>
__device__ __forceinline__ void phase_outproj(KP p, char* lds, int l, const void* xin) {
    const half_t* W = p->Wt_o + (size_t)l * DM * DM;
    const float* g1 = p->modf + (size_t)l * 16 * 6144 + 2 * 1024;
    for (int u = BID(); u < 256 * 4; u += gridDim.x) {
        const int xl = u & 7, Lx = u >> 3, mi = Lx & 7, rr_ = Lx >> 3;
        const int nt = rr_ & 3, mt = 32 * xl + 8 * (rr_ >> 2) + mi;
        gemm_tile2(lds, 32, (size_t)T_TOK * 32,
            [&](int kt, int row) { return W + ((size_t)kt * DM + nt * 256 + row) * 32; },
            [&](int row) { return p->ycat + (size_t)(mt * 128 + row) * 32; },
            [&](f16v (&acc)[4][2], int wn, int wm, int lane) {
                const int hh = lane >> 5, tid = TID();
                float* stg = (float*)lds;
#pragma unroll
                for (int rnd = 0; rnd < 2; ++rnd) {
                    __syncthreads();
                    if (wm == rnd) {
#pragma unroll
                        for (int j = 0; j < 2; ++j)
#pragma unroll
                            for (int i = 0; i < 4; ++i)
#pragma unroll
                                for (int g = 0; g < 4; ++g)
                                    *(float4*)(stg + (j * 32 + (lane & 31)) * 260 + wn * 128 + i * 32 + 4 * hh + 8 * g) = make_float4(acc[i][j][4 * g], acc[i][j][4 * g + 1], acc[i][j][4 * g + 2], acc[i][j][4 * g + 3]);
                    }
                    __syncthreads();
#pragma unroll 4
                    for (int it = 0; it < 16; ++it) {
                        const int idx = it * 256 + tid, row = idx >> 6, c = idx & 63;
                        const int tok = mt * 128 + rnd * 64 + row, n = nt * 256 + 4 * c;
                        const float4 a4 = *(const float4*)(stg + row * 260 + 4 * c);
                        const float4 xi = ldx4<HIN>(xin, (size_t)tok * DM + n);
                        const float4 gg = *(const float4*)(g1 + (size_t)(tok >> 11) * 6144 + n);
                        *(h4*)(p->xr + (size_t)tok * DM + n) = pack4(xi.x + gg.x * a4.x, xi.y + gg.y * a4.y, xi.z + gg.z * a4.z, xi.w + gg.w * a4.w);
                    }
                }
            });
    }
}

struct MoeTab { int tb, nt, nc; };
__device__ __forceinline__ MoeTab moe_table(const int* cnt) {
    const int c = TID() & 31;
    MoeTab t;
    t.nc = (c < NCLS) ? cnt[c * 64] : 0;
    t.nt = (t.nc + 127) >> 7;
    int incl = t.nt;
#pragma unroll
    for (int o = 1; o < 32; o <<= 1) { const int v = __shfl_up(incl, o, 32); if (c >= o) incl += v; }
    t.tb = incl - t.nt;
    return t;
}
__device__ __forceinline__ bool moe_tile(const MoeTab& t, int tile, int& cls, int& pos0, int& n) {
    const unsigned long long m = __ballot(tile >= t.tb && tile < t.tb + t.nt);
    if (m == 0ull) return false;
    cls = __ffsll((long long)m) - 1;
    pos0 = (tile - __builtin_amdgcn_readlane(t.tb, cls)) * 128;
    n = __builtin_amdgcn_readlane(t.nc, cls);
    return true;
}
__device__ __forceinline__ void cls_experts(int cls, int& e1, int& e2) {
    const int g = cls / 6, pi = cls % 6;
    const int a = pi < 3 ? 0 : (pi < 5 ? 1 : 2);
    const int b = pi < 3 ? pi + 1 : (pi < 5 ? pi - 1 : 3);
    e1 = g * 4 + a; e2 = g * 4 + b;
}
__device__ __forceinline__ void phase_moe_up(KP p, char* lds, int l) {
    const MoeTab tab = moe_table(p->cnt + l * 32 * 64);
    for (int u = BID(); u < (256 + NCLS) * 8; u += gridDim.x) {
        const int xl = u & 7, Lx = u >> 3;
        const int nt = Lx & 7, tile = (Lx >> 3) * 8 + xl;
        int cls, pos0, nc;
        if (!moe_tile(tab, tile, cls, pos0, nc)) continue;
        int e1, e2; cls_experts(cls, e1, e2);
        const int slot = nt >> 2;
        const half_t* W = p->Wt_gu + ((size_t)(l * 16 + (slot ? e2 : e1)) * 512 + (nt & 3) * 128) * 1024;
        const int* lst = p->lists + (size_t)cls * T_TOK + pos0;
        const int nvalid = nc - pos0;
        int tokE[2]; float wgtE[2];
        {
            const int lane_ = TID() & 63, wm_ = TID() >> 7;
#pragma unroll
            for (int j = 0; j < 2; ++j) {
                const int row = wm_ * 64 + j * 32 + (lane_ & 31);
                tokE[j] = lst[row < nvalid ? row : 0];
                wgtE[j] = p->tokw[(size_t)tokE[j] * 2 + slot];
            }
        }
        gemm_tile(lds, 16,
            [&](int kt, int row) { return W + (size_t)row * 1024 + kt * 64; },
            [&](int row) { const int tok = lst[row < nvalid ? row : 0]; return p->hn + (size_t)tok * DM; },
            [&](f16v (&acc)[2][2], int wn, int wm, int lane) {
                const int hh = lane >> 5;
#pragma unroll
                for (int j = 0; j < 2; ++j) {
                    const int row = wm * 64 + j * 32 + (lane & 31);
                    if (row < nvalid) {
                        const int tok = tokE[j];
                        const float wgt = wgtE[j];
                        half_t* dst = p->act + (size_t)tok * 512 + slot * 256 + ((nt & 3) * 2 + wn) * 32 + 4 * hh;
#pragma unroll
                        for (int g = 0; g < 4; ++g) {
                            float a[4];
#pragma unroll
                            for (int r = 0; r < 4; ++r) { const float gv = acc[0][j][4 * g + r], uv = acc[1][j][4 * g + r]; a[r] = gv * sigmoidf_(gv) * uv * wgt; }
                            *(h4*)(dst + 8 * g) = pack4(a[0], a[1], a[2], a[3]);
                        }
                    }
                }
            });
    }
}
__device__ __forceinline__ void phase_moe_down(KP p, char* lds, int l, float gsc) {
    const MoeTab tab = moe_table(p->cnt + l * 32 * 64);
    const float* g2 = p->modf + (size_t)l * 16 * 6144 + 5 * 1024;
    for (int u = BID(); u < (256 + NCLS) * 8; u += gridDim.x) {
        const int xl = u & 7, Lx = u >> 3;
        const int nt = Lx & 7, tile = (Lx >> 3) * 8 + xl;
        int cls, pos0, nc;
        if (!moe_tile(tab, tile, cls, pos0, nc)) continue;
        int e1, e2; cls_experts(cls, e1, e2);
        const half_t* W1 = p->Wt_d + ((size_t)(l * 16 + e1) * 1024 + nt * 128) * 256;
        const half_t* W2 = p->Wt_d + ((size_t)(l * 16 + e2) * 1024 + nt * 128) * 256;
        const int* lst = p->lists + (size_t)cls * T_TOK + pos0;
        const int nvalid = nc - pos0;
        int tokS[8];
        {
            const int r0 = TID() >> 4;
#pragma unroll
            for (int it = 0; it < 8; ++it) { const int row = it * 16 + r0; tokS[it] = lst[row < nvalid ? row : 0]; }
        }
        gemm_tile(lds, 8,
            [&](int kt, int row) { return (kt < 4 ? W1 : W2) + (size_t)row * 256 + (kt & 3) * 64; },
            [&](int row) { const int tok = lst[row < nvalid ? row : 0]; return p->act + (size_t)tok * 512; },
            [&](f16v (&acc)[2][2], int wn, int wm, int lane) {
                const int hh = lane >> 5, tid = TID();
                float* stg = (float*)lds;
                __syncthreads();
#pragma unroll
                for (int j = 0; j < 2; ++j)
#pragma unroll
                    for (int i = 0; i < 2; ++i)
#pragma unroll
                        for (int g = 0; g < 4; ++g)
                            *(float4*)(stg + (wm * 64 + j * 32 + (lane & 31)) * 132 + wn * 64 + i * 32 + 8 * g + 4 * hh) =
                                make_float4(acc[i][j][4 * g], acc[i][j][4 * g + 1], acc[i][j][4 * g + 2], acc[i][j][4 * g + 3]);
                __syncthreads();
                const int r0 = tid >> 4, c8 = (tid & 15) * 8;
#pragma unroll
                for (int it = 0; it < 8; ++it) {
                    const int row = it * 16 + r0;
                    if (row < nvalid) {
                        const int tok = tokS[it];
                        const int n = nt * 128 + c8;
                        const float* gp = g2 + (size_t)(tok >> 11) * 6144 + n;
                        const float4 a0 = *(const float4*)(stg + row * 132 + c8), a1 = *(const float4*)(stg + row * 132 + c8 + 4);
                        const float4 g0 = *(const float4*)gp, g1 = *(const float4*)(gp + 4);
                        h8* xp = (h8*)(p->xr + (size_t)tok * DM + n);
                        const h8 xi = *xp;
                        h8 o;
                        o[0] = (half_t)((float)xi[0] + gsc * g0.x * a0.x); o[1] = (half_t)((float)xi[1] + gsc * g0.y * a0.y);
                        o[2] = (half_t)((float)xi[2] + gsc * g0.z * a0.z); o[3] = (half_t)((float)xi[3] + gsc * g0.w * a0.w);
                        o[4] = (half_t)((float)xi[4] + gsc * g1.x * a1.x); o[5] = (half_t)((float)xi[5] + gsc * g1.y * a1.y);
                        o[6] = (half_t)((float)xi[6] + gsc * g1.z * a1.z); o[7] = (half_t)((float)xi[7] + gsc * g1.w * a1.w);
                        *xp = o;
                    }
                }
            });
    }
}

__device__ __forceinline__ void dsa_select_unit(KP p, char* lds, int b, int qt) {
    unsigned* hist = (unsigned*)lds;
    unsigned* maskl = hist + 16 * 257 + 16;
    unsigned* stP = maskl + 1024;
    unsigned* stNeed = stP + 16;
    unsigned* stDone = stNeed + 16;
    unsigned* flag = stDone + 16;
    unsigned* dummyb = flag + 16;
    const int tid = TID(), lane = tid & 63, wave = tid >> 6;
    const int q0 = qt * 16, tokbase = b * SEQ;
    __syncthreads();
    if (q0 < 256) {
        for (int i = tid; i < 1024; i += 256) {
            const int q = i >> 6, wd = i & 63;
            const int n = q0 + q + 1 - 32 * wd;
            const unsigned w = n >= 32 ? 0xFFFFFFFFu : (n <= 0 ? 0u : ((1u << n) - 1u));
            p->dmask[(size_t)(tokbase + q0 + q) * 64 + wd] = w;
        }
        return;
    }
    for (int i = tid; i < 1024; i += 256) maskl[i] = 0u;
    if (tid < 16) { stP[tid] = 0u; stNeed[tid] = 256u; stDone[tid] = 0u; }
    for (int i = tid; i < 16 * 257; i += 256) hist[i] = 0u;
    __syncthreads();
    const int ql = lane & 15, fq = lane >> 4;
    const int tq = q0 + ql;
    const half_t* Pb = p->P + (size_t)tokbase * NP;
    h8 iqf[4];
#pragma unroll
    for (int hd = 0; hd < 4; ++hd) iqf[hd] = *(const h8*)(Pb + (size_t)tq * NP + PC_IQ + hd * 32 + 8 * fq);
    const float4 iw4 = *(const float4*)(p->iwf + (size_t)(tokbase + tq) * 4);
    const float wsc0 = iw4.x * 0.08838834764831845f, wsc1 = iw4.y * 0.08838834764831845f, wsc2 = iw4.z * 0.08838834764831845f, wsc3 = iw4.w * 0.08838834764831845f;
    const int ng = qt + 1;
    unsigned sc[32][4];
    const half_t* ikp = Pb + (size_t)ql * NP + PC_IK + 8 * fq;
#pragma unroll
    for (int gb = 0; gb < 4; ++gb) {
        h8 ik[8];
#pragma unroll
        for (int x = 0; x < 8; ++x) {
            int g = wave + 4 * (gb * 8 + x);
            g = g < ng ? g : ng - 1;
            ik[x] = *(const h8*)(ikp + (size_t)(16 * g) * NP);
        }
#pragma unroll
        for (int x = 0; x < 8; ++x) {
            const int gi = gb * 8 + x;
            const int g = wave + 4 * gi;
            const f4v z = {0.f, 0.f, 0.f, 0.f};
            const f4v c0 = __builtin_amdgcn_mfma_f32_16x16x32_f16(ik[x], iqf[0], z, 0, 0, 0);
            const f4v c1 = __builtin_amdgcn_mfma_f32_16x16x32_f16(ik[x], iqf[1], z, 0, 0, 0);
            const f4v c2 = __builtin_amdgcn_mfma_f32_16x16x32_f16(ik[x], iqf[2], z, 0, 0, 0);
            const f4v c3 = __builtin_amdgcn_mfma_f32_16x16x32_f16(ik[x], iqf[3], z, 0, 0, 0);
#pragma unroll
            for (int r = 0; r < 4; ++r) {
                const int j = 16 * g + 4 * fq + r;
                float sv = wsc0 * __builtin_amdgcn_fmed3f(c0[r], 0.f, INFINITY);
                sv = fmaf(wsc1, __builtin_amdgcn_fmed3f(c1[r], 0.f, INFINITY), sv);
                sv = fmaf(wsc2, __builtin_amdgcn_fmed3f(c2[r], 0.f, INFINITY), sv);
                sv = fmaf(wsc3, __builtin_amdgcn_fmed3f(c3[r], 0.f, INFINITY), sv);
                sv += 0.0f;
                const int sb = __float_as_int(sv);
                const unsigned su = (unsigned)sb ^ ((unsigned)(sb >> 31) | 0x80000000u);
                const unsigned ck = (su & 0xFFFFF800u) | (unsigned)(2047 - j);
                sc[gi][r] = (g < ng && j <= tq) ? ck : 0u;
            }
            if (g < ng) {
#pragma unroll
                for (int r = 0; r < 4; ++r) atomicAdd(hist + ql * 257 + (sc[gi][r] >> 24), 1u);
            }
        }
    }
    bool alldone = false;
    for (int pass = 0; pass < 5; ++pass) {
        const bool fin = alldone;
        if (!fin && pass > 0) { for (int i = tid; i < 16 * 257; i += 256) hist[i] = 0u; }
        if (tid == 0) *flag = 0u;
        __syncthreads();
        if (pass > 0) {
        const unsigned sP = stP[ql], sDone = stDone[ql];
        int wv = wave, fqv = fq;
        asm volatile("" : "+v"(wv), "+v"(fqv));
        if (fin) {
            const int sh = (int)(32u - 8u * (sDone ? sDone : 1u));
            unsigned* mrow = maskl + ql * 64;
#pragma unroll
            for (int gi = 0; gi < 32; ++gi) {
                const int g = wv + 4 * gi;
                unsigned nib = 0u;
#pragma unroll
                for (int r = 0; r < 4; ++r) {
                    const unsigned uu = sc[gi][r];
                    nib |= ((uu >> sh) >= sP) ? (1u << r) : 0u;
                }
                if (g < ng) atomicOr(&mrow[g >> 1], nib << ((g & 1) * 16 + 4 * fqv));
            }
        } else {
            const int shm = pass ? 32 - 8 * pass : 0, shd = 24 - 8 * pass;
            const unsigned orm = pass ? 0u : 0xFFFFFFFFu;
            const unsigned cmpv = pass ? (sDone == 0u ? sP : 0xFFFFFFFFu) : 0xFFFFFFFFu;
            unsigned* hrow = hist + ql * 257;
            unsigned* dummy = dummyb + lane;
#pragma unroll
            for (int gi = 0; gi < 32; ++gi) {
                const int g = wv + 4 * gi;
                if (g < ng) {
#pragma unroll
                    for (int r = 0; r < 4; ++r) {
                        const unsigned uu = sc[gi][r];
                        const bool match = (((uu >> shm) | orm) == cmpv);
                        const unsigned dig = (uu >> shd) & 255u;
                        unsigned* a = match ? hrow + dig : dummy;
                        atomicAdd(a, 1u);
                    }
                }
            }
        }
        }
        __syncthreads();
        if (fin) break;
        {
            const int qq = tid >> 4, seg = tid & 15;
            const bool active = (stDone[qq] == 0u);
            unsigned c16 = 0u;
            if (active) {
#pragma unroll
                for (int d = 0; d < 16; ++d) c16 += hist[qq * 257 + seg * 16 + d];
            }
            unsigned v = c16;
#pragma unroll
            for (int off = 1; off < 16; off <<= 1) { const unsigned t = __shfl_down(v, off, 16); if (seg + off < 16) v += t; }
            const unsigned suf = v - c16;
            const unsigned need = stNeed[qq];
            if (active && suf < need && need <= suf + c16) {
                unsigned run = suf, D = 0u, cD = 0u, nn = need;
                for (int d = 15; d >= 0; --d) {
                    const unsigned cc = hist[qq * 257 + seg * 16 + d];
                    if (run + cc >= need) { D = (unsigned)(seg * 16 + d); cD = cc; nn = need - run; break; }
                    run += cc;
                }
                const bool done = (cD == nn) || pass == 3;
                stP[qq] = (stP[qq] << 8) | D; stNeed[qq] = nn;
                if (done) stDone[qq] = (unsigned)(pass + 1); else atomicAdd(flag, 1u);
            }
        }
        __syncthreads();
        alldone = (*flag == 0u);
    }
    for (int i = tid; i < 1024; i += 256) p->dmask[(size_t)(tokbase + q0 + (i >> 6)) * 64 + (i & 63)] = maskl[i];
}

__device__ __forceinline__ void conv_unit(KP p, char* lds, int l, int b, int c) {
    float* red = (float*)lds;
    const int ch = TID(), lane = ch & 63, wave = ch >> 6;
    const int t0 = c * 32, tokbase = b * SEQ;
    half_t* tile = (half_t*)(lds + 4096);
    __syncthreads();
#pragma unroll
    for (int it = 0; it < 8; ++it) {
        const int i = it * 256 + ch;
        if (i < 62 * 32) {
            const int rr = i >> 5, c16 = i & 31;
            const int tt = t0 - 30 + rr;
            h8 v;
#pragma unroll
            for (int j = 0; j < 8; ++j) v[j] = (half_t)0.f;
            if (tt >= 0) v = *(const h8*)(p->P + (size_t)(tokbase + tt) * NP + c16 * 8);
            *(h8*)(tile + rr * 256 + c16 * 8) = v;
        }
    }
    __syncthreads();
    float aw[62];
#pragma unroll
    for (int rr = 0; rr < 62; ++rr) aw[rr] = (float)tile[rr * 256 + ch];
    float w[31];
#pragma unroll
    for (int i = 0; i < 31; ++i) w[i] = p->w_dw[(l * 31 + i) * 256 + ch];
    const float bias = p->b_dw[l * 256 + ch];
    float y[32], s1[32], s2[32];
#pragma unroll
    for (int tk = 0; tk < 32; ++tk) {
        float sacc = bias;
#pragma unroll
        for (int i = 0; i < 31; ++i) sacc = fmaf(aw[tk + i], w[i], sacc);
        y[tk] = sacc; s1[tk] = sacc; s2[tk] = sacc * sacc;
    }
    {
        const bool b5 = lane & 32, b4 = lane & 16, b3 = lane & 8, b2 = lane & 4, b1 = lane & 2;
        float a16[16], c16[16], a8[8], c8[8], a4[4], c4[4], a2[2], c2[2];
#pragma unroll
        for (int e = 0; e < 16; ++e) { a16[e] = (b5 ? s1[e + 16] : s1[e]) + __shfl_xor(b5 ? s1[e] : s1[e + 16], 32); c16[e] = (b5 ? s2[e + 16] : s2[e]) + __shfl_xor(b5 ? s2[e] : s2[e + 16], 32); }
#pragma unroll
        for (int e = 0; e < 8; ++e) { a8[e] = (b4 ? a16[e + 8] : a16[e]) + __shfl_xor(b4 ? a16[e] : a16[e + 8], 16); c8[e] = (b4 ? c16[e + 8] : c16[e]) + __shfl_xor(b4 ? c16[e] : c16[e + 8], 16); }
#pragma unroll
        for (int e = 0; e < 4; ++e) { a4[e] = (b3 ? a8[e + 4] : a8[e]) + __shfl_xor(b3 ? a8[e] : a8[e + 4], 8); c4[e] = (b3 ? c8[e + 4] : c8[e]) + __shfl_xor(b3 ? c8[e] : c8[e + 4], 8); }
#pragma unroll
        for (int e = 0; e < 2; ++e) { a2[e] = (b2 ? a4[e + 2] : a4[e]) + __shfl_xor(b2 ? a4[e] : a4[e + 2], 4); c2[e] = (b2 ? c4[e + 2] : c4[e]) + __shfl_xor(b2 ? c4[e] : c4[e + 2], 4); }
        float av = (b1 ? a2[1] : a2[0]) + __shfl_xor(b1 ? a2[0] : a2[1], 2), cv = (b1 ? c2[1] : c2[0]) + __shfl_xor(b1 ? c2[0] : c2[1], 2);
        av += __shfl_xor(av, 1); cv += __shfl_xor(cv, 1);
        const int tokk = (b5 ? 16 : 0) + (b4 ? 8 : 0) + (b3 ? 4 : 0) + (b2 ? 2 : 0) + (b1 ? 1 : 0);
        __syncthreads();
        if ((lane & 1) == 0) { red[(tokk * 4 + wave) * 2] = av; red[(tokk * 4 + wave) * 2 + 1] = cv; }
        __syncthreads();
    }
    const float lg = p->ln_g[l * 256 + ch], lb = p->ln_b[l * 256 + ch];
#pragma unroll
    for (int tk = 0; tk < 32; ++tk) {
        const float4 ra = *(const float4*)(red + tk * 8), rb = *(const float4*)(red + tk * 8 + 4);
        const float t1 = (ra.x + ra.z) + (rb.x + rb.z);
        const float t2 = (ra.y + ra.w) + (rb.y + rb.w);
        const float mu = t1 * (1.0f / 256.0f);
        float var = t2 * (1.0f / 256.0f) - mu * mu; var = var < 0.f ? 0.f : var;
        float z = (y[tk] - mu) * (1.0f / sqrtf(var + 1e-6f)) * lg + lb;
        z = z * sigmoidf_(z);
        p->ycat[((size_t)(ch >> 5) * T_TOK + tokbase + t0 + tk) * 32 + (ch & 31)] = (half_t)z;
    }
}

__device__ __forceinline__ void kmean_unit(KP p, char* lds, int b, int h, int blk) {
    float* part = (float*)lds;
    const int tid = TID(), c = tid & 7, rg = tid >> 3;
    const half_t* r = p->P + (size_t)(b * SEQ + blk * 256 + rg * 8) * NP + PC_MK + h * 64 + c * 8;
    h8 v[8];
#pragma unroll
    for (int k = 0; k < 8; ++k) v[k] = *(const h8*)(r + (size_t)k * NP);
    float sacc[8];
#pragma unroll
    for (int j = 0; j < 8; ++j) {
        float t = 0.f;
#pragma unroll
        for (int k = 0; k < 8; ++k) t += (float)v[k][j];
        sacc[j] = t;
    }
    __syncthreads();
    *(float4*)(part + rg * 64 + c * 8) = make_float4(sacc[0], sacc[1], sacc[2], sacc[3]);
    *(float4*)(part + rg * 64 + c * 8 + 4) = make_float4(sacc[4], sacc[5], sacc[6], sacc[7]);
    __syncthreads();
    if (tid < 64) {
        float t = 0.f;
#pragma unroll
        for (int g = 0; g < 32; ++g) t += part[g * 64 + tid];
        p->kmean[(((size_t)b * 6 + h) * 8 + blk) * 64 + tid] = t * (1.0f / 256.0f);
    }
}

#ifndef POST_MASK
#define POST_MASK 7
#endif
__device__ __forceinline__ void phase_post(KP p, char* lds, int l, int tm) {
    const int NA = 2048, NB = 1024, NC = 768;
    const int G_ = gridDim.x;
    for (int u0 = BID(), k_ = 0; u0 < NA + NB + NC; u0 += G_, ++k_) {
        int u = u0;
        if (u0 < NA && (k_ & 1) && (k_ + 1) * G_ <= NA) u = k_ * G_ + (G_ - 1 - (u0 - k_ * G_));
        if (u < NA) { if (tm & 1) dsa_select_unit(p, lds, u % 16, 127 - (u / 16)); }
        else if (u < NA + NB) { const int v = u - NA; if (tm & 2) conv_unit(p, lds, l, v % 16, v / 16); }
        else { const int v = u - NA - NB; if (tm & 4) kmean_unit(p, lds, v / 48, (v / 8) % 6, v % 8); }
    }
}

template <int MODE>
__device__ __forceinline__ void attn_unit(KP p, char* lds, int b, int h, int qt) {
    const int tid = TID(), lane = tid & 63, wave = tid >> 6, hh = lane >> 5, ql = lane & 31;
    const int q0 = qt * 128, tokbase = b * SEQ;
    const int tq = q0 + wave * 32 + ql;
    const half_t* Pb = p->P + (size_t)tokbase * NP;
    const int QOFF = MODE ? PC_MQ + h * 64 : PC_DQ + h * 64;
    const int KOFF = MODE ? PC_MK + h * 64 : PC_DK;
    const int VOFF = MODE ? PC_MV + h * 64 : PC_DV;
    const int own = qt >> 1;
    unsigned mysel = 0u, anysel = 0u;
    __syncthreads();
    h8 qf[4];
#pragma unroll
    for (int ks = 0; ks < 4; ++ks) qf[ks] = *(const h8*)(Pb + (size_t)tq * NP + QOFF + 16 * ks + 8 * hh);
    if (MODE == 1) {
        float* km = (float*)(lds + 32768);
        unsigned* anyb = (unsigned*)(km + 512);
        for (int i = tid; i < 512; i += 256) km[i] = p->kmean[((size_t)b * 6 + h) * 512 + i];
        if (tid == 0) *anyb = 0u;
        __syncthreads();
        float gt[8];
#pragma unroll
        for (int j = 0; j < 8; ++j) {
            float sacc = 0.f;
            if (j < own) {
#pragma unroll
                for (int ks = 0; ks < 4; ++ks) {
                    const float4 k0 = *(const float4*)(km + j * 64 + 16 * ks + 8 * hh), k1 = *(const float4*)(km + j * 64 + 16 * ks + 8 * hh + 4);
                    sacc = fmaf((float)qf[ks][0], k0.x, sacc); sacc = fmaf((float)qf[ks][1], k0.y, sacc); sacc = fmaf((float)qf[ks][2], k0.z, sacc); sacc = fmaf((float)qf[ks][3], k0.w, sacc);
                    sacc = fmaf((float)qf[ks][4], k1.x, sacc); sacc = fmaf((float)qf[ks][5], k1.y, sacc); sacc = fmaf((float)qf[ks][6], k1.z, sacc); sacc = fmaf((float)qf[ks][7], k1.w, sacc);
                }
            }
            gt[j] = sacc + __shfl_xor(sacc, 32);
        }
        unsigned m = 0u;
        const int want = own < 3 ? own : 3;
#pragma unroll
        for (int r = 0; r < 3; ++r) {
            if (r < want) {
                int best = -1; float bv = -INFINITY;
#pragma unroll
                for (int j = 0; j < 8; ++j) { if (j < own && !((m >> j) & 1u) && (best < 0 || gt[j] > bv)) { best = j; bv = gt[j]; } }
                m |= 1u << best;
            }
        }
        mysel = m;
        unsigned wmk = m;
#pragma unroll
        for (int o = 16; o >= 1; o >>= 1) wmk |= (unsigned)__shfl_xor((int)wmk, o);
        if (lane == 0 && wmk) atomicOr(anyb, wmk);
        __syncthreads();
        anysel = *anyb;
    }
    f16v O0, O1;
#pragma unroll
    for (int r = 0; r < 16; ++r) { O0[r] = 0.f; O1[r] = 0.f; }
    float l_run = 0.f;
    bool unset = true;
    f16v negm;
#pragma unroll
    for (int r = 0; r < 16; ++r) negm[r] = 0.f;
    const float THR = 8.0f;
    const int ntile = 2 * qt + 2;
    auto skip = [&](int kt) -> bool { return MODE == 1 && kt < 4 * own && !((anysel >> (kt >> 2)) & 1u); };
    auto nexttile = [&](int kt) -> int { ++kt; while (kt < ntile && skip(kt)) ++kt; return kt; };
    const int lrow = tid >> 3;
    const int kchunk = (tid & 7) ^ ((tid >> 4) & 7);
    const int vchunk = (tid & 7) ^ (((tid >> 4) & 1) << 2);
    char* ldst = lds + lrow * 128 + (tid & 7) * 16;
    auto issue = [&](int kt, int s) {
        const half_t* src = Pb + (size_t)(kt * 64 + lrow) * NP;
        char* d = ldst + s * 16384;
        glds16(src + KOFF + kchunk * 8, d);
        glds16(src + (size_t)32 * NP + KOFF + kchunk * 8, d + 4096);
        glds16(src + VOFF + vchunk * 8, d + 8192);
        glds16(src + (size_t)32 * NP + VOFF + vchunk * 8, d + 8192 + 4096);
    };
    const int rsw = (lane >> 1) & 7;
    const int kro = ql * 128;
    const int li = lane & 15, qp = li >> 2, pp = li & 3, swv = (qp >> 1) & 1;
    const int vb0 = 8192 + (4 * hh + qp) * 128 + 32 * ((lane >> 4) & 1) + 8 * pp + 64 * (0 ^ swv);
    const int vb1 = 8192 + (4 * hh + qp) * 128 + 32 * ((lane >> 4) & 1) + 8 * pp + 64 * (1 ^ swv);
    int kt = -1; kt = nexttile(kt);
    int s = 0;
    if (kt < ntile) issue(kt, 0);
    while (kt < ntile) {
        const int ktn = nexttile(kt);
        asm volatile("s_waitcnt vmcnt(0)" ::: "memory");
        __syncthreads();
        if (ktn < ntile) issue(ktn, s ^ 1);
        const bool wave_active = (kt * 64 <= q0 + wave * 32 + 31);
        if (wave_active) {
            const char* base = lds + s * 16384;
            uint2 mw = make_uint2(0u, 0u);
            if (MODE == 0) mw = *(const uint2*)(p->dmask + (size_t)(tokbase + tq) * 64 + 2 * kt);
            h8 vf0[4], vf1[4];
#pragma unroll
            for (int kk = 0; kk < 4; ++kk) {
                const int roff = (32 * (kk >> 1) + 16 * (kk & 1)) * 128;
                const s4v lo0 = __builtin_amdgcn_ds_read_tr16_b64_v4i16((LAS s4v*)(base + vb0 + roff));
                const s4v hi0 = __builtin_amdgcn_ds_read_tr16_b64_v4i16((LAS s4v*)(base + vb0 + roff + 8 * 128));
                const s4v lo1 = __builtin_amdgcn_ds_read_tr16_b64_v4i16((LAS s4v*)(base + vb1 + roff));
                const s4v hi1 = __builtin_amdgcn_ds_read_tr16_b64_v4i16((LAS s4v*)(base + vb1 + roff + 8 * 128));
                vf0[kk] = __builtin_bit_cast(h8, __builtin_shufflevector(lo0, hi0, 0, 1, 2, 3, 4, 5, 6, 7));
                vf1[kk] = __builtin_bit_cast(h8, __builtin_shufflevector(lo1, hi1, 0, 1, 2, 3, 4, 5, 6, 7));
            }
            bool lane_on = true;
            if (MODE == 1 && kt < 4 * own) lane_on = (mysel >> (kt >> 2)) & 1u;
            f16v cin = negm;
            if (MODE == 1 && kt < 4 * own) {
#pragma unroll
                for (int r = 0; r < 16; ++r) cin[r] = lane_on ? negm[r] : -INFINITY;
            }
            f16v s0 = cin, s1 = cin;
#pragma unroll
            for (int ks = 0; ks < 4; ++ks) {
                const int co = ((2 * ks + hh) ^ rsw) << 4;
                const h8 k0 = *(const h8*)(base + kro + co), k1 = *(const h8*)(base + kro + 4096 + co);
                s0 = __builtin_amdgcn_mfma_f32_32x32x16_f16(k0, qf[ks], s0, 0, 0, 0);
                s1 = __builtin_amdgcn_mfma_f32_32x32x16_f16(k1, qf[ks], s1, 0, 0, 0);
            }
            if (MODE == 0) {
                const unsigned w0 = mw.x >> (4 * hh), w1 = mw.y >> (4 * hh);
#pragma unroll
                for (int r = 0; r < 16; ++r) {
                    const int pos = (r & 3) + 8 * (r >> 2);
                    const unsigned m0 = (unsigned)__builtin_amdgcn_sbfe((int)w0, pos, 1), m1 = (unsigned)__builtin_amdgcn_sbfe((int)w1, pos, 1);
                    s0[r] = __uint_as_float((__float_as_uint(s0[r]) & m0) | (0xFF800000u & ~m0));
                    s1[r] = __uint_as_float((__float_as_uint(s1[r]) & m1) | (0xFF800000u & ~m1));
                }
            } else if (kt >= 4 * own && kt * 64 + 63 > q0 + wave * 32) {
#pragma unroll
                for (int r = 0; r < 16; ++r) {
                    const int key = kt * 64 + (r & 3) + 8 * (r >> 2) + 4 * hh;
                    s0[r] = (key <= tq) ? s0[r] : -INFINITY;
                    s1[r] = (key + 32 <= tq) ? s1[r] : -INFINITY;
                }
            }
            float mx = s0[0];
#pragma unroll
            for (int r = 1; r < 16; ++r) mx = fmaxf(mx, s0[r]);
#pragma unroll
            for (int r = 0; r < 16; ++r) mx = fmaxf(mx, s1[r]);
            mx = fmaxf(mx, __shfl_xor(mx, 32));
            const bool need = unset ? (mx > -INFINITY) : (mx > THR);
            if (__any(need)) {
                const float delta = need ? mx : 0.f;
                const float alpha = (need && !unset) ? __builtin_amdgcn_exp2f(-delta) : 1.0f;
#pragma unroll
                for (int r = 0; r < 16; ++r) { s0[r] -= delta; s1[r] -= delta; negm[r] -= delta; O0[r] *= alpha; O1[r] *= alpha; }
                l_run *= alpha;
                unset = unset && !need;
            }
            float ls = 0.f;
#pragma unroll
            for (int r = 0; r < 16; ++r) { s0[r] = __builtin_amdgcn_exp2f(s0[r]); ls += s0[r]; }
#pragma unroll
            for (int r = 0; r < 16; ++r) { s1[r] = __builtin_amdgcn_exp2f(s1[r]); ls += s1[r]; }
            l_run += ls;
#pragma unroll
            for (int kk = 0; kk < 4; ++kk) {
                h8 pf;
#pragma unroll
                for (int j = 0; j < 8; ++j) pf[j] = (half_t)((kk >> 1) ? s1[8 * (kk & 1) + j] : s0[8 * (kk & 1) + j]);
                O0 = __builtin_amdgcn_mfma_f32_32x32x16_f16(vf0[kk], pf, O0, 0, 0, 0);
                O1 = __builtin_amdgcn_mfma_f32_32x32x16_f16(vf1[kk], pf, O1, 0, 0, 0);
            }
        }
        kt = ktn; s ^= 1;
    }
    const float lt = l_run + __shfl_xor(l_run, 32);
    const float inv = 1.0f / lt;
    const int ycol = (MODE ? 640 : 256) + h * 64;
    half_t* dst = p->ycat + ((size_t)(ycol >> 5) * T_TOK + tokbase + tq) * 32 + 4 * hh;
#pragma unroll
    for (int g = 0; g < 4; ++g) {
        *(h4*)(dst + 8 * g) = pack4(O0[4 * g] * inv, O0[4 * g + 1] * inv, O0[4 * g + 2] * inv, O0[4 * g + 3] * inv);
        *(h4*)(dst + (size_t)T_TOK * 32 + 8 * g) = pack4(O1[4 * g] * inv, O1[4 * g + 1] * inv, O1[4 * g + 2] * inv, O1[4 * g + 3] * inv);
    }
}

#ifndef ATT_MASK
#define ATT_MASK 3
#endif
__device__ __forceinline__ void phase_attn(KP p, char* lds, int tm) {
    const int G_ = gridDim.x, per_ = G_ >> 3;
    const bool snake_ = (G_ >= 8) && ((G_ & 7) == 0);
    for (int k_ = 0, b_ = BID(); snake_ ? (k_ * per_ < 384) : (b_ + k_ * G_ < 3072); ++k_) {
        int xl, Lx;
        if (snake_) { const int idx_ = b_ >> 3; xl = b_ & 7; Lx = k_ * per_ + ((k_ & 1) ? (per_ - 1 - idx_) : idx_); }
        else { const int u = b_ + k_ * G_; xl = u & 7; Lx = u >> 3; }
        if (Lx >= 384) continue;
        const int qt = 15 - (Lx / 24), rem = Lx % 24;
        const int type = rem & 1, bh = xl * 12 + (rem >> 1);
        if (type == 0) { if (tm & 1) attn_unit<0>(p, lds, bh / 6, bh % 6, qt); }
        else { if (tm & 2) attn_unit<1>(p, lds, bh / 6, bh % 6, qt); }
    }
}

__global__ void __launch_bounds__(256, 2) mk_fwd(Params p_unused) {
    extern __shared__ __attribute__((aligned(16))) char lds[];
    volatile LAS unsigned* stw = (volatile LAS unsigned*)(lds + LDS_CTL);
    if (threadIdx.x < 4) stw[threadIdx.x] = 0u;
    __syncthreads();
    KP p0 = (KP)__builtin_amdgcn_kernarg_segment_ptr();
    XcdBarrier bar; bar.bar = p0->bar; bar.x = 0; bar.st = stw;
#if !MK_SPLIT
    bar = xcd_barrier_post(p0->bar, stw);
#endif
    const int ph_lo = p0->ph_lo, ph_hi = p0->ph_hi;
    for (int ph = ph_lo; ph < ph_hi; ++ph) {
      KP p = p0; asm volatile("" : "+s"(p));
      const int nrep = (DUP_SUB >= 0 && ((DUP_SUB == 100 && ph == 0) || (ph >= 2 && ph < NPHASE - 1 && ((ph - 2) & 7) == DUP_SUB && (DUP_SUB != 4 || ph < 10)))) ? 2 : 1;
      for (int rep = 0; rep < nrep; ++rep) {
        if (ph == 0) phase_prologue(p, lds);
        else if (ph == 1) phase_modsum(p);
        else if (ph == NPHASE - 1) phase_norm<2, true>(p, lds, p->xr, p->g_final, nullptr, nullptr, 0);
        else {
            const int l = (ph - 2) >> 3, sub = (ph - 2) & 7;
            const float* mf = p->modf + (size_t)l * 16 * 6144;
            if (sub == 0) { if (l == 0) phase_norm<0, false>(p, lds, p->x, p->g_mix + l * DM, mf, mf + 1024, l); else phase_norm<0, true>(p, lds, p->xr, p->g_mix + l * DM, mf, mf + 1024, l); }
            else if (sub == 1) phase_inproj(p, lds, l);
            else if (sub == 2) phase_post(p, lds, l, rep ? POST_MASK : 7);
            else if (sub == 3) phase_attn(p, lds, rep ? ATT_MASK : 3);
            else if (sub == 4) { if (l == 0) phase_outproj<false>(p, lds, l, p->x); else phase_outproj<true>(p, lds, l, p->xr); }
            else if (sub == 5) phase_norm_router(p, lds, p->xr, p->g_ffn + l * DM, mf + 3 * 1024, mf + 4 * 1024, (nrep == 2 && rep == 0) ? l + 2 : l);
            else if (sub == 6) phase_moe_up(p, lds, l);
            else phase_moe_down(p, lds, l, nrep == 2 ? 0.5f : 1.0f);
        }
      }
#if !MK_SPLIT
        if (ph + 1 < ph_hi) xcd_barrier(bar);
#endif
    }
}

extern "C" void kernel_launch(void* const* d_in, const int* in_sizes, int n_in, void* d_out, int out_size, void* d_ws, size_t ws_size, hipStream_t stream) {
    static int grid = 0;
    if (grid == 0) {
        int dev = 0, cus = 0, per_cu = 0;
        (void)hipGetDevice(&dev);
        (void)hipDeviceGetAttribute(&cus, hipDeviceAttributeMultiprocessorCount, dev);
        (void)hipFuncSetAttribute((const void*)mk_fwd, hipFuncAttributeMaxDynamicSharedMemorySize, LDS_BYTES);
        if (hipOccupancyMaxActiveBlocksPerMultiprocessor(&per_cu, (const void*)mk_fwd, 256, LDS_BYTES) != hipSuccess || per_cu < 1) per_cu = 1;
        (void)hipGetLastError();
        if (per_cu > 2) per_cu = 2;
        grid = cus * per_cu;
        fprintf(stderr, "mk_fwd: cus %d per_cu %d grid %d\n", cus, per_cu, grid);
    }
    Params p{};
    const float** pin = (const float**)&p.x;
    for (int i = 0; i < 18; ++i) pin[i] = (const float*)d_in[i];
    p.out = (float*)d_out;
    char* ws = (char*)d_ws;
    size_t off = 0;
    auto carve = [&](size_t bytes) { void* q = ws + off; off += (bytes + 255) & ~(size_t)255; return q; };
    p.bar = (unsigned*)carve(XCD_BAR_WORDS * 4);
    p.cnt = (int*)carve(4 * 32 * 64 * 4);
    const size_t zero_bytes = off;
    p.Wt_in = (half_t*)carve((size_t)2 * NP * DM * 2);
    p.Wt_o = (half_t*)carve((size_t)2 * DM * DM * 2);
    p.Wt_gu = (half_t*)carve((size_t)2 * 16 * 512 * 1024 * 2);
    p.Wt_d = (half_t*)carve((size_t)2 * 16 * 1024 * 256 * 2);
    p.hn = (half_t*)carve((size_t)T_TOK * DM * 2);
    p.P = (half_t*)carve((size_t)T_TOK * NP * 2);
    p.ycat = (half_t*)carve((size_t)T_TOK * DM * 2);
    p.act = (half_t*)carve((size_t)T_TOK * 512 * 2);
    p.xr = (half_t*)carve((size_t)T_TOK * DM * 2);
    p.modpart = (float*)carve((size_t)8 * 2 * 16 * 6144 * 4);
    p.modf = (float*)carve((size_t)2 * 16 * 6144 * 4);
    p.kmean = (float*)carve((size_t)16 * 6 * 8 * 64 * 4);
    p.rope = (float*)carve((size_t)2048 * 24 * 4);
    p.iwf = (float*)carve((size_t)T_TOK * 4 * 4);
    p.tokw = (float*)carve((size_t)T_TOK * 2 * 4);
    p.dmask = (unsigned*)carve((size_t)T_TOK * 64 * 4);
    p.lists = (int*)carve((size_t)NCLS * T_TOK * 4);
    if (off > ws_size) { fprintf(stderr, "workspace too small: need %zu have %zu\n", off, ws_size); return; }
    (void)hipMemsetAsync(d_ws, 0, zero_bytes, stream);
#if MK_SPLIT
    for (int ph = 0; ph < NPHASE; ++ph) {
        p.ph_lo = ph; p.ph_hi = ph + 1;
        hipLaunchKernelGGL(mk_fwd, dim3(grid), dim3(256), LDS_BYTES, stream, p);
    }
#else
    p.ph_lo = 0; p.ph_hi = NPHASE;
    hipLaunchKernelGGL(mk_fwd, dim3(grid), dim3(256), LDS_BYTES, stream, p);
#endif
}
```

```cpp
#include <hip/hip_runtime.h>
#include <cstdio>
#include <cstdint>

#ifndef MK_SPLIT
#define MK_SPLIT 0
#endif

#define T_TOK 32768
#define DM 1024
#define SEQ 2048
#define INW 2340
#define NP 2432
#define PC_CU 0
#define PC_CG 256
#define PC_DQ 512
#define PC_DK 896
#define PC_DV 960
#define PC_IQ 1024
#define PC_IK 1152
#define PC_IW 1184
#define PC_MQ 1280
#define PC_MK 1664
#define PC_MV 2048
#define LOG_THETA 13.122363377404328f
#define NCLS 24
#define LDS_CTL 73728
#define LDS_BYTES 78336
#define NPHASE 19
#ifndef DUP_SUB
#define DUP_SUB -1
#endif

typedef _Float16 half_t;
typedef _Float16 h8 __attribute__((ext_vector_type(8)));
typedef _Float16 h4 __attribute__((ext_vector_type(4)));
typedef short s4v __attribute__((ext_vector_type(4)));
typedef short s8v __attribute__((ext_vector_type(8)));
typedef float f16v __attribute__((ext_vector_type(16)));
typedef float f4v __attribute__((ext_vector_type(4)));
#define LAS __attribute__((address_space(3)))

struct Params {
    const float *x, *c, *w_ada, *b_ada, *g_mix, *w_in, *w_dw, *b_dw, *ln_g, *ln_b, *w_o, *g_ffn, *w_router, *b_router, *w_gate, *w_up, *w_down, *g_final;
    float* out;
    half_t *Wt_in, *Wt_o, *Wt_gu, *Wt_d, *hn, *P, *ycat, *act, *xr;
    float *modpart, *modf, *kmean, *rope, *iwf, *tokw;
    unsigned* dmask; int* cnt; int* lists; unsigned* bar;
    int ph_lo, ph_hi;
};

#define XB_TMO      128
#define XB_XCNT(j)  (256  + 64 * (j))
#define XB_XSUB(j)  (1280 + 64 * (j))
#define XB_XGEN(j)  (2304 + 64 * (j))
#define XB_TOP      3328
#define XB_TOPGEN   3392
#define XCD_BAR_WORDS 3456
#define XB_SPIN_CAP (1u << 20)
__device__ __forceinline__ unsigned xb_ld(unsigned* p)              { return __hip_atomic_load(p, __ATOMIC_RELAXED, __HIP_MEMORY_SCOPE_AGENT); }
__device__ __forceinline__ unsigned xb_add(unsigned* p, unsigned v) { return __hip_atomic_fetch_add(p, v, __ATOMIC_RELAXED, __HIP_MEMORY_SCOPE_AGENT); }
__device__ __forceinline__ unsigned xb_xcc_id() { return (unsigned)__builtin_amdgcn_s_getreg((3 << 11) | 20) & 0xFu; }
#define XB_SPIN(cond, bar) do { unsigned _sp = 0; while (cond) { __builtin_amdgcn_s_sleep(1); \
    if ((++_sp & 255u) == 0u) { if (xb_ld(&(bar)[XB_TMO])) break; if (_sp > XB_SPIN_CAP) { atomicAdd(&(bar)[XB_TMO], 1u); break; } } } } while (0)
struct XcdBarrier { unsigned* bar; unsigned x; volatile LAS unsigned* st; };
__device__ __forceinline__ XcdBarrier xcd_barrier_post(unsigned* bar, volatile LAS unsigned* st) {
    XcdBarrier b; b.bar = bar; b.x = xb_xcc_id(); b.st = st;
    if (threadIdx.x == 0) (void)xb_add(&bar[XB_XCNT(b.x)], 1u);
    return b;
}
__device__ __forceinline__ void xcd_barrier_complete(unsigned* bar, unsigned x, unsigned& nloc, unsigned& nx) {
    const unsigned G = gridDim.x * gridDim.y * gridDim.z;
    unsigned sum, cnt, mine, sp = 0u;
    for (;;) {
        sum = 0u; cnt = 0u; mine = 0u;
#pragma unroll
        for (unsigned j = 0; j < 16; ++j) { const unsigned c = xb_ld(&bar[XB_XCNT(j)]); sum += c; cnt += (c > 0u) ? 1u : 0u; mine = (j == x) ? c : mine; }
        if (sum == G) break;
        __builtin_amdgcn_s_sleep(1);
        if ((++sp & 255u) == 0u) { if (xb_ld(&bar[XB_TMO])) break; if (sp > XB_SPIN_CAP) { atomicAdd(&bar[XB_TMO], 1u); break; } }
    }
    nloc = mine > 0u ? mine : 1u; nx = cnt > 0u ? cnt : 1u;
}
__device__ __forceinline__ void xcd_barrier(const XcdBarrier& b) {
    asm volatile("s_waitcnt vmcnt(0)" ::: "memory");
    __syncthreads();
    if (threadIdx.x == 0) {
        unsigned* bar = b.bar;
        __builtin_amdgcn_s_waitcnt(0);
        unsigned nloc = b.st[0], nx = b.st[1];
        if (nloc == 0u) { xcd_barrier_complete(bar, b.x, nloc, nx); b.st[0] = nloc; b.st[1] = nx; }
        const unsigned old = xb_add(&bar[XB_XSUB(b.x)], 1u);
        const unsigned gen = old / nloc;
        if (old + 1u == (gen + 1u) * nloc) {
            __builtin_amdgcn_fence(__ATOMIC_RELEASE, "agent");
            asm volatile("s_waitcnt vmcnt(0)" ::: "memory");
            const unsigned og = xb_add(&bar[XB_TOP], 1u);
            const unsigned tg = og / nx;
            if (og + 1u == (tg + 1u) * nx) xb_add(&bar[XB_TOPGEN], 1u);
            else XB_SPIN(xb_ld(&bar[XB_TOPGEN]) == tg, bar);
            __builtin_amdgcn_fence(__ATOMIC_ACQUIRE, "agent");
            xb_add(&bar[XB_XGEN(b.x)], 1u);
            asm volatile("s_waitcnt vmcnt(0)" ::: "memory");
        } else {
            XB_SPIN(xb_ld(&bar[XB_XGEN(b.x)]) == gen, bar);
            __builtin_amdgcn_fence(__ATOMIC_ACQUIRE, "agent");
            asm volatile("s_waitcnt vmcnt(0)" ::: "memory");
        }
    }
    __syncthreads();
}

typedef const __attribute__((address_space(4))) Params* KP;
__device__ __forceinline__ int TID() { int t = threadIdx.x; asm volatile("" : "+v"(t)); return t; }
__device__ __forceinline__ int BID() { int b = blockIdx.x; asm volatile("" : "+s"(b)); return b; }
__device__ __forceinline__ float sigmoidf_(float v) { return __builtin_amdgcn_rcpf(1.0f + __expf(-v)); }
__device__ __forceinline__ void glds16(const void* g, char* l) { __builtin_amdgcn_global_load_lds((const unsigned*)g, (unsigned*)l, 16, 0, 0); }
__device__ __forceinline__ unsigned f2sortable(float f) { unsigned u = __float_as_uint(f); return (u & 0x80000000u) ? ~u : (u | 0x80000000u); }
template <bool HIN> __device__ __forceinline__ float4 ldx4(const void* base, size_t idx) {
    if (HIN) { const h4 t = *(const h4*)((const half_t*)base + idx); return make_float4((float)t[0], (float)t[1], (float)t[2], (float)t[3]); }
    return *(const float4*)((const float*)base + idx);
}
__device__ __forceinline__ h4 pack4(float a, float b, float c, float d) { h4 r = {(half_t)a, (half_t)b, (half_t)c, (half_t)d}; return r; }

template <class CF>
__device__ __forceinline__ void conv_tile_panel(char* lds, CF colf, int src_ld, int k0, int n0, half_t* dst, int nrows) {
    float* tl = (float*)lds;
    const int tid = TID();
    __syncthreads();
    {
        const int nn = tid & 63;
        const float* cp = colf(nn);
        float tv[16];
#pragma unroll
        for (int i = 0; i < 16; ++i) { const int k = i * 4 + (tid >> 6); tv[i] = cp ? cp[(size_t)(k0 + k) * src_ld] : 0.f; }
#pragma unroll
        for (int i = 0; i < 16; ++i) { const int k = i * 4 + (tid >> 6); tl[k * 65 + nn] = tv[i]; }
    }
    __syncthreads();
    {
        const int n = tid >> 2, kq = (tid & 3) * 16;
        h8 a, b;
#pragma unroll
        for (int j = 0; j < 8; ++j) { a[j] = (half_t)tl[(kq + j) * 65 + n]; b[j] = (half_t)tl[(kq + 8 + j) * 65 + n]; }
        const int k = k0 + kq;
        h8* d = (h8*)(dst + ((size_t)(k >> 5) * nrows + n0 + n) * 32 + (k & 31));
        d[0] = a; d[1] = b;
    }
}
template <class CF>
__device__ __forceinline__ void conv_tile(char* lds, CF colf, int src_ld, int k0, half_t* dst_tile  , int dstK) {
    float* tl = (float*)lds;
    const int tid = TID();
    __syncthreads();
    {
        const int nn = tid & 63;
        const float* cp = colf(nn);
        float tv[16];
#pragma unroll
        for (int i = 0; i < 16; ++i) { const int k = i * 4 + (tid >> 6); tv[i] = cp ? cp[(size_t)(k0 + k) * src_ld] : 0.f; }
#pragma unroll
        for (int i = 0; i < 16; ++i) { const int k = i * 4 + (tid >> 6); tl[k * 65 + nn] = tv[i]; }
    }
    __syncthreads();
    {
        const int n = tid >> 2, kq = (tid & 3) * 16;
        h8 a, b;
#pragma unroll
        for (int j = 0; j < 8; ++j) { a[j] = (half_t)tl[(kq + j) * 65 + n]; b[j] = (half_t)tl[(kq + 8 + j) * 65 + n]; }
        h8* d = (h8*)(dst_tile + (size_t)n * dstK + kq);
        d[0] = a; d[1] = b;
    }
}

__device__ __forceinline__ void phase_prologue(KP p, char* lds) {
    const int tid = TID();
    const int NA = 2 * 16 * 38, NB = 2 * 16 * 16, NC = 2 * 16 * 16 * 8, ND = 2 * 16 * 4 * 16, NE = 384, NF = 8;
    const int total = NA + NB + NC + ND + NE + NF;
    for (int u0 = BID(); u0 < total; u0 += gridDim.x) {
        int u = u0;
        if (u < NA) {
            const int nt = u % 38, kt = (u / 38) % 16, l = u / (38 * 16);
            const float* src = p->w_in + (size_t)l * DM * INW;
            const int n0 = nt * 64;
            conv_tile_panel(lds, [&](int nn) -> const float* { const int np = n0 + nn; const int sc = np < 512 ? (((np & 63) < 32) ? 32 * (np >> 6) + (np & 31) : 256 + 32 * (np >> 6) + (np & 31)) : (np < 1188 ? np : (np < 1280 ? -1 : np - 92)); return sc >= 0 ? src + sc : (const float*)nullptr; },
                      INW, kt * 64, n0, p->Wt_in + (size_t)l * NP * DM, NP);
            continue;
        }
        u -= NA;
        if (u < NB) {
            const int nt = u % 16, kt = (u / 16) % 16, l = u / 256;
            const float* src = p->w_o + (size_t)l * DM * DM + nt * 64;
            conv_tile_panel(lds, [&](int nn) -> const float* { return src + nn; }, DM, kt * 64, nt * 64, p->Wt_o + (size_t)l * DM * DM, DM);
            continue;
        }
        u -= NB;
        if (u < NC) {
            const int nt = u % 8, kt = (u / 8) % 16, le = u / 128;
            const float* sg = p->w_gate + (size_t)le * 1024 * 256 + nt * 32;
            const float* su = p->w_up + (size_t)le * 1024 * 256 + nt * 32;
            conv_tile(lds, [&](int nn) -> const float* { return nn < 32 ? sg + nn : su + (nn - 32); }, 256, kt * 64, p->Wt_gu + ((size_t)le * 512 + nt * 64) * 1024 + kt * 64, 1024);
            continue;
        }
        u -= NC;
        if (u < ND) {
            const int nt = u % 16, kt = (u / 16) % 4, le = u / 64;
            const float* src = p->w_down + (size_t)le * 256 * 1024 + nt * 64;
            conv_tile(lds, [&](int nn) -> const float* { return src + nn; }, 1024, kt * 64, p->Wt_d + ((size_t)le * 1024 + nt * 64) * 256 + kt * 64, 256);
            continue;
        }
        u -= ND;
        if (u < NE) {
            const int kc = u % 8, cc = (u / 8) % 24, l = u / 192;
            float* ca = (float*)lds;
            __syncthreads();
            for (int i = tid; i < 2048; i += 256) { const int b = i >> 7, k = i & 127; const float v = p->c[b * 1024 + kc * 128 + k]; ca[i] = v / (1.0f + expf(-v)); }
            __syncthreads();
            const int n = cc * 256 + tid;
            float acc[16];
#pragma unroll
            for (int b = 0; b < 16; ++b) acc[b] = 0.f;
            const float* w = p->w_ada + ((size_t)l * 1024 + kc * 128) * 6144 + n;
            for (int k0 = 0; k0 < 128; k0 += 32) {
                float wv[32];
#pragma unroll
                for (int j = 0; j < 32; ++j) wv[j] = w[(size_t)(k0 + j) * 6144];
                __builtin_amdgcn_sched_barrier(0);
#pragma unroll
                for (int j4 = 0; j4 < 8; ++j4) {
#pragma unroll
                    for (int b = 0; b < 16; ++b) {
                        const float4 c4 = *(const float4*)(ca + b * 128 + k0 + 4 * j4);
                        acc[b] = fmaf(c4.x, wv[4 * j4], fmaf(c4.y, wv[4 * j4 + 1], fmaf(c4.z, wv[4 * j4 + 2], fmaf(c4.w, wv[4 * j4 + 3], acc[b]))));
                    }
                }
                __builtin_amdgcn_sched_barrier(0);
            }
#pragma unroll
            for (int b = 0; b < 16; ++b) p->modpart[(((size_t)kc * 2 + l) * 16 + b) * 6144 + n] = acc[b];
            continue;
        }
        u -= NE;
        {
            for (int i = u * 256 + tid; i < 2048 * 12; i += NF * 256) {
                const int t = i / 12, r = i % 12;
                const int fi = r < 8 ? r : r - 8;
                const float rot = r < 8 ? 16.f : 8.f;
                const float inv = expf(-LOG_THETA * ((float)fi * 2.0f / rot));
                const float ang = (float)t * inv;
                float sn, cs; sincosf(ang, &sn, &cs);
                if (r < 8) { p->rope[t * 8 + fi] = cs; p->rope[16384 + t * 8 + fi] = sn; }
                else { p->rope[32768 + t * 4 + fi] = cs; p->rope[32768 + 8192 + t * 4 + fi] = sn; }
            }
        }
    }
}

__device__ __forceinline__ void phase_modsum(KP p) {
    for (int i = BID() * 256 + TID(); i < 2 * 16 * 6144; i += gridDim.x * 256) {
        const int n = i % 6144, l = i / (16 * 6144);
        float s = p->b_ada[l * 6144 + n];
#pragma unroll
        for (int kc = 0; kc < 8; ++kc) s += p->modpart[(size_t)kc * (2 * 16 * 6144) + i];
        p->modf[i] = s;
    }
}

__device__ __forceinline__ void route_flush(KP p, char* lds, int lane, int wave, int n, int myrow, int layer) {
    const float* lg = (const float*)(lds + LDS_CTL + 512) + wave * 256;
    int* lc = (int*)(lds + LDS_CTL + 64);
    int* lbase = lc + 32;
    const int tid = wave * 64 + lane;
    if (tid < 32) lc[tid] = 0;
    __syncthreads();
    int cls = 0, lpos = 0;
    if (lane < n) {
        float aff[16], bia[16];
#pragma unroll
        for (int e = 0; e < 16; ++e) { aff[e] = 1.0f / (1.0f + expf(-lg[lane * 16 + e])); bia[e] = aff[e] + p->b_router[e]; }
        int bestg = 0; float bests = -INFINITY;
#pragma unroll
        for (int gi = 0; gi < 4; ++gi) {
            float m1 = -INFINITY, m2 = -INFINITY;
#pragma unroll
            for (int j = 0; j < 4; ++j) { const float vv = bia[gi * 4 + j]; if (vv > m1) { m2 = m1; m1 = vv; } else if (vv > m2) m2 = vv; }
            const float s = m1 + m2;
            if (s > bests) { bests = s; bestg = gi; }
        }
        float bsel[4], asel[4];
#pragma unroll
        for (int j = 0; j < 4; ++j) { bsel[j] = 0.f; asel[j] = 0.f; }
#pragma unroll
        for (int gi = 0; gi < 4; ++gi) if (gi == bestg) {
#pragma unroll
            for (int j = 0; j < 4; ++j) { bsel[j] = bia[gi * 4 + j]; asel[j] = aff[gi * 4 + j]; }
        }
        int i1 = -1, i2 = -1; float v1 = -INFINITY, v2 = -INFINITY;
#pragma unroll
        for (int j = 0; j < 4; ++j) { const float vv = bsel[j]; if (vv > v1) { v2 = v1; i2 = i1; v1 = vv; i1 = j; } else if (vv > v2) { v2 = vv; i2 = j; } }
        const int a = i1 < i2 ? i1 : i2, bb = i1 < i2 ? i2 : i1;
        float wa = 0.f, wb = 0.f;
#pragma unroll
        for (int j = 0; j < 4; ++j) { if (j == a) wa = asel[j]; if (j == bb) wb = asel[j]; }
        const float sw = wa + wb;
        const int pi = (a == 0) ? (bb - 1) : (a == 1 ? (bb + 1) : 5);
        cls = bestg * 6 + pi;
        *(float2*)(p->tokw + (size_t)myrow * 2) = make_float2(wa / sw, wb / sw);
        lpos = atomicAdd(&lc[cls], 1);
    }
    __syncthreads();
    if (tid < NCLS) { const int c = lc[tid]; lbase[tid] = c ? atomicAdd(&p->cnt[(layer * 32 + tid) * 64], c) : 0; }
    __syncthreads();
    if (lane < n) p->lists[(size_t)cls * T_TOK + lbase[cls] + lpos] = myrow;
}

template <int MODE, bool HIN>
__device__ __forceinline__ void phase_norm(KP p, char* lds, const void* xin, const float* g, const float* sh, const float* sc, int layer) {
    const int lane = TID() & 63, wave = TID() >> 6;
    float* wt = (float*)lds;
    if (MODE == 1) {
        __syncthreads();
        for (int i = TID(); i < 4096; i += 256) {
            const float4 w4 = ((const float4*)p->w_router)[i];
            const int k = i >> 2, e0 = (i & 3) * 4;
            wt[(e0 + 0) * 1024 + k] = w4.x; wt[(e0 + 1) * 1024 + k] = w4.y; wt[(e0 + 2) * 1024 + k] = w4.z; wt[(e0 + 3) * 1024 + k] = w4.w;
        }
        __syncthreads();
    }
    float* lgb = (float*)(lds + LDS_CTL + 512);
    int myrow = 0, it = 0;
    float4 vn[4];
    {
        const int row0 = BID() * 4 + wave;
        const size_t xo = (size_t)(row0 < T_TOK ? row0 : 0) * DM;
#pragma unroll
        for (int i = 0; i < 4; ++i) vn[i] = ldx4<HIN>(xin, xo + (lane + 64 * i) * 4);
    }
    for (int row = BID() * 4 + wave; row < T_TOK; row += gridDim.x * 4) {
        const int b = row >> 11;
        float4 v[4]; float ss = 0.f;
#pragma unroll
        for (int i = 0; i < 4; ++i) v[i] = vn[i];
        {
            const int rown = row + gridDim.x * 4;
            const size_t xo = (size_t)(rown < T_TOK ? rown : row) * DM;
#pragma unroll
            for (int i = 0; i < 4; ++i) vn[i] = ldx4<HIN>(xin, xo + (lane + 64 * i) * 4);
        }
#pragma unroll
        for (int i = 0; i < 4; ++i) ss += v[i].x * v[i].x + v[i].y * v[i].y + v[i].z * v[i].z + v[i].w * v[i].w;
#pragma unroll
        for (int o = 32; o >= 1; o >>= 1) ss += __shfl_xor(ss, o);
        const float rstd = 1.0f / sqrtf(ss * (1.0f / 1024.0f) + 1e-6f);
        float acc[16], ya[16];
#pragma unroll
        for (int i = 0; i < 4; ++i) {
            const int k = (lane + 64 * i) * 4;
            const float4 gg = *(const float4*)(g + k);
            float y[4] = {v[i].x * rstd * gg.x, v[i].y * rstd * gg.y, v[i].z * rstd * gg.z, v[i].w * rstd * gg.w};
            if (MODE != 2) {
                const float4 s1 = *(const float4*)(sh + (size_t)b * 6144 + k), s2 = *(const float4*)(sc + (size_t)b * 6144 + k);
                y[0] = y[0] * (1.f + s2.x) + s1.x; y[1] = y[1] * (1.f + s2.y) + s1.y; y[2] = y[2] * (1.f + s2.z) + s1.z; y[3] = y[3] * (1.f + s2.w) + s1.w;
                if (MODE == 0) *(h4*)(p->hn + ((size_t)(k >> 5) * T_TOK + row) * 32 + (k & 31)) = pack4(y[0], y[1], y[2], y[3]);
                else *(h4*)(p->hn + (size_t)row * DM + k) = pack4(y[0], y[1], y[2], y[3]);
            } else {
                *(float4*)(p->out + (size_t)row * DM + k) = make_float4(y[0], y[1], y[2], y[3]);
            }
            ya[4 * i] = y[0]; ya[4 * i + 1] = y[1]; ya[4 * i + 2] = y[2]; ya[4 * i + 3] = y[3];
        }
        if (MODE == 1) {
#pragma unroll
            for (int e = 0; e < 16; ++e) acc[e] = 0.f;
            float4 wq[2][4];
            const float* wl = wt + lane * 4;
#pragma unroll
            for (int e = 0; e < 4; ++e) wq[0][e] = *(const float4*)(wl + e * 1024);
#pragma unroll
            for (int st = 0; st < 16; ++st) {
                const int i = st >> 2, eg = st & 3, cur = st & 1;
                if (st + 1 < 16) {
                    const int i2 = (st + 1) >> 2, eg2 = (st + 1) & 3;
#pragma unroll
                    for (int e = 0; e < 4; ++e) wq[cur ^ 1][e] = *(const float4*)(wl + (eg2 * 4 + e) * 1024 + i2 * 256);
                }
#pragma unroll
                for (int e = 0; e < 4; ++e) {
                    const float4 w4 = wq[cur][e];
                    acc[eg * 4 + e] = fmaf(ya[4 * i], w4.x, fmaf(ya[4 * i + 1], w4.y, fmaf(ya[4 * i + 2], w4.z, fmaf(ya[4 * i + 3], w4.w, acc[eg * 4 + e]))));
                }
                __builtin_amdgcn_sched_barrier(0);
            }
        }
        if (MODE == 1) {
            const bool b5 = lane & 32, b4 = lane & 16, b3 = lane & 8, b2 = lane & 4;
            float r8[8], r4[4], r2[2];
#pragma unroll
            for (int e = 0; e < 8; ++e) { const float snd = b5 ? acc[e] : acc[e + 8], kp = b5 ? acc[e + 8] : acc[e]; r8[e] = kp + __shfl_xor(snd, 32); }
#pragma unroll
            for (int e = 0; e < 4; ++e) { const float snd = b4 ? r8[e] : r8[e + 4], kp = b4 ? r8[e + 4] : r8[e]; r4[e] = kp + __shfl_xor(snd, 16); }
#pragma unroll
            for (int e = 0; e < 2; ++e) { const float snd = b3 ? r4[e] : r4[e + 2], kp = b3 ? r4[e + 2] : r4[e]; r2[e] = kp + __shfl_xor(snd, 8); }
            float rv; { const float snd = b2 ? r2[0] : r2[1], kp = b2 ? r2[1] : r2[0]; rv = kp + __shfl_xor(snd, 4); }
            rv += __shfl_xor(rv, 2); rv += __shfl_xor(rv, 1);
            if ((lane & 3) == 0) lgb[(wave * 16 + it) * 16 + (lane >> 2)] = rv;
            if (lane == it) myrow = row;
            ++it;
            if (it == 16) { route_flush(p, lds, lane, wave, it, myrow, layer); it = 0; }
        }
    }
    if (MODE == 1 && it > 0) route_flush(p, lds, lane, wave, it, myrow, layer);
}

typedef float f2_t __attribute__((ext_vector_type(2)));
#define NRR 2
__device__ __forceinline__ void phase_norm_router(KP p, char* lds, const half_t* xin, const float* g, const float* sh, const float* sc, int layer) {
    const int lane = TID() & 63, wave = TID() >> 6;
    float* wt = (float*)lds;
    __syncthreads();
    for (int i = TID(); i < 4096; i += 256) {
        const float4 w4 = ((const float4*)p->w_router)[i];
        const int k = i >> 2, e0 = (i & 3) * 4;
        wt[(e0 + 0) * 1024 + k] = w4.x; wt[(e0 + 1) * 1024 + k] = w4.y; wt[(e0 + 2) * 1024 + k] = w4.z; wt[(e0 + 3) * 1024 + k] = w4.w;
    }
    __syncthreads();
    float* lgb = (float*)(lds + LDS_CTL + 512);
    int myrow = 0, it = 0;
    const int rstride = gridDim.x * 4;
    for (int row0 = BID() * 4 + wave; row0 < T_TOK; row0 += rstride * NRR) {
        f2_t ya[NRR / 2][16];
        float ss[NRR];
        int nv = 0;
#pragma unroll
        for (int j = 0; j < NRR; ++j) nv += (row0 + j * rstride < T_TOK) ? 1 : 0;
        {
            float4 v[NRR][4];
#pragma unroll
            for (int j = 0; j < NRR; ++j) {
                const int r = row0 + j * rstride;
                const size_t xo = (size_t)(r < T_TOK ? r : row0) * DM;
#pragma unroll
                for (int i = 0; i < 4; ++i) v[j][i] = ldx4<true>(xin, xo + (lane + 64 * i) * 4);
            }
#pragma unroll
            for (int j = 0; j < NRR; ++j) {
                ss[j] = 0.f;
#pragma unroll
                for (int i = 0; i < 4; ++i) ss[j] += v[j][i].x * v[j][i].x + v[j][i].y * v[j][i].y + v[j][i].z * v[j][i].z + v[j][i].w * v[j][i].w;
            }
#pragma unroll
            for (int o = 32; o >= 1; o >>= 1) {
#pragma unroll
                for (int j = 0; j < NRR; ++j) ss[j] += __shfl_xor(ss[j], o);
            }
#pragma unroll
            for (int j = 0; j < NRR; ++j) ss[j] = 1.0f / sqrtf(ss[j] * (1.0f / 1024.0f) + 1e-6f);
#pragma unroll
            for (int j = 0; j < NRR; ++j) {
                const int r = row0 + j * rstride;
                const int rr = r < T_TOK ? r : row0;
                const int b = rr >> 11;
                const float rs = ss[j];
#pragma unroll
                for (int i = 0; i < 4; ++i) {
                    const int k = (lane + 64 * i) * 4;
                    const float4 gg = *(const float4*)(g + k);
                    const float4 s1 = *(const float4*)(sh + (size_t)b * 6144 + k), s2 = *(const float4*)(sc + (size_t)b * 6144 + k);
                    const float y0 = v[j][i].x * rs * gg.x * (1.f + s2.x) + s1.x, y1 = v[j][i].y * rs * gg.y * (1.f + s2.y) + s1.y;
                    const float y2 = v[j][i].z * rs * gg.z * (1.f + s2.z) + s1.z, y3 = v[j][i].w * rs * gg.w * (1.f + s2.w) + s1.w;
                    if (r < T_TOK) *(h4*)(p->hn + (size_t)r * DM + k) = pack4(y0, y1, y2, y3);
                    if (j & 1) { ya[j >> 1][4 * i].y = y0; ya[j >> 1][4 * i + 1].y = y1; ya[j >> 1][4 * i + 2].y = y2; ya[j >> 1][4 * i + 3].y = y3; }
                    else       { ya[j >> 1][4 * i].x = y0; ya[j >> 1][4 * i + 1].x = y1; ya[j >> 1][4 * i + 2].x = y2; ya[j >> 1][4 * i + 3].x = y3; }
                }
                __builtin_amdgcn_sched_barrier(0);
            }
        }
        f2_t acc[NRR / 2][16];
#pragma unroll
        for (int e = 0; e < 16; ++e) {
#pragma unroll
            for (int jp = 0; jp < NRR / 2; ++jp) acc[jp][e] = (f2_t){0.f, 0.f};
        }
        {
            float4 wq[2][4];
            const float* wl = wt + lane * 4;
#pragma unroll
            for (int e = 0; e < 4; ++e) wq[0][e] = *(const float4*)(wl + e * 1024);
#pragma unroll
            for (int st = 0; st < 16; ++st) {
                const int i = st >> 2, eg = st & 3, cur = st & 1;
                if (st + 1 < 16) {
                    const int i2 = (st + 1) >> 2, eg2 = (st + 1) & 3;
#pragma unroll
                    for (int e = 0; e < 4; ++e) wq[cur ^ 1][e] = *(const float4*)(wl + (eg2 * 4 + e) * 1024 + i2 * 256);
                }
#pragma unroll
                for (int e = 0; e < 4; ++e) {
                    const float4 w4 = wq[cur][e];
#pragma unroll
                    for (int jp = 0; jp < NRR / 2; ++jp) {
                        f2_t a = acc[jp][eg * 4 + e];
                        a = ya[jp][4 * i + 3] * (f2_t){w4.w, w4.w} + a;
                        a = ya[jp][4 * i + 2] * (f2_t){w4.z, w4.z} + a;
                        a = ya[jp][4 * i + 1] * (f2_t){w4.y, w4.y} + a;
                        a = ya[jp][4 * i] * (f2_t){w4.x, w4.x} + a;
                        acc[jp][eg * 4 + e] = a;
                    }
                }
                __builtin_amdgcn_sched_barrier(0);
            }
        }
        const bool b5 = lane & 32, b4 = lane & 16, b3 = lane & 8, b2 = lane & 4;
#pragma unroll
        for (int j = 0; j < NRR; ++j) {
            float r8[8], r4[4], r2[2];
#pragma unroll
            for (int e = 0; e < 8; ++e) {
                const float lo = (j & 1) ? acc[j >> 1][e].y : acc[j >> 1][e].x, hi = (j & 1) ? acc[j >> 1][e + 8].y : acc[j >> 1][e + 8].x;
                const float snd = b5 ? lo : hi, kp = b5 ? hi : lo; r8[e] = kp + __shfl_xor(snd, 32);
            }
#pragma unroll
            for (int e = 0; e < 4; ++e) { const float snd = b4 ? r8[e] : r8[e + 4], kp = b4 ? r8[e + 4] : r8[e]; r4[e] = kp + __shfl_xor(snd, 16); }
#pragma unroll
            for (int e = 0; e < 2; ++e) { const float snd = b3 ? r4[e] : r4[e + 2], kp = b3 ? r4[e + 2] : r4[e]; r2[e] = kp + __shfl_xor(snd, 8); }
            float rv; { const float snd = b2 ? r2[0] : r2[1], kp = b2 ? r2[1] : r2[0]; rv = kp + __shfl_xor(snd, 4); }
            rv += __shfl_xor(rv, 2); rv += __shfl_xor(rv, 1);
            if (j < nv) {
                if ((lane & 3) == 0) lgb[(wave * 16 + it) * 16 + (lane >> 2)] = rv;
                if (lane == it) myrow = row0 + j * rstride;
                ++it;
            }
        }
        if (it == 16) { route_flush(p, lds, lane, wave, it, myrow, layer); it = 0; }
    }
    if (it > 0) route_flush(p, lds, lane, wave, it, myrow, layer);
}

template <class WF, class XF, class EPI>
__device__ __forceinline__ void gemm_tile(char* lds, int nkt, WF wf, XF xf, EPI epi) {
    const int tid = TID(), lane = tid & 63, wave = tid >> 6;
    const int wn = wave & 1, wm = wave >> 1, hh = lane >> 5;
    const int lrow = tid >> 3;
    const int lchunk = (tid & 7) ^ ((tid >> 4) & 7);
    const half_t* xs[4];
#pragma unroll
    for (int i = 0; i < 4; ++i) xs[i] = xf(lrow + 32 * i) + lchunk * 8;
    char* ldst = lds + lrow * 128 + (tid & 7) * 16;
    f16v acc[2][2];
#pragma unroll
    for (int i = 0; i < 2; ++i)
#pragma unroll
        for (int j = 0; j < 2; ++j)
#pragma unroll
            for (int r = 0; r < 16; ++r) acc[i][j][r] = 0.f;
    auto issue = [&](int kt, int s) {
        char* d = ldst + s * 32768;
#pragma unroll
        for (int i = 0; i < 4; ++i) glds16(wf(kt, lrow + 32 * i) + lchunk * 8, d + i * 4096);
#pragma unroll
        for (int i = 0; i < 4; ++i) glds16(xs[i] + kt * 64, d + 16384 + i * 4096);
    };
    __syncthreads();
    issue(0, 0);
    const int rsw = (lane >> 1) & 7;
    const int roff_w = (wn * 64 + (lane & 31)) * 128, roff_x = 16384 + (wm * 64 + (lane & 31)) * 128;
    for (int kt = 0; kt < nkt; ++kt) {
        asm volatile("s_waitcnt vmcnt(0)" ::: "memory");
        __syncthreads();
        if (kt + 1 < nkt) issue(kt + 1, (kt + 1) & 1);
        const char* base = lds + (kt & 1) * 32768;
#pragma unroll
        for (int ks = 0; ks < 4; ++ks) {
            const int co = ((2 * ks + hh) ^ rsw) << 4;
            const h8 a0 = *(const h8*)(base + roff_w + co), a1 = *(const h8*)(base + roff_w + 4096 + co);
            const h8 b0 = *(const h8*)(base + roff_x + co), b1 = *(const h8*)(base + roff_x + 4096 + co);
            acc[0][0] = __builtin_amdgcn_mfma_f32_32x32x16_f16(a0, b0, acc[0][0], 0, 0, 0);
            acc[0][1] = __builtin_amdgcn_mfma_f32_32x32x16_f16(a0, b1, acc[0][1], 0, 0, 0);
            acc[1][0] = __builtin_amdgcn_mfma_f32_32x32x16_f16(a1, b0, acc[1][0], 0, 0, 0);
            acc[1][1] = __builtin_amdgcn_mfma_f32_32x32x16_f16(a1, b1, acc[1][1], 0, 0, 0);
        }
    }
    epi(acc, wn, wm, lane);
}

template <class WF, class XF, class EPI>
__device__ __forceinline__ void gemm_tile2(char* lds, int nkt, size_t xkstride, WF wf, XF xf, EPI epi) {
    const int tid = TID(), lane = tid & 63, wave = tid >> 6;
    const int wn = wave & 1, wm = wave >> 1, hh = lane >> 5;
    const int lrow = tid >> 2;
    const int lchunk = (tid & 3) ^ ((tid >> 4) & 3);
    const half_t* xs[2];
#pragma unroll
    for (int i = 0; i < 2; ++i) xs[i] = xf(lrow + 64 * i) + lchunk * 8;
    char* ldst = lds + lrow * 64 + (tid & 3) * 16;
    f16v acc[4][2];
#pragma unroll
    for (int i = 0; i < 4; ++i)
#pragma unroll
        for (int j = 0; j < 2; ++j)
#pragma unroll
            for (int r = 0; r < 16; ++r) acc[i][j][r] = 0.f;
    auto issue = [&](int kt, int s) {
        char* d = ldst + s * 24576;
#pragma unroll
        for (int i = 0; i < 4; ++i) glds16(wf(kt, lrow + 64 * i) + lchunk * 8, d + i * 4096);
#pragma unroll
        for (int i = 0; i < 2; ++i) glds16(xs[i] + (size_t)kt * xkstride, d + 16384 + i * 4096);
    };
    __syncthreads();
    issue(0, 0); issue(1, 1);
    const int rsw = (lane >> 2) & 3;
    const int roff_w = (wn * 128 + (lane & 31)) * 64, roff_x = 16384 + (wm * 64 + (lane & 31)) * 64;
    int st = 0;
    for (int kt = 0; kt < nkt; ++kt) {
        if (kt + 1 < nkt) asm volatile("s_waitcnt vmcnt(6)" ::: "memory");
        else asm volatile("s_waitcnt vmcnt(0)" ::: "memory");
        asm volatile("s_waitcnt lgkmcnt(0)" ::: "memory");
        __builtin_amdgcn_s_barrier();
        if (kt + 2 < nkt) issue(kt + 2, st >= 1 ? st - 1 : 2);
        const char* base = lds + st * 24576;
        st = st == 2 ? 0 : st + 1;
#pragma unroll
        for (int ks = 0; ks < 2; ++ks) {
            const int co = ((2 * ks + hh) ^ rsw) << 4;
            h8 a[4], b[2];
#pragma unroll
            for (int i = 0; i < 4; ++i) a[i] = *(const h8*)(base + roff_w + i * 2048 + co);
#pragma unroll
            for (int j = 0; j < 2; ++j) b[j] = *(const h8*)(base + roff_x + j * 2048 + co);
#pragma unroll
            for (int i = 0; i < 4; ++i)
#pragma unroll
                for (int j = 0; j < 2; ++j) acc[i][j] = __builtin_amdgcn_mfma_f32_32x32x16_f16(a[i], b[j], acc[i][j], 0, 0, 0);
        }
    }
    epi(acc, wn, wm, lane);
}

__device__ __forceinline__ void phase_inproj(KP p, char* lds, int l) {
    const half_t* W = p->Wt_in + (size_t)l * NP * DM;
    const float* rc16 = p->rope; const float* rs16 = p->rope + 16384; const float* rc8 = p->rope + 32768; const float* rs8 = p->rope + 32768 + 8192;
    for (int u = BID(); u < 256 * 10; u += gridDim.x) {
        const int xl = u & 7, Lx = u >> 3, mi = Lx & 15, rr_ = Lx >> 4;
        const int nt = rr_ % 10, mt = 32 * xl + 16 * (rr_ / 10) + mi;
        gemm_tile2(lds, 32, (size_t)T_TOK * 32,
            [&](int kt, int row) { int n = nt * 256 + row; n = n < NP ? n : NP - 1; return W + ((size_t)kt * NP + n) * 32; },
            [&](int row) { return p->hn + (size_t)(mt * 128 + row) * 32; },
            [&](f16v (&acc)[4][2], int wn, int wm, int lane) {
                const int hh = lane >> 5;
                half_t* stg = (half_t*)lds;
                __syncthreads();
#pragma unroll
                for (int i = 0; i < 4; ++i) {
                    const int nb = nt * 256 + wn * 128 + i * 32;
                    if (nb == 1216 || nb == 1248 || nb >= NP) continue;
                    if (nt < 2) {
                        if (i & 1) continue;
#pragma unroll
                        for (int j = 0; j < 2; ++j) {
                            half_t* dst = stg + (wm * 64 + j * 32 + (lane & 31)) * 260 + wn * 64 + (i >> 1) * 32 + 4 * hh;
#pragma unroll
                            for (int g = 0; g < 4; ++g) {
                                float a4[4];
#pragma unroll
                                for (int r = 0; r < 4; ++r) a4[r] = acc[i][j][4 * g + r] * sigmoidf_(acc[i + 1][j][4 * g + r]);
                                *(h4*)(dst + 8 * g) = pack4(a4[0], a4[1], a4[2], a4[3]);
                            }
                        }
                        continue;
                    }
                    const bool rope64 = ((nb >= PC_DQ && nb < PC_DV) || (nb >= PC_MQ && nb < PC_MV)) && ((nb & 63) == 0);
                    const bool rope32 = (nb >= PC_IQ && nb < PC_IW);
#pragma unroll
                    for (int j = 0; j < 2; ++j) {
                        const int tok = mt * 128 + wm * 64 + j * 32 + (lane & 31);
                        const int t = tok & 2047;
                        f16v v = acc[i][j];
                        if (nb == PC_IW) { if (hh == 0) *(float4*)(p->iwf + (size_t)tok * 4) = make_float4(v[0], v[1], v[2], v[3]); continue; }
                        if (rope64) {
                            const float4 c4 = *(const float4*)(rc16 + t * 8 + 4 * hh), s4 = *(const float4*)(rs16 + t * 8 + 4 * hh);
                            const float cc[4] = {c4.x, c4.y, c4.z, c4.w}, sn[4] = {s4.x, s4.y, s4.z, s4.w};
#pragma unroll
                            for (int r = 0; r < 4; ++r) { const float x1 = v[r], x2 = v[r + 4]; v[r] = x1 * cc[r] - x2 * sn[r]; v[r + 4] = x2 * cc[r] + x1 * sn[r]; }
                        } else if (rope32) {
                            const float4 c4 = *(const float4*)(rc8 + t * 4), s4 = *(const float4*)(rs8 + t * 4);
                            const float cc[4] = {c4.x, c4.y, c4.z, c4.w}, sn[4] = {s4.x, s4.y, s4.z, s4.w};
#pragma unroll
                            for (int r = 0; r < 4; ++r) { const float o = __shfl_xor(v[r], 32); v[r] = hh ? (v[r] * cc[r] + o * sn[r]) : (v[r] * cc[r] - o * sn[r]); }
                        }
                        if ((nb >= PC_DQ && nb < PC_DK) || (nb >= PC_MQ && nb < PC_MK)) {
#pragma unroll
                            for (int r = 0; r < 16; ++r) v[r] *= 0.18033688011112042f;
                        }
                        half_t* dst = stg + (wm * 64 + j * 32 + (lane & 31)) * 260 + wn * 128 + i * 32 + 4 * hh;
#pragma unroll
                        for (int g = 0; g < 4; ++g) *(h4*)(dst + 8 * g) = pack4(v[4 * g], v[4 * g + 1], v[4 * g + 2], v[4 * g + 3]);
                    }
                }
                __syncthreads();
                const int wv_ = TID() >> 6;
#pragma unroll 4
                for (int it = 0; it < 32; ++it) {
                    const int row = it * 4 + wv_;
                    const uint2 v2 = *(const uint2*)(stg + row * 260 + lane * 4);
                    if (nt < 2) { if (lane < 32) *(uint2*)(p->P + (size_t)(mt * 128 + row) * NP + nt * 128 + lane * 4) = v2; }
                    else { const int n = nt * 256 + lane * 4; if (n < NP) *(uint2*)(p->P + (size_t)(mt * 128 + row) * NP + n) = v2; }
                }
            });
    }
}

__device__ __forceinline__ void stage_acc_f32(char* lds, const f16v (&acc)[2][2], int wn, int wm, int lane) {
    float* stg = (float*)lds;
    const int hh = lane >> 5;
    __syncthreads();
#pragma unroll
    for (int j = 0; j < 2; ++j)
#pragma unroll
        for (int i = 0; i < 2; ++i)
#pragma unroll
            for (int g = 0; g < 4; ++g)
                *(float4*)(stg + (wm * 64 + j * 32 + (lane & 31)) * 132 + wn * 64 + i * 32 + 4 * hh + 8 * g) = make_float4(acc[i][j][4 * g], acc[i][j][4 * g + 1], acc[i][j][4 * g + 2], acc[i][j][4 * g + 3]);
    __syncthreads();
}
template <bool HIN>
__device__ __forceinline__ void phase_outproj(KP p, char* lds, int l, const void* xin) {
    const half_t* W = p->Wt_o + (size_t)l * DM * DM;
    const float* g1 = p->modf + (size_t)l * 16 * 6144 + 2 * 1024;
    for (int u = BID(); u < 256 * 4; u += gridDim.x) {
        const int xl = u & 7, Lx = u >> 3, mi = Lx & 7, rr_ = Lx >> 3;
        const int nt = rr_ & 3, mt = 32 * xl + 8 * (rr_ >> 2) + mi;
        gemm_tile2(lds, 32, (size_t)T_TOK * 32,
            [&](int kt, int row) { return W + ((size_t)kt * DM + nt * 256 + row) * 32; },
            [&](int row) { return p->ycat + (size_t)(mt * 128 + row) * 32; },
            [&](f16v (&acc)[4][2], int wn, int wm, int lane) {
                const int hh = lane >> 5, tid = TID();
                float* stg = (float*)lds;
#pragma unroll
                for (int rnd = 0; rnd < 2; ++rnd) {
                    __syncthreads();
                    if (wm == rnd) {
#pragma unroll
                        for (int j = 0; j < 2; ++j)
#pragma unroll
                            for (int i = 0; i < 4; ++i)
#pragma unroll
                                for (int g = 0; g < 4; ++g)
                                    *(float4*)(stg + (j * 32 + (lane & 31)) * 260 + wn * 128 + i * 32 + 4 * hh + 8 * g) = make_float4(acc[i][j][4 * g], acc[i][j][4 * g + 1], acc[i][j][4 * g + 2], acc[i][j][4 * g + 3]);
                    }
                    __syncthreads();
#pragma unroll 8
                    for (int it = 0; it < 16; ++it) {
                        const int idx = it * 256 + tid, row = idx >> 6, c = idx & 63;
                        const int tok = mt * 128 + rnd * 64 + row, n = nt * 256 + 4 * c;
                        const float4 a4 = *(const float4*)(stg + row * 260 + 4 * c);
                        const float4 xi = ldx4<HIN>(xin, (size_t)tok * DM + n);
                        const float4 gg = *(const float4*)(g1 + (size_t)(tok >> 11) * 6144 + n);
                        *(h4*)(p->xr + (size_t)tok * DM + n) = pack4(xi.x + gg.x * a4.x, xi.y + gg.y * a4.y, xi.z + gg.z * a4.z, xi.w + gg.w * a4.w);
                    }
                }
            });
    }
}

struct MoeTab { int tb, nt, nc; };
__device__ __forceinline__ MoeTab moe_table(const int* cnt) {
    const int c = TID() & 31;
    MoeTab t;
    t.nc = (c < NCLS) ? cnt[c * 64] : 0;
    t.nt = (t.nc + 127) >> 7;
    int incl = t.nt;
#pragma unroll
    for (int o = 1; o < 32; o <<= 1) { const int v = __shfl_up(incl, o, 32); if (c >= o) incl += v; }
    t.tb = incl - t.nt;
    return t;
}
__device__ __forceinline__ bool moe_tile(const MoeTab& t, int tile, int& cls, int& pos0, int& n) {
    const unsigned long long m = __ballot(tile >= t.tb && tile < t.tb + t.nt);
    if (m == 0ull) return false;
    cls = __ffsll((long long)m) - 1;
    pos0 = (tile - __builtin_amdgcn_readlane(t.tb, cls)) * 128;
    n = __builtin_amdgcn_readlane(t.nc, cls);
    return true;
}
__device__ __forceinline__ void cls_experts(int cls, int& e1, int& e2) {
    const int g = cls / 6, pi = cls % 6;
    const int a = pi < 3 ? 0 : (pi < 5 ? 1 : 2);
    const int b = pi < 3 ? pi + 1 : (pi < 5 ? pi - 1 : 3);
    e1 = g * 4 + a; e2 = g * 4 + b;
}
__device__ __forceinline__ void phase_moe_up(KP p, char* lds, int l) {
    const MoeTab tab = moe_table(p->cnt + l * 32 * 64);
    for (int u = BID(); u < (256 + NCLS) * 8; u += gridDim.x) {
        const int xl = u & 7, Lx = u >> 3;
        const int nt = Lx & 7, tile = (Lx >> 3) * 8 + xl;
        int cls, pos0, nc;
        if (!moe_tile(tab, tile, cls, pos0, nc)) continue;
        int e1, e2; cls_experts(cls, e1, e2);
        const int slot = nt >> 2;
        const half_t* W = p->Wt_gu + ((size_t)(l * 16 + (slot ? e2 : e1)) * 512 + (nt & 3) * 128) * 1024;
        const int* lst = p->lists + (size_t)cls * T_TOK + pos0;
        const int nvalid = nc - pos0;
        int tokE[2]; float wgtE[2];
        {
            const int lane_ = TID() & 63, wm_ = TID() >> 7;
#pragma unroll
            for (int j = 0; j < 2; ++j) {
                const int row = wm_ * 64 + j * 32 + (lane_ & 31);
                tokE[j] = lst[row < nvalid ? row : 0];
                wgtE[j] = p->tokw[(size_t)tokE[j] * 2 + slot];
            }
        }
        gemm_tile(lds, 16,
            [&](int kt, int row) { return W + (size_t)row * 1024 + kt * 64; },
            [&](int row) { const int tok = lst[row < nvalid ? row : 0]; return p->hn + (size_t)tok * DM; },
            [&](f16v (&acc)[2][2], int wn, int wm, int lane) {
                const int hh = lane >> 5;
#pragma unroll
                for (int j = 0; j < 2; ++j) {
                    const int row = wm * 64 + j * 32 + (lane & 31);
                    if (row < nvalid) {
                        const int tok = tokE[j];
                        const float wgt = wgtE[j];
                        half_t* dst = p->act + (size_t)tok * 512 + slot * 256 + ((nt & 3) * 2 + wn) * 32 + 4 * hh;
#pragma unroll
                        for (int g = 0; g < 4; ++g) {
                            float a[4];
#pragma unroll
                            for (int r = 0; r < 4; ++r) { const float gv = acc[0][j][4 * g + r], uv = acc[1][j][4 * g + r]; a[r] = gv * sigmoidf_(gv) * uv * wgt; }
                            *(h4*)(dst + 8 * g) = pack4(a[0], a[1], a[2], a[3]);
                        }
                    }
                }
            });
    }
}
__device__ __forceinline__ void phase_moe_down(KP p, char* lds, int l, float gsc) {
    const MoeTab tab = moe_table(p->cnt + l * 32 * 64);
    const float* g2 = p->modf + (size_t)l * 16 * 6144 + 5 * 1024;
    for (int u = BID(); u < (256 + NCLS) * 8; u += gridDim.x) {
        const int xl = u & 7, Lx = u >> 3;
        const int nt = Lx & 7, tile = (Lx >> 3) * 8 + xl;
        int cls, pos0, nc;
        if (!moe_tile(tab, tile, cls, pos0, nc)) continue;
        int e1, e2; cls_experts(cls, e1, e2);
        const half_t* W1 = p->Wt_d + ((size_t)(l * 16 + e1) * 1024 + nt * 128) * 256;
        const half_t* W2 = p->Wt_d + ((size_t)(l * 16 + e2) * 1024 + nt * 128) * 256;
        const int* lst = p->lists + (size_t)cls * T_TOK + pos0;
        const int nvalid = nc - pos0;
        int tokS[8];
        {
            const int r0 = TID() >> 4;
#pragma unroll
            for (int it = 0; it < 8; ++it) { const int row = it * 16 + r0; tokS[it] = lst[row < nvalid ? row : 0]; }
        }
        gemm_tile(lds, 8,
            [&](int kt, int row) { return (kt < 4 ? W1 : W2) + (size_t)row * 256 + (kt & 3) * 64; },
            [&](int row) { const int tok = lst[row < nvalid ? row : 0]; return p->act + (size_t)tok * 512; },
            [&](f16v (&acc)[2][2], int wn, int wm, int lane) {
                const int hh = lane >> 5, tid = TID();
                float* stg = (float*)lds;
                __syncthreads();
#pragma unroll
                for (int j = 0; j < 2; ++j)
#pragma unroll
                    for (int i = 0; i < 2; ++i)
#pragma unroll
                        for (int g = 0; g < 4; ++g)
                            *(float4*)(stg + (wm * 64 + j * 32 + (lane & 31)) * 132 + wn * 64 + i * 32 + 8 * g + 4 * hh) =
                                make_float4(acc[i][j][4 * g], acc[i][j][4 * g + 1], acc[i][j][4 * g + 2], acc[i][j][4 * g + 3]);
                __syncthreads();
                const int r0 = tid >> 4, c8 = (tid & 15) * 8;
                const int n = nt * 128 + c8;
                h8 xi[8]; float4 g0[8], g1[8];
#pragma unroll
                for (int it = 0; it < 8; ++it) {
                    const int tok = tokS[it];
                    const float* gp = g2 + (size_t)(tok >> 11) * 6144 + n;
                    xi[it] = *(const h8*)(p->xr + (size_t)tok * DM + n);
                    g0[it] = *(const float4*)gp; g1[it] = *(const float4*)(gp + 4);
                }
#pragma unroll
                for (int it = 0; it < 8; ++it) {
                    const int row = it * 16 + r0;
                    const float4 a0 = *(const float4*)(stg + row * 132 + c8), a1 = *(const float4*)(stg + row * 132 + c8 + 4);
                    h8 o;
                    o[0] = (half_t)((float)xi[it][0] + gsc * g0[it].x * a0.x); o[1] = (half_t)((float)xi[it][1] + gsc * g0[it].y * a0.y);
                    o[2] = (half_t)((float)xi[it][2] + gsc * g0[it].z * a0.z); o[3] = (half_t)((float)xi[it][3] + gsc * g0[it].w * a0.w);
                    o[4] = (half_t)((float)xi[it][4] + gsc * g1[it].x * a1.x); o[5] = (half_t)((float)xi[it][5] + gsc * g1[it].y * a1.y);
                    o[6] = (half_t)((float)xi[it][6] + gsc * g1[it].z * a1.z); o[7] = (half_t)((float)xi[it][7] + gsc * g1[it].w * a1.w);
                    if (row < nvalid) *(h8*)(p->xr + (size_t)tokS[it] * DM + n) = o;
                }
            });
    }
}

__device__ __forceinline__ void dsa_select_unit(KP p, char* lds, int b, int qt) {
    unsigned* hist = (unsigned*)lds;
    unsigned* maskl = hist + 16 * 257 + 16;
    unsigned* stP = maskl + 1024;
    unsigned* stNeed = stP + 16;
    unsigned* stDone = stNeed + 16;
    unsigned* flag = stDone + 16;
    unsigned* dummyb = flag + 16;
    const int tid = TID(), lane = tid & 63, wave = tid >> 6;
    const int q0 = qt * 16, tokbase = b * SEQ;
    __syncthreads();
    if (q0 < 256) {
        for (int i = tid; i < 1024; i += 256) {
            const int q = i >> 6, wd = i & 63;
            const int n = q0 + q + 1 - 32 * wd;
            const unsigned w = n >= 32 ? 0xFFFFFFFFu : (n <= 0 ? 0u : ((1u << n) - 1u));
            p->dmask[(size_t)(tokbase + q0 + q) * 64 + wd] = w;
        }
        return;
    }
    for (int i = tid; i < 1024; i += 256) maskl[i] = 0u;
    if (tid < 16) { stP[tid] = 0u; stNeed[tid] = 256u; stDone[tid] = 0u; }
    for (int i = tid; i < 16 * 257; i += 256) hist[i] = 0u;
    __syncthreads();
    const int ql = lane & 15, fq = lane >> 4;
    const int tq = q0 + ql;
    const half_t* Pb = p->P + (size_t)tokbase * NP;
    h8 iqf[4];
#pragma unroll
    for (int hd = 0; hd < 4; ++hd) iqf[hd] = *(const h8*)(Pb + (size_t)tq * NP + PC_IQ + hd * 32 + 8 * fq);
    const float4 iw4 = *(const float4*)(p->iwf + (size_t)(tokbase + tq) * 4);
    const float wsc0 = iw4.x * 0.08838834764831845f, wsc1 = iw4.y * 0.08838834764831845f, wsc2 = iw4.z * 0.08838834764831845f, wsc3 = iw4.w * 0.08838834764831845f;
    const int ng = qt + 1;
    unsigned sc[32][4];
    const half_t* ikp = Pb + (size_t)ql * NP + PC_IK + 8 * fq;
#pragma unroll
    for (int gb = 0; gb < 4; ++gb) {
        h8 ik[8];
#pragma unroll
        for (int x = 0; x < 8; ++x) {
            int g = wave + 4 * (gb * 8 + x);
            g = g < ng ? g : ng - 1;
            ik[x] = *(const h8*)(ikp + (size_t)(16 * g) * NP);
        }
#pragma unroll
        for (int x = 0; x < 8; ++x) {
            const int gi = gb * 8 + x;
            const int g = wave + 4 * gi;
            const f4v z = {0.f, 0.f, 0.f, 0.f};
            const f4v c0 = __builtin_amdgcn_mfma_f32_16x16x32_f16(ik[x], iqf[0], z, 0, 0, 0);
            const f4v c1 = __builtin_amdgcn_mfma_f32_16x16x32_f16(ik[x], iqf[1], z, 0, 0, 0);
            const f4v c2 = __builtin_amdgcn_mfma_f32_16x16x32_f16(ik[x], iqf[2], z, 0, 0, 0);
            const f4v c3 = __builtin_amdgcn_mfma_f32_16x16x32_f16(ik[x], iqf[3], z, 0, 0, 0);
#pragma unroll
            for (int r = 0; r < 4; ++r) {
                const int j = 16 * g + 4 * fq + r;
                float sv = wsc0 * __builtin_amdgcn_fmed3f(c0[r], 0.f, INFINITY);
                sv = fmaf(wsc1, __builtin_amdgcn_fmed3f(c1[r], 0.f, INFINITY), sv);
                sv = fmaf(wsc2, __builtin_amdgcn_fmed3f(c2[r], 0.f, INFINITY), sv);
                sv = fmaf(wsc3, __builtin_amdgcn_fmed3f(c3[r], 0.f, INFINITY), sv);
                sv += 0.0f;
                const int sb = __float_as_int(sv);
                const unsigned su = (unsigned)sb ^ ((unsigned)(sb >> 31) | 0x80000000u);
                const unsigned ck = (su & 0xFFFFF800u) | (unsigned)(2047 - j);
                sc[gi][r] = (g < ng && j <= tq) ? ck : 0u;
            }
            if (g < ng) {
#pragma unroll
                for (int r = 0; r < 4; ++r) atomicAdd(hist + ql * 257 + (sc[gi][r] >> 24), 1u);
            }
        }
    }
    bool alldone = false;
    for (int pass = 0; pass < 5; ++pass) {
        const bool fin = alldone;
        if (!fin && pass > 0) { for (int i = tid; i < 16 * 257; i += 256) hist[i] = 0u; }
        if (tid == 0) *flag = 0u;
        __syncthreads();
        if (pass > 0) {
        const unsigned sP = stP[ql], sDone = stDone[ql];
        int wv = wave, fqv = fq;
        asm volatile("" : "+v"(wv), "+v"(fqv));
        if (fin) {
            const int sh = (int)(32u - 8u * (sDone ? sDone : 1u));
            unsigned* mrow = maskl + ql * 64;
#pragma unroll
            for (int gi = 0; gi < 32; ++gi) {
                const int g = wv + 4 * gi;
                unsigned nib = 0u;
#pragma unroll
                for (int r = 0; r < 4; ++r) {
                    const unsigned uu = sc[gi][r];
                    nib |= ((uu >> sh) >= sP) ? (1u << r) : 0u;
                }
                if (g < ng) atomicOr(&mrow[g >> 1], nib << ((g & 1) * 16 + 4 * fqv));
            }
        } else {
            const int shm = pass ? 32 - 8 * pass : 0, shd = 24 - 8 * pass;
            const unsigned orm = pass ? 0u : 0xFFFFFFFFu;
            const unsigned cmpv = pass ? (sDone == 0u ? sP : 0xFFFFFFFFu) : 0xFFFFFFFFu;
            unsigned* hrow = hist + ql * 257;
            unsigned* dummy = dummyb + lane;
#pragma unroll
            for (int gi = 0; gi < 32; ++gi) {
                const int g = wv + 4 * gi;
                if (g < ng) {
#pragma unroll
                    for (int r = 0; r < 4; ++r) {
                        const unsigned uu = sc[gi][r];
                        const bool match = (((uu >> shm) | orm) == cmpv);
                        const unsigned dig = (uu >> shd) & 255u;
                        unsigned* a = match ? hrow + dig : dummy;
                        atomicAdd(a, 1u);
                    }
                }
            }
        }
        }
        __syncthreads();
        if (fin) break;
        {
            const int qq = tid >> 4, seg = tid & 15;
            const bool active = (stDone[qq] == 0u);
            unsigned c16 = 0u;
            if (active) {
#pragma unroll
                for (int d = 0; d < 16; ++d) c16 += hist[qq * 257 + seg * 16 + d];
            }
            unsigned v = c16;
#pragma unroll
            for (int off = 1; off < 16; off <<= 1) { const unsigned t = __shfl_down(v, off, 16); if (seg + off < 16) v += t; }
            const unsigned suf = v - c16;
            const unsigned need = stNeed[qq];
            if (active && suf < need && need <= suf + c16) {
                unsigned run = suf, D = 0u, cD = 0u, nn = need;
                for (int d = 15; d >= 0; --d) {
                    const unsigned cc = hist[qq * 257 + seg * 16 + d];
                    if (run + cc >= need) { D = (unsigned)(seg * 16 + d); cD = cc; nn = need - run; break; }
                    run += cc;
                }
                const bool done = (cD == nn) || pass == 3;
                stP[qq] = (stP[qq] << 8) | D; stNeed[qq] = nn;
                if (done) stDone[qq] = (unsigned)(pass + 1); else atomicAdd(flag, 1u);
            }
        }
        __syncthreads();
        alldone = (*flag == 0u);
    }
    for (int i = tid; i < 1024; i += 256) p->dmask[(size_t)(tokbase + q0 + (i >> 6)) * 64 + (i & 63)] = maskl[i];
}

__device__ __forceinline__ void conv_unit(KP p, char* lds, int l, int b, int c) {
    float* red = (float*)lds;
    const int ch = TID(), lane = ch & 63, wave = ch >> 6;
    const int t0 = c * 32, tokbase = b * SEQ;
    half_t* tile = (half_t*)(lds + 4096);
    __syncthreads();
    {
        h8 vt[8];
#pragma unroll
        for (int it = 0; it < 8; ++it) {
            int i = it * 256 + ch; i = i < 62 * 32 ? i : 62 * 32 - 1;
            const int rr = i >> 5, c16 = i & 31;
            int tt = t0 - 30 + rr; tt = tt >= 0 ? tt : 0;
            vt[it] = *(const h8*)(p->P + (size_t)(tokbase + tt) * NP + c16 * 8);
        }
#pragma unroll
        for (int it = 0; it < 8; ++it) {
            const int i = it * 256 + ch;
            if (i < 62 * 32) {
                const int rr = i >> 5, c16 = i & 31;
                h8 v = vt[it];
                if (t0 - 30 + rr < 0) {
#pragma unroll
                    for (int j = 0; j < 8; ++j) v[j] = (half_t)0.f;
                }
                *(h8*)(tile + rr * 256 + c16 * 8) = v;
            }
        }
    }
    __syncthreads();
    float aw[62];
#pragma unroll
    for (int rr = 0; rr < 62; ++rr) aw[rr] = (float)tile[rr * 256 + ch];
    float w[31];
#pragma unroll
    for (int i = 0; i < 31; ++i) w[i] = p->w_dw[(l * 31 + i) * 256 + ch];
    const float bias = p->b_dw[l * 256 + ch];
    float y[32], s1[32], s2[32];
#pragma unroll
    for (int tk = 0; tk < 32; ++tk) {
        float sacc = bias;
#pragma unroll
        for (int i = 0; i < 31; ++i) sacc = fmaf(aw[tk + i], w[i], sacc);
        y[tk] = sacc; s1[tk] = sacc; s2[tk] = sacc * sacc;
    }
    {
        const bool b5 = lane & 32, b4 = lane & 16, b3 = lane & 8, b2 = lane & 4, b1 = lane & 2;
        float a16[16], c16[16], a8[8], c8[8], a4[4], c4[4], a2[2], c2[2];
#pragma unroll
        for (int e = 0; e < 16; ++e) { a16[e] = (b5 ? s1[e + 16] : s1[e]) + __shfl_xor(b5 ? s1[e] : s1[e + 16], 32); c16[e] = (b5 ? s2[e + 16] : s2[e]) + __shfl_xor(b5 ? s2[e] : s2[e + 16], 32); }
#pragma unroll
        for (int e = 0; e < 8; ++e) { a8[e] = (b4 ? a16[e + 8] : a16[e]) + __shfl_xor(b4 ? a16[e] : a16[e + 8], 16); c8[e] = (b4 ? c16[e + 8] : c16[e]) + __shfl_xor(b4 ? c16[e] : c16[e + 8], 16); }
#pragma unroll
        for (int e = 0; e < 4; ++e) { a4[e] = (b3 ? a8[e + 4] : a8[e]) + __shfl_xor(b3 ? a8[e] : a8[e + 4], 8); c4[e] = (b3 ? c8[e + 4] : c8[e]) + __shfl_xor(b3 ? c8[e] : c8[e + 4], 8); }
#pragma unroll
        for (int e = 0; e < 2; ++e) { a2[e] = (b2 ? a4[e + 2] : a4[e]) + __shfl_xor(b2 ? a4[e] : a4[e + 2], 4); c2[e] = (b2 ? c4[e + 2] : c4[e]) + __shfl_xor(b2 ? c4[e] : c4[e + 2], 4); }
        float av = (b1 ? a2[1] : a2[0]) + __shfl_xor(b1 ? a2[0] : a2[1], 2), cv = (b1 ? c2[1] : c2[0]) + __shfl_xor(b1 ? c2[0] : c2[1], 2);
        av += __shfl_xor(av, 1); cv += __shfl_xor(cv, 1);
        const int tokk = (b5 ? 16 : 0) + (b4 ? 8 : 0) + (b3 ? 4 : 0) + (b2 ? 2 : 0) + (b1 ? 1 : 0);
        __syncthreads();
        if ((lane & 1) == 0) { red[(tokk * 4 + wave) * 2] = av; red[(tokk * 4 + wave) * 2 + 1] = cv; }
        __syncthreads();
    }
    const float lg = p->ln_g[l * 256 + ch], lb = p->ln_b[l * 256 + ch];
#pragma unroll
    for (int tk = 0; tk < 32; ++tk) {
        const float4 ra = *(const float4*)(red + tk * 8), rb = *(const float4*)(red + tk * 8 + 4);
        const float t1 = (ra.x + ra.z) + (rb.x + rb.z);
        const float t2 = (ra.y + ra.w) + (rb.y + rb.w);
        const float mu = t1 * (1.0f / 256.0f);
        float var = t2 * (1.0f / 256.0f) - mu * mu; var = var < 0.f ? 0.f : var;
        float z = (y[tk] - mu) * (1.0f / sqrtf(var + 1e-6f)) * lg + lb;
        z = z * sigmoidf_(z);
        p->ycat[((size_t)(ch >> 5) * T_TOK + tokbase + t0 + tk) * 32 + (ch & 31)] = (half_t)z;
    }
}

__device__ __forceinline__ void kmean_unit(KP p, char* lds, int b, int h, int blk) {
    float* part = (float*)lds;
    const int tid = TID(), c = tid & 7, rg = tid >> 3;
    const half_t* r = p->P + (size_t)(b * SEQ + blk * 256 + rg * 8) * NP + PC_MK + h * 64 + c * 8;
    h8 v[8];
#pragma unroll
    for (int k = 0; k < 8; ++k) v[k] = *(const h8*)(r + (size_t)k * NP);
    float sacc[8];
#pragma unroll
    for (int j = 0; j < 8; ++j) {
        float t = 0.f;
#pragma unroll
        for (int k = 0; k < 8; ++k) t += (float)v[k][j];
        sacc[j] = t;
    }
    __syncthreads();
    *(float4*)(part + rg * 64 + c * 8) = make_float4(sacc[0], sacc[1], sacc[2], sacc[3]);
    *(float4*)(part + rg * 64 + c * 8 + 4) = make_float4(sacc[4], sacc[5], sacc[6], sacc[7]);
    __syncthreads();
    if (tid < 64) {
        float t = 0.f;
#pragma unroll
        for (int g = 0; g < 32; ++g) t += part[g * 64 + tid];
        p->kmean[(((size_t)b * 6 + h) * 8 + blk) * 64 + tid] = t * (1.0f / 256.0f);
    }
}

#ifndef POST_MASK
#define POST_MASK 7
#endif
__device__ __forceinline__ void phase_post(KP p, char* lds, int l, int tm) {
    const int NA = 2048, NB = 1024, NC = 768;
    const int G_ = gridDim.x;
    for (int u0 = BID(), k_ = 0; u0 < NA + NB + NC; u0 += G_, ++k_) {
        int u = u0;
        if (u0 < NA && (k_ & 1) && (k_ + 1) * G_ <= NA) u = k_ * G_ + (G_ - 1 - (u0 - k_ * G_));
        if (u < NA) { if (tm & 1) dsa_select_unit(p, lds, u % 16, 127 - (u / 16)); }
        else if (u < NA + NB) { const int v = u - NA; if (tm & 2) conv_unit(p, lds, l, v % 16, v / 16); }
        else { const int v = u - NA - NB; if (tm & 4) kmean_unit(p, lds, v / 48, (v / 8) % 6, v % 8); }
    }
}

template <int MODE>
__device__ __forceinline__ void attn_unit(KP p, char* lds, int b, int h, int qt) {
    const int tid = TID(), lane = tid & 63, wave = tid >> 6, hh = lane >> 5, ql = lane & 31;
    const int q0 = qt * 128, tokbase = b * SEQ;
    const int tq = q0 + wave * 32 + ql;
    const half_t* Pb = p->P + (size_t)tokbase * NP;
    const int QOFF = MODE ? PC_MQ + h * 64 : PC_DQ + h * 64;
    const int KOFF = MODE ? PC_MK + h * 64 : PC_DK;
    const int VOFF = MODE ? PC_MV + h * 64 : PC_DV;
    const int own = qt >> 1;
    unsigned mysel = 0u, anysel = 0u;
    __syncthreads();
    h8 qf[4];
#pragma unroll
    for (int ks = 0; ks < 4; ++ks) qf[ks] = *(const h8*)(Pb + (size_t)tq * NP + QOFF + 16 * ks + 8 * hh);
    if (MODE == 1) {
        float* km = (float*)(lds + 32768);
        unsigned* anyb = (unsigned*)(km + 512);
        for (int i = tid; i < 512; i += 256) km[i] = p->kmean[((size_t)b * 6 + h) * 512 + i];
        if (tid == 0) *anyb = 0u;
        __syncthreads();
        float gt[8];
#pragma unroll
        for (int j = 0; j < 8; ++j) {
            float sacc = 0.f;
            if (j < own) {
#pragma unroll
                for (int ks = 0; ks < 4; ++ks) {
                    const float4 k0 = *(const float4*)(km + j * 64 + 16 * ks + 8 * hh), k1 = *(const float4*)(km + j * 64 + 16 * ks + 8 * hh + 4);
                    sacc = fmaf((float)qf[ks][0], k0.x, sacc); sacc = fmaf((float)qf[ks][1], k0.y, sacc); sacc = fmaf((float)qf[ks][2], k0.z, sacc); sacc = fmaf((float)qf[ks][3], k0.w, sacc);
                    sacc = fmaf((float)qf[ks][4], k1.x, sacc); sacc = fmaf((float)qf[ks][5], k1.y, sacc); sacc = fmaf((float)qf[ks][6], k1.z, sacc); sacc = fmaf((float)qf[ks][7], k1.w, sacc);
                }
            }
            gt[j] = sacc + __shfl_xor(sacc, 32);
        }
        unsigned m = 0u;
        const int want = own < 3 ? own : 3;
#pragma unroll
        for (int r = 0; r < 3; ++r) {
            if (r < want) {
                int best = -1; float bv = -INFINITY;
#pragma unroll
                for (int j = 0; j < 8; ++j) { if (j < own && !((m >> j) & 1u) && (best < 0 || gt[j] > bv)) { best = j; bv = gt[j]; } }
                m |= 1u << best;
            }
        }
        mysel = m;
        unsigned wmk = m;
#pragma unroll
        for (int o = 16; o >= 1; o >>= 1) wmk |= (unsigned)__shfl_xor((int)wmk, o);
        if (lane == 0 && wmk) atomicOr(anyb, wmk);
        __syncthreads();
        anysel = *anyb;
    }
    f16v O0, O1;
#pragma unroll
    for (int r = 0; r < 16; ++r) { O0[r] = 0.f; O1[r] = 0.f; }
    float l_run = 0.f;
    bool unset = true;
    f16v negm;
#pragma unroll
    for (int r = 0; r < 16; ++r) negm[r] = 0.f;
    const float THR = 8.0f;
    const int ntile = 2 * qt + 2;
    auto skip = [&](int kt) -> bool { return MODE == 1 && kt < 4 * own && !((anysel >> (kt >> 2)) & 1u); };
    auto nexttile = [&](int kt) -> int { ++kt; while (kt < ntile && skip(kt)) ++kt; return kt; };
    const int lrow = tid >> 3;
    const int kchunk = (tid & 7) ^ ((tid >> 4) & 7);
    const int vchunk = (tid & 7) ^ (((tid >> 4) & 1) << 2);
    char* ldst = lds + lrow * 128 + (tid & 7) * 16;
    auto issue = [&](int kt, int s) {
        const half_t* src = Pb + (size_t)(kt * 64 + lrow) * NP;
        char* d = ldst + s * 16384;
        glds16(src + KOFF + kchunk * 8, d);
        glds16(src + (size_t)32 * NP + KOFF + kchunk * 8, d + 4096);
        glds16(src + VOFF + vchunk * 8, d + 8192);
        glds16(src + (size_t)32 * NP + VOFF + vchunk * 8, d + 8192 + 4096);
    };
    const int rsw = (lane >> 1) & 7;
    const int kro = ql * 128;
    const int li = lane & 15, qp = li >> 2, pp = li & 3, swv = (qp >> 1) & 1;
    const int vb0 = 8192 + (4 * hh + qp) * 128 + 32 * ((lane >> 4) & 1) + 8 * pp + 64 * (0 ^ swv);
    const int vb1 = 8192 + (4 * hh + qp) * 128 + 32 * ((lane >> 4) & 1) + 8 * pp + 64 * (1 ^ swv);
    int kt = -1; kt = nexttile(kt);
    int s = 0;
    if (kt < ntile) issue(kt, 0);
    while (kt < ntile) {
        const int ktn = nexttile(kt);
        asm volatile("s_waitcnt vmcnt(0)" ::: "memory");
        __syncthreads();
        if (ktn < ntile) issue(ktn, s ^ 1);
        const bool wave_active = (kt * 64 <= q0 + wave * 32 + 31);
        if (wave_active) {
            const char* base = lds + s * 16384;
            uint2 mw = make_uint2(0u, 0u);
            if (MODE == 0) mw = *(const uint2*)(p->dmask + (size_t)(tokbase + tq) * 64 + 2 * kt);
            h8 vf0[4], vf1[4];
#pragma unroll
            for (int kk = 0; kk < 4; ++kk) {
                const int roff = (32 * (kk >> 1) + 16 * (kk & 1)) * 128;
                const s4v lo0 = __builtin_amdgcn_ds_read_tr16_b64_v4i16((LAS s4v*)(base + vb0 + roff));
                const s4v hi0 = __builtin_amdgcn_ds_read_tr16_b64_v4i16((LAS s4v*)(base + vb0 + roff + 8 * 128));
                const s4v lo1 = __builtin_amdgcn_ds_read_tr16_b64_v4i16((LAS s4v*)(base + vb1 + roff));
                const s4v hi1 = __builtin_amdgcn_ds_read_tr16_b64_v4i16((LAS s4v*)(base + vb1 + roff + 8 * 128));
                vf0[kk] = __builtin_bit_cast(h8, __builtin_shufflevector(lo0, hi0, 0, 1, 2, 3, 4, 5, 6, 7));
                vf1[kk] = __builtin_bit_cast(h8, __builtin_shufflevector(lo1, hi1, 0, 1, 2, 3, 4, 5, 6, 7));
            }
            bool lane_on = true;
            if (MODE == 1 && kt < 4 * own) lane_on = (mysel >> (kt >> 2)) & 1u;
            f16v cin = negm;
            if (MODE == 1 && kt < 4 * own) {
#pragma unroll
                for (int r = 0; r < 16; ++r) cin[r] = lane_on ? negm[r] : -INFINITY;
            }
            f16v s0 = cin, s1 = cin;
#pragma unroll
            for (int ks = 0; ks < 4; ++ks) {
                const int co = ((2 * ks + hh) ^ rsw) << 4;
                const h8 k0 = *(const h8*)(base + kro + co), k1 = *(const h8*)(base + kro + 4096 + co);
                s0 = __builtin_amdgcn_mfma_f32_32x32x16_f16(k0, qf[ks], s0, 0, 0, 0);
                s1 = __builtin_amdgcn_mfma_f32_32x32x16_f16(k1, qf[ks], s1, 0, 0, 0);
            }
            if (MODE == 0) {
                const unsigned w0 = mw.x >> (4 * hh), w1 = mw.y >> (4 * hh);
#pragma unroll
                for (int r = 0; r < 16; ++r) {
                    const int pos = (r & 3) + 8 * (r >> 2);
                    const unsigned m0 = (unsigned)__builtin_amdgcn_sbfe((int)w0, pos, 1), m1 = (unsigned)__builtin_amdgcn_sbfe((int)w1, pos, 1);
                    s0[r] = __uint_as_float((__float_as_uint(s0[r]) & m0) | (0xFF800000u & ~m0));
                    s1[r] = __uint_as_float((__float_as_uint(s1[r]) & m1) | (0xFF800000u & ~m1));
                }
            } else if (kt >= 4 * own && kt * 64 + 63 > q0 + wave * 32) {
#pragma unroll
                for (int r = 0; r < 16; ++r) {
                    const int key = kt * 64 + (r & 3) + 8 * (r >> 2) + 4 * hh;
                    s0[r] = (key <= tq) ? s0[r] : -INFINITY;
                    s1[r] = (key + 32 <= tq) ? s1[r] : -INFINITY;
                }
            }
            float mx = s0[0];
#pragma unroll
            for (int r = 1; r < 16; ++r) mx = fmaxf(mx, s0[r]);
#pragma unroll
            for (int r = 0; r < 16; ++r) mx = fmaxf(mx, s1[r]);
            mx = fmaxf(mx, __shfl_xor(mx, 32));
            const bool need = unset ? (mx > -INFINITY) : (mx > THR);
            if (__any(need)) {
                const float delta = need ? mx : 0.f;
                const float alpha = (need && !unset) ? __builtin_amdgcn_exp2f(-delta) : 1.0f;
#pragma unroll
                for (int r = 0; r < 16; ++r) { s0[r] -= delta; s1[r] -= delta; negm[r] -= delta; O0[r] *= alpha; O1[r] *= alpha; }
                l_run *= alpha;
                unset = unset && !need;
            }
            float ls = 0.f;
#pragma unroll
            for (int r = 0; r < 16; ++r) { s0[r] = __builtin_amdgcn_exp2f(s0[r]); ls += s0[r]; }
#pragma unroll
            for (int r = 0; r < 16; ++r) { s1[r] = __builtin_amdgcn_exp2f(s1[r]); ls += s1[r]; }
            l_run += ls;
#pragma unroll
            for (int kk = 0; kk < 4; ++kk) {
                h8 pf;
#pragma unroll
                for (int j = 0; j < 8; ++j) pf[j] = (half_t)((kk >> 1) ? s1[8 * (kk & 1) + j] : s0[8 * (kk & 1) + j]);
                O0 = __builtin_amdgcn_mfma_f32_32x32x16_f16(vf0[kk], pf, O0, 0, 0, 0);
                O1 = __builtin_amdgcn_mfma_f32_32x32x16_f16(vf1[kk], pf, O1, 0, 0, 0);
            }
        }
        kt = ktn; s ^= 1;
    }
    const float lt = l_run + __shfl_xor(l_run, 32);
    const float inv = 1.0f / lt;
    const int ycol = (MODE ? 640 : 256) + h * 64;
    half_t* dst = p->ycat + ((size_t)(ycol >> 5) * T_TOK + tokbase + tq) * 32 + 4 * hh;
#pragma unroll
    for (int g = 0; g < 4; ++g) {
        *(h4*)(dst + 8 * g) = pack4(O0[4 * g] * inv, O0[4 * g + 1] * inv, O0[4 * g + 2] * inv, O0[4 * g + 3] * inv);
        *(h4*)(dst + (size_t)T_TOK * 32 + 8 * g) = pack4(O1[4 * g] * inv, O1[4 * g + 1] * inv, O1[4 * g + 2] * inv, O1[4 * g + 3] * inv);
    }
}

#ifndef ATT_MASK
#define ATT_MASK 3
#endif
__device__ __forceinline__ void phase_attn(KP p, char* lds, int tm) {
    const int G_ = gridDim.x, per_ = G_ >> 3;
    const bool snake_ = (G_ >= 8) && ((G_ & 7) == 0);
    for (int k_ = 0, b_ = BID(); snake_ ? (k_ * per_ < 384) : (b_ + k_ * G_ < 3072); ++k_) {
        int xl, Lx;
        if (snake_) { const int idx_ = b_ >> 3; xl = b_ & 7; Lx = k_ * per_ + ((k_ & 1) ? (per_ - 1 - idx_) : idx_); }
        else { const int u = b_ + k_ * G_; xl = u & 7; Lx = u >> 3; }
        if (Lx >= 384) continue;
        const int qt = 15 - (Lx / 24), rem = Lx % 24;
        const int type = rem & 1, bh = xl * 12 + (rem >> 1);
        if (type == 0) { if (tm & 1) attn_unit<0>(p, lds, bh / 6, bh % 6, qt); }
        else { if (tm & 2) attn_unit<1>(p, lds, bh / 6, bh % 6, qt); }
    }
}

__global__ void __launch_bounds__(256, 2) mk_fwd(Params p_unused) {
    extern __shared__ __attribute__((aligned(16))) char lds[];
    volatile LAS unsigned* stw = (volatile LAS unsigned*)(lds + LDS_CTL);
    if (threadIdx.x < 4) stw[threadIdx.x] = 0u;
    __syncthreads();
    KP p0 = (KP)__builtin_amdgcn_kernarg_segment_ptr();
    XcdBarrier bar; bar.bar = p0->bar; bar.x = 0; bar.st = stw;
#if !MK_SPLIT
    bar = xcd_barrier_post(p0->bar, stw);
#endif
    const int ph_lo = p0->ph_lo, ph_hi = p0->ph_hi;
    for (int ph = ph_lo; ph < ph_hi; ++ph) {
      KP p = p0; asm volatile("" : "+s"(p));
      const int nrep = (DUP_SUB >= 0 && ((DUP_SUB == 100 && ph == 0) || (ph >= 2 && ph < NPHASE - 1 && ((ph - 2) & 7) == DUP_SUB && (DUP_SUB != 4 || ph < 10)))) ? 2 : 1;
      for (int rep = 0; rep < nrep; ++rep) {
        if (ph == 0) phase_prologue(p, lds);
        else if (ph == 1) phase_modsum(p);
        else if (ph == NPHASE - 1) phase_norm<2, true>(p, lds, p->xr, p->g_final, nullptr, nullptr, 0);
        else {
            const int l = (ph - 2) >> 3, sub = (ph - 2) & 7;
            const float* mf = p->modf + (size_t)l * 16 * 6144;
            if (sub == 0) { if (l == 0) phase_norm<0, false>(p, lds, p->x, p->g_mix + l * DM, mf, mf + 1024, l); else phase_norm<0, true>(p, lds, p->xr, p->g_mix + l * DM, mf, mf + 1024, l); }
            else if (sub == 1) phase_inproj(p, lds, l);
            else if (sub == 2) phase_post(p, lds, l, rep ? POST_MASK : 7);
            else if (sub == 3) phase_attn(p, lds, rep ? ATT_MASK : 3);
            else if (sub == 4) { if (l == 0) phase_outproj<false>(p, lds, l, p->x); else phase_outproj<true>(p, lds, l, p->xr); }
            else if (sub == 5) phase_norm_router(p, lds, p->xr, p->g_ffn + l * DM, mf + 3 * 1024, mf + 4 * 1024, (nrep == 2 && rep == 0) ? l + 2 : l);
            else if (sub == 6) phase_moe_up(p, lds, l);
            else phase_moe_down(p, lds, l, nrep == 2 ? 0.5f : 1.0f);
        }
      }
#if !MK_SPLIT
        if (ph + 1 < ph_hi) xcd_barrier(bar);
#endif
    }
}

extern "C" void kernel_launch(void* const* d_in, const int* in_sizes, int n_in, void* d_out, int out_size, void* d_ws, size_t ws_size, hipStream_t stream) {
    static int grid = 0;
    if (grid == 0) {
        int dev = 0, cus = 0, per_cu = 0;
        (void)hipGetDevice(&dev);
        (void)hipDeviceGetAttribute(&cus, hipDeviceAttributeMultiprocessorCount, dev);
        (void)hipFuncSetAttribute((const void*)mk_fwd, hipFuncAttributeMaxDynamicSharedMemorySize, LDS_BYTES);
        if (hipOccupancyMaxActiveBlocksPerMultiprocessor(&per_cu, (const void*)mk_fwd, 256, LDS_BYTES) != hipSuccess || per_cu < 1) per_cu = 1;
        (void)hipGetLastError();
        if (per_cu > 2) per_cu = 2;
        grid = cus * per_cu;
        fprintf(stderr, "mk_fwd: cus %d per_cu %d grid %d\n", cus, per_cu, grid);
    }
    Params p{};
    const float** pin = (const float**)&p.x;
    for (int i = 0; i < 18; ++i) pin[i] = (const float*)d_in[i];
    p.out = (float*)d_out;
    char* ws = (char*)d_ws;
    size_t off = 0;
    auto carve = [&](size_t bytes) { void* q = ws + off; off += (bytes + 255) & ~(size_t)255; return q; };
    p.bar = (unsigned*)carve(XCD_BAR_WORDS * 4);
    p.cnt = (int*)carve(4 * 32 * 64 * 4);
    const size_t zero_bytes = off;
    p.Wt_in = (half_t*)carve((size_t)2 * NP * DM * 2);
    p.Wt_o = (half_t*)carve((size_t)2 * DM * DM * 2);
    p.Wt_gu = (half_t*)carve((size_t)2 * 16 * 512 * 1024 * 2);
    p.Wt_d = (half_t*)carve((size_t)2 * 16 * 1024 * 256 * 2);
    p.hn = (half_t*)carve((size_t)T_TOK * DM * 2);
    p.P = (half_t*)carve((size_t)T_TOK * NP * 2);
    p.ycat = (half_t*)carve((size_t)T_TOK * DM * 2);
    p.act = (half_t*)carve((size_t)T_TOK * 512 * 2);
    p.xr = (half_t*)carve((size_t)T_TOK * DM * 2);
    p.modpart = (float*)carve((size_t)8 * 2 * 16 * 6144 * 4);
    p.modf = (float*)carve((size_t)2 * 16 * 6144 * 4);
    p.kmean = (float*)carve((size_t)16 * 6 * 8 * 64 * 4);
    p.rope = (float*)carve((size_t)2048 * 24 * 4);
    p.iwf = (float*)carve((size_t)T_TOK * 4 * 4);
    p.tokw = (float*)carve((size_t)T_TOK * 2 * 4);
    p.dmask = (unsigned*)carve((size_t)T_TOK * 64 * 4);
    p.lists = (int*)carve((size_t)NCLS * T_TOK * 4);
    if (off > ws_size) { fprintf(stderr, "workspace too small: need %zu have %zu\n", off, ws_size); return; }
    (void)hipMemsetAsync(d_ws, 0, zero_bytes, stream);
#if MK_SPLIT
    for (int ph = 0; ph < NPHASE; ++ph) {
        p.ph_lo = ph; p.ph_hi = ph + 1;
        hipLaunchKernelGGL(mk_fwd, dim3(grid), dim3(256), LDS_BYTES, stream, p);
    }
#else
    p.ph_lo = 0; p.ph_hi = NPHASE;
    hipLaunchKernelGGL(mk_fwd, dim3(grid), dim3(256), LDS_BYTES, stream, p);
#endif
}
```

```cpp
#include <hip/hip_runtime.h>
#include <cstdio>
#include <cstdint>

#ifndef MK_SPLIT
#define MK_SPLIT 0
#endif

#define T_TOK 32768
#define DM 1024
#define SEQ 2048
#define INW 2340
#define NP 2432
#define PC_CU 0
#define PC_CG 256
#define PC_DQ 512
#define PC_DK 896
#define PC_DV 960
#define PC_IQ 1024
#define PC_IK 1152
#define PC_IW 1184
#define PC_MQ 1280
#define PC_MK 1664
#define PC_MV 2048
#define LOG_THETA 13.122363377404328f
#define NCLS 24
#define LDS_CTL 73728
#define LDS_BYTES 78336
#define NPHASE 19
#ifndef DUP_SUB
#define DUP_SUB -1
#endif

typedef _Float16 half_t;
typedef _Float16 h8 __attribute__((ext_vector_type(8)));
typedef _Float16 h4 __attribute__((ext_vector_type(4)));
typedef short s4v __attribute__((ext_vector_type(4)));
typedef short s8v __attribute__((ext_vector_type(8)));
typedef float f16v __attribute__((ext_vector_type(16)));
typedef float f4v __attribute__((ext_vector_type(4)));
#define LAS __attribute__((address_space(3)))

struct Params {
    const float *x, *c, *w_ada, *b_ada, *g_mix, *w_in, *w_dw, *b_dw, *ln_g, *ln_b, *w_o, *g_ffn, *w_router, *b_router, *w_gate, *w_up, *w_down, *g_final;
    float* out;
    half_t *Wt_in, *Wt_o, *Wt_gu, *Wt_d, *hn, *P, *ycat, *act, *xr;
    float *modpart, *modf, *kmean, *rope, *iwf, *tokw;
    unsigned* dmask; int* cnt; int* lists; unsigned* bar;
    int ph_lo, ph_hi;
};

#define XB_TMO      128
#define XB_XCNT(j)  (256  + 64 * (j))
#define XB_XSUB(j)  (1280 + 64 * (j))
#define XB_XGEN(j)  (2304 + 64 * (j))
#define XB_TOP      3328
#define XB_TOPGEN   3392
#define XCD_BAR_WORDS 3456
#define XB_SPIN_CAP (1u << 20)
__device__ __forceinline__ unsigned xb_ld(unsigned* p)              { return __hip_atomic_load(p, __ATOMIC_RELAXED, __HIP_MEMORY_SCOPE_AGENT); }
__device__ __forceinline__ unsigned xb_add(unsigned* p, unsigned v) { return __hip_atomic_fetch_add(p, v, __ATOMIC_RELAXED, __HIP_MEMORY_SCOPE_AGENT); }
__device__ __forceinline__ unsigned xb_xcc_id() { return (unsigned)__builtin_amdgcn_s_getreg((3 << 11) | 20) & 0xFu; }
#define XB_SPIN(cond, bar) do { unsigned _sp = 0; while (cond) { __builtin_amdgcn_s_sleep(1); \
    if ((++_sp & 255u) == 0u) { if (xb_ld(&(bar)[XB_TMO])) break; if (_sp > XB_SPIN_CAP) { atomicAdd(&(bar)[XB_TMO], 1u); break; } } } } while (0)
struct XcdBarrier { unsigned* bar; unsigned x; volatile LAS unsigned* st; };
__device__ __forceinline__ XcdBarrier xcd_barrier_post(unsigned* bar, volatile LAS unsigned* st) {
    XcdBarrier b; b.bar = bar; b.x = xb_xcc_id(); b.st = st;
    if (threadIdx.x == 0) (void)xb_add(&bar[XB_XCNT(b.x)], 1u);
    return b;
}
__device__ __forceinline__ void xcd_barrier_complete(unsigned* bar, unsigned x, unsigned& nloc, unsigned& nx) {
    const unsigned G = gridDim.x * gridDim.y * gridDim.z;
    unsigned sum, cnt, mine, sp = 0u;
    for (;;) {
        sum = 0u; cnt = 0u; mine = 0u;
#pragma unroll
        for (unsigned j = 0; j < 16; ++j) { const unsigned c = xb_ld(&bar[XB_XCNT(j)]); sum += c; cnt += (c > 0u) ? 1u : 0u; mine = (j == x) ? c : mine; }
        if (sum == G) break;
        __builtin_amdgcn_s_sleep(1);
        if ((++sp & 255u) == 0u) { if (xb_ld(&bar[XB_TMO])) break; if (sp > XB_SPIN_CAP) { atomicAdd(&bar[XB_TMO], 1u); break; } }
    }
    nloc = mine > 0u ? mine : 1u; nx = cnt > 0u ? cnt : 1u;
}
__device__ __forceinline__ void xcd_barrier(const XcdBarrier& b) {
    asm volatile("s_waitcnt vmcnt(0)" ::: "memory");
    __syncthreads();
    if (threadIdx.x == 0) {
        unsigned* bar = b.bar;
        __builtin_amdgcn_s_waitcnt(0);
        unsigned nloc = b.st[0], nx = b.st[1];
        if (nloc == 0u) { xcd_barrier_complete(bar, b.x, nloc, nx); b.st[0] = nloc; b.st[1] = nx; }
        const unsigned old = xb_add(&bar[XB_XSUB(b.x)], 1u);
        const unsigned gen = old / nloc;
        if (old + 1u == (gen + 1u) * nloc) {
            __builtin_amdgcn_fence(__ATOMIC_RELEASE, "agent");
            asm volatile("s_waitcnt vmcnt(0)" ::: "memory");
            const unsigned og = xb_add(&bar[XB_TOP], 1u);
            const unsigned tg = og / nx;
            if (og + 1u == (tg + 1u) * nx) xb_add(&bar[XB_TOPGEN], 1u);
            else XB_SPIN(xb_ld(&bar[XB_TOPGEN]) == tg, bar);
            __builtin_amdgcn_fence(__ATOMIC_ACQUIRE, "agent");
            xb_add(&bar[XB_XGEN(b.x)], 1u);
            asm volatile("s_waitcnt vmcnt(0)" ::: "memory");
        } else {
            XB_SPIN(xb_ld(&bar[XB_XGEN(b.x)]) == gen, bar);
            __builtin_amdgcn_fence(__ATOMIC_ACQUIRE, "agent");
            asm volatile("s_waitcnt vmcnt(0)" ::: "memory");
        }
    }
    __syncthreads();
}

typedef const __attribute__((address_space(4))) Params* KP;
__device__ __forceinline__ int TID() { int t = threadIdx.x; asm volatile("" : "+v"(t)); return t; }
__device__ __forceinline__ int BID() { int b = blockIdx.x; asm volatile("" : "+s"(b)); return b; }
__device__ __forceinline__ float sigmoidf_(float v) { return __builtin_amdgcn_rcpf(1.0f + __expf(-v)); }
__device__ __forceinline__ void glds16(const void* g, char* l) { __builtin_amdgcn_global_load_lds((const unsigned*)g, (unsigned*)l, 16, 0, 0); }
__device__ __forceinline__ unsigned f2sortable(float f) { unsigned u = __float_as_uint(f); return (u & 0x80000000u) ? ~u : (u | 0x80000000u); }
template <bool HIN> __device__ __forceinline__ float4 ldx4(const void* base, size_t idx) {
    if (HIN) { const h4 t = *(const h4*)((const half_t*)base + idx); return make_float4((float)t[0], (float)t[1], (float)t[2], (float)t[3]); }
    return *(const float4*)((const float*)base + idx);
}
__device__ __forceinline__ h4 pack4(float a, float b, float c, float d) { h4 r = {(half_t)a, (half_t)b, (half_t)c, (half_t)d}; return r; }

template <class CF>
__device__ __forceinline__ void conv_tile_panel(char* lds, CF colf, int src_ld, int k0, int n0, half_t* dst, int nrows) {
    float* tl = (float*)lds;
    const int tid = TID();
    __syncthreads();
    {
        const int nn = tid & 63;
        const float* cp = colf(nn);
        float tv[16];
#pragma unroll
        for (int i = 0; i < 16; ++i) { const int k = i * 4 + (tid >> 6); tv[i] = cp ? cp[(size_t)(k0 + k) * src_ld] : 0.f; }
#pragma unroll
        for (int i = 0; i < 16; ++i) { const int k = i * 4 + (tid >> 6); tl[k * 65 + nn] = tv[i]; }
    }
    __syncthreads();
    {
        const int n = tid >> 2, kq = (tid & 3) * 16;
        h8 a, b;
#pragma unroll
        for (int j = 0; j < 8; ++j) { a[j] = (half_t)tl[(kq + j) * 65 + n]; b[j] = (half_t)tl[(kq + 8 + j) * 65 + n]; }
        const int k = k0 + kq;
        h8* d = (h8*)(dst + ((size_t)(k >> 5) * nrows + n0 + n) * 32 + (k & 31));
        d[0] = a; d[1] = b;
    }
}
template <class CF>
__device__ __forceinline__ void conv_tile(char* lds, CF colf, int src_ld, int k0, half_t* dst_tile  , int dstK) {
    float* tl = (float*)lds;
    const int tid = TID();
    __syncthreads();
    {
        const int nn = tid & 63;
        const float* cp = colf(nn);
        float tv[16];
#pragma unroll
        for (int i = 0; i < 16; ++i) { const int k = i * 4 + (tid >> 6); tv[i] = cp ? cp[(size_t)(k0 + k) * src_ld] : 0.f; }
#pragma unroll
        for (int i = 0; i < 16; ++i) { const int k = i * 4 + (tid >> 6); tl[k * 65 + nn] = tv[i]; }
    }
    __syncthreads();
    {
        const int n = tid >> 2, kq = (tid & 3) * 16;
        h8 a, b;
#pragma unroll
        for (int j = 0; j < 8; ++j) { a[j] = (half_t)tl[(kq + j) * 65 + n]; b[j] = (half_t)tl[(kq + 8 + j) * 65 + n]; }
        h8* d = (h8*)(dst_tile + (size_t)n * dstK + kq);
        d[0] = a; d[1] = b;
    }
}

__device__ __forceinline__ void phase_prologue(KP p, char* lds) {
    const int tid = TID();
    const int NA = 2 * 16 * 38, NB = 2 * 16 * 16, NC = 2 * 16 * 16 * 8, ND = 2 * 16 * 4 * 16, NE = 384, NF = 8;
    const int total = NA + NB + NC + ND + NE + NF;
    for (int u0 = BID(); u0 < total; u0 += gridDim.x) {
        int u = u0;
        if (u < NA) {
            const int nt = u % 38, kt = (u / 38) % 16, l = u / (38 * 16);
            const float* src = p->w_in + (size_t)l * DM * INW;
            const int n0 = nt * 64;
            conv_tile_panel(lds, [&](int nn) -> const float* { const int np = n0 + nn; const int sc = np < 512 ? (((np & 63) < 32) ? 32 * (np >> 6) + (np & 31) : 256 + 32 * (np >> 6) + (np & 31)) : (np < 1188 ? np : (np < 1280 ? -1 : np - 92)); return sc >= 0 ? src + sc : (const float*)nullptr; },
                      INW, kt * 64, n0, p->Wt_in + (size_t)l * NP * DM, NP);
            continue;
        }
        u -= NA;
        if (u < NB) {
            const int nt = u % 16, kt = (u / 16) % 16, l = u / 256;
            const float* src = p->w_o + (size_t)l * DM * DM + nt * 64;
            conv_tile_panel(lds, [&](int nn) -> const float* { return src + nn; }, DM, kt * 64, nt * 64, p->Wt_o + (size_t)l * DM * DM, DM);
            continue;
        }
        u -= NB;
        if (u < NC) {
            const int nt = u % 8, kt = (u / 8) % 16, le = u / 128;
            const float* sg = p->w_gate + (size_t)le * 1024 * 256 + nt * 32;
            const float* su = p->w_up + (size_t)le * 1024 * 256 + nt * 32;
            conv_tile(lds, [&](int nn) -> const float* { return nn < 32 ? sg + nn : su + (nn - 32); }, 256, kt * 64, p->Wt_gu + ((size_t)le * 512 + nt * 64) * 1024 + kt * 64, 1024);
            continue;
        }
        u -= NC;
        if (u < ND) {
            const int nt = u % 16, kt = (u / 16) % 4, le = u / 64;
            const float* src = p->w_down + (size_t)le * 256 * 1024 + nt * 64;
            conv_tile(lds, [&](int nn) -> const float* { return src + nn; }, 1024, kt * 64, p->Wt_d + ((size_t)le * 1024 + nt * 64) * 256 + kt * 64, 256);
            continue;
        }
        u -= ND;
        if (u < NE) {
            const int kc = u % 8, cc = (u / 8) % 24, l = u / 192;
            float* ca = (float*)lds;
            __syncthreads();
            for (int i = tid; i < 2048; i += 256) { const int b = i >> 7, k = i & 127; const float v = p->c[b * 1024 + kc * 128 + k]; ca[i] = v / (1.0f + expf(-v)); }
            __syncthreads();
            const int n = cc * 256 + tid;
            float acc[16];
#pragma unroll
            for (int b = 0; b < 16; ++b) acc[b] = 0.f;
            const float* w = p->w_ada + ((size_t)l * 1024 + kc * 128) * 6144 + n;
            for (int k0 = 0; k0 < 128; k0 += 32) {
                float wv[32];
#pragma unroll
                for (int j = 0; j < 32; ++j) wv[j] = w[(size_t)(k0 + j) * 6144];
                __builtin_amdgcn_sched_barrier(0);
#pragma unroll
                for (int j4 = 0; j4 < 8; ++j4) {
#pragma unroll
                    for (int b = 0; b < 16; ++b) {
                        const float4 c4 = *(const float4*)(ca + b * 128 + k0 + 4 * j4);
                        acc[b] = fmaf(c4.x, wv[4 * j4], fmaf(c4.y, wv[4 * j4 + 1], fmaf(c4.z, wv[4 * j4 + 2], fmaf(c4.w, wv[4 * j4 + 3], acc[b]))));
                    }
                }
                __builtin_amdgcn_sched_barrier(0);
            }
#pragma unroll
            for (int b = 0; b < 16; ++b) p->modpart[(((size_t)kc * 2 + l) * 16 + b) * 6144 + n] = acc[b];
            continue;
        }
        u -= NE;
        {
            for (int i = u * 256 + tid; i < 2048 * 12; i += NF * 256) {
                const int t = i / 12, r = i % 12;
                const int fi = r < 8 ? r : r - 8;
                const float rot = r < 8 ? 16.f : 8.f;
                const float inv = expf(-LOG_THETA * ((float)fi * 2.0f / rot));
                const float ang = (float)t * inv;
                float sn, cs; sincosf(ang, &sn, &cs);
                if (r < 8) { p->rope[t * 8 + fi] = cs; p->rope[16384 + t * 8 + fi] = sn; }
                else { p->rope[32768 + t * 4 + fi] = cs; p->rope[32768 + 8192 + t * 4 + fi] = sn; }
            }
        }
    }
}

__device__ __forceinline__ void phase_modsum(KP p) {
    for (int i = BID() * 256 + TID(); i < 2 * 16 * 6144; i += gridDim.x * 256) {
        const int n = i % 6144, l = i / (16 * 6144);
        float s = p->b_ada[l * 6144 + n];
#pragma unroll
        for (int kc = 0; kc < 8; ++kc) s += p->modpart[(size_t)kc * (2 * 16 * 6144) + i];
        p->modf[i] = s;
    }
}

__device__ __forceinline__ void route_flush(KP p, char* lds, int lane, int wave, int n, int myrow, int layer) {
    const float* lg = (const float*)(lds + LDS_CTL + 512) + wave * 256;
    int* lc = (int*)(lds + LDS_CTL + 64);
    int* lbase = lc + 32;
    const int tid = wave * 64 + lane;
    if (tid < 32) lc[tid] = 0;
    __syncthreads();
    int cls = 0, lpos = 0;
    if (lane < n) {
        float aff[16], bia[16];
#pragma unroll
        for (int e = 0; e < 16; ++e) { aff[e] = 1.0f / (1.0f + expf(-lg[lane * 16 + e])); bia[e] = aff[e] + p->b_router[e]; }
        int bestg = 0; float bests = -INFINITY;
#pragma unroll
        for (int gi = 0; gi < 4; ++gi) {
            float m1 = -INFINITY, m2 = -INFINITY;
#pragma unroll
            for (int j = 0; j < 4; ++j) { const float vv = bia[gi * 4 + j]; if (vv > m1) { m2 = m1; m1 = vv; } else if (vv > m2) m2 = vv; }
            const float s = m1 + m2;
            if (s > bests) { bests = s; bestg = gi; }
        }
        float bsel[4], asel[4];
#pragma unroll
        for (int j = 0; j < 4; ++j) { bsel[j] = 0.f; asel[j] = 0.f; }
#pragma unroll
        for (int gi = 0; gi < 4; ++gi) if (gi == bestg) {
#pragma unroll
            for (int j = 0; j < 4; ++j) { bsel[j] = bia[gi * 4 + j]; asel[j] = aff[gi * 4 + j]; }
        }
        int i1 = -1, i2 = -1; float v1 = -INFINITY, v2 = -INFINITY;
#pragma unroll
        for (int j = 0; j < 4; ++j) { const float vv = bsel[j]; if (vv > v1) { v2 = v1; i2 = i1; v1 = vv; i1 = j; } else if (vv > v2) { v2 = vv; i2 = j; } }
        const int a = i1 < i2 ? i1 : i2, bb = i1 < i2 ? i2 : i1;
        float wa = 0.f, wb = 0.f;
#pragma unroll
        for (int j = 0; j < 4; ++j) { if (j == a) wa = asel[j]; if (j == bb) wb = asel[j]; }
        const float sw = wa + wb;
        const int pi = (a == 0) ? (bb - 1) : (a == 1 ? (bb + 1) : 5);
        cls = bestg * 6 + pi;
        *(float2*)(p->tokw + (size_t)myrow * 2) = make_float2(wa / sw, wb / sw);
        lpos = atomicAdd(&lc[cls], 1);
    }
    __syncthreads();
    if (tid < NCLS) { const int c = lc[tid]; lbase[tid] = c ? atomicAdd(&p->cnt[(layer * 32 + tid) * 64], c) : 0; }
    __syncthreads();
    if (lane < n) p->lists[(size_t)cls * T_TOK + lbase[cls] + lpos] = myrow;
}

template <int MODE, bool HIN>
__device__ __forceinline__ void phase_norm(KP p, char* lds, const void* xin, const float* g, const float* sh, const float* sc, int layer) {
    const int lane = TID() & 63, wave = TID() >> 6;
    float* wt = (float*)lds;
    if (MODE == 1) {
        __syncthreads();
        for (int i = TID(); i < 4096; i += 256) {
            const float4 w4 = ((const float4*)p->w_router)[i];
            const int k = i >> 2, e0 = (i & 3) * 4;
            wt[(e0 + 0) * 1024 + k] = w4.x; wt[(e0 + 1) * 1024 + k] = w4.y; wt[(e0 + 2) * 1024 + k] = w4.z; wt[(e0 + 3) * 1024 + k] = w4.w;
        }
        __syncthreads();
    }
    float* lgb = (float*)(lds + LDS_CTL + 512);
    int myrow = 0, it = 0;
    float4 vn[4];
    const int nwv = gridDim.x * 4, rpw = (T_TOK + nwv - 1) / nwv;
    const int rbeg = (BID() * 4 + wave) * rpw, rend = rbeg + rpw < T_TOK ? rbeg + rpw : T_TOK;
    {
        const size_t xo = (size_t)(rbeg < T_TOK ? rbeg : 0) * DM;
#pragma unroll
        for (int i = 0; i < 4; ++i) vn[i] = ldx4<HIN>(xin, xo + (lane + 64 * i) * 4);
    }
    float4 ggr[4], s1r[4], s2r[4];
#pragma unroll
    for (int i = 0; i < 4; ++i) { ggr[i] = *(const float4*)(g + (lane + 64 * i) * 4); s1r[i] = make_float4(0.f, 0.f, 0.f, 0.f); s2r[i] = s1r[i]; }
    int bcur = -1;
    for (int row = rbeg; row < rend; ++row) {
        const int b = row >> 11;
        if (MODE != 2 && b != bcur) {
            bcur = b;
#pragma unroll
            for (int i = 0; i < 4; ++i) { const int k = (lane + 64 * i) * 4; s1r[i] = *(const float4*)(sh + (size_t)b * 6144 + k); s2r[i] = *(const float4*)(sc + (size_t)b * 6144 + k); }
        }
        float4 v[4]; float ss = 0.f;
#pragma unroll
        for (int i = 0; i < 4; ++i) v[i] = vn[i];
        {
            const int rown = row + 1;
            const size_t xo = (size_t)(rown < rend ? rown : row) * DM;
#pragma unroll
            for (int i = 0; i < 4; ++i) vn[i] = ldx4<HIN>(xin, xo + (lane + 64 * i) * 4);
        }
#pragma unroll
        for (int i = 0; i < 4; ++i) ss += v[i].x * v[i].x + v[i].y * v[i].y + v[i].z * v[i].z + v[i].w * v[i].w;
#pragma unroll
        for (int o = 32; o >= 1; o >>= 1) ss += __shfl_xor(ss, o);
        const float rstd = 1.0f / sqrtf(ss * (1.0f / 1024.0f) + 1e-6f);
        float acc[16], ya[16];
#pragma unroll
        for (int i = 0; i < 4; ++i) {
            const int k = (lane + 64 * i) * 4;
            const float4 gg = ggr[i];
            float y[4] = {v[i].x * rstd * gg.x, v[i].y * rstd * gg.y, v[i].z * rstd * gg.z, v[i].w * rstd * gg.w};
            if (MODE != 2) {
                const float4 s1 = s1r[i], s2 = s2r[i];
                y[0] = y[0] * (1.f + s2.x) + s1.x; y[1] = y[1] * (1.f + s2.y) + s1.y; y[2] = y[2] * (1.f + s2.z) + s1.z; y[3] = y[3] * (1.f + s2.w) + s1.w;
                if (MODE == 0) *(h4*)(p->hn + ((size_t)(k >> 5) * T_TOK + row) * 32 + (k & 31)) = pack4(y[0], y[1], y[2], y[3]);
                else *(h4*)(p->hn + (size_t)row * DM + k) = pack4(y[0], y[1], y[2], y[3]);
            } else {
                *(float4*)(p->out + (size_t)row * DM + k) = make_float4(y[0], y[1], y[2], y[3]);
            }
            ya[4 * i] = y[0]; ya[4 * i + 1] = y[1]; ya[4 * i + 2] = y[2]; ya[4 * i + 3] = y[3];
        }
        if (MODE == 1) {
#pragma unroll
            for (int e = 0; e < 16; ++e) acc[e] = 0.f;
            float4 wq[2][4];
            const float* wl = wt + lane * 4;
#pragma unroll
            for (int e = 0; e < 4; ++e) wq[0][e] = *(const float4*)(wl + e * 1024);
#pragma unroll
            for (int st = 0; st < 16; ++st) {
                const int i = st >> 2, eg = st & 3, cur = st & 1;
                if (st + 1 < 16) {
                    const int i2 = (st + 1) >> 2, eg2 = (st + 1) & 3;
#pragma unroll
                    for (int e = 0; e < 4; ++e) wq[cur ^ 1][e] = *(const float4*)(wl + (eg2 * 4 + e) * 1024 + i2 * 256);
                }
#pragma unroll
                for (int e = 0; e < 4; ++e) {
                    const float4 w4 = wq[cur][e];
                    acc[eg * 4 + e] = fmaf(ya[4 * i], w4.x, fmaf(ya[4 * i + 1], w4.y, fmaf(ya[4 * i + 2], w4.z, fmaf(ya[4 * i + 3], w4.w, acc[eg * 4 + e]))));
                }
                __builtin_amdgcn_sched_barrier(0);
            }
        }
        if (MODE == 1) {
            const bool b5 = lane & 32, b4 = lane & 16, b3 = lane & 8, b2 = lane & 4;
            float r8[8], r4[4], r2[2];
#pragma unroll
            for (int e = 0; e < 8; ++e) { const float snd = b5 ? acc[e] : acc[e + 8], kp = b5 ? acc[e + 8] : acc[e]; r8[e] = kp + __shfl_xor(snd, 32); }
#pragma unroll
            for (int e = 0; e < 4; ++e) { const float snd = b4 ? r8[e] : r8[e + 4], kp = b4 ? r8[e + 4] : r8[e]; r4[e] = kp + __shfl_xor(snd, 16); }
#pragma unroll
            for (int e = 0; e < 2; ++e) { const float snd = b3 ? r4[e] : r4[e + 2], kp = b3 ? r4[e + 2] : r4[e]; r2[e] = kp + __shfl_xor(snd, 8); }
            float rv; { const float snd = b2 ? r2[0] : r2[1], kp = b2 ? r2[1] : r2[0]; rv = kp + __shfl_xor(snd, 4); }
            rv += __shfl_xor(rv, 2); rv += __shfl_xor(rv, 1);
            if ((lane & 3) == 0) lgb[(wave * 16 + it) * 16 + (lane >> 2)] = rv;
            if (lane == it) myrow = row;
            ++it;
            if (it == 16) { route_flush(p, lds, lane, wave, it, myrow, layer); it = 0; }
        }
    }
    if (MODE == 1 && it > 0) route_flush(p, lds, lane, wave, it, myrow, layer);
}

typedef float f2_t __attribute__((ext_vector_type(2)));
#define NRR 2
__device__ __forceinline__ void phase_norm_router(KP p, char* lds, const half_t* xin, const float* g, const float* sh, const float* sc, int layer) {
    const int lane = TID() & 63, wave = TID() >> 6;
    float* wt = (float*)lds;
    __syncthreads();
    for (int i = TID(); i < 4096; i += 256) {
        const float4 w4 = ((const float4*)p->w_router)[i];
        const int k = i >> 2, e0 = (i & 3) * 4;
        wt[(e0 + 0) * 1024 + k] = w4.x; wt[(e0 + 1) * 1024 + k] = w4.y; wt[(e0 + 2) * 1024 + k] = w4.z; wt[(e0 + 3) * 1024 + k] = w4.w;
    }
    __syncthreads();
    float* lgb = (float*)(lds + LDS_CTL + 512);
    int myrow = 0, it = 0;
    const int rstride = 1;
    const int nwv = gridDim.x * 4, rpw = (T_TOK + nwv - 1) / nwv;
    const int rbeg = (BID() * 4 + wave) * rpw, rend = rbeg + rpw < T_TOK ? rbeg + rpw : T_TOK;
    float4 gpr[4], s1r[4];
#pragma unroll
    for (int i = 0; i < 4; ++i) { gpr[i] = make_float4(0.f, 0.f, 0.f, 0.f); s1r[i] = gpr[i]; }
    int bcur = -1, nv = NRR;
    for (int row0 = rbeg; row0 < rend; row0 += nv) {
        f2_t ya[NRR / 2][16];
        float ss[NRR];
        const int b = row0 >> 11;
        nv = 0;
#pragma unroll
        for (int j = 0; j < NRR; ++j) nv += (row0 + j < rend && ((row0 + j) >> 11) == b) ? 1 : 0;
        if (b != bcur) {
            bcur = b;
#pragma unroll
            for (int i = 0; i < 4; ++i) {
                const int k = (lane + 64 * i) * 4;
                const float4 gg = *(const float4*)(g + k), s2 = *(const float4*)(sc + (size_t)b * 6144 + k);
                gpr[i] = make_float4(gg.x * (1.f + s2.x), gg.y * (1.f + s2.y), gg.z * (1.f + s2.z), gg.w * (1.f + s2.w));
                s1r[i] = *(const float4*)(sh + (size_t)b * 6144 + k);
            }
        }
        {
            float4 v[NRR][4];
#pragma unroll
            for (int j = 0; j < NRR; ++j) {
                const int r = row0 + j * rstride;
                const size_t xo = (size_t)(j < nv ? r : row0) * DM;
#pragma unroll
                for (int i = 0; i < 4; ++i) v[j][i] = ldx4<true>(xin, xo + (lane + 64 * i) * 4);
            }
#pragma unroll
            for (int j = 0; j < NRR; ++j) {
                ss[j] = 0.f;
#pragma unroll
                for (int i = 0; i < 4; ++i) ss[j] += v[j][i].x * v[j][i].x + v[j][i].y * v[j][i].y + v[j][i].z * v[j][i].z + v[j][i].w * v[j][i].w;
            }
#pragma unroll
            for (int o = 32; o >= 1; o >>= 1) {
#pragma unroll
                for (int j = 0; j < NRR; ++j) ss[j] += __shfl_xor(ss[j], o);
            }
#pragma unroll
            for (int j = 0; j < NRR; ++j) ss[j] = 1.0f / sqrtf(ss[j] * (1.0f / 1024.0f) + 1e-6f);
#pragma unroll
            for (int j = 0; j < NRR; ++j) {
                const int r = row0 + j * rstride;
                const float rs = ss[j];
#pragma unroll
                for (int i = 0; i < 4; ++i) {
                    const int k = (lane + 64 * i) * 4;
                    const float4 gp = gpr[i], s1 = s1r[i];
                    const float y0 = v[j][i].x * rs * gp.x + s1.x, y1 = v[j][i].y * rs * gp.y + s1.y;
                    const float y2 = v[j][i].z * rs * gp.z + s1.z, y3 = v[j][i].w * rs * gp.w + s1.w;
                    if (j < nv) *(h4*)(p->hn + (size_t)r * DM + k) = pack4(y0, y1, y2, y3);
                    if (j & 1) { ya[j >> 1][4 * i].y = y0; ya[j >> 1][4 * i + 1].y = y1; ya[j >> 1][4 * i + 2].y = y2; ya[j >> 1][4 * i + 3].y = y3; }
                    else       { ya[j >> 1][4 * i].x = y0; ya[j >> 1][4 * i + 1].x = y1; ya[j >> 1][4 * i + 2].x = y2; ya[j >> 1][4 * i + 3].x = y3; }
                }
                __builtin_amdgcn_sched_barrier(0);
            }
        }
        f2_t acc[NRR / 2][16];
#pragma unroll
        for (int e = 0; e < 16; ++e) {
#pragma unroll
            for (int jp = 0; jp < NRR / 2; ++jp) acc[jp][e] = (f2_t){0.f, 0.f};
        }
        {
            float4 wq[2][4];
            const float* wl = wt + lane * 4;
#pragma unroll
            for (int e = 0; e < 4; ++e) wq[0][e] = *(const float4*)(wl + e * 1024);
#pragma unroll
            for (int st = 0; st < 16; ++st) {
                const int i = st >> 2, eg = st & 3, cur = st & 1;
                if (st + 1 < 16) {
                    const int i2 = (st + 1) >> 2, eg2 = (st + 1) & 3;
#pragma unroll
                    for (int e = 0; e < 4; ++e) wq[cur ^ 1][e] = *(const float4*)(wl + (eg2 * 4 + e) * 1024 + i2 * 256);
                }
#pragma unroll
                for (int e = 0; e < 4; ++e) {
                    const float4 w4 = wq[cur][e];
#pragma unroll
                    for (int jp = 0; jp < NRR / 2; ++jp) {
                        f2_t a = acc[jp][eg * 4 + e];
                        a = ya[jp][4 * i + 3] * (f2_t){w4.w, w4.w} + a;
                        a = ya[jp][4 * i + 2] * (f2_t){w4.z, w4.z} + a;
                        a = ya[jp][4 * i + 1] * (f2_t){w4.y, w4.y} + a;
                        a = ya[jp][4 * i] * (f2_t){w4.x, w4.x} + a;
                        acc[jp][eg * 4 + e] = a;
                    }
                }
                __builtin_amdgcn_sched_barrier(0);
            }
        }
        const bool b5 = lane & 32, b4 = lane & 16, b3 = lane & 8, b2 = lane & 4;
#pragma unroll
        for (int j = 0; j < NRR; ++j) {
            float r8[8], r4[4], r2[2];
#pragma unroll
            for (int e = 0; e < 8; ++e) {
                const float lo = (j & 1) ? acc[j >> 1][e].y : acc[j >> 1][e].x, hi = (j & 1) ? acc[j >> 1][e + 8].y : acc[j >> 1][e + 8].x;
                const float snd = b5 ? lo : hi, kp = b5 ? hi : lo; r8[e] = kp + __shfl_xor(snd, 32);
            }
#pragma unroll
            for (int e = 0; e < 4; ++e) { const float snd = b4 ? r8[e] : r8[e + 4], kp = b4 ? r8[e + 4] : r8[e]; r4[e] = kp + __shfl_xor(snd, 16); }
#pragma unroll
            for (int e = 0; e < 2; ++e) { const float snd = b3 ? r4[e] : r4[e + 2], kp = b3 ? r4[e + 2] : r4[e]; r2[e] = kp + __shfl_xor(snd, 8); }
            float rv; { const float snd = b2 ? r2[0] : r2[1], kp = b2 ? r2[1] : r2[0]; rv = kp + __shfl_xor(snd, 4); }
            rv += __shfl_xor(rv, 2); rv += __shfl_xor(rv, 1);
            if (j < nv) {
                if ((lane & 3) == 0) lgb[(wave * 16 + it) * 16 + (lane >> 2)] = rv;
                if (lane == it) myrow = row0 + j * rstride;
                ++it;
            }
        }
        if (it == 16) { route_flush(p, lds, lane, wave, it, myrow, layer); it = 0; }
    }
    if (it > 0) route_flush(p, lds, lane, wave, it, myrow, layer);
}

template <class WF, class XF, class EPI>
__device__ __forceinline__ void gemm_tile(char* lds, int nkt, WF wf, XF xf, EPI epi) {
    const int tid = TID(), lane = tid & 63, wave = tid >> 6;
    const int wn = wave & 1, wm = wave >> 1, hh = lane >> 5;
    const int lrow = tid >> 3;
    const int lchunk = (tid & 7) ^ ((tid >> 4) & 7);
    const half_t* xs[4];
#pragma unroll
    for (int i = 0; i < 4; ++i) xs[i] = xf(lrow + 32 * i) + lchunk * 8;
    char* ldst = lds + lrow * 128 + (tid & 7) * 16;
    f16v acc[2][2];
#pragma unroll
    for (int i = 0; i < 2; ++i)
#pragma unroll
        for (int j = 0; j < 2; ++j)
#pragma unroll
            for (int r = 0; r < 16; ++r) acc[i][j][r] = 0.f;
    auto issue = [&](int kt, int s) {
        char* d = ldst + s * 32768;
#pragma unroll
        for (int i = 0; i < 4; ++i) glds16(wf(kt, lrow + 32 * i) + lchunk * 8, d + i * 4096);
#pragma unroll
        for (int i = 0; i < 4; ++i) glds16(xs[i] + kt * 64, d + 16384 + i * 4096);
    };
    __syncthreads();
    issue(0, 0);
    const int rsw = (lane >> 1) & 7;
    const int roff_w = (wn * 64 + (lane & 31)) * 128, roff_x = 16384 + (wm * 64 + (lane & 31)) * 128;
    for (int kt = 0; kt < nkt; ++kt) {
        asm volatile("s_waitcnt vmcnt(0)" ::: "memory");
        __syncthreads();
        if (kt + 1 < nkt) issue(kt + 1, (kt + 1) & 1);
        const char* base = lds + (kt & 1) * 32768;
#pragma unroll
        for (int ks = 0; ks < 4; ++ks) {
            const int co = ((2 * ks + hh) ^ rsw) << 4;
            const h8 a0 = *(const h8*)(base + roff_w + co), a1 = *(const h8*)(base + roff_w + 4096 + co);
            const h8 b0 = *(const h8*)(base + roff_x + co), b1 = *(const h8*)(base + roff_x + 4096 + co);
            acc[0][0] = __builtin_amdgcn_mfma_f32_32x32x16_f16(a0, b0, acc[0][0], 0, 0, 0);
            acc[0][1] = __builtin_amdgcn_mfma_f32_32x32x16_f16(a0, b1, acc[0][1], 0, 0, 0);
            acc[1][0] = __builtin_amdgcn_mfma_f32_32x32x16_f16(a1, b0, acc[1][0], 0, 0, 0);
            acc[1][1] = __builtin_amdgcn_mfma_f32_32x32x16_f16(a1, b1, acc[1][1], 0, 0, 0);
        }
    }
    epi(acc, wn, wm, lane);
}

template <class WF, class XF, class EPI>
__device__ __forceinline__ void gemm_tile2(char* lds, int nkt, size_t xkstride, WF wf, XF xf, EPI epi) {
    const int tid = TID(), lane = tid & 63, wave = tid >> 6;
    const int wn = wave & 1, wm = wave >> 1, hh = lane >> 5;
    const int lrow = tid >> 2;
    const int lchunk = (tid & 3) ^ ((tid >> 4) & 3);
    const half_t* xs[2];
#pragma unroll
    for (int i = 0; i < 2; ++i) xs[i] = xf(lrow + 64 * i) + lchunk * 8;
    char* ldst = lds + lrow * 64 + (tid & 3) * 16;
    f16v acc[4][2];
#pragma unroll
    for (int i = 0; i < 4; ++i)
#pragma unroll
        for (int j = 0; j < 2; ++j)
#pragma unroll
            for (int r = 0; r < 16; ++r) acc[i][j][r] = 0.f;
    auto issue = [&](int kt, int s) {
        char* d = ldst + s * 24576;
#pragma unroll
        for (int i = 0; i < 4; ++i) glds16(wf(kt, lrow + 64 * i) + lchunk * 8, d + i * 4096);
#pragma unroll
        for (int i = 0; i < 2; ++i) glds16(xs[i] + (size_t)kt * xkstride, d + 16384 + i * 4096);
    };
    __syncthreads();
    issue(0, 0); issue(1, 1);
    const int rsw = (lane >> 2) & 3;
    const int roff_w = (wn * 128 + (lane & 31)) * 64, roff_x = 16384 + (wm * 64 + (lane & 31)) * 64;
    int st = 0;
    for (int kt = 0; kt < nkt; ++kt) {
        if (kt + 1 < nkt) asm volatile("s_waitcnt vmcnt(6)" ::: "memory");
        else asm volatile("s_waitcnt vmcnt(0)" ::: "memory");
        asm volatile("s_waitcnt lgkmcnt(0)" ::: "memory");
        __builtin_amdgcn_s_barrier();
        if (kt + 2 < nkt) issue(kt + 2, st >= 1 ? st - 1 : 2);
        const char* base = lds + st * 24576;
        st = st == 2 ? 0 : st + 1;
#pragma unroll
        for (int ks = 0; ks < 2; ++ks) {
            const int co = ((2 * ks + hh) ^ rsw) << 4;
            h8 a[4], b[2];
#pragma unroll
            for (int i = 0; i < 4; ++i) a[i] = *(const h8*)(base + roff_w + i * 2048 + co);
#pragma unroll
            for (int j = 0; j < 2; ++j) b[j] = *(const h8*)(base + roff_x + j * 2048 + co);
#pragma unroll
            for (int i = 0; i < 4; ++i)
#pragma unroll
                for (int j = 0; j < 2; ++j) acc[i][j] = __builtin_amdgcn_mfma_f32_32x32x16_f16(a[i], b[j], acc[i][j], 0, 0, 0);
        }
    }
    epi(acc, wn, wm, lane);
}

__device__ __forceinline__ void phase_inproj(KP p, char* lds, int l) {
    const half_t* W = p->Wt_in + (size_t)l * NP * DM;
    const float* rc16 = p->rope; const float* rs16 = p->rope + 16384; const float* rc8 = p->rope + 32768; const float* rs8 = p->rope + 32768 + 8192;
    for (int u = BID(); u < 256 * 10; u += gridDim.x) {
        const int xl = u & 7, Lx = u >> 3, mi = Lx & 15, rr_ = Lx >> 4;
        const int nt = rr_ % 10, mt = 32 * xl + 16 * (rr_ / 10) + mi;
        gemm_tile2(lds, 32, (size_t)T_TOK * 32,
            [&](int kt, int row) { int n = nt * 256 + row; n = n < NP ? n : NP - 1; return W + ((size_t)kt * NP + n) * 32; },
            [&](int row) { return p->hn + (size_t)(mt * 128 + row) * 32; },
            [&](f16v (&acc)[4][2], int wn, int wm, int lane) {
                const int hh = lane >> 5;
                half_t* stg = (half_t*)lds;
                __syncthreads();
#pragma unroll
                for (int i = 0; i < 4; ++i) {
                    const int nb = nt * 256 + wn * 128 + i * 32;
                    if (nb == 1216 || nb == 1248 || nb >= NP) continue;
                    if (nt < 2) {
                        if (i & 1) continue;
#pragma unroll
                        for (int j = 0; j < 2; ++j) {
                            half_t* dst = stg + (wm * 64 + j * 32 + (lane & 31)) * 260 + wn * 64 + (i >> 1) * 32 + 4 * hh;
#pragma unroll
                            for (int g = 0; g < 4; ++g) {
                                float a4[4];
#pragma unroll
                                for (int r = 0; r < 4; ++r) a4[r] = acc[i][j][4 * g + r] * sigmoidf_(acc[i + 1][j][4 * g + r]);
                                *(h4*)(dst + 8 * g) = pack4(a4[0], a4[1], a4[2], a4[3]);
                            }
                        }
                        continue;
                    }
                    const bool rope64 = ((nb >= PC_DQ && nb < PC_DV) || (nb >= PC_MQ && nb < PC_MV)) && ((nb & 63) == 0);
                    const bool rope32 = (nb >= PC_IQ && nb < PC_IW);
#pragma unroll
                    for (int j = 0; j < 2; ++j) {
                        const int tok = mt * 128 + wm * 64 + j * 32 + (lane & 31);
                        const int t = tok & 2047;
                        f16v v = acc[i][j];
                        if (nb == PC_IW) { if (hh == 0) *(float4*)(p->iwf + (size_t)tok * 4) = make_float4(v[0], v[1], v[2], v[3]); continue; }
                        if (rope64) {
                            const float4 c4 = *(const float4*)(rc16 + t * 8 + 4 * hh), s4 = *(const float4*)(rs16 + t * 8 + 4 * hh);
                            const float cc[4] = {c4.x, c4.y, c4.z, c4.w}, sn[4] = {s4.x, s4.y, s4.z, s4.w};
#pragma unroll
                            for (int r = 0; r < 4; ++r) { const float x1 = v[r], x2 = v[r + 4]; v[r] = x1 * cc[r] - x2 * sn[r]; v[r + 4] = x2 * cc[r] + x1 * sn[r]; }
                        } else if (rope32) {
                            const float4 c4 = *(const float4*)(rc8 + t * 4), s4 = *(const float4*)(rs8 + t * 4);
                            const float cc[4] = {c4.x, c4.y, c4.z, c4.w}, sn[4] = {s4.x, s4.y, s4.z, s4.w};
#pragma unroll
                            for (int r = 0; r < 4; ++r) { const float o = __shfl_xor(v[r], 32); v[r] = hh ? (v[r] * cc[r] + o * sn[r]) : (v[r] * cc[r] - o * sn[r]); }
                        }
                        if ((nb >= PC_DQ && nb < PC_DK) || (nb >= PC_MQ && nb < PC_MK)) {
#pragma unroll
                            for (int r = 0; r < 16; ++r) v[r] *= 0.18033688011112042f;
                        }
                        half_t* dst = stg + (wm * 64 + j * 32 + (lane & 31)) * 260 + wn * 128 + i * 32 + 4 * hh;
#pragma unroll
                        for (int g = 0; g < 4; ++g) *(h4*)(dst + 8 * g) = pack4(v[4 * g], v[4 * g + 1], v[4 * g + 2], v[4 * g + 3]);
                    }
                }
                __syncthreads();
                const int wv_ = TID() >> 6;
#pragma unroll 4
                for (int it = 0; it < 32; ++it) {
                    const int row = it * 4 + wv_;
                    const uint2 v2 = *(const uint2*)(stg + row * 260 + lane * 4);
                    if (nt < 2) { if (lane < 32) *(uint2*)(p->P + (size_t)(mt * 128 + row) * NP + nt * 128 + lane * 4) = v2; }
                    else { const int n = nt * 256 + lane * 4; if (n < NP) *(uint2*)(p->P + (size_t)(mt * 128 + row) * NP + n) = v2; }
                }
            });
    }
}

__device__ __forceinline__ void stage_acc_f32(char* lds, const f16v (&acc)[2][2], int wn, int wm, int lane) {
    float* stg = (float*)lds;
    const int hh = lane >> 5;
    __syncthreads();
#pragma unroll
    for (int j = 0; j < 2; ++j)
#pragma unroll
        for (int i = 0; i < 2; ++i)
#pragma unroll
            for (int g = 0; g < 4; ++g)
                *(float4*)(stg + (wm * 64 + j * 32 + (lane & 31)) * 132 + wn * 64 + i * 32 + 4 * hh + 8 * g) = make_float4(acc[i][j][4 * g], acc[i][j][4 * g + 1], acc[i][j][4 * g + 2], acc[i][j][4 * g + 3]);
    __syncthreads();
}
template <bool HIN>
__device__ __forceinline__ void phase_outproj(KP p, char* lds, int l, const void* xin) {
    const half_t* W = p->Wt_o + (size_t)l * DM * DM;
    const float* g1 = p->modf + (size_t)l * 16 * 6144 + 2 * 1024;
    for (int u = BID(); u < 256 * 4; u += gridDim.x) {
        const int xl = u & 7, Lx = u >> 3, mi = Lx & 7, rr_ = Lx >> 3;
        const int nt = rr_ & 3, mt = 32 * xl + 8 * (rr_ >> 2) + mi;
        gemm_tile2(lds, 32, (size_t)T_TOK * 32,
            [&](int kt, int row) { return W + ((size_t)kt * DM + nt * 256 + row) * 32; },
            [&](int row) { return p->ycat + (size_t)(mt * 128 + row) * 32; },
            [&](f16v (&acc)[4][2], int wn, int wm, int lane) {
                const int hh = lane >> 5, tid = TID();
                float* stg = (float*)lds;
#pragma unroll
                for (int rnd = 0; rnd < 2; ++rnd) {
                    __syncthreads();
                    if (wm == rnd) {
#pragma unroll
                        for (int j = 0; j < 2; ++j)
#pragma unroll
                            for (int i = 0; i < 4; ++i)
#pragma unroll
                                for (int g = 0; g < 4; ++g)
                                    *(float4*)(stg + (j * 32 + (lane & 31)) * 260 + wn * 128 + i * 32 + 4 * hh + 8 * g) = make_float4(acc[i][j][4 * g], acc[i][j][4 * g + 1], acc[i][j][4 * g + 2], acc[i][j][4 * g + 3]);
                    }
                    __syncthreads();
#pragma unroll 8
                    for (int it = 0; it < 16; ++it) {
                        const int idx = it * 256 + tid, row = idx >> 6, c = idx & 63;
                        const int tok = mt * 128 + rnd * 64 + row, n = nt * 256 + 4 * c;
                        const float4 a4 = *(const float4*)(stg + row * 260 + 4 * c);
                        const float4 xi = ldx4<HIN>(xin, (size_t)tok * DM + n);
                        const float4 gg = *(const float4*)(g1 + (size_t)(tok >> 11) * 6144 + n);
                        *(h4*)(p->xr + (size_t)tok * DM + n) = pack4(xi.x + gg.x * a4.x, xi.y + gg.y * a4.y, xi.z + gg.z * a4.z, xi.w + gg.w * a4.w);
                    }
                }
            });
    }
}

struct MoeTab { int tb, nt, nc; };
__device__ __forceinline__ MoeTab moe_table(const int* cnt) {
    const int c = TID() & 31;
    MoeTab t;
    t.nc = (c < NCLS) ? cnt[c * 64] : 0;
    t.nt = (t.nc + 127) >> 7;
    int incl = t.nt;
#pragma unroll
    for (int o = 1; o < 32; o <<= 1) { const int v = __shfl_up(incl, o, 32); if (c >= o) incl += v; }
    t.tb = incl - t.nt;
    return t;
}
__device__ __forceinline__ bool moe_tile(const MoeTab& t, int tile, int& cls, int& pos0, int& n) {
    const unsigned long long m = __ballot(tile >= t.tb && tile < t.tb + t.nt);
    if (m == 0ull) return false;
    cls = __ffsll((long long)m) - 1;
    pos0 = (tile - __builtin_amdgcn_readlane(t.tb, cls)) * 128;
    n = __builtin_amdgcn_readlane(t.nc, cls);
    return true;
}
__device__ __forceinline__ void cls_experts(int cls, int& e1, int& e2) {
    const int g = cls / 6, pi = cls % 6;
    const int a = pi < 3 ? 0 : (pi < 5 ? 1 : 2);
    const int b = pi < 3 ? pi + 1 : (pi < 5 ? pi - 1 : 3);
    e1 = g * 4 + a; e2 = g * 4 + b;
}
__device__ __forceinline__ void phase_moe_up(KP p, char* lds, int l) {
    const MoeTab tab = moe_table(p->cnt + l * 32 * 64);
    for (int u = BID(); u < (256 + NCLS) * 8; u += gridDim.x) {
        const int xl = u & 7, Lx = u >> 3;
        const int nt = Lx & 7, tile = (Lx >> 3) * 8 + xl;
        int cls, pos0, nc;
        if (!moe_tile(tab, tile, cls, pos0, nc)) continue;
        int e1, e2; cls_experts(cls, e1, e2);
        const int slot = nt >> 2;
        const half_t* W = p->Wt_gu + ((size_t)(l * 16 + (slot ? e2 : e1)) * 512 + (nt & 3) * 128) * 1024;
        const int* lst = p->lists + (size_t)cls * T_TOK + pos0;
        const int nvalid = nc - pos0;
        int tokE[2]; float wgtE[2];
        {
            const int lane_ = TID() & 63, wm_ = TID() >> 7;
#pragma unroll
            for (int j = 0; j < 2; ++j) {
                const int row = wm_ * 64 + j * 32 + (lane_ & 31);
                tokE[j] = lst[row < nvalid ? row : 0];
                wgtE[j] = p->tokw[(size_t)tokE[j] * 2 + slot];
            }
        }
        gemm_tile(lds, 16,
            [&](int kt, int row) { return W + (size_t)row * 1024 + kt * 64; },
            [&](int row) { const int tok = lst[row < nvalid ? row : 0]; return p->hn + (size_t)tok * DM; },
            [&](f16v (&acc)[2][2], int wn, int wm, int lane) {
                const int hh = lane >> 5;
#pragma unroll
                for (int j = 0; j < 2; ++j) {
                    const int row = wm * 64 + j * 32 + (lane & 31);
                    if (row < nvalid) {
                        const int tok = tokE[j];
                        const float wgt = wgtE[j];
                        half_t* dst = p->act + (size_t)tok * 512 + slot * 256 + ((nt & 3) * 2 + wn) * 32 + 4 * hh;
#pragma unroll
                        for (int g = 0; g < 4; ++g) {
                            float a[4];
#pragma unroll
                            for (int r = 0; r < 4; ++r) { const float gv = acc[0][j][4 * g + r], uv = acc[1][j][4 * g + r]; a[r] = gv * sigmoidf_(gv) * uv * wgt; }
                            *(h4*)(dst + 8 * g) = pack4(a[0], a[1], a[2], a[3]);
                        }
                    }
                }
            });
    }
}
__device__ __forceinline__ void phase_moe_down(KP p, char* lds, int l, float gsc) {
    const MoeTab tab = moe_table(p->cnt + l * 32 * 64);
    const float* g2 = p->modf + (size_t)l * 16 * 6144 + 5 * 1024;
    for (int u = BID(); u < (256 + NCLS) * 8; u += gridDim.x) {
        const int xl = u & 7, Lx = u >> 3;
        const int nt = Lx & 7, tile = (Lx >> 3) * 8 + xl;
        int cls, pos0, nc;
        if (!moe_tile(tab, tile, cls, pos0, nc)) continue;
        int e1, e2; cls_experts(cls, e1, e2);
        const half_t* W1 = p->Wt_d + ((size_t)(l * 16 + e1) * 1024 + nt * 128) * 256;
        const half_t* W2 = p->Wt_d + ((size_t)(l * 16 + e2) * 1024 + nt * 128) * 256;
        const int* lst = p->lists + (size_t)cls * T_TOK + pos0;
        const int nvalid = nc - pos0;
        int tokS[8];
        {
            const int r0 = TID() >> 4;
#pragma unroll
            for (int it = 0; it < 8; ++it) { const int row = it * 16 + r0; tokS[it] = lst[row < nvalid ? row : 0]; }
        }
        gemm_tile(lds, 8,
            [&](int kt, int row) { return (kt < 4 ? W1 : W2) + (size_t)row * 256 + (kt & 3) * 64; },
            [&](int row) { const int tok = lst[row < nvalid ? row : 0]; return p->act + (size_t)tok * 512; },
            [&](f16v (&acc)[2][2], int wn, int wm, int lane) {
                const int hh = lane >> 5, tid = TID();
                float* stg = (float*)lds;
                __syncthreads();
#pragma unroll
                for (int j = 0; j < 2; ++j)
#pragma unroll
                    for (int i = 0; i < 2; ++i)
#pragma unroll
                        for (int g = 0; g < 4; ++g)
                            *(float4*)(stg + (wm * 64 + j * 32 + (lane & 31)) * 132 + wn * 64 + i * 32 + 8 * g + 4 * hh) =
                                make_float4(acc[i][j][4 * g], acc[i][j][4 * g + 1], acc[i][j][4 * g + 2], acc[i][j][4 * g + 3]);
                __syncthreads();
                const int r0 = tid >> 4, c8 = (tid & 15) * 8;
                const int n = nt * 128 + c8;
                h8 xi[8]; float4 g0[8], g1[8];
#pragma unroll
                for (int it = 0; it < 8; ++it) {
                    const int tok = tokS[it];
                    const float* gp = g2 + (size_t)(tok >> 11) * 6144 + n;
                    xi[it] = *(const h8*)(p->xr + (size_t)tok * DM + n);
                    g0[it] = *(const float4*)gp; g1[it] = *(const float4*)(gp + 4);
                }
#pragma unroll
                for (int it = 0; it < 8; ++it) {
                    const int row = it * 16 + r0;
                    const float4 a0 = *(const float4*)(stg + row * 132 + c8), a1 = *(const float4*)(stg + row * 132 + c8 + 4);
                    h8 o;
                    o[0] = (half_t)((float)xi[it][0] + gsc * g0[it].x * a0.x); o[1] = (half_t)((float)xi[it][1] + gsc * g0[it].y * a0.y);
                    o[2] = (half_t)((float)xi[it][2] + gsc * g0[it].z * a0.z); o[3] = (half_t)((float)xi[it][3] + gsc * g0[it].w * a0.w);
                    o[4] = (half_t)((float)xi[it][4] + gsc * g1[it].x * a1.x); o[5] = (half_t)((float)xi[it][5] + gsc * g1[it].y * a1.y);
                    o[6] = (half_t)((float)xi[it][6] + gsc * g1[it].z * a1.z); o[7] = (half_t)((float)xi[it][7] + gsc * g1[it].w * a1.w);
                    if (row < nvalid) *(h8*)(p->xr + (size_t)tokS[it] * DM + n) = o;
                }
            });
    }
}

__device__ __forceinline__ void dsa_select_unit(KP p, char* lds, int b, int qt) {
    unsigned* hist = (unsigned*)lds;
    unsigned* maskl = hist + 16 * 257 + 16;
    unsigned* stP = maskl + 1024;
    unsigned* stNeed = stP + 16;
    unsigned* stDone = stNeed + 16;
    unsigned* flag = stDone + 16;
    unsigned* dummyb = flag + 16;
    const int tid = TID(), lane = tid & 63, wave = tid >> 6;
    const int q0 = qt * 16, tokbase = b * SEQ;
    __syncthreads();
    if (q0 < 256) {
        for (int i = tid; i < 1024; i += 256) {
            const int q = i >> 6, wd = i & 63;
            const int n = q0 + q + 1 - 32 * wd;
            const unsigned w = n >= 32 ? 0xFFFFFFFFu : (n <= 0 ? 0u : ((1u << n) - 1u));
            p->dmask[(size_t)(tokbase + q0 + q) * 64 + wd] = w;
        }
        return;
    }
    for (int i = tid; i < 1024; i += 256) maskl[i] = 0u;
    if (tid < 16) { stP[tid] = 0u; stNeed[tid] = 256u; stDone[tid] = 0u; }
    for (int i = tid; i < 16 * 257; i += 256) hist[i] = 0u;
    __syncthreads();
    const int ql = lane & 15, fq = lane >> 4;
    const int tq = q0 + ql;
    const half_t* Pb = p->P + (size_t)tokbase * NP;
    h8 iqf[4];
#pragma unroll
    for (int hd = 0; hd < 4; ++hd) iqf[hd] = *(const h8*)(Pb + (size_t)tq * NP + PC_IQ + hd * 32 + 8 * fq);
    const float4 iw4 = *(const float4*)(p->iwf + (size_t)(tokbase + tq) * 4);
    const float wsc0 = iw4.x * 0.08838834764831845f, wsc1 = iw4.y * 0.08838834764831845f, wsc2 = iw4.z * 0.08838834764831845f, wsc3 = iw4.w * 0.08838834764831845f;
    const int ng = qt + 1;
    unsigned sc[32][4];
    const half_t* ikp = Pb + (size_t)ql * NP + PC_IK + 8 * fq;
#pragma unroll
    for (int gb = 0; gb < 4; ++gb) {
        h8 ik[8];
#pragma unroll
        for (int x = 0; x < 8; ++x) {
            int g = wave + 4 * (gb * 8 + x);
            g = g < ng ? g : ng - 1;
            ik[x] = *(const h8*)(ikp + (size_t)(16 * g) * NP);
        }
#pragma unroll
        for (int x = 0; x < 8; ++x) {
            const int gi = gb * 8 + x;
            const int g = wave + 4 * gi;
            const f4v z = {0.f, 0.f, 0.f, 0.f};
            const f4v c0 = __builtin_amdgcn_mfma_f32_16x16x32_f16(ik[x], iqf[0], z, 0, 0, 0);
            const f4v c1 = __builtin_amdgcn_mfma_f32_16x16x32_f16(ik[x], iqf[1], z, 0, 0, 0);
            const f4v c2 = __builtin_amdgcn_mfma_f32_16x16x32_f16(ik[x], iqf[2], z, 0, 0, 0);
            const f4v c3 = __builtin_amdgcn_mfma_f32_16x16x32_f16(ik[x], iqf[3], z, 0, 0, 0);
#pragma unroll
            for (int r = 0; r < 4; ++r) {
                const int j = 16 * g + 4 * fq + r;
                float sv = wsc0 * __builtin_amdgcn_fmed3f(c0[r], 0.f, INFINITY);
                sv = fmaf(wsc1, __builtin_amdgcn_fmed3f(c1[r], 0.f, INFINITY), sv);
                sv = fmaf(wsc2, __builtin_amdgcn_fmed3f(c2[r], 0.f, INFINITY), sv);
                sv = fmaf(wsc3, __builtin_amdgcn_fmed3f(c3[r], 0.f, INFINITY), sv);
                sv += 0.0f;
                const int sb = __float_as_int(sv);
                const unsigned su = (unsigned)sb ^ ((unsigned)(sb >> 31) | 0x80000000u);
                const unsigned ck = (su & 0xFFFFF800u) | (unsigned)(2047 - j);
                sc[gi][r] = (g < ng && j <= tq) ? ck : 0u;
            }
            if (g < ng) {
#pragma unroll
                for (int r = 0; r < 4; ++r) atomicAdd(hist + ql * 257 + (sc[gi][r] >> 24), 1u);
            }
        }
    }
    bool alldone = false;
    for (int pass = 0; pass < 5; ++pass) {
        const bool fin = alldone;
        if (!fin && pass > 0) { for (int i = tid; i < 16 * 257; i += 256) hist[i] = 0u; }
        if (tid == 0) *flag = 0u;
        __syncthreads();
        if (pass > 0) {
        const unsigned sP = stP[ql], sDone = stDone[ql];
        int wv = wave, fqv = fq;
        asm volatile("" : "+v"(wv), "+v"(fqv));
        if (fin) {
            const int sh = (int)(32u - 8u * (sDone ? sDone : 1u));
            unsigned* mrow = maskl + ql * 64;
#pragma unroll
            for (int gi = 0; gi < 32; ++gi) {
                const int g = wv + 4 * gi;
                unsigned nib = 0u;
#pragma unroll
                for (int r = 0; r < 4; ++r) {
                    const unsigned uu = sc[gi][r];
                    nib |= ((uu >> sh) >= sP) ? (1u << r) : 0u;
                }
                if (g < ng) atomicOr(&mrow[g >> 1], nib << ((g & 1) * 16 + 4 * fqv));
            }
        } else {
            const int shm = pass ? 32 - 8 * pass : 0, shd = 24 - 8 * pass;
            const unsigned orm = pass ? 0u : 0xFFFFFFFFu;
            const unsigned cmpv = pass ? (sDone == 0u ? sP : 0xFFFFFFFFu) : 0xFFFFFFFFu;
            unsigned* hrow = hist + ql * 257;
            unsigned* dummy = dummyb + lane;
#pragma unroll
            for (int gi = 0; gi < 32; ++gi) {
                const int g = wv + 4 * gi;
                if (g < ng) {
#pragma unroll
                    for (int r = 0; r < 4; ++r) {
                        const unsigned uu = sc[gi][r];
                        const bool match = (((uu >> shm) | orm) == cmpv);
                        const unsigned dig = (uu >> shd) & 255u;
                        unsigned* a = match ? hrow + dig : dummy;
                        atomicAdd(a, 1u);
                    }
                }
            }
        }
        }
        __syncthreads();
        if (fin) break;
        {
            const int qq = tid >> 4, seg = tid & 15;
            const bool active = (stDone[qq] == 0u);
            unsigned c16 = 0u;
            if (active) {
#pragma unroll
                for (int d = 0; d < 16; ++d) c16 += hist[qq * 257 + seg * 16 + d];
            }
            unsigned v = c16;
#pragma unroll
            for (int off = 1; off < 16; off <<= 1) { const unsigned t = __shfl_down(v, off, 16); if (seg + off < 16) v += t; }
            const unsigned suf = v - c16;
            const unsigned need = stNeed[qq];
            if (active && suf < need && need <= suf + c16) {
                unsigned run = suf, D = 0u, cD = 0u, nn = need;
                for (int d = 15; d >= 0; --d) {
                    const unsigned cc = hist[qq * 257 + seg * 16 + d];
                    if (run + cc >= need) { D = (unsigned)(seg * 16 + d); cD = cc; nn = need - run; break; }
                    run += cc;
                }
                const bool done = (cD == nn) || pass == 3;
                stP[qq] = (stP[qq] << 8) | D; stNeed[qq] = nn;
                if (done) stDone[qq] = (unsigned)(pass + 1); else atomicAdd(flag, 1u);
            }
        }
        __syncthreads();
        alldone = (*flag == 0u);
    }
    for (int i = tid; i < 1024; i += 256) p->dmask[(size_t)(tokbase + q0 + (i >> 6)) * 64 + (i & 63)] = maskl[i];
}

__device__ __forceinline__ void conv_unit(KP p, char* lds, int l, int b, int c) {
    float* red = (float*)lds;
    const int ch = TID(), lane = ch & 63, wave = ch >> 6;
    const int t0 = c * 32, tokbase = b * SEQ;
    half_t* tile = (half_t*)(lds + 4096);
    __syncthreads();
    {
        h8 vt[8];
#pragma unroll
        for (int it = 0; it < 8; ++it) {
            int i = it * 256 + ch; i = i < 62 * 32 ? i : 62 * 32 - 1;
            const int rr = i >> 5, c16 = i & 31;
            int tt = t0 - 30 + rr; tt = tt >= 0 ? tt : 0;
            vt[it] = *(const h8*)(p->P + (size_t)(tokbase + tt) * NP + c16 * 8);
        }
#pragma unroll
        for (int it = 0; it < 8; ++it) {
            const int i = it * 256 + ch;
            if (i < 62 * 32) {
                const int rr = i >> 5, c16 = i & 31;
                h8 v = vt[it];
                if (t0 - 30 + rr < 0) {
#pragma unroll
                    for (int j = 0; j < 8; ++j) v[j] = (half_t)0.f;
                }
                *(h8*)(tile + rr * 256 + c16 * 8) = v;
            }
        }
    }
    __syncthreads();
    float aw[62];
#pragma unroll
    for (int rr = 0; rr < 62; ++rr) aw[rr] = (float)tile[rr * 256 + ch];
    float w[31];
#pragma unroll
    for (int i = 0; i < 31; ++i) w[i] = p->w_dw[(l * 31 + i) * 256 + ch];
    const float bias = p->b_dw[l * 256 + ch];
    float y[32], s1[32], s2[32];
#pragma unroll
    for (int tk = 0; tk < 32; ++tk) {
        float sacc = bias;
#pragma unroll
        for (int i = 0; i < 31; ++i) sacc = fmaf(aw[tk + i], w[i], sacc);
        y[tk] = sacc; s1[tk] = sacc; s2[tk] = sacc * sacc;
    }
    {
        const bool b5 = lane & 32, b4 = lane & 16, b3 = lane & 8, b2 = lane & 4, b1 = lane & 2;
        float a16[16], c16[16], a8[8], c8[8], a4[4], c4[4], a2[2], c2[2];
#pragma unroll
        for (int e = 0; e < 16; ++e) { a16[e] = (b5 ? s1[e + 16] : s1[e]) + __shfl_xor(b5 ? s1[e] : s1[e + 16], 32); c16[e] = (b5 ? s2[e + 16] : s2[e]) + __shfl_xor(b5 ? s2[e] : s2[e + 16], 32); }
#pragma unroll
        for (int e = 0; e < 8; ++e) { a8[e] = (b4 ? a16[e + 8] : a16[e]) + __shfl_xor(b4 ? a16[e] : a16[e + 8], 16); c8[e] = (b4 ? c16[e + 8] : c16[e]) + __shfl_xor(b4 ? c16[e] : c16[e + 8], 16); }
#pragma unroll
        for (int e = 0; e < 4; ++e) { a4[e] = (b3 ? a8[e + 4] : a8[e]) + __shfl_xor(b3 ? a8[e] : a8[e + 4], 8); c4[e] = (b3 ? c8[e + 4] : c8[e]) + __shfl_xor(b3 ? c8[e] : c8[e + 4], 8); }
#pragma unroll
        for (int e = 0; e < 2; ++e) { a2[e] = (b2 ? a4[e + 2] : a4[e]) + __shfl_xor(b2 ? a4[e] : a4[e + 2], 4); c2[e] = (b2 ? c4[e + 2] : c4[e]) + __shfl_xor(b2 ? c4[e] : c4[e + 2], 4); }
        float av = (b1 ? a2[1] : a2[0]) + __shfl_xor(b1 ? a2[0] : a2[1], 2), cv = (b1 ? c2[1] : c2[0]) + __shfl_xor(b1 ? c2[0] : c2[1], 2);
        av += __shfl_xor(av, 1); cv += __shfl_xor(cv, 1);
        const int tokk = (b5 ? 16 : 0) + (b4 ? 8 : 0) + (b3 ? 4 : 0) + (b2 ? 2 : 0) + (b1 ? 1 : 0);
        __syncthreads();
        if ((lane & 1) == 0) { red[(tokk * 4 + wave) * 2] = av; red[(tokk * 4 + wave) * 2 + 1] = cv; }
        __syncthreads();
    }
    const float lg = p->ln_g[l * 256 + ch], lb = p->ln_b[l * 256 + ch];
#pragma unroll
    for (int tk = 0; tk < 32; ++tk) {
        const float4 ra = *(const float4*)(red + tk * 8), rb = *(const float4*)(red + tk * 8 + 4);
        const float t1 = (ra.x + ra.z) + (rb.x + rb.z);
        const float t2 = (ra.y + ra.w) + (rb.y + rb.w);
        const float mu = t1 * (1.0f / 256.0f);
        float var = t2 * (1.0f / 256.0f) - mu * mu; var = var < 0.f ? 0.f : var;
        float z = (y[tk] - mu) * (1.0f / sqrtf(var + 1e-6f)) * lg + lb;
        z = z * sigmoidf_(z);
        p->ycat[((size_t)(ch >> 5) * T_TOK + tokbase + t0 + tk) * 32 + (ch & 31)] = (half_t)z;
    }
}

__device__ __forceinline__ void kmean_unit(KP p, char* lds, int b, int h, int blk) {
    float* part = (float*)lds;
    const int tid = TID(), c = tid & 7, rg = tid >> 3;
    const half_t* r = p->P + (size_t)(b * SEQ + blk * 256 + rg * 8) * NP + PC_MK + h * 64 + c * 8;
    h8 v[8];
#pragma unroll
    for (int k = 0; k < 8; ++k) v[k] = *(const h8*)(r + (size_t)k * NP);
    float sacc[8];
#pragma unroll
    for (int j = 0; j < 8; ++j) {
        float t = 0.f;
#pragma unroll
        for (int k = 0; k < 8; ++k) t += (float)v[k][j];
        sacc[j] = t;
    }
    __syncthreads();
    *(float4*)(part + rg * 64 + c * 8) = make_float4(sacc[0], sacc[1], sacc[2], sacc[3]);
    *(float4*)(part + rg * 64 + c * 8 + 4) = make_float4(sacc[4], sacc[5], sacc[6], sacc[7]);
    __syncthreads();
    if (tid < 64) {
        float t = 0.f;
#pragma unroll
        for (int g = 0; g < 32; ++g) t += part[g * 64 + tid];
        p->kmean[(((size_t)b * 6 + h) * 8 + blk) * 64 + tid] = t * (1.0f / 256.0f);
    }
}

#ifndef POST_MASK
#define POST_MASK 7
#endif
__device__ __forceinline__ void phase_post(KP p, char* lds, int l, int tm) {
    const int NA = 2048, NB = 1024, NC = 768;
    const int G_ = gridDim.x;
    for (int u0 = BID(), k_ = 0; u0 < NA + NB + NC; u0 += G_, ++k_) {
        int u = u0;
        if (u0 < NA && (k_ & 1) && (k_ + 1) * G_ <= NA) u = k_ * G_ + (G_ - 1 - (u0 - k_ * G_));
        if (u < NA) { if (tm & 1) dsa_select_unit(p, lds, u % 16, 127 - (u / 16)); }
        else if (u < NA + NB) { const int v = u - NA; if (tm & 2) conv_unit(p, lds, l, v % 16, v / 16); }
        else { const int v = u - NA - NB; if (tm & 4) kmean_unit(p, lds, v / 48, (v / 8) % 6, v % 8); }
    }
}

template <int MODE>
__device__ __forceinline__ void attn_unit(KP p, char* lds, int b, int h, int qt) {
    const int tid = TID(), lane = tid & 63, wave = tid >> 6, hh = lane >> 5, ql = lane & 31;
    const int q0 = qt * 128, tokbase = b * SEQ;
    const int tq = q0 + wave * 32 + ql;
    const half_t* Pb = p->P + (size_t)tokbase * NP;
    const int QOFF = MODE ? PC_MQ + h * 64 : PC_DQ + h * 64;
    const int KOFF = MODE ? PC_MK + h * 64 : PC_DK;
    const int VOFF = MODE ? PC_MV + h * 64 : PC_DV;
    const int own = qt >> 1;
    unsigned mysel = 0u, anysel = 0u;
    __syncthreads();
    h8 qf[4];
#pragma unroll
    for (int ks = 0; ks < 4; ++ks) qf[ks] = *(const h8*)(Pb + (size_t)tq * NP + QOFF + 16 * ks + 8 * hh);
    if (MODE == 1) {
        float* km = (float*)(lds + 32768);
        unsigned* anyb = (unsigned*)(km + 512);
        for (int i = tid; i < 512; i += 256) km[i] = p->kmean[((size_t)b * 6 + h) * 512 + i];
        if (tid == 0) *anyb = 0u;
        __syncthreads();
        float gt[8];
#pragma unroll
        for (int j = 0; j < 8; ++j) {
            float sacc = 0.f;
            if (j < own) {
#pragma unroll
                for (int ks = 0; ks < 4; ++ks) {
                    const float4 k0 = *(const float4*)(km + j * 64 + 16 * ks + 8 * hh), k1 = *(const float4*)(km + j * 64 + 16 * ks + 8 * hh + 4);
                    sacc = fmaf((float)qf[ks][0], k0.x, sacc); sacc = fmaf((float)qf[ks][1], k0.y, sacc); sacc = fmaf((float)qf[ks][2], k0.z, sacc); sacc = fmaf((float)qf[ks][3], k0.w, sacc);
                    sacc = fmaf((float)qf[ks][4], k1.x, sacc); sacc = fmaf((float)qf[ks][5], k1.y, sacc); sacc = fmaf((float)qf[ks][6], k1.z, sacc); sacc = fmaf((float)qf[ks][7], k1.w, sacc);
                }
            }
            gt[j] = sacc + __shfl_xor(sacc, 32);
        }
        unsigned m = 0u;
        const int want = own < 3 ? own : 3;
#pragma unroll
        for (int r = 0; r < 3; ++r) {
            if (r < want) {
                int best = -1; float bv = -INFINITY;
#pragma unroll
                for (int j = 0; j < 8; ++j) { if (j < own && !((m >> j) & 1u) && (best < 0 || gt[j] > bv)) { best = j; bv = gt[j]; } }
                m |= 1u << best;
            }
        }
        mysel = m;
        unsigned wmk = m;
#pragma unroll
        for (int o = 16; o >= 1; o >>= 1) wmk |= (unsigned)__shfl_xor((int)wmk, o);
        if (lane == 0 && wmk) atomicOr(anyb, wmk);
        __syncthreads();
        anysel = *anyb;
    }
    f16v O0, O1;
#pragma unroll
    for (int r = 0; r < 16; ++r) { O0[r] = 0.f; O1[r] = 0.f; }
    float l_run = 0.f;
    bool unset = true;
    f16v negm;
#pragma unroll
    for (int r = 0; r < 16; ++r) negm[r] = 0.f;
    const float THR = 8.0f;
    const int ntile = 2 * qt + 2;
    auto skip = [&](int kt) -> bool { return MODE == 1 && kt < 4 * own && !((anysel >> (kt >> 2)) & 1u); };
    auto nexttile = [&](int kt) -> int { ++kt; while (kt < ntile && skip(kt)) ++kt; return kt; };
    const int lrow = tid >> 3;
    const int kchunk = (tid & 7) ^ ((tid >> 4) & 7);
    const int vchunk = (tid & 7) ^ (((tid >> 4) & 1) << 2);
    char* ldst = lds + lrow * 128 + (tid & 7) * 16;
    auto issue = [&](int kt, int s) {
        const half_t* src = Pb + (size_t)(kt * 64 + lrow) * NP;
        char* d = ldst + s * 16384;
        glds16(src + KOFF + kchunk * 8, d);
        glds16(src + (size_t)32 * NP + KOFF + kchunk * 8, d + 4096);
        glds16(src + VOFF + vchunk * 8, d + 8192);
        glds16(src + (size_t)32 * NP + VOFF + vchunk * 8, d + 8192 + 4096);
    };
    const int rsw = (lane >> 1) & 7;
    const int kro = ql * 128;
    const int li = lane & 15, qp = li >> 2, pp = li & 3, swv = (qp >> 1) & 1;
    const int vb0 = 8192 + (4 * hh + qp) * 128 + 32 * ((lane >> 4) & 1) + 8 * pp + 64 * (0 ^ swv);
    const int vb1 = 8192 + (4 * hh + qp) * 128 + 32 * ((lane >> 4) & 1) + 8 * pp + 64 * (1 ^ swv);
    int kt = -1; kt = nexttile(kt);
    int s = 0;
    if (kt < ntile) issue(kt, 0);
    while (kt < ntile) {
        const int ktn = nexttile(kt);
        asm volatile("s_waitcnt vmcnt(0)" ::: "memory");
        __syncthreads();
        if (ktn < ntile) issue(ktn, s ^ 1);
        const bool wave_active = (kt * 64 <= q0 + wave * 32 + 31);
        if (wave_active) {
            const char* base = lds + s * 16384;
            uint2 mw = make_uint2(0u, 0u);
            if (MODE == 0) mw = *(const uint2*)(p->dmask + (size_t)(tokbase + tq) * 64 + 2 * kt);
            h8 vf0[4], vf1[4];
#pragma unroll
            for (int kk = 0; kk < 4; ++kk) {
                const int roff = (32 * (kk >> 1) + 16 * (kk & 1)) * 128;
                const s4v lo0 = __builtin_amdgcn_ds_read_tr16_b64_v4i16((LAS s4v*)(base + vb0 + roff));
                const s4v hi0 = __builtin_amdgcn_ds_read_tr16_b64_v4i16((LAS s4v*)(base + vb0 + roff + 8 * 128));
                const s4v lo1 = __builtin_amdgcn_ds_read_tr16_b64_v4i16((LAS s4v*)(base + vb1 + roff));
                const s4v hi1 = __builtin_amdgcn_ds_read_tr16_b64_v4i16((LAS s4v*)(base + vb1 + roff + 8 * 128));
                vf0[kk] = __builtin_bit_cast(h8, __builtin_shufflevector(lo0, hi0, 0, 1, 2, 3, 4, 5, 6, 7));
                vf1[kk] = __builtin_bit_cast(h8, __builtin_shufflevector(lo1, hi1, 0, 1, 2, 3, 4, 5, 6, 7));
            }
            bool lane_on = true;
            if (MODE == 1 && kt < 4 * own) lane_on = (mysel >> (kt >> 2)) & 1u;
            f16v cin = negm;
            if (MODE == 1 && kt < 4 * own) {
#pragma unroll
                for (int r = 0; r < 16; ++r) cin[r] = lane_on ? negm[r] : -INFINITY;
            }
            f16v s0 = cin, s1 = cin;
#pragma unroll
            for (int ks = 0; ks < 4; ++ks) {
                const int co = ((2 * ks + hh) ^ rsw) << 4;
                const h8 k0 = *(const h8*)(base + kro + co), k1 = *(const h8*)(base + kro + 4096 + co);
                s0 = __builtin_amdgcn_mfma_f32_32x32x16_f16(k0, qf[ks], s0, 0, 0, 0);
                s1 = __builtin_amdgcn_mfma_f32_32x32x16_f16(k1, qf[ks], s1, 0, 0, 0);
            }
            if (MODE == 0) {
                const unsigned w0 = mw.x >> (4 * hh), w1 = mw.y >> (4 * hh);
#pragma unroll
                for (int r = 0; r < 16; ++r) {
                    const int pos = (r & 3) + 8 * (r >> 2);
                    const unsigned m0 = (unsigned)__builtin_amdgcn_sbfe((int)w0, pos, 1), m1 = (unsigned)__builtin_amdgcn_sbfe((int)w1, pos, 1);
                    s0[r] = __uint_as_float((__float_as_uint(s0[r]) & m0) | (0xFF800000u & ~m0));
                    s1[r] = __uint_as_float((__float_as_uint(s1[r]) & m1) | (0xFF800000u & ~m1));
                }
            } else if (kt >= 4 * own && kt * 64 + 63 > q0 + wave * 32) {
#pragma unroll
                for (int r = 0; r < 16; ++r) {
                    const int key = kt * 64 + (r & 3) + 8 * (r >> 2) + 4 * hh;
                    s0[r] = (key <= tq) ? s0[r] : -INFINITY;
                    s1[r] = (key + 32 <= tq) ? s1[r] : -INFINITY;
                }
            }
            float mx = s0[0];
#pragma unroll
            for (int r = 1; r < 16; ++r) mx = fmaxf(mx, s0[r]);
#pragma unroll
            for (int r = 0; r < 16; ++r) mx = fmaxf(mx, s1[r]);
            mx = fmaxf(mx, __shfl_xor(mx, 32));
            const bool need = unset ? (mx > -INFINITY) : (mx > THR);
            if (__any(need)) {
                const float delta = need ? mx : 0.f;
                const float alpha = (need && !unset) ? __builtin_amdgcn_exp2f(-delta) : 1.0f;
#pragma unroll
                for (int r = 0; r < 16; ++r) { s0[r] -= delta; s1[r] -= delta; negm[r] -= delta; O0[r] *= alpha; O1[r] *= alpha; }
                l_run *= alpha;
                unset = unset && !need;
            }
            float ls = 0.f;
#pragma unroll
            for (int r = 0; r < 16; ++r) { s0[r] = __builtin_amdgcn_exp2f(s0[r]); ls += s0[r]; }
#pragma unroll
            for (int r = 0; r < 16; ++r) { s1[r] = __builtin_amdgcn_exp2f(s1[r]); ls += s1[r]; }
            l_run += ls;
#pragma unroll
            for (int kk = 0; kk < 4; ++kk) {
                h8 pf;
#pragma unroll
                for (int j = 0; j < 8; ++j) pf[j] = (half_t)((kk >> 1) ? s1[8 * (kk & 1) + j] : s0[8 * (kk & 1) + j]);
                O0 = __builtin_amdgcn_mfma_f32_32x32x16_f16(vf0[kk], pf, O0, 0, 0, 0);
                O1 = __builtin_amdgcn_mfma_f32_32x32x16_f16(vf1[kk], pf, O1, 0, 0, 0);
            }
        }
        kt = ktn; s ^= 1;
    }
    const float lt = l_run + __shfl_xor(l_run, 32);
    const float inv = 1.0f / lt;
    const int ycol = (MODE ? 640 : 256) + h * 64;
    half_t* dst = p->ycat + ((size_t)(ycol >> 5) * T_TOK + tokbase + tq) * 32 + 4 * hh;
#pragma unroll
    for (int g = 0; g < 4; ++g) {
        *(h4*)(dst + 8 * g) = pack4(O0[4 * g] * inv, O0[4 * g + 1] * inv, O0[4 * g + 2] * inv, O0[4 * g + 3] * inv);
        *(h4*)(dst + (size_t)T_TOK * 32 + 8 * g) = pack4(O1[4 * g] * inv, O1[4 * g + 1] * inv, O1[4 * g + 2] * inv, O1[4 * g + 3] * inv);
    }
}

#ifndef ATT_MASK
#define ATT_MASK 3
#endif
__device__ __forceinline__ void phase_attn(KP p, char* lds, int tm) {
    const int G_ = gridDim.x, per_ = G_ >> 3;
    const bool snake_ = (G_ >= 8) && ((G_ & 7) == 0);
    for (int k_ = 0, b_ = BID(); snake_ ? (k_ * per_ < 384) : (b_ + k_ * G_ < 3072); ++k_) {
        int xl, Lx;
        if (snake_) { const int idx_ = b_ >> 3; xl = b_ & 7; Lx = k_ * per_ + ((k_ & 1) ? (per_ - 1 - idx_) : idx_); }
        else { const int u = b_ + k_ * G_; xl = u & 7; Lx = u >> 3; }
        if (Lx >= 384) continue;
        const int qt = 15 - (Lx / 24), rem = Lx % 24;
        const int type = rem & 1, bh = xl * 12 + (rem >> 1);
        if (type == 0) { if (tm & 1) attn_unit<0>(p, lds, bh / 6, bh % 6, qt); }
        else { if (tm & 2) attn_unit<1>(p, lds, bh / 6, bh % 6, qt); }
    }
}

__global__ void __launch_bounds__(256, 2) mk_fwd(Params p_unused) {
    extern __shared__ __attribute__((aligned(16))) char lds[];
    volatile LAS unsigned* stw = (volatile LAS unsigned*)(lds + LDS_CTL);
    if (threadIdx.x < 4) stw[threadIdx.x] = 0u;
    __syncthreads();
    KP p0 = (KP)__builtin_amdgcn_kernarg_segment_ptr();
    XcdBarrier bar; bar.bar = p0->bar; bar.x = 0; bar.st = stw;
#if !MK_SPLIT
    bar = xcd_barrier_post(p0->bar, stw);
#endif
    const int ph_lo = p0->ph_lo, ph_hi = p0->ph_hi;
    for (int ph = ph_lo; ph < ph_hi; ++ph) {
      KP p = p0; asm volatile("" : "+s"(p));
      const int nrep = (DUP_SUB >= 0 && ((DUP_SUB == 100 && ph == 0) || (ph >= 2 && ph < NPHASE - 1 && ((ph - 2) & 7) == DUP_SUB && (DUP_SUB != 4 || ph < 10)))) ? 2 : 1;
      for (int rep = 0; rep < nrep; ++rep) {
        if (ph == 0) phase_prologue(p, lds);
        else if (ph == 1) phase_modsum(p);
        else if (ph == NPHASE - 1) phase_norm<2, true>(p, lds, p->xr, p->g_final, nullptr, nullptr, 0);
        else {
            const int l = (ph - 2) >> 3, sub = (ph - 2) & 7;
            const float* mf = p->modf + (size_t)l * 16 * 6144;
            if (sub == 0) { if (l == 0) phase_norm<0, false>(p, lds, p->x, p->g_mix + l * DM, mf, mf + 1024, l); else phase_norm<0, true>(p, lds, p->xr, p->g_mix + l * DM, mf, mf + 1024, l); }
            else if (sub == 1) phase_inproj(p, lds, l);
            else if (sub == 2) phase_post(p, lds, l, rep ? POST_MASK : 7);
            else if (sub == 3) phase_attn(p, lds, rep ? ATT_MASK : 3);
            else if (sub == 4) { if (l == 0) phase_outproj<false>(p, lds, l, p->x); else phase_outproj<true>(p, lds, l, p->xr); }
            else if (sub == 5) phase_norm_router(p, lds, p->xr, p->g_ffn + l * DM, mf + 3 * 1024, mf + 4 * 1024, (nrep == 2 && rep == 0) ? l + 2 : l);
            else if (sub == 6) phase_moe_up(p, lds, l);
            else phase_moe_down(p, lds, l, nrep == 2 ? 0.5f : 1.0f);
        }
      }
#if !MK_SPLIT
        if (ph + 1 < ph_hi) xcd_barrier(bar);
#endif
    }
}

extern "C" void kernel_launch(void* const* d_in, const int* in_sizes, int n_in, void* d_out, int out_size, void* d_ws, size_t ws_size, hipStream_t stream) {
    static int grid = 0;
    if (grid == 0) {
        int dev = 0, cus = 0, per_cu = 0;
        (void)hipGetDevice(&dev);
        (void)hipDeviceGetAttribute(&cus, hipDeviceAttributeMultiprocessorCount, dev);
        (void)hipFuncSetAttribute((const void*)mk_fwd, hipFuncAttributeMaxDynamicSharedMemorySize, LDS_BYTES);
        if (hipOccupancyMaxActiveBlocksPerMultiprocessor(&per_cu, (const void*)mk_fwd, 256, LDS_BYTES) != hipSuccess || per_cu < 1) per_cu = 1;
        (void)hipGetLastError();
        if (per_cu > 2) per_cu = 2;
        grid = cus * per_cu;
        fprintf(stderr, "mk_fwd: cus %d per_cu %d grid %d\n", cus, per_cu, grid);
    }
    Params p{};
    const float** pin = (const float**)&p.x;
    for (int i = 0; i < 18; ++i) pin[i] = (const float*)d_in[i];
    p.out = (float*)d_out;
    char* ws = (char*)d_ws;
    size_t off = 0;
    auto carve = [&](size_t bytes) { void* q = ws + off; off += (bytes + 255) & ~(size_t)255; return q; };
    p.bar = (unsigned*)carve(XCD_BAR_WORDS * 4);
    p.cnt = (int*)carve(4 * 32 * 64 * 4);
    const size_t zero_bytes = off;
    p.Wt_in = (half_t*)carve((size_t)2 * NP * DM * 2);
    p.Wt_o = (half_t*)carve((size_t)2 * DM * DM * 2);
    p.Wt_gu = (half_t*)carve((size_t)2 * 16 * 512 * 1024 * 2);
    p.Wt_d = (half_t*)carve((size_t)2 * 16 * 1024 * 256 * 2);
    p.hn = (half_t*)carve((size_t)T_TOK * DM * 2);
    p.P = (half_t*)carve((size_t)T_TOK * NP * 2);
    p.ycat = (half_t*)carve((size_t)T_TOK * DM * 2);
    p.act = (half_t*)carve((size_t)T_TOK * 512 * 2);
    p.xr = (half_t*)carve((size_t)T_TOK * DM * 2);
    p.modpart = (float*)carve((size_t)8 * 2 * 16 * 6144 * 4);
    p.modf = (float*)carve((size_t)2 * 16 * 6144 * 4);
    p.kmean = (float*)carve((size_t)16 * 6 * 8 * 64 * 4);
    p.rope = (float*)carve((size_t)2048 * 24 * 4);
    p.iwf = (float*)carve((size_t)T_TOK * 4 * 4);
    p.tokw = (float*)carve((size_t)T_TOK * 2 * 4);
    p.dmask = (unsigned*)carve((size_t)T_TOK * 64 * 4);
    p.lists = (int*)carve((size_t)NCLS * T_TOK * 4);
    if (off > ws_size) { fprintf(stderr, "workspace too small: need %zu have %zu\n", off, ws_size); return; }
    (void)hipMemsetAsync(d_ws, 0, zero_bytes, stream);
#if MK_SPLIT
    for (int ph = 0; ph < NPHASE; ++ph) {
        p.ph_lo = ph; p.ph_hi = ph + 1;
        hipLaunchKernelGGL(mk_fwd, dim3(grid), dim3(256), LDS_BYTES, stream, p);
    }
#else
    p.ph_lo = 0; p.ph_hi = NPHASE;
    hipLaunchKernelGGL(mk_fwd, dim3(grid), dim3(256), LDS_BYTES, stream, p);
#endif
}
```

```cpp
#include <hip/hip_runtime.h>
#include <cstdio>
#include <cstdint>

#ifndef MK_SPLIT
#define MK_SPLIT 0
#endif

#define T_TOK 32768
#define DM 1024
#define SEQ 2048
#define INW 2340
#define NP 2432
#define PC_CU 0
#define PC_CG 256
#define PC_DQ 512
#define PC_DK 896
#define PC_DV 960
#define PC_IQ 1024
#define PC_IK 1152
#define PC_IW 1184
#define PC_MQ 1280
#define PC_MK 1664
#define PC_MV 2048
#define LOG_THETA 13.122363377404328f
#define NCLS 24
#define LDS_CTL 73728
#define LDS_BYTES 78336
#define NPHASE 19
#ifndef DUP_SUB
#define DUP_SUB -1
#endif

typedef _Float16 half_t;
typedef _Float16 h8 __attribute__((ext_vector_type(8)));
typedef _Float16 h4 __attribute__((ext_vector_type(4)));
typedef short s4v __attribute__((ext_vector_type(4)));
typedef short s8v __attribute__((ext_vector_type(8)));
typedef float f16v __attribute__((ext_vector_type(16)));
typedef float f4v __attribute__((ext_vector_type(4)));
#define LAS __attribute__((address_space(3)))

struct Params {
    const float *x, *c, *w_ada, *b_ada, *g_mix, *w_in, *w_dw, *b_dw, *ln_g, *ln_b, *w_o, *g_ffn, *w_router, *b_router, *w_gate, *w_up, *w_down, *g_final;
    float* out;
    half_t *Wt_in, *Wt_o, *Wt_gu, *Wt_d, *hn, *P, *ycat, *act, *xr;
    float *modpart, *modf, *kmean, *rope, *iwf, *tokw;
    unsigned* dmask; int* cnt; int* lists; unsigned* bar;
    int ph_lo, ph_hi;
};

#define XB_TMO      128
#define XB_XCNT(j)  (256  + 64 * (j))
#define XB_XSUB(j)  (1280 + 64 * (j))
#define XB_XGEN(j)  (2304 + 64 * (j))
#define XB_TOP      3328
#define XB_TOPGEN   3392
#define XB_CLS      3456
#define XCD_BAR_WORDS 3968
#define XB_SPIN_CAP (1u << 20)
__device__ __forceinline__ unsigned xb_ld(unsigned* p)              { return __hip_atomic_load(p, __ATOMIC_RELAXED, __HIP_MEMORY_SCOPE_AGENT); }
__device__ __forceinline__ unsigned xb_add(unsigned* p, unsigned v) { return __hip_atomic_fetch_add(p, v, __ATOMIC_RELAXED, __HIP_MEMORY_SCOPE_AGENT); }
__device__ __forceinline__ unsigned xb_xcc_id() { return (unsigned)__builtin_amdgcn_s_getreg((3 << 11) | 20) & 0xFu; }
#define XB_SPIN(cond, bar) do { unsigned _sp = 0; while (cond) { __builtin_amdgcn_s_sleep(1); \
    if ((++_sp & 255u) == 0u) { if (xb_ld(&(bar)[XB_TMO])) break; if (_sp > XB_SPIN_CAP) { atomicAdd(&(bar)[XB_TMO], 1u); break; } } } } while (0)
struct XcdBarrier { unsigned* bar; unsigned x; volatile LAS unsigned* st; };
__device__ __forceinline__ XcdBarrier xcd_barrier_post(unsigned* bar, volatile LAS unsigned* st) {
    XcdBarrier b; b.bar = bar; b.x = xb_xcc_id(); b.st = st;
    if (threadIdx.x == 0) {
        (void)__hip_atomic_fetch_or(&bar[XB_CLS + 64 * (blockIdx.x & 7)], 1u << b.x, __ATOMIC_RELAXED, __HIP_MEMORY_SCOPE_AGENT);
        asm volatile("s_waitcnt vmcnt(0)" ::: "memory");
        (void)xb_add(&bar[XB_XCNT(b.x)], 1u);
    }
    return b;
}
__device__ __forceinline__ void xcd_barrier_complete(unsigned* bar, unsigned x, unsigned& nloc, unsigned& nx, bool& uniform) {
    const unsigned G = gridDim.x * gridDim.y * gridDim.z;
    unsigned sum, cnt, mine, sp = 0u;
    for (;;) {
        sum = 0u; cnt = 0u; mine = 0u; uniform = (G & 7u) == 0u;
#pragma unroll
        for (unsigned j = 0; j < 16; ++j) {
            const unsigned c = xb_ld(&bar[XB_XCNT(j)]); sum += c; cnt += (c > 0u) ? 1u : 0u; mine = (j == x) ? c : mine;
            uniform = uniform && (j < 8u ? c == (G >> 3) : c == 0u);
        }
        if (sum == G) {
#pragma unroll
            for (unsigned j = 0; j < 8; ++j) { const unsigned m = xb_ld(&bar[XB_CLS + 64 * j]); uniform = uniform && (m != 0u) && ((m & (m - 1u)) == 0u); }
            uniform = uniform && (xb_ld(&bar[XB_CLS + 64 * (blockIdx.x & 7)]) == (1u << x));
            break;
        }
        __builtin_amdgcn_s_sleep(1);
        if ((++sp & 255u) == 0u) { if (xb_ld(&bar[XB_TMO])) break; if (sp > XB_SPIN_CAP) { atomicAdd(&bar[XB_TMO], 1u); break; } }
    }
    nloc = mine > 0u ? mine : 1u; nx = cnt > 0u ? cnt : 1u;
}
__device__ __forceinline__ void xcd_barrier(const XcdBarrier& b, bool grid = true) {
    asm volatile("s_waitcnt vmcnt(0)" ::: "memory");
    __syncthreads();
    if (threadIdx.x == 0) {
        unsigned* bar = b.bar;
        __builtin_amdgcn_s_waitcnt(0);
        unsigned nloc = b.st[0], nx = b.st[1];
        if (nloc == 0u) {
            bool uniform; xcd_barrier_complete(bar, b.x, nloc, nx, uniform); b.st[0] = nloc; b.st[1] = nx;
            b.st[4] = uniform ? 1u : 0u;
        }
        const bool local = !grid && b.st[4] != 0u;
        const unsigned old = xb_add(&bar[XB_XSUB(b.x)], 1u);
        const unsigned gen = old / nloc;
        if (old + 1u == (gen + 1u) * nloc) {
            if (!local) {
                __builtin_amdgcn_fence(__ATOMIC_RELEASE, "agent");
                asm volatile("s_waitcnt vmcnt(0)" ::: "memory");
            }
            if (!local) {
                const unsigned og = xb_add(&bar[XB_TOP], 1u);
                const unsigned tg = og / nx;
                if (og + 1u == (tg + 1u) * nx) xb_add(&bar[XB_TOPGEN], 1u);
                else XB_SPIN(xb_ld(&bar[XB_TOPGEN]) == tg, bar);
            }
            xb_add(&bar[XB_XGEN(b.x)], 1u);
            __builtin_amdgcn_fence(__ATOMIC_ACQUIRE, "agent");
            asm volatile("s_waitcnt vmcnt(0)" ::: "memory");
        } else {
            __builtin_amdgcn_fence(__ATOMIC_ACQUIRE, "agent");
            XB_SPIN(xb_ld(&bar[XB_XGEN(b.x)]) == gen, bar);
            asm volatile("s_waitcnt vmcnt(0)" ::: "memory");
        }
    }
    __syncthreads();
}

typedef const __attribute__((address_space(4))) Params* KP;
__device__ __forceinline__ int TID() { int t = threadIdx.x; asm volatile("" : "+v"(t)); return t; }
__device__ __forceinline__ int BID() { int b = blockIdx.x; asm volatile("" : "+s"(b)); return b; }
template <int CTRL> __device__ __forceinline__ float dppf(float v) { return __builtin_bit_cast(float, __builtin_amdgcn_update_dpp(0, __builtin_bit_cast(int, v), CTRL, 0xF, 0xF, true)); }
template <int CTRL> __device__ __forceinline__ unsigned dppu(unsigned v) { return (unsigned)__builtin_amdgcn_update_dpp(0, (int)v, CTRL, 0xF, 0xF, true); }
__device__ __forceinline__ float xor1f(float v) { return dppf<0xB1>(v); }
__device__ __forceinline__ float xor2f(float v) { return dppf<0x4E>(v); }
__device__ __forceinline__ float xor4f(float v) { return dppf<0x1B>(dppf<0x141>(v)); }
__device__ __forceinline__ float xor8f(float v) { return dppf<0x128>(v); }
__device__ __forceinline__ void swap32(unsigned& a, unsigned& b) { asm volatile("s_nop 1\n\tv_permlane32_swap_b32 %0, %1" : "+v"(a), "+v"(b)); }
__device__ __forceinline__ void swap16(unsigned& a, unsigned& b) { asm volatile("s_nop 1\n\tv_permlane16_swap_b32 %0, %1" : "+v"(a), "+v"(b)); }
__device__ __forceinline__ float swapsum32(float a, float b) {
    unsigned x = __builtin_bit_cast(unsigned, a), y = __builtin_bit_cast(unsigned, b); swap32(x, y);
    return __builtin_bit_cast(float, x) + __builtin_bit_cast(float, y);
}
__device__ __forceinline__ float swapsum16(float a, float b) {
    unsigned x = __builtin_bit_cast(unsigned, a), y = __builtin_bit_cast(unsigned, b); swap16(x, y);
    return __builtin_bit_cast(float, x) + __builtin_bit_cast(float, y);
}
__device__ __forceinline__ float swapmax32(float v) {
    unsigned x = __builtin_bit_cast(unsigned, v), y = x; swap32(x, y);
    return fmaxf(__builtin_bit_cast(float, x), __builtin_bit_cast(float, y));
}
__device__ __forceinline__ float xor32f(float v, bool upper) {
    unsigned x = __builtin_bit_cast(unsigned, v), y = x; swap32(x, y);
    return __builtin_bit_cast(float, upper ? x : y);
}
__device__ __forceinline__ float wave_sum(float v) {
    v += dppf<0xB1>(v); v += dppf<0x4E>(v); v += dppf<0x141>(v); v += dppf<0x140>(v);
    v = swapsum16(v, v);
    return swapsum32(v, v);
}
__device__ __forceinline__ unsigned wave_or(unsigned v) {
    v |= dppu<0xB1>(v); v |= dppu<0x4E>(v); v |= dppu<0x141>(v); v |= dppu<0x140>(v);
    { unsigned x = v, y = v; swap16(x, y); v = x | y; }
    { unsigned x = v, y = v; swap32(x, y); v = x | y; }
    return v;
}
__device__ __forceinline__ float relu_(float v) { const int b = __builtin_bit_cast(int, v); return __builtin_bit_cast(float, b > 0 ? b : 0); }
__device__ __forceinline__ float sigmoidf_(float v) { return __builtin_amdgcn_rcpf(1.0f + __expf(-v)); }
__device__ __forceinline__ void glds16(const void* g, char* l) { __builtin_amdgcn_global_load_lds((const unsigned*)g, (unsigned*)l, 16, 0, 0); }
__device__ __forceinline__ unsigned f2sortable(float f) { unsigned u = __float_as_uint(f); return (u & 0x80000000u) ? ~u : (u | 0x80000000u); }
template <bool HIN> __device__ __forceinline__ float4 ldx4(const void* base, size_t idx) {
    if (HIN) { const h4 t = *(const h4*)((const half_t*)base + idx); return make_float4((float)t[0], (float)t[1], (float)t[2], (float)t[3]); }
    return *(const float4*)((const float*)base + idx);
}
__device__ __forceinline__ h4 pack4(float a, float b, float c, float d) { h4 r = {(half_t)a, (half_t)b, (half_t)c, (half_t)d}; return r; }

template <class CF>
__device__ __forceinline__ void conv_tile_panel(char* lds, CF colf, int src_ld, int k0, int n0, half_t* dst, int nrows) {
    float* tl = (float*)lds;
    const int tid = TID();
    __syncthreads();
    {
        const int nn = tid & 63;
        const float* cp = colf(nn);
        float tv[16];
#pragma unroll
        for (int i = 0; i < 16; ++i) { const int k = i * 4 + (tid >> 6); tv[i] = cp ? cp[(size_t)(k0 + k) * src_ld] : 0.f; }
#pragma unroll
        for (int i = 0; i < 16; ++i) { const int k = i * 4 + (tid >> 6); tl[k * 65 + nn] = tv[i]; }
    }
    __syncthreads();
    {
        const int n = tid >> 2, kq = (tid & 3) * 16;
        h8 a, b;
#pragma unroll
        for (int j = 0; j < 8; ++j) { a[j] = (half_t)tl[(kq + j) * 65 + n]; b[j] = (half_t)tl[(kq + 8 + j) * 65 + n]; }
        const int k = k0 + kq;
        h8* d = (h8*)(dst + ((size_t)(k >> 5) * nrows + n0 + n) * 32 + (k & 31));
        d[0] = a; d[1] = b;
    }
}
template <class CF>
__device__ __forceinline__ void conv_tile(char* lds, CF colf, int src_ld, int k0, half_t* dst_tile  , int dstK) {
    float* tl = (float*)lds;
    const int tid = TID();
    __syncthreads();
    {
        const int nn = tid & 63;
        const float* cp = colf(nn);
        float tv[16];
#pragma unroll
        for (int i = 0; i < 16; ++i) { const int k = i * 4 + (tid >> 6); tv[i] = cp ? cp[(size_t)(k0 + k) * src_ld] : 0.f; }
#pragma unroll
        for (int i = 0; i < 16; ++i) { const int k = i * 4 + (tid >> 6); tl[k * 65 + nn] = tv[i]; }
    }
    __syncthreads();
    {
        const int n = tid >> 2, kq = (tid & 3) * 16;
        h8 a, b;
#pragma unroll
        for (int j = 0; j < 8; ++j) { a[j] = (half_t)tl[(kq + j) * 65 + n]; b[j] = (half_t)tl[(kq + 8 + j) * 65 + n]; }
        h8* d = (h8*)(dst_tile + (size_t)n * dstK + kq);
        d[0] = a; d[1] = b;
    }
}

__device__ __forceinline__ void phase_prologue(KP p, char* lds) {
    const int tid = TID();
    const int NA = 2 * 16 * 38, NB = 2 * 16 * 16, NC = 2 * 16 * 16 * 8, ND = 2 * 16 * 4 * 16, NE = 384, NF = 8;
    const int total = NA + NB + NC + ND + NE + NF;
    for (int u0 = BID(); u0 < total; u0 += gridDim.x) {
        int u = u0;
        if (u < NA) {
            const int nt = u % 38, kt = (u / 38) % 16, l = u / (38 * 16);
            const float* src = p->w_in + (size_t)l * DM * INW;
            const int n0 = nt * 64;
            conv_tile_panel(lds, [&](int nn) -> const float* { const int np = n0 + nn; const int sc = np < 512 ? (((np & 63) < 32) ? 32 * (np >> 6) + (np & 31) : 256 + 32 * (np >> 6) + (np & 31)) : (np < 1188 ? np : (np < 1280 ? -1 : np - 92)); return sc >= 0 ? src + sc : (const float*)nullptr; },
                      INW, kt * 64, n0, p->Wt_in + (size_t)l * NP * DM, NP);
            continue;
        }
        u -= NA;
        if (u < NB) {
            const int nt = u % 16, kt = (u / 16) % 16, l = u / 256;
            const float* src = p->w_o + (size_t)l * DM * DM + nt * 64;
            conv_tile_panel(lds, [&](int nn) -> const float* { return src + nn; }, DM, kt * 64, nt * 64, p->Wt_o + (size_t)l * DM * DM, DM);
            continue;
        }
        u -= NB;
        if (u < NC) {
            const int nt = u % 8, kt = (u / 8) % 16, le = u / 128;
            const float* sg = p->w_gate + (size_t)le * 1024 * 256 + nt * 32;
            const float* su = p->w_up + (size_t)le * 1024 * 256 + nt * 32;
            conv_tile(lds, [&](int nn) -> const float* { return nn < 32 ? sg + nn : su + (nn - 32); }, 256, kt * 64, p->Wt_gu + ((size_t)le * 512 + nt * 64) * 1024 + kt * 64, 1024);
            continue;
        }
        u -= NC;
        if (u < ND) {
            const int nt = u % 16, kt = (u / 16) % 4, le = u / 64;
            const float* src = p->w_down + (size_t)le * 256 * 1024 + nt * 64;
            conv_tile(lds, [&](int nn) -> const float* { return src + nn; }, 1024, kt * 64, p->Wt_d + ((size_t)le * 1024 + nt * 64) * 256 + kt * 64, 256);
            continue;
        }
        u -= ND;
        if (u < NE) {
            const int kc = u % 8, cc = (u / 8) % 24, l = u / 192;
            float* ca = (float*)lds;
            __syncthreads();
            for (int i = tid; i < 2048; i += 256) { const int b = i >> 7, k = i & 127; const float v = p->c[b * 1024 + kc * 128 + k]; ca[i] = v / (1.0f + expf(-v)); }
            __syncthreads();
            const int n = cc * 256 + tid;
            float acc[16];
#pragma unroll
            for (int b = 0; b < 16; ++b) acc[b] = 0.f;
            const float* w = p->w_ada + ((size_t)l * 1024 + kc * 128) * 6144 + n;
            for (int k0 = 0; k0 < 128; k0 += 32) {
                float wv[32];
#pragma unroll
                for (int j = 0; j < 32; ++j) wv[j] = w[(size_t)(k0 + j) * 6144];
                __builtin_amdgcn_sched_barrier(0);
#pragma unroll
                for (int j4 = 0; j4 < 8; ++j4) {
#pragma unroll
                    for (int b = 0; b < 16; ++b) {
                        const float4 c4 = *(const float4*)(ca + b * 128 + k0 + 4 * j4);
                        acc[b] = fmaf(c4.x, wv[4 * j4], fmaf(c4.y, wv[4 * j4 + 1], fmaf(c4.z, wv[4 * j4 + 2], fmaf(c4.w, wv[4 * j4 + 3], acc[b]))));
                    }
                }
                __builtin_amdgcn_sched_barrier(0);
            }
#pragma unroll
            for (int b = 0; b < 16; ++b) p->modpart[(((size_t)kc * 2 + l) * 16 + b) * 6144 + n] = acc[b];
            continue;
        }
        u -= NE;
        {
            for (int i = u * 256 + tid; i < 2048 * 12; i += NF * 256) {
                const int t = i / 12, r = i % 12;
                const int fi = r < 8 ? r : r - 8;
                const float rot = r < 8 ? 16.f : 8.f;
                const float inv = expf(-LOG_THETA * ((float)fi * 2.0f / rot));
                const float ang = (float)t * inv;
                float sn, cs; sincosf(ang, &sn, &cs);
                if (r < 8) { p->rope[t * 8 + fi] = cs; p->rope[16384 + t * 8 + fi] = sn; }
                else { p->rope[32768 + t * 4 + fi] = cs; p->rope[32768 + 8192 + t * 4 + fi] = sn; }
            }
        }
    }
}

__device__ __forceinline__ void phase_modsum(KP p) {
    const int G_ = gridDim.x, per_ = (G_ & 7) ? G_ : (G_ >> 3);
    const int x_ = (G_ & 7) ? 0 : (BID() & 7), rk_ = (G_ & 7) ? BID() : (BID() >> 3);
    const int nitem_ = (G_ & 7) ? 2 * 16 * 6144 : 4 * 6144;
    for (int i0 = rk_ * 256 + TID(); i0 < nitem_; i0 += per_ * 256) {
        int i = i0;
        if (!(G_ & 7)) { const int lb = i0 / 6144; i = ((lb >> 1) * 16 + 2 * x_ + (lb & 1)) * 6144 + (i0 % 6144); }
        const int n = i % 6144, l = i / (16 * 6144);
        float s = p->b_ada[l * 6144 + n];
#pragma unroll
        for (int kc = 0; kc < 8; ++kc) s += p->modpart[(size_t)kc * (2 * 16 * 6144) + i];
        p->modf[i] = s;
    }
}

__device__ __forceinline__ void route_flush(KP p, char* lds, int lane, int wave, int n, int myrow, int layer) {
    const float* lg = (const float*)(lds + LDS_CTL + 512) + wave * 256;
    int* lc = (int*)(lds + LDS_CTL + 64);
    int* lbase = lc + 32;
    const int tid = wave * 64 + lane;
    if (tid < 32) lc[tid] = 0;
    __syncthreads();
    int cls = 0, lpos = 0;
    if (lane < n) {
        float aff[16], bia[16];
#pragma unroll
        for (int e = 0; e < 16; ++e) { aff[e] = 1.0f / (1.0f + expf(-lg[lane * 16 + e])); bia[e] = aff[e] + p->b_router[e]; }
        int bestg = 0; float bests = -INFINITY;
#pragma unroll
        for (int gi = 0; gi < 4; ++gi) {
            float m1 = -INFINITY, m2 = -INFINITY;
#pragma unroll
            for (int j = 0; j < 4; ++j) { const float vv = bia[gi * 4 + j]; if (vv > m1) { m2 = m1; m1 = vv; } else if (vv > m2) m2 = vv; }
            const float s = m1 + m2;
            if (s > bests) { bests = s; bestg = gi; }
        }
        float bsel[4], asel[4];
#pragma unroll
        for (int j = 0; j < 4; ++j) { bsel[j] = 0.f; asel[j] = 0.f; }
#pragma unroll
        for (int gi = 0; gi < 4; ++gi) if (gi == bestg) {
#pragma unroll
            for (int j = 0; j < 4; ++j) { bsel[j] = bia[gi * 4 + j]; asel[j] = aff[gi * 4 + j]; }
        }
        int i1 = -1, i2 = -1; float v1 = -INFINITY, v2 = -INFINITY;
#pragma unroll
        for (int j = 0; j < 4; ++j) { const float vv = bsel[j]; if (vv > v1) { v2 = v1; i2 = i1; v1 = vv; i1 = j; } else if (vv > v2) { v2 = vv; i2 = j; } }
        const int a = i1 < i2 ? i1 : i2, bb = i1 < i2 ? i2 : i1;
        float wa = 0.f, wb = 0.f;
#pragma unroll
        for (int j = 0; j < 4; ++j) { if (j == a) wa = asel[j]; if (j == bb) wb = asel[j]; }
        const float sw = wa + wb;
        const int pi = (a == 0) ? (bb - 1) : (a == 1 ? (bb + 1) : 5);
        cls = bestg * 6 + pi;
        *(float2*)(p->tokw + (size_t)myrow * 2) = make_float2(wa / sw, wb / sw);
        lpos = atomicAdd(&lc[cls], 1);
    }
    __syncthreads();
    if (tid < NCLS) { const int c = lc[tid]; lbase[tid] = c ? atomicAdd(&p->cnt[(layer * 32 + tid) * 64], c) : 0; }
    __syncthreads();
    if (lane < n) p->lists[(size_t)cls * T_TOK + lbase[cls] + lpos] = myrow;
}

template <int MODE, bool HIN, bool PART>
__device__ __forceinline__ void phase_norm(KP p, char* lds, const void* xin, const float* g, const float* sh, const float* sc, int layer) {
    const int lane = TID() & 63, wave = TID() >> 6;
    float* wt = (float*)lds;
    if (MODE == 1) {
        __syncthreads();
        for (int i = TID(); i < 4096; i += 256) {
            const float4 w4 = ((const float4*)p->w_router)[i];
            const int k = i >> 2, e0 = (i & 3) * 4;
            wt[(e0 + 0) * 1024 + k] = w4.x; wt[(e0 + 1) * 1024 + k] = w4.y; wt[(e0 + 2) * 1024 + k] = w4.z; wt[(e0 + 3) * 1024 + k] = w4.w;
        }
        __syncthreads();
    }
    float* lgb = (float*)(lds + LDS_CTL + 512);
    int myrow = 0, it = 0;
    float4 vn[4];
    const int nwv = gridDim.x * 4, rpw = (T_TOK + nwv - 1) / nwv;
    const int vb_ = BID(), G8_ = gridDim.x >> 3;
    const int wrun_ = ((gridDim.x & 7) ? vb_ : (vb_ & 7) * G8_ + (vb_ >> 3)) * 4 + wave;
    const int rbeg = wrun_ * rpw, rend = rbeg + rpw < T_TOK ? rbeg + rpw : T_TOK;
    {
        const size_t xo = (size_t)(rbeg < T_TOK ? rbeg : 0) * DM;
#pragma unroll
        for (int i = 0; i < 4; ++i) vn[i] = ldx4<HIN>(xin, xo + (lane + 64 * i) * 4);
    }
    float4 ggr[4], s1r[4], s2r[4];
#pragma unroll
    for (int i = 0; i < 4; ++i) { ggr[i] = *(const float4*)(g + (lane + 64 * i) * 4); s1r[i] = make_float4(0.f, 0.f, 0.f, 0.f); s2r[i] = s1r[i]; }
    int bcur = -1;
    for (int row = rbeg; row < rend; ++row) {
        const int b = row >> 11;
        if (MODE != 2 && b != bcur) {
            bcur = b;
#pragma unroll
            for (int i = 0; i < 4; ++i) {
                const int k = (lane + 64 * i) * 4;
                if (PART) {
                    float4 a = *(const float4*)(p->b_ada + k), c = *(const float4*)(p->b_ada + 1024 + k);
#pragma unroll
                    for (int kc = 0; kc < 8; ++kc) {
                        const float* mp = p->modpart + (size_t)kc * (2 * 16 * 6144) + (size_t)b * 6144 + k;
                        const float4 pa = *(const float4*)mp, pc = *(const float4*)(mp + 1024);
                        a.x += pa.x; a.y += pa.y; a.z += pa.z; a.w += pa.w; c.x += pc.x; c.y += pc.y; c.z += pc.z; c.w += pc.w;
                    }
                    s1r[i] = a; s2r[i] = c;
                } else { s1r[i] = *(const float4*)(sh + (size_t)b * 6144 + k); s2r[i] = *(const float4*)(sc + (size_t)b * 6144 + k); }
            }
        }
        float4 v[4]; float ss = 0.f;
#pragma unroll
        for (int i = 0; i < 4; ++i) v[i] = vn[i];
        {
            const int rown = row + 1;
            const size_t xo = (size_t)(rown < rend ? rown : row) * DM;
#pragma unroll
            for (int i = 0; i < 4; ++i) vn[i] = ldx4<HIN>(xin, xo + (lane + 64 * i) * 4);
        }
#pragma unroll
        for (int i = 0; i < 4; ++i) ss += v[i].x * v[i].x + v[i].y * v[i].y + v[i].z * v[i].z + v[i].w * v[i].w;
        ss = wave_sum(ss);
        const float rstd = 1.0f / sqrtf(ss * (1.0f / 1024.0f) + 1e-6f);
        float acc[16], ya[16];
#pragma unroll
        for (int i = 0; i < 4; ++i) {
            const int k = (lane + 64 * i) * 4;
            const float4 gg = ggr[i];
            float y[4] = {v[i].x * rstd * gg.x, v[i].y * rstd * gg.y, v[i].z * rstd * gg.z, v[i].w * rstd * gg.w};
            if (MODE != 2) {
                const float4 s1 = s1r[i], s2 = s2r[i];
                y[0] = y[0] * (1.f + s2.x) + s1.x; y[1] = y[1] * (1.f + s2.y) + s1.y; y[2] = y[2] * (1.f + s2.z) + s1.z; y[3] = y[3] * (1.f + s2.w) + s1.w;
                if (MODE == 0) *(h4*)(p->hn + ((size_t)(k >> 5) * T_TOK + row) * 32 + (k & 31)) = pack4(y[0], y[1], y[2], y[3]);
                else *(h4*)(p->hn + (size_t)row * DM + k) = pack4(y[0], y[1], y[2], y[3]);
            } else {
                typedef float f4nt_ __attribute__((ext_vector_type(4)));
                f4nt_ o4; o4.x = y[0]; o4.y = y[1]; o4.z = y[2]; o4.w = y[3];
                __builtin_nontemporal_store(o4, (f4nt_*)(p->out + (size_t)row * DM + k));
            }
            ya[4 * i] = y[0]; ya[4 * i + 1] = y[1]; ya[4 * i + 2] = y[2]; ya[4 * i + 3] = y[3];
        }
        if (MODE == 1) {
#pragma unroll
            for (int e = 0; e < 16; ++e) acc[e] = 0.f;
            float4 wq[2][4];
            const float* wl = wt + lane * 4;
#pragma unroll
            for (int e = 0; e < 4; ++e) wq[0][e] = *(const float4*)(wl + e * 1024);
#pragma unroll
            for (int st = 0; st < 16; ++st) {
                const int i = st >> 2, eg = st & 3, cur = st & 1;
                if (st + 1 < 16) {
                    const int i2 = (st + 1) >> 2, eg2 = (st + 1) & 3;
#pragma unroll
                    for (int e = 0; e < 4; ++e) wq[cur ^ 1][e] = *(const float4*)(wl + (eg2 * 4 + e) * 1024 + i2 * 256);
                }
#pragma unroll
                for (int e = 0; e < 4; ++e) {
                    const float4 w4 = wq[cur][e];
                    acc[eg * 4 + e] = fmaf(ya[4 * i], w4.x, fmaf(ya[4 * i + 1], w4.y, fmaf(ya[4 * i + 2], w4.z, fmaf(ya[4 * i + 3], w4.w, acc[eg * 4 + e]))));
                }
                __builtin_amdgcn_sched_barrier(0);
            }
        }
        if (MODE == 1) {
            const bool b5 = lane & 32, b4 = lane & 16, b3 = lane & 8, b2 = lane & 4;
            float r8[8], r4[4], r2[2];
#pragma unroll
            for (int e = 0; e < 8; ++e) { const float snd = b5 ? acc[e] : acc[e + 8], kp = b5 ? acc[e + 8] : acc[e]; r8[e] = kp + __shfl_xor(snd, 32); }
#pragma unroll
            for (int e = 0; e < 4; ++e) { const float snd = b4 ? r8[e] : r8[e + 4], kp = b4 ? r8[e + 4] : r8[e]; r4[e] = kp + __shfl_xor(snd, 16); }
#pragma unroll
            for (int e = 0; e < 2; ++e) { const float snd = b3 ? r4[e] : r4[e + 2], kp = b3 ? r4[e + 2] : r4[e]; r2[e] = kp + __shfl_xor(snd, 8); }
            float rv; { const float snd = b2 ? r2[0] : r2[1], kp = b2 ? r2[1] : r2[0]; rv = kp + __shfl_xor(snd, 4); }
            rv += __shfl_xor(rv, 2); rv += __shfl_xor(rv, 1);
            if ((lane & 3) == 0) lgb[(wave * 16 + it) * 16 + (lane >> 2)] = rv;
            if (lane == it) myrow = row;
            ++it;
            if (it == 16) { route_flush(p, lds, lane, wave, it, myrow, layer); it = 0; }
        }
    }
    if (MODE == 1 && it > 0) route_flush(p, lds, lane, wave, it, myrow, layer);
}

typedef float f2_t __attribute__((ext_vector_type(2)));
#define NRR 2
__device__ __forceinline__ void phase_norm_router(KP p, char* lds, const half_t* xin, const float* g, const float* sh, const float* sc, int layer) {
    const int lane = TID() & 63, wave = TID() >> 6;
    float* wt = (float*)lds;
    __syncthreads();
    for (int i = TID(); i < 4096; i += 256) {
        const float4 w4 = ((const float4*)p->w_router)[i];
        const int k = i >> 2, e0 = (i & 3) * 4;
        wt[(e0 + 0) * 1024 + k] = w4.x; wt[(e0 + 1) * 1024 + k] = w4.y; wt[(e0 + 2) * 1024 + k] = w4.z; wt[(e0 + 3) * 1024 + k] = w4.w;
    }
    __syncthreads();
    float* lgb = (float*)(lds + LDS_CTL + 512);
    int myrow = 0, it = 0;
    const int rstride = 1;
    const int nwv = gridDim.x * 4, rpw = (T_TOK + nwv - 1) / nwv;
    const int vb_ = BID(), G8_ = gridDim.x >> 3;
    const int wrun_ = ((gridDim.x & 7) ? vb_ : (vb_ & 7) * G8_ + (vb_ >> 3)) * 4 + wave;
    const int rbeg = wrun_ * rpw, rend = rbeg + rpw < T_TOK ? rbeg + rpw : T_TOK;
    float4 gpr[4], s1r[4];
#pragma unroll
    for (int i = 0; i < 4; ++i) { gpr[i] = make_float4(0.f, 0.f, 0.f, 0.f); s1r[i] = gpr[i]; }
    int bcur = -1, nv = NRR;
    float4 vn[NRR][4];
#pragma unroll
    for (int j = 0; j < NRR; ++j) {
        const int r = rbeg + j;
        const size_t xo = (size_t)(r < rend ? r : (rbeg < T_TOK ? rbeg : 0)) * DM;
#pragma unroll
        for (int i = 0; i < 4; ++i) vn[j][i] = ldx4<true>(xin, xo + (lane + 64 * i) * 4);
    }
    for (int row0 = rbeg; row0 < rend; row0 += nv) {
        f2_t ya[NRR / 2][16];
        float ss[NRR];
        const int b = row0 >> 11;
        nv = 0;
#pragma unroll
        for (int j = 0; j < NRR; ++j) nv += (row0 + j < rend && ((row0 + j) >> 11) == b) ? 1 : 0;
        if (b != bcur) {
            bcur = b;
#pragma unroll
            for (int i = 0; i < 4; ++i) {
                const int k = (lane + 64 * i) * 4;
                const float4 gg = *(const float4*)(g + k), s2 = *(const float4*)(sc + (size_t)b * 6144 + k);
                gpr[i] = make_float4(gg.x * (1.f + s2.x), gg.y * (1.f + s2.y), gg.z * (1.f + s2.z), gg.w * (1.f + s2.w));
                s1r[i] = *(const float4*)(sh + (size_t)b * 6144 + k);
            }
        }
        {
            float4 v[NRR][4];
#pragma unroll
            for (int j = 0; j < NRR; ++j) {
#pragma unroll
                for (int i = 0; i < 4; ++i) v[j][i] = vn[j][i];
            }
#pragma unroll
            for (int j = 0; j < NRR; ++j) {
                const int r = row0 + nv + j;
                const size_t xo = (size_t)(r < rend ? r : row0) * DM;
#pragma unroll
                for (int i = 0; i < 4; ++i) vn[j][i] = ldx4<true>(xin, xo + (lane + 64 * i) * 4);
            }
#pragma unroll
            for (int j = 0; j < NRR; ++j) {
                ss[j] = 0.f;
#pragma unroll
                for (int i = 0; i < 4; ++i) ss[j] += v[j][i].x * v[j][i].x + v[j][i].y * v[j][i].y + v[j][i].z * v[j][i].z + v[j][i].w * v[j][i].w;
            }
#pragma unroll
            for (int j = 0; j < NRR; ++j) ss[j] = wave_sum(ss[j]);
#pragma unroll
            for (int j = 0; j < NRR; ++j) ss[j] = 1.0f / sqrtf(ss[j] * (1.0f / 1024.0f) + 1e-6f);
#pragma unroll
            for (int j = 0; j < NRR; ++j) {
                const int r = row0 + j * rstride;
                const float rs = ss[j];
#pragma unroll
                for (int i = 0; i < 4; ++i) {
                    const int k = (lane + 64 * i) * 4;
                    const float4 gp = gpr[i], s1 = s1r[i];
                    const float y0 = v[j][i].x * rs * gp.x + s1.x, y1 = v[j][i].y * rs * gp.y + s1.y;
                    const float y2 = v[j][i].z * rs * gp.z + s1.z, y3 = v[j][i].w * rs * gp.w + s1.w;
                    if (j < nv) *(h4*)(p->P + (size_t)r * NP + k) = pack4(y0, y1, y2, y3);
                    if (j & 1) { ya[j >> 1][4 * i].y = y0; ya[j >> 1][4 * i + 1].y = y1; ya[j >> 1][4 * i + 2].y = y2; ya[j >> 1][4 * i + 3].y = y3; }
                    else       { ya[j >> 1][4 * i].x = y0; ya[j >> 1][4 * i + 1].x = y1; ya[j >> 1][4 * i + 2].x = y2; ya[j >> 1][4 * i + 3].x = y3; }
                }
                __builtin_amdgcn_sched_barrier(0);
            }
        }
        f2_t acc[NRR / 2][16];
#pragma unroll
        for (int e = 0; e < 16; ++e) {
#pragma unroll
            for (int jp = 0; jp < NRR / 2; ++jp) acc[jp][e] = (f2_t){0.f, 0.f};
        }
        {
            float4 wq[2][4];
            const float* wl = wt + lane * 4;
#pragma unroll
            for (int e = 0; e < 4; ++e) wq[0][e] = *(const float4*)(wl + e * 1024);
#pragma unroll
            for (int st = 0; st < 16; ++st) {
                const int i = st >> 2, eg = st & 3, cur = st & 1;
                if (st + 1 < 16) {
                    const int i2 = (st + 1) >> 2, eg2 = (st + 1) & 3;
#pragma unroll
                    for (int e = 0; e < 4; ++e) wq[cur ^ 1][e] = *(const float4*)(wl + (eg2 * 4 + e) * 1024 + i2 * 256);
                }
#pragma unroll
                for (int e = 0; e < 4; ++e) {
                    const float4 w4 = wq[cur][e];
#pragma unroll
                    for (int jp = 0; jp < NRR / 2; ++jp) {
                        f2_t a = acc[jp][eg * 4 + e];
                        a = ya[jp][4 * i + 3] * (f2_t){w4.w, w4.w} + a;
                        a = ya[jp][4 * i + 2] * (f2_t){w4.z, w4.z} + a;
                        a = ya[jp][4 * i + 1] * (f2_t){w4.y, w4.y} + a;
                        a = ya[jp][4 * i] * (f2_t){w4.x, w4.x} + a;
                        acc[jp][eg * 4 + e] = a;
                    }
                }
                __builtin_amdgcn_sched_barrier(0);
            }
        }
        const bool b5 = lane & 32, b4 = lane & 16, b3 = lane & 8, b2 = lane & 4;
#pragma unroll
        for (int j = 0; j < NRR; ++j) {
            float r8[8], r4[4], r2[2];
#pragma unroll
            for (int e = 0; e < 8; ++e) {
                const float lo = (j & 1) ? acc[j >> 1][e].y : acc[j >> 1][e].x, hi = (j & 1) ? acc[j >> 1][e + 8].y : acc[j >> 1][e + 8].x;
                r8[e] = swapsum32(lo, hi);
            }
#pragma unroll
            for (int e = 0; e < 4; ++e) r4[e] = swapsum16(r8[e], r8[e + 4]);
#pragma unroll
            for (int e = 0; e < 2; ++e) { const float snd = b3 ? r4[e] : r4[e + 2], kp = b3 ? r4[e + 2] : r4[e]; r2[e] = kp + xor8f(snd); }
            float rv; { const float snd = b2 ? r2[0] : r2[1], kp = b2 ? r2[1] : r2[0]; rv = kp + xor4f(snd); }
            rv += xor2f(rv); rv += xor1f(rv);
            if (j < nv) {
                if ((lane & 3) == 0) lgb[(wave * 16 + it) * 16 + (lane >> 2)] = rv;
                if (lane == it) myrow = row0 + j * rstride;
                ++it;
            }
        }
        if (it == 16) { route_flush(p, lds, lane, wave, it, myrow, layer); it = 0; }
    }
    if (it > 0) route_flush(p, lds, lane, wave, it, myrow, layer);
}

template <class WF, class XF, class EPI>
__device__ __forceinline__ void gemm_tile(char* lds, int nkt, WF wf, XF xf, EPI epi) {
    const int tid = TID(), lane = tid & 63, wave = tid >> 6;
    const int wn = wave & 1, wm = wave >> 1, hh = lane >> 5;
    const int lrow = tid >> 3;
    const int lchunk = (tid & 7) ^ ((tid >> 4) & 7);
    const half_t* xs[4];
#pragma unroll
    for (int i = 0; i < 4; ++i) xs[i] = xf(lrow + 32 * i) + lchunk * 8;
    char* ldst = lds + lrow * 128 + (tid & 7) * 16;
    f16v acc[2][2];
#pragma unroll
    for (int i = 0; i < 2; ++i)
#pragma unroll
        for (int j = 0; j < 2; ++j)
#pragma unroll
            for (int r = 0; r < 16; ++r) acc[i][j][r] = 0.f;
    auto issue = [&](int kt, int s) {
        char* d = ldst + s * 32768;
#pragma unroll
        for (int i = 0; i < 4; ++i) glds16(wf(kt, lrow + 32 * i) + lchunk * 8, d + i * 4096);
#pragma unroll
        for (int i = 0; i < 4; ++i) glds16(xs[i] + kt * 64, d + 16384 + i * 4096);
    };
    __syncthreads();
    issue(0, 0);
    const int rsw = (lane >> 1) & 7;
    const int roff_w = (wn * 64 + (lane & 31)) * 128, roff_x = 16384 + (wm * 64 + (lane & 31)) * 128;
    for (int kt = 0; kt < nkt; ++kt) {
        asm volatile("s_waitcnt vmcnt(0)" ::: "memory");
        __syncthreads();
        if (kt + 1 < nkt) issue(kt + 1, (kt + 1) & 1);
        const char* base = lds + (kt & 1) * 32768;
#pragma unroll
        for (int ks = 0; ks < 4; ++ks) {
            const int co = ((2 * ks + hh) ^ rsw) << 4;
            const h8 a0 = *(const h8*)(base + roff_w + co), a1 = *(const h8*)(base + roff_w + 4096 + co);
            const h8 b0 = *(const h8*)(base + roff_x + co), b1 = *(const h8*)(base + roff_x + 4096 + co);
            acc[0][0] = __builtin_amdgcn_mfma_f32_32x32x16_f16(a0, b0, acc[0][0], 0, 0, 0);
            acc[0][1] = __builtin_amdgcn_mfma_f32_32x32x16_f16(a0, b1, acc[0][1], 0, 0, 0);
            acc[1][0] = __builtin_amdgcn_mfma_f32_32x32x16_f16(a1, b0, acc[1][0], 0, 0, 0);
            acc[1][1] = __builtin_amdgcn_mfma_f32_32x32x16_f16(a1, b1, acc[1][1], 0, 0, 0);
        }
    }
    epi(acc, wn, wm, lane);
}

template <class WF, class XF, class EPI>
__device__ __forceinline__ void gemm_tile2(char* lds, int nkt, size_t xkstride, WF wf, XF xf, EPI epi) {
    const int tid = TID(), lane = tid & 63, wave = tid >> 6;
    const int wn = wave & 1, wm = wave >> 1, hh = lane >> 5;
    const int lrow = tid >> 2;
    const int lchunk = (tid & 3) ^ ((tid >> 4) & 3);
    const half_t* xs[2];
#pragma unroll
    for (int i = 0; i < 2; ++i) xs[i] = xf(lrow + 64 * i) + lchunk * 8;
    char* ldst = lds + lrow * 64 + (tid & 3) * 16;
    f16v acc[4][2];
#pragma unroll
    for (int i = 0; i < 4; ++i)
#pragma unroll
        for (int j = 0; j < 2; ++j)
#pragma unroll
            for (int r = 0; r < 16; ++r) acc[i][j][r] = 0.f;
    auto issue = [&](int kt, int s) {
        char* d = ldst + s * 24576;
#pragma unroll
        for (int i = 0; i < 4; ++i) glds16(wf(kt, lrow + 64 * i) + lchunk * 8, d + i * 4096);
#pragma unroll
        for (int i = 0; i < 2; ++i) glds16(xs[i] + (size_t)kt * xkstride, d + 16384 + i * 4096);
    };
    __syncthreads();
    issue(0, 0); issue(1, 1);
    const int rsw = (lane >> 2) & 3;
    const int roff_w = (wn * 128 + (lane & 31)) * 64, roff_x = 16384 + (wm * 64 + (lane & 31)) * 64;
    int st = 0;
    for (int kt = 0; kt < nkt; ++kt) {
        if (kt + 1 < nkt) asm volatile("s_waitcnt vmcnt(6)" ::: "memory");
        else asm volatile("s_waitcnt vmcnt(0)" ::: "memory");
        asm volatile("s_waitcnt lgkmcnt(0)" ::: "memory");
        __builtin_amdgcn_s_barrier();
        if (kt + 2 < nkt) issue(kt + 2, st >= 1 ? st - 1 : 2);
        const char* base = lds + st * 24576;
        st = st == 2 ? 0 : st + 1;
#pragma unroll
        for (int ks = 0; ks < 2; ++ks) {
            const int co = ((2 * ks + hh) ^ rsw) << 4;
            h8 a[4], b[2];
#pragma unroll
            for (int i = 0; i < 4; ++i) a[i] = *(const h8*)(base + roff_w + i * 2048 + co);
#pragma unroll
            for (int j = 0; j < 2; ++j) b[j] = *(const h8*)(base + roff_x + j * 2048 + co);
#pragma unroll
            for (int i = 0; i < 4; ++i)
#pragma unroll
                for (int j = 0; j < 2; ++j) acc[i][j] = __builtin_amdgcn_mfma_f32_32x32x16_f16(a[i], b[j], acc[i][j], 0, 0, 0);
        }
    }
    epi(acc, wn, wm, lane);
}

__device__ __forceinline__ void phase_inproj(KP p, char* lds, int l) {
    const half_t* W = p->Wt_in + (size_t)l * NP * DM;
    const float* rc16 = p->rope; const float* rs16 = p->rope + 16384; const float* rc8 = p->rope + 32768; const float* rs8 = p->rope + 32768 + 8192;
    for (int u = BID(); u < 256 * 10; u += gridDim.x) {
        const int xl = u & 7, Lx = u >> 3, mi = Lx & 15, rr_ = Lx >> 4;
        const int nt = rr_ % 10, mt = 32 * xl + 16 * (rr_ / 10) + mi;
        gemm_tile2(lds, 32, (size_t)T_TOK * 32,
            [&](int kt, int row) { int n = nt * 256 + row; n = n < NP ? n : NP - 1; return W + ((size_t)kt * NP + n) * 32; },
            [&](int row) { return p->hn + (size_t)(mt * 128 + row) * 32; },
            [&](f16v (&acc)[4][2], int wn, int wm, int lane) {
                const int hh = lane >> 5;
                half_t* stg = (half_t*)lds;
                float4 rc16v[2], rs16v[2], rc8v[2], rs8v[2];
                if (nt >= 2) {
#pragma unroll
                    for (int j = 0; j < 2; ++j) {
                        const int t = (mt * 128 + wm * 64 + j * 32 + (lane & 31)) & 2047;
                        rc16v[j] = *(const float4*)(rc16 + t * 8 + 4 * hh); rs16v[j] = *(const float4*)(rs16 + t * 8 + 4 * hh);
                        rc8v[j] = *(const float4*)(rc8 + t * 4); rs8v[j] = *(const float4*)(rs8 + t * 4);
                    }
                }
                __syncthreads();
#pragma unroll
                for (int i = 0; i < 4; ++i) {
                    const int nb = nt * 256 + wn * 128 + i * 32;
                    if (nb == 1216 || nb == 1248 || nb >= NP) continue;
                    if (nt < 2) {
                        if (i & 1) continue;
#pragma unroll
                        for (int j = 0; j < 2; ++j) {
                            half_t* dst = stg + (wm * 64 + j * 32 + (lane & 31)) * 260 + wn * 64 + (i >> 1) * 32 + 4 * hh;
#pragma unroll
                            for (int g = 0; g < 4; ++g) {
                                float a4[4];
#pragma unroll
                                for (int r = 0; r < 4; ++r) a4[r] = acc[i][j][4 * g + r] * sigmoidf_(acc[i + 1][j][4 * g + r]);
                                *(h4*)(dst + 8 * g) = pack4(a4[0], a4[1], a4[2], a4[3]);
                            }
                        }
                        continue;
                    }
                    const bool rope64 = ((nb >= PC_DQ && nb < PC_DV) || (nb >= PC_MQ && nb < PC_MV)) && ((nb & 63) == 0);
                    const bool rope32 = (nb >= PC_IQ && nb < PC_IW);
#pragma unroll
                    for (int j = 0; j < 2; ++j) {
                        const int tok = mt * 128 + wm * 64 + j * 32 + (lane & 31);
                        const int t = tok & 2047;
                        f16v v = acc[i][j];
                        if (nb == PC_IW) { if (hh == 0) *(float4*)(p->iwf + (size_t)tok * 4) = make_float4(v[0], v[1], v[2], v[3]); continue; }
                        if (rope64) {
                            const float4 c4 = rc16v[j], s4 = rs16v[j];
                            const float cc[4] = {c4.x, c4.y, c4.z, c4.w}, sn[4] = {s4.x, s4.y, s4.z, s4.w};
#pragma unroll
                            for (int r = 0; r < 4; ++r) { const float x1 = v[r], x2 = v[r + 4]; v[r] = x1 * cc[r] - x2 * sn[r]; v[r + 4] = x2 * cc[r] + x1 * sn[r]; }
                        } else if (rope32) {
                            const float4 c4 = rc8v[j], s4 = rs8v[j];
                            const float cc[4] = {c4.x, c4.y, c4.z, c4.w}, sn[4] = {s4.x, s4.y, s4.z, s4.w};
#pragma unroll
                            for (int r = 0; r < 4; ++r) { const float o = xor32f(v[r], hh != 0); v[r] = hh ? (v[r] * cc[r] + o * sn[r]) : (v[r] * cc[r] - o * sn[r]); }
                        }
                        if ((nb >= PC_DQ && nb < PC_DK) || (nb >= PC_MQ && nb < PC_MK)) {
#pragma unroll
                            for (int r = 0; r < 16; ++r) v[r] *= 0.18033688011112042f;
                        }
                        half_t* dst = stg + (wm * 64 + j * 32 + (lane & 31)) * 260 + wn * 128 + i * 32 + 4 * hh;
#pragma unroll
                        for (int g = 0; g < 4; ++g) *(h4*)(dst + 8 * g) = pack4(v[4 * g], v[4 * g + 1], v[4 * g + 2], v[4 * g + 3]);
                    }
                }
                __syncthreads();
                const int wv_ = TID() >> 6;
                if (nt < 2) {
#pragma unroll 4
                    for (int it = 0; it < 32; ++it) {
                        const int row = it * 4 + wv_;
                        const uint2 v2 = *(const uint2*)(stg + row * 260 + lane * 4);
                        if (lane < 32) *(uint2*)(p->P + (size_t)(mt * 128 + row) * NP + nt * 128 + lane * 4) = v2;
                    }
                } else {
                    const int hl_ = lane >> 5, l5_ = lane & 31;
#pragma unroll 4
                    for (int it = 0; it < 16; ++it) {
                        const int row = it * 8 + wv_ * 2 + hl_;
                        const uint2 va = *(const uint2*)(stg + row * 260 + l5_ * 8), vb = *(const uint2*)(stg + row * 260 + l5_ * 8 + 4);
                        const int n = nt * 256 + l5_ * 8;
                        if (n < NP) *(uint4*)(p->P + (size_t)(mt * 128 + row) * NP + n) = make_uint4(va.x, va.y, vb.x, vb.y);
                    }
                }
            });
    }
}

__device__ __forceinline__ void stage_acc_f32(char* lds, const f16v (&acc)[2][2], int wn, int wm, int lane) {
    float* stg = (float*)lds;
    const int hh = lane >> 5;
    __syncthreads();
#pragma unroll
    for (int j = 0; j < 2; ++j)
#pragma unroll
        for (int i = 0; i < 2; ++i)
#pragma unroll
            for (int g = 0; g < 4; ++g)
                *(float4*)(stg + (wm * 64 + j * 32 + (lane & 31)) * 132 + wn * 64 + i * 32 + 4 * hh + 8 * g) = make_float4(acc[i][j][4 * g], acc[i][j][4 * g + 1], acc[i][j][4 * g + 2], acc[i][j][4 * g + 3]);
    __syncthreads();
}
template <bool HIN>
__device__ __forceinline__ void phase_outproj(KP p, char* lds, int l, const void* xin) {
    const half_t* W = p->Wt_o + (size_t)l * DM * DM;
    const float* g1 = p->modf + (size_t)l * 16 * 6144 + 2 * 1024;
    for (int u = BID(); u < 256 * 4; u += gridDim.x) {
        const int xl = u & 7, Lx = u >> 3, mi = Lx & 7, rr_ = Lx >> 3;
        const int nt = rr_ & 3, mt = 32 * xl + 8 * (rr_ >> 2) + mi;
        gemm_tile2(lds, 32, (size_t)T_TOK * 32,
            [&](int kt, int row) { return W + ((size_t)kt * DM + nt * 256 + row) * 32; },
            [&](int row) { return p->ycat + (size_t)(mt * 128 + row) * 32; },
            [&](f16v (&acc)[4][2], int wn, int wm, int lane) {
                const int hh = lane >> 5, tid = TID();
                float* stg = (float*)lds;
#pragma unroll
                for (int rnd = 0; rnd < 2; ++rnd) {
                    __syncthreads();
                    if (wm == rnd) {
#pragma unroll
                        for (int j = 0; j < 2; ++j)
#pragma unroll
                            for (int i = 0; i < 4; ++i)
#pragma unroll
                                for (int g = 0; g < 4; ++g)
                                    *(float4*)(stg + (j * 32 + (lane & 31)) * 260 + wn * 128 + i * 32 + 4 * hh + 8 * g) = make_float4(acc[i][j][4 * g], acc[i][j][4 * g + 1], acc[i][j][4 * g + 2], acc[i][j][4 * g + 3]);
                    }
                    __syncthreads();
#pragma unroll
                    for (int hf = 0; hf < 4; ++hf) {
                        float4 xa[2], xb[2], ga[2], gb[2];
#pragma unroll
                        for (int q = 0; q < 2; ++q) {
                            const int idx = (hf * 2 + q) * 256 + tid, row = idx >> 5, c = idx & 31;
                            const int tok = mt * 128 + rnd * 64 + row, n = nt * 256 + 8 * c;
                            if (HIN) {
                                const h8 t8 = *(const h8*)((const half_t*)xin + (size_t)tok * DM + n);
                                xa[q] = make_float4((float)t8[0], (float)t8[1], (float)t8[2], (float)t8[3]); xb[q] = make_float4((float)t8[4], (float)t8[5], (float)t8[6], (float)t8[7]);
                            } else {
                                const float* xp = (const float*)xin + (size_t)tok * DM + n;
                                xa[q] = *(const float4*)xp; xb[q] = *(const float4*)(xp + 4);
                            }
                            const float* gp = g1 + (size_t)(tok >> 11) * 6144 + n;
                            ga[q] = *(const float4*)gp; gb[q] = *(const float4*)(gp + 4);
                        }
                        __builtin_amdgcn_sched_barrier(0);
#pragma unroll
                        for (int q = 0; q < 2; ++q) {
                            const int idx = (hf * 2 + q) * 256 + tid, row = idx >> 5, c = idx & 31;
                            const int tok = mt * 128 + rnd * 64 + row, n = nt * 256 + 8 * c;
                            const float4 a0 = *(const float4*)(stg + row * 260 + 8 * c), a1 = *(const float4*)(stg + row * 260 + 8 * c + 4);
                            h8 o;
                            o[0] = (half_t)(xa[q].x + ga[q].x * a0.x); o[1] = (half_t)(xa[q].y + ga[q].y * a0.y); o[2] = (half_t)(xa[q].z + ga[q].z * a0.z); o[3] = (half_t)(xa[q].w + ga[q].w * a0.w);
                            o[4] = (half_t)(xb[q].x + gb[q].x * a1.x); o[5] = (half_t)(xb[q].y + gb[q].y * a1.y); o[6] = (half_t)(xb[q].z + gb[q].z * a1.z); o[7] = (half_t)(xb[q].w + gb[q].w * a1.w);
                            *(h8*)(p->xr + (size_t)tok * DM + n) = o;
                        }
                        __builtin_amdgcn_sched_barrier(0);
                    }
                }
            });
    }
}

struct MoeTab { int tb, nt, nc; };
__device__ __forceinline__ MoeTab moe_table(const int* cnt) {
    const int c = TID() & 31;
    MoeTab t;
    t.nc = (c < NCLS) ? cnt[c * 64] : 0;
    t.nt = (t.nc + 127) >> 7;
    int incl = t.nt;
#pragma unroll
    for (int o = 1; o < 32; o <<= 1) { const int v = __shfl_up(incl, o, 32); if (c >= o) incl += v; }
    t.tb = incl - t.nt;
    return t;
}
__device__ __forceinline__ bool moe_tile(const MoeTab& t, int tile, int& cls, int& pos0, int& n) {
    const unsigned long long m = __ballot(tile >= t.tb && tile < t.tb + t.nt);
    if (m == 0ull) return false;
    cls = __ffsll((long long)m) - 1;
    pos0 = (tile - __builtin_amdgcn_readlane(t.tb, cls)) * 128;
    n = __builtin_amdgcn_readlane(t.nc, cls);
    return true;
}
__device__ __forceinline__ void cls_experts(int cls, int& e1, int& e2) {
    const int g = cls / 6, pi = cls % 6;
    const int a = pi < 3 ? 0 : (pi < 5 ? 1 : 2);
    const int b = pi < 3 ? pi + 1 : (pi < 5 ? pi - 1 : 3);
    e1 = g * 4 + a; e2 = g * 4 + b;
}
__device__ __forceinline__ void phase_moe_up(KP p, char* lds, int l) {
    const MoeTab tab = moe_table(p->cnt + l * 32 * 64);
    for (int u = BID(); u < (256 + NCLS) * 8; u += gridDim.x) {
        const int xl = u & 7, Lx = u >> 3;
        const int nt = Lx & 7, tile = (Lx >> 3) * 8 + xl;
        int cls, pos0, nc;
        if (!moe_tile(tab, tile, cls, pos0, nc)) continue;
        int e1, e2; cls_experts(cls, e1, e2);
        const int slot = nt >> 2;
        const half_t* W = p->Wt_gu + ((size_t)(l * 16 + (slot ? e2 : e1)) * 512 + (nt & 3) * 128) * 1024;
        const int* lst = p->lists + (size_t)cls * T_TOK + pos0;
        const int nvalid = nc - pos0;
        int tokE[2]; float wgtE[2];
        {
            const int lane_ = TID() & 63, wm_ = TID() >> 7;
#pragma unroll
            for (int j = 0; j < 2; ++j) {
                const int row = wm_ * 64 + j * 32 + (lane_ & 31);
                tokE[j] = lst[row < nvalid ? row : 0];
                wgtE[j] = p->tokw[(size_t)tokE[j] * 2 + slot];
            }
        }
        gemm_tile(lds, 16,
            [&](int kt, int row) { return W + (size_t)row * 1024 + kt * 64; },
            [&](int row) { const int tok = lst[row < nvalid ? row : 0]; return p->P + (size_t)tok * NP; },
            [&](f16v (&acc)[2][2], int wn, int wm, int lane) {
                const int hh = lane >> 5;
#pragma unroll
                for (int j = 0; j < 2; ++j) {
                    const int row = wm * 64 + j * 32 + (lane & 31);
                    if (row < nvalid) {
                        const int tok = tokE[j];
                        const float wgt = wgtE[j];
                        half_t* dst = p->act + (size_t)tok * 512 + slot * 256 + ((nt & 3) * 2 + wn) * 32 + 4 * hh;
#pragma unroll
                        for (int g = 0; g < 4; ++g) {
                            float a[4];
#pragma unroll
                            for (int r = 0; r < 4; ++r) { const float gv = acc[0][j][4 * g + r], uv = acc[1][j][4 * g + r]; a[r] = gv * sigmoidf_(gv) * uv * wgt; }
                            *(h4*)(dst + 8 * g) = pack4(a[0], a[1], a[2], a[3]);
                        }
                    }
                }
            });
    }
}
__device__ __forceinline__ void phase_moe_down(KP p, char* lds, int l, float gsc) {
    const MoeTab tab = moe_table(p->cnt + l * 32 * 64);
    const float* g2 = p->modf + (size_t)l * 16 * 6144 + 5 * 1024;
    for (int u = BID(); u < (256 + NCLS) * 8; u += gridDim.x) {
        const int xl = u & 7, Lx = u >> 3;
        const int nt = Lx & 7, tile = (Lx >> 3) * 8 + xl;
        int cls, pos0, nc;
        if (!moe_tile(tab, tile, cls, pos0, nc)) continue;
        int e1, e2; cls_experts(cls, e1, e2);
        const half_t* W1 = p->Wt_d + ((size_t)(l * 16 + e1) * 1024 + nt * 128) * 256;
        const half_t* W2 = p->Wt_d + ((size_t)(l * 16 + e2) * 1024 + nt * 128) * 256;
        const int* lst = p->lists + (size_t)cls * T_TOK + pos0;
        const int nvalid = nc - pos0;
        int tokS[8];
        {
            const int r0 = TID() >> 4;
#pragma unroll
            for (int it = 0; it < 8; ++it) { const int row = it * 16 + r0; tokS[it] = lst[row < nvalid ? row : 0]; }
        }
        gemm_tile(lds, 8,
            [&](int kt, int row) { return (kt < 4 ? W1 : W2) + (size_t)row * 256 + (kt & 3) * 64; },
            [&](int row) { const int tok = lst[row < nvalid ? row : 0]; return p->act + (size_t)tok * 512; },
            [&](f16v (&acc)[2][2], int wn, int wm, int lane) {
                const int hh = lane >> 5, tid = TID();
                float* stg = (float*)lds;
                __syncthreads();
#pragma unroll
                for (int j = 0; j < 2; ++j)
#pragma unroll
                    for (int i = 0; i < 2; ++i)
#pragma unroll
                        for (int g = 0; g < 4; ++g)
                            *(float4*)(stg + (wm * 64 + j * 32 + (lane & 31)) * 132 + wn * 64 + i * 32 + 8 * g + 4 * hh) =
                                make_float4(acc[i][j][4 * g], acc[i][j][4 * g + 1], acc[i][j][4 * g + 2], acc[i][j][4 * g + 3]);
                __syncthreads();
                const int r0 = tid >> 4, c8 = (tid & 15) * 8;
                const int n = nt * 128 + c8;
                h8 xi[8]; float4 g0[8], g1[8];
#pragma unroll
                for (int it = 0; it < 8; ++it) {
                    const int tok = tokS[it];
                    const float* gp = g2 + (size_t)(tok >> 11) * 6144 + n;
                    xi[it] = *(const h8*)(p->xr + (size_t)tok * DM + n);
                    g0[it] = *(const float4*)gp; g1[it] = *(const float4*)(gp + 4);
                }
#pragma unroll
                for (int it = 0; it < 8; ++it) {
                    const int row = it * 16 + r0;
                    const float4 a0 = *(const float4*)(stg + row * 132 + c8), a1 = *(const float4*)(stg + row * 132 + c8 + 4);
                    h8 o;
                    o[0] = (half_t)((float)xi[it][0] + gsc * g0[it].x * a0.x); o[1] = (half_t)((float)xi[it][1] + gsc * g0[it].y * a0.y);
                    o[2] = (half_t)((float)xi[it][2] + gsc * g0[it].z * a0.z); o[3] = (half_t)((float)xi[it][3] + gsc * g0[it].w * a0.w);
                    o[4] = (half_t)((float)xi[it][4] + gsc * g1[it].x * a1.x); o[5] = (half_t)((float)xi[it][5] + gsc * g1[it].y * a1.y);
                    o[6] = (half_t)((float)xi[it][6] + gsc * g1[it].z * a1.z); o[7] = (half_t)((float)xi[it][7] + gsc * g1[it].w * a1.w);
                    if (row < nvalid) *(h8*)(p->xr + (size_t)tokS[it] * DM + n) = o;
                }
            });
    }
}

__device__ __forceinline__ void dsa_select_unit(KP p, char* lds, int b, int qt) {
    unsigned* hist = (unsigned*)lds;
    unsigned* maskl = hist + 16 * 257 + 16;
    unsigned* stP = maskl + 1024;
    unsigned* stNeed = stP + 16;
    unsigned* stDone = stNeed + 16;
    unsigned* flag = stDone + 16;
    unsigned* dummyb = flag + 16;
    const int tid = TID(), lane = tid & 63, wave = tid >> 6;
    const int q0 = qt * 16, tokbase = b * SEQ;
    __syncthreads();
    if (q0 < 256) {
        for (int i = tid; i < 1024; i += 256) {
            const int q = i >> 6, wd = i & 63;
            const int n = q0 + q + 1 - 32 * wd;
            const unsigned w = n >= 32 ? 0xFFFFFFFFu : (n <= 0 ? 0u : ((1u << n) - 1u));
            p->dmask[(size_t)(tokbase + q0 + q) * 64 + wd] = w;
        }
        return;
    }
    for (int i = tid; i < 1024; i += 256) maskl[i] = 0u;
    if (tid < 16) { stP[tid] = 0u; stNeed[tid] = 256u; stDone[tid] = 0u; flag[tid] = 0u; }
    for (int i = tid; i < 16 * 257; i += 256) hist[i] = 0u;
    __syncthreads();
    const int ql = lane & 15, fq = lane >> 4;
    const int tq = q0 + ql;
    const half_t* Pb = p->P + (size_t)tokbase * NP;
    h8 iqf[4];
#pragma unroll
    for (int hd = 0; hd < 4; ++hd) iqf[hd] = *(const h8*)(Pb + (size_t)tq * NP + PC_IQ + hd * 32 + 8 * fq);
    const float4 iw4 = *(const float4*)(p->iwf + (size_t)(tokbase + tq) * 4);
    const float wsc0 = iw4.x * 0.08838834764831845f, wsc1 = iw4.y * 0.08838834764831845f, wsc2 = iw4.z * 0.08838834764831845f, wsc3 = iw4.w * 0.08838834764831845f;
    const int ng = qt + 1;
    unsigned sc[32][4];
    const half_t* ikp = Pb + (size_t)ql * NP + PC_IK + 8 * fq;
#pragma unroll
    for (int gb = 0; gb < 4; ++gb) {
        h8 ik[8];
#pragma unroll
        for (int x = 0; x < 8; ++x) {
            int g = wave + 4 * (gb * 8 + x);
            g = g < ng ? g : ng - 1;
            ik[x] = *(const h8*)(ikp + (size_t)(16 * g) * NP);
        }
#pragma unroll
        for (int x = 0; x < 8; ++x) {
            const int gi = gb * 8 + x;
            const int g = wave + 4 * gi;
            const f4v z = {0.f, 0.f, 0.f, 0.f};
            const f4v c0 = __builtin_amdgcn_mfma_f32_16x16x32_f16(ik[x], iqf[0], z, 0, 0, 0);
            const f4v c1 = __builtin_amdgcn_mfma_f32_16x16x32_f16(ik[x], iqf[1], z, 0, 0, 0);
            const f4v c2 = __builtin_amdgcn_mfma_f32_16x16x32_f16(ik[x], iqf[2], z, 0, 0, 0);
            const f4v c3 = __builtin_amdgcn_mfma_f32_16x16x32_f16(ik[x], iqf[3], z, 0, 0, 0);
#pragma unroll
            for (int r = 0; r < 4; ++r) {
                const int j = 16 * g + 4 * fq + r;
                float sv = wsc0 * relu_(c0[r]);
                sv = fmaf(wsc1, relu_(c1[r]), sv);
                sv = fmaf(wsc2, relu_(c2[r]), sv);
                sv = fmaf(wsc3, relu_(c3[r]), sv);
                const int sb = __float_as_int(sv);
                const unsigned su = (unsigned)sb ^ ((unsigned)(sb >> 31) | 0x80000000u);
                const unsigned ck = (su & 0xFFFFF800u) | (unsigned)(2047 - j);
                sc[gi][r] = (g < ng && j <= tq) ? ck : 0u;
            }
            if (g < ng) {
#pragma unroll
                for (int r = 0; r < 4; ++r) atomicAdd(hist + ql * 257 + (sc[gi][r] >> 24), 1u);
            }
        }
    }
    bool alldone = false;
    for (int pass = 0; pass < 5; ++pass) {
        const bool fin = alldone;
        if (pass > 0) {
        const unsigned sP = stP[ql], sDone = stDone[ql];
        int wv = wave, fqv = fq;
        asm volatile("" : "+v"(wv), "+v"(fqv));
        if (fin) {
            const int sh = (int)(32u - 8u * (sDone ? sDone : 1u));
            unsigned* mrow = maskl + ql * 64;
#pragma unroll
            for (int gi = 0; gi < 32; ++gi) {
                const int g = wv + 4 * gi;
                unsigned nib = 0u;
#pragma unroll
                for (int r = 0; r < 4; ++r) {
                    const unsigned uu = sc[gi][r];
                    nib |= ((uu >> sh) >= sP) ? (1u << r) : 0u;
                }
                if (g < ng) atomicOr(&mrow[g >> 1], nib << ((g & 1) * 16 + 4 * fqv));
            }
        } else {
            const int shm = pass ? 32 - 8 * pass : 0, shd = 24 - 8 * pass;
            const unsigned orm = pass ? 0u : 0xFFFFFFFFu;
            const unsigned cmpv = pass ? (sDone == 0u ? sP : 0xFFFFFFFFu) : 0xFFFFFFFFu;
            unsigned* hrow = hist + ql * 257;
            unsigned* dummy = dummyb + lane;
#pragma unroll
            for (int gi = 0; gi < 32; ++gi) {
                const int g = wv + 4 * gi;
                if (g < ng) {
#pragma unroll
                    for (int r = 0; r < 4; ++r) {
                        const unsigned uu = sc[gi][r];
                        const bool match = (((uu >> shm) | orm) == cmpv);
                        const unsigned dig = (uu >> shd) & 255u;
                        unsigned* a = match ? hrow + dig : dummy;
                        atomicAdd(a, 1u);
                    }
                }
            }
        }
        }
        __syncthreads();
        if (fin) break;
        {
            const int qq = tid >> 4, seg = tid & 15;
            const bool active = (stDone[qq] == 0u);
            unsigned cn[16], c16 = 0u;
#pragma unroll
            for (int d = 0; d < 16; ++d) { cn[d] = active ? hist[qq * 257 + seg * 16 + d] : 0u; c16 += cn[d]; }
            if (active) {
#pragma unroll
                for (int d = 0; d < 16; ++d) hist[qq * 257 + seg * 16 + d] = 0u;
            }
            unsigned v = c16;
            v += dppu<0x101>(v); v += dppu<0x102>(v); v += dppu<0x104>(v); v += dppu<0x108>(v);
            const unsigned suf = v - c16;
            const unsigned need = stNeed[qq];
            if (active && suf < need && need <= suf + c16) {
                unsigned run = suf, D = 0u, cD = 0u, nn = need;
                bool found = false;
#pragma unroll
                for (int d = 15; d >= 0; --d) {
                    const unsigned cc = cn[d];
                    const bool hit = !found && (run + cc >= need);
                    if (hit) { D = (unsigned)(seg * 16 + d); cD = cc; nn = need - run; }
                    found = found || hit;
                    run += found ? 0u : cc;
                }
                const bool done = (cD == nn) || pass == 3;
                stP[qq] = (stP[qq] << 8) | D; stNeed[qq] = nn;
                if (done) stDone[qq] = (unsigned)(pass + 1); else atomicAdd(flag + pass, 1u);
            }
        }
        __syncthreads();
        alldone = (flag[pass] == 0u);
    }
    for (int i = tid; i < 1024; i += 256) p->dmask[(size_t)(tokbase + q0 + (i >> 6)) * 64 + (i & 63)] = maskl[i];
}

__device__ __forceinline__ void conv_unit(KP p, char* lds, int l, int b, int c) {
    float* red = (float*)lds;
    const int ch = TID(), lane = ch & 63, wave = ch >> 6;
    const int t0 = c * 32, tokbase = b * SEQ;
    half_t* tile = (half_t*)(lds + 4096);
    float w[31];
#pragma unroll
    for (int i = 0; i < 31; ++i) w[i] = p->w_dw[(l * 31 + i) * 256 + ch];
    const float bias = p->b_dw[l * 256 + ch];
    const float lg = p->ln_g[l * 256 + ch], lb = p->ln_b[l * 256 + ch];
    __syncthreads();
    {
        h8 vt[8];
#pragma unroll
        for (int it = 0; it < 8; ++it) {
            int i = it * 256 + ch; i = i < 62 * 32 ? i : 62 * 32 - 1;
            const int rr = i >> 5, c16 = i & 31;
            int tt = t0 - 30 + rr; tt = tt >= 0 ? tt : 0;
            vt[it] = *(const h8*)(p->P + (size_t)(tokbase + tt) * NP + c16 * 8);
        }
#pragma unroll
        for (int it = 0; it < 8; ++it) {
            const int i = it * 256 + ch;
            if (i < 62 * 32) {
                const int rr = i >> 5, c16 = i & 31;
                h8 v = vt[it];
                if (t0 - 30 + rr < 0) {
#pragma unroll
                    for (int j = 0; j < 8; ++j) v[j] = (half_t)0.f;
                }
                *(h8*)(tile + rr * 256 + c16 * 8) = v;
            }
        }
    }
    __syncthreads();
    float aw[62];
#pragma unroll
    for (int rr = 0; rr < 62; ++rr) aw[rr] = (float)tile[rr * 256 + ch];
    float y[32], s1[32], s2[32];
#pragma unroll
    for (int tk = 0; tk < 32; ++tk) {
        float sacc = bias;
#pragma unroll
        for (int i = 0; i < 31; ++i) sacc = fmaf(aw[tk + i], w[i], sacc);
        y[tk] = sacc; s1[tk] = sacc; s2[tk] = sacc * sacc;
    }
    {
        const bool b5 = lane & 32, b4 = lane & 16, b3 = lane & 8, b2 = lane & 4, b1 = lane & 2;
        float a16[16], c16[16], a8[8], c8[8], a4[4], c4[4], a2[2], c2[2];
#pragma unroll
        for (int e = 0; e < 16; ++e) { a16[e] = swapsum32(s1[e], s1[e + 16]); c16[e] = swapsum32(s2[e], s2[e + 16]); }
#pragma unroll
        for (int e = 0; e < 8; ++e) { a8[e] = swapsum16(a16[e], a16[e + 8]); c8[e] = swapsum16(c16[e], c16[e + 8]); }
#pragma unroll
        for (int e = 0; e < 4; ++e) { a4[e] = (b3 ? a8[e + 4] : a8[e]) + xor8f(b3 ? a8[e] : a8[e + 4]); c4[e] = (b3 ? c8[e + 4] : c8[e]) + xor8f(b3 ? c8[e] : c8[e + 4]); }
#pragma unroll
        for (int e = 0; e < 2; ++e) { a2[e] = (b2 ? a4[e + 2] : a4[e]) + xor4f(b2 ? a4[e] : a4[e + 2]); c2[e] = (b2 ? c4[e + 2] : c4[e]) + xor4f(b2 ? c4[e] : c4[e + 2]); }
        float av = (b1 ? a2[1] : a2[0]) + xor2f(b1 ? a2[0] : a2[1]), cv = (b1 ? c2[1] : c2[0]) + xor2f(b1 ? c2[0] : c2[1]);
        av += xor1f(av); cv += xor1f(cv);
        const int tokk = (b5 ? 16 : 0) + (b4 ? 8 : 0) + (b3 ? 4 : 0) + (b2 ? 2 : 0) + (b1 ? 1 : 0);
        __syncthreads();
        if ((lane & 1) == 0) { red[(tokk * 4 + wave) * 2] = av; red[(tokk * 4 + wave) * 2 + 1] = cv; }
        __syncthreads();
    }
#pragma unroll
    for (int tk = 0; tk < 32; ++tk) {
        const float4 ra = *(const float4*)(red + tk * 8), rb = *(const float4*)(red + tk * 8 + 4);
        const float t1 = (ra.x + ra.z) + (rb.x + rb.z);
        const float t2 = (ra.y + ra.w) + (rb.y + rb.w);
        const float mu = t1 * (1.0f / 256.0f);
        float var = t2 * (1.0f / 256.0f) - mu * mu; var = var < 0.f ? 0.f : var;
        float z = (y[tk] - mu) * (1.0f / sqrtf(var + 1e-6f)) * lg + lb;
        z = z * sigmoidf_(z);
        tile[tk * 256 + ch] = (half_t)z;
    }
    __syncthreads();
#pragma unroll
    for (int it = 0; it < 4; ++it) {
        const int c = it * 256 + ch, part = c & 3, tk = (c >> 2) & 31, pnl = c >> 7;
        *(h8*)(p->ycat + ((size_t)pnl * T_TOK + tokbase + t0 + tk) * 32 + part * 8) = *(const h8*)(tile + tk * 256 + pnl * 32 + part * 8);
    }
}

__device__ __forceinline__ void kmean_unit(KP p, char* lds, int b, int h, int blk) {
    float* part = (float*)lds;
    const int tid = TID(), c = tid & 7, rg = tid >> 3;
    const half_t* r = p->P + (size_t)(b * SEQ + blk * 256 + rg * 8) * NP + PC_MK + h * 64 + c * 8;
    h8 v[8];
#pragma unroll
    for (int k = 0; k < 8; ++k) v[k] = *(const h8*)(r + (size_t)k * NP);
    float sacc[8];
#pragma unroll
    for (int j = 0; j < 8; ++j) {
        float t = 0.f;
#pragma unroll
        for (int k = 0; k < 8; ++k) t += (float)v[k][j];
        sacc[j] = t;
    }
    __syncthreads();
    *(float4*)(part + rg * 64 + c * 8) = make_float4(sacc[0], sacc[1], sacc[2], sacc[3]);
    *(float4*)(part + rg * 64 + c * 8 + 4) = make_float4(sacc[4], sacc[5], sacc[6], sacc[7]);
    __syncthreads();
    if (tid < 64) {
        float t = 0.f;
#pragma unroll
        for (int g = 0; g < 32; ++g) t += part[g * 64 + tid];
        p->kmean[(((size_t)b * 6 + h) * 8 + blk) * 64 + tid] = t * (1.0f / 256.0f);
    }
}

#ifndef POST_MASK
#define POST_MASK 7
#endif
__device__ __forceinline__ void phase_post(KP p, char* lds, int l, int tm) {
    const int NA = 2048, NB = 1024, NC = 768;
    const int G_ = gridDim.x;
    for (int u0 = BID(), k_ = 0; u0 < NA + NB + NC; u0 += G_, ++k_) {
        int u = u0;
        if (u0 < NA && (k_ & 1) && (k_ + 1) * G_ <= NA) {
            const int idx_ = u0 - k_ * G_;
            u = k_ * G_ + ((G_ & 7) ? (G_ - 1 - idx_) : ((((G_ >> 3) - 1 - (idx_ >> 3)) << 3) | (idx_ & 7)));
        }
        if (u < NA) { const int r_ = u >> 3; if (tm & 1) dsa_select_unit(p, lds, 2 * (u & 7) + (r_ & 1), 127 - (r_ >> 1)); }
        else if (u < NA + NB) { const int v = u - NA, r_ = v >> 3; if (tm & 2) conv_unit(p, lds, l, 2 * (v & 7) + (r_ & 1), r_ >> 1); }
        else { const int v = u - NA - NB, r_ = v >> 3, hb = r_ >> 1; if (tm & 4) kmean_unit(p, lds, 2 * (v & 7) + (r_ & 1), hb >> 3, hb & 7); }
    }
}

template <int MODE>
__device__ __forceinline__ void attn_unit(KP p, char* lds, int b, int h, int qt) {
    const int tid = TID(), lane = tid & 63, wave = tid >> 6, hh = lane >> 5, ql = lane & 31;
    const int q0 = qt * 128, tokbase = b * SEQ;
    const int tq = q0 + wave * 32 + ql;
    const half_t* Pb = p->P + (size_t)tokbase * NP;
    const int QOFF = MODE ? PC_MQ + h * 64 : PC_DQ + h * 64;
    const int KOFF = MODE ? PC_MK + h * 64 : PC_DK;
    const int VOFF = MODE ? PC_MV + h * 64 : PC_DV;
    const int own = qt >> 1;
    unsigned mysel = 0u, anysel = 0u;
    __syncthreads();
    h8 qf[4];
#pragma unroll
    for (int ks = 0; ks < 4; ++ks) qf[ks] = *(const h8*)(Pb + (size_t)tq * NP + QOFF + 16 * ks + 8 * hh);
    if (MODE == 1) {
        float* km = (float*)(lds + 32768);
        unsigned* anyb = (unsigned*)(km + 512);
        for (int i = tid; i < 512; i += 256) km[i] = p->kmean[((size_t)b * 6 + h) * 512 + i];
        if (tid == 0) *anyb = 0u;
        __syncthreads();
        float gt[8];
#pragma unroll
        for (int j = 0; j < 8; ++j) {
            float sacc = 0.f;
            if (j < own) {
#pragma unroll
                for (int ks = 0; ks < 4; ++ks) {
                    const float4 k0 = *(const float4*)(km + j * 64 + 16 * ks + 8 * hh), k1 = *(const float4*)(km + j * 64 + 16 * ks + 8 * hh + 4);
                    sacc = fmaf((float)qf[ks][0], k0.x, sacc); sacc = fmaf((float)qf[ks][1], k0.y, sacc); sacc = fmaf((float)qf[ks][2], k0.z, sacc); sacc = fmaf((float)qf[ks][3], k0.w, sacc);
                    sacc = fmaf((float)qf[ks][4], k1.x, sacc); sacc = fmaf((float)qf[ks][5], k1.y, sacc); sacc = fmaf((float)qf[ks][6], k1.z, sacc); sacc = fmaf((float)qf[ks][7], k1.w, sacc);
                }
            }
            gt[j] = swapsum32(sacc, sacc);
        }
        unsigned m = 0u;
        const int want = own < 3 ? own : 3;
#pragma unroll
        for (int r = 0; r < 3; ++r) {
            if (r < want) {
                int best = -1; float bv = -INFINITY;
#pragma unroll
                for (int j = 0; j < 8; ++j) { if (j < own && !((m >> j) & 1u) && (best < 0 || gt[j] > bv)) { best = j; bv = gt[j]; } }
                m |= 1u << best;
            }
        }
        mysel = m;
        const unsigned wmk = wave_or(m);
        if (lane == 0 && wmk) atomicOr(anyb, wmk);
        __syncthreads();
        anysel = *anyb;
    }
    f16v O0, O1;
#pragma unroll
    for (int r = 0; r < 16; ++r) { O0[r] = 0.f; O1[r] = 0.f; }
    float l_run = 0.f;
    bool unset = true;
    f16v negm;
#pragma unroll
    for (int r = 0; r < 16; ++r) negm[r] = 0.f;
    const float THR = 8.0f;
    const int ntile = 2 * qt + 2;
    auto skip = [&](int kt) -> bool { return MODE == 1 && kt < 4 * own && !((anysel >> (kt >> 2)) & 1u); };
    auto nexttile = [&](int kt) -> int { ++kt; while (kt < ntile && skip(kt)) ++kt; return kt; };
    const int lrow = tid >> 3;
    const int kchunk = (tid & 7) ^ ((tid >> 4) & 7);
    const int vchunk = (tid & 7) ^ (((tid >> 4) & 1) << 2);
    char* ldst = lds + lrow * 128 + (tid & 7) * 16;
    auto issue = [&](int kt, int s) {
        const half_t* src = Pb + (size_t)(kt * 64 + lrow) * NP;
        char* d = ldst + s * 16384;
        glds16(src + KOFF + kchunk * 8, d);
        glds16(src + (size_t)32 * NP + KOFF + kchunk * 8, d + 4096);
        glds16(src + VOFF + vchunk * 8, d + 8192);
        glds16(src + (size_t)32 * NP + VOFF + vchunk * 8, d + 8192 + 4096);
    };
    const int rsw = (lane >> 1) & 7;
    const int kro = ql * 128;
    const int li = lane & 15, qp = li >> 2, pp = li & 3, swv = (qp >> 1) & 1;
    const int vb0 = 8192 + (4 * hh + qp) * 128 + 32 * ((lane >> 4) & 1) + 8 * pp + 64 * (0 ^ swv);
    const int vb1 = 8192 + (4 * hh + qp) * 128 + 32 * ((lane >> 4) & 1) + 8 * pp + 64 * (1 ^ swv);
    int kt = -1; kt = nexttile(kt);
    int s = 0;
    const unsigned* mrow = p->dmask + (size_t)(tokbase + tq) * 64;
    uint2 mwn = make_uint2(0u, 0u);
    if (MODE == 0) mwn = *(const uint2*)(mrow + 2 * kt);
    if (kt < ntile) issue(kt, 0);
    while (kt < ntile) {
        const int ktn = nexttile(kt);
        asm volatile("s_waitcnt vmcnt(0)" ::: "memory");
        __syncthreads();
        const uint2 mw = mwn;
        const bool wave_active = (kt * 64 <= q0 + wave * 32 + 31);
        if (!wave_active) {
            if (ktn < ntile) issue(ktn, s ^ 1);
            if (MODE == 0) mwn = *(const uint2*)(mrow + 2 * (ktn < ntile ? ktn : kt));
        }
        if (wave_active) {
            const char* base = lds + s * 16384;
            bool lane_on = true;
            if (MODE == 1 && kt < 4 * own) lane_on = (mysel >> (kt >> 2)) & 1u;
            f16v cin = negm;
            if (MODE == 1 && kt < 4 * own) {
#pragma unroll
                for (int r = 0; r < 16; ++r) cin[r] = lane_on ? negm[r] : -INFINITY;
            }
            f16v s0 = cin, s1 = cin;
#pragma unroll
            for (int ks = 0; ks < 4; ++ks) {
                const int co = ((2 * ks + hh) ^ rsw) << 4;
                const h8 k0 = *(const h8*)(base + kro + co), k1 = *(const h8*)(base + kro + 4096 + co);
                s0 = __builtin_amdgcn_mfma_f32_32x32x16_f16(k0, qf[ks], s0, 0, 0, 0);
                s1 = __builtin_amdgcn_mfma_f32_32x32x16_f16(k1, qf[ks], s1, 0, 0, 0);
            }
            h8 vf0[4], vf1[4];
#pragma unroll
            for (int kk = 0; kk < 4; ++kk) {
                const int roff = (32 * (kk >> 1) + 16 * (kk & 1)) * 128;
                const s4v lo0 = __builtin_amdgcn_ds_read_tr16_b64_v4i16((LAS s4v*)(base + vb0 + roff));
                const s4v hi0 = __builtin_amdgcn_ds_read_tr16_b64_v4i16((LAS s4v*)(base + vb0 + roff + 8 * 128));
                const s4v lo1 = __builtin_amdgcn_ds_read_tr16_b64_v4i16((LAS s4v*)(base + vb1 + roff));
                const s4v hi1 = __builtin_amdgcn_ds_read_tr16_b64_v4i16((LAS s4v*)(base + vb1 + roff + 8 * 128));
                vf0[kk] = __builtin_bit_cast(h8, __builtin_shufflevector(lo0, hi0, 0, 1, 2, 3, 4, 5, 6, 7));
                vf1[kk] = __builtin_bit_cast(h8, __builtin_shufflevector(lo1, hi1, 0, 1, 2, 3, 4, 5, 6, 7));
            }
            if (ktn < ntile) issue(ktn, s ^ 1);
            if (MODE == 0) mwn = *(const uint2*)(mrow + 2 * (ktn < ntile ? ktn : kt));
            if (MODE == 0) {
                const unsigned w0 = mw.x >> (4 * hh), w1 = mw.y >> (4 * hh);
#pragma unroll
                for (int r = 0; r < 16; ++r) {
                    const int pos = (r & 3) + 8 * (r >> 2);
                    const unsigned m0 = (unsigned)__builtin_amdgcn_sbfe((int)w0, pos, 1), m1 = (unsigned)__builtin_amdgcn_sbfe((int)w1, pos, 1);
                    s0[r] = __uint_as_float((__float_as_uint(s0[r]) & m0) | (0xFF800000u & ~m0));
                    s1[r] = __uint_as_float((__float_as_uint(s1[r]) & m1) | (0xFF800000u & ~m1));
                }
            } else if (kt >= 4 * own && kt * 64 + 63 > q0 + wave * 32) {
#pragma unroll
                for (int r = 0; r < 16; ++r) {
                    const int key = kt * 64 + (r & 3) + 8 * (r >> 2) + 4 * hh;
                    s0[r] = (key <= tq) ? s0[r] : -INFINITY;
                    s1[r] = (key + 32 <= tq) ? s1[r] : -INFINITY;
                }
            }
            float mx = s0[0];
#pragma unroll
            for (int r = 1; r < 16; ++r) mx = fmaxf(mx, s0[r]);
#pragma unroll
            for (int r = 0; r < 16; ++r) mx = fmaxf(mx, s1[r]);
            mx = swapmax32(mx);
            const bool need = unset ? (mx > -INFINITY) : (mx > THR);
            if (__any(need)) {
                const float delta = need ? mx : 0.f;
                const float alpha = (need && !unset) ? __builtin_amdgcn_exp2f(-delta) : 1.0f;
#pragma unroll
                for (int r = 0; r < 16; ++r) { s0[r] -= delta; s1[r] -= delta; negm[r] -= delta; O0[r] *= alpha; O1[r] *= alpha; }
                l_run *= alpha;
                unset = unset && !need;
            }
            float ls = 0.f;
#pragma unroll
            for (int r = 0; r < 16; ++r) { s0[r] = __builtin_amdgcn_exp2f(s0[r]); ls += s0[r]; }
#pragma unroll
            for (int r = 0; r < 16; ++r) { s1[r] = __builtin_amdgcn_exp2f(s1[r]); ls += s1[r]; }
            l_run += ls;
#pragma unroll
            for (int kk = 0; kk < 4; ++kk) {
                h8 pf;
#pragma unroll
                for (int j = 0; j < 8; ++j) pf[j] = (half_t)((kk >> 1) ? s1[8 * (kk & 1) + j] : s0[8 * (kk & 1) + j]);
                O0 = __builtin_amdgcn_mfma_f32_32x32x16_f16(vf0[kk], pf, O0, 0, 0, 0);
                O1 = __builtin_amdgcn_mfma_f32_32x32x16_f16(vf1[kk], pf, O1, 0, 0, 0);
            }
        }
        kt = ktn; s ^= 1;
    }
    const float lt = swapsum32(l_run, l_run);
    const float inv = 1.0f / lt;
    const int ycol = (MODE ? 640 : 256) + h * 64;
    half_t* dst = p->ycat + ((size_t)(ycol >> 5) * T_TOK + tokbase + tq) * 32 + 4 * hh;
#pragma unroll
    for (int g = 0; g < 4; ++g) {
        *(h4*)(dst + 8 * g) = pack4(O0[4 * g] * inv, O0[4 * g + 1] * inv, O0[4 * g + 2] * inv, O0[4 * g + 3] * inv);
        *(h4*)(dst + (size_t)T_TOK * 32 + 8 * g) = pack4(O1[4 * g] * inv, O1[4 * g + 1] * inv, O1[4 * g + 2] * inv, O1[4 * g + 3] * inv);
    }
}

#ifndef ATT_MASK
#define ATT_MASK 3
#endif
__device__ __forceinline__ void phase_attn(KP p, char* lds, int tm) {
    const int G_ = gridDim.x, per_ = G_ >> 3;
    const bool snake_ = (G_ >= 8) && ((G_ & 7) == 0);
    for (int k_ = 0, b_ = BID(); snake_ ? (k_ * per_ < 384) : (b_ + k_ * G_ < 3072); ++k_) {
        int xl, Lx;
        if (snake_) { const int idx_ = b_ >> 3; xl = b_ & 7; Lx = k_ * per_ + ((k_ & 1) ? (per_ - 1 - idx_) : idx_); }
        else { const int u = b_ + k_ * G_; xl = u & 7; Lx = u >> 3; }
        if (Lx >= 384) continue;
        const int qt = 15 - (Lx / 24), rem = Lx % 24;
        const int type = rem & 1, bh = xl * 12 + (rem >> 1);
        if (type == 0) { if (tm & 1) attn_unit<0>(p, lds, bh / 6, bh % 6, qt); }
        else { if (tm & 2) attn_unit<1>(p, lds, bh / 6, bh % 6, qt); }
    }
}

__global__ void __launch_bounds__(256, 2) mk_fwd(Params p_unused) {
    extern __shared__ __attribute__((aligned(16))) char lds[];
    volatile LAS unsigned* stw = (volatile LAS unsigned*)(lds + LDS_CTL);
    if (threadIdx.x < 8) stw[threadIdx.x] = 0u;
    __syncthreads();
    KP p0 = (KP)__builtin_amdgcn_kernarg_segment_ptr();
    XcdBarrier bar; bar.bar = p0->bar; bar.x = 0; bar.st = stw;
#if !MK_SPLIT
    bar = xcd_barrier_post(p0->bar, stw);
#endif
    const int ph_lo = p0->ph_lo, ph_hi = p0->ph_hi;
    for (int ph = ph_lo; ph < ph_hi; ++ph) {
      if (ph == 1) continue;
      KP p = p0; asm volatile("" : "+s"(p));
      const int nrep = (DUP_SUB >= 0 && ((DUP_SUB == 100 && ph == 0) || (ph >= 2 && ph < NPHASE - 1 && ((ph - 2) & 7) == DUP_SUB && (DUP_SUB != 4 || ph < 10)))) ? 2 : 1;
      for (int rep = 0; rep < nrep; ++rep) {
        if (ph == 0) phase_prologue(p, lds);
        else if (ph == NPHASE - 1) phase_norm<2, true, false>(p, lds, p->xr, p->g_final, nullptr, nullptr, 0);
        else {
            const int l = (ph - 2) >> 3, sub = (ph - 2) & 7;
            const float* mf = p->modf + (size_t)l * 16 * 6144;
            if (sub == 0) { if (l == 0) { phase_norm<0, false, true>(p, lds, p->x, p->g_mix + l * DM, mf, mf + 1024, l); phase_modsum(p); } else phase_norm<0, true, false>(p, lds, p->xr, p->g_mix + l * DM, mf, mf + 1024, l); }
            else if (sub == 1) phase_inproj(p, lds, l);
            else if (sub == 2) phase_post(p, lds, l, rep ? POST_MASK : 7);
            else if (sub == 3) phase_attn(p, lds, rep ? ATT_MASK : 3);
            else if (sub == 4) { if (l == 0) phase_outproj<false>(p, lds, l, p->x); else phase_outproj<true>(p, lds, l, p->xr); }
            else if (sub == 5) phase_norm_router(p, lds, p->xr, p->g_ffn + l * DM, mf + 3 * 1024, mf + 4 * 1024, (nrep == 2 && rep == 0) ? l + 2 : l);
            else if (sub == 6) phase_moe_up(p, lds, l);
            else phase_moe_down(p, lds, l, nrep == 2 ? 0.5f : 1.0f);
        }
      }
#if !MK_SPLIT
        if (ph + 1 < ph_hi) {
            const int sub_ = (ph - 2) & 7;
            const bool grid_ = ph == 0 || sub_ == 5 || sub_ == 7;
            xcd_barrier(bar, grid_);
        }
#endif
    }
}

extern "C" void kernel_launch(void* const* d_in, const int* in_sizes, int n_in, void* d_out, int out_size, void* d_ws, size_t ws_size, hipStream_t stream) {
    static int grid = 0;
    if (grid == 0) {
        int dev = 0, cus = 0, per_cu = 0;
        (void)hipGetDevice(&dev);
        (void)hipDeviceGetAttribute(&cus, hipDeviceAttributeMultiprocessorCount, dev);
        (void)hipFuncSetAttribute((const void*)mk_fwd, hipFuncAttributeMaxDynamicSharedMemorySize, LDS_BYTES);
        if (hipOccupancyMaxActiveBlocksPerMultiprocessor(&per_cu, (const void*)mk_fwd, 256, LDS_BYTES) != hipSuccess || per_cu < 1) per_cu = 1;
        (void)hipGetLastError();
        if (per_cu > 2) per_cu = 2;
        grid = cus * per_cu;
        if (grid < 1) grid = 1;
        if (T_TOK % (grid * 8) != 0) { int g2 = 1; while (g2 * 2 <= grid && g2 * 2 <= 4096) g2 *= 2; grid = g2; }
        fprintf(stderr, "mk_fwd: cus %d per_cu %d grid %d\n", cus, per_cu, grid);
    }
    Params p{};
    const float** pin = (const float**)&p.x;
    for (int i = 0; i < 18; ++i) pin[i] = (const float*)d_in[i];
    p.out = (float*)d_out;
    char* ws = (char*)d_ws;
    size_t off = 0;
    auto carve = [&](size_t bytes) { void* q = ws + off; off += (bytes + 255) & ~(size_t)255; return q; };
    p.bar = (unsigned*)carve(XCD_BAR_WORDS * 4);
    p.cnt = (int*)carve(4 * 32 * 64 * 4);
    const size_t zero_bytes = off;
    p.Wt_in = (half_t*)carve((size_t)2 * NP * DM * 2);
    p.Wt_o = (half_t*)carve((size_t)2 * DM * DM * 2);
    p.Wt_gu = (half_t*)carve((size_t)2 * 16 * 512 * 1024 * 2);
    p.Wt_d = (half_t*)carve((size_t)2 * 16 * 1024 * 256 * 2);
    p.hn = (half_t*)carve((size_t)T_TOK * DM * 2);
    p.P = (half_t*)carve((size_t)T_TOK * NP * 2);
    p.ycat = (half_t*)carve((size_t)T_TOK * DM * 2);
    p.act = (half_t*)carve((size_t)T_TOK * 512 * 2);
    p.xr = (half_t*)carve((size_t)T_TOK * DM * 2);
    p.modpart = (float*)carve((size_t)8 * 2 * 16 * 6144 * 4);
    p.modf = (float*)carve((size_t)2 * 16 * 6144 * 4);
    p.kmean = (float*)carve((size_t)16 * 6 * 8 * 64 * 4);
    p.rope = (float*)carve((size_t)2048 * 24 * 4);
    p.iwf = (float*)carve((size_t)T_TOK * 4 * 4);
    p.tokw = (float*)carve((size_t)T_TOK * 2 * 4);
    p.dmask = (unsigned*)carve((size_t)T_TOK * 64 * 4);
    p.lists = (int*)carve((size_t)NCLS * T_TOK * 4);
    if (off > ws_size) { fprintf(stderr, "workspace too small: need %zu have %zu\n", off, ws_size); return; }
    (void)hipMemsetAsync(d_ws, 0, zero_bytes, stream);
#if MK_SPLIT
    for (int ph = 0; ph < NPHASE; ++ph) {
        p.ph_lo = ph; p.ph_hi = ph + 1;
        hipLaunchKernelGGL(mk_fwd, dim3(grid), dim3(256), LDS_BYTES, stream, p);
    }
#else
    p.ph_lo = 0; p.ph_hi = NPHASE;
    hipLaunchKernelGGL(mk_fwd, dim3(grid), dim3(256), LDS_BYTES, stream, p);
#endif
}
```
